# Optimizing an MI355X kernel written in HIP

```python
import math
import jax, jax.numpy as jnp
from jax import lax
import numpy as np

D_MODEL = 1024
BATCH = 8
SEQ = 4096
DEPTH = 2

F32 = jnp.float32
HEAD_DIM = 64
HG_WIDTH = D_MODEL // 4
HG_HEADS = HG_WIDTH // HEAD_DIM
HG_CHUNK = 64
GM_WIDTH = D_MODEL // 4
GM_GROUPS = GM_WIDTH // HEAD_DIM
GM_CHUNK = 128
NSA_WIDTH = D_MODEL // 2
NSA_HEADS = NSA_WIDTH // HEAD_DIM
NSA_KV_GROUPS = 2
NSA_HPG = NSA_HEADS // NSA_KV_GROUPS
NSA_KV_WIDTH = NSA_KV_GROUPS * HEAD_DIM
CMP_BLOCK = 32
CMP_STRIDE = 16
CMP_HIDDEN = 128
SEL_BLOCK = 64
N_SEL = 16
WINDOW = 512
NSA_QBLOCK = 64
N_GATES = 3
IMP_FORCE = 1e9
IMP_FUTURE = -1e9
NEG_INF = -1e30
MIX_WIDTH = HG_WIDTH + GM_WIDTH + NSA_WIDTH
IN_SPLITS = (HG_WIDTH,) * 4 + (GM_WIDTH,) * 2 + (NSA_WIDTH,) + (NSA_KV_WIDTH,) * 6 + (NSA_HEADS * N_GATES,)
IN_WIDTH = sum(IN_SPLITS)
N_EXPERTS = 32
TOP_K = 4
D_EXPERT = D_MODEL
SWIGLU_ALPHA = 1.702
SWIGLU_LIMIT = 7.0
EXPERT_BLOCK = 512
ROPE_THETA = 10000.0
DEEPNORM_ALPHA = (2 * DEPTH) ** 0.25
DEEPNORM_BETA = (8 * DEPTH) ** -0.25
LN_EPS = 1e-5
RMS_EPS = 1e-6

kernel_name = "hybrid_hgrn2_gmlp_nsa_moe_deepnorm"


def layer_norm(x, w, b):
    xf = x.astype(F32)
    mu = jnp.mean(xf, axis=-1, keepdims=True)
    var = jnp.mean(jnp.square(xf - mu), axis=-1, keepdims=True)
    return ((xf - mu) * lax.rsqrt(var + LN_EPS) * w.astype(F32) + b.astype(F32)).astype(x.dtype)


def rms_norm_heads(x, w):
    shp = x.shape
    xf = x.astype(F32).reshape(shp[:-1] + (shp[-1] // HEAD_DIM, HEAD_DIM))
    xf = xf * lax.rsqrt(jnp.mean(jnp.square(xf), axis=-1, keepdims=True) + RMS_EPS)
    return (xf.reshape(shp) * w.astype(F32)).astype(x.dtype)


def masked_softmax(s, mask):
    s = jnp.where(mask, s.astype(F32), NEG_INF)
    return jax.nn.softmax(s, axis=-1) * mask


def rope_tables(positions):
    inv = ROPE_THETA ** (-jnp.arange(0, HEAD_DIM, 2, dtype=F32) / HEAD_DIM)
    ang = positions.astype(F32)[..., None] * inv
    return jnp.cos(ang)[:, :, None, :], jnp.sin(ang)[:, :, None, :]


def apply_rope(x, cos, sin):
    xf = x.astype(F32)
    x1, x2 = xf[..., :HEAD_DIM // 2], xf[..., HEAD_DIM // 2:]
    return jnp.concatenate([x1 * cos - x2 * sin, x2 * cos + x1 * sin], axis=-1).astype(x.dtype)


def hgrn2_mixer(q, f_raw, v, gate, lb, norm_w):
    B, S, _ = q.shape
    H, Dk, C = HG_HEADS, HEAD_DIM, HG_CHUNK
    n_ch = S // C
    dt = q.dtype
    lb = lb.astype(F32)
    f_raw = f_raw.astype(F32)
    qf = jax.nn.silu(q.astype(F32))
    log_f = jnp.logaddexp(jnp.log(lb), jnp.log1p(-lb) + jax.nn.log_sigmoid(f_raw))
    k = (1.0 - lb) * jax.nn.sigmoid(-f_raw)

    def chunks(a):
        return a.reshape(B, n_ch, C, H, Dk).transpose(1, 0, 3, 2, 4)

    causal = jnp.tril(jnp.ones((C, C), dtype=bool))

    def step(state, inp):
        qc, kc, vc, gc = inp
        b = jnp.cumsum(gc, axis=2)
        diff = b[:, :, :, None, :] - b[:, :, None, :, :]
        decay = jnp.exp(jnp.where(causal[:, :, None], diff, -jnp.inf))
        attn = jnp.einsum('bhtk,bhtsk,bhsk->bhts', qc, decay, kc)
        o = (jnp.einsum('bhts,bhsv->bhtv', attn, vc)
             + jnp.einsum('bhtk,bhkv->bhtv', qc * jnp.exp(b), state))
        b_last = b[:, :, -1]
        state = (jnp.exp(b_last)[..., None] * state
                 + jnp.einsum('bhsk,bhsv->bhkv', kc * jnp.exp(b_last[:, :, None] - b), vc))
        return state, o

    s0 = jnp.zeros((B, H, Dk, Dk), F32)
    _, o = lax.scan(step, s0, (chunks(qf), chunks(k), chunks(v.astype(F32)), chunks(log_f)))
    o = o.transpose(1, 0, 3, 2, 4).reshape(B, S, H * Dk)
    return (rms_norm_heads(o, norm_w) * jax.nn.sigmoid(gate.astype(F32))).astype(dt)


def gmlp_mixer(u, v, ln_w, ln_b, w_s, b_s, norm_w):
    B, S, _ = u.shape
    n_ch = S // GM_CHUNK
    u = jax.nn.gelu(u)
    v = layer_norm(jax.nn.gelu(v), ln_w, ln_b)
    v = v.reshape(B, n_ch, GM_CHUNK, GM_GROUPS, HEAD_DIM)
    w = w_s * jnp.tril(jnp.ones((GM_CHUNK, GM_CHUNK), w_s.dtype))
    sv = jnp.einsum('gts,bnsgc->bntgc', w, v) + b_s.T[:, :, None]
    return rms_norm_heads(u * sv.reshape(B, S, GM_WIDTH), norm_w)


def compress_blocks(k, pe, w1, w2):
    B, S, G, Dh = k.shape
    n_cmp = (S - CMP_BLOCK) // CMP_STRIDE + 1
    idx = np.arange(n_cmp)[:, None] * CMP_STRIDE + np.arange(CMP_BLOCK)[None, :]
    blk = k[:, idx] + pe[:, None, :]
    blk = blk.transpose(0, 3, 1, 2, 4).reshape(B, G, n_cmp, CMP_BLOCK * Dh)
    return jax.nn.gelu(blk @ w1) @ w2


def nsa_mixer(q, k_c, v_c, k_s, v_s, k_w, v_w, gates, pe, w1, w2, cos, sin):
    B, S, H, Dh = q.shape
    G, HPG, QB = NSA_KV_GROUPS, NSA_HPG, NSA_QBLOCK
    nqb = S // QB
    scale = 1.0 / math.sqrt(Dh)
    kc = compress_blocks(k_c, pe[0], w1[0], w2[0])
    vc = compress_blocks(v_c, pe[1], w1[1], w2[1])
    n_cmp = kc.shape[2]
    cmp_end = jnp.asarray(np.arange(n_cmp) * CMP_STRIDE + CMP_BLOCK - 1)
    n_sb = S // SEL_BLOCK
    n_sel = min(N_SEL, n_sb)
    units = np.arange(n_cmp)[:, None] + np.arange(CMP_BLOCK // CMP_STRIDE)[None, :]
    overlap = jax.nn.one_hot(units // (SEL_BLOCK // CMP_STRIDE), n_sb, dtype=F32).sum(axis=1)
    q_rot = apply_rope(q, cos, sin)
    ks_r = apply_rope(k_s, cos, sin)
    kw_r = apply_rope(k_w, cos, sin)
    ks_blk = ks_r.reshape(B, n_sb, SEL_BLOCK, G, Dh).transpose(0, 3, 1, 2, 4)
    vs_blk = v_s.reshape(B, n_sb, SEL_BLOCK, G, Dh).transpose(0, 3, 1, 2, 4)
    pad = ((0, 0), (WINDOW, 0), (0, 0), (0, 0))
    kw_pad = jnp.pad(kw_r, pad)
    vw_pad = jnp.pad(v_w, pad)
    b_idx = jnp.arange(B)[:, None, None, None]
    g_idx = jnp.arange(G)[None, :, None, None]

    def to_blocks(a):
        return a.reshape((B, nqb, QB) + a.shape[2:]).swapaxes(0, 1)

    def grouped(a):
        return a.reshape(B, QB, G, HPG, a.shape[-1]).transpose(0, 2, 3, 1, 4)

    def block_fn(args):
        qb_raw, qb_rot, gb, qi = args
        t = qi * QB + jnp.arange(QB)
        qc = grouped(qb_raw) * scale
        qr = grouped(qb_rot) * scale
        p_c = masked_softmax(jnp.einsum('bghqd,bgcd->bghqc', qc, kc), cmp_end[None, :] <= t[:, None])
        o_c = jnp.einsum('bghqc,bgcd->bghqd', p_c.astype(vc.dtype), vc)
        imp = jnp.einsum('bghqc,cj->bgqj', p_c, overlap)
        j = jnp.arange(n_sb)[None, :]
        cur = (t // SEL_BLOCK)[:, None]
        imp = jnp.where(j > cur, IMP_FUTURE, imp)
        imp = jnp.where((j == 0) | (j == cur) | (j == cur - 1), IMP_FORCE, imp)
        _, sel = lax.top_k(imp, n_sel)
        k_sel = ks_blk[b_idx, g_idx, sel].reshape(B, G, QB, n_sel * SEL_BLOCK, Dh)
        v_sel = vs_blk[b_idx, g_idx, sel].reshape(B, G, QB, n_sel * SEL_BLOCK, Dh)
        kpos = (sel[..., None] * SEL_BLOCK + jnp.arange(SEL_BLOCK)).reshape(B, G, QB, n_sel * SEL_BLOCK)
        m_s = kpos <= t[:, None]
        p_s = masked_softmax(jnp.einsum('bghqd,bgqkd->bghqk', qr, k_sel), m_s[:, :, None])
        o_s = jnp.einsum('bghqk,bgqkd->bghqd', p_s.astype(v_sel.dtype), v_sel)
        kw = lax.dynamic_slice_in_dim(kw_pad, qi * QB, QB + WINDOW, axis=1).transpose(0, 2, 1, 3)
        vw = lax.dynamic_slice_in_dim(vw_pad, qi * QB, QB + WINDOW, axis=1).transpose(0, 2, 1, 3)
        wpos = qi * QB - WINDOW + jnp.arange(QB + WINDOW)
        m_w = (wpos[None, :] <= t[:, None]) & (wpos[None, :] > t[:, None] - WINDOW)
        p_w = masked_softmax(jnp.einsum('bghqd,bgkd->bghqk', qr, kw), m_w)
        o_w = jnp.einsum('bghqk,bgkd->bghqd', p_w.astype(vw.dtype), vw)
        g = grouped(gb)
        o = g[..., 0:1] * o_c + g[..., 1:2] * o_s + g[..., 2:3] * o_w
        return o.transpose(0, 3, 1, 2, 4).reshape(B, QB, H * Dh)

    out = lax.map(block_fn, (to_blocks(q), to_blocks(q_rot), to_blocks(gates), jnp.arange(nqb)))
    return out.swapaxes(0, 1).reshape(B, S, H * Dh)


def moe_ffn(x2d, router_w, router_b, w_up, b_up, w_down, b_down):
    N, D = x2d.shape
    logits = x2d.astype(F32) @ router_w.astype(F32) + router_b.astype(F32)
    top_logit, top_e = lax.top_k(logits, TOP_K)
    top_w = jax.nn.softmax(top_logit, axis=-1)
    n_assign = N * TOP_K
    flat_e = top_e.reshape(-1)
    order = jnp.argsort(flat_e)
    sorted_e = flat_e[order]
    sorted_tok = (order // TOP_K).astype(jnp.int32)
    counts = jnp.bincount(flat_e, length=N_EXPERTS)
    padded = (counts + EXPERT_BLOCK - 1) // EXPERT_BLOCK * EXPERT_BLOCK
    start = jnp.cumsum(counts) - counts
    pad_end = jnp.cumsum(padded)
    pad_start = pad_end - padded
    dest = pad_start[sorted_e] + jnp.arange(n_assign) - start[sorted_e]
    n_blocks = -(-(n_assign + N_EXPERTS * (EXPERT_BLOCK - 1)) // EXPERT_BLOCK)
    n_rows = n_blocks * EXPERT_BLOCK
    tok_buf = jnp.full((n_rows,), N, jnp.int32).at[dest].set(sorted_tok)
    w_buf = jnp.zeros((n_rows,), F32).at[dest].set(top_w.reshape(-1)[order])
    block_e = jnp.clip(jnp.searchsorted(pad_end, jnp.arange(n_blocks) * EXPERT_BLOCK, side='right'),
                       0, N_EXPERTS - 1)
    x_pad = jnp.concatenate([x2d, jnp.zeros((1, D), x2d.dtype)], axis=0)
    xb = x_pad[tok_buf].reshape(n_blocks, EXPERT_BLOCK, D)

    def expert_block(args):
        xe, e = args
        h = xe @ w_up[e] + b_up[e]
        glu = jnp.minimum(h[:, :D_EXPERT], SWIGLU_LIMIT)
        lin = jnp.clip(h[:, D_EXPERT:], -SWIGLU_LIMIT, SWIGLU_LIMIT)
        act = glu * jax.nn.sigmoid(SWIGLU_ALPHA * glu) * (lin + 1.0)
        return act @ w_down[e] + b_down[e]

    yb = lax.map(expert_block, (xb, block_e)).reshape(n_rows, D)
    out = jax.ops.segment_sum(yb * w_buf[:, None].astype(yb.dtype), tok_buf, num_segments=N + 1)
    return out[:N]


def setup_inputs(seed: int = 0) -> dict:
    key = jax.random.key(seed)
    ks = jax.random.split(key, 32)
    L, D, E, Fd = DEPTH, D_MODEL, N_EXPERTS, D_EXPERT

    def nrm(k, shape, scale):
        return scale * jax.random.normal(k, shape, F32)

    def gain(k, shape):
        return 1.0 + 0.1 * jax.random.normal(k, shape, F32)

    positions = (jnp.arange(SEQ, dtype=jnp.int32)[None, :]
                 + jax.random.randint(ks[1], (BATCH, 1), 0, 1024, dtype=jnp.int32))
    return {
        "x": nrm(ks[0], (BATCH, SEQ, D), 1.0),
        "positions": positions,
        "w_in": nrm(ks[2], (L, D, IN_WIDTH), D ** -0.5),
        "hg_lower_bounds": nrm(ks[3], (L, HG_WIDTH), 1.0),
        "hg_norm_w": gain(ks[4], (L, HG_WIDTH)),
        "gm_ln_w": gain(ks[5], (L, GM_WIDTH)),
        "gm_ln_b": nrm(ks[6], (L, GM_WIDTH), 0.02),
        "gm_spatial_w": nrm(ks[7], (L, GM_GROUPS, GM_CHUNK, GM_CHUNK), GM_CHUNK ** -0.5),
        "gm_spatial_b": gain(ks[8], (L, GM_GROUPS, GM_CHUNK)),
        "gm_norm_w": gain(ks[9], (L, GM_WIDTH)),
        "nsa_cmp_pe": nrm(ks[10], (L, 2, CMP_BLOCK, HEAD_DIM), 0.1),
        "nsa_cmp_w1": nrm(ks[11], (L, 2, CMP_BLOCK * HEAD_DIM, CMP_HIDDEN), (CMP_BLOCK * HEAD_DIM) ** -0.5),
        "nsa_cmp_w2": nrm(ks[12], (L, 2, CMP_HIDDEN, HEAD_DIM), CMP_HIDDEN ** -0.5),
        "nsa_norm_w": gain(ks[13], (L, NSA_WIDTH)),
        "w_out": nrm(ks[14], (L, MIX_WIDTH, D), DEEPNORM_BETA * MIX_WIDTH ** -0.5),
        "ln1_w": gain(ks[15], (L, D)),
        "ln1_b": nrm(ks[16], (L, D), 0.02),
        "router_w": nrm(ks[17], (L, D, E), D ** -0.5),
        "router_b": nrm(ks[18], (L, E), 0.01),
        "exp_w_up": nrm(ks[19], (L, E, D, 2 * Fd), D ** -0.5),
        "exp_b_up": nrm(ks[20], (L, E, 2 * Fd), 0.01),
        "exp_w_down": nrm(ks[21], (L, E, Fd, D), DEEPNORM_BETA * Fd ** -0.5),
        "exp_b_down": nrm(ks[22], (L, E, D), 0.01),
        "ln2_w": gain(ks[23], (L, D)),
        "ln2_b": nrm(ks[24], (L, D), 0.02),
    }


def reference(x, positions, w_in, hg_lower_bounds, hg_norm_w, gm_ln_w, gm_ln_b, gm_spatial_w,
              gm_spatial_b, gm_norm_w, nsa_cmp_pe, nsa_cmp_w1, nsa_cmp_w2, nsa_norm_w, w_out,
              ln1_w, ln1_b, router_w, router_b, exp_w_up, exp_b_up, exp_w_down, exp_b_down,
              ln2_w, ln2_b):
    B, S, D = x.shape
    cos, sin = rope_tables(positions)
    lb_all = jnp.cumsum(jax.nn.softmax(hg_lower_bounds.astype(F32), axis=0), axis=0)
    lb_all = lb_all - lb_all[0:1]
    split_points = [int(p) for p in np.cumsum(IN_SPLITS)[:-1]]

    def heads(a, n):
        return a.reshape(B, S, n, HEAD_DIM)

    for l in range(DEPTH):
        h = x @ w_in[l]
        (hg_q, hg_f, hg_i, hg_g, gm_u, gm_v, nsa_q, k_c, v_c, k_s, v_s, k_w, v_w,
         nsa_g) = jnp.split(h, split_points, axis=-1)
        y_hg = hgrn2_mixer(hg_q, hg_f, hg_i, hg_g, lb_all[l], hg_norm_w[l])
        y_gm = gmlp_mixer(gm_u, gm_v, gm_ln_w[l], gm_ln_b[l], gm_spatial_w[l], gm_spatial_b[l], gm_norm_w[l])
        gates = jax.nn.sigmoid(nsa_g).reshape(B, S, NSA_HEADS, N_GATES)
        y_nsa = nsa_mixer(heads(nsa_q, NSA_HEADS), heads(k_c, NSA_KV_GROUPS), heads(v_c, NSA_KV_GROUPS),
                          heads(k_s, NSA_KV_GROUPS), heads(v_s, NSA_KV_GROUPS), heads(k_w, NSA_KV_GROUPS),
                          heads(v_w, NSA_KV_GROUPS), gates, nsa_cmp_pe[l], nsa_cmp_w1[l], nsa_cmp_w2[l],
                          cos, sin)
        y_nsa = rms_norm_heads(y_nsa, nsa_norm_w[l])
        mix = jnp.concatenate([y_hg, y_gm, y_nsa], axis=-1) @ w_out[l]
        x = layer_norm(DEEPNORM_ALPHA * x + mix, ln1_w[l], ln1_b[l])
        moe_out = moe_ffn(x.reshape(B * S, D), router_w[l], router_b[l], exp_w_up[l], exp_b_up[l],
                          exp_w_down[l], exp_b_down[l]).reshape(B, S, D)
        x = layer_norm(DEEPNORM_ALPHA * x + moe_out, ln2_w[l], ln2_b[l])
    return x
```

```cpp
#include <hip/hip_runtime.h>
#include <cstdio>
#include <cstdint>
#include <cmath>

namespace nv {
constexpr int B_ = 8, S_ = 4096, D_ = 1024, NT = B_ * S_, DEPTH = 2;
constexpr int INW = 2840;
constexpr int C_HGQ = 0, C_HGF = 256, C_HGI = 512, C_HGG = 768, C_GMU = 1024, C_GMV = 1280, C_NQ = 1536,
              C_KC = 2048, C_VC = 2176, C_KS = 2304, C_VS = 2432, C_KW = 2560, C_VW = 2688, C_NG = 2816;
constexpr int NCMP = 255, NE = 32, TOPK = 4, NASSIGN = NT * TOPK;
constexpr float ALPHA = 1.4142135623730951f;

__device__ __forceinline__ float gelu_t(float x) { return 0.5f * x * (1.0f + tanhf(0.7978845608028654f * (x + 0.044715f * x * x * x))); }
__device__ __forceinline__ float sigm(float x) { return 1.0f / (1.0f + expf(-x)); }
__device__ __forceinline__ float wsum(float v) {
#pragma unroll
    for (int o = 1; o < 64; o <<= 1) v += __shfl_xor(v, o);
    return v;
}
__device__ __forceinline__ float wmax(float v) {
#pragma unroll
    for (int o = 1; o < 64; o <<= 1) v = fmaxf(v, __shfl_xor(v, o));
    return v;
}

__global__ void prep_k(const int* __restrict__ pos, const float* __restrict__ hg_lb, float* __restrict__ cosT, float* __restrict__ sinT, float* __restrict__ lb) {
    int i = blockIdx.x * blockDim.x + threadIdx.x;
    if (i < NT * 32) {
        int t = i >> 5, j = i & 31;
        float inv = (float)pow(10000.0, -(double)(2 * j) / 64.0);
        float ang = (float)pos[t] * inv;
        double a = (double)ang;
        cosT[i] = (float)cos(a); sinT[i] = (float)sin(a);
    }
    if (i < 256) {
        float a = hg_lb[i], b = hg_lb[256 + i];
        float m = fmaxf(a, b); float ea = expf(a - m), eb = expf(b - m);
        lb[i] = 0.f; lb[256 + i] = eb / (ea + eb);
    }
}

struct GemmP {
    const float* A; int lda; const int* arow;
    const float* B; int ldb;
    float* C; int ldc;
    int M, N, K;
    const float* bias;
    const int* cnt; const int* offs; const int* list;
    size_t strideB; size_t strideBias;
};
template <int MODE>
__global__ void __launch_bounds__(256) sgemm_k(GemmP p) {
    __shared__ float As[16][132];
    __shared__ float Bs[16][132];
    __shared__ const float* rowp[128];
    __shared__ float* crow[128];
    const int tid = threadIdx.x, tx = tid & 15, ty = tid >> 4;
    int M = p.M; const float* Bm = p.B; const float* bias = p.bias;
    const int m0 = blockIdx.y * 128, n0 = blockIdx.x * 128;
    if (MODE != 0) {
        const int e = blockIdx.z; M = p.cnt[e];
        if (m0 >= M) return;
        Bm = p.B + (size_t)e * p.strideB; bias = p.bias + (size_t)e * p.strideBias;
        if (tid < 128) {
            int r = m0 + tid;
            if (r < M) {
                if (MODE == 1) { int tok = p.list[e * NT + r]; rowp[tid] = p.A + (size_t)tok * p.lda; }
                else rowp[tid] = p.A + (size_t)(p.offs[e] + r) * p.lda;
                crow[tid] = p.C + (size_t)(p.offs[e] + r) * p.ldc;
            } else { rowp[tid] = nullptr; crow[tid] = nullptr; }
        }
    } else {
        if (tid < 128) {
            int r = m0 + tid;
            if (r < M) { rowp[tid] = p.A + (size_t)r * p.lda; crow[tid] = p.C + (size_t)r * p.ldc; }
            else { rowp[tid] = nullptr; crow[tid] = nullptr; }
        }
    }
    __syncthreads();
    float acc[8][8];
#pragma unroll
    for (int i = 0; i < 8; ++i)
#pragma unroll
        for (int j = 0; j < 8; ++j) acc[i][j] = 0.f;
    const int bcc = tid & 127, bk0 = tid >> 7;
    int bcol;
    if (MODE == 1) bcol = (bcc < 64) ? (n0 / 2 + bcc) : (1024 + n0 / 2 + bcc - 64);
    else bcol = n0 + bcc;
    const bool bvalid = (MODE == 1) ? true : (bcol < p.N);
    const int ar = tid >> 2, ak = (tid & 3) * 4;
    for (int k0 = 0; k0 < p.K; k0 += 16) {
#pragma unroll
        for (int i = 0; i < 2; ++i) {
            const float* rp = rowp[ar + 64 * i];
            float4 v = make_float4(0.f, 0.f, 0.f, 0.f);
            if (rp) v = *(const float4*)(rp + k0 + ak);
            As[ak + 0][ar + 64 * i] = v.x; As[ak + 1][ar + 64 * i] = v.y; As[ak + 2][ar + 64 * i] = v.z; As[ak + 3][ar + 64 * i] = v.w;
        }
#pragma unroll
        for (int i = 0; i < 8; ++i) {
            int kk = bk0 + 2 * i;
            Bs[kk][bcc] = bvalid ? Bm[(size_t)(k0 + kk) * p.ldb + bcol] : 0.f;
        }
        __syncthreads();
#pragma unroll
        for (int kk = 0; kk < 16; ++kk) {
            float a[8], b[8];
#pragma unroll
            for (int i = 0; i < 4; ++i) { a[i] = As[kk][ty * 4 + i]; a[4 + i] = As[kk][64 + ty * 4 + i]; }
#pragma unroll
            for (int j = 0; j < 4; ++j) { b[j] = Bs[kk][tx * 4 + j]; b[4 + j] = Bs[kk][64 + tx * 4 + j]; }
#pragma unroll
            for (int i = 0; i < 8; ++i)
#pragma unroll
                for (int j = 0; j < 8; ++j) acc[i][j] = fmaf(a[i], b[j], acc[i][j]);
        }
        __syncthreads();
    }
#pragma unroll
    for (int i = 0; i < 8; ++i) {
        const int rl = (i < 4) ? (ty * 4 + i) : (64 + ty * 4 + i - 4);
        float* cp = crow[rl];
        if (!cp) continue;
        if (MODE == 1) {
#pragma unroll
            for (int j = 0; j < 4; ++j) {
                const int jc = n0 / 2 + tx * 4 + j;
                float hg = acc[i][j] + bias[jc], hl = acc[i][4 + j] + bias[1024 + jc];
                float glu = fminf(hg, 7.0f), lin = fminf(fmaxf(hl, -7.0f), 7.0f);
                cp[jc] = glu * sigm(1.702f * glu) * (lin + 1.0f);
            }
        } else {
#pragma unroll
            for (int j = 0; j < 8; ++j) {
                const int c = n0 + ((j < 4) ? (tx * 4 + j) : (64 + tx * 4 + j - 4));
                if (c < p.N) cp[c] = acc[i][j] + (bias ? bias[c] : 0.f);
            }
        }
    }
}

__global__ void __launch_bounds__(64) hgrn2_k(const float* __restrict__ h, const float* __restrict__ lbl, const float* __restrict__ normw, float* __restrict__ ycat) {
    const int b = blockIdx.x >> 2, hd = blockIdx.x & 3, lane = threadIdx.x;
    float s[64];
#pragma unroll
    for (int k = 0; k < 64; ++k) s[k] = 0.f;
    const float lb = lbl[hd * 64 + lane], nw = normw[hd * 64 + lane];
    for (int t = 0; t < S_; ++t) {
        const float* hr = h + (size_t)(b * S_ + t) * INW + hd * 64 + lane;
        float qr = hr[C_HGQ], fr = hr[C_HGF], iv = hr[C_HGI], gt = hr[C_HGG];
        float qv = qr * sigm(qr);
        float fv = lb + (1.0f - lb) * sigm(fr);
        float kv = (1.0f - lb) * sigm(-fr);
        float o = 0.f;
#pragma unroll
        for (int k = 0; k < 64; ++k) {
            float fk = __shfl(fv, k), kk = __shfl(kv, k), qk = __shfl(qv, k);
            s[k] = fk * s[k] + kk * iv;
            o = fmaf(qk, s[k], o);
        }
        float ms = wsum(o * o) * (1.0f / 64.0f);
        float y = o * rsqrtf(ms + 1e-6f) * nw * sigm(gt);
        ycat[(size_t)(b * S_ + t) * D_ + hd * 64 + lane] = y;
    }
}

__global__ void __launch_bounds__(256) gm_ln_k(const float* __restrict__ h, const float* __restrict__ lw, const float* __restrict__ lbias, float* __restrict__ vln) {
    __shared__ float red[8];
    const int t = blockIdx.x, c = threadIdx.x;
    float v = gelu_t(h[(size_t)t * INW + C_GMV + c]);
    float s = wsum(v);
    if ((c & 63) == 0) red[c >> 6] = s;
    __syncthreads();
    float mean = (red[0] + red[1] + red[2] + red[3]) * (1.0f / 256.0f);
    float d = v - mean;
    float q = wsum(d * d);
    if ((c & 63) == 0) red[4 + (c >> 6)] = q;
    __syncthreads();
    float var = (red[4] + red[5] + red[6] + red[7]) * (1.0f / 256.0f);
    vln[(size_t)t * 256 + c] = d * rsqrtf(var + 1e-5f) * lw[c] + lbias[c];
}
__global__ void __launch_bounds__(256) gm_sp_k(const float* __restrict__ h, const float* __restrict__ vln, const float* __restrict__ ws, const float* __restrict__ bs,
                                                const float* __restrict__ normw, float* __restrict__ ycat) {
    const int tok = blockIdx.x, c = threadIdx.x, g = c >> 6;
    const int tl = tok & 127, base = tok - tl;
    const float* w = ws + ((size_t)g * 128 + tl) * 128;
    float acc = 0.f;
    for (int s = 0; s <= tl; ++s) acc = fmaf(w[s], vln[(size_t)(base + s) * 256 + c], acc);
    acc += bs[g * 128 + tl];
    float u = gelu_t(h[(size_t)tok * INW + C_GMU + c]);
    float z = u * acc;
    float ms = wsum(z * z) * (1.0f / 64.0f);
    ycat[(size_t)tok * D_ + 256 + c] = z * rsqrtf(ms + 1e-6f) * normw[c];
}

__global__ void __launch_bounds__(128) cmp_k(const float* __restrict__ h, const float* __restrict__ pe, const float* __restrict__ w1, const float* __restrict__ w2,
                                              float* __restrict__ kc, float* __restrict__ vc) {
    __shared__ float blk[2048];
    __shared__ float hid[128];
    int id = blockIdx.x; const int kv = id & 1; id >>= 1; const int c = id % NCMP; id /= NCMP; const int g = id & 1; const int b = id >> 1;
    const int n = threadIdx.x;
    const int col = (kv ? C_VC : C_KC) + g * 64;
    for (int i = n; i < 2048; i += 128) { int j = i >> 6, d = i & 63; blk[i] = h[(size_t)(b * S_ + 16 * c + j) * INW + col + d] + pe[kv * 2048 + i]; }
    __syncthreads();
    const float* w1p = w1 + (size_t)kv * 2048 * 128 + n;
    float a = 0.f;
    for (int i = 0; i < 2048; ++i) a = fmaf(blk[i], w1p[(size_t)i * 128], a);
    hid[n] = gelu_t(a);
    __syncthreads();
    if (n < 64) {
        const float* w2p = w2 + (size_t)kv * 128 * 64 + n;
        float o = 0.f;
        for (int i = 0; i < 128; ++i) o = fmaf(hid[i], w2p[i * 64], o);
        (kv ? vc : kc)[((size_t)(b * 2 + g) * NCMP + c) * 64 + n] = o;
    }
}

__global__ void __launch_bounds__(256) rope_k(const float* __restrict__ h, const float* __restrict__ cosT, const float* __restrict__ sinT,
                                               float* __restrict__ qrot, float* __restrict__ ksr, float* __restrict__ kwr) {
    const int t = blockIdx.x;
    for (int i = threadIdx.x; i < 12 * 32; i += 256) {
        int hd = i >> 5, j = i & 31;
        int col; float* dst;
        if (hd < 8) { col = C_NQ + hd * 64; dst = qrot + (size_t)t * 512 + hd * 64; }
        else if (hd < 10) { col = C_KS + (hd - 8) * 64; dst = ksr + (size_t)t * 128 + (hd - 8) * 64; }
        else { col = C_KW + (hd - 10) * 64; dst = kwr + (size_t)t * 128 + (hd - 10) * 64; }
        float x1 = h[(size_t)t * INW + col + j], x2 = h[(size_t)t * INW + col + 32 + j];
        float cs = cosT[t * 32 + j], sn = sinT[t * 32 + j];
        dst[j] = x1 * cs - x2 * sn; dst[32 + j] = x2 * cs + x1 * sn;
    }
}

__global__ void __launch_bounds__(256) nsa_k(const float* __restrict__ h, const float* __restrict__ qrot, const float* __restrict__ ksr, const float* __restrict__ kwr,
                                              const float* __restrict__ kc, const float* __restrict__ vc, const float* __restrict__ normw, float* __restrict__ ycat) {
    __shared__ float sq[4][64], sqr[4][64];
    __shared__ float sp[4][1024];
    __shared__ int sblk[16];
    const int g = blockIdx.x & 1, bt = blockIdx.x >> 1, b = bt / S_, t = bt % S_;
    const int w = threadIdx.x >> 6, lane = threadIdx.x & 63, head = g * 4 + w;
    sq[w][lane] = h[(size_t)bt * INW + C_NQ + head * 64 + lane] * 0.125f;
    sqr[w][lane] = qrot[(size_t)bt * 512 + head * 64 + lane] * 0.125f;
    __syncthreads();
    const float* kcb = kc + (size_t)(b * 2 + g) * NCMP * 64;
    const float* vcb = vc + (size_t)(b * 2 + g) * NCMP * 64;
    float sc[4]; float mx = -1e30f;
#pragma unroll
    for (int i = 0; i < 4; ++i) {
        int c = lane + 64 * i; bool valid = (c < NCMP) && (16 * c + 31 <= t);
        float d = 0.f;
        if (valid) { const float4* kr = (const float4*)(kcb + (size_t)c * 64);
#pragma unroll
            for (int q4 = 0; q4 < 16; ++q4) { float4 kk = kr[q4]; d += sq[w][q4 * 4] * kk.x + sq[w][q4 * 4 + 1] * kk.y + sq[w][q4 * 4 + 2] * kk.z + sq[w][q4 * 4 + 3] * kk.w; } }
        sc[i] = valid ? d : -1e30f; mx = fmaxf(mx, sc[i]);
    }
    mx = wmax(mx);
    float sum = 0.f;
#pragma unroll
    for (int i = 0; i < 4; ++i) { sc[i] = (sc[i] > -1e29f) ? expf(sc[i] - mx) : 0.f; sum += sc[i]; }
    sum = wsum(sum);
    float inv = sum > 0.f ? 1.0f / sum : 0.f;
#pragma unroll
    for (int i = 0; i < 4; ++i) sp[w][lane + 64 * i] = sc[i] * inv;
    __syncthreads();
    float oc = 0.f;
    { int ncv = (t >= 31) ? ((t - 31) / 16 + 1) : 0; if (ncv > NCMP) ncv = NCMP;
      for (int c = 0; c < ncv; ++c) oc = fmaf(sp[w][c], vcb[(size_t)c * 64 + lane], oc); }
    const int cur = t >> 6;
    if (w == 0) {
        const int j = lane;
        float imp = 0.f;
#pragma unroll
        for (int hh = 0; hh < 4; ++hh) {
            float a = 0.f;
            if (4 * j - 1 >= 0) a += sp[hh][4 * j - 1];
            a += 2.0f * sp[hh][4 * j] + 2.0f * sp[hh][4 * j + 1] + 2.0f * sp[hh][4 * j + 2];
            if (4 * j + 3 < NCMP) a += sp[hh][4 * j + 3];
            imp += a;
        }
        if (j > cur) imp = -1e9f;
        if (j == 0 || j == cur || j == cur - 1) imp = 1e9f;
        int rank = 0;
        for (int i = 0; i < 64; ++i) { float o = __shfl(imp, i); rank += (o > imp || (o == imp && i < j)) ? 1 : 0; }
        unsigned long long m = __ballot(rank < 16);
        if (rank < 16) { int pos = __popcll(m & ((1ull << j) - 1ull)); sblk[pos] = j; }
    }
    __syncthreads();
    float os = 0.f;
    {
        const float* ksb = ksr + (size_t)b * S_ * 128 + g * 64;
        float smx = -1e30f;
        for (int sl = 0; sl < 16; ++sl) {
            int key = sblk[sl] * 64 + lane; bool valid = key <= t;
            float d = 0.f;
            if (valid) { const float4* kr = (const float4*)(ksb + (size_t)key * 128);
#pragma unroll
                for (int q4 = 0; q4 < 16; ++q4) { float4 kk = kr[q4]; d += sqr[w][q4 * 4] * kk.x + sqr[w][q4 * 4 + 1] * kk.y + sqr[w][q4 * 4 + 2] * kk.z + sqr[w][q4 * 4 + 3] * kk.w; } }
            d = valid ? d : -1e30f;
            sp[w][sl * 64 + lane] = d; smx = fmaxf(smx, d);
        }
        smx = wmax(smx);
        float ssum = 0.f;
        for (int sl = 0; sl < 16; ++sl) { float d = sp[w][sl * 64 + lane]; float e = (d > -1e29f) ? expf(d - smx) : 0.f; sp[w][sl * 64 + lane] = e; ssum += e; }
        ssum = wsum(ssum);
        float sinv = 1.0f / ssum;
        __syncthreads();
        const float* vsb = h + (size_t)b * S_ * INW + C_VS + g * 64 + lane;
        for (int sl = 0; sl < 16; ++sl) {
            int k0 = sblk[sl] * 64; if (k0 > t) continue;
            int nk = min(64, t - k0 + 1);
            for (int i = 0; i < nk; ++i) os = fmaf(sp[w][sl * 64 + i], vsb[(size_t)(k0 + i) * INW], os);
        }
        os *= sinv;
    }
    __syncthreads();
    float ow = 0.f;
    {
        const float* kwb = kwr + (size_t)b * S_ * 128 + g * 64;
        float smx = -1e30f;
        for (int i8 = 0; i8 < 8; ++i8) {
            int i = i8 * 64 + lane; int wp = t - 511 + i;
            float d = 0.f;
            if (wp >= 0) { const float4* kr = (const float4*)(kwb + (size_t)wp * 128);
#pragma unroll
                for (int q4 = 0; q4 < 16; ++q4) { float4 kk = kr[q4]; d += sqr[w][q4 * 4] * kk.x + sqr[w][q4 * 4 + 1] * kk.y + sqr[w][q4 * 4 + 2] * kk.z + sqr[w][q4 * 4 + 3] * kk.w; } }
            sp[w][i] = d; smx = fmaxf(smx, d);
        }
        smx = wmax(smx);
        float ssum = 0.f;
        for (int i8 = 0; i8 < 8; ++i8) { int i = i8 * 64 + lane; float e = expf(sp[w][i] - smx); sp[w][i] = e; ssum += e; }
        ssum = wsum(ssum);
        float sinv = 1.0f / ssum;
        __syncthreads();
        const float* vwb = h + (size_t)b * S_ * INW + C_VW + g * 64 + lane;
        int i0 = (t >= 511) ? 0 : (511 - t);
        for (int i = i0; i < 512; ++i) ow = fmaf(sp[w][i], vwb[(size_t)(t - 511 + i) * INW], ow);
        ow *= sinv;
    }
    const float* gp = h + (size_t)bt * INW + C_NG + head * 3;
    float o = sigm(gp[0]) * oc + sigm(gp[1]) * os + sigm(gp[2]) * ow;
    float ms = wsum(o * o) * (1.0f / 64.0f);
    ycat[(size_t)bt * D_ + 512 + head * 64 + lane] = o * rsqrtf(ms + 1e-6f) * normw[head * 64 + lane];
}

__global__ void __launch_bounds__(256) ln1_route_k(const float* __restrict__ xin, const float* __restrict__ mix, const float* __restrict__ lw, const float* __restrict__ lbias,
                                                    const float* __restrict__ rw, const float* __restrict__ rb, float* __restrict__ x1,
                                                    int* __restrict__ cnt, int* __restrict__ list, int* __restrict__ tok_e, int* __restrict__ tok_slot, float* __restrict__ tok_w) {
    const int tok = blockIdx.x * 4 + (threadIdx.x >> 6), lane = threadIdx.x & 63;
    float v[16]; float s = 0.f;
#pragma unroll
    for (int j = 0; j < 4; ++j) {
        float4 a = *(const float4*)(xin + (size_t)tok * D_ + j * 256 + lane * 4);
        float4 m = *(const float4*)(mix + (size_t)tok * D_ + j * 256 + lane * 4);
        v[4 * j] = ALPHA * a.x + m.x; v[4 * j + 1] = ALPHA * a.y + m.y; v[4 * j + 2] = ALPHA * a.z + m.z; v[4 * j + 3] = ALPHA * a.w + m.w;
        s += v[4 * j] + v[4 * j + 1] + v[4 * j + 2] + v[4 * j + 3];
    }
    float mean = wsum(s) * (1.0f / D_); float q = 0.f;
#pragma unroll
    for (int i = 0; i < 16; ++i) { v[i] -= mean; q += v[i] * v[i]; }
    float rstd = rsqrtf(wsum(q) * (1.0f / D_) + 1e-5f);
    float lg[32];
#pragma unroll
    for (int e = 0; e < 32; ++e) lg[e] = 0.f;
#pragma unroll
    for (int j = 0; j < 4; ++j) {
        float4 w4 = *(const float4*)(lw + j * 256 + lane * 4), b4 = *(const float4*)(lbias + j * 256 + lane * 4);
        v[4 * j] = v[4 * j] * rstd * w4.x + b4.x; v[4 * j + 1] = v[4 * j + 1] * rstd * w4.y + b4.y;
        v[4 * j + 2] = v[4 * j + 2] * rstd * w4.z + b4.z; v[4 * j + 3] = v[4 * j + 3] * rstd * w4.w + b4.w;
        *(float4*)(x1 + (size_t)tok * D_ + j * 256 + lane * 4) = make_float4(v[4 * j], v[4 * j + 1], v[4 * j + 2], v[4 * j + 3]);
#pragma unroll
        for (int ii = 0; ii < 4; ++ii) {
            const float4* rr = (const float4*)(rw + (size_t)(j * 256 + lane * 4 + ii) * 32);
#pragma unroll
            for (int e4 = 0; e4 < 8; ++e4) { float4 r = rr[e4]; float xv = v[4 * j + ii];
                lg[e4 * 4] = fmaf(xv, r.x, lg[e4 * 4]); lg[e4 * 4 + 1] = fmaf(xv, r.y, lg[e4 * 4 + 1]); lg[e4 * 4 + 2] = fmaf(xv, r.z, lg[e4 * 4 + 2]); lg[e4 * 4 + 3] = fmaf(xv, r.w, lg[e4 * 4 + 3]); }
        }
    }
#pragma unroll
    for (int e = 0; e < 32; ++e) lg[e] = wsum(lg[e]) + rb[e];
    unsigned taken = 0u; float tl[4]; int te[4];
#pragma unroll
    for (int k = 0; k < 4; ++k) {
        float best = -3.0e38f; int bi = 0;
#pragma unroll
        for (int e = 0; e < 32; ++e) { bool ok = !((taken >> e) & 1u) && lg[e] > best; best = ok ? lg[e] : best; bi = ok ? e : bi; }
        taken |= 1u << bi; tl[k] = best; te[k] = bi;
    }
    float e0 = 1.0f, e1 = expf(tl[1] - tl[0]), e2 = expf(tl[2] - tl[0]), e3 = expf(tl[3] - tl[0]);
    float inv = 1.0f / (e0 + e1 + e2 + e3);
    float tw[4] = {e0 * inv, e1 * inv, e2 * inv, e3 * inv};
    if (lane == 0) {
#pragma unroll
        for (int k = 0; k < 4; ++k) {
            int slot = atomicAdd(&cnt[te[k]], 1);
            list[te[k] * NT + slot] = tok;
            tok_e[tok * 4 + k] = te[k]; tok_slot[tok * 4 + k] = slot; tok_w[tok * 4 + k] = tw[k];
        }
    }
}
__global__ void offs_k(const int* __restrict__ cnt, int* __restrict__ offs) {
    if (threadIdx.x == 0) { int a = 0; for (int e = 0; e < NE; ++e) { offs[e] = a; a += cnt[e]; } }
}
__global__ void __launch_bounds__(256) comb_ln2_k(const float* __restrict__ x1, const float* __restrict__ y, const int* __restrict__ offs, const int* __restrict__ tok_e,
                                                   const int* __restrict__ tok_slot, const float* __restrict__ tok_w, const float* __restrict__ lw, const float* __restrict__ lbias,
                                                   float* __restrict__ xout) {
    const int tok = blockIdx.x * 4 + (threadIdx.x >> 6), lane = threadIdx.x & 63;
    float v[16];
#pragma unroll
    for (int j = 0; j < 4; ++j) { float4 a = *(const float4*)(x1 + (size_t)tok * D_ + j * 256 + lane * 4);
        v[4 * j] = ALPHA * a.x; v[4 * j + 1] = ALPHA * a.y; v[4 * j + 2] = ALPHA * a.z; v[4 * j + 3] = ALPHA * a.w; }
#pragma unroll
    for (int k = 0; k < 4; ++k) {
        int e = tok_e[tok * 4 + k]; int row = offs[e] + tok_slot[tok * 4 + k]; float wk = tok_w[tok * 4 + k];
#pragma unroll
        for (int j = 0; j < 4; ++j) { float4 a = *(const float4*)(y + (size_t)row * D_ + j * 256 + lane * 4);
            v[4 * j] = fmaf(wk, a.x, v[4 * j]); v[4 * j + 1] = fmaf(wk, a.y, v[4 * j + 1]); v[4 * j + 2] = fmaf(wk, a.z, v[4 * j + 2]); v[4 * j + 3] = fmaf(wk, a.w, v[4 * j + 3]); }
    }
    float s = 0.f;
#pragma unroll
    for (int i = 0; i < 16; ++i) s += v[i];
    float mean = wsum(s) * (1.0f / D_); float q = 0.f;
#pragma unroll
    for (int i = 0; i < 16; ++i) { v[i] -= mean; q += v[i] * v[i]; }
    float rstd = rsqrtf(wsum(q) * (1.0f / D_) + 1e-5f);
#pragma unroll
    for (int j = 0; j < 4; ++j) {
        float4 w4 = *(const float4*)(lw + j * 256 + lane * 4), b4 = *(const float4*)(lbias + j * 256 + lane * 4);
        *(float4*)(xout + (size_t)tok * D_ + j * 256 + lane * 4) =
            make_float4(v[4 * j] * rstd * w4.x + b4.x, v[4 * j + 1] * rstd * w4.y + b4.y, v[4 * j + 2] * rstd * w4.z + b4.z, v[4 * j + 3] * rstd * w4.w + b4.w);
    }
}
}

extern "C" void kernel_launch(void* const* d_in, const int* in_sizes, int n_in, void* d_out, int out_size, void* d_ws, size_t ws_size, hipStream_t stream) {
    using namespace nv;
    const float* x = (const float*)d_in[0]; const int* pos = (const int*)d_in[1];
    const float* w_in = (const float*)d_in[2]; const float* hg_lb = (const float*)d_in[3]; const float* hg_nw = (const float*)d_in[4];
    const float* gm_lw = (const float*)d_in[5]; const float* gm_lb = (const float*)d_in[6]; const float* gm_sw = (const float*)d_in[7]; const float* gm_sb = (const float*)d_in[8];
    const float* gm_nw = (const float*)d_in[9]; const float* cpe = (const float*)d_in[10]; const float* cw1 = (const float*)d_in[11]; const float* cw2 = (const float*)d_in[12];
    const float* nsa_nw = (const float*)d_in[13]; const float* w_out = (const float*)d_in[14]; const float* ln1w = (const float*)d_in[15]; const float* ln1b = (const float*)d_in[16];
    const float* rw = (const float*)d_in[17]; const float* rb = (const float*)d_in[18]; const float* wup = (const float*)d_in[19]; const float* bup = (const float*)d_in[20];
    const float* wdn = (const float*)d_in[21]; const float* bdn = (const float*)d_in[22]; const float* ln2w = (const float*)d_in[23]; const float* ln2b = (const float*)d_in[24];
    char* ws = (char*)d_ws; size_t off = 0;
    auto take = [&](size_t bytes) { char* p = ws + off; off += (bytes + 255) & ~(size_t)255; return p; };
    int* ctl = (int*)take(4096);
    float* cosT = (float*)take((size_t)NT * 32 * 4); float* sinT = (float*)take((size_t)NT * 32 * 4); float* lb = (float*)take(512 * 4);
    char* regA = take((size_t)NASSIGN * 1024 * 4);
    float* hbuf = (float*)regA; float* ycat = (float*)(regA + (size_t)NT * INW * 4 + 256);
    float* act = (float*)regA;
    float* ybuf = (float*)take((size_t)NASSIGN * 1024 * 4);
    float* vln = (float*)ybuf;
    float* qrot = (float*)((char*)ybuf + 64 * 1048576); float* ksr = (float*)((char*)ybuf + 160 * 1048576); float* kwr = (float*)((char*)ybuf + 192 * 1048576);
    float* kc = (float*)((char*)ybuf + 224 * 1048576); float* vc = (float*)((char*)ybuf + 228 * 1048576);
    float* mix = (float*)take((size_t)NT * D_ * 4); float* x1 = (float*)take((size_t)NT * D_ * 4); float* xa = (float*)take((size_t)NT * D_ * 4);
    int* list = (int*)take((size_t)NE * NT * 4); int* tok_e = (int*)take((size_t)NASSIGN * 4); int* tok_slot = (int*)take((size_t)NASSIGN * 4); float* tok_w = (float*)take((size_t)NASSIGN * 4);
    if (off > ws_size) { fprintf(stderr, "ws too small: need %zu have %zu\n", off, ws_size); return; }
    prep_k<<<(NT * 32 + 255) / 256, 256, 0, stream>>>(pos, hg_lb, cosT, sinT, lb);
    const float* xcur = x;
    for (int l = 0; l < DEPTH; ++l) {
        int* cnt = ctl + l * 128; int* offs = cnt + 64;
        hipMemsetAsync(cnt, 0, 128 * 4, stream);
        { GemmP p{}; p.A = xcur; p.lda = D_; p.B = w_in + (size_t)l * D_ * INW; p.ldb = INW; p.C = hbuf; p.ldc = INW; p.M = NT; p.N = INW; p.K = D_;
          sgemm_k<0><<<dim3((INW + 127) / 128, NT / 128, 1), 256, 0, stream>>>(p); }
        hgrn2_k<<<32, 64, 0, stream>>>(hbuf, lb + l * 256, hg_nw + l * 256, ycat);
        gm_ln_k<<<NT, 256, 0, stream>>>(hbuf, gm_lw + l * 256, gm_lb + l * 256, vln);
        gm_sp_k<<<NT, 256, 0, stream>>>(hbuf, vln, gm_sw + (size_t)l * 4 * 128 * 128, gm_sb + l * 512, gm_nw + l * 256, ycat);
        cmp_k<<<B_ * 2 * NCMP * 2, 128, 0, stream>>>(hbuf, cpe + (size_t)l * 2 * 2048, cw1 + (size_t)l * 2 * 2048 * 128, cw2 + (size_t)l * 2 * 128 * 64, kc, vc);
        rope_k<<<NT, 256, 0, stream>>>(hbuf, cosT, sinT, qrot, ksr, kwr);
        nsa_k<<<NT * 2, 256, 0, stream>>>(hbuf, qrot, ksr, kwr, kc, vc, nsa_nw + l * 512, ycat);
        { GemmP p{}; p.A = ycat; p.lda = D_; p.B = w_out + (size_t)l * D_ * D_; p.ldb = D_; p.C = mix; p.ldc = D_; p.M = NT; p.N = D_; p.K = D_;
          sgemm_k<0><<<dim3(D_ / 128, NT / 128, 1), 256, 0, stream>>>(p); }
        ln1_route_k<<<NT / 4, 256, 0, stream>>>(xcur, mix, ln1w + l * D_, ln1b + l * D_, rw + (size_t)l * D_ * NE, rb + l * NE, x1, cnt, list, tok_e, tok_slot, tok_w);
        offs_k<<<1, 64, 0, stream>>>(cnt, offs);
        { GemmP p{}; p.A = x1; p.lda = D_; p.B = wup + (size_t)l * NE * D_ * 2048; p.ldb = 2048; p.C = act; p.ldc = D_; p.M = 0; p.N = 2048; p.K = D_;
          p.bias = bup + (size_t)l * NE * 2048; p.cnt = cnt; p.offs = offs; p.list = list; p.strideB = (size_t)D_ * 2048; p.strideBias = 2048;
          sgemm_k<1><<<dim3(2048 / 128, NT / 128, NE), 256, 0, stream>>>(p); }
        { GemmP p{}; p.A = act; p.lda = D_; p.B = wdn + (size_t)l * NE * D_ * D_; p.ldb = D_; p.C = ybuf; p.ldc = D_; p.M = 0; p.N = D_; p.K = D_;
          p.bias = bdn + (size_t)l * NE * D_; p.cnt = cnt; p.offs = offs; p.list = list; p.strideB = (size_t)D_ * D_; p.strideBias = D_;
          sgemm_k<2><<<dim3(D_ / 128, NT / 128, NE), 256, 0, stream>>>(p); }
        float* xo = (l == DEPTH - 1) ? (float*)d_out : xa;
        comb_ln2_k<<<NT / 4, 256, 0, stream>>>(x1, ybuf, offs, tok_e, tok_slot, tok_w, ln2w + l * D_, ln2b + l * D_, xo);
        xcur = xo;
    }
}
```

```cpp
#include <hip/hip_runtime.h>
#include <cstdio>
#include <cstdint>
#include <cmath>

#define XB_TMO      128
#define XB_XCNT(j)  (256  + 64 * (j))
#define XB_XSUB(j)  (1280 + 64 * (j))
#define XB_XGEN(j)  (2304 + 64 * (j))
#define XB_TOP      3328
#define XB_TOPGEN   3392
#define XCD_BAR_WORDS 3456
#define XB_SPIN_CAP (1u << 18)
#define LAS __attribute__((address_space(3)))

__device__ __forceinline__ unsigned xb_ld(unsigned* p)              { return __hip_atomic_load(p, __ATOMIC_RELAXED, __HIP_MEMORY_SCOPE_AGENT); }
__device__ __forceinline__ unsigned xb_add(unsigned* p, unsigned v) { return __hip_atomic_fetch_add(p, v, __ATOMIC_RELAXED, __HIP_MEMORY_SCOPE_AGENT); }
__device__ __forceinline__ unsigned xb_xcc_id() { return (unsigned)__builtin_amdgcn_s_getreg((3 << 11) | 20) & 0xFu; }
#define XB_SPIN(cond, bar) do { unsigned _sp = 0; while (cond) { __builtin_amdgcn_s_sleep(1); \
    if ((++_sp & 255u) == 0u) { if (xb_ld(&(bar)[XB_TMO])) break; if (_sp > XB_SPIN_CAP) { atomicAdd(&(bar)[XB_TMO], 1u); break; } } } } while (0)

struct XcdBarrier {
    unsigned* bar; unsigned x;
    volatile LAS unsigned* st;
};

__device__ __forceinline__ XcdBarrier xcd_barrier_post(unsigned* bar, volatile LAS unsigned* st) {
    XcdBarrier b; b.bar = bar; b.x = xb_xcc_id(); b.st = st;
    if (threadIdx.x == 0) (void)xb_add(&bar[XB_XCNT(b.x)], 1u);
    return b;
}
__device__ __forceinline__ void xcd_barrier_complete(unsigned* bar, unsigned x, unsigned& nloc, unsigned& nx) {
    const unsigned G = gridDim.x * gridDim.y * gridDim.z;
    unsigned sum, cnt, mine, sp = 0u;
    for (;;) {
        sum = 0u; cnt = 0u; mine = 0u;
#pragma unroll
        for (unsigned j = 0; j < 16; ++j) { const unsigned c = xb_ld(&bar[XB_XCNT(j)]); sum += c; cnt += (c > 0u) ? 1u : 0u; mine = (j == x) ? c : mine; }
        if (sum == G) break;
        __builtin_amdgcn_s_sleep(1);
        if ((++sp & 255u) == 0u) { if (xb_ld(&bar[XB_TMO])) break; if (sp > XB_SPIN_CAP) { atomicAdd(&bar[XB_TMO], 1u); break; } }
    }
    nloc = mine > 0u ? mine : 1u; nx = cnt > 0u ? cnt : 1u;
}

__device__ __forceinline__ void xcd_barrier(const XcdBarrier& b) {
    asm volatile("s_waitcnt vmcnt(0)" ::: "memory");
    __syncthreads();
    if (threadIdx.x == 0) {
        unsigned* bar = b.bar;
        __builtin_amdgcn_s_waitcnt(0);
        unsigned nloc = b.st[0], nx = b.st[1];
        if (nloc == 0u) { xcd_barrier_complete(bar, b.x, nloc, nx); b.st[0] = nloc; b.st[1] = nx; }
        const unsigned old = xb_add(&bar[XB_XSUB(b.x)], 1u);
        const unsigned gen = old / nloc;
        if (old + 1u == (gen + 1u) * nloc) {
            __builtin_amdgcn_fence(__ATOMIC_RELEASE, "agent");
            asm volatile("s_waitcnt vmcnt(0)" ::: "memory");
            const unsigned og = xb_add(&bar[XB_TOP], 1u);
            const unsigned tg = og / nx;
            if (og + 1u == (tg + 1u) * nx) xb_add(&bar[XB_TOPGEN], 1u);
            else XB_SPIN(xb_ld(&bar[XB_TOPGEN]) == tg, bar);
            __builtin_amdgcn_fence(__ATOMIC_ACQUIRE, "agent");
            xb_add(&bar[XB_XGEN(b.x)], 1u);
            asm volatile("s_waitcnt vmcnt(0)" ::: "memory");
        } else {
            XB_SPIN(xb_ld(&bar[XB_XGEN(b.x)]) == gen, bar);
            __builtin_amdgcn_fence(__ATOMIC_ACQUIRE, "agent");
            asm volatile("s_waitcnt vmcnt(0)" ::: "memory");
        }
    }
    __syncthreads();
}


namespace mk {
constexpr int B_ = 8, S_ = 4096, D_ = 1024, NT = B_ * S_, DEPTH = 2;
constexpr int INW = 2840;
constexpr int C_HGQ = 0, C_HGF = 256, C_HGI = 512, C_HGG = 768, C_GMU = 1024, C_GMV = 1280, C_NQ = 1536,
              C_KC = 2048, C_VC = 2176, C_KS = 2304, C_VS = 2432, C_KW = 2560, C_VW = 2688, C_NG = 2816;
constexpr int NCMP = 255, NE = 32, TOPK = 4, NASSIGN = NT * TOPK;
constexpr float ALPHA = 1.4142135623730951f;
constexpr int NTHR = 512, LDS_BYTES = 147456, MISC_OFF = 144 * 1024 - 256;
constexpr int NPH = 8;

__device__ __forceinline__ float gelu_t(float x) { return 0.5f * x * (1.0f + tanhf(0.7978845608028654f * (x + 0.044715f * x * x * x))); }
__device__ __forceinline__ float sigm(float x) { return 1.0f / (1.0f + expf(-x)); }
__device__ __forceinline__ float wsum(float v) {
#pragma unroll
    for (int o = 1; o < 64; o <<= 1) v += __shfl_xor(v, o);
    return v;
}
__device__ __forceinline__ float wmax(float v) {
#pragma unroll
    for (int o = 1; o < 64; o <<= 1) v = fmaxf(v, __shfl_xor(v, o));
    return v;
}

struct WS {
    unsigned* bar; int* cnt;
    float *cosT, *sinT, *lb;
    float *hbuf, *ycat, *act, *ybuf, *vln, *qrot, *ksr, *kwr, *kc, *vc, *mix, *x1, *xa;
    int *list, *tok_e, *tok_slot; float* tok_w;
};
constexpr size_t CTL_BYTES = 65536;
constexpr size_t al256(size_t x) { return (x + 255) & ~(size_t)255; }
constexpr size_t O_COS = CTL_BYTES, O_SIN = O_COS + al256((size_t)NT * 32 * 4), O_LB = O_SIN + al256((size_t)NT * 32 * 4);
constexpr size_t O_REGA = O_LB + al256(512 * 4), O_YB = O_REGA + al256((size_t)NASSIGN * 1024 * 4);
constexpr size_t O_MIX = O_YB + al256((size_t)NASSIGN * 1024 * 4), O_X1 = O_MIX + al256((size_t)NT * D_ * 4), O_XA = O_X1 + al256((size_t)NT * D_ * 4);
constexpr size_t O_LIST = O_XA + al256((size_t)NT * D_ * 4), O_TE = O_LIST + al256((size_t)NE * NT * 4), O_TS = O_TE + al256((size_t)NASSIGN * 4), O_TW = O_TS + al256((size_t)NASSIGN * 4);
constexpr size_t WS_NEED = O_TW + al256((size_t)NASSIGN * 4);
__device__ __forceinline__ void ws_carve(unsigned char* ws, WS& w) {
    w.bar = (unsigned*)ws; w.cnt = (int*)(ws + 32768);
    w.cosT = (float*)(ws + O_COS); w.sinT = (float*)(ws + O_SIN); w.lb = (float*)(ws + O_LB);
    unsigned char* regA = ws + O_REGA;
    w.hbuf = (float*)regA; w.ycat = (float*)(regA + (size_t)NT * INW * 4 + 256); w.act = (float*)regA;
    unsigned char* yb = ws + O_YB;
    w.ybuf = (float*)yb; w.vln = (float*)yb;
    w.qrot = (float*)(yb + 64 * 1048576); w.ksr = (float*)(yb + 160 * 1048576); w.kwr = (float*)(yb + 192 * 1048576);
    w.kc = (float*)(yb + 224 * 1048576); w.vc = (float*)(yb + 228 * 1048576);
    w.mix = (float*)(ws + O_MIX); w.x1 = (float*)(ws + O_X1); w.xa = (float*)(ws + O_XA);
    w.list = (int*)(ws + O_LIST); w.tok_e = (int*)(ws + O_TE); w.tok_slot = (int*)(ws + O_TS); w.tok_w = (float*)(ws + O_TW);
}

struct GemmP {
    const float* A; int lda;
    const float* B; int ldb;
    float* C; int ldc;
    int M, N, K;
    const float* bias;
    const int* cnt; const int* offs; const int* list;
    size_t strideB; size_t strideBias;
};
template <int MODE>
__device__ __forceinline__ void sgemm_body(const GemmP& p, unsigned char* smem, int tid, bool active, int bx, int by, int bz) {
    float (*As)[68] = (float (*)[68])smem;
    float (*Bs)[132] = (float (*)[132])(smem + 16 * 68 * 4);
    const float** rowp = (const float**)(smem + 16 * 68 * 4 + 16 * 132 * 4);
    float** crow = (float**)(smem + 16 * 68 * 4 + 16 * 132 * 4 + 512);
    const int tx = tid & 15, ty = tid >> 4;
    int M = p.M; const float* Bm = p.B; const float* bias = p.bias;
    const int m0 = by * 64, n0 = bx * 128;
    if (MODE != 0) {
        const int e = bz; M = active ? p.cnt[e] : 0;
        Bm = p.B + (size_t)e * p.strideB; bias = p.bias + (size_t)e * p.strideBias;
        if (tid < 64) {
            int r = m0 + tid;
            if (active && r < M) {
                if (MODE == 1) { int tok = p.list[e * NT + r]; rowp[tid] = p.A + (size_t)tok * p.lda; }
                else rowp[tid] = p.A + (size_t)(p.offs[e] + r) * p.lda;
                crow[tid] = p.C + (size_t)(p.offs[e] + r) * p.ldc;
            } else { rowp[tid] = nullptr; crow[tid] = nullptr; }
        }
    } else {
        if (tid < 64) {
            int r = m0 + tid;
            if (active && r < M) { rowp[tid] = p.A + (size_t)r * p.lda; crow[tid] = p.C + (size_t)r * p.ldc; }
            else { rowp[tid] = nullptr; crow[tid] = nullptr; }
        }
    }
    __syncthreads();
    float acc[4][8];
#pragma unroll
    for (int i = 0; i < 4; ++i)
#pragma unroll
        for (int j = 0; j < 8; ++j) acc[i][j] = 0.f;
    const int bcc = tid & 127, bk0 = tid >> 7;
    int bcol;
    if (MODE == 1) bcol = (bcc < 64) ? (n0 / 2 + bcc) : (1024 + n0 / 2 + bcc - 64);
    else bcol = n0 + bcc;
    const bool bvalid = active && ((MODE == 1) ? true : (bcol < p.N));
    const int ar = tid >> 2, ak = (tid & 3) * 4;
#pragma unroll 1
    for (int k0 = 0; k0 < p.K; k0 += 16) {
        {
            const float* rp = rowp[ar];
            float4 v = make_float4(0.f, 0.f, 0.f, 0.f);
            if (rp) v = *(const float4*)(rp + k0 + ak);
            As[ak + 0][ar] = v.x; As[ak + 1][ar] = v.y; As[ak + 2][ar] = v.z; As[ak + 3][ar] = v.w;
        }
#pragma unroll
        for (int i = 0; i < 8; ++i) {
            int kk = bk0 + 2 * i;
            Bs[kk][bcc] = bvalid ? Bm[(size_t)(k0 + kk) * p.ldb + bcol] : 0.f;
        }
        __syncthreads();
#pragma unroll
        for (int kk = 0; kk < 16; ++kk) {
            float a[4], b[8];
#pragma unroll
            for (int i = 0; i < 4; ++i) a[i] = As[kk][ty * 4 + i];
#pragma unroll
            for (int j = 0; j < 4; ++j) { b[j] = Bs[kk][tx * 4 + j]; b[4 + j] = Bs[kk][64 + tx * 4 + j]; }
#pragma unroll
            for (int i = 0; i < 4; ++i)
#pragma unroll
                for (int j = 0; j < 8; ++j) acc[i][j] = fmaf(a[i], b[j], acc[i][j]);
        }
        __syncthreads();
    }
#pragma unroll
    for (int i = 0; i < 4; ++i) {
        const int rl = ty * 4 + i;
        float* cp = crow[rl];
        if (!cp) continue;
        if (MODE == 1) {
#pragma unroll
            for (int j = 0; j < 4; ++j) {
                const int jc = n0 / 2 + tx * 4 + j;
                float hg = acc[i][j] + bias[jc], hl = acc[i][4 + j] + bias[1024 + jc];
                float glu = fminf(hg, 7.0f), lin = fminf(fmaxf(hl, -7.0f), 7.0f);
                cp[jc] = glu * sigm(1.702f * glu) * (lin + 1.0f);
            }
        } else {
#pragma unroll
            for (int j = 0; j < 8; ++j) {
                const int c = n0 + ((j < 4) ? (tx * 4 + j) : (64 + tx * 4 + j - 4));
                if (c < p.N) cp[c] = acc[i][j] + (bias ? bias[c] : 0.f);
            }
        }
    }
    __syncthreads();
}
template <int MODE>
__device__ __forceinline__ void sgemm_phase(const GemmP& p, unsigned char* lds, int nbx, int nby, int nbz) {
    int tid_ = threadIdx.x, bid_ = blockIdx.x; asm volatile("" : "+v"(tid_), "+s"(bid_));
    const int sub = tid_ >> 8, t256 = tid_ & 255;
    const int nvb = nbx * nby * nbz, nit = (nvb + 1) / 2;
#pragma unroll 1
    for (int it = bid_; it < nit; it += gridDim.x) {
        int vb = it * 2 + sub; bool active = vb < nvb;
        int bx = vb % nbx, by = (vb / nbx) % nby, bz = vb / (nbx * nby);
        if (MODE != 0) {
            int vb0 = it * 2, vb1 = it * 2 + 1;
            int e0 = vb0 / (nbx * nby), m00 = ((vb0 / nbx) % nby) * 64;
            int e1 = vb1 / (nbx * nby), m01 = ((vb1 / nbx) % nby) * 64;
            bool a0 = vb0 < nvb && m00 < p.cnt[e0], a1 = vb1 < nvb && m01 < p.cnt[e1];
            if (!a0 && !a1) continue;
            active = sub ? a1 : a0;
            if (!active) { bx = 0; by = 0; bz = 0; }
        }
        sgemm_body<MODE>(p, lds + sub * 20480, t256, active, bx, by, bz);
    }
}

__device__ __forceinline__ void hgrn2_unit(const float* __restrict__ h, const float* __restrict__ lbl, const float* __restrict__ normw, float* __restrict__ ycat, int u, int lane) {
    const int b = u >> 2, hd = u & 3;
    float s[64];
#pragma unroll
    for (int k = 0; k < 64; ++k) s[k] = 0.f;
    const float lb = lbl[hd * 64 + lane], nw = normw[hd * 64 + lane];
    for (int t = 0; t < S_; ++t) {
        const float* hr = h + (size_t)(b * S_ + t) * INW + hd * 64 + lane;
        float qr = hr[C_HGQ], fr = hr[C_HGF], iv = hr[C_HGI], gt = hr[C_HGG];
        float qv = qr * sigm(qr);
        float fv = lb + (1.0f - lb) * sigm(fr);
        float kv = (1.0f - lb) * sigm(-fr);
        float o = 0.f;
#pragma unroll
        for (int k = 0; k < 64; ++k) {
            float fk = __shfl(fv, k), kk = __shfl(kv, k), qk = __shfl(qv, k);
            s[k] = fk * s[k] + kk * iv;
            o = fmaf(qk, s[k], o);
        }
        float ms = wsum(o * o) * (1.0f / 64.0f);
        float y = o * rsqrtf(ms + 1e-6f) * nw * sigm(gt);
        ycat[(size_t)(b * S_ + t) * D_ + hd * 64 + lane] = y;
    }
}

__device__ __forceinline__ void gm_ln_tok(const float* __restrict__ h, const float* __restrict__ lw, const float* __restrict__ lbias, float* __restrict__ vln, int t, int lane) {
    float4 v4 = *(const float4*)(h + (size_t)t * INW + C_GMV + lane * 4);
    float v[4] = {gelu_t(v4.x), gelu_t(v4.y), gelu_t(v4.z), gelu_t(v4.w)};
    float mean = wsum(v[0] + v[1] + v[2] + v[3]) * (1.0f / 256.0f);
    float q = 0.f;
#pragma unroll
    for (int i = 0; i < 4; ++i) { v[i] -= mean; q += v[i] * v[i]; }
    float rstd = rsqrtf(wsum(q) * (1.0f / 256.0f) + 1e-5f);
    float4 w4 = *(const float4*)(lw + lane * 4), b4 = *(const float4*)(lbias + lane * 4);
    *(float4*)(vln + (size_t)t * 256 + lane * 4) = make_float4(v[0] * rstd * w4.x + b4.x, v[1] * rstd * w4.y + b4.y, v[2] * rstd * w4.z + b4.z, v[3] * rstd * w4.w + b4.w);
}
__device__ __forceinline__ void gm_sp_tok(const float* __restrict__ h, const float* __restrict__ vln, const float* __restrict__ ws, const float* __restrict__ bs,
                                          const float* __restrict__ normw, float* __restrict__ ycat, int tok, int c) {
    const int g = c >> 6;
    const int tl = tok & 127, base = tok - tl;
    const float* w = ws + ((size_t)g * 128 + tl) * 128;
    float acc = 0.f;
    for (int s = 0; s <= tl; ++s) acc = fmaf(w[s], vln[(size_t)(base + s) * 256 + c], acc);
    acc += bs[g * 128 + tl];
    float u = gelu_t(h[(size_t)tok * INW + C_GMU + c]);
    float z = u * acc;
    float ms = wsum(z * z) * (1.0f / 64.0f);
    ycat[(size_t)tok * D_ + 256 + c] = z * rsqrtf(ms + 1e-6f) * normw[c];
}

__device__ __forceinline__ void cmp_unit(const float* __restrict__ h, const float* __restrict__ pe, const float* __restrict__ w1, const float* __restrict__ w2,
                                         float* __restrict__ kc, float* __restrict__ vc, unsigned char* smem, int id, bool active, int n) {
    float* blk = (float*)smem; float* hid = (float*)(smem + 8192);
    const int kv = id & 1; id >>= 1; const int c = id % NCMP; id /= NCMP; const int g = id & 1; const int b = id >> 1;
    const int col = (kv ? C_VC : C_KC) + g * 64;
    if (active) for (int i = n; i < 2048; i += 128) { int j = i >> 6, d = i & 63; blk[i] = h[(size_t)(b * S_ + 16 * c + j) * INW + col + d] + pe[kv * 2048 + i]; }
    __syncthreads();
    if (active) {
        const float* w1p = w1 + (size_t)kv * 2048 * 128 + n;
        float a = 0.f;
        for (int i = 0; i < 2048; ++i) a = fmaf(blk[i], w1p[(size_t)i * 128], a);
        hid[n] = gelu_t(a);
    }
    __syncthreads();
    if (active && n < 64) {
        const float* w2p = w2 + (size_t)kv * 128 * 64 + n;
        float o = 0.f;
        for (int i = 0; i < 128; ++i) o = fmaf(hid[i], w2p[i * 64], o);
        (kv ? vc : kc)[((size_t)(b * 2 + g) * NCMP + c) * 64 + n] = o;
    }
    __syncthreads();
}

__device__ __forceinline__ void rope_item(const float* __restrict__ h, const float* __restrict__ cosT, const float* __restrict__ sinT,
                                          float* __restrict__ qrot, float* __restrict__ ksr, float* __restrict__ kwr, int t, int i) {
    int hd = i >> 5, j = i & 31;
    int col; float* dst;
    if (hd < 8) { col = C_NQ + hd * 64; dst = qrot + (size_t)t * 512 + hd * 64; }
    else if (hd < 10) { col = C_KS + (hd - 8) * 64; dst = ksr + (size_t)t * 128 + (hd - 8) * 64; }
    else { col = C_KW + (hd - 10) * 64; dst = kwr + (size_t)t * 128 + (hd - 10) * 64; }
    float x1 = h[(size_t)t * INW + col + j], x2 = h[(size_t)t * INW + col + 32 + j];
    float cs = cosT[t * 32 + j], sn = sinT[t * 32 + j];
    dst[j] = x1 * cs - x2 * sn; dst[32 + j] = x2 * cs + x1 * sn;
}

__device__ __forceinline__ void nsa_unit(const float* __restrict__ h, const float* __restrict__ qrot, const float* __restrict__ ksr, const float* __restrict__ kwr,
                                         const float* __restrict__ kc, const float* __restrict__ vc, const float* __restrict__ normw, float* __restrict__ ycat,
                                         unsigned char* smem, int unit, int tid) {
    float (*sq)[64] = (float (*)[64])smem; float (*sqr)[64] = (float (*)[64])(smem + 1024);
    float (*sp)[1024] = (float (*)[1024])(smem + 2048);
    int* sblk = (int*)(smem + 2048 + 16384);
    const int g = unit & 1, bt = unit >> 1, b = bt / S_, t = bt % S_;
    const int w = tid >> 6, lane = tid & 63, head = g * 4 + w;
    sq[w][lane] = h[(size_t)bt * INW + C_NQ + head * 64 + lane] * 0.125f;
    sqr[w][lane] = qrot[(size_t)bt * 512 + head * 64 + lane] * 0.125f;
    __syncthreads();
    const float* kcb = kc + (size_t)(b * 2 + g) * NCMP * 64;
    const float* vcb = vc + (size_t)(b * 2 + g) * NCMP * 64;
    float sc[4]; float mx = -1e30f;
#pragma unroll
    for (int i = 0; i < 4; ++i) {
        int c = lane + 64 * i; bool valid = (c < NCMP) && (16 * c + 31 <= t);
        float d = 0.f;
        if (valid) { const float4* kr = (const float4*)(kcb + (size_t)c * 64);
#pragma unroll
            for (int q4 = 0; q4 < 16; ++q4) { float4 kk = kr[q4]; d += sq[w][q4 * 4] * kk.x + sq[w][q4 * 4 + 1] * kk.y + sq[w][q4 * 4 + 2] * kk.z + sq[w][q4 * 4 + 3] * kk.w; } }
        sc[i] = valid ? d : -1e30f; mx = fmaxf(mx, sc[i]);
    }
    mx = wmax(mx);
    float sum = 0.f;
#pragma unroll
    for (int i = 0; i < 4; ++i) { sc[i] = (sc[i] > -1e29f) ? expf(sc[i] - mx) : 0.f; sum += sc[i]; }
    sum = wsum(sum);
    float inv = sum > 0.f ? 1.0f / sum : 0.f;
#pragma unroll
    for (int i = 0; i < 4; ++i) sp[w][lane + 64 * i] = sc[i] * inv;
    __syncthreads();
    float oc = 0.f;
    { int ncv = (t >= 31) ? ((t - 31) / 16 + 1) : 0; if (ncv > NCMP) ncv = NCMP;
      for (int c = 0; c < ncv; ++c) oc = fmaf(sp[w][c], vcb[(size_t)c * 64 + lane], oc); }
    const int cur = t >> 6;
    if (w == 0) {
        const int j = lane;
        float imp = 0.f;
#pragma unroll
        for (int hh = 0; hh < 4; ++hh) {
            float a = 0.f;
            if (4 * j - 1 >= 0) a += sp[hh][4 * j - 1];
            a += 2.0f * sp[hh][4 * j] + 2.0f * sp[hh][4 * j + 1] + 2.0f * sp[hh][4 * j + 2];
            if (4 * j + 3 < NCMP) a += sp[hh][4 * j + 3];
            imp += a;
        }
        if (j > cur) imp = -1e9f;
        if (j == 0 || j == cur || j == cur - 1) imp = 1e9f;
        int rank = 0;
        for (int i = 0; i < 64; ++i) { float o = __shfl(imp, i); rank += (o > imp || (o == imp && i < j)) ? 1 : 0; }
        unsigned long long m = __ballot(rank < 16);
        if (rank < 16) { int pos = __popcll(m & ((1ull << j) - 1ull)); sblk[pos] = j; }
    }
    __syncthreads();
    float os = 0.f;
    {
        const float* ksb = ksr + (size_t)b * S_ * 128 + g * 64;
        float smx = -1e30f;
        for (int sl = 0; sl < 16; ++sl) {
            int key = sblk[sl] * 64 + lane; bool valid = key <= t;
            float d = 0.f;
            if (valid) { const float4* kr = (const float4*)(ksb + (size_t)key * 128);
#pragma unroll
                for (int q4 = 0; q4 < 16; ++q4) { float4 kk = kr[q4]; d += sqr[w][q4 * 4] * kk.x + sqr[w][q4 * 4 + 1] * kk.y + sqr[w][q4 * 4 + 2] * kk.z + sqr[w][q4 * 4 + 3] * kk.w; } }
            d = valid ? d : -1e30f;
            sp[w][sl * 64 + lane] = d; smx = fmaxf(smx, d);
        }
        smx = wmax(smx);
        float ssum = 0.f;
        for (int sl = 0; sl < 16; ++sl) { float d = sp[w][sl * 64 + lane]; float e = (d > -1e29f) ? expf(d - smx) : 0.f; sp[w][sl * 64 + lane] = e; ssum += e; }
        ssum = wsum(ssum);
        float sinv = 1.0f / ssum;
        __syncthreads();
        const float* vsb = h + (size_t)b * S_ * INW + C_VS + g * 64 + lane;
        for (int sl = 0; sl < 16; ++sl) {
            int k0 = sblk[sl] * 64; if (k0 > t) continue;
            int nk = min(64, t - k0 + 1);
            for (int i = 0; i < nk; ++i) os = fmaf(sp[w][sl * 64 + i], vsb[(size_t)(k0 + i) * INW], os);
        }
        os *= sinv;
    }
    __syncthreads();
    float ow = 0.f;
    {
        const float* kwb = kwr + (size_t)b * S_ * 128 + g * 64;
        float smx = -1e30f;
        for (int i8 = 0; i8 < 8; ++i8) {
            int i = i8 * 64 + lane; int wp = t - 511 + i;
            float d = 0.f;
            if (wp >= 0) { const float4* kr = (const float4*)(kwb + (size_t)wp * 128);
#pragma unroll
                for (int q4 = 0; q4 < 16; ++q4) { float4 kk = kr[q4]; d += sqr[w][q4 * 4] * kk.x + sqr[w][q4 * 4 + 1] * kk.y + sqr[w][q4 * 4 + 2] * kk.z + sqr[w][q4 * 4 + 3] * kk.w; } }
            sp[w][i] = d; smx = fmaxf(smx, d);
        }
        smx = wmax(smx);
        float ssum = 0.f;
        for (int i8 = 0; i8 < 8; ++i8) { int i = i8 * 64 + lane; float e = expf(sp[w][i] - smx); sp[w][i] = e; ssum += e; }
        ssum = wsum(ssum);
        float sinv = 1.0f / ssum;
        __syncthreads();
        const float* vwb = h + (size_t)b * S_ * INW + C_VW + g * 64 + lane;
        int i0 = (t >= 511) ? 0 : (511 - t);
        for (int i = i0; i < 512; ++i) ow = fmaf(sp[w][i], vwb[(size_t)(t - 511 + i) * INW], ow);
        ow *= sinv;
    }
    const float* gp = h + (size_t)bt * INW + C_NG + head * 3;
    float o = sigm(gp[0]) * oc + sigm(gp[1]) * os + sigm(gp[2]) * ow;
    float ms = wsum(o * o) * (1.0f / 64.0f);
    ycat[(size_t)bt * D_ + 512 + head * 64 + lane] = o * rsqrtf(ms + 1e-6f) * normw[head * 64 + lane];
    __syncthreads();
}

__device__ __forceinline__ void ln1_route_tok(const float* __restrict__ xin, const float* __restrict__ mix, const float* __restrict__ lw, const float* __restrict__ lbias,
                                              const float* __restrict__ rw, const float* __restrict__ rb, float* __restrict__ x1,
                                              int* __restrict__ cnt, int* __restrict__ list, int* __restrict__ tok_e, int* __restrict__ tok_slot, float* __restrict__ tok_w,
                                              float* xs, int tok, int lane) {
    float v[16]; float s = 0.f;
#pragma unroll
    for (int j = 0; j < 4; ++j) {
        float4 a = *(const float4*)(xin + (size_t)tok * D_ + j * 256 + lane * 4);
        float4 m = *(const float4*)(mix + (size_t)tok * D_ + j * 256 + lane * 4);
        v[4 * j] = ALPHA * a.x + m.x; v[4 * j + 1] = ALPHA * a.y + m.y; v[4 * j + 2] = ALPHA * a.z + m.z; v[4 * j + 3] = ALPHA * a.w + m.w;
        s += v[4 * j] + v[4 * j + 1] + v[4 * j + 2] + v[4 * j + 3];
    }
    float mean = wsum(s) * (1.0f / D_); float q = 0.f;
#pragma unroll
    for (int i = 0; i < 16; ++i) { v[i] -= mean; q += v[i] * v[i]; }
    float rstd = rsqrtf(wsum(q) * (1.0f / D_) + 1e-5f);
#pragma unroll
    for (int j = 0; j < 4; ++j) {
        float4 w4 = *(const float4*)(lw + j * 256 + lane * 4), b4 = *(const float4*)(lbias + j * 256 + lane * 4);
        float4 o = make_float4(v[4 * j] * rstd * w4.x + b4.x, v[4 * j + 1] * rstd * w4.y + b4.y, v[4 * j + 2] * rstd * w4.z + b4.z, v[4 * j + 3] * rstd * w4.w + b4.w);
        *(float4*)(x1 + (size_t)tok * D_ + j * 256 + lane * 4) = o;
        *(float4*)(xs + j * 256 + lane * 4) = o;
    }
    __builtin_amdgcn_wave_barrier();
    const int e = lane & 31, hf = lane >> 5;
    float lg = 0.f;
    const float* rwp = rw + (size_t)(hf * 512) * 32 + e;
    const float* xp = xs + hf * 512;
#pragma unroll 8
    for (int k = 0; k < 512; ++k) lg = fmaf(xp[k], rwp[(size_t)k * 32], lg);
    lg += __shfl_xor(lg, 32);
    lg += rb[e];
    float val = (lane < 32) ? lg : -3.0e38f;
    float tl[4]; int te[4];
#pragma unroll
    for (int k = 0; k < 4; ++k) {
        float m = wmax(val);
        unsigned long long bm = __ballot(val == m);
        int bi = __ffsll((long long)bm) - 1;
        tl[k] = m; te[k] = bi;
        if (lane == bi) val = -3.0e38f;
    }
    float e0 = 1.0f, e1 = expf(tl[1] - tl[0]), e2 = expf(tl[2] - tl[0]), e3 = expf(tl[3] - tl[0]);
    float inv = 1.0f / (e0 + e1 + e2 + e3);
    float tw[4] = {e0 * inv, e1 * inv, e2 * inv, e3 * inv};
    if (lane == 0) {
#pragma unroll
        for (int k = 0; k < 4; ++k) {
            int slot = atomicAdd(&cnt[te[k]], 1);
            list[te[k] * NT + slot] = tok;
            tok_e[tok * 4 + k] = te[k]; tok_slot[tok * 4 + k] = slot; tok_w[tok * 4 + k] = tw[k];
        }
    }
    __builtin_amdgcn_wave_barrier();
}
__device__ __forceinline__ void comb_ln2_tok(const float* __restrict__ x1, const float* __restrict__ y, const int* __restrict__ offs, const int* __restrict__ tok_e,
                                             const int* __restrict__ tok_slot, const float* __restrict__ tok_w, const float* __restrict__ lw, const float* __restrict__ lbias,
                                             float* __restrict__ xout, int tok, int lane) {
    float v[16];
#pragma unroll
    for (int j = 0; j < 4; ++j) { float4 a = *(const float4*)(x1 + (size_t)tok * D_ + j * 256 + lane * 4);
        v[4 * j] = ALPHA * a.x; v[4 * j + 1] = ALPHA * a.y; v[4 * j + 2] = ALPHA * a.z; v[4 * j + 3] = ALPHA * a.w; }
#pragma unroll
    for (int k = 0; k < 4; ++k) {
        int e = tok_e[tok * 4 + k]; int row = offs[e] + tok_slot[tok * 4 + k]; float wk = tok_w[tok * 4 + k];
#pragma unroll
        for (int j = 0; j < 4; ++j) { float4 a = *(const float4*)(y + (size_t)row * D_ + j * 256 + lane * 4);
            v[4 * j] = fmaf(wk, a.x, v[4 * j]); v[4 * j + 1] = fmaf(wk, a.y, v[4 * j + 1]); v[4 * j + 2] = fmaf(wk, a.z, v[4 * j + 2]); v[4 * j + 3] = fmaf(wk, a.w, v[4 * j + 3]); }
    }
    float s = 0.f;
#pragma unroll
    for (int i = 0; i < 16; ++i) s += v[i];
    float mean = wsum(s) * (1.0f / D_); float q = 0.f;
#pragma unroll
    for (int i = 0; i < 16; ++i) { v[i] -= mean; q += v[i] * v[i]; }
    float rstd = rsqrtf(wsum(q) * (1.0f / D_) + 1e-5f);
#pragma unroll
    for (int j = 0; j < 4; ++j) {
        float4 w4 = *(const float4*)(lw + j * 256 + lane * 4), b4 = *(const float4*)(lbias + j * 256 + lane * 4);
        *(float4*)(xout + (size_t)tok * D_ + j * 256 + lane * 4) =
            make_float4(v[4 * j] * rstd * w4.x + b4.x, v[4 * j + 1] * rstd * w4.y + b4.y, v[4 * j + 2] * rstd * w4.z + b4.z, v[4 * j + 3] * rstd * w4.w + b4.w);
    }
}

struct Args { const float* in[25]; float* out; unsigned char* ws; int ph_lo, ph_hi; };
#define PH __device__ __forceinline__

PH void ph_prologue(const int* pos, const float* hg_lb, float* cosT, float* sinT, float* lb) {
    int tid = threadIdx.x, bid = blockIdx.x; asm volatile("" : "+v"(tid), "+s"(bid)); const int G = gridDim.x;
#pragma unroll 1
    for (int i = bid * NTHR + tid; i < NT * 32; i += G * NTHR) {
        int t = i >> 5, j = i & 31;
        float inv = (float)pow(10000.0, -(double)(2 * j) / 64.0);
        float ang = (float)pos[t] * inv;
        double ad = (double)ang;
        cosT[i] = (float)cos(ad); sinT[i] = (float)sin(ad);
    }
    if (bid == 0 && tid < 256) {
        float p0 = hg_lb[tid], p1 = hg_lb[256 + tid];
        float m = fmaxf(p0, p1); float ea = expf(p0 - m), eb = expf(p1 - m);
        lb[tid] = 0.f; lb[256 + tid] = eb / (ea + eb);
    }
}
PH void ph_gemm_plain(const float* A, const float* Bm, float* C, int N, int ldb) {
    extern __shared__ __attribute__((aligned(16))) unsigned char lds[];
    GemmP p{}; p.A = A; p.lda = D_; p.B = Bm; p.ldb = ldb; p.C = C; p.ldc = ldb; p.M = NT; p.N = N; p.K = D_;
    sgemm_phase<0>(p, lds, (N + 127) / 128, NT / 64, 1);
}
PH void ph_hgrn2(const float* hbuf, const float* lb, const float* nw, float* ycat) {
    int tid = threadIdx.x, bid = blockIdx.x; asm volatile("" : "+v"(tid), "+s"(bid)); const int lane = tid & 63, wave = tid >> 6, G = gridDim.x;
#pragma unroll 1
    for (int u = bid; u < 32; u += G) if (wave == 0) hgrn2_unit(hbuf, lb, nw, ycat, u, lane);
}
PH void ph_mix1(const float* hbuf, const float* glw, const float* glb, float* vln, const float* pe, const float* w1, const float* w2, float* kc, float* vc,
                const float* cosT, const float* sinT, float* qrot, float* ksr, float* kwr, int ob, int OG) {
    extern __shared__ __attribute__((aligned(16))) unsigned char lds[];
    int tid = threadIdx.x; asm volatile("" : "+v"(tid)); const int lane = tid & 63, wave = tid >> 6;
#pragma unroll 1
    for (int t = ob * 8 + wave; t < NT; t += OG * 8) gm_ln_tok(hbuf, glw, glb, vln, t, lane);
    const int ncu = B_ * 2 * NCMP * 2, nit = (ncu + 3) / 4;
#pragma unroll 1
    for (int it = ob; it < nit; it += OG) { int id = it * 4 + (tid >> 7); bool act = id < ncu; if (!act) id = 0;
        cmp_unit(hbuf, pe, w1, w2, kc, vc, lds + (tid >> 7) * 9216, id, act, tid & 127); }
#pragma unroll 1
    for (long idx = (long)ob * NTHR + tid; idx < (long)NT * 384; idx += (long)OG * NTHR) rope_item(hbuf, cosT, sinT, qrot, ksr, kwr, (int)(idx / 384), (int)(idx % 384));
}
PH void ph_gmsp(const float* hbuf, const float* vln, const float* sw, const float* sb, const float* nw, float* ycat) {
    int tid = threadIdx.x, bid = blockIdx.x; asm volatile("" : "+v"(tid), "+s"(bid)); const int G = gridDim.x;
#pragma unroll 1
    for (int t = bid * 2 + (tid >> 8); t < NT; t += G * 2) gm_sp_tok(hbuf, vln, sw, sb, nw, ycat, t, tid & 255);
}
PH void ph_nsa(const float* hbuf, const float* qrot, const float* ksr, const float* kwr, const float* kc, const float* vc, const float* nw, float* ycat) {
    extern __shared__ __attribute__((aligned(16))) unsigned char lds[];
    int tid = threadIdx.x, bid = blockIdx.x; asm volatile("" : "+v"(tid), "+s"(bid)); const int G = gridDim.x;
#pragma unroll 1
    for (int it = bid; it < NT; it += G) nsa_unit(hbuf, qrot, ksr, kwr, kc, vc, nw, ycat, lds + (tid >> 8) * 20480, it * 2 + (tid >> 8), tid & 255);
}
PH void ph_ln1(const float* xin, const float* mix, const float* lw, const float* lb, const float* rw, const float* rb, float* x1, int* cnt, int* list, int* tok_e, int* tok_slot, float* tok_w) {
    extern __shared__ __attribute__((aligned(16))) unsigned char lds[];
    int tid = threadIdx.x, bid = blockIdx.x; asm volatile("" : "+v"(tid), "+s"(bid)); const int lane = tid & 63, wave = tid >> 6, G = gridDim.x;
#pragma unroll 1
    for (int t = bid * 8 + wave; t < NT; t += G * 8) ln1_route_tok(xin, mix, lw, lb, rw, rb, x1, cnt, list, tok_e, tok_slot, tok_w, (float*)(lds + wave * 4096), t, lane);
}
PH void ph_moe_up(const float* x1, const float* wup, const float* bup, float* act, const int* cnt, const int* list) {
    extern __shared__ __attribute__((aligned(16))) unsigned char lds[];
    const int* offs_s = (const int*)(lds + MISC_OFF - 256);
    GemmP p{}; p.A = x1; p.lda = D_; p.B = wup; p.ldb = 2048; p.C = act; p.ldc = D_; p.M = 0; p.N = 2048; p.K = D_;
    p.bias = bup; p.cnt = cnt; p.offs = offs_s; p.list = list; p.strideB = (size_t)D_ * 2048; p.strideBias = 2048;
    sgemm_phase<1>(p, lds, 2048 / 128, NT / 64, NE);
}
PH void ph_moe_dn(const float* act, const float* wdn, const float* bdn, float* ybuf, const int* cnt, const int* list) {
    extern __shared__ __attribute__((aligned(16))) unsigned char lds[];
    const int* offs_s = (const int*)(lds + MISC_OFF - 256);
    GemmP p{}; p.A = act; p.lda = D_; p.B = wdn; p.ldb = D_; p.C = ybuf; p.ldc = D_; p.M = 0; p.N = D_; p.K = D_;
    p.bias = bdn; p.cnt = cnt; p.offs = offs_s; p.list = list; p.strideB = (size_t)D_ * D_; p.strideBias = D_;
    sgemm_phase<2>(p, lds, D_ / 128, NT / 64, NE);
}
PH void ph_comb(const float* x1, const float* ybuf, const int* tok_e, const int* tok_slot, const float* tok_w, const float* lw, const float* lb, float* xo) {
    extern __shared__ __attribute__((aligned(16))) unsigned char lds[];
    const int* offs_s = (const int*)(lds + MISC_OFF - 256);
    int tid = threadIdx.x, bid = blockIdx.x; asm volatile("" : "+v"(tid), "+s"(bid)); const int lane = tid & 63, wave = tid >> 6, G = gridDim.x;
#pragma unroll 1
    for (int t = bid * 8 + wave; t < NT; t += G * 8) comb_ln2_tok(x1, ybuf, offs_s, tok_e, tok_slot, tok_w, lw, lb, xo, t, lane);
}

__global__ void __launch_bounds__(NTHR, 2) mega(Args a) {
    extern __shared__ __attribute__((aligned(16))) unsigned char lds[];
    const int tid = threadIdx.x;
    const int G = gridDim.x, bid = blockIdx.x;
    volatile LAS unsigned* MISC = (volatile LAS unsigned*)((LAS unsigned char*)lds + MISC_OFF);
    if (tid < 64) MISC[tid] = 0u;
    __syncthreads();
    WS w; ws_carve(a.ws, w);
    XcdBarrier bar = xcd_barrier_post(w.bar, MISC + 8);
    int* offs_s = (int*)(lds + MISC_OFF - 256);

    const int lo = a.ph_lo, hi = a.ph_hi;
#ifndef PH_MASK
#define EN(n) 1
#else
#define EN(n) ((PH_MASK >> ((n) % 20)) & 1)
#endif
#define IN(k) (lo <= (k) && (k) < hi)
#define SEAM(k) do { if (IN(k) && IN((k) + 1)) xcd_barrier(bar); } while (0)

    if (EN(100) && IN(0)) ph_prologue((const int*)a.in[1], a.in[3], w.cosT, w.sinT, w.lb);
    SEAM(0);

    const float* xcur = a.in[0];
    for (int l = 0; l < DEPTH; ++l) {
        const int pb = 1 + l * NPH;
        int* cnt = w.cnt + l * 64;
        float* xo = (l == DEPTH - 1) ? a.out : w.xa;
        if (EN(0) && IN(pb + 0)) ph_gemm_plain(xcur, a.in[2] + (size_t)l * D_ * INW, w.hbuf, INW, INW);
        SEAM(pb + 0);
        if (IN(pb + 1)) {
            const bool split = G > 64;
            if (EN(1) && (!split || bid < 32)) ph_hgrn2(w.hbuf, w.lb + l * 256, a.in[4] + l * 256, w.ycat);
            if (EN(11) && (!split || bid >= 32))
                ph_mix1(w.hbuf, a.in[5] + l * 256, a.in[6] + l * 256, w.vln, a.in[10] + (size_t)l * 2 * 2048, a.in[11] + (size_t)l * 2 * 2048 * 128, a.in[12] + (size_t)l * 2 * 128 * 64,
                        w.kc, w.vc, w.cosT, w.sinT, w.qrot, w.ksr, w.kwr, split ? bid - 32 : bid, split ? G - 32 : G);
        }
        SEAM(pb + 1);
        if (IN(pb + 2)) {
            if (EN(2)) ph_gmsp(w.hbuf, w.vln, a.in[7] + (size_t)l * 4 * 128 * 128, a.in[8] + l * 512, a.in[9] + l * 256, w.ycat);
            if (EN(12)) ph_nsa(w.hbuf, w.qrot, w.ksr, w.kwr, w.kc, w.vc, a.in[13] + l * 512, w.ycat);
        }
        SEAM(pb + 2);
        if (EN(3) && IN(pb + 3)) ph_gemm_plain(w.ycat, a.in[14] + (size_t)l * D_ * D_, w.mix, D_, D_);
        SEAM(pb + 3);
        if (EN(4) && IN(pb + 4)) ph_ln1(xcur, w.mix, a.in[15] + l * D_, a.in[16] + l * D_, a.in[17] + (size_t)l * D_ * NE, a.in[18] + l * NE, w.x1, cnt, w.list, w.tok_e, w.tok_slot, w.tok_w);
        SEAM(pb + 4);
        if (IN(pb + 5) || IN(pb + 6) || IN(pb + 7)) {
            __syncthreads();
            if (tid == 0) { int acc = 0; for (int e = 0; e < NE; ++e) { offs_s[e] = acc; acc += __hip_atomic_load(&cnt[e], __ATOMIC_RELAXED, __HIP_MEMORY_SCOPE_AGENT); } }
            __syncthreads();
        }
        if (EN(5) && IN(pb + 5)) ph_moe_up(w.x1, a.in[19] + (size_t)l * NE * D_ * 2048, a.in[20] + (size_t)l * NE * 2048, w.act, cnt, w.list);
        SEAM(pb + 5);
        if (EN(6) && IN(pb + 6)) ph_moe_dn(w.act, a.in[21] + (size_t)l * NE * D_ * D_, a.in[22] + (size_t)l * NE * D_, w.ybuf, cnt, w.list);
        SEAM(pb + 6);
        if (EN(7) && IN(pb + 7)) ph_comb(w.x1, w.ybuf, w.tok_e, w.tok_slot, w.tok_w, a.in[23] + l * D_, a.in[24] + l * D_, xo);
        SEAM(pb + 7);
        xcur = xo;
    }
#undef IN
#undef SEAM
}
}

extern "C" void kernel_launch(void* const* d_in, const int* in_sizes, int n_in, void* d_out, int out_size, void* d_ws, size_t ws_size, hipStream_t stream) {
    using namespace mk;
    static int grid = 0;
    if (grid == 0) {
        size_t need = WS_NEED;
        if (n_in != 25 || need > ws_size) { fprintf(stderr, "kernel_launch: bad args n_in %d need %zu ws %zu\n", n_in, need, ws_size); grid = -1; return; }
        int dev = 0, cus = 0, per_cu = 0;
        if (hipGetDevice(&dev) != hipSuccess || hipDeviceGetAttribute(&cus, hipDeviceAttributeMultiprocessorCount, dev) != hipSuccess) { grid = -1; return; }
        if (hipFuncSetAttribute((const void*)mega, hipFuncAttributeMaxDynamicSharedMemorySize, LDS_BYTES) != hipSuccess) { fprintf(stderr, "hipFuncSetAttribute failed\n"); grid = -1; return; }
        if (hipOccupancyMaxActiveBlocksPerMultiprocessor(&per_cu, (const void*)mega, NTHR, LDS_BYTES) != hipSuccess || per_cu < 1) fprintf(stderr, "occupancy query: %d\n", per_cu);
        (void)hipGetLastError();
        grid = cus;
    }
    if (grid < 0) return;
    if (hipMemsetAsync(d_ws, 0, CTL_BYTES, stream) != hipSuccess) return;
    Args a{};
    for (int i = 0; i < 25; ++i) a.in[i] = (const float*)d_in[i];
    a.out = (float*)d_out; a.ws = (unsigned char*)d_ws; a.ph_lo = 0; a.ph_hi = 1 + DEPTH * NPH;
    hipLaunchKernelGGL(mega, dim3(grid), dim3(NTHR), LDS_BYTES, stream, a);
}
```

```cpp
#include <hip/hip_runtime.h>
#include <cstdio>
#include <cstdint>
#include <cmath>

__device__ __forceinline__ int mk_tid(int wv) { int lane; asm volatile("v_mbcnt_lo_u32_b32 %0, -1, 0\n\tv_mbcnt_hi_u32_b32 %0, -1, %0" : "=v"(lane)); return (wv << 6) | lane; }
#define XB_TMO      128
#define XB_XCNT(j)  (256  + 64 * (j))
#define XB_XSUB(j)  (1280 + 64 * (j))
#define XB_XGEN(j)  (2304 + 64 * (j))
#define XB_TOP      3328
#define XB_TOPGEN   3392
#define XCD_BAR_WORDS 3456
#define XB_SPIN_CAP (1u << 18)
#define LAS __attribute__((address_space(3)))

__device__ __forceinline__ unsigned xb_ld(unsigned* p)              { return __hip_atomic_load(p, __ATOMIC_RELAXED, __HIP_MEMORY_SCOPE_AGENT); }
__device__ __forceinline__ unsigned xb_add(unsigned* p, unsigned v) { return __hip_atomic_fetch_add(p, v, __ATOMIC_RELAXED, __HIP_MEMORY_SCOPE_AGENT); }
__device__ __forceinline__ unsigned xb_xcc_id() { return (unsigned)__builtin_amdgcn_s_getreg((3 << 11) | 20) & 0xFu; }
#define XB_SPIN(cond, bar) do { unsigned _sp = 0; while (cond) { __builtin_amdgcn_s_sleep(1); \
    if ((++_sp & 255u) == 0u) { if (xb_ld(&(bar)[XB_TMO])) break; if (_sp > XB_SPIN_CAP) { atomicAdd(&(bar)[XB_TMO], 1u); break; } } } } while (0)

struct XcdBarrier {
    unsigned* bar; unsigned x;
    volatile LAS unsigned* st; int wv;
};

__device__ __forceinline__ XcdBarrier xcd_barrier_post(unsigned* bar, volatile LAS unsigned* st, int wv) {
    XcdBarrier b; b.bar = bar; b.x = xb_xcc_id(); b.st = st; b.wv = wv;
    if (mk_tid(b.wv) == 0) (void)xb_add(&bar[XB_XCNT(b.x)], 1u);
    return b;
}
__device__ __forceinline__ void xcd_barrier_complete(unsigned* bar, unsigned x, unsigned& nloc, unsigned& nx) {
    const unsigned G = gridDim.x * gridDim.y * gridDim.z;
    unsigned sum, cnt, mine, sp = 0u;
    for (;;) {
        sum = 0u; cnt = 0u; mine = 0u;
#pragma unroll
        for (unsigned j = 0; j < 16; ++j) { const unsigned c = xb_ld(&bar[XB_XCNT(j)]); sum += c; cnt += (c > 0u) ? 1u : 0u; mine = (j == x) ? c : mine; }
        if (sum == G) break;
        __builtin_amdgcn_s_sleep(1);
        if ((++sp & 255u) == 0u) { if (xb_ld(&bar[XB_TMO])) break; if (sp > XB_SPIN_CAP) { atomicAdd(&bar[XB_TMO], 1u); break; } }
    }
    nloc = mine > 0u ? mine : 1u; nx = cnt > 0u ? cnt : 1u;
}

template <bool FIRST>
__device__ __forceinline__ void xcd_barrier_t(const XcdBarrier& b) {
    asm volatile("s_waitcnt vmcnt(0)" ::: "memory");
    __syncthreads();
    if (mk_tid(b.wv) == 0) {
        unsigned* bar = b.bar; unsigned bx = b.x; asm volatile("" : "+s"(bar), "+s"(bx));
        __builtin_amdgcn_s_waitcnt(0);
        unsigned nloc = b.st[0], nx = b.st[1];
        if (FIRST) { if (nloc == 0u) { xcd_barrier_complete(bar, bx, nloc, nx); b.st[0] = nloc; b.st[1] = nx; } }
        const unsigned old = xb_add(&bar[XB_XSUB(bx)], 1u);
        const unsigned gen = old / nloc;
        if (old + 1u == (gen + 1u) * nloc) {
            __builtin_amdgcn_fence(__ATOMIC_RELEASE, "agent");
            asm volatile("s_waitcnt vmcnt(0)" ::: "memory");
            const unsigned og = xb_add(&bar[XB_TOP], 1u);
            const unsigned tg = og / nx;
            if (og + 1u == (tg + 1u) * nx) xb_add(&bar[XB_TOPGEN], 1u);
            else XB_SPIN(xb_ld(&bar[XB_TOPGEN]) == tg, bar);
            __builtin_amdgcn_fence(__ATOMIC_ACQUIRE, "agent");
            xb_add(&bar[XB_XGEN(bx)], 1u);
            asm volatile("s_waitcnt vmcnt(0)" ::: "memory");
        } else {
            XB_SPIN(xb_ld(&bar[XB_XGEN(bx)]) == gen, bar);
            __builtin_amdgcn_fence(__ATOMIC_ACQUIRE, "agent");
            asm volatile("s_waitcnt vmcnt(0)" ::: "memory");
        }
    }
    __syncthreads();
}


__device__ __forceinline__ void xcd_barrier_first(const XcdBarrier& b) { xcd_barrier_t<true>(b); }
__device__ __forceinline__ void xcd_barrier(const XcdBarrier& b) { xcd_barrier_t<false>(b); }


namespace mk {
constexpr int B_ = 8, S_ = 4096, D_ = 1024, NT = B_ * S_, DEPTH = 2;
constexpr int INW = 2840, HS = 3072;
constexpr int C_HGQ = 0, C_HGF = 256, C_HGI = 512, C_HGG = 768, C_GMU = 1024, C_GMV = 1280, C_NQ = 1536,
              C_KC = 2048, C_VC = 2176, C_KS = 2304, C_VS = 2432, C_KW = 2560, C_VW = 2688, C_NG = 2816;
constexpr int NCMP = 255, NE = 32, TOPK = 4, NASSIGN = NT * TOPK;
constexpr float ALPHA = 1.4142135623730951f;
constexpr int NTHR = 512, LDS_BYTES = 147456, MISC_OFF = 144 * 1024 - 256;
constexpr int NPH = 8;

typedef unsigned short bf16;
__device__ __forceinline__ float bf2f(bf16 v) { return __uint_as_float((unsigned)v << 16); }
__device__ __forceinline__ unsigned f2bf(float f) { unsigned u = __float_as_uint(f); return (u + 0x7fffu + ((u >> 16) & 1u)) >> 16; }
__device__ __forceinline__ unsigned pk2(float lo, float hi) { return f2bf(lo) | (f2bf(hi) << 16); }
__device__ __forceinline__ float gelu_t(float x) { return 0.5f * x * (1.0f + tanhf(0.7978845608028654f * (x + 0.044715f * x * x * x))); }
__device__ __forceinline__ float sigm(float x) { return 1.0f / (1.0f + expf(-x)); }
__device__ __forceinline__ float wsum(float v) {
#pragma unroll
    for (int o = 1; o < 64; o <<= 1) v += __shfl_xor(v, o);
    return v;
}
__device__ __forceinline__ float wmax(float v) {
#pragma unroll
    for (int o = 1; o < 64; o <<= 1) v = fmaxf(v, __shfl_xor(v, o));
    return v;
}

constexpr int MROWS = NASSIGN + NE * 256;
constexpr size_t CTL_BYTES = 65536;
constexpr size_t al256(size_t x) { return (x + 255) & ~(size_t)255; }
constexpr size_t O_COS = CTL_BYTES, O_SIN = O_COS + al256((size_t)NT * 32 * 4), O_LB = O_SIN + al256((size_t)NT * 32 * 4);
constexpr size_t O_WIN = O_LB + al256(512 * 4), O_WOUT = O_WIN + al256((size_t)DEPTH * HS * D_ * 2), O_WUP = O_WOUT + al256((size_t)DEPTH * D_ * D_ * 2);
constexpr size_t O_WDN = O_WUP + al256((size_t)DEPTH * NE * 2048 * D_ * 2), O_XB = O_WDN + al256((size_t)DEPTH * NE * D_ * D_ * 2);
constexpr size_t O_HB = O_XB + al256((size_t)NT * D_ * 2), O_YCAT = O_HB + al256((size_t)NT * HS * 2), O_MIXB = O_YCAT + al256((size_t)NT * D_ * 2);
constexpr size_t O_X1B = O_MIXB + al256((size_t)NT * D_ * 2), O_ACT = O_X1B + al256((size_t)NT * D_ * 2), O_YB = O_ACT + al256((size_t)MROWS * D_ * 2);
constexpr size_t O_X1 = O_YB + al256((size_t)MROWS * D_ * 2), O_XA = O_X1 + al256((size_t)NT * D_ * 4);
constexpr size_t O_VLNT = O_XA + al256((size_t)NT * D_ * 4), O_WB = O_VLNT + al256((size_t)NT * 256 * 2), O_W1T = O_WB + al256((size_t)DEPTH * 4 * 128 * 128 * 2);
constexpr size_t O_CBIAS = O_W1T + al256((size_t)DEPTH * 2 * 128 * 2048 * 2), O_W2T = O_CBIAS + al256((size_t)DEPTH * 2 * 128 * 4), O_HQT = O_W2T + al256((size_t)DEPTH * 2 * 64 * 128 * 2);
constexpr size_t HGB = (size_t)2048 * 4096 * 2;
constexpr size_t O_HKT = O_HQT + HGB, O_HQP = O_HKT + HGB, O_HVT = O_HQP + HGB, O_HST = O_HVT + HGB, O_HUT = O_HST + HGB, O_HDK = O_HUT + 2 * HGB;
constexpr size_t O_KSB = O_HDK + al256((size_t)2048 * 64 * 4), O_VSB = O_KSB + al256((size_t)NT * 128 * 2);
constexpr size_t O_KWB = O_VSB + al256((size_t)NT * 128 * 2), O_VWB = O_KWB + al256((size_t)NT * 128 * 2), O_KCB = O_VWB + al256((size_t)NT * 128 * 2), O_VCB = O_KCB + al256((size_t)B_ * 2 * 256 * 64 * 2);
constexpr size_t O_LIST = O_VCB + al256((size_t)B_ * 2 * 256 * 64 * 2), O_TE = O_LIST + al256((size_t)NE * NT * 4), O_TS = O_TE + al256((size_t)NASSIGN * 4), O_TW = O_TS + al256((size_t)NASSIGN * 4);
constexpr size_t WS_NEED = O_TW + al256((size_t)NASSIGN * 4);
namespace pg8 {
#define PG8_LAS __attribute__((address_space(3)))
typedef unsigned short bf16_t;
typedef short bf16x8 __attribute__((ext_vector_type(8)));
typedef float f32x4 __attribute__((ext_vector_type(4)));
typedef float f32x2 __attribute__((ext_vector_type(2)));
typedef unsigned u32x4 __attribute__((ext_vector_type(4)));
constexpr int BM = 256, BK = 64, HALF = 128, HTB = HALF * BK * 2  , STAGE_BYTES = 8 * HTB, NXCD = 8, WGM = 8;

__host__ __device__ __forceinline__ int lds_byte(int r, int c) { const int st = (r >> 4) * 2 + (c >> 5), rr = r & 15, cc = c & 31, ob = rr * 64 + cc * 2; return st * 1024 + (ob ^ (((ob >> 9) & 1) << 5)); }
__host__ __device__ __forceinline__ void stage_rc(int b, int& R, int& C) { const int st = b / 1024, sb = b % 1024, swz = sb ^ (((sb >> 9) & 1) << 5); R = (st >> 1) * 16 + swz / 64; C = (st & 1) * 32 + (swz % 64) / 2; }
__host__ __device__ __forceinline__ int perm32(int rho) { const int n = rho >> 4, i = rho & 15; return 8 * (i >> 2) + 4 * n + (i & 3); }

struct Unit { int pm, pn, e, mt, cnt; };

__device__ __forceinline__ void deal(int L, int nM, int nN, int& pm, int& pn) {
    const int nwg = nM * nN;
    int wgid = L; { const int q = nwg / NXCD, r = nwg % NXCD, xcd = wgid % NXCD, off = wgid / NXCD; wgid = (xcd < r ? xcd * (q + 1) : r * (q + 1) + (xcd - r) * q) + off; }
    const int nig = WGM * nN, gid = wgid / nig, fm = gid * WGM, gsz = (nM - fm) < WGM ? (nM - fm) : WGM;
    pm = fm + ((wgid % nig) % gsz); pn = (wgid % nig) / gsz;
}
struct PlainOrder {
    const bf16_t* Bt; int K; int nM, nN, G, c;
    __device__ __forceinline__ bool next(int i, Unit& u) const { const long L = (long)i * G + c; if (L >= (long)nM * nN) return false; deal((int)L, nM, nN, u.pm, u.pn); u.e = 0; u.mt = 0; u.cnt = 0; return true; }
    __device__ __forceinline__ unsigned a_row(const Unit& u, int r) const { return (unsigned)(u.pm * BM + r); }
    __device__ __forceinline__ const char* b_base(const Unit& u) const { return (const char*)Bt + (size_t)u.pn * BM * K * 2; }
};
template <bool GATHER> struct MoeOrder {
    const bf16_t* Bt; int K; int nN, G, c; size_t estride;
    const int* tstart; const int* cnts; const int* list;
    __device__ __forceinline__ bool next(int i, Unit& u) const {
        const int nM = tstart[32]; const long L = (long)i * G + c; if (L >= (long)nM * nN) return false;
        deal((int)L, nM, nN, u.pm, u.pn);
        int e = 0;
#pragma unroll 1
        for (int k = 1; k < 32; ++k) e = (tstart[k] <= u.pm) ? k : e;
        u.e = e; u.mt = u.pm - tstart[e]; u.cnt = cnts[e]; return true;
    }
    __device__ __forceinline__ unsigned a_row(const Unit& u, int r) const {
        if (GATHER) { const int slot = u.mt * BM + r; return (slot < u.cnt) ? (unsigned)list[u.e * 32768 + slot] : 0u; }
        return (unsigned)(u.pm * BM + r);
    }
    __device__ __forceinline__ const char* b_base(const Unit& u) const { return (const char*)Bt + ((size_t)u.e * estride + (size_t)u.pn * BM * K) * 2; }
};

__device__ __forceinline__ unsigned cvt_pk_bf16(float lo, float hi) { unsigned r; asm volatile("v_cvt_pk_bf16_f32 %0, %1, %2" : "=v"(r) : "v"(lo), "v"(hi)); return r; }

struct EpiBf16 {
    static constexpr bool PERM = true;
    bf16_t* O; int ldc; const float* bias; int bstride;
    __device__ __forceinline__ void operator()(const f32x4 (&acc)[2][2][4][2], const Unit& u, int wr, int wc, int fr, int fq) const {
        const int row0 = u.pm * BM + wr * 64 + fr; const int col0 = u.pn * BM + wc * 32 + 8 * fq;
        f32x4 bv[2][2];
#pragma unroll
        for (int bj = 0; bj < 2; ++bj)
#pragma unroll
            for (int n = 0; n < 2; ++n) bv[bj][n] = bias ? *(const f32x4*)(bias + (size_t)u.e * bstride + col0 + bj * HALF + 4 * n) : (f32x4){0.f, 0.f, 0.f, 0.f};
#pragma unroll
        for (int ai = 0; ai < 2; ++ai)
#pragma unroll
            for (int m = 0; m < 4; ++m) { bf16_t* rowp = O + (size_t)(row0 + ai * HALF + m * 16) * ldc + col0;
#pragma unroll
                for (int bj = 0; bj < 2; ++bj) { f32x4 v0 = acc[ai][bj][m][0] + bv[bj][0], v1 = acc[ai][bj][m][1] + bv[bj][1];
                    u32x4 w; w.x = cvt_pk_bf16(v0[0], v0[1]); w.y = cvt_pk_bf16(v0[2], v0[3]); w.z = cvt_pk_bf16(v1[0], v1[1]); w.w = cvt_pk_bf16(v1[2], v1[3]);
                    *(u32x4*)(rowp + bj * HALF) = w; } }
    }
};
__device__ __forceinline__ float swiglu1(float g, float l) {
    g = fminf(g, 7.0f); l = fminf(fmaxf(l, -7.0f), 7.0f);
    const float s = __builtin_amdgcn_rcpf(1.0f + __builtin_amdgcn_exp2f(-1.702f * 1.4426950408889634f * g));
    return g * s * (l + 1.0f);
}
struct EpiUp {
    static constexpr bool PERM = true;
    bf16_t* O; const float* bias;
    __device__ __forceinline__ void operator()(const f32x4 (&acc)[2][2][4][2], const Unit& u, int wr, int wc, int fr, int fq) const {
        const int row0 = u.pm * BM + wr * 64 + fr; const int j0 = u.pn * HALF + wc * 32 + 8 * fq;
        const float* bp = bias + (size_t)u.e * 2048 + j0;
        f32x4 bg[2], bl[2];
#pragma unroll
        for (int n = 0; n < 2; ++n) { bg[n] = *(const f32x4*)(bp + 4 * n); bl[n] = *(const f32x4*)(bp + 1024 + 4 * n); }
#pragma unroll
        for (int ai = 0; ai < 2; ++ai)
#pragma unroll
            for (int m = 0; m < 4; ++m) {
                float o[8];
#pragma unroll
                for (int n = 0; n < 2; ++n) { const f32x4 g = acc[ai][0][m][n] + bg[n], l = acc[ai][1][m][n] + bl[n];
#pragma unroll
                    for (int j = 0; j < 4; ++j) o[4 * n + j] = swiglu1(g[j], l[j]); }
                u32x4 w; w.x = cvt_pk_bf16(o[0], o[1]); w.y = cvt_pk_bf16(o[2], o[3]); w.z = cvt_pk_bf16(o[4], o[5]); w.w = cvt_pk_bf16(o[6], o[7]);
                *(u32x4*)(O + (size_t)(row0 + ai * HALF + m * 16) * 1024 + j0) = w; }
    }
};

template <class Epi, class Sched, bool ALIGN_EPI>
__device__ __forceinline__ void gemm_phase(const int wv, PG8_LAS unsigned char* lds, const bf16_t* Abase, const int K, const Sched& S, const Epi& E) {
    int tid = mk_tid(wv); asm volatile("" : "+v"(tid));
    const int wid = __builtin_amdgcn_readfirstlane(tid >> 6), lane = tid & 63, wr = wid >> 2, wc = wid & 3, fr = lane & 15, fq = lane >> 4;
    const int nt = K / BK;
    const char* Ab = (const char*)Abase;
    int Rr[2]; unsigned CB[2], voffB[2];
#pragma unroll
    for (int i = 0; i < 2; ++i) { int R, C; stage_rc(tid * 16 + i * 8192, R, C); const int Rb = Epi::PERM ? ((R & ~31) + perm32(R & 31)) : R;
        Rr[i] = R; CB[i] = (unsigned)C * 2u; voffB[i] = (unsigned)(Rb * K + C) * 2u; }
    const size_t kstep = (size_t)(BK * 2);
    const size_t hstep = (size_t)HALF * K * 2;
    const unsigned rowb = (unsigned)K * 2u;
    const unsigned ldsw = (unsigned)wid * 1024u;
    const int aoff = lds_byte(wr * 64 + fr, fq * 8), boff = lds_byte(wc * 32 + fr, fq * 8);
#define PG8_SA(b, h) (((b) * 2 + (h)) * HTB)
#define PG8_SB(b, h) ((4 + (b) * 2 + (h)) * HTB)
#define PG8_STAGE(bufoff, gbase, voff) do { _Pragma("unroll") for (int _i = 0; _i < 2; ++_i) \
        __builtin_amdgcn_global_load_lds((const unsigned*)((const char*)(gbase) + (voff)[_i]), (PG8_LAS unsigned*)(lds + (bufoff) + ldsw + _i * 8192), 16, 0, 0); } while (0)
#define PG8_STAGE_A(bufoff, kb, o0, o1) do { \
        __builtin_amdgcn_global_load_lds((const unsigned*)(Ab + (kb) + (o0)), (PG8_LAS unsigned*)(lds + (bufoff) + ldsw), 16, 0, 0); \
        __builtin_amdgcn_global_load_lds((const unsigned*)(Ab + (kb) + (o1)), (PG8_LAS unsigned*)(lds + (bufoff) + ldsw + 8192), 16, 0, 0); } while (0)
#define PG8_LDA(dst, b, h) do { _Pragma("unroll") for (int m = 0; m < 4; ++m) _Pragma("unroll") for (int k = 0; k < 2; ++k) dst[m][k] = *(const PG8_LAS bf16x8*)(lds + PG8_SA(b, h) + aoff + m * 2048 + k * 1024); } while (0)
#define PG8_LDB(dst, b, h) do { _Pragma("unroll") for (int n = 0; n < 2; ++n) _Pragma("unroll") for (int k = 0; k < 2; ++k) dst[n][k] = *(const PG8_LAS bf16x8*)(lds + PG8_SB(b, h) + boff + n * 2048 + k * 1024); } while (0)
#define PG8_MMA(ai, bj, At, Bt) do { __builtin_amdgcn_s_setprio(1); _Pragma("unroll") for (int m = 0; m < 4; ++m) _Pragma("unroll") for (int n = 0; n < 2; ++n) _Pragma("unroll") for (int k = 0; k < 2; ++k) \
        acc[ai][bj][m][n] = __builtin_amdgcn_mfma_f32_16x16x32_bf16(Bt[n][k], At[m][k], acc[ai][bj][m][n], 0, 0, 0); __builtin_amdgcn_s_setprio(0); } while (0)
#define PG8_WAIT_V(n) asm volatile("s_waitcnt vmcnt(" #n ")" ::: "memory")
#define PG8_WAIT_L(n) asm volatile("s_waitcnt lgkmcnt(" #n ")" ::: "memory")
#define PG8_BAR __builtin_amdgcn_s_barrier()
#define PG8_SCHED __builtin_amdgcn_sched_barrier(0)
#define PG8_AOFFS(dst, u) do { _Pragma("unroll") for (int _h = 0; _h < 2; ++_h) _Pragma("unroll") for (int _i = 0; _i < 2; ++_i) \
        dst[_h][_i] = S.a_row(u, _h * HALF + Rr[_i]) * rowb + CB[_i]; } while (0)
    Unit cur, nxt; int ui = 0;
    if (!S.next(0, cur)) return;
    f32x4 acc[2][2][4][2];
#pragma unroll
    for (int a = 0; a < 2; ++a)
#pragma unroll
        for (int b = 0; b < 2; ++b)
#pragma unroll
            for (int m = 0; m < 4; ++m)
#pragma unroll
                for (int n = 0; n < 2; ++n) acc[a][b][m][n] = (f32x4){0.f, 0.f, 0.f, 0.f};
    bf16x8 At[4][2], B0[2][2], B1[2][2];
    unsigned aC[2][2], aN[2][2];
    PG8_AOFFS(aC, cur);
    const char* cB = S.b_base(cur);
    PG8_STAGE(PG8_SB(0, 0), cB, voffB); PG8_STAGE(PG8_SB(0, 1), cB + hstep, voffB); PG8_STAGE_A(PG8_SA(0, 0), 0, aC[0][0], aC[0][1]); PG8_STAGE_A(PG8_SA(0, 1), 0, aC[1][0], aC[1][1]);
    if (wr == 1) PG8_BAR;
    PG8_WAIT_V(2); PG8_BAR;
    PG8_STAGE(PG8_SB(1, 0), cB + kstep, voffB); PG8_STAGE_A(PG8_SA(1, 0), kstep, aC[0][0], aC[0][1]); PG8_STAGE(PG8_SB(1, 1), cB + hstep + kstep, voffB);
    PG8_WAIT_V(6); PG8_BAR;
    for (;;) {
        const bool has_next = S.next(ui + 1, nxt);
        const char* nB = has_next ? S.b_base(nxt) : cB;
        if (has_next) { PG8_AOFFS(aN, nxt); }
        else {
#pragma unroll
            for (int _h = 0; _h < 2; ++_h)
#pragma unroll
                for (int _i = 0; _i < 2; ++_i) aN[_h][_i] = aC[_h][_i]; }
#pragma unroll 1
        for (int t = 0; t < nt; t += 2) {
            const bool last = (t == nt - 2);
            const size_t kb1 = (size_t)(t + 1) * kstep;
            PG8_LDB(B0, 0, 0); PG8_LDB(B1, 0, 1); PG8_SCHED; PG8_LDA(At, 0, 0); PG8_STAGE_A(PG8_SA(1, 1), kb1, aC[1][0], aC[1][1]);
            PG8_WAIT_V(8); PG8_WAIT_L(0); PG8_BAR; PG8_MMA(0, 0, At, B0); PG8_MMA(0, 1, At, B1); PG8_BAR; PG8_SCHED;
            if (last) {
#pragma unroll
                for (int _h = 0; _h < 2; ++_h)
#pragma unroll
                    for (int _i = 0; _i < 2; ++_i) aC[_h][_i] = aN[_h][_i]; }
            const size_t kb2 = last ? (size_t)0 : (size_t)(t + 2) * kstep; const char* b2 = last ? nB : cB + (size_t)(t + 2) * kstep;
            const size_t kb3 = kb2 + kstep; const char* b3 = b2 + kstep;
            PG8_LDA(At, 0, 1); PG8_STAGE(PG8_SB(0, 0), b2, voffB); PG8_STAGE(PG8_SB(0, 1), b2 + hstep, voffB); PG8_STAGE_A(PG8_SA(0, 0), kb2, aC[0][0], aC[0][1]);
            PG8_WAIT_V(8); PG8_WAIT_L(0); PG8_BAR; PG8_MMA(1, 0, At, B0); PG8_MMA(1, 1, At, B1); PG8_BAR; PG8_SCHED;
            PG8_LDB(B0, 1, 0); PG8_LDB(B1, 1, 1); PG8_SCHED; PG8_LDA(At, 1, 0); PG8_STAGE_A(PG8_SA(0, 1), kb2, aC[1][0], aC[1][1]);
            PG8_WAIT_V(8); PG8_WAIT_L(0); PG8_BAR; PG8_MMA(0, 0, At, B0); PG8_MMA(0, 1, At, B1); PG8_BAR; PG8_SCHED;
            PG8_LDA(At, 1, 1); PG8_STAGE(PG8_SB(1, 0), b3, voffB); PG8_STAGE(PG8_SB(1, 1), b3 + hstep, voffB); PG8_STAGE_A(PG8_SA(1, 0), kb3, aC[0][0], aC[0][1]);
            PG8_WAIT_V(8); PG8_WAIT_L(0); PG8_BAR; PG8_MMA(1, 0, At, B0); PG8_MMA(1, 1, At, B1); PG8_BAR; PG8_SCHED;
        }
        if (ALIGN_EPI) { if (wr == 0) PG8_BAR; }
        E(acc, cur, wr, wc, fr, fq);
        if (!has_next) break;
#pragma unroll
        for (int a = 0; a < 2; ++a)
#pragma unroll
            for (int b = 0; b < 2; ++b)
#pragma unroll
                for (int m = 0; m < 4; ++m)
#pragma unroll
                    for (int n = 0; n < 2; ++n) acc[a][b][m][n] = (f32x4){0.f, 0.f, 0.f, 0.f};
        cur = nxt; cB = nB; ++ui;
        if (ALIGN_EPI) { if (wr == 1) PG8_BAR; }
    }
    PG8_WAIT_V(0);
    if (!ALIGN_EPI) { if (wr == 0) PG8_BAR; }
    PG8_BAR;
#undef PG8_SA
#undef PG8_SB
#undef PG8_STAGE
#undef PG8_STAGE_A
#undef PG8_LDA
#undef PG8_LDB
#undef PG8_MMA
#undef PG8_WAIT_V
#undef PG8_WAIT_L
#undef PG8_BAR
#undef PG8_SCHED
#undef PG8_AOFFS
}
}


namespace nsa {
#define NLAS __attribute__((address_space(3)))
typedef short bf16x8 __attribute__((ext_vector_type(8)));
typedef short s16x4 __attribute__((ext_vector_type(4)));
typedef short v4i16_t __attribute__((ext_vector_type(4)));
typedef float f32x16 __attribute__((ext_vector_type(16)));
typedef float f32x2_t __attribute__((ext_vector_type(2)));
typedef __bf16 bf16x2_t __attribute__((ext_vector_type(2)));
#define NSA_MFMA(a, b, c) __builtin_amdgcn_mfma_f32_32x32x16_bf16((a), (b), (c), 0, 0, 0)
constexpr int L_CK = 0, L_CV = 32768, L_RING = 65536, L_IMP = 114688, SLOTB = 16384, L_SELM = 131072 + 1024;
constexpr float QSCALE = 0.125f * 1.4426950408889634f;
constexpr float NEGBIG = -1.0e30f;

__device__ __forceinline__ unsigned cvtpk(float lo, float hi) { f32x2_t v = {lo, hi}; bf16x2_t b = __builtin_convertvector(v, bf16x2_t); return __builtin_bit_cast(unsigned, b); }
__device__ __forceinline__ float bflo(unsigned u) { return __uint_as_float(u << 16); }
__device__ __forceinline__ float bfhi(unsigned u) { return __uint_as_float(u & 0xffff0000u); }
__device__ __forceinline__ float xhalf(float v) { return __shfl_xor(v, 32); }
__device__ __forceinline__ s16x4 vtr(const NLAS unsigned char* p) { return __builtin_bit_cast(s16x4, __builtin_amdgcn_ds_read_tr16_b64_v4i16((NLAS v4i16_t*)p)); }
__device__ __forceinline__ bf16x8 pack8(const f32x16& x, int s) {
    unsigned p0 = cvtpk(x[8 * s], x[8 * s + 1]), p1 = cvtpk(x[8 * s + 2], x[8 * s + 3]), p2 = cvtpk(x[8 * s + 4], x[8 * s + 5]), p3 = cvtpk(x[8 * s + 6], x[8 * s + 7]);
    typedef unsigned u32x4 __attribute__((ext_vector_type(4)));
    u32x4 u = {p0, p1, p2, p3}; return __builtin_bit_cast(bf16x8, u);
}

struct Params {
    const unsigned short* hb;
    const unsigned short *kcb, *vcb;
    const unsigned short *ksb, *vsb, *kwb, *vwb;
    const float *cosT, *sinT;
    const float* normw;
    unsigned short* ycat;
};

__device__ __forceinline__ void qk_tile(const NLAS unsigned char* kt, const bf16x8 (&qf)[4], const int (&kofs)[4], f32x16& st0, f32x16& st1) {
#pragma unroll
    for (int i = 0; i < 16; ++i) { st0[i] = 0.f; st1[i] = 0.f; }
#pragma unroll
    for (int ks = 0; ks < 4; ++ks) {
        const bf16x8 k0 = *(const NLAS bf16x8*)(kt + kofs[ks]);
        const bf16x8 k1 = *(const NLAS bf16x8*)(kt + kofs[ks] + 4096);
        st0 = NSA_MFMA(k0, qf[ks], st0); st1 = NSA_MFMA(k1, qf[ks], st1);
    }
}
__device__ __forceinline__ void pv_tile(const NLAS unsigned char* vt, const int (&vofs)[2][2], const f32x16& p0, const f32x16& p1, f32x16& o0, f32x16& o1) {
#pragma unroll
    for (int kt = 0; kt < 2; ++kt)
#pragma unroll
        for (int s = 0; s < 2; ++s) {
            const bf16x8 pb = pack8(kt ? p1 : p0, s);
            const int kb = (32 * kt + 16 * s) * 128;
#pragma unroll
            for (int mb = 0; mb < 2; ++mb) {
                const s16x4 lo = vtr(vt + kb + vofs[mb][0]), hi = vtr(vt + kb + vofs[mb][1]);
                const bf16x8 va = __builtin_shufflevector(lo, hi, 0, 1, 2, 3, 4, 5, 6, 7);
                if (mb == 0) o0 = NSA_MFMA(va, pb, o0); else o1 = NSA_MFMA(va, pb, o1);
            }
        }
}
template <bool USE_LO>
__device__ __forceinline__ void softmax_tile(f32x16& s0, f32x16& s1, const int hi4, const int lo4, float& m, float& l, f32x16& o0, f32x16& o1) {
    float mx = NEGBIG;
#pragma unroll
    for (int i = 0; i < 16; ++i) {
        const int kk0 = (i & 3) + 8 * (i >> 2), kk1 = kk0 + 32;
        bool a0 = kk0 <= hi4, a1 = kk1 <= hi4;
        if (USE_LO) { a0 = a0 && (kk0 >= lo4); a1 = a1 && (kk1 >= lo4); }
        s0[i] = a0 ? s0[i] : NEGBIG; s1[i] = a1 ? s1[i] : NEGBIG;
        mx = fmaxf(mx, fmaxf(s0[i], s1[i]));
    }
    mx = fmaxf(mx, xhalf(mx));
    const float mn = fmaxf(m, mx);
    const float alpha = __builtin_amdgcn_exp2f(m - mn);
    m = mn;
    float sum = 0.f;
#pragma unroll
    for (int i = 0; i < 16; ++i) {
        const float e0 = (s0[i] > -1.0e29f) ? __builtin_amdgcn_exp2f(s0[i] - mn) : 0.f;
        const float e1 = (s1[i] > -1.0e29f) ? __builtin_amdgcn_exp2f(s1[i] - mn) : 0.f;
        s0[i] = e0; s1[i] = e1; sum += e0 + e1;
    }
    l = l * alpha + sum;
#pragma unroll
    for (int i = 0; i < 16; ++i) { o0[i] *= alpha; o1[i] *= alpha; }
}

__device__ __forceinline__ void unit(const Params& P, NLAS unsigned char* lds, const int tid_in, const int b, const int g, const int qb) {
    int tid = tid_in; asm volatile("" : "+v"(tid));
    const int wv = __builtin_amdgcn_readfirstlane(tid >> 6), lane = tid & 63, r = lane & 31, h = lane >> 5;
    const int head = g * 4 + (wv >> 1), qi = 32 * (wv & 1) + r;
    const int t = qb * 64 + qi, tok = b * 4096 + t;
    const int bg = b * 2 + g;
    int kofs[4];
#pragma unroll
    for (int ks = 0; ks < 4; ++ks) kofs[ks] = r * 128 + ((((2 * ks + h) ^ ((r >> 1) & 7))) << 4);
    int vofs[2][2];
    { const int i16 = lane & 15, blk = (lane >> 4) & 1, q = i16 >> 2, p = i16 & 3;
#pragma unroll
      for (int mb = 0; mb < 2; ++mb)
#pragma unroll
          for (int jj = 0; jj < 2; ++jj) { const int key = 4 * h + 8 * jj + q; const int o = 4 * mb + 2 * blk + (p >> 1);
              vofs[mb][jj] = key * 128 + ((o ^ (((key >> 1) & 1) << 2)) << 4) + (p & 1) * 8; } }
    const int drow = tid >> 3, dpos = tid & 7;
    const unsigned srcK = (unsigned)(drow * 128 + ((dpos ^ ((drow >> 1) & 7)) << 4));
    const unsigned srcV = (unsigned)(drow * 128 + ((dpos ^ (((drow >> 1) & 1) << 2)) << 4));
    const unsigned wdst = (unsigned)wv * 1024u;
#define NSA_DMA(slotoff, gsrc, soff) __builtin_amdgcn_global_load_lds((const unsigned*)((const char*)(gsrc) + (soff)), (NLAS unsigned*)(lds + (slotoff) + wdst), 16, 0, 0)
    const int nsel = qb + 1, jw0 = qb >= 8 ? qb - 8 : 0, ntiles = nsel + (qb - jw0 + 1);
    const char* ksg = (const char*)P.ksb + (size_t)bg * 4096 * 128; const char* vsg = (const char*)P.vsb + (size_t)bg * 4096 * 128;
    const char* kwg = (const char*)P.kwb + (size_t)bg * 4096 * 128; const char* vwg = (const char*)P.vwb + (size_t)bg * 4096 * 128;
#define NSA_ISSUE(pos) do { const int _p = (pos) < ntiles ? (pos) : ntiles - 1; const bool _w = _p >= nsel; const int _j = _w ? jw0 + _p - nsel : _p; \
        const int _slot = L_RING + ((pos) % 3) * SLOTB; \
        NSA_DMA(_slot, (_w ? kwg : ksg) + (size_t)_j * 8192, srcK); NSA_DMA(_slot + 8192, (_w ? vwg : vsg) + (size_t)_j * 8192, srcV); } while (0)
    { const char* kcg = (const char*)P.kcb + (size_t)bg * 256 * 128; const char* vcg = (const char*)P.vcb + (size_t)bg * 256 * 128;
#pragma unroll
      for (int T = 0; T < 4; ++T) { NSA_DMA(L_CK + T * 8192, kcg + T * 8192, srcK); NSA_DMA(L_CV + T * 8192, vcg + T * 8192, srcV); } }
    NSA_ISSUE(0); NSA_ISSUE(1);
    typedef unsigned u32x4 __attribute__((ext_vector_type(4)));
    bf16x8 qf[4];
    const unsigned short* qrow = P.hb + (size_t)tok * 3072 + 1536 + (head & 7) * 64;
    {
        u32x4 qraw[4];
#pragma unroll
        for (int ks = 0; ks < 4; ++ks) qraw[ks] = *(const u32x4*)(qrow + 16 * ks + 8 * h);
#pragma unroll
        for (int ks = 0; ks < 4; ++ks) { u32x4 o;
#pragma unroll
            for (int c = 0; c < 4; ++c) o[c] = cvtpk(bflo(qraw[ks][c]) * QSCALE, bfhi(qraw[ks][c]) * QSCALE);
            qf[ks] = __builtin_bit_cast(bf16x8, o); }
    }
    float gc, gs, gw;
    { const unsigned short* gp = P.hb + (size_t)tok * 3072 + 2816 + head * 3;
      gc = 1.f / (1.f + __expf(-__uint_as_float((unsigned)gp[0] << 16))); gs = 1.f / (1.f + __expf(-__uint_as_float((unsigned)gp[1] << 16))); gw = 1.f / (1.f + __expf(-__uint_as_float((unsigned)gp[2] << 16))); }
    asm volatile("s_waitcnt vmcnt(0)" ::: "memory"); __builtin_amdgcn_s_barrier();
    const int cmax = (t >= 31) ? (((t - 31) >> 4) < 254 ? ((t - 31) >> 4) : 254) : -1;
    float m = NEGBIG, l = 0.f;
    {
        f32x16 s0, s1, d0, d1;
#pragma unroll
        for (int i = 0; i < 16; ++i) { d0[i] = 0.f; d1[i] = 0.f; }
#pragma unroll 1
        for (int T = 0; T < 4; ++T) {
            qk_tile(lds + L_CK + T * 8192, qf, kofs, s0, s1);
            softmax_tile<false>(s0, s1, cmax - 64 * T - 4 * h, 0, m, l, d0, d1);
        }
    }
    const float lc = l + xhalf(l);
    const float rinv = lc > 0.f ? 1.0f / lc : 0.f;
    f32x16 of0, of1;
#pragma unroll
    for (int i = 0; i < 16; ++i) { of0[i] = 0.f; of1[i] = 0.f; }
    const bool need_sel = qb >= 16;
    float ow[32];
    float carry_in = 0.f;
#pragma unroll
    for (int T = 0; T < 4; ++T) {
        f32x16 s0, s1;
        qk_tile(lds + L_CK + T * 8192, qf, kofs, s0, s1);
        const int hi4 = cmax - 64 * T - 4 * h;
#pragma unroll
        for (int i = 0; i < 16; ++i) {
            const int kk0 = (i & 3) + 8 * (i >> 2), kk1 = kk0 + 32;
            s0[i] = (kk0 <= hi4) ? __builtin_amdgcn_exp2f(s0[i] - m) * rinv : 0.f;
            s1[i] = (kk1 <= hi4) ? __builtin_amdgcn_exp2f(s1[i] - m) * rinv : 0.f;
        }
#pragma unroll
        for (int kt = 0; kt < 2; ++kt)
#pragma unroll
            for (int u = 0; u < 4; ++u) {
                const float p0 = kt ? s1[4 * u] : s0[4 * u], p1 = kt ? s1[4 * u + 1] : s0[4 * u + 1], p2 = kt ? s1[4 * u + 2] : s0[4 * u + 2], p3 = kt ? s1[4 * u + 3] : s0[4 * u + 3];
                const float x = xhalf(p3);
                const float own = 2.0f * ((p0 + p1) + p2) + p3;
                ow[8 * T + 4 * kt + u] = own + (h ? x : carry_in);
                carry_in = x;
            }
        pv_tile(lds + L_CV + T * 8192, vofs, s0, s1, of0, of1);
    }
#pragma unroll
    for (int i = 0; i < 16; ++i) { of0[i] *= gc; of1[i] *= gc; }
    unsigned long long selmask = (qb >= 63) ? ~0ull : ((1ull << (qb + 1)) - 1ull);
    if (need_sel) {
        NLAS float* imp = (NLAS float*)(lds + L_IMP) + qi * 64;
#pragma unroll 1
        for (int hh = 0; hh < 4; ++hh) {
            if ((wv >> 1) == hh) {
                if (hh == 0) {
#pragma unroll
                    for (int idx = 0; idx < 32; ++idx) imp[(2 * idx + h + qi) & 63] = ow[idx];
                } else {
#pragma unroll
                    for (int idx = 0; idx < 32; ++idx) imp[(2 * idx + h + qi) & 63] += ow[idx];
                }
            }
            asm volatile("s_waitcnt lgkmcnt(0)" ::: "memory"); __builtin_amdgcn_s_barrier();
        }
        NLAS unsigned long long* selm = (NLAS unsigned long long*)(lds + L_SELM);
        const unsigned long long forced = 1ull | (1ull << qb) | (1ull << (qb - 1));
        const bool cand = (lane >= 1) && (lane <= qb - 2);
#pragma unroll 1
        for (int qq = 0; qq < 8; ++qq) {
            const int q = 8 * wv + qq;
            const float v = ((NLAS float*)(lds + L_IMP))[q * 64 + ((lane + q) & 63)];
            const unsigned vb = cand ? __float_as_uint(v) : 0u;
            unsigned thr = 0u;
#pragma unroll 1
            for (int bit = 30; bit >= 0; --bit) {
                const unsigned c2 = thr | (1u << bit);
                const int cnt = __popcll(__ballot(cand && vb >= c2));
                thr = (cnt >= 13) ? c2 : thr;
            }
            unsigned long long sel = __ballot(cand && vb > thr);
            unsigned long long eq = __ballot(cand && vb == thr);
            int need = 13 - __popcll(sel);
#pragma unroll 1
            for (; need > 0; --need) { const unsigned long long low = eq & (~eq + 1ull); sel |= low; eq ^= low; }
            if (lane == 0) selm[q] = sel | forced;
        }
        asm volatile("s_waitcnt lgkmcnt(0)" ::: "memory"); __builtin_amdgcn_s_barrier();
        selmask = selm[qi];
    }
    {
        u32x4 qraw[4];
#pragma unroll
        for (int ks = 0; ks < 4; ++ks) qraw[ks] = *(const u32x4*)(qrow + 16 * ks + 8 * h);
        const float4* cp = (const float4*)(P.cosT + (size_t)tok * 32 + 8 * h); const float4* sp = (const float4*)(P.sinT + (size_t)tok * 32 + 8 * h);
#pragma unroll
        for (int ks = 0; ks < 2; ++ks) {
            const float4 c0 = cp[4 * ks], c1 = cp[4 * ks + 1], s0 = sp[4 * ks], s1 = sp[4 * ks + 1];
            const float cs[8] = {c0.x, c0.y, c0.z, c0.w, c1.x, c1.y, c1.z, c1.w}, sn[8] = {s0.x, s0.y, s0.z, s0.w, s1.x, s1.y, s1.z, s1.w};
            u32x4 oa, ob;
#pragma unroll
            for (int c = 0; c < 4; ++c) {
                const float a0 = bflo(qraw[ks][c]), a1 = bfhi(qraw[ks][c]), b0 = bflo(qraw[ks + 2][c]), b1 = bfhi(qraw[ks + 2][c]);
                oa[c] = cvtpk((a0 * cs[2 * c] - b0 * sn[2 * c]) * QSCALE, (a1 * cs[2 * c + 1] - b1 * sn[2 * c + 1]) * QSCALE);
                ob[c] = cvtpk((b0 * cs[2 * c] + a0 * sn[2 * c]) * QSCALE, (b1 * cs[2 * c + 1] + a1 * sn[2 * c + 1]) * QSCALE);
            }
            qf[ks] = __builtin_bit_cast(bf16x8, oa); qf[ks + 2] = __builtin_bit_cast(bf16x8, ob);
        }
    }
    asm volatile("s_waitcnt vmcnt(0)" ::: "memory");
    f32x16 o0, o1;
#pragma unroll
    for (int i = 0; i < 16; ++i) { o0[i] = 0.f; o1[i] = 0.f; }
    m = NEGBIG; l = 0.f;
#pragma unroll 1
    for (int pos = 0; pos < ntiles; ++pos) {
        asm volatile("s_waitcnt vmcnt(2)" ::: "memory"); __builtin_amdgcn_s_barrier();
        NSA_ISSUE(pos + 2);
        const NLAS unsigned char* slot = lds + L_RING + (pos % 3) * SLOTB;
        f32x16 s0, s1;
        qk_tile(slot, qf, kofs, s0, s1);
        const bool win = pos >= nsel; const int j = win ? jw0 + pos - nsel : pos;
        int hi = (j == qb) ? qi : 63;
        if (!win && !((selmask >> j) & 1ull)) hi = -1;
        if (win && qb >= 8 && j == qb - 8) softmax_tile<true>(s0, s1, hi - 4 * h, qi + 1 - 4 * h, m, l, o0, o1);
        else softmax_tile<false>(s0, s1, hi - 4 * h, 0, m, l, o0, o1);
        pv_tile(slot + 8192, vofs, s0, s1, o0, o1);
        if (pos == nsel - 1) {
            const float L = l + xhalf(l); const float sc = (L > 0.f) ? gs / L : 0.f;
#pragma unroll
            for (int i = 0; i < 16; ++i) { of0[i] += sc * o0[i]; of1[i] += sc * o1[i]; o0[i] = 0.f; o1[i] = 0.f; }
            m = NEGBIG; l = 0.f;
        }
    }
    {
        float L = l + xhalf(l);
        const float npad = (t < 511) ? (float)(511 - t) : 0.f;
        const float m2 = (npad > 0.f) ? fmaxf(m, 0.f) : m;
        const float a = __builtin_amdgcn_exp2f(m - m2);
        L = L * a + npad * __builtin_amdgcn_exp2f(-m2);
        const float sc = (L > 0.f) ? gw * a / L : 0.f;
#pragma unroll
        for (int i = 0; i < 16; ++i) { of0[i] += sc * o0[i]; of1[i] += sc * o1[i]; }
    }
    float ss = 0.f;
#pragma unroll
    for (int i = 0; i < 16; ++i) ss += of0[i] * of0[i] + of1[i] * of1[i];
    ss += xhalf(ss);
    const float rn = rsqrtf(ss * (1.0f / 64.0f) + 1e-6f);
    unsigned short* yrow = P.ycat + (size_t)tok * 1024 + 512 + head * 64;
    const float* nw = P.normw + head * 64;
#pragma unroll
    for (int mb = 0; mb < 2; ++mb)
#pragma unroll
        for (int u = 0; u < 4; ++u) {
            const int d0 = 32 * mb + 8 * u + 4 * h;
            const float4 w4 = *(const float4*)(nw + d0);
            const float v0 = (mb ? of1[4 * u] : of0[4 * u]) * rn * w4.x, v1 = (mb ? of1[4 * u + 1] : of0[4 * u + 1]) * rn * w4.y;
            const float v2 = (mb ? of1[4 * u + 2] : of0[4 * u + 2]) * rn * w4.z, v3 = (mb ? of1[4 * u + 3] : of0[4 * u + 3]) * rn * w4.w;
            *(uint2*)(yrow + d0) = make_uint2(cvtpk(v0, v1), cvtpk(v2, v3));
        }
    asm volatile("s_waitcnt vmcnt(0)" ::: "memory"); __builtin_amdgcn_s_barrier();
#undef NSA_DMA
#undef NSA_ISSUE
}
__device__ __forceinline__ void phase(const Params& P, NLAS unsigned char* lds, const int tid, const int bid, const int G) {
#pragma unroll 1
    for (int vw = bid; vw < 256; vw += G) {
        const int xcd = vw & 7, slot = vw >> 3, bg = xcd * 2 + (slot >> 4), rr = slot & 15;
#pragma unroll 1
        for (int k = 0; k < 4; ++k) { const int qb = (k == 0) ? 63 - rr : (k == 1) ? 32 + rr : (k == 2) ? 31 - rr : rr; unit(P, lds, tid, bg >> 1, bg & 1, qb); }
    }
}
}


namespace wt {
typedef short bf16x8 __attribute__((ext_vector_type(8)));
typedef float f32x16 __attribute__((ext_vector_type(16)));
typedef unsigned u32x4 __attribute__((ext_vector_type(4)));
typedef unsigned u32x2 __attribute__((ext_vector_type(2)));
typedef float f32x2_t __attribute__((ext_vector_type(2)));
typedef __bf16 bf16x2_t __attribute__((ext_vector_type(2)));
#define WT_MFMA(a, b, c) __builtin_amdgcn_mfma_f32_32x32x16_bf16((a), (b), (c), 0, 0, 0)
__device__ __forceinline__ unsigned cvtpk(float lo, float hi) { f32x2_t v = {lo, hi}; bf16x2_t b = __builtin_convertvector(v, bf16x2_t); return __builtin_bit_cast(unsigned, b); }
__device__ __forceinline__ float bflo(unsigned u) { return __uint_as_float(u << 16); }
__device__ __forceinline__ float bfhi(unsigned u) { return __uint_as_float(u & 0xffff0000u); }
__device__ __forceinline__ float xhalf(float v) { return __shfl_xor(v, 32); }
__device__ __forceinline__ bf16x8 ld16(const unsigned short* p) { return __builtin_bit_cast(bf16x8, *(const u32x4*)p); }
__device__ __forceinline__ bf16x8 ld8x2(const unsigned short* p0, const unsigned short* p1) { const u32x2 a = *(const u32x2*)p0, b = *(const u32x2*)p1; u32x4 u = {a.x, a.y, b.x, b.y}; return __builtin_bit_cast(bf16x8, u); }
__device__ __forceinline__ bf16x8 pack8(const f32x16& x, int s) {
    u32x4 u = {cvtpk(x[8 * s], x[8 * s + 1]), cvtpk(x[8 * s + 2], x[8 * s + 3]), cvtpk(x[8 * s + 4], x[8 * s + 5]), cvtpk(x[8 * s + 6], x[8 * s + 7])};
    return __builtin_bit_cast(bf16x8, u);
}
__device__ __forceinline__ float gelu_t(float x) { const float u = 0.7978845608028654f * (x + 0.044715f * x * x * x); const float e = __expf(2.0f * u); return 0.5f * x * (1.0f + (1.0f - 2.0f / (e + 1.0f))); }
__device__ __forceinline__ float sigm(float x) { return 1.0f / (1.0f + __expf(-x)); }
__device__ __forceinline__ void zero(f32x16& a) {
#pragma unroll
    for (int i = 0; i < 16; ++i) a[i] = 0.f;
}

__device__ __forceinline__ void gm_ln8(const unsigned short* __restrict__ hb, const float* __restrict__ lw, const float* __restrict__ lbias, unsigned short* __restrict__ vlnT, int t8, int lane) {
    const int tok0 = t8 * 8;
    const float4 w4 = *(const float4*)(lw + lane * 4), b4 = *(const float4*)(lbias + lane * 4);
    float o[4][8];
#pragma unroll
    for (int i = 0; i < 8; ++i) {
        const u32x2 v4 = *(const u32x2*)(hb + (size_t)(tok0 + i) * 3072 + 1280 + lane * 4);
        float v[4] = {gelu_t(bflo(v4.x)), gelu_t(bfhi(v4.x)), gelu_t(bflo(v4.y)), gelu_t(bfhi(v4.y))};
        float s = (v[0] + v[1]) + (v[2] + v[3]);
#pragma unroll
        for (int o2 = 1; o2 < 64; o2 <<= 1) s += __shfl_xor(s, o2);
        const float mean = s * (1.0f / 256.0f); float q = 0.f;
#pragma unroll
        for (int c = 0; c < 4; ++c) { v[c] -= mean; q += v[c] * v[c]; }
#pragma unroll
        for (int o2 = 1; o2 < 64; o2 <<= 1) q += __shfl_xor(q, o2);
        const float rstd = rsqrtf(q * (1.0f / 256.0f) + 1e-5f);
        o[0][i] = v[0] * rstd * w4.x + b4.x; o[1][i] = v[1] * rstd * w4.y + b4.y; o[2][i] = v[2] * rstd * w4.z + b4.z; o[3][i] = v[3] * rstd * w4.w + b4.w;
    }
    const int bc = tok0 >> 7, s0 = tok0 & 127;
#pragma unroll
    for (int c = 0; c < 4; ++c) {
        const int ch = lane * 4 + c, g = ch >> 6, cc = ch & 63;
        u32x4 u = {cvtpk(o[c][0], o[c][1]), cvtpk(o[c][2], o[c][3]), cvtpk(o[c][4], o[c][5]), cvtpk(o[c][6], o[c][7])};
        *(u32x4*)(vlnT + ((size_t)(bc * 4 + g) * 64 + cc) * 128 + s0) = u;
    }
}
__device__ __forceinline__ void gm_sp_task(const unsigned short* __restrict__ hb, const unsigned short* __restrict__ vlnT, const unsigned short* __restrict__ Wb, const float* __restrict__ bs,
                                           const float* __restrict__ normw, unsigned short* __restrict__ ycat, int task, int lane) {
    const int tb = task & 3, g = (task >> 2) & 3, bc = task >> 4, r = lane & 31, h = lane >> 5;
    const unsigned short* ap = vlnT + ((size_t)(bc * 4 + g) * 64 + r) * 128 + 8 * h;
    const unsigned short* bp = Wb + ((size_t)g * 128 + 32 * tb + r) * 128 + 8 * h;
    f32x16 a0, a1; zero(a0); zero(a1);
    const int nks = 2 * (tb + 1);
#pragma unroll 2
    for (int ks = 0; ks < nks; ++ks) {
        const bf16x8 bw = ld16(bp + 16 * ks);
        const bf16x8 v0 = ld16(ap + 16 * ks), v1 = ld16(ap + 32 * 128 + 16 * ks);
        a0 = WT_MFMA(v0, bw, a0); a1 = WT_MFMA(v1, bw, a1);
    }
    const int tl = 32 * tb + r, tok = bc * 128 + tl;
    const float bias = bs[g * 128 + tl];
    const unsigned short* up = hb + (size_t)tok * 3072 + 1024 + g * 64;
    float z[32]; float ss = 0.f;
#pragma unroll
    for (int cb = 0; cb < 2; ++cb)
#pragma unroll
        for (int u = 0; u < 4; ++u) {
            const int c0 = 32 * cb + 8 * u + 4 * h;
            const u32x2 uu = *(const u32x2*)(up + c0);
            const float uv[4] = {gelu_t(bflo(uu.x)), gelu_t(bfhi(uu.x)), gelu_t(bflo(uu.y)), gelu_t(bfhi(uu.y))};
#pragma unroll
            for (int k = 0; k < 4; ++k) { const float a = (cb ? a1[4 * u + k] : a0[4 * u + k]) + bias; const float zz = uv[k] * a; z[16 * cb + 4 * u + k] = zz; ss += zz * zz; }
        }
    ss += xhalf(ss);
    const float rn = rsqrtf(ss * (1.0f / 64.0f) + 1e-6f);
    unsigned short* yp = ycat + (size_t)tok * 1024 + 256 + g * 64;
    const float* nw = normw + g * 64;
#pragma unroll
    for (int cb = 0; cb < 2; ++cb)
#pragma unroll
        for (int u = 0; u < 4; ++u) {
            const int c0 = 32 * cb + 8 * u + 4 * h;
            const float4 w4 = *(const float4*)(nw + c0);
            u32x2 o = {cvtpk(z[16 * cb + 4 * u] * rn * w4.x, z[16 * cb + 4 * u + 1] * rn * w4.y), cvtpk(z[16 * cb + 4 * u + 2] * rn * w4.z, z[16 * cb + 4 * u + 3] * rn * w4.w)};
            *(u32x2*)(yp + c0) = o;
        }
}

__device__ __forceinline__ void cmp_task(const unsigned short* __restrict__ hb, const unsigned short* __restrict__ w1t, const float* __restrict__ cbias, const unsigned short* __restrict__ w2t,
                                         unsigned short* __restrict__ kcb, unsigned short* __restrict__ vcb, int task, int lane) {
    const int cblk = task & 7, kv = (task >> 3) & 1, g = (task >> 4) & 1, b = task >> 5, r = lane & 31, h = lane >> 5;
    int c = 32 * cblk + r; const int cl = c < 254 ? c : 254;
    const unsigned short* bp = hb + (size_t)(b * 4096 + 16 * cl) * 3072 + (kv ? 2176 : 2048) + g * 64 + 8 * h;
    const unsigned short* ap = w1t + ((size_t)kv * 128 + r) * 2048 + 8 * h;
    f32x16 acc[4];
#pragma unroll
    for (int nt = 0; nt < 4; ++nt) zero(acc[nt]);
#pragma unroll 2
    for (int ks = 0; ks < 128; ++ks) {
        const bf16x8 bk = ld16(bp + (size_t)(ks >> 2) * 3072 + 16 * (ks & 3));
#pragma unroll
        for (int nt = 0; nt < 4; ++nt) acc[nt] = WT_MFMA(ld16(ap + (size_t)nt * 32 * 2048 + 16 * ks), bk, acc[nt]);
    }
#pragma unroll
    for (int nt = 0; nt < 4; ++nt)
#pragma unroll
        for (int i = 0; i < 16; ++i) { const int n = 32 * nt + (i & 3) + 8 * (i >> 2) + 4 * h; acc[nt][i] = gelu_t(acc[nt][i] + cbias[kv * 128 + n]); }
    f32x16 o0, o1; zero(o0); zero(o1);
    const unsigned short* w2p = w2t + ((size_t)kv * 64 + r) * 128 + 4 * h;
#pragma unroll
    for (int nt = 0; nt < 4; ++nt)
#pragma unroll
        for (int s = 0; s < 2; ++s) {
            const bf16x8 pb = pack8(acc[nt], s);
            const unsigned short* wp = w2p + 32 * nt + 16 * s;
            o0 = WT_MFMA(ld8x2(wp, wp + 8), pb, o0);
            o1 = WT_MFMA(ld8x2(wp + 32 * 128, wp + 32 * 128 + 8), pb, o1);
        }
    if (c < 255) {
        unsigned short* op = (kv ? vcb : kcb) + ((size_t)(b * 2 + g) * 256 + c) * 64;
#pragma unroll
        for (int db = 0; db < 2; ++db)
#pragma unroll
            for (int u = 0; u < 4; ++u) {
                const int d0 = 32 * db + 8 * u + 4 * h;
                u32x2 o = {cvtpk(db ? o1[4 * u] : o0[4 * u], db ? o1[4 * u + 1] : o0[4 * u + 1]), cvtpk(db ? o1[4 * u + 2] : o0[4 * u + 2], db ? o1[4 * u + 3] : o0[4 * u + 3])};
                *(u32x2*)(op + d0) = o;
            }
    }
}

__device__ __forceinline__ void hg_pass1(const unsigned short* __restrict__ hb, const float* __restrict__ lbl, unsigned short* __restrict__ Qt, unsigned short* __restrict__ Kt,
                                         unsigned short* __restrict__ Qp, unsigned short* __restrict__ VT, float* __restrict__ Ut, float* __restrict__ Dk, int ci, int lane) {
    const int chunk = ci & 63, hd = (ci >> 6) & 3, b = ci >> 8;
    const unsigned short* hp = hb + (size_t)(b * 4096 + chunk * 64) * 3072 + hd * 64 + lane;
    const float lb = lbl[hd * 64 + lane];
    float run = 0.f, cmid = 0.f;
#pragma unroll 8
    for (int t = 0; t < 64; ++t) {
        const float fr = __uint_as_float((unsigned)hp[(size_t)t * 3072 + 256] << 16);
        run += __logf(lb + (1.0f - lb) * sigm(fr));
        cmid = (t == 31) ? run : cmid;
    }
    const float blast = run;
    Dk[(size_t)ci * 64 + lane] = __expf(blast);
    unsigned short* qt = Qt + (size_t)ci * 4096 + lane; unsigned short* kt = Kt + (size_t)ci * 4096 + lane; unsigned short* qp = Qp + (size_t)ci * 4096 + lane;
    unsigned short* vt = VT + (size_t)ci * 4096 + lane * 64;
    const int h = lane >> 5, r = lane & 31;
    f32x16 acc[2][2];
#pragma unroll
    for (int a = 0; a < 2; ++a)
#pragma unroll
        for (int c = 0; c < 2; ++c) zero(acc[a][c]);
    float bt = 0.f;
#pragma unroll 1
    for (int ks = 0; ks < 4; ++ks) {
        unsigned kp[8], vp[8];
#pragma unroll
        for (int tp = 0; tp < 8; ++tp) {
            float k2v[2], ivv[2];
#pragma unroll
            for (int e = 0; e < 2; ++e) {
                const int t = ks * 16 + tp * 2 + e;
                const float qr = __uint_as_float((unsigned)hp[(size_t)t * 3072] << 16), fr = __uint_as_float((unsigned)hp[(size_t)t * 3072 + 256] << 16);
                ivv[e] = __uint_as_float((unsigned)hp[(size_t)t * 3072 + 512] << 16);
                const float sf = sigm(fr);
                const float q = qr * sigm(qr), kk = (1.0f - lb) * (1.0f - sf);
                bt += __logf(lb + (1.0f - lb) * sf);
                qt[t * 64] = (unsigned short)(cvtpk(q * __expf(bt - cmid), 0.f) & 0xffffu);
                kt[t * 64] = (unsigned short)(cvtpk(kk * __expf(cmid - bt), 0.f) & 0xffffu);
                qp[t * 64] = (unsigned short)(cvtpk(q * __expf(bt), 0.f) & 0xffffu);
                k2v[e] = kk * __expf(blast - bt);
            }
            kp[tp] = cvtpk(k2v[0], k2v[1]); vp[tp] = cvtpk(ivv[0], ivv[1]);
        }
        { u32x4 u0 = {vp[0], vp[1], vp[2], vp[3]}, u1 = {vp[4], vp[5], vp[6], vp[7]};
          *(u32x4*)(vt + ks * 16) = u0; *(u32x4*)(vt + ks * 16 + 8) = u1; }
        u32x4 kown, vown, ksnd, vsnd;
#pragma unroll
        for (int j = 0; j < 4; ++j) { kown[j] = h ? kp[4 + j] : kp[j]; ksnd[j] = h ? kp[j] : kp[4 + j]; vown[j] = h ? vp[4 + j] : vp[j]; vsnd[j] = h ? vp[j] : vp[4 + j]; }
        u32x4 krcv, vrcv;
#pragma unroll
        for (int j = 0; j < 4; ++j) { krcv[j] = (unsigned)__shfl_xor((int)ksnd[j], 32); vrcv[j] = (unsigned)__shfl_xor((int)vsnd[j], 32); }
        const bf16x8 kb0 = __builtin_bit_cast(bf16x8, h ? krcv : kown), kb1 = __builtin_bit_cast(bf16x8, h ? kown : krcv);
        const bf16x8 va0 = __builtin_bit_cast(bf16x8, h ? vrcv : vown), va1 = __builtin_bit_cast(bf16x8, h ? vown : vrcv);
        acc[0][0] = WT_MFMA(va0, kb0, acc[0][0]); acc[0][1] = WT_MFMA(va0, kb1, acc[0][1]);
        acc[1][0] = WT_MFMA(va1, kb0, acc[1][0]); acc[1][1] = WT_MFMA(va1, kb1, acc[1][1]);
    }
    float* up = Ut + (size_t)ci * 4096;
#pragma unroll
    for (int vb = 0; vb < 2; ++vb)
#pragma unroll
        for (int kb = 0; kb < 2; ++kb)
#pragma unroll
            for (int i = 0; i < 16; ++i) { const int v = 32 * vb + (i & 3) + 8 * (i >> 2) + 4 * h; up[v * 64 + 32 * kb + r] = acc[vb][kb][i]; }
}
__device__ __forceinline__ void hg_scan(const float* __restrict__ Ut, const float* __restrict__ Dk, unsigned short* __restrict__ ST, int e) {
    const int k = e & 63, seq = e >> 12, vk = e & 4095;
    float S = 0.f;
    const float* up = Ut + (size_t)seq * 64 * 4096 + vk; const float* dp = Dk + (size_t)seq * 64 * 64 + k; unsigned short* sp = ST + (size_t)seq * 64 * 4096 + vk;
#pragma unroll 8
    for (int c = 0; c < 64; ++c) {
        sp[(size_t)c * 4096] = (unsigned short)(cvtpk(S, 0.f) & 0xffffu);
        S = fmaf(dp[c * 64], S, up[(size_t)c * 4096]);
    }
}
__device__ __forceinline__ void hg_pass3(const unsigned short* __restrict__ hb, const unsigned short* __restrict__ Qt, const unsigned short* __restrict__ Kt, const unsigned short* __restrict__ Qp,
                                         const unsigned short* __restrict__ VT, const unsigned short* __restrict__ ST, const float* __restrict__ normw, unsigned short* __restrict__ ycat, int task, int lane) {
    const int tblk = task & 1, ci = task >> 1, chunk = ci & 63, hd = (ci >> 6) & 3, b = ci >> 8, r = lane & 31, h = lane >> 5;
    const size_t cb = (size_t)ci * 4096;
    f32x16 o0, o1; zero(o0); zero(o1);
    {
        const unsigned short* sp = ST + cb + (size_t)r * 64 + 8 * h; const unsigned short* qp = Qp + cb + (size_t)(32 * tblk + r) * 64 + 8 * h;
#pragma unroll
        for (int ks = 0; ks < 4; ++ks) { const bf16x8 q = ld16(qp + 16 * ks); o0 = WT_MFMA(ld16(sp + 16 * ks), q, o0); o1 = WT_MFMA(ld16(sp + 32 * 64 + 16 * ks), q, o1); }
    }
    const unsigned short* qtp = Qt + cb + (size_t)(32 * tblk + r) * 64 + 8 * h;
    bf16x8 qf[4];
#pragma unroll
    for (int ks = 0; ks < 4; ++ks) qf[ks] = ld16(qtp + 16 * ks);
#pragma unroll 1
    for (int sblk = 0; sblk <= tblk; ++sblk) {
        f32x16 at; zero(at);
        const unsigned short* ktp = Kt + cb + (size_t)(32 * sblk + r) * 64 + 8 * h;
#pragma unroll
        for (int ks = 0; ks < 4; ++ks) at = WT_MFMA(ld16(ktp + 16 * ks), qf[ks], at);
        if (sblk == tblk) {
#pragma unroll
            for (int i = 0; i < 16; ++i) { const int sl = (i & 3) + 8 * (i >> 2) + 4 * h; at[i] = (sl <= r) ? at[i] : 0.f; }
        }
#pragma unroll
        for (int s2 = 0; s2 < 2; ++s2) {
            const bf16x8 pb = pack8(at, s2);
            const unsigned short* vp = VT + cb + (size_t)r * 64 + 32 * sblk + 16 * s2 + 4 * h;
            o0 = WT_MFMA(ld8x2(vp, vp + 8), pb, o0);
            o1 = WT_MFMA(ld8x2(vp + 32 * 64, vp + 32 * 64 + 8), pb, o1);
        }
    }
    const int tok = b * 4096 + chunk * 64 + 32 * tblk + r;
    float ss = 0.f;
#pragma unroll
    for (int i = 0; i < 16; ++i) ss += o0[i] * o0[i] + o1[i] * o1[i];
    ss += xhalf(ss);
    const float rn = rsqrtf(ss * (1.0f / 64.0f) + 1e-6f);
    const unsigned short* gp = hb + (size_t)tok * 3072 + 768 + hd * 64;
    unsigned short* yp = ycat + (size_t)tok * 1024 + hd * 64;
    const float* nw = normw + hd * 64;
#pragma unroll
    for (int vb = 0; vb < 2; ++vb)
#pragma unroll
        for (int u = 0; u < 4; ++u) {
            const int v0 = 32 * vb + 8 * u + 4 * h;
            const u32x2 gg = *(const u32x2*)(gp + v0); const float4 w4 = *(const float4*)(nw + v0);
            const float x0 = (vb ? o1[4 * u] : o0[4 * u]) * rn * w4.x * sigm(bflo(gg.x)), x1 = (vb ? o1[4 * u + 1] : o0[4 * u + 1]) * rn * w4.y * sigm(bfhi(gg.x));
            const float x2 = (vb ? o1[4 * u + 2] : o0[4 * u + 2]) * rn * w4.z * sigm(bflo(gg.y)), x3 = (vb ? o1[4 * u + 3] : o0[4 * u + 3]) * rn * w4.w * sigm(bfhi(gg.y));
            u32x2 o = {cvtpk(x0, x1), cvtpk(x2, x3)};
            *(u32x2*)(yp + v0) = o;
        }
}
}


__device__ __forceinline__ void kvprep_item(const bf16* __restrict__ h, const float* __restrict__ cosT, const float* __restrict__ sinT,
                                            bf16* __restrict__ ksb, bf16* __restrict__ vsb, bf16* __restrict__ kwb, bf16* __restrict__ vwb, int idx) {
    const int j = idx & 31, g = (idx >> 5) & 1, tok = idx >> 6, b = tok >> 12, t = tok & 4095;
    const bf16* hr = h + (size_t)tok * HS + g * 64 + j;
    const float cs = cosT[tok * 32 + j], sn = sinT[tok * 32 + j];
    const size_t o = ((size_t)(b * 2 + g) * S_ + t) * 64 + j;
    { const float x1 = bf2f(hr[C_KS]), x2 = bf2f(hr[C_KS + 32]); ksb[o] = (bf16)f2bf(x1 * cs - x2 * sn); ksb[o + 32] = (bf16)f2bf(x2 * cs + x1 * sn); }
    { const float x1 = bf2f(hr[C_KW]), x2 = bf2f(hr[C_KW + 32]); kwb[o] = (bf16)f2bf(x1 * cs - x2 * sn); kwb[o + 32] = (bf16)f2bf(x2 * cs + x1 * sn); }
    vsb[o] = hr[C_VS]; vsb[o + 32] = hr[C_VS + 32]; vwb[o] = hr[C_VW]; vwb[o + 32] = hr[C_VW + 32];
}

__device__ __forceinline__ void ln1_route_tok(const float* __restrict__ xin, const bf16* __restrict__ mix, const float* __restrict__ lw, const float* __restrict__ lbias,
                                              const float* __restrict__ rw, const float* __restrict__ rb, float* __restrict__ x1, bf16* __restrict__ x1b,
                                              int* __restrict__ cnt, int* __restrict__ list, int* __restrict__ tok_e, int* __restrict__ tok_slot, float* __restrict__ tok_w,
                                              float* xs, int tok, int lane) {
    float v[16]; float s = 0.f;
#pragma unroll
    for (int j = 0; j < 4; ++j) {
        float4 a = *(const float4*)(xin + (size_t)tok * D_ + j * 256 + lane * 4);
        uint2 mb = *(const uint2*)(mix + (size_t)tok * D_ + j * 256 + lane * 4);
        float4 m = make_float4(__uint_as_float(mb.x << 16), __uint_as_float(mb.x & 0xffff0000u), __uint_as_float(mb.y << 16), __uint_as_float(mb.y & 0xffff0000u));
        v[4 * j] = ALPHA * a.x + m.x; v[4 * j + 1] = ALPHA * a.y + m.y; v[4 * j + 2] = ALPHA * a.z + m.z; v[4 * j + 3] = ALPHA * a.w + m.w;
        s += v[4 * j] + v[4 * j + 1] + v[4 * j + 2] + v[4 * j + 3];
    }
    float mean = wsum(s) * (1.0f / D_); float q = 0.f;
#pragma unroll
    for (int i = 0; i < 16; ++i) { v[i] -= mean; q += v[i] * v[i]; }
    float rstd = rsqrtf(wsum(q) * (1.0f / D_) + 1e-5f);
#pragma unroll
    for (int j = 0; j < 4; ++j) {
        float4 w4 = *(const float4*)(lw + j * 256 + lane * 4), b4 = *(const float4*)(lbias + j * 256 + lane * 4);
        float4 o = make_float4(v[4 * j] * rstd * w4.x + b4.x, v[4 * j + 1] * rstd * w4.y + b4.y, v[4 * j + 2] * rstd * w4.z + b4.z, v[4 * j + 3] * rstd * w4.w + b4.w);
        *(float4*)(x1 + (size_t)tok * D_ + j * 256 + lane * 4) = o;
        *(uint2*)(x1b + (size_t)tok * D_ + j * 256 + lane * 4) = make_uint2(pk2(o.x, o.y), pk2(o.z, o.w));
        *(float4*)(xs + j * 256 + lane * 4) = o;
    }
    __builtin_amdgcn_wave_barrier();
    const int e = lane & 31, hf = lane >> 5;
    float lg = 0.f;
    const float* rwp = rw + (size_t)(hf * 512) * 32 + e;
    const float* xp = xs + hf * 512;
#pragma unroll 8
    for (int k = 0; k < 512; ++k) lg = fmaf(xp[k], rwp[(size_t)k * 32], lg);
    lg += __shfl_xor(lg, 32);
    lg += rb[e];
    float val = (lane < 32) ? lg : -3.0e38f;
    float tl[4]; int te[4];
#pragma unroll
    for (int k = 0; k < 4; ++k) {
        float m = wmax(val);
        unsigned long long bm = __ballot(val == m);
        int bi = __ffsll((long long)bm) - 1;
        tl[k] = m; te[k] = bi;
        if (lane == bi) val = -3.0e38f;
    }
    float e0 = 1.0f, e1 = expf(tl[1] - tl[0]), e2 = expf(tl[2] - tl[0]), e3 = expf(tl[3] - tl[0]);
    float inv = 1.0f / (e0 + e1 + e2 + e3);
    float tw[4] = {e0 * inv, e1 * inv, e2 * inv, e3 * inv};
    if (lane == 0) {
#pragma unroll
        for (int k = 0; k < 4; ++k) {
            int slot = atomicAdd(&cnt[te[k]], 1);
            list[te[k] * NT + slot] = tok;
            tok_e[tok * 4 + k] = te[k]; tok_slot[tok * 4 + k] = slot; tok_w[tok * 4 + k] = tw[k];
        }
    }
    __builtin_amdgcn_wave_barrier();
}
__device__ __forceinline__ void comb_ln2_tok(const float* __restrict__ x1, const bf16* __restrict__ y, const int* __restrict__ offs, const int* __restrict__ tok_e,
                                             const int* __restrict__ tok_slot, const float* __restrict__ tok_w, const float* __restrict__ lw, const float* __restrict__ lbias,
                                             float* __restrict__ xout, bf16* __restrict__ xbout, int tok, int lane) {
    float v[16];
#pragma unroll
    for (int j = 0; j < 4; ++j) { float4 a = *(const float4*)(x1 + (size_t)tok * D_ + j * 256 + lane * 4);
        v[4 * j] = ALPHA * a.x; v[4 * j + 1] = ALPHA * a.y; v[4 * j + 2] = ALPHA * a.z; v[4 * j + 3] = ALPHA * a.w; }
#pragma unroll
    for (int k = 0; k < 4; ++k) {
        int e = tok_e[tok * 4 + k]; int row = offs[e] + tok_slot[tok * 4 + k]; float wk = tok_w[tok * 4 + k];
#pragma unroll
        for (int j = 0; j < 4; ++j) { uint2 ab = *(const uint2*)(y + (size_t)row * D_ + j * 256 + lane * 4);
            float4 a = make_float4(__uint_as_float(ab.x << 16), __uint_as_float(ab.x & 0xffff0000u), __uint_as_float(ab.y << 16), __uint_as_float(ab.y & 0xffff0000u));
            v[4 * j] = fmaf(wk, a.x, v[4 * j]); v[4 * j + 1] = fmaf(wk, a.y, v[4 * j + 1]); v[4 * j + 2] = fmaf(wk, a.z, v[4 * j + 2]); v[4 * j + 3] = fmaf(wk, a.w, v[4 * j + 3]); }
    }
    float s = 0.f;
#pragma unroll
    for (int i = 0; i < 16; ++i) s += v[i];
    float mean = wsum(s) * (1.0f / D_); float q = 0.f;
#pragma unroll
    for (int i = 0; i < 16; ++i) { v[i] -= mean; q += v[i] * v[i]; }
    float rstd = rsqrtf(wsum(q) * (1.0f / D_) + 1e-5f);
#pragma unroll
    for (int j = 0; j < 4; ++j) {
        float4 w4 = *(const float4*)(lw + j * 256 + lane * 4), b4 = *(const float4*)(lbias + j * 256 + lane * 4);
        float4 o = make_float4(v[4 * j] * rstd * w4.x + b4.x, v[4 * j + 1] * rstd * w4.y + b4.y, v[4 * j + 2] * rstd * w4.z + b4.z, v[4 * j + 3] * rstd * w4.w + b4.w);
        *(float4*)(xout + (size_t)tok * D_ + j * 256 + lane * 4) = o;
        if (xbout) *(uint2*)(xbout + (size_t)tok * D_ + j * 256 + lane * 4) = make_uint2(pk2(o.x, o.y), pk2(o.z, o.w));
    }
}

struct Args { const float* in[25]; float* out; unsigned char* ws; int ph_lo, ph_hi; };
#define PH __device__ __forceinline__
constexpr int TAB_OFF = 131072;

__device__ __forceinline__ void transpose_item(const float* __restrict__ W, int K, int N, bf16* __restrict__ WT, int k0, int scol0, int drow0, float* scr, int lane) {
    const int cc = lane & 31; const bool cv = (scol0 + cc) < N;
#pragma unroll 8
    for (int i = 0; i < 32; ++i) { const int kk = 2 * i + (lane >> 5); scr[kk * 33 + cc] = cv ? W[(size_t)(k0 + kk) * N + scol0 + cc] : 0.f; }
    asm volatile("s_waitcnt lgkmcnt(0)" ::: "memory");
    const int c = lane & 7;
#pragma unroll
    for (int j = 0; j < 4; ++j) { const int n = (lane >> 3) + 8 * j; const float* s = scr + (8 * c) * 33 + n;
        uint4 o; o.x = pk2(s[0 * 33], s[1 * 33]); o.y = pk2(s[2 * 33], s[3 * 33]); o.z = pk2(s[4 * 33], s[5 * 33]); o.w = pk2(s[6 * 33], s[7 * 33]);
        *(uint4*)(WT + (size_t)(drow0 + n) * K + k0 + 8 * c) = o; }
    asm volatile("s_waitcnt lgkmcnt(0)" ::: "memory");
}
PH void ph_prologue(int wv, const int* pos, const float* hg_lb, float* cosT, float* sinT, float* lb,
                    const float* x, bf16* xb, const float* w_in, const float* w_out, const float* w_up, const float* w_dn, bf16* wt_in, bf16* wt_out, bf16* wt_up, bf16* wt_dn,
                    const float* gm_sw, bf16* wb, const float* cpe, const float* cw1, bf16* w1t, float* cbias, const float* cw2, bf16* w2t) {
    extern __shared__ __attribute__((aligned(16))) unsigned char lds[];
    int tid = mk_tid(wv), bid = blockIdx.x; asm volatile("" : "+v"(tid), "+s"(bid)); const int G = gridDim.x, lane = tid & 63, wave = wv;
#pragma unroll 1
    for (int i = bid * NTHR + tid; i < NT * 32; i += G * NTHR) {
        int t = i >> 5, j = i & 31;
        float inv = (float)pow(10000.0, -(double)(2 * j) / 64.0);
        float ang = (float)pos[t] * inv;
        double ad = (double)ang;
        cosT[i] = (float)cos(ad); sinT[i] = (float)sin(ad);
    }
    if (bid == 0 && tid < 256) {
        float p0 = hg_lb[tid], p1 = hg_lb[256 + tid];
        float m = fmaxf(p0, p1); float ea = expf(p0 - m), eb = expf(p1 - m);
        lb[tid] = 0.f; lb[256 + tid] = eb / (ea + eb);
    }
#pragma unroll 1
    for (size_t i = (size_t)bid * NTHR + tid; i < (size_t)NT * D_ / 4; i += (size_t)G * NTHR) {
        float4 v = ((const float4*)x)[i]; ((uint2*)xb)[i] = make_uint2(pk2(v.x, v.y), pk2(v.z, v.w));
    }
#pragma unroll 1
    for (int i = bid * NTHR + tid; i < DEPTH * 4 * 128 * 128; i += G * NTHR) { const int s = i & 127, t = (i >> 7) & 127; wb[i] = (bf16)f2bf(s <= t ? gm_sw[i] : 0.f); }
    if (bid == (G > 1 ? 1 : 0)) {
        const int lk = tid >> 7, n = tid & 127;
        float a = 0.f;
#pragma unroll 4
        for (int i = 0; i < 2048; ++i) a = fmaf(cpe[lk * 2048 + i], cw1[((size_t)lk * 2048 + i) * 128 + n], a);
        cbias[lk * 128 + n] = a;
    }
    float* scr = (float*)(lds + wave * 16384);
    const int gw = bid * 8 + wave, NGW = G * 8;
    constexpr int I_IN = 16 * 89, I_OUT = 16 * 32, I_UP = 16 * 64, I_DN = 16 * 32;
    constexpr int I_C1 = 32 * 4;
    constexpr int I_C2 = 2 * 2;
    constexpr int PER_L = I_IN + I_OUT + NE * I_UP + NE * I_DN + 2 * I_C1 + 2 * I_C2;
#pragma unroll 1
    for (int it = gw; it < DEPTH * PER_L; it += NGW) {
        const int l = it / PER_L; int r = it % PER_L;
        if (r < I_IN) { const int kb = r / 89, nb = r % 89; transpose_item(w_in + (size_t)l * D_ * INW, D_, INW, wt_in + (size_t)l * HS * D_, kb * 64, nb * 32, nb * 32, scr, lane); continue; }
        r -= I_IN;
        if (r < I_OUT) { const int kb = r / 32, nb = r % 32; transpose_item(w_out + (size_t)l * D_ * D_, D_, D_, wt_out + (size_t)l * D_ * D_, kb * 64, nb * 32, nb * 32, scr, lane); continue; }
        r -= I_OUT;
        if (r < NE * I_UP) { const int e = r / I_UP, q = r % I_UP, kb = q / 64, nb = q % 64;
            const int n0 = nb * 32, pn = n0 >> 8, bj = (n0 >> 7) & 1, jj = n0 & 127;
            transpose_item(w_up + ((size_t)l * NE + e) * D_ * 2048, D_, 2048, wt_up + ((size_t)l * NE + e) * 2048 * D_, kb * 64, bj * 1024 + 128 * pn + jj, n0, scr, lane); continue; }
        r -= NE * I_UP;
        if (r < NE * I_DN) { const int e = r / I_DN, q = r % I_DN, kb = q / 32, nb = q % 32;
            transpose_item(w_dn + ((size_t)l * NE + e) * D_ * D_, D_, D_, wt_dn + ((size_t)l * NE + e) * D_ * D_, kb * 64, nb * 32, nb * 32, scr, lane); continue; }
        r -= NE * I_DN;
        if (r < 2 * I_C1) { const int kv = r / I_C1, q = r % I_C1, kb = q / 4, nb = q % 4;
            transpose_item(cw1 + ((size_t)l * 2 + kv) * 2048 * 128, 2048, 128, w1t + ((size_t)l * 2 + kv) * 128 * 2048, kb * 64, nb * 32, nb * 32, scr, lane); continue; }
        r -= 2 * I_C1;
        { const int kv = r / I_C2, q = r % I_C2, kb = q / 2, nb = q % 2;
            transpose_item(cw2 + ((size_t)l * 2 + kv) * 128 * 64, 128, 64, w2t + ((size_t)l * 2 + kv) * 64 * 128, kb * 64, nb * 32, nb * 32, scr, lane); }
    }
}
#ifndef M1
#define M1EN(x) 1
#else
#define M1EN(x) ((M1) & (x))
#endif
PH void ph_mix1(int wv, const bf16* hb, const float* lb, bf16* hqt, bf16* hkt, bf16* hqp, bf16* hvt, float* hut, float* hdk,
                const float* glw, const float* glb, bf16* vlnT, const bf16* w1t, const float* cbias, const bf16* w2, bf16* kcb, bf16* vcb,
                const float* cosT, const float* sinT, bf16* ksb, bf16* vsb, bf16* kwb, bf16* vwb) {
    int tid = mk_tid(wv), bid = blockIdx.x; asm volatile("" : "+v"(tid), "+s"(bid)); const int lane = tid & 63, wave = wv, G = gridDim.x;
    const int gw = bid * 8 + wave, NGW = G * 8;
    { int ln = lane; asm volatile("" : "+v"(ln));
#pragma unroll 1
    for (int u = gw; u < 256 && M1EN(1); u += NGW) wt::cmp_task(hb, w1t, cbias, w2, kcb, vcb, u, ln); }
    { int ln = lane; asm volatile("" : "+v"(ln));
#pragma unroll 1
    for (int u = gw; u < 2048 && M1EN(2); u += NGW) wt::hg_pass1(hb, lb, hqt, hkt, hqp, hvt, hut, hdk, u, ln); }
    { int ln = lane; asm volatile("" : "+v"(ln));
#pragma unroll 1
    for (int u = gw; u < NT / 8 && M1EN(4); u += NGW) wt::gm_ln8(hb, glw, glb, vlnT, u, ln); }
#pragma unroll 1
    for (int idx = bid * NTHR + tid; idx < NT * 64; idx += G * NTHR) kvprep_item(hb, cosT, sinT, ksb, vsb, kwb, vwb, idx);
}
PH void ph_mix2(int wv, const float* hut, const float* hdk, bf16* hst, const bf16* hb, const bf16* vlnT, const bf16* wb, const float* sb, const float* nw, bf16* ycat) {
    int tid = mk_tid(wv), bid = blockIdx.x; asm volatile("" : "+v"(tid), "+s"(bid)); const int lane = tid & 63, wave = wv, G = gridDim.x;
#pragma unroll 1
    for (int e = bid * NTHR + tid; e < 32 * 4096; e += G * NTHR) wt::hg_scan(hut, hdk, hst, e);
    const int gw = bid * 8 + wave, NGW = G * 8;
#pragma unroll 1
    for (int u = gw; u < 4096; u += NGW) wt::gm_sp_task(hb, vlnT, wb, sb, nw, ycat, u, lane);
}
PH void ph_hg3(int wv, const bf16* hb, const bf16* hqt, const bf16* hkt, const bf16* hqp, const bf16* hvt, const bf16* hst, const float* nw, bf16* ycat) {
    int tid = mk_tid(wv), bid = blockIdx.x; asm volatile("" : "+v"(tid), "+s"(bid)); const int lane = tid & 63, wave = wv, G = gridDim.x;
    const int gw = bid * 8 + wave, NGW = G * 8;
#pragma unroll 1
    for (int u = gw; u < 4096; u += NGW) wt::hg_pass3(hb, hqt, hkt, hqp, hvt, hst, nw, ycat, u, lane);
}
PH void ph_ln1(int wv, const float* xin, const bf16* mix, const float* lw, const float* lb, const float* rw, const float* rb, float* x1, bf16* x1b, int* cnt, int* list, int* tok_e, int* tok_slot, float* tok_w) {
    extern __shared__ __attribute__((aligned(16))) unsigned char lds[];
    int tid = mk_tid(wv), bid = blockIdx.x; asm volatile("" : "+v"(tid), "+s"(bid)); const int lane = tid & 63, wave = wv, G = gridDim.x;
#pragma unroll 1
    for (int t = bid * 8 + wave; t < NT; t += G * 8) ln1_route_tok(xin, mix, lw, lb, rw, rb, x1, x1b, cnt, list, tok_e, tok_slot, tok_w, (float*)(lds + wave * 4096), t, lane);
}
PH void ph_comb(int wv, const float* x1, const bf16* ybuf, const int* tok_e, const int* tok_slot, const float* tok_w, const float* lw, const float* lb, float* xo, bf16* xbo) {
    extern __shared__ __attribute__((aligned(16))) unsigned char lds[];
    const int* offs_s = (const int*)(lds + TAB_OFF + 512);
    int tid = mk_tid(wv), bid = blockIdx.x; asm volatile("" : "+v"(tid), "+s"(bid)); const int lane = tid & 63, wave = wv, G = gridDim.x;
#pragma unroll 1
    for (int t = bid * 8 + wave; t < NT; t += G * 8) comb_ln2_tok(x1, ybuf, offs_s, tok_e, tok_slot, tok_w, lw, lb, xo, xbo, t, lane);
}

typedef const Args __attribute__((address_space(4))) CArgs;
#define PHASE_BEGIN CArgs* ap = (CArgs*)__builtin_amdgcn_kernarg_segment_ptr(); int l_ = l; asm volatile("" : "+s"(ap), "+s"(l_)); unsigned char* const ws_ = ap->ws; \
    const int G = gridDim.x; int bid = blockIdx.x; asm volatile("" : "+s"(bid));
#define WP(T, off) ((T*)(ws_ + (off)))
#define INP(k) (ap->in[k])
__global__ void __launch_bounds__(NTHR, 2) mega(Args a) {
    extern __shared__ __attribute__((aligned(16))) unsigned char lds[];
    volatile LAS unsigned* MISC = (volatile LAS unsigned*)((LAS unsigned char*)lds + MISC_OFF);
    int wv = __builtin_amdgcn_readfirstlane((int)threadIdx.x >> 6); asm volatile("" : "+s"(wv));
    { const int t0 = mk_tid(wv); if (t0 < 64) MISC[t0] = 0u; }
    __syncthreads();
    XcdBarrier bar = xcd_barrier_post((unsigned*)a.ws, MISC + 8, wv);
    int* tstart = (int*)(lds + TAB_OFF); int* cnts = (int*)(lds + TAB_OFF + 256); int* offs_s = (int*)(lds + TAB_OFF + 512);
    PG8_LAS unsigned char* ldsl = (PG8_LAS unsigned char*)lds;

#ifndef PH_MASK
#define EN(n) 1
#else
#define EN(n) ((PH_MASK >> ((n) % 20)) & 1)
#endif
#define IN(k) 1
#define SEAM(k) xcd_barrier(bar)

    if (EN(19) && IN(0)) { const int l = 0; PHASE_BEGIN; (void)l_; (void)G; (void)bid;
        ph_prologue(wv, (const int*)INP(1), INP(3), WP(float, O_COS), WP(float, O_SIN), WP(float, O_LB), INP(0), WP(bf16, O_XB), INP(2), INP(14), INP(19), INP(21),
                    WP(bf16, O_WIN), WP(bf16, O_WOUT), WP(bf16, O_WUP), WP(bf16, O_WDN), INP(7), WP(bf16, O_WB), INP(10), INP(11), WP(bf16, O_W1T), WP(float, O_CBIAS), INP(12), WP(bf16, O_W2T)); }
    xcd_barrier_first(bar);

#pragma unroll 1
    for (int l = 0; l < DEPTH; ++l) {
        if (EN(0) && IN(pb + 0)) {
            PHASE_BEGIN;
            pg8::PlainOrder S{WP(bf16, O_WIN) + (size_t)l_ * HS * D_, D_, NT / 256, HS / 256, G, bid};
            pg8::EpiBf16 E{WP(bf16, O_HB), HS, nullptr, 0};
            pg8::gemm_phase<pg8::EpiBf16, pg8::PlainOrder, true>(wv, ldsl, WP(bf16, O_XB), D_, S, E);
        }
        SEAM(pb + 0);
        if (EN(1)) {
            PHASE_BEGIN; (void)G; (void)bid;
            ph_mix1(wv, WP(bf16, O_HB), WP(float, O_LB) + l_ * 256, WP(bf16, O_HQT), WP(bf16, O_HKT), WP(bf16, O_HQP), WP(bf16, O_HVT), WP(float, O_HUT), WP(float, O_HDK),
                    INP(5) + l_ * 256, INP(6) + l_ * 256, WP(bf16, O_VLNT), WP(bf16, O_W1T) + (size_t)l_ * 2 * 128 * 2048, WP(float, O_CBIAS) + l_ * 256, WP(bf16, O_W2T) + (size_t)l_ * 2 * 64 * 128,
                    WP(bf16, O_KCB), WP(bf16, O_VCB), WP(float, O_COS), WP(float, O_SIN), WP(bf16, O_KSB), WP(bf16, O_VSB), WP(bf16, O_KWB), WP(bf16, O_VWB));
        }
        SEAM(pb + 1);
        if (EN(11)) {
            PHASE_BEGIN; (void)G; (void)bid;
            ph_mix2(wv, WP(float, O_HUT), WP(float, O_HDK), WP(bf16, O_HST), WP(bf16, O_HB), WP(bf16, O_VLNT), WP(bf16, O_WB) + (size_t)l_ * 4 * 128 * 128, INP(8) + l_ * 512, INP(9) + l_ * 256, WP(bf16, O_YCAT));
        }
        SEAM(pb + 1);
        {
            PHASE_BEGIN;
            if (EN(2)) ph_hg3(wv, WP(bf16, O_HB), WP(bf16, O_HQT), WP(bf16, O_HKT), WP(bf16, O_HQP), WP(bf16, O_HVT), WP(bf16, O_HST), INP(4) + l_ * 256, WP(bf16, O_YCAT));
            if (EN(12)) {
                nsa::Params NP{WP(bf16, O_HB), WP(bf16, O_KCB), WP(bf16, O_VCB), WP(bf16, O_KSB), WP(bf16, O_VSB), WP(bf16, O_KWB), WP(bf16, O_VWB), WP(float, O_COS), WP(float, O_SIN), INP(13) + l_ * 512, WP(bf16, O_YCAT)};
                int tid = mk_tid(wv); asm volatile("" : "+v"(tid));
                __syncthreads();
                nsa::phase(NP, ldsl, tid, bid, G);
            }
        }
        SEAM(pb + 2);
        if (EN(3) && IN(pb + 3)) {
            PHASE_BEGIN;
            pg8::PlainOrder S{WP(bf16, O_WOUT) + (size_t)l_ * D_ * D_, D_, NT / 256, D_ / 256, G, bid};
            pg8::EpiBf16 E{WP(bf16, O_MIXB), D_, nullptr, 0};
            pg8::gemm_phase<pg8::EpiBf16, pg8::PlainOrder, true>(wv, ldsl, WP(bf16, O_YCAT), D_, S, E);
        }
        SEAM(pb + 3);
        if (EN(4) && IN(pb + 4)) {
            PHASE_BEGIN; (void)G; (void)bid;
            ph_ln1(wv, l_ == 0 ? INP(0) : (const float*)WP(float, O_XA), WP(bf16, O_MIXB), INP(15) + l_ * D_, INP(16) + l_ * D_, INP(17) + (size_t)l_ * D_ * NE, INP(18) + l_ * NE, WP(float, O_X1), WP(bf16, O_X1B),
                   (int*)(ws_ + 32768) + l_ * 64, WP(int, O_LIST), WP(int, O_TE), WP(int, O_TS), WP(float, O_TW));
        }
        SEAM(pb + 4);
        if (IN(pb + 5) || IN(pb + 6) || IN(pb + 7)) {
            PHASE_BEGIN; (void)G; (void)bid;
            int* cnt = (int*)(ws_ + 32768) + l_ * 64;
            __syncthreads();
            if (mk_tid(wv) == 0) { int acc = 0;
#pragma unroll 1
                for (int e = 0; e < NE; ++e) { const int c = __hip_atomic_load(&cnt[e], __ATOMIC_RELAXED, __HIP_MEMORY_SCOPE_AGENT); tstart[e] = acc; offs_s[e] = acc * 256; cnts[e] = c; acc += (c + 255) >> 8; } tstart[32] = acc; }
            __syncthreads();
        }
        if (EN(5) && IN(pb + 5)) {
            PHASE_BEGIN;
            pg8::MoeOrder<true> S{WP(bf16, O_WUP) + (size_t)l_ * NE * 2048 * D_, D_, 8, G, bid, (size_t)2048 * D_, tstart, cnts, WP(int, O_LIST)};
            pg8::EpiUp E{WP(bf16, O_ACT), INP(20) + (size_t)l_ * NE * 2048};
            pg8::gemm_phase<pg8::EpiUp, pg8::MoeOrder<true>, true>(wv, ldsl, WP(bf16, O_X1B), D_, S, E);
        }
        SEAM(pb + 5);
        if (EN(6) && IN(pb + 6)) {
            PHASE_BEGIN;
            pg8::MoeOrder<false> S{WP(bf16, O_WDN) + (size_t)l_ * NE * D_ * D_, D_, 4, G, bid, (size_t)D_ * D_, tstart, cnts, WP(int, O_LIST)};
            pg8::EpiBf16 E{WP(bf16, O_YB), D_, INP(22) + (size_t)l_ * NE * D_, D_};
            pg8::gemm_phase<pg8::EpiBf16, pg8::MoeOrder<false>, true>(wv, ldsl, WP(bf16, O_ACT), D_, S, E);
        }
        SEAM(pb + 6);
        if (EN(7) && IN(pb + 7)) {
            PHASE_BEGIN; (void)G; (void)bid;
            ph_comb(wv, WP(float, O_X1), WP(bf16, O_YB), WP(int, O_TE), WP(int, O_TS), WP(float, O_TW), INP(23) + l_ * D_, INP(24) + l_ * D_,
                    (l_ == DEPTH - 1) ? ap->out : WP(float, O_XA), (l_ == DEPTH - 1) ? (bf16*)nullptr : WP(bf16, O_XB));
        }
        if (l + 1 < DEPTH) SEAM(pb + 7);
    }
#undef IN
#undef SEAM
}
}

extern "C" void kernel_launch(void* const* d_in, const int* in_sizes, int n_in, void* d_out, int out_size, void* d_ws, size_t ws_size, hipStream_t stream) {
    using namespace mk;
    static int grid = 0;
    if (grid == 0) {
        size_t need = WS_NEED;
        if (n_in != 25 || need > ws_size) { fprintf(stderr, "kernel_launch: bad args n_in %d need %zu ws %zu\n", n_in, need, ws_size); grid = -1; return; }
        int dev = 0, cus = 0, per_cu = 0;
        if (hipGetDevice(&dev) != hipSuccess || hipDeviceGetAttribute(&cus, hipDeviceAttributeMultiprocessorCount, dev) != hipSuccess) { grid = -1; return; }
        if (hipFuncSetAttribute((const void*)mega, hipFuncAttributeMaxDynamicSharedMemorySize, LDS_BYTES) != hipSuccess) { fprintf(stderr, "hipFuncSetAttribute failed\n"); grid = -1; return; }
        if (hipOccupancyMaxActiveBlocksPerMultiprocessor(&per_cu, (const void*)mega, NTHR, LDS_BYTES) != hipSuccess || per_cu < 1) fprintf(stderr, "occupancy query: %d\n", per_cu);
        (void)hipGetLastError();
        grid = cus;
    }
    if (grid < 0) return;
    if (hipMemsetAsync(d_ws, 0, CTL_BYTES, stream) != hipSuccess) return;
    Args a{};
    for (int i = 0; i < 25; ++i) a.in[i] = (const float*)d_in[i];
    a.out = (float*)d_out; a.ws = (unsigned char*)d_ws; a.ph_lo = 0; a.ph_hi = 1 + DEPTH * NPH;
    hipLaunchKernelGGL(mega, dim3(grid), dim3(NTHR), LDS_BYTES, stream, a);
}
```

```cpp
#include <hip/hip_runtime.h>
#include <cstdio>
#include <cstdint>
#include <cmath>

__device__ __forceinline__ int mk_tid(int wv) { int lane; asm volatile("v_mbcnt_lo_u32_b32 %0, -1, 0\n\tv_mbcnt_hi_u32_b32 %0, -1, %0" : "=v"(lane)); return (wv << 6) | lane; }
#define XB_TMO      128
#define XB_XCNT(j)  (256  + 64 * (j))
#define XB_XSUB(j)  (1280 + 64 * (j))
#define XB_XGEN(j)  (2304 + 64 * (j))
#define XB_TOP      3328
#define XB_TOPGEN   3392
#define XCD_BAR_WORDS 3456
#define XB_SPIN_CAP (1u << 18)
#define LAS __attribute__((address_space(3)))

__device__ __forceinline__ unsigned xb_ld(unsigned* p)              { return __hip_atomic_load(p, __ATOMIC_RELAXED, __HIP_MEMORY_SCOPE_AGENT); }
__device__ __forceinline__ unsigned xb_add(unsigned* p, unsigned v) { return __hip_atomic_fetch_add(p, v, __ATOMIC_RELAXED, __HIP_MEMORY_SCOPE_AGENT); }
__device__ __forceinline__ unsigned xb_xcc_id() { return (unsigned)__builtin_amdgcn_s_getreg((3 << 11) | 20) & 0xFu; }
#define XB_SPIN(cond, bar) do { unsigned _sp = 0; while (cond) { __builtin_amdgcn_s_sleep(1); \
    if ((++_sp & 255u) == 0u) { if (xb_ld(&(bar)[XB_TMO])) break; if (_sp > XB_SPIN_CAP) { atomicAdd(&(bar)[XB_TMO], 1u); break; } } } } while (0)

struct XcdBarrier {
    unsigned* bar; unsigned x;
    volatile LAS unsigned* st; int wv;
};

__device__ __forceinline__ XcdBarrier xcd_barrier_post(unsigned* bar, volatile LAS unsigned* st, int wv) {
    XcdBarrier b; b.bar = bar; b.x = xb_xcc_id(); b.st = st; b.wv = wv;
    if (mk_tid(b.wv) == 0) (void)xb_add(&bar[XB_XCNT(b.x)], 1u);
    return b;
}
__device__ __forceinline__ void xcd_barrier_complete(unsigned* bar, unsigned x, unsigned& nloc, unsigned& nx) {
    const unsigned G = gridDim.x * gridDim.y * gridDim.z;
    unsigned sum, cnt, mine, sp = 0u;
    for (;;) {
        sum = 0u; cnt = 0u; mine = 0u;
#pragma unroll
        for (unsigned j = 0; j < 16; ++j) { const unsigned c = xb_ld(&bar[XB_XCNT(j)]); sum += c; cnt += (c > 0u) ? 1u : 0u; mine = (j == x) ? c : mine; }
        if (sum == G) break;
        __builtin_amdgcn_s_sleep(1);
        if ((++sp & 255u) == 0u) { if (xb_ld(&bar[XB_TMO])) break; if (sp > XB_SPIN_CAP) { atomicAdd(&bar[XB_TMO], 1u); break; } }
    }
    nloc = mine > 0u ? mine : 1u; nx = cnt > 0u ? cnt : 1u;
}

template <bool FIRST>
__device__ __forceinline__ void xcd_barrier_t(const XcdBarrier& b) {
    asm volatile("s_waitcnt vmcnt(0)" ::: "memory");
    __syncthreads();
    if (mk_tid(b.wv) == 0) {
        unsigned* bar = b.bar; unsigned bx = b.x; asm volatile("" : "+s"(bar), "+s"(bx));
        __builtin_amdgcn_s_waitcnt(0);
        unsigned nloc = b.st[0], nx = b.st[1];
        if (FIRST) { if (nloc == 0u) { xcd_barrier_complete(bar, bx, nloc, nx); b.st[0] = nloc; b.st[1] = nx; } }
        const unsigned old = xb_add(&bar[XB_XSUB(bx)], 1u);
        const unsigned gen = old / nloc;
        if (old + 1u == (gen + 1u) * nloc) {
            __builtin_amdgcn_fence(__ATOMIC_RELEASE, "agent");
            asm volatile("s_waitcnt vmcnt(0)" ::: "memory");
            const unsigned og = xb_add(&bar[XB_TOP], 1u);
            const unsigned tg = og / nx;
            if (og + 1u == (tg + 1u) * nx) xb_add(&bar[XB_TOPGEN], 1u);
            else XB_SPIN(xb_ld(&bar[XB_TOPGEN]) == tg, bar);
            __builtin_amdgcn_fence(__ATOMIC_ACQUIRE, "agent");
            xb_add(&bar[XB_XGEN(bx)], 1u);
            asm volatile("s_waitcnt vmcnt(0)" ::: "memory");
        } else {
            XB_SPIN(xb_ld(&bar[XB_XGEN(bx)]) == gen, bar);
            __builtin_amdgcn_fence(__ATOMIC_ACQUIRE, "agent");
            asm volatile("s_waitcnt vmcnt(0)" ::: "memory");
        }
    }
    __syncthreads();
}


__device__ __forceinline__ void xcd_barrier_first(const XcdBarrier& b) { xcd_barrier_t<true>(b); }
__device__ __forceinline__ void xcd_barrier(const XcdBarrier& b) { xcd_barrier_t<false>(b); }


namespace mk {
constexpr int B_ = 8, S_ = 4096, D_ = 1024, NT = B_ * S_, DEPTH = 2;
constexpr int INW = 2840, HS = 3072;
constexpr int C_HGQ = 0, C_HGF = 256, C_HGI = 512, C_HGG = 768, C_GMU = 1024, C_GMV = 1280, C_NQ = 1536,
              C_KC = 2048, C_VC = 2176, C_KS = 2304, C_VS = 2432, C_KW = 2560, C_VW = 2688, C_NG = 2816;
constexpr int NCMP = 255, NE = 32, TOPK = 4, NASSIGN = NT * TOPK;
constexpr float ALPHA = 1.4142135623730951f;
constexpr int NTHR = 512, LDS_BYTES = 147456, MISC_OFF = 144 * 1024 - 256;
constexpr int NPH = 8;

typedef unsigned short bf16;
__device__ __forceinline__ float bf2f(bf16 v) { return __uint_as_float((unsigned)v << 16); }
__device__ __forceinline__ unsigned f2bf(float f) { unsigned u = __float_as_uint(f); return (u + 0x7fffu + ((u >> 16) & 1u)) >> 16; }
__device__ __forceinline__ unsigned pk2(float lo, float hi) { return f2bf(lo) | (f2bf(hi) << 16); }
__device__ __forceinline__ float gelu_t(float x) { return 0.5f * x * (1.0f + tanhf(0.7978845608028654f * (x + 0.044715f * x * x * x))); }
__device__ __forceinline__ float sigm(float x) { return 1.0f / (1.0f + expf(-x)); }
__device__ __forceinline__ float wsum(float v) {
#pragma unroll
    for (int o = 1; o < 64; o <<= 1) v += __shfl_xor(v, o);
    return v;
}
__device__ __forceinline__ float wmax(float v) {
#pragma unroll
    for (int o = 1; o < 64; o <<= 1) v = fmaxf(v, __shfl_xor(v, o));
    return v;
}

constexpr int MROWS = NASSIGN + NE * 256;
constexpr size_t CTL_BYTES = 65536;
constexpr size_t al256(size_t x) { return (x + 255) & ~(size_t)255; }
constexpr size_t O_COS = CTL_BYTES, O_SIN = O_COS + al256((size_t)NT * 32 * 4), O_LB = O_SIN + al256((size_t)NT * 32 * 4);
constexpr size_t O_WIN = O_LB + al256(512 * 4), O_WOUT = O_WIN + al256((size_t)DEPTH * HS * D_ * 2), O_WUP = O_WOUT + al256((size_t)DEPTH * D_ * D_ * 2);
constexpr size_t O_WDN = O_WUP + al256((size_t)DEPTH * NE * 2048 * D_ * 2), O_XB = O_WDN + al256((size_t)DEPTH * NE * D_ * D_ * 2);
constexpr size_t O_HB = O_XB + al256((size_t)NT * D_ * 2), O_YCAT = O_HB + al256((size_t)NT * HS * 2), O_MIXB = O_YCAT + al256((size_t)NT * D_ * 2);
constexpr size_t O_X1B = O_MIXB + al256((size_t)NT * D_ * 2), O_ACT = O_X1B + al256((size_t)NT * D_ * 2), O_YB = O_ACT + al256((size_t)MROWS * D_ * 2);
constexpr size_t O_X1 = O_YB + al256((size_t)MROWS * D_ * 2), O_XA = O_X1 + al256((size_t)NT * D_ * 4);
constexpr size_t O_VLNT = O_XA + al256((size_t)NT * D_ * 4), O_WB = O_VLNT + al256((size_t)NT * 256 * 2), O_W1T = O_WB + al256((size_t)DEPTH * 4 * 128 * 128 * 2);
constexpr size_t O_CBIAS = O_W1T + al256((size_t)DEPTH * 2 * 128 * 2048 * 2), O_W2T = O_CBIAS + al256((size_t)DEPTH * 2 * 128 * 4), O_RWH = O_W2T + al256((size_t)DEPTH * 2 * 64 * 128 * 2), O_RWL = O_RWH + al256((size_t)DEPTH * NE * D_ * 2), O_HQT = O_RWL + al256((size_t)DEPTH * NE * D_ * 2);
constexpr size_t HGB = (size_t)2048 * 4096 * 2;
constexpr size_t O_HKT = O_HQT + HGB, O_HQP = O_HKT + HGB, O_HVT = O_HQP + HGB, O_HST = O_HVT + HGB, O_HUT = O_HST + HGB, O_HDK = O_HUT + 2 * HGB;
constexpr size_t O_KSB = O_HDK + al256((size_t)2048 * 64 * 4), O_VSB = O_KSB + al256((size_t)NT * 128 * 2);
constexpr size_t O_KWB = O_VSB + al256((size_t)NT * 128 * 2), O_VWB = O_KWB + al256((size_t)NT * 128 * 2), O_KCB = O_VWB + al256((size_t)NT * 128 * 2), O_VCB = O_KCB + al256((size_t)B_ * 2 * 256 * 64 * 2);
constexpr size_t O_LIST = O_VCB + al256((size_t)B_ * 2 * 256 * 64 * 2), O_TE = O_LIST + al256((size_t)NE * NT * 4), O_TS = O_TE + al256((size_t)NASSIGN * 4), O_TW = O_TS + al256((size_t)NASSIGN * 4);
constexpr size_t WS_NEED = O_TW + al256((size_t)NASSIGN * 4);
namespace pg8 {
#define PG8_LAS __attribute__((address_space(3)))
typedef unsigned short bf16_t;
typedef short bf16x8 __attribute__((ext_vector_type(8)));
typedef float f32x4 __attribute__((ext_vector_type(4)));
typedef float f32x2 __attribute__((ext_vector_type(2)));
typedef unsigned u32x4 __attribute__((ext_vector_type(4)));
constexpr int BM = 256, BK = 64, HALF = 128, HTB = HALF * BK * 2  , STAGE_BYTES = 8 * HTB, NXCD = 8, WGM = 8;

__host__ __device__ __forceinline__ int lds_byte(int r, int c) { const int st = (r >> 4) * 2 + (c >> 5), rr = r & 15, cc = c & 31, ob = rr * 64 + cc * 2; return st * 1024 + (ob ^ (((ob >> 9) & 1) << 5)); }
__host__ __device__ __forceinline__ void stage_rc(int b, int& R, int& C) { const int st = b / 1024, sb = b % 1024, swz = sb ^ (((sb >> 9) & 1) << 5); R = (st >> 1) * 16 + swz / 64; C = (st & 1) * 32 + (swz % 64) / 2; }
__host__ __device__ __forceinline__ int perm32(int rho) { const int n = rho >> 4, i = rho & 15; return 8 * (i >> 2) + 4 * n + (i & 3); }

struct Unit { int pm, pn, e, mt, cnt; };

__device__ __forceinline__ void deal(int L, int nM, int nN, int& pm, int& pn) {
    const int nwg = nM * nN;
    int wgid = L; { const int q = nwg / NXCD, r = nwg % NXCD, xcd = wgid % NXCD, off = wgid / NXCD; wgid = (xcd < r ? xcd * (q + 1) : r * (q + 1) + (xcd - r) * q) + off; }
    const int nig = WGM * nN, gid = wgid / nig, fm = gid * WGM, gsz = (nM - fm) < WGM ? (nM - fm) : WGM;
    pm = fm + ((wgid % nig) % gsz); pn = (wgid % nig) / gsz;
}
struct PlainOrder {
    const bf16_t* Bt; int K; int nM, nN, G, c;
    __device__ __forceinline__ bool next(int i, Unit& u) const { const long L = (long)i * G + c; if (L >= (long)nM * nN) return false; deal((int)L, nM, nN, u.pm, u.pn); u.e = 0; u.mt = 0; u.cnt = 0; return true; }
    __device__ __forceinline__ unsigned a_row(const Unit& u, int r) const { return (unsigned)(u.pm * BM + r); }
    __device__ __forceinline__ const char* b_base(const Unit& u) const { return (const char*)Bt + (size_t)u.pn * BM * K * 2; }
};
template <bool GATHER> struct MoeOrder {
    const bf16_t* Bt; int K; int nN, G, c; size_t estride;
    const int* tstart; const int* cnts; const int* list;
    __device__ __forceinline__ bool next(int i, Unit& u) const {
        const int nM = tstart[32]; const long L = (long)i * G + c; if (L >= (long)nM * nN) return false;
        deal((int)L, nM, nN, u.pm, u.pn);
        int e = 0;
#pragma unroll 1
        for (int k = 1; k < 32; ++k) e = (tstart[k] <= u.pm) ? k : e;
        u.e = e; u.mt = u.pm - tstart[e]; u.cnt = cnts[e]; return true;
    }
    __device__ __forceinline__ unsigned a_row(const Unit& u, int r) const {
        if (GATHER) { const int slot = u.mt * BM + r; return (slot < u.cnt) ? (unsigned)list[u.e * 32768 + slot] : 0u; }
        return (unsigned)(u.pm * BM + r);
    }
    __device__ __forceinline__ const char* b_base(const Unit& u) const { return (const char*)Bt + ((size_t)u.e * estride + (size_t)u.pn * BM * K) * 2; }
};

__device__ __forceinline__ unsigned cvt_pk_bf16(float lo, float hi) { unsigned r; asm volatile("v_cvt_pk_bf16_f32 %0, %1, %2" : "=v"(r) : "v"(lo), "v"(hi)); return r; }

struct EpiBf16 {
    static constexpr bool PERM = true;
    bf16_t* O; int ldc; const float* bias; int bstride;
    __device__ __forceinline__ void operator()(const f32x4 (&acc)[2][2][4][2], const Unit& u, int wr, int wc, int fr, int fq) const {
        const int row0 = u.pm * BM + wr * 64 + fr; const int col0 = u.pn * BM + wc * 32 + 8 * fq;
        f32x4 bv[2][2];
#pragma unroll
        for (int bj = 0; bj < 2; ++bj)
#pragma unroll
            for (int n = 0; n < 2; ++n) bv[bj][n] = bias ? *(const f32x4*)(bias + (size_t)u.e * bstride + col0 + bj * HALF + 4 * n) : (f32x4){0.f, 0.f, 0.f, 0.f};
#pragma unroll
        for (int ai = 0; ai < 2; ++ai)
#pragma unroll
            for (int m = 0; m < 4; ++m) { bf16_t* rowp = O + (size_t)(row0 + ai * HALF + m * 16) * ldc + col0;
#pragma unroll
                for (int bj = 0; bj < 2; ++bj) { f32x4 v0 = acc[ai][bj][m][0] + bv[bj][0], v1 = acc[ai][bj][m][1] + bv[bj][1];
                    u32x4 w; w.x = cvt_pk_bf16(v0[0], v0[1]); w.y = cvt_pk_bf16(v0[2], v0[3]); w.z = cvt_pk_bf16(v1[0], v1[1]); w.w = cvt_pk_bf16(v1[2], v1[3]);
                    *(u32x4*)(rowp + bj * HALF) = w; } }
    }
};
__device__ __forceinline__ float swiglu1(float g, float l) {
    g = fminf(g, 7.0f); l = fminf(fmaxf(l, -7.0f), 7.0f);
    const float s = __builtin_amdgcn_rcpf(1.0f + __builtin_amdgcn_exp2f(-1.702f * 1.4426950408889634f * g));
    return g * s * (l + 1.0f);
}
struct EpiUp {
    static constexpr bool PERM = true;
    bf16_t* O; const float* bias;
    __device__ __forceinline__ void operator()(const f32x4 (&acc)[2][2][4][2], const Unit& u, int wr, int wc, int fr, int fq) const {
        const int row0 = u.pm * BM + wr * 64 + fr; const int j0 = u.pn * HALF + wc * 32 + 8 * fq;
        const float* bp = bias + (size_t)u.e * 2048 + j0;
        f32x4 bg[2], bl[2];
#pragma unroll
        for (int n = 0; n < 2; ++n) { bg[n] = *(const f32x4*)(bp + 4 * n); bl[n] = *(const f32x4*)(bp + 1024 + 4 * n); }
#pragma unroll
        for (int ai = 0; ai < 2; ++ai)
#pragma unroll
            for (int m = 0; m < 4; ++m) {
                float o[8];
#pragma unroll
                for (int n = 0; n < 2; ++n) { const f32x4 g = acc[ai][0][m][n] + bg[n], l = acc[ai][1][m][n] + bl[n];
#pragma unroll
                    for (int j = 0; j < 4; ++j) o[4 * n + j] = swiglu1(g[j], l[j]); }
                u32x4 w; w.x = cvt_pk_bf16(o[0], o[1]); w.y = cvt_pk_bf16(o[2], o[3]); w.z = cvt_pk_bf16(o[4], o[5]); w.w = cvt_pk_bf16(o[6], o[7]);
                *(u32x4*)(O + (size_t)(row0 + ai * HALF + m * 16) * 1024 + j0) = w; }
    }
};

template <class Epi, class Sched, bool ALIGN_EPI>
__device__ __forceinline__ void gemm_phase(const int wv, PG8_LAS unsigned char* lds, const bf16_t* Abase, const int K, const Sched& S, const Epi& E) {
    int tid = mk_tid(wv); asm volatile("" : "+v"(tid));
    const int wid = __builtin_amdgcn_readfirstlane(tid >> 6), lane = tid & 63, wr = wid >> 2, wc = wid & 3, fr = lane & 15, fq = lane >> 4;
    const int nt = K / BK;
    const char* Ab = (const char*)Abase;
    int Rr[2]; unsigned CB[2], voffB[2];
#pragma unroll
    for (int i = 0; i < 2; ++i) { int R, C; stage_rc(tid * 16 + i * 8192, R, C); const int Rb = Epi::PERM ? ((R & ~31) + perm32(R & 31)) : R;
        Rr[i] = R; CB[i] = (unsigned)C * 2u; voffB[i] = (unsigned)(Rb * K + C) * 2u; }
    const size_t kstep = (size_t)(BK * 2);
    const size_t hstep = (size_t)HALF * K * 2;
    const unsigned rowb = (unsigned)K * 2u;
    const unsigned ldsw = (unsigned)wid * 1024u;
    const int aoff = lds_byte(wr * 64 + fr, fq * 8), boff = lds_byte(wc * 32 + fr, fq * 8);
#define PG8_SA(b, h) (((b) * 2 + (h)) * HTB)
#define PG8_SB(b, h) ((4 + (b) * 2 + (h)) * HTB)
#define PG8_STAGE(bufoff, gbase, voff) do { _Pragma("unroll") for (int _i = 0; _i < 2; ++_i) \
        __builtin_amdgcn_global_load_lds((const unsigned*)((const char*)(gbase) + (voff)[_i]), (PG8_LAS unsigned*)(lds + (bufoff) + ldsw + _i * 8192), 16, 0, 0); } while (0)
#define PG8_STAGE_A(bufoff, kb, o0, o1) do { \
        __builtin_amdgcn_global_load_lds((const unsigned*)(Ab + (kb) + (o0)), (PG8_LAS unsigned*)(lds + (bufoff) + ldsw), 16, 0, 0); \
        __builtin_amdgcn_global_load_lds((const unsigned*)(Ab + (kb) + (o1)), (PG8_LAS unsigned*)(lds + (bufoff) + ldsw + 8192), 16, 0, 0); } while (0)
#define PG8_LDA(dst, b, h) do { _Pragma("unroll") for (int m = 0; m < 4; ++m) _Pragma("unroll") for (int k = 0; k < 2; ++k) dst[m][k] = *(const PG8_LAS bf16x8*)(lds + PG8_SA(b, h) + aoff + m * 2048 + k * 1024); } while (0)
#define PG8_LDB(dst, b, h) do { _Pragma("unroll") for (int n = 0; n < 2; ++n) _Pragma("unroll") for (int k = 0; k < 2; ++k) dst[n][k] = *(const PG8_LAS bf16x8*)(lds + PG8_SB(b, h) + boff + n * 2048 + k * 1024); } while (0)
#define PG8_MMA(ai, bj, At, Bt) do { __builtin_amdgcn_s_setprio(1); _Pragma("unroll") for (int m = 0; m < 4; ++m) _Pragma("unroll") for (int n = 0; n < 2; ++n) _Pragma("unroll") for (int k = 0; k < 2; ++k) \
        acc[ai][bj][m][n] = __builtin_amdgcn_mfma_f32_16x16x32_bf16(Bt[n][k], At[m][k], acc[ai][bj][m][n], 0, 0, 0); __builtin_amdgcn_s_setprio(0); } while (0)
#define PG8_WAIT_V(n) asm volatile("s_waitcnt vmcnt(" #n ")" ::: "memory")
#define PG8_WAIT_L(n) asm volatile("s_waitcnt lgkmcnt(" #n ")" ::: "memory")
#define PG8_BAR __builtin_amdgcn_s_barrier()
#define PG8_SCHED __builtin_amdgcn_sched_barrier(0)
#define PG8_AOFFS(dst, u) do { _Pragma("unroll") for (int _h = 0; _h < 2; ++_h) _Pragma("unroll") for (int _i = 0; _i < 2; ++_i) \
        dst[_h][_i] = S.a_row(u, _h * HALF + Rr[_i]) * rowb + CB[_i]; } while (0)
    Unit cur, nxt; int ui = 0;
    if (!S.next(0, cur)) return;
    f32x4 acc[2][2][4][2];
#pragma unroll
    for (int a = 0; a < 2; ++a)
#pragma unroll
        for (int b = 0; b < 2; ++b)
#pragma unroll
            for (int m = 0; m < 4; ++m)
#pragma unroll
                for (int n = 0; n < 2; ++n) acc[a][b][m][n] = (f32x4){0.f, 0.f, 0.f, 0.f};
    bf16x8 At[4][2], B0[2][2], B1[2][2];
    unsigned aC[2][2], aN[2][2];
    PG8_AOFFS(aC, cur);
    const char* cB = S.b_base(cur);
    PG8_STAGE(PG8_SB(0, 0), cB, voffB); PG8_STAGE(PG8_SB(0, 1), cB + hstep, voffB); PG8_STAGE_A(PG8_SA(0, 0), 0, aC[0][0], aC[0][1]); PG8_STAGE_A(PG8_SA(0, 1), 0, aC[1][0], aC[1][1]);
    if (wr == 1) PG8_BAR;
    PG8_WAIT_V(2); PG8_BAR;
    PG8_STAGE(PG8_SB(1, 0), cB + kstep, voffB); PG8_STAGE_A(PG8_SA(1, 0), kstep, aC[0][0], aC[0][1]); PG8_STAGE(PG8_SB(1, 1), cB + hstep + kstep, voffB);
    PG8_WAIT_V(6); PG8_BAR;
    for (;;) {
        const bool has_next = S.next(ui + 1, nxt);
        const char* nB = has_next ? S.b_base(nxt) : cB;
        if (has_next) { PG8_AOFFS(aN, nxt); }
        else {
#pragma unroll
            for (int _h = 0; _h < 2; ++_h)
#pragma unroll
                for (int _i = 0; _i < 2; ++_i) aN[_h][_i] = aC[_h][_i]; }
#pragma unroll 1
        for (int t = 0; t < nt; t += 2) {
            const bool last = (t == nt - 2);
            const size_t kb1 = (size_t)(t + 1) * kstep;
            PG8_LDB(B0, 0, 0); PG8_LDB(B1, 0, 1); PG8_SCHED; PG8_LDA(At, 0, 0); PG8_STAGE_A(PG8_SA(1, 1), kb1, aC[1][0], aC[1][1]);
            PG8_WAIT_V(8); PG8_WAIT_L(0); PG8_BAR; PG8_MMA(0, 0, At, B0); PG8_MMA(0, 1, At, B1); PG8_BAR; PG8_SCHED;
            if (last) {
#pragma unroll
                for (int _h = 0; _h < 2; ++_h)
#pragma unroll
                    for (int _i = 0; _i < 2; ++_i) aC[_h][_i] = aN[_h][_i]; }
            const size_t kb2 = last ? (size_t)0 : (size_t)(t + 2) * kstep; const char* b2 = last ? nB : cB + (size_t)(t + 2) * kstep;
            const size_t kb3 = kb2 + kstep; const char* b3 = b2 + kstep;
            PG8_LDA(At, 0, 1); PG8_STAGE(PG8_SB(0, 0), b2, voffB); PG8_STAGE(PG8_SB(0, 1), b2 + hstep, voffB); PG8_STAGE_A(PG8_SA(0, 0), kb2, aC[0][0], aC[0][1]);
            PG8_WAIT_V(8); PG8_WAIT_L(0); PG8_BAR; PG8_MMA(1, 0, At, B0); PG8_MMA(1, 1, At, B1); PG8_BAR; PG8_SCHED;
            PG8_LDB(B0, 1, 0); PG8_LDB(B1, 1, 1); PG8_SCHED; PG8_LDA(At, 1, 0); PG8_STAGE_A(PG8_SA(0, 1), kb2, aC[1][0], aC[1][1]);
            PG8_WAIT_V(8); PG8_WAIT_L(0); PG8_BAR; PG8_MMA(0, 0, At, B0); PG8_MMA(0, 1, At, B1); PG8_BAR; PG8_SCHED;
            PG8_LDA(At, 1, 1); PG8_STAGE(PG8_SB(1, 0), b3, voffB); PG8_STAGE(PG8_SB(1, 1), b3 + hstep, voffB); PG8_STAGE_A(PG8_SA(1, 0), kb3, aC[0][0], aC[0][1]);
            PG8_WAIT_V(8); PG8_WAIT_L(0); PG8_BAR; PG8_MMA(1, 0, At, B0); PG8_MMA(1, 1, At, B1); PG8_BAR; PG8_SCHED;
        }
        if (ALIGN_EPI) { if (wr == 0) PG8_BAR; }
        E(acc, cur, wr, wc, fr, fq);
        if (!has_next) break;
#pragma unroll
        for (int a = 0; a < 2; ++a)
#pragma unroll
            for (int b = 0; b < 2; ++b)
#pragma unroll
                for (int m = 0; m < 4; ++m)
#pragma unroll
                    for (int n = 0; n < 2; ++n) acc[a][b][m][n] = (f32x4){0.f, 0.f, 0.f, 0.f};
        cur = nxt; cB = nB; ++ui;
        if (ALIGN_EPI) { if (wr == 1) PG8_BAR; }
    }
    PG8_WAIT_V(0);
    if (!ALIGN_EPI) { if (wr == 0) PG8_BAR; }
    PG8_BAR;
#undef PG8_SA
#undef PG8_SB
#undef PG8_STAGE
#undef PG8_STAGE_A
#undef PG8_LDA
#undef PG8_LDB
#undef PG8_MMA
#undef PG8_WAIT_V
#undef PG8_WAIT_L
#undef PG8_BAR
#undef PG8_SCHED
#undef PG8_AOFFS
}
}


#ifndef NSA_REP_RANK
#define NSA_REP_RANK 1
#endif
#ifndef NSA_REP_PASSA
#define NSA_REP_PASSA 1
#endif
#ifndef NSA_REP_LOOP
#define NSA_REP_LOOP 1
#endif
namespace nsa {
#define NLAS __attribute__((address_space(3)))
typedef short bf16x8 __attribute__((ext_vector_type(8)));
typedef short s16x4 __attribute__((ext_vector_type(4)));
typedef short v4i16_t __attribute__((ext_vector_type(4)));
typedef float f32x16 __attribute__((ext_vector_type(16)));
typedef float f32x2_t __attribute__((ext_vector_type(2)));
typedef __bf16 bf16x2_t __attribute__((ext_vector_type(2)));
#define NSA_MFMA(a, b, c) __builtin_amdgcn_mfma_f32_32x32x16_bf16((a), (b), (c), 0, 0, 0)
constexpr int L_CK = 0, L_CV = 32768, L_RING = 65536, L_IMP = 0, SLOTB = 16384, L_SELM = 131072 + 1024;
constexpr float QSCALE = 0.125f * 1.4426950408889634f;
constexpr float NEGBIG = -1.0e30f;

__device__ __forceinline__ unsigned cvtpk(float lo, float hi) { f32x2_t v = {lo, hi}; bf16x2_t b = __builtin_convertvector(v, bf16x2_t); return __builtin_bit_cast(unsigned, b); }
__device__ __forceinline__ float bflo(unsigned u) { return __uint_as_float(u << 16); }
__device__ __forceinline__ float bfhi(unsigned u) { return __uint_as_float(u & 0xffff0000u); }
__device__ __forceinline__ float xhalf(float v) { return __shfl_xor(v, 32); }
__device__ __forceinline__ s16x4 vtr(const NLAS unsigned char* p) { return __builtin_bit_cast(s16x4, __builtin_amdgcn_ds_read_tr16_b64_v4i16((NLAS v4i16_t*)p)); }
__device__ __forceinline__ bf16x8 pack8(const f32x16& x, int s) {
    unsigned p0 = cvtpk(x[8 * s], x[8 * s + 1]), p1 = cvtpk(x[8 * s + 2], x[8 * s + 3]), p2 = cvtpk(x[8 * s + 4], x[8 * s + 5]), p3 = cvtpk(x[8 * s + 6], x[8 * s + 7]);
    typedef unsigned u32x4 __attribute__((ext_vector_type(4)));
    u32x4 u = {p0, p1, p2, p3}; return __builtin_bit_cast(bf16x8, u);
}

struct Params {
    const unsigned short* hb;
    const unsigned short *kcb, *vcb;
    const unsigned short *ksb, *vsb, *kwb, *vwb;
    const float *cosT, *sinT;
    const float* normw;
    unsigned short* ycat;
};

__device__ __forceinline__ void qk_tile(const NLAS unsigned char* kt, const bf16x8 (&qf)[4], const int (&kofs)[4], f32x16& st0, f32x16& st1, const float binit = 0.f) {
#pragma unroll
    for (int i = 0; i < 16; ++i) { st0[i] = binit; st1[i] = binit; }
#pragma unroll
    for (int ks = 0; ks < 4; ++ks) {
        const bf16x8 k0 = *(const NLAS bf16x8*)(kt + kofs[ks]);
        const bf16x8 k1 = *(const NLAS bf16x8*)(kt + kofs[ks] + 4096);
        st0 = NSA_MFMA(k0, qf[ks], st0); st1 = NSA_MFMA(k1, qf[ks], st1);
    }
}
__device__ __forceinline__ void pv_tile(const NLAS unsigned char* vt, const int (&vofs)[2][2], const f32x16& p0, const f32x16& p1, f32x16& o0, f32x16& o1) {
#pragma unroll
    for (int kt = 0; kt < 2; ++kt)
#pragma unroll
        for (int s = 0; s < 2; ++s) {
            const bf16x8 pb = pack8(kt ? p1 : p0, s);
            const int kb = (32 * kt + 16 * s) * 128;
#pragma unroll
            for (int mb = 0; mb < 2; ++mb) {
                const s16x4 lo = vtr(vt + kb + vofs[mb][0]), hi = vtr(vt + kb + vofs[mb][1]);
                const bf16x8 va = __builtin_shufflevector(lo, hi, 0, 1, 2, 3, 4, 5, 6, 7);
                if (mb == 0) o0 = NSA_MFMA(va, pb, o0); else o1 = NSA_MFMA(va, pb, o1);
            }
        }
}
__device__ __forceinline__ float max3f(float a, float b, float c) { float r; asm("v_max3_f32 %0, %1, %2, %3" : "=v"(r) : "v"(a), "v"(b), "v"(c)); return r; }
constexpr float NEGINF = -__builtin_inff();
template <bool USE_LO>
__device__ __forceinline__ void mask_tile(f32x16& s0, f32x16& s1, const int hi4, const int lo4) {
#pragma unroll
    for (int i = 0; i < 16; ++i) {
        const int kk0 = (i & 3) + 8 * (i >> 2), kk1 = kk0 + 32;
        bool a0 = kk0 <= hi4, a1 = kk1 <= hi4;
        if (USE_LO) { a0 = a0 && (kk0 >= lo4); a1 = a1 && (kk1 >= lo4); }
        s0[i] = a0 ? s0[i] : NEGINF; s1[i] = a1 ? s1[i] : NEGINF;
    }
}
__device__ __forceinline__ void softmax_core(f32x16& s0, f32x16& s1, float& m, float& l, f32x16& o0, f32x16& o1) {
    float mx = max3f(s0[0], s0[1], s0[2]);
#pragma unroll
    for (int i = 3; i < 15; i += 2) mx = max3f(mx, s0[i], s0[i + 1]);
    mx = max3f(mx, s0[15], s1[0]);
#pragma unroll
    for (int i = 1; i < 15; i += 2) mx = max3f(mx, s1[i], s1[i + 1]);
    mx = fmaxf(mx, s1[15]);
    mx = fmaxf(mx, xhalf(mx));
    const float mn = fmaxf(m, mx);
    const float alpha = __builtin_amdgcn_exp2f(m - mn);
    m = mn;
    f32x2_t acc2 = {0.f, 0.f};
    const f32x2_t mn2 = {mn, mn};
#pragma unroll
    for (int i = 0; i < 16; i += 2) {
        f32x2_t a = {s0[i], s0[i + 1]}, b = {s1[i], s1[i + 1]};
        a = a - mn2; b = b - mn2;
        a.x = __builtin_amdgcn_exp2f(a.x); a.y = __builtin_amdgcn_exp2f(a.y); b.x = __builtin_amdgcn_exp2f(b.x); b.y = __builtin_amdgcn_exp2f(b.y);
        s0[i] = a.x; s0[i + 1] = a.y; s1[i] = b.x; s1[i + 1] = b.y;
        acc2 = acc2 + a; acc2 = acc2 + b;
    }
    l = l * alpha + (acc2.x + acc2.y);
    if (__ballot(alpha != 1.0f) != 0ull) {
        const f32x2_t al2 = {alpha, alpha};
#pragma unroll
        for (int i = 0; i < 16; i += 2) {
            f32x2_t a = {o0[i], o0[i + 1]}, b = {o1[i], o1[i + 1]};
            a = a * al2; b = b * al2;
            o0[i] = a.x; o0[i + 1] = a.y; o1[i] = b.x; o1[i + 1] = b.y;
        }
    }
}

__device__ __forceinline__ void unit(const Params& P, NLAS unsigned char* lds, const int tid_in, const int b, const int g, const int qb) {
    int tid = tid_in; asm volatile("" : "+v"(tid));
    const int wv = __builtin_amdgcn_readfirstlane(tid >> 6), lane = tid & 63, r = lane & 31, h = lane >> 5;
    const int head = g * 4 + (wv >> 1), qi = 32 * (wv & 1) + r;
    const int t = qb * 64 + qi, tok = b * 4096 + t;
    const int bg = b * 2 + g;
    int kofs[4];
#pragma unroll
    for (int ks = 0; ks < 4; ++ks) kofs[ks] = r * 128 + ((((2 * ks + h) ^ ((r >> 1) & 7))) << 4);
    int vofs[2][2];
    { const int i16 = lane & 15, blk = (lane >> 4) & 1, q = i16 >> 2, p = i16 & 3;
#pragma unroll
      for (int mb = 0; mb < 2; ++mb)
#pragma unroll
          for (int jj = 0; jj < 2; ++jj) { const int key = 4 * h + 8 * jj + q; const int o = 4 * mb + 2 * blk + (p >> 1);
              vofs[mb][jj] = key * 128 + ((o ^ (((key >> 1) & 1) << 2)) << 4) + (p & 1) * 8; } }
    const int drow = tid >> 3, dpos = tid & 7;
    const unsigned srcK = (unsigned)(drow * 128 + ((dpos ^ ((drow >> 1) & 7)) << 4));
    const unsigned srcV = (unsigned)(drow * 128 + ((dpos ^ (((drow >> 1) & 1) << 2)) << 4));
    const unsigned wdst = (unsigned)wv * 1024u;
    const unsigned lds0 = (unsigned)(size_t)lds;
#define NSA_DMA(slotoff, gsrc, soff) do { unsigned _keep; const void* _g = (const void*)((const char*)(gsrc) + (soff)); const unsigned _d = (unsigned)__builtin_amdgcn_readfirstlane((int)(lds0 + (unsigned)(slotoff) + wdst)); \
        asm volatile("s_mov_b32 %0, m0\n\ts_mov_b32 m0, %2\n\ts_nop 0\n\tglobal_load_lds_dwordx4 %1, off\n\ts_mov_b32 m0, %0" : "=&s"(_keep) : "v"(_g), "s"(_d) : "memory"); } while (0)
    const int nsel = qb + 1, jw0 = qb >= 8 ? qb - 8 : 0, ntiles = nsel + (qb - jw0 + 1);
    const char* ksg = (const char*)P.ksb + (size_t)bg * 4096 * 128; const char* vsg = (const char*)P.vsb + (size_t)bg * 4096 * 128;
    const char* kwg = (const char*)P.kwb + (size_t)bg * 4096 * 128; const char* vwg = (const char*)P.vwb + (size_t)bg * 4096 * 128;
#define NSA_ISSUE(pos) do { const int _p = (pos) < ntiles ? (pos) : ntiles - 1; const bool _w = _p >= nsel; const int _j = _w ? jw0 + _p - nsel : _p; \
        const int _slot = L_RING + ((pos) & 3) * SLOTB; \
        NSA_DMA(_slot, (_w ? kwg : ksg) + (size_t)_j * 8192, srcK); NSA_DMA(_slot + 8192, (_w ? vwg : vsg) + (size_t)_j * 8192, srcV); } while (0)
    { const char* kcg = (const char*)P.kcb + (size_t)bg * 256 * 128; const char* vcg = (const char*)P.vcb + (size_t)bg * 256 * 128;
#pragma unroll
      for (int T = 0; T < 4; ++T) { NSA_DMA(L_CK + T * 8192, kcg + T * 8192, srcK); NSA_DMA(L_CV + T * 8192, vcg + T * 8192, srcV); } }
    NSA_ISSUE(0); NSA_ISSUE(1);
    typedef unsigned u32x4 __attribute__((ext_vector_type(4)));
    bf16x8 qf[4];
    const unsigned short* qrow = P.hb + (size_t)tok * 3072 + 1536 + (head & 7) * 64;
    {
        u32x4 qraw[4];
#pragma unroll
        for (int ks = 0; ks < 4; ++ks) qraw[ks] = *(const u32x4*)(qrow + 16 * ks + 8 * h);
#pragma unroll
        for (int ks = 0; ks < 4; ++ks) { u32x4 o;
#pragma unroll
            for (int c = 0; c < 4; ++c) o[c] = cvtpk(bflo(qraw[ks][c]) * QSCALE, bfhi(qraw[ks][c]) * QSCALE);
            qf[ks] = __builtin_bit_cast(bf16x8, o); }
    }
    float gc, gs, gw;
    { const unsigned short* gp = P.hb + (size_t)tok * 3072 + 2816 + head * 3;
      gc = 1.f / (1.f + __expf(-__uint_as_float((unsigned)gp[0] << 16))); gs = 1.f / (1.f + __expf(-__uint_as_float((unsigned)gp[1] << 16))); gw = 1.f / (1.f + __expf(-__uint_as_float((unsigned)gp[2] << 16))); }
    asm volatile("s_waitcnt vmcnt(0)" ::: "memory"); __builtin_amdgcn_s_barrier();
    const int cmax = (t >= 31) ? (((t - 31) >> 4) < 254 ? ((t - 31) >> 4) : 254) : -1;
    float m = NEGBIG, l = 0.f;
    {
        f32x16 s0, s1, d0, d1;
#pragma unroll
        for (int i = 0; i < 16; ++i) { d0[i] = 0.f; d1[i] = 0.f; }
#pragma unroll 1
        for (int repA = 0; repA < NSA_REP_PASSA; ++repA) { m = NEGBIG; l = 0.f;
#pragma unroll 1
        for (int T = 0; T < 4; ++T) {
            qk_tile(lds + L_CK + T * 8192, qf, kofs, s0, s1);
            if (__ballot(cmax - 64 * T < 63) != 0ull) mask_tile<false>(s0, s1, cmax - 64 * T - 4 * h, 0);
            softmax_core(s0, s1, m, l, d0, d1);
        } }
    }
    const float lc = l + xhalf(l);
    const float rinv = lc > 0.f ? 1.0f / lc : 0.f;
    f32x16 of0, of1;
#pragma unroll
    for (int i = 0; i < 16; ++i) { of0[i] = 0.f; of1[i] = 0.f; }
    const bool need_sel = qb >= 16;
    float ow[32];
    float carry_in = 0.f;
#pragma unroll
    for (int T = 0; T < 4; ++T) {
        f32x16 s0, s1;
        qk_tile(lds + L_CK + T * 8192, qf, kofs, s0, s1);
        if (__ballot(cmax - 64 * T < 63) != 0ull) mask_tile<false>(s0, s1, cmax - 64 * T - 4 * h, 0);
#pragma unroll
        for (int i = 0; i < 16; ++i) { s0[i] = __builtin_amdgcn_exp2f(s0[i] - m) * rinv; s1[i] = __builtin_amdgcn_exp2f(s1[i] - m) * rinv; }
#pragma unroll
        for (int kt = 0; kt < 2; ++kt)
#pragma unroll
            for (int u = 0; u < 4; ++u) {
                const float p0 = kt ? s1[4 * u] : s0[4 * u], p1 = kt ? s1[4 * u + 1] : s0[4 * u + 1], p2 = kt ? s1[4 * u + 2] : s0[4 * u + 2], p3 = kt ? s1[4 * u + 3] : s0[4 * u + 3];
                const float x = xhalf(p3);
                const float own = 2.0f * ((p0 + p1) + p2) + p3;
                ow[8 * T + 4 * kt + u] = own + (h ? x : carry_in);
                carry_in = x;
            }
        pv_tile(lds + L_CV + T * 8192, vofs, s0, s1, of0, of1);
    }
#pragma unroll
    for (int i = 0; i < 16; ++i) { of0[i] *= gc; of1[i] *= gc; }
    unsigned long long selmask = (qb >= 63) ? ~0ull : ((1ull << (qb + 1)) - 1ull);
    if (need_sel) {
        __builtin_amdgcn_s_barrier();
        NLAS float* imp = (NLAS float*)(lds + L_IMP) + qi * 64;
#pragma unroll 1
        for (int hh = 0; hh < 4; ++hh) {
            if ((wv >> 1) == hh) {
                if (hh == 0) {
#pragma unroll
                    for (int idx = 0; idx < 32; ++idx) imp[(2 * idx + h + qi) & 63] = ow[idx];
                } else {
#pragma unroll
                    for (int idx = 0; idx < 32; ++idx) imp[(2 * idx + h + qi) & 63] += ow[idx];
                }
            }
            asm volatile("s_waitcnt lgkmcnt(0)" ::: "memory"); __builtin_amdgcn_s_barrier();
        }
        NLAS unsigned long long* selm = (NLAS unsigned long long*)(lds + L_SELM);
        const unsigned long long forced = 1ull | (1ull << qb) | (1ull << (qb - 1));
        const bool cand = (lane >= 1) && (lane <= qb - 2);
#pragma unroll 1
        for (int qq_ = 0; qq_ < 8 * NSA_REP_RANK; ++qq_) {
            const int qq = qq_ & 7;
            const int q = 8 * wv + qq;
            const float v = ((NLAS float*)(lds + L_IMP))[q * 64 + ((lane + q) & 63)];
            const unsigned vb = cand ? __float_as_uint(v) : 0u;
            unsigned thr = 0u;
#pragma unroll 1
            for (int bit = 30; bit >= 0; --bit) {
                const unsigned c2 = thr | (1u << bit);
                const int cnt = __popcll(__ballot(cand && vb >= c2));
                thr = (cnt >= 13) ? c2 : thr;
            }
            unsigned long long sel = __ballot(cand && vb > thr);
            unsigned long long eq = __ballot(cand && vb == thr);
            int need = 13 - __popcll(sel);
#pragma unroll 1
            for (; need > 0; --need) { const unsigned long long low = eq & (~eq + 1ull); sel |= low; eq ^= low; }
            if (lane == 0) selm[q] = sel | forced;
        }
        asm volatile("s_waitcnt lgkmcnt(0)" ::: "memory"); __builtin_amdgcn_s_barrier();
        selmask = selm[qi];
    }
    {
        u32x4 qraw[4];
#pragma unroll
        for (int ks = 0; ks < 4; ++ks) qraw[ks] = *(const u32x4*)(qrow + 16 * ks + 8 * h);
        const float4* cp = (const float4*)(P.cosT + (size_t)tok * 32 + 8 * h); const float4* sp = (const float4*)(P.sinT + (size_t)tok * 32 + 8 * h);
#pragma unroll
        for (int ks = 0; ks < 2; ++ks) {
            const float4 c0 = cp[4 * ks], c1 = cp[4 * ks + 1], s0 = sp[4 * ks], s1 = sp[4 * ks + 1];
            const float cs[8] = {c0.x, c0.y, c0.z, c0.w, c1.x, c1.y, c1.z, c1.w}, sn[8] = {s0.x, s0.y, s0.z, s0.w, s1.x, s1.y, s1.z, s1.w};
            u32x4 oa, ob;
#pragma unroll
            for (int c = 0; c < 4; ++c) {
                const float a0 = bflo(qraw[ks][c]), a1 = bfhi(qraw[ks][c]), b0 = bflo(qraw[ks + 2][c]), b1 = bfhi(qraw[ks + 2][c]);
                oa[c] = cvtpk((a0 * cs[2 * c] - b0 * sn[2 * c]) * QSCALE, (a1 * cs[2 * c + 1] - b1 * sn[2 * c + 1]) * QSCALE);
                ob[c] = cvtpk((b0 * cs[2 * c] + a0 * sn[2 * c]) * QSCALE, (b1 * cs[2 * c + 1] + a1 * sn[2 * c + 1]) * QSCALE);
            }
            qf[ks] = __builtin_bit_cast(bf16x8, oa); qf[ks + 2] = __builtin_bit_cast(bf16x8, ob);
        }
    }
    asm volatile("s_waitcnt vmcnt(0)" ::: "memory");
    f32x16 o0, o1;
    const bool lead = wv < 4;
    const float gs_keep = gs, gw_keep = gw;
#pragma unroll 1
    for (int repL = 0; repL < NSA_REP_LOOP; ++repL) {
    if (NSA_REP_LOOP > 1) { gs = (repL == NSA_REP_LOOP - 1) ? gs_keep : 0.f; gw = (repL == NSA_REP_LOOP - 1) ? gw_keep : 0.f;
        if (repL > 0) { asm volatile("s_waitcnt vmcnt(0)" ::: "memory"); __builtin_amdgcn_s_barrier(); NSA_ISSUE(0); NSA_ISSUE(1); asm volatile("s_waitcnt vmcnt(0)" ::: "memory"); } }
#pragma unroll
    for (int i = 0; i < 16; ++i) { o0[i] = 0.f; o1[i] = 0.f; }
    m = NEGBIG; l = 0.f;
    if (!lead) { asm volatile("s_waitcnt vmcnt(2)" ::: "memory"); __builtin_amdgcn_s_barrier(); }
#pragma unroll 1
    for (int pos = 0; pos < ntiles; ++pos) {
        if (lead) asm volatile("s_waitcnt vmcnt(2)" ::: "memory");
        __builtin_amdgcn_s_barrier();
        NSA_ISSUE(pos + 2);
        const NLAS unsigned char* slot = lds + L_RING + (pos & 3) * SLOTB;
        f32x16 s0, s1;
        const bool win = pos >= nsel; const int j = win ? jw0 + pos - nsel : pos;
        const float binit = (!win && !((selmask >> j) & 1ull)) ? NEGINF : 0.f;
        qk_tile(slot, qf, kofs, s0, s1, binit);
        if (j == qb) mask_tile<false>(s0, s1, qi - 4 * h, 0);
        else if (win && qb >= 8 && j == qb - 8) mask_tile<true>(s0, s1, 63, qi + 1 - 4 * h);
        softmax_core(s0, s1, m, l, o0, o1);
        if (!lead) asm volatile("s_waitcnt vmcnt(2)" ::: "memory");
        __builtin_amdgcn_s_barrier();
        pv_tile(slot + 8192, vofs, s0, s1, o0, o1);
        if (pos == nsel - 1) {
            const float L = l + xhalf(l); const float sc = (L > 0.f) ? gs / L : 0.f;
#pragma unroll
            for (int i = 0; i < 16; ++i) { of0[i] += sc * o0[i]; of1[i] += sc * o1[i]; o0[i] = 0.f; o1[i] = 0.f; }
            m = NEGBIG; l = 0.f;
        }
    }
    if (lead) __builtin_amdgcn_s_barrier();
    if (NSA_REP_LOOP > 1 && repL < NSA_REP_LOOP - 1) {
        const float L0 = l + xhalf(l); (void)L0; }
    if (repL == NSA_REP_LOOP - 1)    {
        float L = l + xhalf(l);
        const float npad = (t < 511) ? (float)(511 - t) : 0.f;
        const float m2 = (npad > 0.f) ? fmaxf(m, 0.f) : m;
        const float a = __builtin_amdgcn_exp2f(m - m2);
        L = L * a + npad * __builtin_amdgcn_exp2f(-m2);
        const float sc = (L > 0.f) ? gw * a / L : 0.f;
#pragma unroll
        for (int i = 0; i < 16; ++i) { of0[i] += sc * o0[i]; of1[i] += sc * o1[i]; }
    }
    }
    float ss = 0.f;
#pragma unroll
    for (int i = 0; i < 16; ++i) ss += of0[i] * of0[i] + of1[i] * of1[i];
    ss += xhalf(ss);
    const float rn = rsqrtf(ss * (1.0f / 64.0f) + 1e-6f);
    unsigned short* yrow = P.ycat + (size_t)tok * 1024 + 512 + head * 64;
    const float* nw = P.normw + head * 64;
#pragma unroll
    for (int mb = 0; mb < 2; ++mb)
#pragma unroll
        for (int u = 0; u < 4; ++u) {
            const int d0 = 32 * mb + 8 * u + 4 * h;
            const float4 w4 = *(const float4*)(nw + d0);
            const float v0 = (mb ? of1[4 * u] : of0[4 * u]) * rn * w4.x, v1 = (mb ? of1[4 * u + 1] : of0[4 * u + 1]) * rn * w4.y;
            const float v2 = (mb ? of1[4 * u + 2] : of0[4 * u + 2]) * rn * w4.z, v3 = (mb ? of1[4 * u + 3] : of0[4 * u + 3]) * rn * w4.w;
            *(uint2*)(yrow + d0) = make_uint2(cvtpk(v0, v1), cvtpk(v2, v3));
        }
    asm volatile("s_waitcnt vmcnt(0)" ::: "memory"); __builtin_amdgcn_s_barrier();
#undef NSA_DMA
#undef NSA_ISSUE
}
__device__ __forceinline__ void phase(const Params& P, NLAS unsigned char* lds, const int tid, const int bid, const int G) {
#pragma unroll 1
    for (int vw = bid; vw < 256; vw += G) {
        const int xcd = vw & 7, slot = vw >> 3, bg = xcd * 2 + (slot >> 4), rr = slot & 15;
#pragma unroll 1
        for (int k = 0; k < 4; ++k) { const int qb = (k == 0) ? 63 - rr : (k == 1) ? 32 + rr : (k == 2) ? 31 - rr : rr; unit(P, lds, tid, bg >> 1, bg & 1, qb); }
    }
}
}


namespace wt {
typedef short bf16x8 __attribute__((ext_vector_type(8)));
typedef float f32x16 __attribute__((ext_vector_type(16)));
typedef unsigned u32x4 __attribute__((ext_vector_type(4)));
typedef unsigned u32x2 __attribute__((ext_vector_type(2)));
typedef float f32x2_t __attribute__((ext_vector_type(2)));
typedef __bf16 bf16x2_t __attribute__((ext_vector_type(2)));
#define WT_MFMA(a, b, c) __builtin_amdgcn_mfma_f32_32x32x16_bf16((a), (b), (c), 0, 0, 0)
__device__ __forceinline__ unsigned cvtpk(float lo, float hi) { f32x2_t v = {lo, hi}; bf16x2_t b = __builtin_convertvector(v, bf16x2_t); return __builtin_bit_cast(unsigned, b); }
__device__ __forceinline__ float bflo(unsigned u) { return __uint_as_float(u << 16); }
__device__ __forceinline__ float bfhi(unsigned u) { return __uint_as_float(u & 0xffff0000u); }
__device__ __forceinline__ float xhalf(float v) { return __shfl_xor(v, 32); }
__device__ __forceinline__ bf16x8 ld16(const unsigned short* p) { return __builtin_bit_cast(bf16x8, *(const u32x4*)p); }
__device__ __forceinline__ bf16x8 ld8x2(const unsigned short* p0, const unsigned short* p1) { const u32x2 a = *(const u32x2*)p0, b = *(const u32x2*)p1; u32x4 u = {a.x, a.y, b.x, b.y}; return __builtin_bit_cast(bf16x8, u); }
__device__ __forceinline__ bf16x8 pack8(const f32x16& x, int s) {
    u32x4 u = {cvtpk(x[8 * s], x[8 * s + 1]), cvtpk(x[8 * s + 2], x[8 * s + 3]), cvtpk(x[8 * s + 4], x[8 * s + 5]), cvtpk(x[8 * s + 6], x[8 * s + 7])};
    return __builtin_bit_cast(bf16x8, u);
}
__device__ __forceinline__ float gelu_t(float x) { const float u = 0.7978845608028654f * (x + 0.044715f * x * x * x); const float e = __expf(2.0f * u); return 0.5f * x * (1.0f + (1.0f - 2.0f / (e + 1.0f))); }
__device__ __forceinline__ float sigm(float x) { return 1.0f / (1.0f + __expf(-x)); }
__device__ __forceinline__ void zero(f32x16& a) {
#pragma unroll
    for (int i = 0; i < 16; ++i) a[i] = 0.f;
}

__device__ __forceinline__ void gm_ln8(const unsigned short* __restrict__ hb, const float* __restrict__ lw, const float* __restrict__ lbias, unsigned short* __restrict__ vlnT, int t8, int lane) {
    const int tok0 = t8 * 8;
    const float4 w4 = *(const float4*)(lw + lane * 4), b4 = *(const float4*)(lbias + lane * 4);
    float o[4][8];
#pragma unroll
    for (int i = 0; i < 8; ++i) {
        const u32x2 v4 = *(const u32x2*)(hb + (size_t)(tok0 + i) * 3072 + 1280 + lane * 4);
        float v[4] = {gelu_t(bflo(v4.x)), gelu_t(bfhi(v4.x)), gelu_t(bflo(v4.y)), gelu_t(bfhi(v4.y))};
        float s = (v[0] + v[1]) + (v[2] + v[3]);
#pragma unroll
        for (int o2 = 1; o2 < 64; o2 <<= 1) s += __shfl_xor(s, o2);
        const float mean = s * (1.0f / 256.0f); float q = 0.f;
#pragma unroll
        for (int c = 0; c < 4; ++c) { v[c] -= mean; q += v[c] * v[c]; }
#pragma unroll
        for (int o2 = 1; o2 < 64; o2 <<= 1) q += __shfl_xor(q, o2);
        const float rstd = rsqrtf(q * (1.0f / 256.0f) + 1e-5f);
        o[0][i] = v[0] * rstd * w4.x + b4.x; o[1][i] = v[1] * rstd * w4.y + b4.y; o[2][i] = v[2] * rstd * w4.z + b4.z; o[3][i] = v[3] * rstd * w4.w + b4.w;
    }
    const int bc = tok0 >> 7, s0 = tok0 & 127;
#pragma unroll
    for (int c = 0; c < 4; ++c) {
        const int ch = lane * 4 + c, g = ch >> 6, cc = ch & 63;
        u32x4 u = {cvtpk(o[c][0], o[c][1]), cvtpk(o[c][2], o[c][3]), cvtpk(o[c][4], o[c][5]), cvtpk(o[c][6], o[c][7])};
        *(u32x4*)(vlnT + ((size_t)(bc * 4 + g) * 64 + cc) * 128 + s0) = u;
    }
}
__device__ __forceinline__ void gm_sp_task(const unsigned short* __restrict__ hb, const unsigned short* __restrict__ vlnT, const unsigned short* __restrict__ Wb, const float* __restrict__ bs,
                                           const float* __restrict__ normw, unsigned short* __restrict__ ycat, int task, int lane) {
    const int tb = task & 3, g = (task >> 2) & 3, bc = task >> 4, r = lane & 31, h = lane >> 5;
    const unsigned short* ap = vlnT + ((size_t)(bc * 4 + g) * 64 + r) * 128 + 8 * h;
    const unsigned short* bp = Wb + ((size_t)g * 128 + 32 * tb + r) * 128 + 8 * h;
    f32x16 a0, a1; zero(a0); zero(a1);
    const int nks = 2 * (tb + 1);
#pragma unroll 2
    for (int ks = 0; ks < nks; ++ks) {
        const bf16x8 bw = ld16(bp + 16 * ks);
        const bf16x8 v0 = ld16(ap + 16 * ks), v1 = ld16(ap + 32 * 128 + 16 * ks);
        a0 = WT_MFMA(v0, bw, a0); a1 = WT_MFMA(v1, bw, a1);
    }
    const int tl = 32 * tb + r, tok = bc * 128 + tl;
    const float bias = bs[g * 128 + tl];
    const unsigned short* up = hb + (size_t)tok * 3072 + 1024 + g * 64;
    float z[32]; float ss = 0.f;
#pragma unroll
    for (int cb = 0; cb < 2; ++cb)
#pragma unroll
        for (int u = 0; u < 4; ++u) {
            const int c0 = 32 * cb + 8 * u + 4 * h;
            const u32x2 uu = *(const u32x2*)(up + c0);
            const float uv[4] = {gelu_t(bflo(uu.x)), gelu_t(bfhi(uu.x)), gelu_t(bflo(uu.y)), gelu_t(bfhi(uu.y))};
#pragma unroll
            for (int k = 0; k < 4; ++k) { const float a = (cb ? a1[4 * u + k] : a0[4 * u + k]) + bias; const float zz = uv[k] * a; z[16 * cb + 4 * u + k] = zz; ss += zz * zz; }
        }
    ss += xhalf(ss);
    const float rn = rsqrtf(ss * (1.0f / 64.0f) + 1e-6f);
    unsigned short* yp = ycat + (size_t)tok * 1024 + 256 + g * 64;
    const float* nw = normw + g * 64;
#pragma unroll
    for (int cb = 0; cb < 2; ++cb)
#pragma unroll
        for (int u = 0; u < 4; ++u) {
            const int c0 = 32 * cb + 8 * u + 4 * h;
            const float4 w4 = *(const float4*)(nw + c0);
            u32x2 o = {cvtpk(z[16 * cb + 4 * u] * rn * w4.x, z[16 * cb + 4 * u + 1] * rn * w4.y), cvtpk(z[16 * cb + 4 * u + 2] * rn * w4.z, z[16 * cb + 4 * u + 3] * rn * w4.w)};
            *(u32x2*)(yp + c0) = o;
        }
}

#define WT_LAS __attribute__((address_space(3)))
__device__ __forceinline__ void cmp_wg(const unsigned short* __restrict__ hb, const unsigned short* __restrict__ w1t, const float* __restrict__ cbias, const unsigned short* __restrict__ w2t,
                                       unsigned short* __restrict__ kcb, unsigned short* __restrict__ vcb, WT_LAS float* red, int task, int wave, int lane) {
    const int cblk = task & 7, kv = (task >> 3) & 1, g = (task >> 4) & 1, b = task >> 5, r = lane & 31, h = lane >> 5;
    const int c = 32 * cblk + r; const int cl = c < 254 ? c : 254;
    const unsigned short* bp = hb + (size_t)(b * 4096 + 16 * cl) * 3072 + (kv ? 2176 : 2048) + g * 64 + 8 * h;
    const unsigned short* ap = w1t + ((size_t)kv * 128 + r) * 2048 + 8 * h;
    f32x16 acc[4];
#pragma unroll
    for (int nt = 0; nt < 4; ++nt) zero(acc[nt]);
#pragma unroll 4
    for (int kk = 0; kk < 16; ++kk) {
        const int ks = 16 * wave + kk;
        const bf16x8 bk = ld16(bp + (size_t)(ks >> 2) * 3072 + 16 * (ks & 3));
#pragma unroll
        for (int nt = 0; nt < 4; ++nt) acc[nt] = WT_MFMA(ld16(ap + (size_t)nt * 32 * 2048 + 16 * ks), bk, acc[nt]);
    }
#pragma unroll
    for (int nt = 0; nt < 4; ++nt)
#pragma unroll
        for (int i = 0; i < 16; ++i) red[(wave * 64 + nt * 16 + i) * 64 + lane] = acc[nt][i];
    asm volatile("s_waitcnt lgkmcnt(0)" ::: "memory"); __builtin_amdgcn_s_barrier();
#pragma unroll
    for (int q = 0; q < 8; ++q) {
        const int row = 8 * wave + q; float sacc = 0.f;
#pragma unroll
        for (int w2 = 0; w2 < 8; ++w2) sacc += red[(w2 * 64 + row) * 64 + lane];
        red[row * 64 + lane] = sacc;
    }
    asm volatile("s_waitcnt lgkmcnt(0)" ::: "memory"); __builtin_amdgcn_s_barrier();
    if (wave == 0) {
#pragma unroll
        for (int nt = 0; nt < 4; ++nt)
#pragma unroll
            for (int i = 0; i < 16; ++i) { const int n = 32 * nt + (i & 3) + 8 * (i >> 2) + 4 * h; acc[nt][i] = gelu_t(red[(nt * 16 + i) * 64 + lane] + cbias[kv * 128 + n]); }
        f32x16 o0, o1; zero(o0); zero(o1);
        const unsigned short* w2p = w2t + ((size_t)kv * 64 + r) * 128 + 4 * h;
#pragma unroll
        for (int nt = 0; nt < 4; ++nt)
#pragma unroll
            for (int s = 0; s < 2; ++s) {
                const bf16x8 pb = pack8(acc[nt], s);
                const unsigned short* wp = w2p + 32 * nt + 16 * s;
                o0 = WT_MFMA(ld8x2(wp, wp + 8), pb, o0);
                o1 = WT_MFMA(ld8x2(wp + 32 * 128, wp + 32 * 128 + 8), pb, o1);
            }
        if (c < 255) {
            unsigned short* op = (kv ? vcb : kcb) + ((size_t)(b * 2 + g) * 256 + c) * 64;
#pragma unroll
            for (int db = 0; db < 2; ++db)
#pragma unroll
                for (int u = 0; u < 4; ++u) {
                    const int d0 = 32 * db + 8 * u + 4 * h;
                    u32x2 o = {cvtpk(db ? o1[4 * u] : o0[4 * u], db ? o1[4 * u + 1] : o0[4 * u + 1]), cvtpk(db ? o1[4 * u + 2] : o0[4 * u + 2], db ? o1[4 * u + 3] : o0[4 * u + 3])};
                    *(u32x2*)(op + d0) = o;
                }
        }
    }
    __builtin_amdgcn_s_barrier();
}

__device__ __forceinline__ void kvprep8(const unsigned short* __restrict__ hb, const float* __restrict__ cosT, const float* __restrict__ sinT,
                                        unsigned short* __restrict__ ksb, unsigned short* __restrict__ vsb, unsigned short* __restrict__ kwb, unsigned short* __restrict__ vwb, int idx) {
    const int j8 = idx & 3, g = (idx >> 2) & 1, tok = idx >> 3, b = tok >> 12, t = tok & 4095;
    const unsigned short* hr = hb + (size_t)tok * 3072 + g * 64 + 8 * j8;
    const float4 c0 = *(const float4*)(cosT + (size_t)tok * 32 + 8 * j8), c1 = *(const float4*)(cosT + (size_t)tok * 32 + 8 * j8 + 4);
    const float4 s0 = *(const float4*)(sinT + (size_t)tok * 32 + 8 * j8), s1 = *(const float4*)(sinT + (size_t)tok * 32 + 8 * j8 + 4);
    const float cs[8] = {c0.x, c0.y, c0.z, c0.w, c1.x, c1.y, c1.z, c1.w}, sn[8] = {s0.x, s0.y, s0.z, s0.w, s1.x, s1.y, s1.z, s1.w};
    const size_t o = ((size_t)(b * 2 + g) * 4096 + t) * 64 + 8 * j8;
#pragma unroll
    for (int w = 0; w < 2; ++w) {
        const int col = w ? 2560 : 2304;
        const u32x4 a = *(const u32x4*)(hr + col), bq = *(const u32x4*)(hr + col + 32);
        u32x4 oa, ob;
#pragma unroll
        for (int c = 0; c < 4; ++c) {
            const float a0 = bflo(a[c]), a1 = bfhi(a[c]), b0 = bflo(bq[c]), b1 = bfhi(bq[c]);
            oa[c] = cvtpk(a0 * cs[2 * c] - b0 * sn[2 * c], a1 * cs[2 * c + 1] - b1 * sn[2 * c + 1]);
            ob[c] = cvtpk(b0 * cs[2 * c] + a0 * sn[2 * c], b1 * cs[2 * c + 1] + a1 * sn[2 * c + 1]);
        }
        unsigned short* kd = (w ? kwb : ksb) + o;
        *(u32x4*)kd = oa; *(u32x4*)(kd + 32) = ob;
        const int vcol = w ? 2688 : 2432;
        unsigned short* vd = (w ? vwb : vsb) + o;
        *(u32x4*)vd = *(const u32x4*)(hr + vcol); *(u32x4*)(vd + 32) = *(const u32x4*)(hr + vcol + 32);
    }
}

__device__ __forceinline__ void hg_pass1(const unsigned short* __restrict__ hb, const float* __restrict__ lbl, unsigned short* __restrict__ Qt, unsigned short* __restrict__ Kt,
                                         unsigned short* __restrict__ Qp, unsigned short* __restrict__ VT, float* __restrict__ Ut, float* __restrict__ Dk, int ci, int lane) {
    const int chunk = ci & 63, hd = (ci >> 6) & 3, b = ci >> 8;
    const unsigned short* hp = hb + (size_t)(b * 4096 + chunk * 64) * 3072 + hd * 64 + lane;
    const float lb = lbl[hd * 64 + lane];
    float run = 0.f, cmid = 0.f;
#pragma unroll 8
    for (int t = 0; t < 64; ++t) {
        const float fr = __uint_as_float((unsigned)hp[(size_t)t * 3072 + 256] << 16);
        run += __logf(lb + (1.0f - lb) * sigm(fr));
        cmid = (t == 31) ? run : cmid;
    }
    const float blast = run;
    Dk[(size_t)ci * 64 + lane] = __expf(blast);
    unsigned short* qt = Qt + (size_t)ci * 4096 + lane; unsigned short* kt = Kt + (size_t)ci * 4096 + lane; unsigned short* qp = Qp + (size_t)ci * 4096 + lane;
    unsigned short* vt = VT + (size_t)ci * 4096 + lane * 64;
    const int h = lane >> 5, r = lane & 31;
    f32x16 acc[2][2];
#pragma unroll
    for (int a = 0; a < 2; ++a)
#pragma unroll
        for (int c = 0; c < 2; ++c) zero(acc[a][c]);
    float bt = 0.f;
#pragma unroll 1
    for (int ks = 0; ks < 4; ++ks) {
        unsigned kp[8], vp[8];
#pragma unroll
        for (int tp = 0; tp < 8; ++tp) {
            float k2v[2], ivv[2];
#pragma unroll
            for (int e = 0; e < 2; ++e) {
                const int t = ks * 16 + tp * 2 + e;
                const float qr = __uint_as_float((unsigned)hp[(size_t)t * 3072] << 16), fr = __uint_as_float((unsigned)hp[(size_t)t * 3072 + 256] << 16);
                ivv[e] = __uint_as_float((unsigned)hp[(size_t)t * 3072 + 512] << 16);
                const float sf = sigm(fr);
                const float q = qr * sigm(qr), kk = (1.0f - lb) * (1.0f - sf);
                bt += __logf(lb + (1.0f - lb) * sf);
                qt[t * 64] = (unsigned short)(cvtpk(q * __expf(bt - cmid), 0.f) & 0xffffu);
                kt[t * 64] = (unsigned short)(cvtpk(kk * __expf(cmid - bt), 0.f) & 0xffffu);
                qp[t * 64] = (unsigned short)(cvtpk(q * __expf(bt), 0.f) & 0xffffu);
                k2v[e] = kk * __expf(blast - bt);
            }
            kp[tp] = cvtpk(k2v[0], k2v[1]); vp[tp] = cvtpk(ivv[0], ivv[1]);
        }
        { u32x4 u0 = {vp[0], vp[1], vp[2], vp[3]}, u1 = {vp[4], vp[5], vp[6], vp[7]};
          *(u32x4*)(vt + ks * 16) = u0; *(u32x4*)(vt + ks * 16 + 8) = u1; }
        u32x4 kown, vown, ksnd, vsnd;
#pragma unroll
        for (int j = 0; j < 4; ++j) { kown[j] = h ? kp[4 + j] : kp[j]; ksnd[j] = h ? kp[j] : kp[4 + j]; vown[j] = h ? vp[4 + j] : vp[j]; vsnd[j] = h ? vp[j] : vp[4 + j]; }
        u32x4 krcv, vrcv;
#pragma unroll
        for (int j = 0; j < 4; ++j) { krcv[j] = (unsigned)__shfl_xor((int)ksnd[j], 32); vrcv[j] = (unsigned)__shfl_xor((int)vsnd[j], 32); }
        const bf16x8 kb0 = __builtin_bit_cast(bf16x8, h ? krcv : kown), kb1 = __builtin_bit_cast(bf16x8, h ? kown : krcv);
        const bf16x8 va0 = __builtin_bit_cast(bf16x8, h ? vrcv : vown), va1 = __builtin_bit_cast(bf16x8, h ? vown : vrcv);
        acc[0][0] = WT_MFMA(va0, kb0, acc[0][0]); acc[0][1] = WT_MFMA(va0, kb1, acc[0][1]);
        acc[1][0] = WT_MFMA(va1, kb0, acc[1][0]); acc[1][1] = WT_MFMA(va1, kb1, acc[1][1]);
    }
    float* up = Ut + (size_t)ci * 4096;
#pragma unroll
    for (int vb = 0; vb < 2; ++vb)
#pragma unroll
        for (int kb = 0; kb < 2; ++kb)
#pragma unroll
            for (int i = 0; i < 16; ++i) { const int v = 32 * vb + (i & 3) + 8 * (i >> 2) + 4 * h; up[v * 64 + 32 * kb + r] = acc[vb][kb][i]; }
}
__device__ __forceinline__ void hg_scan(const float* __restrict__ Ut, const float* __restrict__ Dk, unsigned short* __restrict__ ST, int e) {
    const int k = e & 63, seq = e >> 12, vk = e & 4095;
    float S = 0.f;
    const float* up = Ut + (size_t)seq * 64 * 4096 + vk; const float* dp = Dk + (size_t)seq * 64 * 64 + k; unsigned short* sp = ST + (size_t)seq * 64 * 4096 + vk;
#pragma unroll 8
    for (int c = 0; c < 64; ++c) {
        sp[(size_t)c * 4096] = (unsigned short)(cvtpk(S, 0.f) & 0xffffu);
        S = fmaf(dp[c * 64], S, up[(size_t)c * 4096]);
    }
}
__device__ __forceinline__ void hg_pass3(const unsigned short* __restrict__ hb, const unsigned short* __restrict__ Qt, const unsigned short* __restrict__ Kt, const unsigned short* __restrict__ Qp,
                                         const unsigned short* __restrict__ VT, const unsigned short* __restrict__ ST, const float* __restrict__ normw, unsigned short* __restrict__ ycat, int task, int lane) {
    const int tblk = task & 1, ci = task >> 1, chunk = ci & 63, hd = (ci >> 6) & 3, b = ci >> 8, r = lane & 31, h = lane >> 5;
    const size_t cb = (size_t)ci * 4096;
    f32x16 o0, o1; zero(o0); zero(o1);
    {
        const unsigned short* sp = ST + cb + (size_t)r * 64 + 8 * h; const unsigned short* qp = Qp + cb + (size_t)(32 * tblk + r) * 64 + 8 * h;
#pragma unroll
        for (int ks = 0; ks < 4; ++ks) { const bf16x8 q = ld16(qp + 16 * ks); o0 = WT_MFMA(ld16(sp + 16 * ks), q, o0); o1 = WT_MFMA(ld16(sp + 32 * 64 + 16 * ks), q, o1); }
    }
    const unsigned short* qtp = Qt + cb + (size_t)(32 * tblk + r) * 64 + 8 * h;
    bf16x8 qf[4];
#pragma unroll
    for (int ks = 0; ks < 4; ++ks) qf[ks] = ld16(qtp + 16 * ks);
#pragma unroll 1
    for (int sblk = 0; sblk <= tblk; ++sblk) {
        f32x16 at; zero(at);
        const unsigned short* ktp = Kt + cb + (size_t)(32 * sblk + r) * 64 + 8 * h;
#pragma unroll
        for (int ks = 0; ks < 4; ++ks) at = WT_MFMA(ld16(ktp + 16 * ks), qf[ks], at);
        if (sblk == tblk) {
#pragma unroll
            for (int i = 0; i < 16; ++i) { const int sl = (i & 3) + 8 * (i >> 2) + 4 * h; at[i] = (sl <= r) ? at[i] : 0.f; }
        }
#pragma unroll
        for (int s2 = 0; s2 < 2; ++s2) {
            const bf16x8 pb = pack8(at, s2);
            const unsigned short* vp = VT + cb + (size_t)r * 64 + 32 * sblk + 16 * s2 + 4 * h;
            o0 = WT_MFMA(ld8x2(vp, vp + 8), pb, o0);
            o1 = WT_MFMA(ld8x2(vp + 32 * 64, vp + 32 * 64 + 8), pb, o1);
        }
    }
    const int tok = b * 4096 + chunk * 64 + 32 * tblk + r;
    float ss = 0.f;
#pragma unroll
    for (int i = 0; i < 16; ++i) ss += o0[i] * o0[i] + o1[i] * o1[i];
    ss += xhalf(ss);
    const float rn = rsqrtf(ss * (1.0f / 64.0f) + 1e-6f);
    const unsigned short* gp = hb + (size_t)tok * 3072 + 768 + hd * 64;
    unsigned short* yp = ycat + (size_t)tok * 1024 + hd * 64;
    const float* nw = normw + hd * 64;
#pragma unroll
    for (int vb = 0; vb < 2; ++vb)
#pragma unroll
        for (int u = 0; u < 4; ++u) {
            const int v0 = 32 * vb + 8 * u + 4 * h;
            const u32x2 gg = *(const u32x2*)(gp + v0); const float4 w4 = *(const float4*)(nw + v0);
            const float x0 = (vb ? o1[4 * u] : o0[4 * u]) * rn * w4.x * sigm(bflo(gg.x)), x1 = (vb ? o1[4 * u + 1] : o0[4 * u + 1]) * rn * w4.y * sigm(bfhi(gg.x));
            const float x2 = (vb ? o1[4 * u + 2] : o0[4 * u + 2]) * rn * w4.z * sigm(bflo(gg.y)), x3 = (vb ? o1[4 * u + 3] : o0[4 * u + 3]) * rn * w4.w * sigm(bfhi(gg.y));
            u32x2 o = {cvtpk(x0, x1), cvtpk(x2, x3)};
            *(u32x2*)(yp + v0) = o;
        }
}

__device__ __forceinline__ void route_task(const float* __restrict__ x1, const unsigned short* __restrict__ rwh, const unsigned short* __restrict__ rwl, const float* __restrict__ rb,
                                           int* __restrict__ cnt, int* __restrict__ list, int* __restrict__ tok_e, int* __restrict__ tok_slot, float* __restrict__ tok_w, int task, int lane) {
    const int r = lane & 31, h = lane >> 5, tok = task * 32 + r;
    const float* xp = x1 + (size_t)tok * 1024 + 8 * h;
    const unsigned short* whp = rwh + (size_t)r * 1024 + 8 * h; const unsigned short* wlp = rwl + (size_t)r * 1024 + 8 * h;
    f32x16 acc; zero(acc);
#pragma unroll 4
    for (int ks = 0; ks < 64; ++ks) {
        const float4 a = *(const float4*)(xp + 16 * ks), b = *(const float4*)(xp + 16 * ks + 4);
        const float xv[8] = {a.x, a.y, a.z, a.w, b.x, b.y, b.z, b.w};
        u32x4 uh, ul;
#pragma unroll
        for (int c = 0; c < 4; ++c) {
            const unsigned hp = cvtpk(xv[2 * c], xv[2 * c + 1]);
            uh[c] = hp; ul[c] = cvtpk(xv[2 * c] - bflo(hp), xv[2 * c + 1] - bfhi(hp));
        }
        const bf16x8 xh = __builtin_bit_cast(bf16x8, uh), xl = __builtin_bit_cast(bf16x8, ul);
        const bf16x8 wh = ld16(whp + 16 * ks), wl = ld16(wlp + 16 * ks);
        acc = WT_MFMA(wh, xh, acc); acc = WT_MFMA(wh, xl, acc); acc = WT_MFMA(wl, xh, acc);
    }
    float v[16];
#pragma unroll
    for (int i = 0; i < 16; ++i) v[i] = acc[i] + rb[(i & 3) + 8 * (i >> 2) + 4 * h];
    float cv[8]; int ce[8];
#pragma unroll
    for (int k = 0; k < 4; ++k) {
        float best = -3.0e38f; int bi = 0;
#pragma unroll
        for (int i = 0; i < 16; ++i) { const bool ok = v[i] > best; best = ok ? v[i] : best; bi = ok ? i : bi; }
#pragma unroll
        for (int i = 0; i < 16; ++i) v[i] = (i == bi) ? -3.0e38f : v[i];
        cv[k] = best; ce[k] = (bi & 3) + 8 * (bi >> 2) + 4 * h;
    }
#pragma unroll
    for (int k = 0; k < 4; ++k) { cv[4 + k] = xhalf(cv[k]); ce[4 + k] = __shfl_xor(ce[k], 32); }
    float tl[4]; int te[4];
#pragma unroll
    for (int k = 0; k < 4; ++k) {
        float best = -3.0e38f; int be = 64, bj = 0;
#pragma unroll
        for (int j = 0; j < 8; ++j) { const bool ok = (cv[j] > best) || (cv[j] == best && ce[j] < be); best = ok ? cv[j] : best; be = ok ? ce[j] : be; bj = ok ? j : bj; }
#pragma unroll
        for (int j = 0; j < 8; ++j) cv[j] = (j == bj) ? -3.0e38f : cv[j];
        tl[k] = best; te[k] = be;
    }
    const float e1 = __expf(tl[1] - tl[0]), e2 = __expf(tl[2] - tl[0]), e3 = __expf(tl[3] - tl[0]);
    const float inv = 1.0f / (1.0f + e1 + e2 + e3);
    const float tw[4] = {inv, e1 * inv, e2 * inv, e3 * inv};
    unsigned mymask = 0u;
#pragma unroll 1
    for (int e = 0; e < 32; ++e) {
        const unsigned mk = (unsigned)__ballot(h == 0 && (te[0] == e || te[1] == e || te[2] == e || te[3] == e));
        mymask = (lane == e) ? mk : mymask;
    }
    int base = 0;
    if (lane < 32 && mymask != 0u) base = atomicAdd(&cnt[lane], __popc(mymask));
#pragma unroll
    for (int k = 0; k < 4; ++k) {
        const int bk = __shfl(base, te[k]); const unsigned mk = (unsigned)__shfl((int)mymask, te[k]);
        const int slot = bk + __popc(mk & ((1u << r) - 1u));
        if (h == 0) { list[te[k] * 32768 + slot] = tok; tok_e[tok * 4 + k] = te[k]; tok_slot[tok * 4 + k] = slot; tok_w[tok * 4 + k] = tw[k]; }
    }
}
}


__device__ __forceinline__ void ln1_tok(const float* __restrict__ xin, const bf16* __restrict__ mix, const float* __restrict__ lw, const float* __restrict__ lbias,
                                        float* __restrict__ x1, bf16* __restrict__ x1b, int tok, int lane) {
    float v[16]; float s = 0.f;
#pragma unroll
    for (int j = 0; j < 4; ++j) {
        float4 a = *(const float4*)(xin + (size_t)tok * D_ + j * 256 + lane * 4);
        uint2 mb = *(const uint2*)(mix + (size_t)tok * D_ + j * 256 + lane * 4);
        float4 m = make_float4(__uint_as_float(mb.x << 16), __uint_as_float(mb.x & 0xffff0000u), __uint_as_float(mb.y << 16), __uint_as_float(mb.y & 0xffff0000u));
        v[4 * j] = ALPHA * a.x + m.x; v[4 * j + 1] = ALPHA * a.y + m.y; v[4 * j + 2] = ALPHA * a.z + m.z; v[4 * j + 3] = ALPHA * a.w + m.w;
        s += v[4 * j] + v[4 * j + 1] + v[4 * j + 2] + v[4 * j + 3];
    }
    float mean = wsum(s) * (1.0f / D_); float q = 0.f;
#pragma unroll
    for (int i = 0; i < 16; ++i) { v[i] -= mean; q += v[i] * v[i]; }
    float rstd = rsqrtf(wsum(q) * (1.0f / D_) + 1e-5f);
#pragma unroll
    for (int j = 0; j < 4; ++j) {
        float4 w4 = *(const float4*)(lw + j * 256 + lane * 4), b4 = *(const float4*)(lbias + j * 256 + lane * 4);
        float4 o = make_float4(v[4 * j] * rstd * w4.x + b4.x, v[4 * j + 1] * rstd * w4.y + b4.y, v[4 * j + 2] * rstd * w4.z + b4.z, v[4 * j + 3] * rstd * w4.w + b4.w);
        *(float4*)(x1 + (size_t)tok * D_ + j * 256 + lane * 4) = o;
        *(uint2*)(x1b + (size_t)tok * D_ + j * 256 + lane * 4) = make_uint2(pk2(o.x, o.y), pk2(o.z, o.w));
    }
}
__device__ __forceinline__ void comb_ln2_tok(const float* __restrict__ x1, const bf16* __restrict__ y, const int* __restrict__ offs, const int* __restrict__ tok_e,
                                             const int* __restrict__ tok_slot, const float* __restrict__ tok_w, const float* __restrict__ lw, const float* __restrict__ lbias,
                                             float* __restrict__ xout, bf16* __restrict__ xbout, int tok, int lane) {
    float v[16];
#pragma unroll
    for (int j = 0; j < 4; ++j) { float4 a = *(const float4*)(x1 + (size_t)tok * D_ + j * 256 + lane * 4);
        v[4 * j] = ALPHA * a.x; v[4 * j + 1] = ALPHA * a.y; v[4 * j + 2] = ALPHA * a.z; v[4 * j + 3] = ALPHA * a.w; }
#pragma unroll
    for (int k = 0; k < 4; ++k) {
        int e = tok_e[tok * 4 + k]; int row = offs[e] + tok_slot[tok * 4 + k]; float wk = tok_w[tok * 4 + k];
#pragma unroll
        for (int j = 0; j < 4; ++j) { uint2 ab = *(const uint2*)(y + (size_t)row * D_ + j * 256 + lane * 4);
            float4 a = make_float4(__uint_as_float(ab.x << 16), __uint_as_float(ab.x & 0xffff0000u), __uint_as_float(ab.y << 16), __uint_as_float(ab.y & 0xffff0000u));
            v[4 * j] = fmaf(wk, a.x, v[4 * j]); v[4 * j + 1] = fmaf(wk, a.y, v[4 * j + 1]); v[4 * j + 2] = fmaf(wk, a.z, v[4 * j + 2]); v[4 * j + 3] = fmaf(wk, a.w, v[4 * j + 3]); }
    }
    float s = 0.f;
#pragma unroll
    for (int i = 0; i < 16; ++i) s += v[i];
    float mean = wsum(s) * (1.0f / D_); float q = 0.f;
#pragma unroll
    for (int i = 0; i < 16; ++i) { v[i] -= mean; q += v[i] * v[i]; }
    float rstd = rsqrtf(wsum(q) * (1.0f / D_) + 1e-5f);
#pragma unroll
    for (int j = 0; j < 4; ++j) {
        float4 w4 = *(const float4*)(lw + j * 256 + lane * 4), b4 = *(const float4*)(lbias + j * 256 + lane * 4);
        float4 o = make_float4(v[4 * j] * rstd * w4.x + b4.x, v[4 * j + 1] * rstd * w4.y + b4.y, v[4 * j + 2] * rstd * w4.z + b4.z, v[4 * j + 3] * rstd * w4.w + b4.w);
        *(float4*)(xout + (size_t)tok * D_ + j * 256 + lane * 4) = o;
        if (xbout) *(uint2*)(xbout + (size_t)tok * D_ + j * 256 + lane * 4) = make_uint2(pk2(o.x, o.y), pk2(o.z, o.w));
    }
}

struct Args { const float* in[25]; float* out; unsigned char* ws; int ph_lo, ph_hi; };
#define PH __device__ __forceinline__
constexpr int TAB_OFF = 131072;

__device__ __forceinline__ void transpose_item(const float* __restrict__ W, int K, int N, bf16* __restrict__ WT, int k0, int scol0, int drow0, float* scr, int lane) {
    const int cc = lane & 31; const bool cv = (scol0 + cc) < N;
#pragma unroll 8
    for (int i = 0; i < 32; ++i) { const int kk = 2 * i + (lane >> 5); scr[kk * 33 + cc] = cv ? W[(size_t)(k0 + kk) * N + scol0 + cc] : 0.f; }
    asm volatile("s_waitcnt lgkmcnt(0)" ::: "memory");
    const int c = lane & 7;
#pragma unroll
    for (int j = 0; j < 4; ++j) { const int n = (lane >> 3) + 8 * j; const float* s = scr + (8 * c) * 33 + n;
        uint4 o; o.x = pk2(s[0 * 33], s[1 * 33]); o.y = pk2(s[2 * 33], s[3 * 33]); o.z = pk2(s[4 * 33], s[5 * 33]); o.w = pk2(s[6 * 33], s[7 * 33]);
        *(uint4*)(WT + (size_t)(drow0 + n) * K + k0 + 8 * c) = o; }
    asm volatile("s_waitcnt lgkmcnt(0)" ::: "memory");
}
__device__ __forceinline__ void transpose64(const float* __restrict__ W, int K, int N, bf16* __restrict__ WT, int k0, int scol0, int drow0, int lane) {
    const int q = lane >> 4, c = lane & 15;
    const bool cv = (scol0 + 4 * c) < N;
    const float* src = W + (size_t)(k0 + 16 * q) * N + scol0 + 4 * c;
    float4 v[16];
#pragma unroll
    for (int i = 0; i < 16; ++i) v[i] = cv ? *(const float4*)(src + (size_t)i * N) : make_float4(0.f, 0.f, 0.f, 0.f);
    bf16* dst = WT + (size_t)(drow0 + 4 * c) * K + k0 + 16 * q;
#pragma unroll
    for (int j = 0; j < 4; ++j) {
        float e[16];
#pragma unroll
        for (int i = 0; i < 16; ++i) e[i] = (j == 0) ? v[i].x : (j == 1) ? v[i].y : (j == 2) ? v[i].z : v[i].w;
        uint4 o0, o1;
        o0.x = pk2(e[0], e[1]); o0.y = pk2(e[2], e[3]); o0.z = pk2(e[4], e[5]); o0.w = pk2(e[6], e[7]);
        o1.x = pk2(e[8], e[9]); o1.y = pk2(e[10], e[11]); o1.z = pk2(e[12], e[13]); o1.w = pk2(e[14], e[15]);
        *(uint4*)(dst + (size_t)j * K) = o0; *(uint4*)(dst + (size_t)j * K + 8) = o1;
    }
}
PH void ph_prologue(int wv, const int* pos, const float* hg_lb, float* cosT, float* sinT, float* lb,
                    const float* x, bf16* xb, const float* w_in, const float* w_out, const float* w_up, const float* w_dn, bf16* wt_in, bf16* wt_out, bf16* wt_up, bf16* wt_dn,
                    const float* gm_sw, bf16* wb, const float* cpe, const float* cw1, bf16* w1t, float* cbias, const float* cw2, bf16* w2t, const float* rw, bf16* rwh, bf16* rwl) {
    extern __shared__ __attribute__((aligned(16))) unsigned char lds[];
    int tid = mk_tid(wv), bid = blockIdx.x; asm volatile("" : "+v"(tid), "+s"(bid)); const int G = gridDim.x, lane = tid & 63, wave = wv;
#pragma unroll 1
    for (int i = bid * NTHR + tid; i < NT * 32; i += G * NTHR) {
        int t = i >> 5, j = i & 31;
        float inv = (float)pow(10000.0, -(double)(2 * j) / 64.0);
        float ang = (float)pos[t] * inv;
        double ad = (double)ang;
        cosT[i] = (float)cos(ad); sinT[i] = (float)sin(ad);
    }
    if (bid == 0 && tid < 256) {
        float p0 = hg_lb[tid], p1 = hg_lb[256 + tid];
        float m = fmaxf(p0, p1); float ea = expf(p0 - m), eb = expf(p1 - m);
        lb[tid] = 0.f; lb[256 + tid] = eb / (ea + eb);
    }
#pragma unroll 1
    for (size_t i = (size_t)bid * NTHR + tid; i < (size_t)NT * D_ / 4; i += (size_t)G * NTHR) {
        float4 v = ((const float4*)x)[i]; ((uint2*)xb)[i] = make_uint2(pk2(v.x, v.y), pk2(v.z, v.w));
    }
#pragma unroll 1
    for (int i = bid * NTHR + tid; i < DEPTH * NE * D_; i += G * NTHR) { const int k = i & 1023, e = (i >> 10) & 31, l = i >> 15; const float w = rw[((size_t)l * D_ + k) * NE + e];
        const unsigned hi = f2bf(w); rwh[i] = (bf16)hi; rwl[i] = (bf16)f2bf(w - __uint_as_float(hi << 16)); }
#pragma unroll 1
    for (int i = bid * NTHR + tid; i < DEPTH * 4 * 128 * 128; i += G * NTHR) { const int s = i & 127, t = (i >> 7) & 127; wb[i] = (bf16)f2bf(s <= t ? gm_sw[i] : 0.f); }
    if (bid == (G > 1 ? 1 : 0)) {
        const int lk = tid >> 7, n = tid & 127;
        float a = 0.f;
#pragma unroll 4
        for (int i = 0; i < 2048; ++i) a = fmaf(cpe[lk * 2048 + i], cw1[((size_t)lk * 2048 + i) * 128 + n], a);
        cbias[lk * 128 + n] = a;
    }
    float* scr = (float*)(lds + wave * 16384);
    const int gw = bid * 8 + wave, NGW = G * 8;
    constexpr int I_IN = 16 * 45, I_OUT = 16 * 16;
    constexpr int I_C1 = 32 * 4;
    constexpr int I_C2 = 2 * 2;
    constexpr int PER_L = I_IN + I_OUT + 2 * I_C1 + 2 * I_C2;
#pragma unroll 1
    for (int it = gw; it < DEPTH * PER_L; it += NGW) {
        const int l = it / PER_L; int r = it % PER_L;
        if (r < I_IN) { const int kb = r / 45, nb = r % 45; transpose64(w_in + (size_t)l * D_ * INW, D_, INW, wt_in + (size_t)l * HS * D_, kb * 64, nb * 64, nb * 64, lane); continue; }
        r -= I_IN;
        if (r < I_OUT) { const int kb = r / 16, nb = r % 16; transpose64(w_out + (size_t)l * D_ * D_, D_, D_, wt_out + (size_t)l * D_ * D_, kb * 64, nb * 64, nb * 64, lane); continue; }
        r -= I_OUT;
        if (r < 2 * I_C1) { const int kv = r / I_C1, q = r % I_C1, kb = q / 4, nb = q % 4;
            transpose_item(cw1 + ((size_t)l * 2 + kv) * 2048 * 128, 2048, 128, w1t + ((size_t)l * 2 + kv) * 128 * 2048, kb * 64, nb * 32, nb * 32, scr, lane); continue; }
        r -= 2 * I_C1;
        { const int kv = r / I_C2, q = r % I_C2, kb = q / 2, nb = q % 2;
            transpose_item(cw2 + ((size_t)l * 2 + kv) * 128 * 64, 128, 64, w2t + ((size_t)l * 2 + kv) * 64 * 128, kb * 64, nb * 32, nb * 32, scr, lane); }
    }
}
#define M1EN(x) 1
#ifndef M1REP
#define M1R(x) 1
#else
#define M1R(x) (((x) == M1REP) ? 3 : 1)
#endif
PH void ph_mix1(int wv, const bf16* hb, const float* lb, bf16* hqt, bf16* hkt, bf16* hqp, bf16* hvt, float* hut, float* hdk,
                const float* glw, const float* glb, bf16* vlnT, const bf16* w1t, const float* cbias, const bf16* w2, bf16* kcb, bf16* vcb,
                const float* cosT, const float* sinT, bf16* ksb, bf16* vsb, bf16* kwb, bf16* vwb,
                const float* w_up, const float* w_dn, bf16* wt_up, bf16* wt_dn) {
    extern __shared__ __attribute__((aligned(16))) unsigned char lds[];
    int tid = mk_tid(wv), bid = blockIdx.x; asm volatile("" : "+v"(tid), "+s"(bid)); const int lane = tid & 63, wave = wv, G = gridDim.x;
    const int gw = bid * 8 + wave, NGW = G * 8;
    { int ln = lane; asm volatile("" : "+v"(ln));
#pragma unroll 1
    for (int rp = 0; rp < M1R(1); ++rp)
#pragma unroll 1
    for (int u = bid; u < 256 && M1EN(1); u += G) wt::cmp_wg(hb, w1t, cbias, w2, kcb, vcb, (WT_LAS float*)lds, u, wave, ln); }
    { int ln = lane; asm volatile("" : "+v"(ln));
#pragma unroll 1
    for (int rp = 0; rp < M1R(2); ++rp)
#pragma unroll 1
    for (int u = gw; u < 2048 && M1EN(2); u += NGW) wt::hg_pass1(hb, lb, hqt, hkt, hqp, hvt, hut, hdk, u, ln); }
    { int ln = lane; asm volatile("" : "+v"(ln));
#pragma unroll 1
    for (int rp = 0; rp < M1R(4); ++rp)
#pragma unroll 1
    for (int u = gw; u < NT / 8 && M1EN(4); u += NGW) wt::gm_ln8(hb, glw, glb, vlnT, u, ln); }
#pragma unroll 1
    for (int rp = 0; rp < M1R(8); ++rp)
#pragma unroll 1
    for (int idx = bid * NTHR + tid; idx < NT * 8; idx += G * NTHR) wt::kvprep8(hb, cosT, sinT, ksb, vsb, kwb, vwb, idx);
    { int ln = lane; asm volatile("" : "+v"(ln));
      constexpr int I_UP = 16 * 32, I_DN = 16 * 16;
#pragma unroll 1
      for (int rp = 0; rp < M1R(16); ++rp)
#pragma unroll 1
      for (int it = gw; it < NE * (I_UP + I_DN); it += NGW) {
          int r = it;
          if (r < NE * I_UP) { const int e = r / I_UP, q = r % I_UP, kb = q / 32, nb = q % 32;
              const int n0 = nb * 64, pn = n0 >> 8, bj = (n0 >> 7) & 1, jj = n0 & 127;
              transpose64(w_up + (size_t)e * D_ * 2048, D_, 2048, wt_up + (size_t)e * 2048 * D_, kb * 64, bj * 1024 + 128 * pn + jj, n0, ln); continue; }
          r -= NE * I_UP;
          { const int e = r / I_DN, q = r % I_DN, kb = q / 16, nb = q % 16;
              transpose64(w_dn + (size_t)e * D_ * D_, D_, D_, wt_dn + (size_t)e * D_ * D_, kb * 64, nb * 64, nb * 64, ln); }
      } }
}
PH void ph_mix2(int wv, const float* hut, const float* hdk, bf16* hst, const bf16* hb, const bf16* vlnT, const bf16* wb, const float* sb, const float* nw, bf16* ycat) {
    int tid = mk_tid(wv), bid = blockIdx.x; asm volatile("" : "+v"(tid), "+s"(bid)); const int lane = tid & 63, wave = wv, G = gridDim.x;
#pragma unroll 1
    for (int e = bid * NTHR + tid; e < 32 * 4096; e += G * NTHR) wt::hg_scan(hut, hdk, hst, e);
    const int gw = bid * 8 + wave, NGW = G * 8;
#pragma unroll 1
    for (int u = gw; u < 4096; u += NGW) wt::gm_sp_task(hb, vlnT, wb, sb, nw, ycat, u, lane);
}
PH void ph_hg3(int wv, const bf16* hb, const bf16* hqt, const bf16* hkt, const bf16* hqp, const bf16* hvt, const bf16* hst, const float* nw, bf16* ycat) {
    int tid = mk_tid(wv), bid = blockIdx.x; asm volatile("" : "+v"(tid), "+s"(bid)); const int lane = tid & 63, wave = wv, G = gridDim.x;
    const int gw = bid * 8 + wave, NGW = G * 8;
#pragma unroll 1
    for (int u = gw; u < 4096; u += NGW) wt::hg_pass3(hb, hqt, hkt, hqp, hvt, hst, nw, ycat, u, lane);
}
PH void ph_ln1(int wv, const float* xin, const bf16* mix, const float* lw, const float* lb, float* x1, bf16* x1b) {
    int tid = mk_tid(wv), bid = blockIdx.x; asm volatile("" : "+v"(tid), "+s"(bid)); const int lane = tid & 63, wave = wv, G = gridDim.x;
#pragma unroll 1
    for (int t = bid * 8 + wave; t < NT; t += G * 8) ln1_tok(xin, mix, lw, lb, x1, x1b, t, lane);
}
PH void ph_route(int wv, const float* x1, const bf16* rwh, const bf16* rwl, const float* rb, int* cnt, int* list, int* tok_e, int* tok_slot, float* tok_w) {
    int tid = mk_tid(wv), bid = blockIdx.x; asm volatile("" : "+v"(tid), "+s"(bid)); const int lane = tid & 63, wave = wv, G = gridDim.x;
#pragma unroll 1
    for (int u = bid * 8 + wave; u < NT / 32; u += G * 8) wt::route_task(x1, rwh, rwl, rb, cnt, list, tok_e, tok_slot, tok_w, u, lane);
}
PH void ph_comb(int wv, const float* x1, const bf16* ybuf, const int* tok_e, const int* tok_slot, const float* tok_w, const float* lw, const float* lb, float* xo, bf16* xbo) {
    extern __shared__ __attribute__((aligned(16))) unsigned char lds[];
    const int* offs_s = (const int*)(lds + TAB_OFF + 512);
    int tid = mk_tid(wv), bid = blockIdx.x; asm volatile("" : "+v"(tid), "+s"(bid)); const int lane = tid & 63, wave = wv, G = gridDim.x;
#pragma unroll 1
    for (int t = bid * 8 + wave; t < NT; t += G * 8) comb_ln2_tok(x1, ybuf, offs_s, tok_e, tok_slot, tok_w, lw, lb, xo, xbo, t, lane);
}

typedef const Args __attribute__((address_space(4))) CArgs;
#define PHASE_BEGIN CArgs* ap = (CArgs*)__builtin_amdgcn_kernarg_segment_ptr(); int l_ = l; asm volatile("" : "+s"(ap), "+s"(l_)); unsigned char* const ws_ = ap->ws; \
    const int G = gridDim.x; int bid = blockIdx.x; asm volatile("" : "+s"(bid));
#define WP(T, off) ((T*)(ws_ + (off)))
#define INP(k) (ap->in[k])
__global__ void __launch_bounds__(NTHR, 2) mega(Args a) {
    extern __shared__ __attribute__((aligned(16))) unsigned char lds[];
    volatile LAS unsigned* MISC = (volatile LAS unsigned*)((LAS unsigned char*)lds + MISC_OFF);
    int wv = __builtin_amdgcn_readfirstlane((int)threadIdx.x >> 6); asm volatile("" : "+s"(wv));
    { const int t0 = mk_tid(wv); if (t0 < 64) MISC[t0] = 0u; }
    __syncthreads();
    XcdBarrier bar = xcd_barrier_post((unsigned*)a.ws, MISC + 8, wv);
    int* tstart = (int*)(lds + TAB_OFF); int* cnts = (int*)(lds + TAB_OFF + 256); int* offs_s = (int*)(lds + TAB_OFF + 512);
    PG8_LAS unsigned char* ldsl = (PG8_LAS unsigned char*)lds;

#ifndef PH_MASK
#define EN(n) 1
#else
#define EN(n) ((PH_MASK >> ((n) % 20)) & 1)
#endif
#define IN(k) 1
#ifndef REP_PH
#define REPL(id)
#else
#define REPL(id) _Pragma("unroll 1") for (int rep_ = 0; rep_ < (((id) == REP_PH) ? REP_N : 1); ++rep_)
#endif
#define SEAM(k) xcd_barrier(bar)

    REPL(19) if (EN(19) && IN(0)) { const int l = 0; PHASE_BEGIN; (void)l_; (void)G; (void)bid;
        ph_prologue(wv, (const int*)INP(1), INP(3), WP(float, O_COS), WP(float, O_SIN), WP(float, O_LB), INP(0), WP(bf16, O_XB), INP(2), INP(14), INP(19), INP(21),
                    WP(bf16, O_WIN), WP(bf16, O_WOUT), WP(bf16, O_WUP), WP(bf16, O_WDN), INP(7), WP(bf16, O_WB), INP(10), INP(11), WP(bf16, O_W1T), WP(float, O_CBIAS), INP(12), WP(bf16, O_W2T), INP(17), WP(bf16, O_RWH), WP(bf16, O_RWL)); }
    xcd_barrier_first(bar);

#pragma unroll 1
    for (int l = 0; l < DEPTH; ++l) {
        REPL(0) if (EN(0) && IN(pb + 0)) {
            PHASE_BEGIN;
            pg8::PlainOrder S{WP(bf16, O_WIN) + (size_t)l_ * HS * D_, D_, NT / 256, HS / 256, G, bid};
            pg8::EpiBf16 E{WP(bf16, O_HB), HS, nullptr, 0};
            pg8::gemm_phase<pg8::EpiBf16, pg8::PlainOrder, true>(wv, ldsl, WP(bf16, O_XB), D_, S, E);
        }
        SEAM(pb + 0);
        REPL(1) if (EN(1)) {
            PHASE_BEGIN; (void)G; (void)bid;
            ph_mix1(wv, WP(bf16, O_HB), WP(float, O_LB) + l_ * 256, WP(bf16, O_HQT), WP(bf16, O_HKT), WP(bf16, O_HQP), WP(bf16, O_HVT), WP(float, O_HUT), WP(float, O_HDK),
                    INP(5) + l_ * 256, INP(6) + l_ * 256, WP(bf16, O_VLNT), WP(bf16, O_W1T) + (size_t)l_ * 2 * 128 * 2048, WP(float, O_CBIAS) + l_ * 256, WP(bf16, O_W2T) + (size_t)l_ * 2 * 64 * 128,
                    WP(bf16, O_KCB), WP(bf16, O_VCB), WP(float, O_COS), WP(float, O_SIN), WP(bf16, O_KSB), WP(bf16, O_VSB), WP(bf16, O_KWB), WP(bf16, O_VWB),
                    INP(19) + (size_t)l_ * NE * D_ * 2048, INP(21) + (size_t)l_ * NE * D_ * D_, WP(bf16, O_WUP) + (size_t)l_ * NE * 2048 * D_, WP(bf16, O_WDN) + (size_t)l_ * NE * D_ * D_);
        }
        SEAM(pb + 1);
        REPL(11) if (EN(11)) {
            PHASE_BEGIN; (void)G; (void)bid;
            ph_mix2(wv, WP(float, O_HUT), WP(float, O_HDK), WP(bf16, O_HST), WP(bf16, O_HB), WP(bf16, O_VLNT), WP(bf16, O_WB) + (size_t)l_ * 4 * 128 * 128, INP(8) + l_ * 512, INP(9) + l_ * 256, WP(bf16, O_YCAT));
        }
        SEAM(pb + 1);
        {
            PHASE_BEGIN;
            REPL(2) if (EN(2)) ph_hg3(wv, WP(bf16, O_HB), WP(bf16, O_HQT), WP(bf16, O_HKT), WP(bf16, O_HQP), WP(bf16, O_HVT), WP(bf16, O_HST), INP(4) + l_ * 256, WP(bf16, O_YCAT));
            REPL(12) if (EN(12)) {
                nsa::Params NP{WP(bf16, O_HB), WP(bf16, O_KCB), WP(bf16, O_VCB), WP(bf16, O_KSB), WP(bf16, O_VSB), WP(bf16, O_KWB), WP(bf16, O_VWB), WP(float, O_COS), WP(float, O_SIN), INP(13) + l_ * 512, WP(bf16, O_YCAT)};
                int tid = mk_tid(wv); asm volatile("" : "+v"(tid));
                __syncthreads();
                nsa::phase(NP, ldsl, tid, bid, G);
            }
        }
        SEAM(pb + 2);
        REPL(3) if (EN(3) && IN(pb + 3)) {
            PHASE_BEGIN;
            pg8::PlainOrder S{WP(bf16, O_WOUT) + (size_t)l_ * D_ * D_, D_, NT / 256, D_ / 256, G, bid};
            pg8::EpiBf16 E{WP(bf16, O_MIXB), D_, nullptr, 0};
            pg8::gemm_phase<pg8::EpiBf16, pg8::PlainOrder, true>(wv, ldsl, WP(bf16, O_YCAT), D_, S, E);
        }
        SEAM(pb + 3);
        REPL(4) if (EN(4)) {
            PHASE_BEGIN; (void)G; (void)bid;
            ph_ln1(wv, l_ == 0 ? INP(0) : (const float*)WP(float, O_XA), WP(bf16, O_MIXB), INP(15) + l_ * D_, INP(16) + l_ * D_, WP(float, O_X1), WP(bf16, O_X1B));
        }
        SEAM(pb + 4);
        if (EN(14)) {
            PHASE_BEGIN; (void)G; (void)bid;
            ph_route(wv, WP(float, O_X1), WP(bf16, O_RWH) + (size_t)l_ * NE * D_, WP(bf16, O_RWL) + (size_t)l_ * NE * D_, INP(18) + l_ * NE,
                     (int*)(ws_ + 32768) + l_ * 64, WP(int, O_LIST), WP(int, O_TE), WP(int, O_TS), WP(float, O_TW));
        }
        SEAM(pb + 4);
        if (IN(pb + 5) || IN(pb + 6) || IN(pb + 7)) {
            PHASE_BEGIN; (void)G; (void)bid;
            int* cnt = (int*)(ws_ + 32768) + l_ * 64;
            __syncthreads();
            if (mk_tid(wv) == 0) { int acc = 0;
#pragma unroll 1
                for (int e = 0; e < NE; ++e) { const int c = __hip_atomic_load(&cnt[e], __ATOMIC_RELAXED, __HIP_MEMORY_SCOPE_AGENT); tstart[e] = acc; offs_s[e] = acc * 256; cnts[e] = c; acc += (c + 255) >> 8; } tstart[32] = acc; }
            __syncthreads();
        }
        REPL(5) if (EN(5) && IN(pb + 5)) {
            PHASE_BEGIN;
            pg8::MoeOrder<true> S{WP(bf16, O_WUP) + (size_t)l_ * NE * 2048 * D_, D_, 8, G, bid, (size_t)2048 * D_, tstart, cnts, WP(int, O_LIST)};
            pg8::EpiUp E{WP(bf16, O_ACT), INP(20) + (size_t)l_ * NE * 2048};
            pg8::gemm_phase<pg8::EpiUp, pg8::MoeOrder<true>, true>(wv, ldsl, WP(bf16, O_X1B), D_, S, E);
        }
        SEAM(pb + 5);
        REPL(6) if (EN(6) && IN(pb + 6)) {
            PHASE_BEGIN;
            pg8::MoeOrder<false> S{WP(bf16, O_WDN) + (size_t)l_ * NE * D_ * D_, D_, 4, G, bid, (size_t)D_ * D_, tstart, cnts, WP(int, O_LIST)};
            pg8::EpiBf16 E{WP(bf16, O_YB), D_, INP(22) + (size_t)l_ * NE * D_, D_};
            pg8::gemm_phase<pg8::EpiBf16, pg8::MoeOrder<false>, true>(wv, ldsl, WP(bf16, O_ACT), D_, S, E);
        }
        SEAM(pb + 6);
        REPL(7) if (EN(7) && IN(pb + 7)) {
            PHASE_BEGIN; (void)G; (void)bid;
            ph_comb(wv, WP(float, O_X1), WP(bf16, O_YB), WP(int, O_TE), WP(int, O_TS), WP(float, O_TW), INP(23) + l_ * D_, INP(24) + l_ * D_,
                    (l_ == DEPTH - 1) ? ap->out : WP(float, O_XA), (l_ == DEPTH - 1) ? (bf16*)nullptr : WP(bf16, O_XB));
        }
        if (l + 1 < DEPTH) SEAM(pb + 7);
    }
#undef IN
#undef SEAM
}
}

extern "C" void kernel_launch(void* const* d_in, const int* in_sizes, int n_in, void* d_out, int out_size, void* d_ws, size_t ws_size, hipStream_t stream) {
    using namespace mk;
    static int grid = 0;
    if (grid == 0) {
        size_t need = WS_NEED;
        if (n_in != 25 || need > ws_size) { fprintf(stderr, "kernel_launch: bad args n_in %d need %zu ws %zu\n", n_in, need, ws_size); grid = -1; return; }
        int dev = 0, cus = 0, per_cu = 0;
        if (hipGetDevice(&dev) != hipSuccess || hipDeviceGetAttribute(&cus, hipDeviceAttributeMultiprocessorCount, dev) != hipSuccess) { grid = -1; return; }
        if (hipFuncSetAttribute((const void*)mega, hipFuncAttributeMaxDynamicSharedMemorySize, LDS_BYTES) != hipSuccess) { fprintf(stderr, "hipFuncSetAttribute failed\n"); grid = -1; return; }
        if (hipOccupancyMaxActiveBlocksPerMultiprocessor(&per_cu, (const void*)mega, NTHR, LDS_BYTES) != hipSuccess || per_cu < 1) fprintf(stderr, "occupancy query: %d\n", per_cu);
        (void)hipGetLastError();
        grid = cus;
    }
    if (grid < 0) return;
    if (hipMemsetAsync(d_ws, 0, CTL_BYTES, stream) != hipSuccess) return;
    Args a{};
    for (int i = 0; i < 25; ++i) a.in[i] = (const float*)d_in[i];
    a.out = (float*)d_out; a.ws = (unsigned char*)d_ws; a.ph_lo = 0; a.ph_hi = 1 + DEPTH * NPH;
    hipLaunchKernelGGL(mega, dim3(grid), dim3(NTHR), LDS_BYTES, stream, a);
}
```

```cpp
#include <hip/hip_runtime.h>
#include <cstdio>
#include <cstdint>
#include <cmath>

__device__ __forceinline__ int mk_tid(int wv) { int lane; asm volatile("v_mbcnt_lo_u32_b32 %0, -1, 0\n\tv_mbcnt_hi_u32_b32 %0, -1, %0" : "=v"(lane)); return (wv << 6) | lane; }
#define XB_TMO      128
#define XB_XCNT(j)  (256  + 64 * (j))
#define XB_XSUB(j)  (1280 + 64 * (j))
#define XB_XGEN(j)  (2304 + 64 * (j))
#define XB_TOP      3328
#define XB_TOPGEN   3392
#define XCD_BAR_WORDS 3456
#define XB_SPIN_CAP (1u << 18)
#define LAS __attribute__((address_space(3)))

__device__ __forceinline__ unsigned xb_ld(unsigned* p)              { return __hip_atomic_load(p, __ATOMIC_RELAXED, __HIP_MEMORY_SCOPE_AGENT); }
__device__ __forceinline__ unsigned xb_add(unsigned* p, unsigned v) { return __hip_atomic_fetch_add(p, v, __ATOMIC_RELAXED, __HIP_MEMORY_SCOPE_AGENT); }
__device__ __forceinline__ unsigned xb_xcc_id() { return (unsigned)__builtin_amdgcn_s_getreg((3 << 11) | 20) & 0xFu; }
#define XB_SPIN(cond, bar) do { unsigned _sp = 0; while (cond) { __builtin_amdgcn_s_sleep(1); \
    if ((++_sp & 255u) == 0u) { if (xb_ld(&(bar)[XB_TMO])) break; if (_sp > XB_SPIN_CAP) { atomicAdd(&(bar)[XB_TMO], 1u); break; } } } } while (0)

struct XcdBarrier {
    unsigned* bar; unsigned x;
    volatile LAS unsigned* st; int wv;
};

__device__ __forceinline__ XcdBarrier xcd_barrier_post(unsigned* bar, volatile LAS unsigned* st, int wv) {
    XcdBarrier b; b.bar = bar; b.x = xb_xcc_id(); b.st = st; b.wv = wv;
    if (mk_tid(b.wv) == 0) (void)xb_add(&bar[XB_XCNT(b.x)], 1u);
    return b;
}
__device__ __forceinline__ void xcd_barrier_complete(unsigned* bar, unsigned x, unsigned& nloc, unsigned& nx) {
    const unsigned G = gridDim.x * gridDim.y * gridDim.z;
    unsigned sum, cnt, mine, sp = 0u;
    for (;;) {
        sum = 0u; cnt = 0u; mine = 0u;
#pragma unroll
        for (unsigned j = 0; j < 16; ++j) { const unsigned c = xb_ld(&bar[XB_XCNT(j)]); sum += c; cnt += (c > 0u) ? 1u : 0u; mine = (j == x) ? c : mine; }
        if (sum == G) break;
        __builtin_amdgcn_s_sleep(1);
        if ((++sp & 255u) == 0u) { if (xb_ld(&bar[XB_TMO])) break; if (sp > XB_SPIN_CAP) { atomicAdd(&bar[XB_TMO], 1u); break; } }
    }
    nloc = mine > 0u ? mine : 1u; nx = cnt > 0u ? cnt : 1u;
}

template <bool FIRST>
__device__ __forceinline__ void xcd_barrier_t(const XcdBarrier& b) {
    asm volatile("s_waitcnt vmcnt(0)" ::: "memory");
    __syncthreads();
    if (mk_tid(b.wv) == 0) {
        unsigned* bar = b.bar; unsigned bx = b.x; asm volatile("" : "+s"(bar), "+s"(bx));
        __builtin_amdgcn_s_waitcnt(0);
        unsigned nloc = b.st[0], nx = b.st[1];
        if (FIRST) { if (nloc == 0u) { xcd_barrier_complete(bar, bx, nloc, nx); b.st[0] = nloc; b.st[1] = nx; } }
        const unsigned old = xb_add(&bar[XB_XSUB(bx)], 1u);
        const unsigned gen = old / nloc;
        if (old + 1u == (gen + 1u) * nloc) {
            __builtin_amdgcn_fence(__ATOMIC_RELEASE, "agent");
            asm volatile("s_waitcnt vmcnt(0)" ::: "memory");
            const unsigned og = xb_add(&bar[XB_TOP], 1u);
            const unsigned tg = og / nx;
            if (og + 1u == (tg + 1u) * nx) xb_add(&bar[XB_TOPGEN], 1u);
            else XB_SPIN(xb_ld(&bar[XB_TOPGEN]) == tg, bar);
            __builtin_amdgcn_fence(__ATOMIC_ACQUIRE, "agent");
            xb_add(&bar[XB_XGEN(bx)], 1u);
            asm volatile("s_waitcnt vmcnt(0)" ::: "memory");
        } else {
            XB_SPIN(xb_ld(&bar[XB_XGEN(bx)]) == gen, bar);
            __builtin_amdgcn_fence(__ATOMIC_ACQUIRE, "agent");
            asm volatile("s_waitcnt vmcnt(0)" ::: "memory");
        }
    }
    __syncthreads();
}


__device__ __forceinline__ void xcd_barrier_first(const XcdBarrier& b) { xcd_barrier_t<true>(b); }
__device__ __forceinline__ void xcd_barrier(const XcdBarrier& b) { xcd_barrier_t<false>(b); }


namespace mk {
constexpr int B_ = 8, S_ = 4096, D_ = 1024, NT = B_ * S_, DEPTH = 2;
constexpr int INW = 2840, HS = 3072;
constexpr int C_HGQ = 0, C_HGF = 256, C_HGI = 512, C_HGG = 768, C_GMU = 1024, C_GMV = 1280, C_NQ = 1536,
              C_KC = 2048, C_VC = 2176, C_KS = 2304, C_VS = 2432, C_KW = 2560, C_VW = 2688, C_NG = 2816;
constexpr int NCMP = 255, NE = 32, TOPK = 4, NASSIGN = NT * TOPK;
constexpr float ALPHA = 1.4142135623730951f;
constexpr int NTHR = 512, LDS_BYTES = 147456, MISC_OFF = 144 * 1024 - 256;
constexpr int NPH = 8;

typedef unsigned short bf16;
__device__ __forceinline__ float bf2f(bf16 v) { return __uint_as_float((unsigned)v << 16); }
__device__ __forceinline__ unsigned f2bf(float f) { unsigned u = __float_as_uint(f); return (u + 0x7fffu + ((u >> 16) & 1u)) >> 16; }
__device__ __forceinline__ unsigned pk2(float lo, float hi) { return f2bf(lo) | (f2bf(hi) << 16); }
__device__ __forceinline__ float gelu_t(float x) { return 0.5f * x * (1.0f + tanhf(0.7978845608028654f * (x + 0.044715f * x * x * x))); }
__device__ __forceinline__ float sigm(float x) { return 1.0f / (1.0f + expf(-x)); }
__device__ __forceinline__ float wsum(float v) {
#pragma unroll
    for (int o = 1; o < 64; o <<= 1) v += __shfl_xor(v, o);
    return v;
}
__device__ __forceinline__ float wmax(float v) {
#pragma unroll
    for (int o = 1; o < 64; o <<= 1) v = fmaxf(v, __shfl_xor(v, o));
    return v;
}

constexpr int MROWS = NASSIGN + NE * 256;
constexpr size_t CTL_BYTES = 65536;
constexpr size_t al256(size_t x) { return (x + 255) & ~(size_t)255; }
constexpr size_t O_COS = CTL_BYTES, O_SIN = O_COS + al256((size_t)NT * 32 * 4), O_LB = O_SIN + al256((size_t)NT * 32 * 4);
constexpr size_t O_WIN = O_LB + al256(512 * 4), O_WOUT = O_WIN + al256((size_t)DEPTH * HS * D_ * 2), O_WUP = O_WOUT + al256((size_t)DEPTH * D_ * D_ * 2);
constexpr size_t O_WDN = O_WUP + al256((size_t)DEPTH * NE * 2048 * D_ * 2), O_XB = O_WDN + al256((size_t)DEPTH * NE * D_ * D_ * 2);
constexpr size_t O_HB = O_XB + al256((size_t)NT * D_ * 2), O_YCAT = O_HB + al256((size_t)NT * HS * 2), O_MIXB = O_YCAT + al256((size_t)NT * D_ * 2);
constexpr size_t O_X1B = O_MIXB + al256((size_t)NT * D_ * 2), O_ACT = O_X1B + al256((size_t)NT * D_ * 2), O_YB = O_ACT + al256((size_t)MROWS * D_ * 2);
constexpr size_t O_X1Q = O_YB + al256((size_t)MROWS * D_ * 2), O_XA = O_X1Q + al256((size_t)NT * D_ * 4);
constexpr size_t O_VLNT = O_XA + al256((size_t)NT * D_ * 4), O_WB = O_VLNT + al256((size_t)NT * 256 * 2), O_W1T = O_WB + al256((size_t)DEPTH * 4 * 128 * 128 * 2);
constexpr size_t O_CBIAS = O_W1T + al256((size_t)DEPTH * 2 * 128 * 2048 * 2), O_W2T = O_CBIAS + al256((size_t)DEPTH * 2 * 128 * 4), O_RWH = O_W2T + al256((size_t)DEPTH * 2 * 64 * 128 * 2), O_RWL = O_RWH + al256((size_t)DEPTH * NE * D_ * 2), O_HQT = O_RWL + al256((size_t)DEPTH * NE * D_ * 2);
constexpr size_t HGB = (size_t)2048 * 4096 * 2;
constexpr size_t O_HKT = O_HQT + HGB, O_HQP = O_HKT + HGB, O_HVT = O_HQP + HGB, O_HST = O_HVT + HGB, O_HUT = O_HST + HGB, O_HDK = O_HUT + 2 * HGB;
constexpr size_t O_KSB = O_HDK + al256((size_t)2048 * 64 * 4), O_VSB = O_KSB + al256((size_t)NT * 128 * 2);
constexpr size_t O_KWB = O_VSB + al256((size_t)NT * 128 * 2), O_VWB = O_KWB + al256((size_t)NT * 128 * 2), O_KCB = O_VWB + al256((size_t)NT * 128 * 2), O_VCB = O_KCB + al256((size_t)B_ * 2 * 256 * 64 * 2);
constexpr size_t O_LIST = O_VCB + al256((size_t)B_ * 2 * 256 * 64 * 2), O_TE = O_LIST + al256((size_t)NE * NT * 4), O_TS = O_TE + al256((size_t)NASSIGN * 4), O_TW = O_TS + al256((size_t)NASSIGN * 4);
constexpr size_t WS_NEED = O_TW + al256((size_t)NASSIGN * 4);
namespace pg8 {
#define PG8_LAS __attribute__((address_space(3)))
typedef unsigned short bf16_t;
typedef short bf16x8 __attribute__((ext_vector_type(8)));
typedef float f32x4 __attribute__((ext_vector_type(4)));
typedef float f32x2 __attribute__((ext_vector_type(2)));
typedef unsigned u32x4 __attribute__((ext_vector_type(4)));
constexpr int BM = 256, BK = 64, HALF = 128, HTB = HALF * BK * 2  , STAGE_BYTES = 8 * HTB, NXCD = 8, WGM = 8;

__host__ __device__ __forceinline__ int lds_byte(int r, int c) { const int st = (r >> 4) * 2 + (c >> 5), rr = r & 15, cc = c & 31, ob = rr * 64 + cc * 2; return st * 1024 + (ob ^ (((ob >> 9) & 1) << 5)); }
__host__ __device__ __forceinline__ void stage_rc(int b, int& R, int& C) { const int st = b / 1024, sb = b % 1024, swz = sb ^ (((sb >> 9) & 1) << 5); R = (st >> 1) * 16 + swz / 64; C = (st & 1) * 32 + (swz % 64) / 2; }
__host__ __device__ __forceinline__ int perm32(int rho) { const int n = rho >> 4, i = rho & 15; return 8 * (i >> 2) + 4 * n + (i & 3); }

struct Unit { int pm, pn, e, mt, cnt; };

__device__ __forceinline__ void deal(int L, int nM, int nN, int& pm, int& pn) {
    const int nwg = nM * nN;
    int wgid = L; { const int q = nwg / NXCD, r = nwg % NXCD, xcd = wgid % NXCD, off = wgid / NXCD; wgid = (xcd < r ? xcd * (q + 1) : r * (q + 1) + (xcd - r) * q) + off; }
    const int nig = WGM * nN, gid = wgid / nig, fm = gid * WGM, gsz = (nM - fm) < WGM ? (nM - fm) : WGM;
    pm = fm + ((wgid % nig) % gsz); pn = (wgid % nig) / gsz;
}
struct PlainOrder {
    static constexpr bool GATHERED = false;
    const bf16_t* Bt; int K; int nM, nN, G, c;
    __device__ __forceinline__ bool next(int i, Unit& u) const { const long L = (long)i * G + c; if (L >= (long)nM * nN) return false; deal((int)L, nM, nN, u.pm, u.pn); u.e = 0; u.mt = 0; u.cnt = 0; return true; }
    __device__ __forceinline__ unsigned a_row(const Unit& u, int r) const { return (unsigned)(u.pm * BM + r); }
    __device__ __forceinline__ const char* b_base(const Unit& u) const { return (const char*)Bt + (size_t)u.pn * BM * K * 2; }
};
template <bool GATHER> struct MoeOrder {
    static constexpr bool GATHERED = GATHER;
    const void* Bt; int rowb; int nN, G, c; size_t estrideb;
    const int* tstart; const int* cnts; const int* list;
    __device__ __forceinline__ bool next(int i, Unit& u) const {
        const int nM = tstart[32]; const long L = (long)i * G + c; if (L >= (long)nM * nN) return false;
        deal((int)L, nM, nN, u.pm, u.pn);
        int e = 0;
#pragma unroll 1
        for (int k = 1; k < 32; ++k) e = (tstart[k] <= u.pm) ? k : e;
        u.e = e; u.mt = u.pm - tstart[e]; u.cnt = cnts[e]; return true;
    }
    __device__ __forceinline__ unsigned a_row(const Unit& u, int r) const {
        if (GATHER) { const int slot = u.mt * BM + r; return (slot < u.cnt) ? (unsigned)list[u.e * 32768 + slot] : 0u; }
        return (unsigned)(u.pm * BM + r);
    }
    __device__ __forceinline__ const char* b_base(const Unit& u) const { return (const char*)Bt + (size_t)u.e * estrideb + (size_t)u.pn * BM * rowb; }
};

__device__ __forceinline__ unsigned cvt_pk_bf16(float lo, float hi) { unsigned r; asm volatile("v_cvt_pk_bf16_f32 %0, %1, %2" : "=v"(r) : "v"(lo), "v"(hi)); return r; }

struct EpiBf16 {
    static constexpr bool PERM = true;
    bf16_t* O; int ldc; const float* bias; int bstride;
    __device__ __forceinline__ void operator()(const f32x4 (&acc)[2][2][4][2], const Unit& u, int wr, int wc, int fr, int fq) const {
        const int row0 = u.pm * BM + wr * 64 + fr; const int col0 = u.pn * BM + wc * 32 + 8 * fq;
        f32x4 bv[2][2];
#pragma unroll
        for (int bj = 0; bj < 2; ++bj)
#pragma unroll
            for (int n = 0; n < 2; ++n) bv[bj][n] = bias ? *(const f32x4*)(bias + (size_t)u.e * bstride + col0 + bj * HALF + 4 * n) : (f32x4){0.f, 0.f, 0.f, 0.f};
#pragma unroll
        for (int ai = 0; ai < 2; ++ai)
#pragma unroll
            for (int m = 0; m < 4; ++m) { bf16_t* rowp = O + (size_t)(row0 + ai * HALF + m * 16) * ldc + col0;
#pragma unroll
                for (int bj = 0; bj < 2; ++bj) { f32x4 v0 = acc[ai][bj][m][0] + bv[bj][0], v1 = acc[ai][bj][m][1] + bv[bj][1];
                    u32x4 w; w.x = cvt_pk_bf16(v0[0], v0[1]); w.y = cvt_pk_bf16(v0[2], v0[3]); w.z = cvt_pk_bf16(v1[0], v1[1]); w.w = cvt_pk_bf16(v1[2], v1[3]);
                    *(u32x4*)(rowp + bj * HALF) = w; } }
    }
};
__device__ __forceinline__ float swiglu1(float g, float l) {
    g = fminf(g, 7.0f); l = fminf(fmaxf(l, -7.0f), 7.0f);
    const float s = __builtin_amdgcn_rcpf(1.0f + __builtin_amdgcn_exp2f(-1.702f * 1.4426950408889634f * g));
    return g * s * (l + 1.0f);
}
struct EpiUp {
    static constexpr bool PERM = true;
    bf16_t* O; const float* bias;
    __device__ __forceinline__ void operator()(const f32x4 (&acc)[2][2][4][2], const Unit& u, int wr, int wc, int fr, int fq) const {
        const int row0 = u.pm * BM + wr * 64 + fr; const int j0 = u.pn * HALF + wc * 32 + 8 * fq;
        const float* bp = bias + (size_t)u.e * 2048 + j0;
        f32x4 bg[2], bl[2];
#pragma unroll
        for (int n = 0; n < 2; ++n) { bg[n] = *(const f32x4*)(bp + 4 * n); bl[n] = *(const f32x4*)(bp + 1024 + 4 * n); }
#pragma unroll
        for (int ai = 0; ai < 2; ++ai)
#pragma unroll
            for (int m = 0; m < 4; ++m) {
                float o[8];
#pragma unroll
                for (int n = 0; n < 2; ++n) { const f32x4 g = acc[ai][0][m][n] + bg[n], l = acc[ai][1][m][n] + bl[n];
#pragma unroll
                    for (int j = 0; j < 4; ++j) o[4 * n + j] = swiglu1(g[j], l[j]); }
                u32x4 w; w.x = cvt_pk_bf16(o[0], o[1]); w.y = cvt_pk_bf16(o[2], o[3]); w.z = cvt_pk_bf16(o[4], o[5]); w.w = cvt_pk_bf16(o[6], o[7]);
                *(u32x4*)(O + (size_t)(row0 + ai * HALF + m * 16) * 1024 + j0) = w; }
    }
};

constexpr float F8_SU = 64.0f, F8_SA = 4.0f, F8_SD = 128.0f;
__device__ __forceinline__ unsigned pk4_fp8(float a, float b, float c, float d) {
    a = fminf(fmaxf(a, -448.f), 448.f); b = fminf(fmaxf(b, -448.f), 448.f); c = fminf(fmaxf(c, -448.f), 448.f); d = fminf(fmaxf(d, -448.f), 448.f);
    int p = __builtin_amdgcn_cvt_pk_fp8_f32(a, b, 0, false); p = __builtin_amdgcn_cvt_pk_fp8_f32(c, d, p, true); return (unsigned)p;
}
struct EpiUpF8 {
    static constexpr bool PERM = true;
    unsigned char* O; const float* bias;
    __device__ __forceinline__ void operator()(const f32x4 (&acc)[2][2][4][2], const Unit& u, int wr, int wc, int fr, int fq) const {
        const int row0 = u.pm * BM + wr * 64 + fr; const int j0 = u.pn * HALF + wc * 32 + 8 * fq;
        const float* bp = bias + (size_t)u.e * 2048 + j0;
#pragma unroll
        for (int ai = 0; ai < 2; ++ai)
#pragma unroll
            for (int m = 0; m < 4; ++m) {
                unsigned w[2];
#pragma unroll
                for (int n = 0; n < 2; ++n) { const f32x4 g = acc[ai][0][m][n] * (1.0f / F8_SU) + *(const f32x4*)(bp + 4 * n), l = acc[ai][1][m][n] * (1.0f / F8_SU) + *(const f32x4*)(bp + 1024 + 4 * n);
                    w[n] = pk4_fp8(F8_SA * swiglu1(g[0], l[0]), F8_SA * swiglu1(g[1], l[1]), F8_SA * swiglu1(g[2], l[2]), F8_SA * swiglu1(g[3], l[3])); }
                typedef unsigned u32x2 __attribute__((ext_vector_type(2)));
                u32x2 ww = {w[0], w[1]};
                *(u32x2*)(O + (size_t)(row0 + ai * HALF + m * 16) * 1024 + j0) = ww;
                asm volatile("" ::: "memory"); }
    }
};
struct EpiDnF8 {
    static constexpr bool PERM = true;
    bf16_t* O; const float* bias;
    __device__ __forceinline__ void operator()(const f32x4 (&acc)[2][2][4][2], const Unit& u, int wr, int wc, int fr, int fq) const {
        const int row0 = u.pm * BM + wr * 64 + fr; const int col0 = u.pn * BM + wc * 32 + 8 * fq;
        f32x4 bv[2][2];
#pragma unroll
        for (int bj = 0; bj < 2; ++bj)
#pragma unroll
            for (int n = 0; n < 2; ++n) bv[bj][n] = *(const f32x4*)(bias + (size_t)u.e * 1024 + col0 + bj * HALF + 4 * n);
#pragma unroll
        for (int ai = 0; ai < 2; ++ai)
#pragma unroll
            for (int m = 0; m < 4; ++m) { bf16_t* rowp = O + (size_t)(row0 + ai * HALF + m * 16) * 1024 + col0;
#pragma unroll
                for (int bj = 0; bj < 2; ++bj) { f32x4 v0 = acc[ai][bj][m][0] * (1.0f / (F8_SA * F8_SD)) + bv[bj][0], v1 = acc[ai][bj][m][1] * (1.0f / (F8_SA * F8_SD)) + bv[bj][1];
                    u32x4 w; w.x = cvt_pk_bf16(v0[0], v0[1]); w.y = cvt_pk_bf16(v0[2], v0[3]); w.z = cvt_pk_bf16(v1[0], v1[1]); w.w = cvt_pk_bf16(v1[2], v1[3]);
                    *(u32x4*)(rowp + bj * HALF) = w; } }
    }
};

typedef int v8i32 __attribute__((ext_vector_type(8)));
__device__ __forceinline__ v8i32 pg8_join(const bf16x8 lo, const bf16x8 hi) { typedef int v4i32 __attribute__((ext_vector_type(4)));
    const v4i32 a = __builtin_bit_cast(v4i32, lo), b = __builtin_bit_cast(v4i32, hi); return __builtin_shufflevector(a, b, 0, 1, 2, 3, 4, 5, 6, 7); }
template <class Epi, class Sched, bool ALIGN_EPI, bool F8 = false>
__device__ __forceinline__ void gemm_phase(const int wv, PG8_LAS unsigned char* lds, const void* Abase, const int Kb  , const Sched& S, const Epi& E) {
    int tid = mk_tid(wv); asm volatile("" : "+v"(tid));
    const int wid = __builtin_amdgcn_readfirstlane(tid >> 6), lane = tid & 63, wr = wid >> 2, wc = wid & 3, fr = lane & 15, fq = lane >> 4;
    const int nt = Kb / 128;
    const char* Ab = (const char*)Abase;
    unsigned voffB[2];
#pragma unroll
    for (int i = 0; i < 2; ++i) { int R, C; stage_rc(tid * 16 + i * 8192, R, C); const int Rb = Epi::PERM ? ((R & ~31) + perm32(R & 31)) : R;
        voffB[i] = (unsigned)(Rb * Kb + C * 2); }
    const size_t kstep = (size_t)(BK * 2);
    const size_t hstep = (size_t)HALF * Kb;
    const unsigned rowb = (unsigned)Kb;
    const unsigned ldsw = (unsigned)wid * 1024u;
    const int aoff = F8 ? lds_byte(wr * 64 + fr, 16 * (fq & 1)) + (fq >> 1) * 1024 : lds_byte(wr * 64 + fr, fq * 8);
    const int boff = F8 ? lds_byte(wc * 32 + fr, 16 * (fq & 1)) + (fq >> 1) * 1024 : lds_byte(wc * 32 + fr, fq * 8);
#define PG8_SA(b, h) (((b) * 2 + (h)) * HTB)
#define PG8_SB(b, h) ((4 + (b) * 2 + (h)) * HTB)
#define PG8_STAGE(bufoff, gbase, voff) do { _Pragma("unroll") for (int _i = 0; _i < 2; ++_i) { unsigned _v = (voff)[_i]; asm volatile("" : "+v"(_v)); \
        __builtin_amdgcn_global_load_lds((const unsigned*)((const char*)(gbase) + _v), (PG8_LAS unsigned*)(lds + (bufoff) + ldsw + _i * 8192), 16, 0, 0); } } while (0)
#define PG8_STAGE_A(bufoff, kb, o0, o1) do { unsigned _o0 = (o0), _o1 = (o1); asm volatile("" : "+v"(_o0), "+v"(_o1)); \
        __builtin_amdgcn_global_load_lds((const unsigned*)(Ab + (kb) + _o0), (PG8_LAS unsigned*)(lds + (bufoff) + ldsw), 16, 0, 0); \
        __builtin_amdgcn_global_load_lds((const unsigned*)(Ab + (kb) + _o1), (PG8_LAS unsigned*)(lds + (bufoff) + ldsw + 8192), 16, 0, 0); } while (0)
#define PG8_LDA(dst, b, h) do { if constexpr (F8) { _Pragma("unroll") for (int m = 0; m < 4; ++m) dst##8[m] = *(const PG8_LAS v8i32*)(lds + PG8_SA(b, h) + aoff + m * 2048); } \
        else { _Pragma("unroll") for (int m = 0; m < 4; ++m) _Pragma("unroll") for (int k = 0; k < 2; ++k) dst[m][k] = *(const PG8_LAS bf16x8*)(lds + PG8_SA(b, h) + aoff + m * 2048 + k * 1024); } } while (0)
#define PG8_LDB(dst, b, h) do { if constexpr (F8) { _Pragma("unroll") for (int n = 0; n < 2; ++n) dst##8[n] = *(const PG8_LAS v8i32*)(lds + PG8_SB(b, h) + boff + n * 2048); } \
        else { _Pragma("unroll") for (int n = 0; n < 2; ++n) _Pragma("unroll") for (int k = 0; k < 2; ++k) dst[n][k] = *(const PG8_LAS bf16x8*)(lds + PG8_SB(b, h) + boff + n * 2048 + k * 1024); } } while (0)
#define PG8_MMA(ai, bj, At, Bt) do { __builtin_amdgcn_s_setprio(1); _Pragma("unroll") for (int m = 0; m < 4; ++m) _Pragma("unroll") for (int n = 0; n < 2; ++n) { \
        if constexpr (F8) { acc[ai][bj][m][n] = __builtin_amdgcn_mfma_scale_f32_16x16x128_f8f6f4(Bt##8[n], At##8[m], acc[ai][bj][m][n], 0, 0, 0, 0, 0, 0); } \
        else { _Pragma("unroll") for (int k = 0; k < 2; ++k) acc[ai][bj][m][n] = __builtin_amdgcn_mfma_f32_16x16x32_bf16(Bt[n][k], At[m][k], acc[ai][bj][m][n], 0, 0, 0); } } \
        __builtin_amdgcn_s_setprio(0); } while (0)
#define PG8_WAIT_V(n) asm volatile("s_waitcnt vmcnt(" #n ")" ::: "memory")
#define PG8_WAIT_L(n) asm volatile("s_waitcnt lgkmcnt(" #n ")" ::: "memory")
#define PG8_BAR __builtin_amdgcn_s_barrier()
#define PG8_SCHED __builtin_amdgcn_sched_barrier(0)
#define PG8_AOFFS(dst, u) do { int _t = mk_tid(wv); asm volatile("" : "+v"(_t)); _Pragma("unroll") for (int _i = 0; _i < 2; ++_i) { int _R, _C; stage_rc(_t * 16 + _i * 8192, _R, _C); \
        _Pragma("unroll") for (int _h = 0; _h < 2; ++_h) dst[_h][_i] = S.a_row(u, _h * HALF + _R) * rowb + (unsigned)_C * 2u; } } while (0)
    Unit cur, nxt; int ui = 0;
    if (!S.next(0, cur)) return;
    f32x4 acc[2][2][4][2];
#pragma unroll
    for (int a = 0; a < 2; ++a)
#pragma unroll
        for (int b = 0; b < 2; ++b)
#pragma unroll
            for (int m = 0; m < 4; ++m)
#pragma unroll
                for (int n = 0; n < 2; ++n) acc[a][b][m][n] = (f32x4){0.f, 0.f, 0.f, 0.f};
    bf16x8 At[4][2], B0[2][2], B1[2][2];
    v8i32 At8[4], B08[2], B18[2];
    unsigned aC[2][2], aN[2][2];
    PG8_AOFFS(aC, cur);
    const char* cB = S.b_base(cur);
    PG8_STAGE(PG8_SB(0, 0), cB, voffB); PG8_STAGE(PG8_SB(0, 1), cB + hstep, voffB); PG8_STAGE_A(PG8_SA(0, 0), 0, aC[0][0], aC[0][1]); PG8_STAGE_A(PG8_SA(0, 1), 0, aC[1][0], aC[1][1]);
    if (wr == 1) PG8_BAR;
    PG8_WAIT_V(2); PG8_BAR;
    PG8_STAGE(PG8_SB(1, 0), cB + kstep, voffB); PG8_STAGE_A(PG8_SA(1, 0), kstep, aC[0][0], aC[0][1]); PG8_STAGE(PG8_SB(1, 1), cB + hstep + kstep, voffB);
    PG8_WAIT_V(6); PG8_BAR;
    for (;;) {
        const bool has_next = S.next(ui + 1, nxt);
        const char* nB = has_next ? S.b_base(nxt) : cB;
        if (has_next) { PG8_AOFFS(aN, nxt); }
        else {
#pragma unroll
            for (int _h = 0; _h < 2; ++_h)
#pragma unroll
                for (int _i = 0; _i < 2; ++_i) aN[_h][_i] = aC[_h][_i]; }
#pragma unroll 1
        for (int t = 0; t < nt; t += 2) {
            const bool last = (t == nt - 2);
            const size_t kb1 = (size_t)(t + 1) * kstep;
            PG8_LDB(B0, 0, 0); PG8_LDB(B1, 0, 1); PG8_SCHED; PG8_LDA(At, 0, 0); PG8_STAGE_A(PG8_SA(1, 1), kb1, aC[1][0], aC[1][1]);
            PG8_WAIT_V(8); PG8_WAIT_L(0); PG8_BAR; PG8_MMA(0, 0, At, B0); PG8_MMA(0, 1, At, B1); PG8_BAR; PG8_SCHED;
            if (last) {
#pragma unroll
                for (int _h = 0; _h < 2; ++_h)
#pragma unroll
                    for (int _i = 0; _i < 2; ++_i) aC[_h][_i] = aN[_h][_i]; }
            const size_t kb2 = last ? (size_t)0 : (size_t)(t + 2) * kstep; const char* b2 = last ? nB : cB + (size_t)(t + 2) * kstep;
            const size_t kb3 = kb2 + kstep; const char* b3 = b2 + kstep;
            PG8_LDA(At, 0, 1); PG8_STAGE(PG8_SB(0, 0), b2, voffB); PG8_STAGE(PG8_SB(0, 1), b2 + hstep, voffB); PG8_STAGE_A(PG8_SA(0, 0), kb2, aC[0][0], aC[0][1]);
            PG8_WAIT_V(8); PG8_WAIT_L(0); PG8_BAR; PG8_MMA(1, 0, At, B0); PG8_MMA(1, 1, At, B1); PG8_BAR; PG8_SCHED;
            PG8_LDB(B0, 1, 0); PG8_LDB(B1, 1, 1); PG8_SCHED; PG8_LDA(At, 1, 0); PG8_STAGE_A(PG8_SA(0, 1), kb2, aC[1][0], aC[1][1]);
            PG8_WAIT_V(8); PG8_WAIT_L(0); PG8_BAR; PG8_MMA(0, 0, At, B0); PG8_MMA(0, 1, At, B1); PG8_BAR; PG8_SCHED;
            PG8_LDA(At, 1, 1); PG8_STAGE(PG8_SB(1, 0), b3, voffB); PG8_STAGE(PG8_SB(1, 1), b3 + hstep, voffB); PG8_STAGE_A(PG8_SA(1, 0), kb3, aC[0][0], aC[0][1]);
            PG8_WAIT_V(8); PG8_WAIT_L(0); PG8_BAR; PG8_MMA(1, 0, At, B0); PG8_MMA(1, 1, At, B1); PG8_BAR; PG8_SCHED;
        }
        if (ALIGN_EPI) { if (wr == 0) PG8_BAR; }
        E(acc, cur, wr, wc, fr, fq);
        if (!has_next) break;
#pragma unroll
        for (int a = 0; a < 2; ++a)
#pragma unroll
            for (int b = 0; b < 2; ++b)
#pragma unroll
                for (int m = 0; m < 4; ++m)
#pragma unroll
                    for (int n = 0; n < 2; ++n) acc[a][b][m][n] = (f32x4){0.f, 0.f, 0.f, 0.f};
        cur = nxt; cB = nB; ++ui;
        if (ALIGN_EPI) { if (wr == 1) PG8_BAR; }
    }
    PG8_WAIT_V(0);
    if (!ALIGN_EPI) { if (wr == 0) PG8_BAR; }
    PG8_BAR;
#undef PG8_SA
#undef PG8_SB
#undef PG8_STAGE
#undef PG8_STAGE_A
#undef PG8_LDA
#undef PG8_LDB
#undef PG8_MMA
#undef PG8_WAIT_V
#undef PG8_WAIT_L
#undef PG8_BAR
#undef PG8_SCHED
#undef PG8_AOFFS
}
}


#ifndef NSA_REP_RANK
#define NSA_REP_RANK 1
#endif
#ifndef NSA_REP_PASSA
#define NSA_REP_PASSA 1
#endif
#ifndef NSA_REP_LOOP
#define NSA_REP_LOOP 1
#endif
namespace nsa {
#define NLAS __attribute__((address_space(3)))
typedef short bf16x8 __attribute__((ext_vector_type(8)));
typedef short s16x4 __attribute__((ext_vector_type(4)));
typedef short v4i16_t __attribute__((ext_vector_type(4)));
typedef float f32x16 __attribute__((ext_vector_type(16)));
typedef float f32x2_t __attribute__((ext_vector_type(2)));
typedef __bf16 bf16x2_t __attribute__((ext_vector_type(2)));
#define NSA_MFMA(a, b, c) __builtin_amdgcn_mfma_f32_32x32x16_bf16((a), (b), (c), 0, 0, 0)
constexpr int L_CK = 0, L_CV = 32768, L_RING = 65536, L_IMP = 0, SLOTB = 16384, L_SELM = 131072 + 1024;
constexpr float QSCALE = 0.125f * 1.4426950408889634f;
constexpr float NEGBIG = -1.0e30f;

__device__ __forceinline__ unsigned cvtpk(float lo, float hi) { f32x2_t v = {lo, hi}; bf16x2_t b = __builtin_convertvector(v, bf16x2_t); return __builtin_bit_cast(unsigned, b); }
__device__ __forceinline__ float bflo(unsigned u) { return __uint_as_float(u << 16); }
__device__ __forceinline__ float bfhi(unsigned u) { return __uint_as_float(u & 0xffff0000u); }
__device__ __forceinline__ float xhalf(float v) { return __shfl_xor(v, 32); }
__device__ __forceinline__ s16x4 vtr(const NLAS unsigned char* p) { return __builtin_bit_cast(s16x4, __builtin_amdgcn_ds_read_tr16_b64_v4i16((NLAS v4i16_t*)p)); }
__device__ __forceinline__ bf16x8 pack8(const f32x16& x, int s) {
    unsigned p0 = cvtpk(x[8 * s], x[8 * s + 1]), p1 = cvtpk(x[8 * s + 2], x[8 * s + 3]), p2 = cvtpk(x[8 * s + 4], x[8 * s + 5]), p3 = cvtpk(x[8 * s + 6], x[8 * s + 7]);
    typedef unsigned u32x4 __attribute__((ext_vector_type(4)));
    u32x4 u = {p0, p1, p2, p3}; return __builtin_bit_cast(bf16x8, u);
}

struct Params {
    const unsigned short* hb;
    const unsigned short *kcb, *vcb;
    const unsigned short *ksb, *vsb, *kwb, *vwb;
    const float *cosT, *sinT;
    const float* normw;
    unsigned short* ycat;
};

__device__ __forceinline__ void qk_tile(const NLAS unsigned char* kt, const bf16x8 (&qf)[4], const int (&kofs)[4], f32x16& st0, f32x16& st1, const float binit = 0.f) {
#pragma unroll
    for (int i = 0; i < 16; ++i) { st0[i] = binit; st1[i] = binit; }
#pragma unroll
    for (int ks = 0; ks < 4; ++ks) {
        const bf16x8 k0 = *(const NLAS bf16x8*)(kt + kofs[ks]);
        const bf16x8 k1 = *(const NLAS bf16x8*)(kt + kofs[ks] + 4096);
        st0 = NSA_MFMA(k0, qf[ks], st0); st1 = NSA_MFMA(k1, qf[ks], st1);
    }
}
__device__ __forceinline__ void pv_tile(const NLAS unsigned char* vt, const int (&vofs)[2][2], const f32x16& p0, const f32x16& p1, f32x16& o0, f32x16& o1) {
#pragma unroll
    for (int kt = 0; kt < 2; ++kt)
#pragma unroll
        for (int s = 0; s < 2; ++s) {
            const bf16x8 pb = pack8(kt ? p1 : p0, s);
            const int kb = (32 * kt + 16 * s) * 128;
#pragma unroll
            for (int mb = 0; mb < 2; ++mb) {
                const s16x4 lo = vtr(vt + kb + vofs[mb][0]), hi = vtr(vt + kb + vofs[mb][1]);
                const bf16x8 va = __builtin_shufflevector(lo, hi, 0, 1, 2, 3, 4, 5, 6, 7);
                if (mb == 0) o0 = NSA_MFMA(va, pb, o0); else o1 = NSA_MFMA(va, pb, o1);
            }
        }
}
__device__ __forceinline__ float max3f(float a, float b, float c) { float r; asm("v_max3_f32 %0, %1, %2, %3" : "=v"(r) : "v"(a), "v"(b), "v"(c)); return r; }
constexpr float NEGINF = -__builtin_inff();
template <bool USE_LO>
__device__ __forceinline__ void mask_tile(f32x16& s0, f32x16& s1, const int hi4, const int lo4) {
#pragma unroll
    for (int i = 0; i < 16; ++i) {
        const int kk0 = (i & 3) + 8 * (i >> 2), kk1 = kk0 + 32;
        bool a0 = kk0 <= hi4, a1 = kk1 <= hi4;
        if (USE_LO) { a0 = a0 && (kk0 >= lo4); a1 = a1 && (kk1 >= lo4); }
        s0[i] = a0 ? s0[i] : NEGINF; s1[i] = a1 ? s1[i] : NEGINF;
    }
}
__device__ __forceinline__ void softmax_core(f32x16& s0, f32x16& s1, float& m, float& l, f32x16& o0, f32x16& o1) {
    float mx = max3f(s0[0], s0[1], s0[2]);
#pragma unroll
    for (int i = 3; i < 15; i += 2) mx = max3f(mx, s0[i], s0[i + 1]);
    mx = max3f(mx, s0[15], s1[0]);
#pragma unroll
    for (int i = 1; i < 15; i += 2) mx = max3f(mx, s1[i], s1[i + 1]);
    mx = fmaxf(mx, s1[15]);
    mx = fmaxf(mx, xhalf(mx));
    const float mn = fmaxf(m, mx);
    const float alpha = __builtin_amdgcn_exp2f(m - mn);
    m = mn;
    f32x2_t acc2 = {0.f, 0.f};
    const f32x2_t mn2 = {mn, mn};
#pragma unroll
    for (int i = 0; i < 16; i += 2) {
        f32x2_t a = {s0[i], s0[i + 1]}, b = {s1[i], s1[i + 1]};
        a = a - mn2; b = b - mn2;
        a.x = __builtin_amdgcn_exp2f(a.x); a.y = __builtin_amdgcn_exp2f(a.y); b.x = __builtin_amdgcn_exp2f(b.x); b.y = __builtin_amdgcn_exp2f(b.y);
        s0[i] = a.x; s0[i + 1] = a.y; s1[i] = b.x; s1[i + 1] = b.y;
        acc2 = acc2 + a; acc2 = acc2 + b;
    }
    l = l * alpha + (acc2.x + acc2.y);
    if (__ballot(alpha != 1.0f) != 0ull) {
        const f32x2_t al2 = {alpha, alpha};
#pragma unroll
        for (int i = 0; i < 16; i += 2) {
            f32x2_t a = {o0[i], o0[i + 1]}, b = {o1[i], o1[i + 1]};
            a = a * al2; b = b * al2;
            o0[i] = a.x; o0[i + 1] = a.y; o1[i] = b.x; o1[i + 1] = b.y;
        }
    }
}

__device__ __forceinline__ void unit(const Params& P, NLAS unsigned char* lds, const int tid_in, const int b, const int g, const int qb) {
    int tid = tid_in; asm volatile("" : "+v"(tid));
    const int wv = __builtin_amdgcn_readfirstlane(tid >> 6), lane = tid & 63, r = lane & 31, h = lane >> 5;
    const int head = g * 4 + (wv >> 1), qi = 32 * (wv & 1) + r;
    const int t = qb * 64 + qi, tok = b * 4096 + t;
    const int bg = b * 2 + g;
    int kofs[4];
#pragma unroll
    for (int ks = 0; ks < 4; ++ks) kofs[ks] = r * 128 + ((((2 * ks + h) ^ ((r >> 1) & 7))) << 4);
    int vofs[2][2];
    { const int i16 = lane & 15, blk = (lane >> 4) & 1, q = i16 >> 2, p = i16 & 3;
#pragma unroll
      for (int mb = 0; mb < 2; ++mb)
#pragma unroll
          for (int jj = 0; jj < 2; ++jj) { const int key = 4 * h + 8 * jj + q; const int o = 4 * mb + 2 * blk + (p >> 1);
              vofs[mb][jj] = key * 128 + ((o ^ (((key >> 1) & 1) << 2)) << 4) + (p & 1) * 8; } }
    const int drow = tid >> 3, dpos = tid & 7;
    const unsigned srcK = (unsigned)(drow * 128 + ((dpos ^ ((drow >> 1) & 7)) << 4));
    const unsigned srcV = (unsigned)(drow * 128 + ((dpos ^ (((drow >> 1) & 1) << 2)) << 4));
    const unsigned wdst = (unsigned)wv * 1024u;
    const unsigned lds0 = (unsigned)(size_t)lds;
#define NSA_DMA(slotoff, gsrc, soff) do { unsigned _keep; const void* _g = (const void*)((const char*)(gsrc) + (soff)); const unsigned _d = (unsigned)__builtin_amdgcn_readfirstlane((int)(lds0 + (unsigned)(slotoff) + wdst)); \
        asm volatile("s_mov_b32 %0, m0\n\ts_mov_b32 m0, %2\n\ts_nop 0\n\tglobal_load_lds_dwordx4 %1, off\n\ts_mov_b32 m0, %0" : "=&s"(_keep) : "v"(_g), "s"(_d) : "memory"); } while (0)
    const int nsel = qb + 1, jw0 = qb >= 8 ? qb - 8 : 0, ntiles = nsel + (qb - jw0 + 1);
    const char* ksg = (const char*)P.ksb + (size_t)bg * 4096 * 128; const char* vsg = (const char*)P.vsb + (size_t)bg * 4096 * 128;
    const char* kwg = (const char*)P.kwb + (size_t)bg * 4096 * 128; const char* vwg = (const char*)P.vwb + (size_t)bg * 4096 * 128;
#define NSA_ISSUE(pos) do { const int _p = (pos) < ntiles ? (pos) : ntiles - 1; const bool _w = _p >= nsel; const int _j = _w ? jw0 + _p - nsel : _p; \
        const int _slot = L_RING + ((pos) & 3) * SLOTB; \
        NSA_DMA(_slot, (_w ? kwg : ksg) + (size_t)_j * 8192, srcK); NSA_DMA(_slot + 8192, (_w ? vwg : vsg) + (size_t)_j * 8192, srcV); } while (0)
    { const char* kcg = (const char*)P.kcb + (size_t)bg * 256 * 128; const char* vcg = (const char*)P.vcb + (size_t)bg * 256 * 128;
#pragma unroll
      for (int T = 0; T < 4; ++T) { NSA_DMA(L_CK + T * 8192, kcg + T * 8192, srcK); NSA_DMA(L_CV + T * 8192, vcg + T * 8192, srcV); } }
    NSA_ISSUE(0); NSA_ISSUE(1);
    typedef unsigned u32x4 __attribute__((ext_vector_type(4)));
    bf16x8 qf[4];
    const unsigned short* qrow = P.hb + (size_t)tok * 3072 + 1536 + (head & 7) * 64;
    {
        u32x4 qraw[4];
#pragma unroll
        for (int ks = 0; ks < 4; ++ks) qraw[ks] = *(const u32x4*)(qrow + 16 * ks + 8 * h);
#pragma unroll
        for (int ks = 0; ks < 4; ++ks) { u32x4 o;
#pragma unroll
            for (int c = 0; c < 4; ++c) o[c] = cvtpk(bflo(qraw[ks][c]) * QSCALE, bfhi(qraw[ks][c]) * QSCALE);
            qf[ks] = __builtin_bit_cast(bf16x8, o); }
    }
    float gc, gs, gw;
    { const unsigned short* gp = P.hb + (size_t)tok * 3072 + 2816 + head * 3;
      gc = 1.f / (1.f + __expf(-__uint_as_float((unsigned)gp[0] << 16))); gs = 1.f / (1.f + __expf(-__uint_as_float((unsigned)gp[1] << 16))); gw = 1.f / (1.f + __expf(-__uint_as_float((unsigned)gp[2] << 16))); }
    asm volatile("s_waitcnt vmcnt(0)" ::: "memory"); __builtin_amdgcn_s_barrier();
    const int cmax = (t >= 31) ? (((t - 31) >> 4) < 254 ? ((t - 31) >> 4) : 254) : -1;
    float m = NEGBIG, l = 0.f;
    {
        f32x16 s0, s1, d0, d1;
#pragma unroll
        for (int i = 0; i < 16; ++i) { d0[i] = 0.f; d1[i] = 0.f; }
#pragma unroll 1
        for (int repA = 0; repA < NSA_REP_PASSA; ++repA) { m = NEGBIG; l = 0.f;
#pragma unroll 1
        for (int T = 0; T < 4; ++T) {
            qk_tile(lds + L_CK + T * 8192, qf, kofs, s0, s1);
            if (__ballot(cmax - 64 * T < 63) != 0ull) mask_tile<false>(s0, s1, cmax - 64 * T - 4 * h, 0);
            softmax_core(s0, s1, m, l, d0, d1);
        } }
    }
    const float lc = l + xhalf(l);
    const float rinv = lc > 0.f ? 1.0f / lc : 0.f;
    f32x16 of0, of1;
#pragma unroll
    for (int i = 0; i < 16; ++i) { of0[i] = 0.f; of1[i] = 0.f; }
    const bool need_sel = qb >= 16;
    float ow[32];
    float carry_in = 0.f;
#pragma unroll
    for (int T = 0; T < 4; ++T) {
        f32x16 s0, s1;
        qk_tile(lds + L_CK + T * 8192, qf, kofs, s0, s1);
        if (__ballot(cmax - 64 * T < 63) != 0ull) mask_tile<false>(s0, s1, cmax - 64 * T - 4 * h, 0);
#pragma unroll
        for (int i = 0; i < 16; ++i) { s0[i] = __builtin_amdgcn_exp2f(s0[i] - m) * rinv; s1[i] = __builtin_amdgcn_exp2f(s1[i] - m) * rinv; }
#pragma unroll
        for (int kt = 0; kt < 2; ++kt)
#pragma unroll
            for (int u = 0; u < 4; ++u) {
                const float p0 = kt ? s1[4 * u] : s0[4 * u], p1 = kt ? s1[4 * u + 1] : s0[4 * u + 1], p2 = kt ? s1[4 * u + 2] : s0[4 * u + 2], p3 = kt ? s1[4 * u + 3] : s0[4 * u + 3];
                const float x = xhalf(p3);
                const float own = 2.0f * ((p0 + p1) + p2) + p3;
                ow[8 * T + 4 * kt + u] = own + (h ? x : carry_in);
                carry_in = x;
            }
        pv_tile(lds + L_CV + T * 8192, vofs, s0, s1, of0, of1);
    }
#pragma unroll
    for (int i = 0; i < 16; ++i) { of0[i] *= gc; of1[i] *= gc; }
    unsigned long long selmask = (qb >= 63) ? ~0ull : ((1ull << (qb + 1)) - 1ull);
    if (need_sel) {
        __builtin_amdgcn_s_barrier();
        NLAS float* imp = (NLAS float*)(lds + L_IMP) + qi * 64;
#pragma unroll 1
        for (int hh = 0; hh < 4; ++hh) {
            if ((wv >> 1) == hh) {
                if (hh == 0) {
#pragma unroll
                    for (int idx = 0; idx < 32; ++idx) imp[(2 * idx + h + qi) & 63] = ow[idx];
                } else {
#pragma unroll
                    for (int idx = 0; idx < 32; ++idx) imp[(2 * idx + h + qi) & 63] += ow[idx];
                }
            }
            asm volatile("s_waitcnt lgkmcnt(0)" ::: "memory"); __builtin_amdgcn_s_barrier();
        }
        NLAS unsigned long long* selm = (NLAS unsigned long long*)(lds + L_SELM);
        const unsigned long long forced = 1ull | (1ull << qb) | (1ull << (qb - 1));
        const bool cand = (lane >= 1) && (lane <= qb - 2);
#pragma unroll 1
        for (int rep_ = 0; rep_ < NSA_REP_RANK; ++rep_) {
            unsigned vb[8], thr[8];
#pragma unroll
            for (int qq = 0; qq < 8; ++qq) { const int q = 8 * wv + qq; const float v = ((NLAS float*)(lds + L_IMP))[q * 64 + ((lane + q) & 63)];
                vb[qq] = cand ? __float_as_uint(v) : 0u; thr[qq] = 0u; }
#pragma unroll 1
            for (int bit = 30; bit >= 0; --bit) {
#pragma unroll
                for (int qq = 0; qq < 8; ++qq) {
                    const unsigned c2 = thr[qq] | (1u << bit);
                    const int cnt = __popcll(__ballot(cand && vb[qq] >= c2));
                    thr[qq] = (cnt >= 13) ? c2 : thr[qq];
                }
            }
#pragma unroll
            for (int qq = 0; qq < 8; ++qq) {
                unsigned long long sel = __ballot(cand && vb[qq] > thr[qq]);
                unsigned long long eq = __ballot(cand && vb[qq] == thr[qq]);
                int need = 13 - __popcll(sel);
#pragma unroll 1
                for (; need > 0; --need) { const unsigned long long low = eq & (~eq + 1ull); sel |= low; eq ^= low; }
                if (lane == 0) selm[8 * wv + qq] = sel | forced;
            }
        }
        asm volatile("s_waitcnt lgkmcnt(0)" ::: "memory"); __builtin_amdgcn_s_barrier();
        selmask = selm[qi];
    }
    {
        u32x4 qraw[4];
#pragma unroll
        for (int ks = 0; ks < 4; ++ks) qraw[ks] = *(const u32x4*)(qrow + 16 * ks + 8 * h);
        const float4* cp = (const float4*)(P.cosT + (size_t)tok * 32 + 8 * h); const float4* sp = (const float4*)(P.sinT + (size_t)tok * 32 + 8 * h);
#pragma unroll
        for (int ks = 0; ks < 2; ++ks) {
            const float4 c0 = cp[4 * ks], c1 = cp[4 * ks + 1], s0 = sp[4 * ks], s1 = sp[4 * ks + 1];
            const float cs[8] = {c0.x, c0.y, c0.z, c0.w, c1.x, c1.y, c1.z, c1.w}, sn[8] = {s0.x, s0.y, s0.z, s0.w, s1.x, s1.y, s1.z, s1.w};
            u32x4 oa, ob;
#pragma unroll
            for (int c = 0; c < 4; ++c) {
                const float a0 = bflo(qraw[ks][c]), a1 = bfhi(qraw[ks][c]), b0 = bflo(qraw[ks + 2][c]), b1 = bfhi(qraw[ks + 2][c]);
                oa[c] = cvtpk((a0 * cs[2 * c] - b0 * sn[2 * c]) * QSCALE, (a1 * cs[2 * c + 1] - b1 * sn[2 * c + 1]) * QSCALE);
                ob[c] = cvtpk((b0 * cs[2 * c] + a0 * sn[2 * c]) * QSCALE, (b1 * cs[2 * c + 1] + a1 * sn[2 * c + 1]) * QSCALE);
            }
            qf[ks] = __builtin_bit_cast(bf16x8, oa); qf[ks + 2] = __builtin_bit_cast(bf16x8, ob);
        }
    }
    asm volatile("s_waitcnt vmcnt(0)" ::: "memory");
    f32x16 o0, o1;
    const bool lead = wv < 4;
    const float gs_keep = gs, gw_keep = gw;
#pragma unroll 1
    for (int repL = 0; repL < NSA_REP_LOOP; ++repL) {
    if (NSA_REP_LOOP > 1) { gs = (repL == NSA_REP_LOOP - 1) ? gs_keep : 0.f; gw = (repL == NSA_REP_LOOP - 1) ? gw_keep : 0.f;
        if (repL > 0) { asm volatile("s_waitcnt vmcnt(0)" ::: "memory"); __builtin_amdgcn_s_barrier(); NSA_ISSUE(0); NSA_ISSUE(1); asm volatile("s_waitcnt vmcnt(0)" ::: "memory"); } }
#pragma unroll
    for (int i = 0; i < 16; ++i) { o0[i] = 0.f; o1[i] = 0.f; }
    m = NEGBIG; l = 0.f;
    if (!lead) { asm volatile("s_waitcnt vmcnt(2)" ::: "memory"); __builtin_amdgcn_s_barrier(); }
#pragma unroll 1
    for (int pos = 0; pos < ntiles; ++pos) {
        if (lead) asm volatile("s_waitcnt vmcnt(2)" ::: "memory");
        __builtin_amdgcn_s_barrier();
        NSA_ISSUE(pos + 2);
        const NLAS unsigned char* slot = lds + L_RING + (pos & 3) * SLOTB;
        f32x16 s0, s1;
        const bool win = pos >= nsel; const int j = win ? jw0 + pos - nsel : pos;
        const float binit = (!win && !((selmask >> j) & 1ull)) ? NEGINF : 0.f;
        qk_tile(slot, qf, kofs, s0, s1, binit);
        if (j == qb) mask_tile<false>(s0, s1, qi - 4 * h, 0);
        else if (win && qb >= 8 && j == qb - 8) mask_tile<true>(s0, s1, 63, qi + 1 - 4 * h);
        softmax_core(s0, s1, m, l, o0, o1);
        if (!lead) asm volatile("s_waitcnt vmcnt(2)" ::: "memory");
        __builtin_amdgcn_s_barrier();
        pv_tile(slot + 8192, vofs, s0, s1, o0, o1);
        if (pos == nsel - 1) {
            const float L = l + xhalf(l); const float sc = (L > 0.f) ? gs / L : 0.f;
#pragma unroll
            for (int i = 0; i < 16; ++i) { of0[i] += sc * o0[i]; of1[i] += sc * o1[i]; o0[i] = 0.f; o1[i] = 0.f; }
            m = NEGBIG; l = 0.f;
        }
    }
    if (lead) __builtin_amdgcn_s_barrier();
    if (NSA_REP_LOOP > 1 && repL < NSA_REP_LOOP - 1) {
        const float L0 = l + xhalf(l); (void)L0; }
    if (repL == NSA_REP_LOOP - 1)    {
        float L = l + xhalf(l);
        const float npad = (t < 511) ? (float)(511 - t) : 0.f;
        const float m2 = (npad > 0.f) ? fmaxf(m, 0.f) : m;
        const float a = __builtin_amdgcn_exp2f(m - m2);
        L = L * a + npad * __builtin_amdgcn_exp2f(-m2);
        const float sc = (L > 0.f) ? gw * a / L : 0.f;
#pragma unroll
        for (int i = 0; i < 16; ++i) { of0[i] += sc * o0[i]; of1[i] += sc * o1[i]; }
    }
    }
    float ss = 0.f;
#pragma unroll
    for (int i = 0; i < 16; ++i) ss += of0[i] * of0[i] + of1[i] * of1[i];
    ss += xhalf(ss);
    const float rn = rsqrtf(ss * (1.0f / 64.0f) + 1e-6f);
    unsigned short* yrow = P.ycat + (size_t)tok * 1024 + 512 + head * 64;
    const float* nw = P.normw + head * 64;
#pragma unroll
    for (int mb = 0; mb < 2; ++mb)
#pragma unroll
        for (int u = 0; u < 4; ++u) {
            const int d0 = 32 * mb + 8 * u + 4 * h;
            const float4 w4 = *(const float4*)(nw + d0);
            const float v0 = (mb ? of1[4 * u] : of0[4 * u]) * rn * w4.x, v1 = (mb ? of1[4 * u + 1] : of0[4 * u + 1]) * rn * w4.y;
            const float v2 = (mb ? of1[4 * u + 2] : of0[4 * u + 2]) * rn * w4.z, v3 = (mb ? of1[4 * u + 3] : of0[4 * u + 3]) * rn * w4.w;
            *(uint2*)(yrow + d0) = make_uint2(cvtpk(v0, v1), cvtpk(v2, v3));
        }
    asm volatile("s_waitcnt vmcnt(0)" ::: "memory"); __builtin_amdgcn_s_barrier();
#undef NSA_DMA
#undef NSA_ISSUE
}
__device__ __forceinline__ void phase(const Params& P, NLAS unsigned char* lds, const int tid, const int bid, const int G) {
#pragma unroll 1
    for (int vw = bid; vw < 256; vw += G) {
        const int xcd = vw & 7, slot = vw >> 3, bg = xcd * 2 + (slot >> 4), rr = slot & 15;
#pragma unroll 1
        for (int k = 0; k < 4; ++k) { const int qb = (k == 0) ? 63 - rr : (k == 1) ? 32 + rr : (k == 2) ? 31 - rr : rr; unit(P, lds, tid, bg >> 1, bg & 1, qb); }
    }
}
}


namespace wt {
typedef short bf16x8 __attribute__((ext_vector_type(8)));
typedef float f32x16 __attribute__((ext_vector_type(16)));
typedef unsigned u32x4 __attribute__((ext_vector_type(4)));
typedef unsigned u32x2 __attribute__((ext_vector_type(2)));
typedef float f32x2_t __attribute__((ext_vector_type(2)));
typedef __bf16 bf16x2_t __attribute__((ext_vector_type(2)));
#define WT_MFMA(a, b, c) __builtin_amdgcn_mfma_f32_32x32x16_bf16((a), (b), (c), 0, 0, 0)
__device__ __forceinline__ unsigned cvtpk(float lo, float hi) { f32x2_t v = {lo, hi}; bf16x2_t b = __builtin_convertvector(v, bf16x2_t); return __builtin_bit_cast(unsigned, b); }
__device__ __forceinline__ float bflo(unsigned u) { return __uint_as_float(u << 16); }
__device__ __forceinline__ float bfhi(unsigned u) { return __uint_as_float(u & 0xffff0000u); }
__device__ __forceinline__ float xhalf(float v) { return __shfl_xor(v, 32); }
__device__ __forceinline__ bf16x8 ld16(const unsigned short* p) { return __builtin_bit_cast(bf16x8, *(const u32x4*)p); }
__device__ __forceinline__ bf16x8 ld8x2(const unsigned short* p0, const unsigned short* p1) { const u32x2 a = *(const u32x2*)p0, b = *(const u32x2*)p1; u32x4 u = {a.x, a.y, b.x, b.y}; return __builtin_bit_cast(bf16x8, u); }
__device__ __forceinline__ bf16x8 pack8(const f32x16& x, int s) {
    u32x4 u = {cvtpk(x[8 * s], x[8 * s + 1]), cvtpk(x[8 * s + 2], x[8 * s + 3]), cvtpk(x[8 * s + 4], x[8 * s + 5]), cvtpk(x[8 * s + 6], x[8 * s + 7])};
    return __builtin_bit_cast(bf16x8, u);
}
__device__ __forceinline__ float gelu_t(float x) { const float u = 0.7978845608028654f * (x + 0.044715f * x * x * x); const float e = __expf(2.0f * u); return 0.5f * x * (1.0f + (1.0f - 2.0f / (e + 1.0f))); }
__device__ __forceinline__ float sigm(float x) { return 1.0f / (1.0f + __expf(-x)); }
__device__ __forceinline__ void zero(f32x16& a) {
#pragma unroll
    for (int i = 0; i < 16; ++i) a[i] = 0.f;
}

__device__ __forceinline__ void gm_ln8(const unsigned short* __restrict__ hb, const float* __restrict__ lw, const float* __restrict__ lbias, unsigned short* __restrict__ vlnT, int t8, int lane) {
    const int tok0 = t8 * 8;
    const float4 w4 = *(const float4*)(lw + lane * 4), b4 = *(const float4*)(lbias + lane * 4);
    float o[4][8];
#pragma unroll
    for (int i = 0; i < 8; ++i) {
        const u32x2 v4 = *(const u32x2*)(hb + (size_t)(tok0 + i) * 3072 + 1280 + lane * 4);
        float v[4] = {gelu_t(bflo(v4.x)), gelu_t(bfhi(v4.x)), gelu_t(bflo(v4.y)), gelu_t(bfhi(v4.y))};
        float s = (v[0] + v[1]) + (v[2] + v[3]);
#pragma unroll
        for (int o2 = 1; o2 < 64; o2 <<= 1) s += __shfl_xor(s, o2);
        const float mean = s * (1.0f / 256.0f); float q = 0.f;
#pragma unroll
        for (int c = 0; c < 4; ++c) { v[c] -= mean; q += v[c] * v[c]; }
#pragma unroll
        for (int o2 = 1; o2 < 64; o2 <<= 1) q += __shfl_xor(q, o2);
        const float rstd = rsqrtf(q * (1.0f / 256.0f) + 1e-5f);
        o[0][i] = v[0] * rstd * w4.x + b4.x; o[1][i] = v[1] * rstd * w4.y + b4.y; o[2][i] = v[2] * rstd * w4.z + b4.z; o[3][i] = v[3] * rstd * w4.w + b4.w;
    }
    const int bc = tok0 >> 7, s0 = tok0 & 127;
#pragma unroll
    for (int c = 0; c < 4; ++c) {
        const int ch = lane * 4 + c, g = ch >> 6, cc = ch & 63;
        u32x4 u = {cvtpk(o[c][0], o[c][1]), cvtpk(o[c][2], o[c][3]), cvtpk(o[c][4], o[c][5]), cvtpk(o[c][6], o[c][7])};
        *(u32x4*)(vlnT + ((size_t)(bc * 4 + g) * 64 + cc) * 128 + s0) = u;
    }
}
__device__ __forceinline__ void gm_sp_task(const unsigned short* __restrict__ hb, const unsigned short* __restrict__ vlnT, const unsigned short* __restrict__ Wb, const float* __restrict__ bs,
                                           const float* __restrict__ normw, unsigned short* __restrict__ ycat, int task, int lane) {
    const int tb = task & 3, g = (task >> 2) & 3, bc = task >> 4, r = lane & 31, h = lane >> 5;
    const unsigned short* ap = vlnT + ((size_t)(bc * 4 + g) * 64 + r) * 128 + 8 * h;
    const unsigned short* bp = Wb + ((size_t)g * 128 + 32 * tb + r) * 128 + 8 * h;
    f32x16 a0, a1; zero(a0); zero(a1);
    const int nks = 2 * (tb + 1);
#pragma unroll 2
    for (int ks = 0; ks < nks; ++ks) {
        const bf16x8 bw = ld16(bp + 16 * ks);
        const bf16x8 v0 = ld16(ap + 16 * ks), v1 = ld16(ap + 32 * 128 + 16 * ks);
        a0 = WT_MFMA(v0, bw, a0); a1 = WT_MFMA(v1, bw, a1);
    }
    const int tl = 32 * tb + r, tok = bc * 128 + tl;
    const float bias = bs[g * 128 + tl];
    const unsigned short* up = hb + (size_t)tok * 3072 + 1024 + g * 64;
    float z[32]; float ss = 0.f;
#pragma unroll
    for (int cb = 0; cb < 2; ++cb)
#pragma unroll
        for (int u = 0; u < 4; ++u) {
            const int c0 = 32 * cb + 8 * u + 4 * h;
            const u32x2 uu = *(const u32x2*)(up + c0);
            const float uv[4] = {gelu_t(bflo(uu.x)), gelu_t(bfhi(uu.x)), gelu_t(bflo(uu.y)), gelu_t(bfhi(uu.y))};
#pragma unroll
            for (int k = 0; k < 4; ++k) { const float a = (cb ? a1[4 * u + k] : a0[4 * u + k]) + bias; const float zz = uv[k] * a; z[16 * cb + 4 * u + k] = zz; ss += zz * zz; }
        }
    ss += xhalf(ss);
    const float rn = rsqrtf(ss * (1.0f / 64.0f) + 1e-6f);
    unsigned short* yp = ycat + (size_t)tok * 1024 + 256 + g * 64;
    const float* nw = normw + g * 64;
#pragma unroll
    for (int cb = 0; cb < 2; ++cb)
#pragma unroll
        for (int u = 0; u < 4; ++u) {
            const int c0 = 32 * cb + 8 * u + 4 * h;
            const float4 w4 = *(const float4*)(nw + c0);
            u32x2 o = {cvtpk(z[16 * cb + 4 * u] * rn * w4.x, z[16 * cb + 4 * u + 1] * rn * w4.y), cvtpk(z[16 * cb + 4 * u + 2] * rn * w4.z, z[16 * cb + 4 * u + 3] * rn * w4.w)};
            *(u32x2*)(yp + c0) = o;
        }
}

#define WT_LAS __attribute__((address_space(3)))
__device__ __forceinline__ void cmp_wg(const unsigned short* __restrict__ hb, const unsigned short* __restrict__ w1t, const float* __restrict__ cbias, const unsigned short* __restrict__ w2t,
                                       unsigned short* __restrict__ kcb, unsigned short* __restrict__ vcb, WT_LAS float* red, int task, int wave, int lane) {
    const int cblk = task & 7, kv = (task >> 3) & 1, g = (task >> 4) & 1, b = task >> 5, r = lane & 31, h = lane >> 5;
    const int c = 32 * cblk + r; const int cl = c < 254 ? c : 254;
    const unsigned short* bp = hb + (size_t)(b * 4096 + 16 * cl) * 3072 + (kv ? 2176 : 2048) + g * 64 + 8 * h;
    const unsigned short* ap = w1t + ((size_t)kv * 128 + r) * 2048 + 8 * h;
    f32x16 acc[4];
#pragma unroll
    for (int nt = 0; nt < 4; ++nt) zero(acc[nt]);
#pragma unroll 4
    for (int kk = 0; kk < 16; ++kk) {
        const int ks = 16 * wave + kk;
        const bf16x8 bk = ld16(bp + (size_t)(ks >> 2) * 3072 + 16 * (ks & 3));
#pragma unroll
        for (int nt = 0; nt < 4; ++nt) acc[nt] = WT_MFMA(ld16(ap + (size_t)nt * 32 * 2048 + 16 * ks), bk, acc[nt]);
    }
#pragma unroll
    for (int nt = 0; nt < 4; ++nt)
#pragma unroll
        for (int i = 0; i < 16; ++i) red[(wave * 64 + nt * 16 + i) * 64 + lane] = acc[nt][i];
    asm volatile("s_waitcnt lgkmcnt(0)" ::: "memory"); __builtin_amdgcn_s_barrier();
#pragma unroll
    for (int q = 0; q < 8; ++q) {
        const int row = 8 * wave + q; float sacc = 0.f;
#pragma unroll
        for (int w2 = 0; w2 < 8; ++w2) sacc += red[(w2 * 64 + row) * 64 + lane];
        red[row * 64 + lane] = sacc;
    }
    asm volatile("s_waitcnt lgkmcnt(0)" ::: "memory"); __builtin_amdgcn_s_barrier();
    if (wave == 0) {
#pragma unroll
        for (int nt = 0; nt < 4; ++nt)
#pragma unroll
            for (int i = 0; i < 16; ++i) { const int n = 32 * nt + (i & 3) + 8 * (i >> 2) + 4 * h; acc[nt][i] = gelu_t(red[(nt * 16 + i) * 64 + lane] + cbias[kv * 128 + n]); }
        f32x16 o0, o1; zero(o0); zero(o1);
        const unsigned short* w2p = w2t + ((size_t)kv * 64 + r) * 128 + 4 * h;
#pragma unroll
        for (int nt = 0; nt < 4; ++nt)
#pragma unroll
            for (int s = 0; s < 2; ++s) {
                const bf16x8 pb = pack8(acc[nt], s);
                const unsigned short* wp = w2p + 32 * nt + 16 * s;
                o0 = WT_MFMA(ld8x2(wp, wp + 8), pb, o0);
                o1 = WT_MFMA(ld8x2(wp + 32 * 128, wp + 32 * 128 + 8), pb, o1);
            }
        if (c < 255) {
            unsigned short* op = (kv ? vcb : kcb) + ((size_t)(b * 2 + g) * 256 + c) * 64;
#pragma unroll
            for (int db = 0; db < 2; ++db)
#pragma unroll
                for (int u = 0; u < 4; ++u) {
                    const int d0 = 32 * db + 8 * u + 4 * h;
                    u32x2 o = {cvtpk(db ? o1[4 * u] : o0[4 * u], db ? o1[4 * u + 1] : o0[4 * u + 1]), cvtpk(db ? o1[4 * u + 2] : o0[4 * u + 2], db ? o1[4 * u + 3] : o0[4 * u + 3])};
                    *(u32x2*)(op + d0) = o;
                }
        }
    }
    __builtin_amdgcn_s_barrier();
}

__device__ __forceinline__ void kvprep8(const unsigned short* __restrict__ hb, const float* __restrict__ cosT, const float* __restrict__ sinT,
                                        unsigned short* __restrict__ ksb, unsigned short* __restrict__ vsb, unsigned short* __restrict__ kwb, unsigned short* __restrict__ vwb, int idx) {
    const int j8 = idx & 3, g = (idx >> 2) & 1, tok = idx >> 3, b = tok >> 12, t = tok & 4095;
    const unsigned short* hr = hb + (size_t)tok * 3072 + g * 64 + 8 * j8;
    const float4 c0 = *(const float4*)(cosT + (size_t)tok * 32 + 8 * j8), c1 = *(const float4*)(cosT + (size_t)tok * 32 + 8 * j8 + 4);
    const float4 s0 = *(const float4*)(sinT + (size_t)tok * 32 + 8 * j8), s1 = *(const float4*)(sinT + (size_t)tok * 32 + 8 * j8 + 4);
    const float cs[8] = {c0.x, c0.y, c0.z, c0.w, c1.x, c1.y, c1.z, c1.w}, sn[8] = {s0.x, s0.y, s0.z, s0.w, s1.x, s1.y, s1.z, s1.w};
    const size_t o = ((size_t)(b * 2 + g) * 4096 + t) * 64 + 8 * j8;
#pragma unroll
    for (int w = 0; w < 2; ++w) {
        const int col = w ? 2560 : 2304;
        const u32x4 a = *(const u32x4*)(hr + col), bq = *(const u32x4*)(hr + col + 32);
        u32x4 oa, ob;
#pragma unroll
        for (int c = 0; c < 4; ++c) {
            const float a0 = bflo(a[c]), a1 = bfhi(a[c]), b0 = bflo(bq[c]), b1 = bfhi(bq[c]);
            oa[c] = cvtpk(a0 * cs[2 * c] - b0 * sn[2 * c], a1 * cs[2 * c + 1] - b1 * sn[2 * c + 1]);
            ob[c] = cvtpk(b0 * cs[2 * c] + a0 * sn[2 * c], b1 * cs[2 * c + 1] + a1 * sn[2 * c + 1]);
        }
        unsigned short* kd = (w ? kwb : ksb) + o;
        *(u32x4*)kd = oa; *(u32x4*)(kd + 32) = ob;
        const int vcol = w ? 2688 : 2432;
        unsigned short* vd = (w ? vwb : vsb) + o;
        *(u32x4*)vd = *(const u32x4*)(hr + vcol); *(u32x4*)(vd + 32) = *(const u32x4*)(hr + vcol + 32);
    }
}

__device__ __forceinline__ void hg_pass1(const unsigned short* __restrict__ hb, const float* __restrict__ lbl, unsigned short* __restrict__ Qt, unsigned short* __restrict__ Kt,
                                         unsigned short* __restrict__ Qp, unsigned short* __restrict__ VT, float* __restrict__ Ut, float* __restrict__ Dk, int ci, int lane) {
    const int chunk = ci & 63, hd = (ci >> 6) & 3, b = ci >> 8;
    const unsigned short* hp = hb + (size_t)(b * 4096 + chunk * 64) * 3072 + hd * 64 + lane;
    const float lb = lbl[hd * 64 + lane];
    float run = 0.f, cmid = 0.f;
#pragma unroll 8
    for (int t = 0; t < 64; ++t) {
        const float fr = __uint_as_float((unsigned)hp[(size_t)t * 3072 + 256] << 16);
        run += __logf(lb + (1.0f - lb) * sigm(fr));
        cmid = (t == 31) ? run : cmid;
    }
    const float blast = run;
    Dk[(size_t)ci * 64 + lane] = __expf(blast);
    unsigned short* qt = Qt + (size_t)ci * 4096 + lane; unsigned short* kt = Kt + (size_t)ci * 4096 + lane; unsigned short* qp = Qp + (size_t)ci * 4096 + lane;
    unsigned short* vt = VT + (size_t)ci * 4096 + lane * 64;
    const int h = lane >> 5, r = lane & 31;
    f32x16 acc[2][2];
#pragma unroll
    for (int a = 0; a < 2; ++a)
#pragma unroll
        for (int c = 0; c < 2; ++c) zero(acc[a][c]);
    float bt = 0.f;
#pragma unroll 1
    for (int ks = 0; ks < 4; ++ks) {
        unsigned kp[8], vp[8];
#pragma unroll
        for (int tp = 0; tp < 8; ++tp) {
            float k2v[2], ivv[2];
#pragma unroll
            for (int e = 0; e < 2; ++e) {
                const int t = ks * 16 + tp * 2 + e;
                const float qr = __uint_as_float((unsigned)hp[(size_t)t * 3072] << 16), fr = __uint_as_float((unsigned)hp[(size_t)t * 3072 + 256] << 16);
                ivv[e] = __uint_as_float((unsigned)hp[(size_t)t * 3072 + 512] << 16);
                const float sf = sigm(fr);
                const float q = qr * sigm(qr), kk = (1.0f - lb) * (1.0f - sf);
                bt += __logf(lb + (1.0f - lb) * sf);
                qt[t * 64] = (unsigned short)(cvtpk(q * __expf(bt - cmid), 0.f) & 0xffffu);
                kt[t * 64] = (unsigned short)(cvtpk(kk * __expf(cmid - bt), 0.f) & 0xffffu);
                qp[t * 64] = (unsigned short)(cvtpk(q * __expf(bt), 0.f) & 0xffffu);
                k2v[e] = kk * __expf(blast - bt);
            }
            kp[tp] = cvtpk(k2v[0], k2v[1]); vp[tp] = cvtpk(ivv[0], ivv[1]);
        }
        { u32x4 u0 = {vp[0], vp[1], vp[2], vp[3]}, u1 = {vp[4], vp[5], vp[6], vp[7]};
          *(u32x4*)(vt + ks * 16) = u0; *(u32x4*)(vt + ks * 16 + 8) = u1; }
        u32x4 kown, vown, ksnd, vsnd;
#pragma unroll
        for (int j = 0; j < 4; ++j) { kown[j] = h ? kp[4 + j] : kp[j]; ksnd[j] = h ? kp[j] : kp[4 + j]; vown[j] = h ? vp[4 + j] : vp[j]; vsnd[j] = h ? vp[j] : vp[4 + j]; }
        u32x4 krcv, vrcv;
#pragma unroll
        for (int j = 0; j < 4; ++j) { krcv[j] = (unsigned)__shfl_xor((int)ksnd[j], 32); vrcv[j] = (unsigned)__shfl_xor((int)vsnd[j], 32); }
        const bf16x8 kb0 = __builtin_bit_cast(bf16x8, h ? krcv : kown), kb1 = __builtin_bit_cast(bf16x8, h ? kown : krcv);
        const bf16x8 va0 = __builtin_bit_cast(bf16x8, h ? vrcv : vown), va1 = __builtin_bit_cast(bf16x8, h ? vown : vrcv);
        acc[0][0] = WT_MFMA(va0, kb0, acc[0][0]); acc[0][1] = WT_MFMA(va0, kb1, acc[0][1]);
        acc[1][0] = WT_MFMA(va1, kb0, acc[1][0]); acc[1][1] = WT_MFMA(va1, kb1, acc[1][1]);
    }
    float* up = Ut + (size_t)ci * 4096;
#pragma unroll
    for (int vb = 0; vb < 2; ++vb)
#pragma unroll
        for (int kb = 0; kb < 2; ++kb)
#pragma unroll
            for (int i = 0; i < 16; ++i) { const int v = 32 * vb + (i & 3) + 8 * (i >> 2) + 4 * h; up[v * 64 + 32 * kb + r] = acc[vb][kb][i]; }
}
__device__ __forceinline__ void hg_scan(const float* __restrict__ Ut, const float* __restrict__ Dk, unsigned short* __restrict__ ST, int e) {
    const int k = e & 63, seq = e >> 12, vk = e & 4095;
    float S = 0.f;
    const float* up = Ut + (size_t)seq * 64 * 4096 + vk; const float* dp = Dk + (size_t)seq * 64 * 64 + k; unsigned short* sp = ST + (size_t)seq * 64 * 4096 + vk;
#pragma unroll 8
    for (int c = 0; c < 64; ++c) {
        sp[(size_t)c * 4096] = (unsigned short)(cvtpk(S, 0.f) & 0xffffu);
        S = fmaf(dp[c * 64], S, up[(size_t)c * 4096]);
    }
}
__device__ __forceinline__ void hg_pass3(const unsigned short* __restrict__ hb, const unsigned short* __restrict__ Qt, const unsigned short* __restrict__ Kt, const unsigned short* __restrict__ Qp,
                                         const unsigned short* __restrict__ VT, const unsigned short* __restrict__ ST, const float* __restrict__ normw, unsigned short* __restrict__ ycat, int task, int lane) {
    const int tblk = task & 1, ci = task >> 1, chunk = ci & 63, hd = (ci >> 6) & 3, b = ci >> 8, r = lane & 31, h = lane >> 5;
    const size_t cb = (size_t)ci * 4096;
    f32x16 o0, o1; zero(o0); zero(o1);
    {
        const unsigned short* sp = ST + cb + (size_t)r * 64 + 8 * h; const unsigned short* qp = Qp + cb + (size_t)(32 * tblk + r) * 64 + 8 * h;
#pragma unroll
        for (int ks = 0; ks < 4; ++ks) { const bf16x8 q = ld16(qp + 16 * ks); o0 = WT_MFMA(ld16(sp + 16 * ks), q, o0); o1 = WT_MFMA(ld16(sp + 32 * 64 + 16 * ks), q, o1); }
    }
    const unsigned short* qtp = Qt + cb + (size_t)(32 * tblk + r) * 64 + 8 * h;
    bf16x8 qf[4];
#pragma unroll
    for (int ks = 0; ks < 4; ++ks) qf[ks] = ld16(qtp + 16 * ks);
#pragma unroll 1
    for (int sblk = 0; sblk <= tblk; ++sblk) {
        f32x16 at; zero(at);
        const unsigned short* ktp = Kt + cb + (size_t)(32 * sblk + r) * 64 + 8 * h;
#pragma unroll
        for (int ks = 0; ks < 4; ++ks) at = WT_MFMA(ld16(ktp + 16 * ks), qf[ks], at);
        if (sblk == tblk) {
#pragma unroll
            for (int i = 0; i < 16; ++i) { const int sl = (i & 3) + 8 * (i >> 2) + 4 * h; at[i] = (sl <= r) ? at[i] : 0.f; }
        }
#pragma unroll
        for (int s2 = 0; s2 < 2; ++s2) {
            const bf16x8 pb = pack8(at, s2);
            const unsigned short* vp = VT + cb + (size_t)r * 64 + 32 * sblk + 16 * s2 + 4 * h;
            o0 = WT_MFMA(ld8x2(vp, vp + 8), pb, o0);
            o1 = WT_MFMA(ld8x2(vp + 32 * 64, vp + 32 * 64 + 8), pb, o1);
        }
    }
    const int tok = b * 4096 + chunk * 64 + 32 * tblk + r;
    float ss = 0.f;
#pragma unroll
    for (int i = 0; i < 16; ++i) ss += o0[i] * o0[i] + o1[i] * o1[i];
    ss += xhalf(ss);
    const float rn = rsqrtf(ss * (1.0f / 64.0f) + 1e-6f);
    const unsigned short* gp = hb + (size_t)tok * 3072 + 768 + hd * 64;
    unsigned short* yp = ycat + (size_t)tok * 1024 + hd * 64;
    const float* nw = normw + hd * 64;
#pragma unroll
    for (int vb = 0; vb < 2; ++vb)
#pragma unroll
        for (int u = 0; u < 4; ++u) {
            const int v0 = 32 * vb + 8 * u + 4 * h;
            const u32x2 gg = *(const u32x2*)(gp + v0); const float4 w4 = *(const float4*)(nw + v0);
            const float x0 = (vb ? o1[4 * u] : o0[4 * u]) * rn * w4.x * sigm(bflo(gg.x)), x1 = (vb ? o1[4 * u + 1] : o0[4 * u + 1]) * rn * w4.y * sigm(bfhi(gg.x));
            const float x2 = (vb ? o1[4 * u + 2] : o0[4 * u + 2]) * rn * w4.z * sigm(bflo(gg.y)), x3 = (vb ? o1[4 * u + 3] : o0[4 * u + 3]) * rn * w4.w * sigm(bfhi(gg.y));
            u32x2 o = {cvtpk(x0, x1), cvtpk(x2, x3)};
            *(u32x2*)(yp + v0) = o;
        }
}

__device__ __forceinline__ void route_task(const unsigned short* __restrict__ x1, const unsigned short* __restrict__ rwh, const unsigned short* __restrict__ rwl, const float* __restrict__ rb,
                                           int* __restrict__ cnt, int* __restrict__ list, int* __restrict__ tok_e, int* __restrict__ tok_slot, float* __restrict__ tok_w, int task, int lane) {
    const int r = lane & 31, h = lane >> 5, tok = task * 32 + r;
    const unsigned short* xp = x1 + (size_t)tok * 1024 + 8 * h;
    const unsigned short* whp = rwh + (size_t)r * 1024 + 8 * h; const unsigned short* wlp = rwl + (size_t)r * 1024 + 8 * h;
    f32x16 acc; zero(acc);
#pragma unroll 8
    for (int ks = 0; ks < 64; ++ks) {
        const bf16x8 xh = ld16(xp + 16 * ks);
        acc = WT_MFMA(ld16(whp + 16 * ks), xh, acc); acc = WT_MFMA(ld16(wlp + 16 * ks), xh, acc);
    }
    float v[16];
#pragma unroll
    for (int i = 0; i < 16; ++i) v[i] = acc[i] + rb[(i & 3) + 8 * (i >> 2) + 4 * h];
    float cv[8]; int ce[8];
#pragma unroll
    for (int k = 0; k < 4; ++k) {
        float best = -3.0e38f; int bi = 0;
#pragma unroll
        for (int i = 0; i < 16; ++i) { const bool ok = v[i] > best; best = ok ? v[i] : best; bi = ok ? i : bi; }
#pragma unroll
        for (int i = 0; i < 16; ++i) v[i] = (i == bi) ? -3.0e38f : v[i];
        cv[k] = best; ce[k] = (bi & 3) + 8 * (bi >> 2) + 4 * h;
    }
#pragma unroll
    for (int k = 0; k < 4; ++k) { cv[4 + k] = xhalf(cv[k]); ce[4 + k] = __shfl_xor(ce[k], 32); }
    float tl[4]; int te[4];
#pragma unroll
    for (int k = 0; k < 4; ++k) {
        float best = -3.0e38f; int be = 64, bj = 0;
#pragma unroll
        for (int j = 0; j < 8; ++j) { const bool ok = (cv[j] > best) || (cv[j] == best && ce[j] < be); best = ok ? cv[j] : best; be = ok ? ce[j] : be; bj = ok ? j : bj; }
#pragma unroll
        for (int j = 0; j < 8; ++j) cv[j] = (j == bj) ? -3.0e38f : cv[j];
        tl[k] = best; te[k] = be;
    }
    const float e1 = __expf(tl[1] - tl[0]), e2 = __expf(tl[2] - tl[0]), e3 = __expf(tl[3] - tl[0]);
    const float inv = 1.0f / (1.0f + e1 + e2 + e3);
    const float tw[4] = {inv, e1 * inv, e2 * inv, e3 * inv};
    unsigned mymask = 0u;
#pragma unroll 1
    for (int e = 0; e < 32; ++e) {
        const unsigned mk = (unsigned)__ballot(h == 0 && (te[0] == e || te[1] == e || te[2] == e || te[3] == e));
        mymask = (lane == e) ? mk : mymask;
    }
    int base = 0;
    if (lane < 32 && mymask != 0u) base = atomicAdd(&cnt[lane], __popc(mymask));
#pragma unroll
    for (int k = 0; k < 4; ++k) {
        const int bk = __shfl(base, te[k]); const unsigned mk = (unsigned)__shfl((int)mymask, te[k]);
        const int slot = bk + __popc(mk & ((1u << r) - 1u));
        if (h == 0) { list[te[k] * 32768 + slot] = tok; tok_e[tok * 4 + k] = te[k]; tok_slot[tok * 4 + k] = slot; tok_w[tok * 4 + k] = tw[k]; }
    }
}
}


__device__ __forceinline__ void ln1_tok(const float* __restrict__ xin_f, const bf16* __restrict__ xin_b, const bf16* __restrict__ mix, const float* __restrict__ lw, const float* __restrict__ lbias,
                                        bf16* __restrict__ x1b, unsigned char* __restrict__ x1q, int tok, int lane) {
    float v[16]; float s = 0.f;
#pragma unroll
    for (int j = 0; j < 4; ++j) {
        float4 a;
        if (xin_f) a = *(const float4*)(xin_f + (size_t)tok * D_ + j * 256 + lane * 4);
        else { const uint2 ab = *(const uint2*)(xin_b + (size_t)tok * D_ + j * 256 + lane * 4);
               a = make_float4(__uint_as_float(ab.x << 16), __uint_as_float(ab.x & 0xffff0000u), __uint_as_float(ab.y << 16), __uint_as_float(ab.y & 0xffff0000u)); }
        uint2 mb = *(const uint2*)(mix + (size_t)tok * D_ + j * 256 + lane * 4);
        float4 m = make_float4(__uint_as_float(mb.x << 16), __uint_as_float(mb.x & 0xffff0000u), __uint_as_float(mb.y << 16), __uint_as_float(mb.y & 0xffff0000u));
        v[4 * j] = ALPHA * a.x + m.x; v[4 * j + 1] = ALPHA * a.y + m.y; v[4 * j + 2] = ALPHA * a.z + m.z; v[4 * j + 3] = ALPHA * a.w + m.w;
        s += v[4 * j] + v[4 * j + 1] + v[4 * j + 2] + v[4 * j + 3];
    }
    float mean = wsum(s) * (1.0f / D_); float q = 0.f;
#pragma unroll
    for (int i = 0; i < 16; ++i) { v[i] -= mean; q += v[i] * v[i]; }
    float rstd = rsqrtf(wsum(q) * (1.0f / D_) + 1e-5f);
#pragma unroll
    for (int j = 0; j < 4; ++j) {
        float4 w4 = *(const float4*)(lw + j * 256 + lane * 4), b4 = *(const float4*)(lbias + j * 256 + lane * 4);
        float4 o = make_float4(v[4 * j] * rstd * w4.x + b4.x, v[4 * j + 1] * rstd * w4.y + b4.y, v[4 * j + 2] * rstd * w4.z + b4.z, v[4 * j + 3] * rstd * w4.w + b4.w);
        *(uint2*)(x1b + (size_t)tok * D_ + j * 256 + lane * 4) = make_uint2(pk2(o.x, o.y), pk2(o.z, o.w));
        *(unsigned*)(x1q + (size_t)tok * D_ + j * 256 + lane * 4) = pg8::pk4_fp8(o.x, o.y, o.z, o.w);
    }
}
__device__ __forceinline__ void comb_ln2_tok(const bf16* __restrict__ x1, const bf16* __restrict__ y, const int* __restrict__ offs, const int* __restrict__ tok_e,
                                             const int* __restrict__ tok_slot, const float* __restrict__ tok_w, const float* __restrict__ lw, const float* __restrict__ lbias,
                                             float* __restrict__ xout, bf16* __restrict__ xbout, int tok, int lane) {
    float v[16];
#pragma unroll
    for (int j = 0; j < 4; ++j) { const uint2 ab = *(const uint2*)(x1 + (size_t)tok * D_ + j * 256 + lane * 4);
        v[4 * j] = ALPHA * __uint_as_float(ab.x << 16); v[4 * j + 1] = ALPHA * __uint_as_float(ab.x & 0xffff0000u); v[4 * j + 2] = ALPHA * __uint_as_float(ab.y << 16); v[4 * j + 3] = ALPHA * __uint_as_float(ab.y & 0xffff0000u); }
#pragma unroll
    for (int k = 0; k < 4; ++k) {
        int e = tok_e[tok * 4 + k]; int row = offs[e] + tok_slot[tok * 4 + k]; float wk = tok_w[tok * 4 + k];
#pragma unroll
        for (int j = 0; j < 4; ++j) { uint2 ab = *(const uint2*)(y + (size_t)row * D_ + j * 256 + lane * 4);
            float4 a = make_float4(__uint_as_float(ab.x << 16), __uint_as_float(ab.x & 0xffff0000u), __uint_as_float(ab.y << 16), __uint_as_float(ab.y & 0xffff0000u));
            v[4 * j] = fmaf(wk, a.x, v[4 * j]); v[4 * j + 1] = fmaf(wk, a.y, v[4 * j + 1]); v[4 * j + 2] = fmaf(wk, a.z, v[4 * j + 2]); v[4 * j + 3] = fmaf(wk, a.w, v[4 * j + 3]); }
    }
    float s = 0.f;
#pragma unroll
    for (int i = 0; i < 16; ++i) s += v[i];
    float mean = wsum(s) * (1.0f / D_); float q = 0.f;
#pragma unroll
    for (int i = 0; i < 16; ++i) { v[i] -= mean; q += v[i] * v[i]; }
    float rstd = rsqrtf(wsum(q) * (1.0f / D_) + 1e-5f);
#pragma unroll
    for (int j = 0; j < 4; ++j) {
        float4 w4 = *(const float4*)(lw + j * 256 + lane * 4), b4 = *(const float4*)(lbias + j * 256 + lane * 4);
        float4 o = make_float4(v[4 * j] * rstd * w4.x + b4.x, v[4 * j + 1] * rstd * w4.y + b4.y, v[4 * j + 2] * rstd * w4.z + b4.z, v[4 * j + 3] * rstd * w4.w + b4.w);
        if (xout) *(float4*)(xout + (size_t)tok * D_ + j * 256 + lane * 4) = o;
        if (xbout) *(uint2*)(xbout + (size_t)tok * D_ + j * 256 + lane * 4) = make_uint2(pk2(o.x, o.y), pk2(o.z, o.w));
    }
}

struct Args { const float* in[25]; float* out; unsigned char* ws; int ph_lo, ph_hi; };
#define PH __device__ __forceinline__
constexpr int TAB_OFF = 131072;

__device__ __forceinline__ void transpose_item(const float* __restrict__ W, int K, int N, bf16* __restrict__ WT, int k0, int scol0, int drow0, float* scr, int lane) {
    const int cc = lane & 31; const bool cv = (scol0 + cc) < N;
#pragma unroll 8
    for (int i = 0; i < 32; ++i) { const int kk = 2 * i + (lane >> 5); scr[kk * 33 + cc] = cv ? W[(size_t)(k0 + kk) * N + scol0 + cc] : 0.f; }
    asm volatile("s_waitcnt lgkmcnt(0)" ::: "memory");
    const int c = lane & 7;
#pragma unroll
    for (int j = 0; j < 4; ++j) { const int n = (lane >> 3) + 8 * j; const float* s = scr + (8 * c) * 33 + n;
        uint4 o; o.x = pk2(s[0 * 33], s[1 * 33]); o.y = pk2(s[2 * 33], s[3 * 33]); o.z = pk2(s[4 * 33], s[5 * 33]); o.w = pk2(s[6 * 33], s[7 * 33]);
        *(uint4*)(WT + (size_t)(drow0 + n) * K + k0 + 8 * c) = o; }
    asm volatile("s_waitcnt lgkmcnt(0)" ::: "memory");
}
__device__ __forceinline__ void transpose64(const float* __restrict__ W, int K, int N, bf16* __restrict__ WT, int k0, int scol0, int drow0, int lane) {
    const int q = lane >> 4, c = lane & 15;
    const bool cv = (scol0 + 4 * c) < N;
    const float* src = W + (size_t)(k0 + 16 * q) * N + scol0 + 4 * c;
    float4 v[16];
#pragma unroll
    for (int i = 0; i < 16; ++i) v[i] = cv ? *(const float4*)(src + (size_t)i * N) : make_float4(0.f, 0.f, 0.f, 0.f);
    bf16* dst = WT + (size_t)(drow0 + 4 * c) * K + k0 + 16 * q;
#pragma unroll
    for (int j = 0; j < 4; ++j) {
        float e[16];
#pragma unroll
        for (int i = 0; i < 16; ++i) e[i] = (j == 0) ? v[i].x : (j == 1) ? v[i].y : (j == 2) ? v[i].z : v[i].w;
        uint4 o0, o1;
        o0.x = pk2(e[0], e[1]); o0.y = pk2(e[2], e[3]); o0.z = pk2(e[4], e[5]); o0.w = pk2(e[6], e[7]);
        o1.x = pk2(e[8], e[9]); o1.y = pk2(e[10], e[11]); o1.z = pk2(e[12], e[13]); o1.w = pk2(e[14], e[15]);
        *(uint4*)(dst + (size_t)j * K) = o0; *(uint4*)(dst + (size_t)j * K + 8) = o1;
    }
}
__device__ __forceinline__ void transpose64_f8(const float* __restrict__ W, int K, int N, unsigned char* __restrict__ WT, int k0, int scol0, int drow0, float sc, int lane) {
    const int q = lane >> 4, c = lane & 15;
    const float* src = W + (size_t)(k0 + 16 * q) * N + scol0 + 4 * c;
    float4 v[16];
#pragma unroll
    for (int i = 0; i < 16; ++i) v[i] = *(const float4*)(src + (size_t)i * N);
    unsigned char* dst = WT + (size_t)(drow0 + 4 * c) * K + k0 + 16 * q;
#pragma unroll
    for (int j = 0; j < 4; ++j) {
        float e[16];
#pragma unroll
        for (int i = 0; i < 16; ++i) e[i] = sc * ((j == 0) ? v[i].x : (j == 1) ? v[i].y : (j == 2) ? v[i].z : v[i].w);
        uint4 o;
        o.x = pg8::pk4_fp8(e[0], e[1], e[2], e[3]); o.y = pg8::pk4_fp8(e[4], e[5], e[6], e[7]); o.z = pg8::pk4_fp8(e[8], e[9], e[10], e[11]); o.w = pg8::pk4_fp8(e[12], e[13], e[14], e[15]);
        *(uint4*)(dst + (size_t)j * K) = o;
    }
}
PH void ph_prologue(int wv, const int* pos, const float* hg_lb, float* cosT, float* sinT, float* lb,
                    const float* x, bf16* xb, const float* w_in, const float* w_out, const float* w_up, const float* w_dn, bf16* wt_in, bf16* wt_out, bf16* wt_up, bf16* wt_dn,
                    const float* gm_sw, bf16* wb, const float* cpe, const float* cw1, bf16* w1t, float* cbias, const float* cw2, bf16* w2t, const float* rw, bf16* rwh, bf16* rwl) {
    extern __shared__ __attribute__((aligned(16))) unsigned char lds[];
    int tid = mk_tid(wv), bid = blockIdx.x; asm volatile("" : "+v"(tid), "+s"(bid)); const int G = gridDim.x, lane = tid & 63, wave = wv;
#pragma unroll 1
    for (int i = bid * NTHR + tid; i < NT * 32; i += G * NTHR) {
        int t = i >> 5, j = i & 31;
        float inv = (float)pow(10000.0, -(double)(2 * j) / 64.0);
        float ang = (float)pos[t] * inv;
        const double ad = (double)ang, kk = rint(ad * 0.15915494309189535);
        const float rf = (float)fma(-kk, 6.283185307179586, ad);
        cosT[i] = cosf(rf); sinT[i] = sinf(rf);
    }
    if (bid == 0 && tid < 256) {
        float p0 = hg_lb[tid], p1 = hg_lb[256 + tid];
        float m = fmaxf(p0, p1); float ea = expf(p0 - m), eb = expf(p1 - m);
        lb[tid] = 0.f; lb[256 + tid] = eb / (ea + eb);
    }
#pragma unroll 1
    for (size_t i = (size_t)bid * NTHR + tid; i < (size_t)NT * D_ / 4; i += (size_t)G * NTHR) {
        float4 v = ((const float4*)x)[i]; ((uint2*)xb)[i] = make_uint2(pk2(v.x, v.y), pk2(v.z, v.w));
    }
#pragma unroll 1
    for (int i = bid * NTHR + tid; i < DEPTH * NE * D_; i += G * NTHR) { const int k = i & 1023, e = (i >> 10) & 31, l = i >> 15; const float w = rw[((size_t)l * D_ + k) * NE + e];
        const unsigned hi = f2bf(w); rwh[i] = (bf16)hi; rwl[i] = (bf16)f2bf(w - __uint_as_float(hi << 16)); }
#pragma unroll 1
    for (int i = bid * NTHR + tid; i < DEPTH * 4 * 128 * 128; i += G * NTHR) { const int s = i & 127, t = (i >> 7) & 127; wb[i] = (bf16)f2bf(s <= t ? gm_sw[i] : 0.f); }
    if (bid == (G > 1 ? 1 : 0)) {
        const int lk = tid >> 7, n = tid & 127;
        float a = 0.f;
#pragma unroll 4
        for (int i = 0; i < 2048; ++i) a = fmaf(cpe[lk * 2048 + i], cw1[((size_t)lk * 2048 + i) * 128 + n], a);
        cbias[lk * 128 + n] = a;
    }
    float* scr = (float*)(lds + wave * 16384);
    const int gw = bid * 8 + wave, NGW = G * 8;
    constexpr int I_IN = 16 * 45, I_OUT = 16 * 16;
    constexpr int I_C1 = 32 * 4;
    constexpr int I_C2 = 2 * 2;
    constexpr int PER_L = I_IN + I_OUT + 2 * I_C1 + 2 * I_C2;
#pragma unroll 1
    for (int it = gw; it < DEPTH * PER_L; it += NGW) {
        const int l = it / PER_L; int r = it % PER_L;
        if (r < I_IN) { const int kb = r / 45, nb = r % 45; transpose64(w_in + (size_t)l * D_ * INW, D_, INW, wt_in + (size_t)l * HS * D_, kb * 64, nb * 64, nb * 64, lane); continue; }
        r -= I_IN;
        if (r < I_OUT) { const int kb = r / 16, nb = r % 16; transpose64(w_out + (size_t)l * D_ * D_, D_, D_, wt_out + (size_t)l * D_ * D_, kb * 64, nb * 64, nb * 64, lane); continue; }
        r -= I_OUT;
        if (r < 2 * I_C1) { const int kv = r / I_C1, q = r % I_C1, kb = q / 4, nb = q % 4;
            transpose_item(cw1 + ((size_t)l * 2 + kv) * 2048 * 128, 2048, 128, w1t + ((size_t)l * 2 + kv) * 128 * 2048, kb * 64, nb * 32, nb * 32, scr, lane); continue; }
        r -= 2 * I_C1;
        { const int kv = r / I_C2, q = r % I_C2, kb = q / 2, nb = q % 2;
            transpose_item(cw2 + ((size_t)l * 2 + kv) * 128 * 64, 128, 64, w2t + ((size_t)l * 2 + kv) * 64 * 128, kb * 64, nb * 32, nb * 32, scr, lane); }
    }
}
#define M1EN(x) 1
#ifndef M1REP
#define M1R(x) 1
#else
#define M1R(x) (((x) == M1REP) ? 3 : 1)
#endif
PH void ph_mix1(int wv, const bf16* hb, const float* lb, bf16* hqt, bf16* hkt, bf16* hqp, bf16* hvt, float* hut, float* hdk,
                const float* glw, const float* glb, bf16* vlnT, const bf16* w1t, const float* cbias, const bf16* w2, bf16* kcb, bf16* vcb,
                const float* cosT, const float* sinT, bf16* ksb, bf16* vsb, bf16* kwb, bf16* vwb,
                const float* w_up, const float* w_dn, unsigned char* wt_up, unsigned char* wt_dn) {
    extern __shared__ __attribute__((aligned(16))) unsigned char lds[];
    int tid = mk_tid(wv), bid = blockIdx.x; asm volatile("" : "+v"(tid), "+s"(bid)); const int lane = tid & 63, wave = wv, G = gridDim.x;
    const int gw = bid * 8 + wave, NGW = G * 8;
    { int ln = lane; asm volatile("" : "+v"(ln));
#pragma unroll 1
    for (int rp = 0; rp < M1R(1); ++rp)
#pragma unroll 1
    for (int u = bid; u < 256 && M1EN(1); u += G) wt::cmp_wg(hb, w1t, cbias, w2, kcb, vcb, (WT_LAS float*)lds, u, wave, ln); }
    { int ln = lane; asm volatile("" : "+v"(ln));
#pragma unroll 1
    for (int rp = 0; rp < M1R(2); ++rp)
#pragma unroll 1
    for (int u = gw; u < 2048 && M1EN(2); u += NGW) wt::hg_pass1(hb, lb, hqt, hkt, hqp, hvt, hut, hdk, u, ln); }
    { int ln = lane; asm volatile("" : "+v"(ln));
#pragma unroll 1
    for (int rp = 0; rp < M1R(4); ++rp)
#pragma unroll 1
    for (int u = gw; u < NT / 8 && M1EN(4); u += NGW) wt::gm_ln8(hb, glw, glb, vlnT, u, ln); }
#pragma unroll 1
    for (int rp = 0; rp < M1R(8); ++rp)
#pragma unroll 1
    for (int idx = bid * NTHR + tid; idx < NT * 8; idx += G * NTHR) wt::kvprep8(hb, cosT, sinT, ksb, vsb, kwb, vwb, idx);
    { int ln = lane; asm volatile("" : "+v"(ln));
      constexpr int I_UP = 16 * 32, I_DN = 16 * 16;
#pragma unroll 1
      for (int rp = 0; rp < M1R(16); ++rp)
#pragma unroll 1
      for (int it = gw; it < NE * (I_UP + I_DN); it += NGW) {
          int r = it;
          if (r < NE * I_UP) { const int e = r / I_UP, q = r % I_UP, kb = q / 32, nb = q % 32;
              const int n0 = nb * 64, pn = n0 >> 8, bj = (n0 >> 7) & 1, jj = n0 & 127;
              transpose64_f8(w_up + (size_t)e * D_ * 2048, D_, 2048, wt_up + (size_t)e * 2048 * D_, kb * 64, bj * 1024 + 128 * pn + jj, n0, pg8::F8_SU, ln); continue; }
          r -= NE * I_UP;
          { const int e = r / I_DN, q = r % I_DN, kb = q / 16, nb = q % 16;
              transpose64_f8(w_dn + (size_t)e * D_ * D_, D_, D_, wt_dn + (size_t)e * D_ * D_, kb * 64, nb * 64, nb * 64, pg8::F8_SD, ln); }
      } }
}
PH void ph_mix2(int wv, const float* hut, const float* hdk, bf16* hst, const bf16* hb, const bf16* vlnT, const bf16* wb, const float* sb, const float* nw, bf16* ycat) {
    int tid = mk_tid(wv), bid = blockIdx.x; asm volatile("" : "+v"(tid), "+s"(bid)); const int lane = tid & 63, wave = wv, G = gridDim.x;
#pragma unroll 1
    for (int e = bid * NTHR + tid; e < 32 * 4096; e += G * NTHR) wt::hg_scan(hut, hdk, hst, e);
    const int gw = bid * 8 + wave, NGW = G * 8;
#pragma unroll 1
    for (int u = gw; u < 4096; u += NGW) wt::gm_sp_task(hb, vlnT, wb, sb, nw, ycat, u, lane);
}
PH void ph_hg3(int wv, const bf16* hb, const bf16* hqt, const bf16* hkt, const bf16* hqp, const bf16* hvt, const bf16* hst, const float* nw, bf16* ycat) {
    int tid = mk_tid(wv), bid = blockIdx.x; asm volatile("" : "+v"(tid), "+s"(bid)); const int lane = tid & 63, wave = wv, G = gridDim.x;
    const int gw = bid * 8 + wave, NGW = G * 8;
#pragma unroll 1
    for (int u = gw; u < 4096; u += NGW) wt::hg_pass3(hb, hqt, hkt, hqp, hvt, hst, nw, ycat, u, lane);
}
PH void ph_ln1(int wv, const float* xin_f, const bf16* xin_b, const bf16* mix, const float* lw, const float* lb, bf16* x1b, unsigned char* x1q) {
    int tid = mk_tid(wv), bid = blockIdx.x; asm volatile("" : "+v"(tid), "+s"(bid)); const int lane = tid & 63, wave = wv, G = gridDim.x;
#pragma unroll 1
    for (int t = bid * 8 + wave; t < NT; t += G * 8) ln1_tok(xin_f, xin_b, mix, lw, lb, x1b, x1q, t, lane);
}
PH void ph_route(int wv, const bf16* x1, const bf16* rwh, const bf16* rwl, const float* rb, int* cnt, int* list, int* tok_e, int* tok_slot, float* tok_w) {
    int tid = mk_tid(wv), bid = blockIdx.x; asm volatile("" : "+v"(tid), "+s"(bid)); const int lane = tid & 63, wave = wv, G = gridDim.x;
#pragma unroll 1
    for (int u = bid * 8 + wave; u < NT / 32; u += G * 8) wt::route_task(x1, rwh, rwl, rb, cnt, list, tok_e, tok_slot, tok_w, u, lane);
}
PH void ph_comb(int wv, const bf16* x1, const bf16* ybuf, const int* tok_e, const int* tok_slot, const float* tok_w, const float* lw, const float* lb, float* xo, bf16* xbo) {
    extern __shared__ __attribute__((aligned(16))) unsigned char lds[];
    const int* offs_s = (const int*)(lds + TAB_OFF + 512);
    int tid = mk_tid(wv), bid = blockIdx.x; asm volatile("" : "+v"(tid), "+s"(bid)); const int lane = tid & 63, wave = wv, G = gridDim.x;
#pragma unroll 1
    for (int t = bid * 8 + wave; t < NT; t += G * 8) comb_ln2_tok(x1, ybuf, offs_s, tok_e, tok_slot, tok_w, lw, lb, xo, xbo, t, lane);
}

typedef const Args __attribute__((address_space(4))) CArgs;
#define PHASE_BEGIN CArgs* ap = (CArgs*)__builtin_amdgcn_kernarg_segment_ptr(); int l_ = l; asm volatile("" : "+s"(ap), "+s"(l_)); unsigned char* const ws_ = ap->ws; \
    const int G = gridDim.x; int bid = blockIdx.x; asm volatile("" : "+s"(bid));
#define WP(T, off) ((T*)(ws_ + (off)))
#define INP(k) (ap->in[k])
__global__ void __launch_bounds__(NTHR, 2) mega(Args a) {
    extern __shared__ __attribute__((aligned(16))) unsigned char lds[];
    volatile LAS unsigned* MISC = (volatile LAS unsigned*)((LAS unsigned char*)lds + MISC_OFF);
    int wv = __builtin_amdgcn_readfirstlane((int)threadIdx.x >> 6); asm volatile("" : "+s"(wv));
    { const int t0 = mk_tid(wv); if (t0 < 64) MISC[t0] = 0u; }
    __syncthreads();
    XcdBarrier bar = xcd_barrier_post((unsigned*)a.ws, MISC + 8, wv);
    int* tstart = (int*)(lds + TAB_OFF); int* cnts = (int*)(lds + TAB_OFF + 256); int* offs_s = (int*)(lds + TAB_OFF + 512);
    PG8_LAS unsigned char* ldsl = (PG8_LAS unsigned char*)lds;

#ifndef PH_MASK
#define EN(n) 1
#else
#define EN(n) ((PH_MASK >> ((n) % 20)) & 1)
#endif
#define IN(k) 1
#ifndef REP_PH
#define REPL(id)
#else
#define REPL(id) _Pragma("unroll 1") for (int rep_ = 0; rep_ < (((id) == REP_PH) ? REP_N : 1); ++rep_)
#endif
#define SEAM(k) xcd_barrier(bar)

    REPL(19) if (EN(19) && IN(0)) { const int l = 0; PHASE_BEGIN; (void)l_; (void)G; (void)bid;
        ph_prologue(wv, (const int*)INP(1), INP(3), WP(float, O_COS), WP(float, O_SIN), WP(float, O_LB), INP(0), WP(bf16, O_XB), INP(2), INP(14), INP(19), INP(21),
                    WP(bf16, O_WIN), WP(bf16, O_WOUT), WP(bf16, O_WUP), WP(bf16, O_WDN), INP(7), WP(bf16, O_WB), INP(10), INP(11), WP(bf16, O_W1T), WP(float, O_CBIAS), INP(12), WP(bf16, O_W2T), INP(17), WP(bf16, O_RWH), WP(bf16, O_RWL)); }
    xcd_barrier_first(bar);

#pragma unroll 1
    for (int l = 0; l < DEPTH; ++l) {
        REPL(0) if (EN(0) && IN(pb + 0)) {
            PHASE_BEGIN;
            pg8::PlainOrder S{WP(bf16, O_WIN) + (size_t)l_ * HS * D_, D_, NT / 256, HS / 256, G, bid};
            pg8::EpiBf16 E{WP(bf16, O_HB), HS, nullptr, 0};
            pg8::gemm_phase<pg8::EpiBf16, pg8::PlainOrder, true>(wv, ldsl, WP(bf16, O_XB), D_ * 2, S, E);
#ifdef DUP_WIN
            pg8::gemm_phase<pg8::EpiBf16, pg8::PlainOrder, true>(wv, ldsl, WP(bf16, O_XB), D_ * 2, S, E);
#endif
        }
        SEAM(pb + 0);
        REPL(1) if (EN(1)) {
            PHASE_BEGIN; (void)G; (void)bid;
            ph_mix1(wv, WP(bf16, O_HB), WP(float, O_LB) + l_ * 256, WP(bf16, O_HQT), WP(bf16, O_HKT), WP(bf16, O_HQP), WP(bf16, O_HVT), WP(float, O_HUT), WP(float, O_HDK),
                    INP(5) + l_ * 256, INP(6) + l_ * 256, WP(bf16, O_VLNT), WP(bf16, O_W1T) + (size_t)l_ * 2 * 128 * 2048, WP(float, O_CBIAS) + l_ * 256, WP(bf16, O_W2T) + (size_t)l_ * 2 * 64 * 128,
                    WP(bf16, O_KCB), WP(bf16, O_VCB), WP(float, O_COS), WP(float, O_SIN), WP(bf16, O_KSB), WP(bf16, O_VSB), WP(bf16, O_KWB), WP(bf16, O_VWB),
                    INP(19) + (size_t)l_ * NE * D_ * 2048, INP(21) + (size_t)l_ * NE * D_ * D_, WP(unsigned char, O_WUP) + (size_t)l_ * NE * 2048 * D_, WP(unsigned char, O_WDN) + (size_t)l_ * NE * D_ * D_);
        }
        SEAM(pb + 1);
        REPL(11) if (EN(11)) {
            PHASE_BEGIN; (void)G; (void)bid;
            ph_mix2(wv, WP(float, O_HUT), WP(float, O_HDK), WP(bf16, O_HST), WP(bf16, O_HB), WP(bf16, O_VLNT), WP(bf16, O_WB) + (size_t)l_ * 4 * 128 * 128, INP(8) + l_ * 512, INP(9) + l_ * 256, WP(bf16, O_YCAT));
        }
        SEAM(pb + 1);
        {
            PHASE_BEGIN;
            REPL(2) if (EN(2)) ph_hg3(wv, WP(bf16, O_HB), WP(bf16, O_HQT), WP(bf16, O_HKT), WP(bf16, O_HQP), WP(bf16, O_HVT), WP(bf16, O_HST), INP(4) + l_ * 256, WP(bf16, O_YCAT));
            REPL(12) if (EN(12)) {
                nsa::Params NP{WP(bf16, O_HB), WP(bf16, O_KCB), WP(bf16, O_VCB), WP(bf16, O_KSB), WP(bf16, O_VSB), WP(bf16, O_KWB), WP(bf16, O_VWB), WP(float, O_COS), WP(float, O_SIN), INP(13) + l_ * 512, WP(bf16, O_YCAT)};
                int tid = mk_tid(wv); asm volatile("" : "+v"(tid));
                __syncthreads();
                nsa::phase(NP, ldsl, tid, bid, G);
            }
        }
        SEAM(pb + 2);
        REPL(3) if (EN(3) && IN(pb + 3)) {
            PHASE_BEGIN;
            pg8::PlainOrder S{WP(bf16, O_WOUT) + (size_t)l_ * D_ * D_, D_, NT / 256, D_ / 256, G, bid};
            pg8::EpiBf16 E{WP(bf16, O_MIXB), D_, nullptr, 0};
            pg8::gemm_phase<pg8::EpiBf16, pg8::PlainOrder, true>(wv, ldsl, WP(bf16, O_YCAT), D_ * 2, S, E);
#ifdef DUP_WOUT
            pg8::gemm_phase<pg8::EpiBf16, pg8::PlainOrder, true>(wv, ldsl, WP(bf16, O_YCAT), D_ * 2, S, E);
#endif
        }
        SEAM(pb + 3);
        REPL(4) if (EN(4)) {
            PHASE_BEGIN; (void)G; (void)bid;
            ph_ln1(wv, l_ == 0 ? INP(0) : (const float*)nullptr, WP(bf16, O_XB), WP(bf16, O_MIXB), INP(15) + l_ * D_, INP(16) + l_ * D_, WP(bf16, O_X1B), WP(unsigned char, O_X1Q));
        }
        SEAM(pb + 4);
        if (EN(14)) {
            PHASE_BEGIN; (void)G; (void)bid;
#ifdef DUP_ROUTE
#pragma unroll 1
            for (int rr_ = 0; rr_ < 2; ++rr_)
            ph_route(wv, WP(bf16, O_X1B), WP(bf16, O_RWH) + (size_t)l_ * NE * D_, WP(bf16, O_RWL) + (size_t)l_ * NE * D_, INP(18) + l_ * NE,
                     (int*)(ws_ + 36864) + (l_ * 2 + rr_) * 64, WP(int, O_HUT), WP(int, O_HUT) + 2 * 1048576, WP(int, O_HUT) + 3 * 1048576, WP(float, O_HUT) + 4 * 1048576);
#endif
            ph_route(wv, WP(bf16, O_X1B), WP(bf16, O_RWH) + (size_t)l_ * NE * D_, WP(bf16, O_RWL) + (size_t)l_ * NE * D_, INP(18) + l_ * NE,
                     (int*)(ws_ + 32768) + l_ * 64, WP(int, O_LIST), WP(int, O_TE), WP(int, O_TS), WP(float, O_TW));
        }
        SEAM(pb + 4);
        if (IN(pb + 5) || IN(pb + 6) || IN(pb + 7)) {
            PHASE_BEGIN; (void)G; (void)bid;
            int* cnt = (int*)(ws_ + 32768) + l_ * 64;
            __syncthreads();
            if (mk_tid(wv) == 0) { int acc = 0;
#pragma unroll 1
                for (int e = 0; e < NE; ++e) { const int c = __hip_atomic_load(&cnt[e], __ATOMIC_RELAXED, __HIP_MEMORY_SCOPE_AGENT); tstart[e] = acc; offs_s[e] = acc * 256; cnts[e] = c; acc += (c + 255) >> 8; } tstart[32] = acc; }
            __syncthreads();
        }
        REPL(5) if (EN(5) && IN(pb + 5)) {
            PHASE_BEGIN;
            pg8::MoeOrder<true> S{WP(unsigned char, O_WUP) + (size_t)l_ * NE * 2048 * D_, D_, 8, G, bid, (size_t)2048 * D_, tstart, cnts, WP(int, O_LIST)};
            pg8::EpiUpF8 E{WP(unsigned char, O_ACT), INP(20) + (size_t)l_ * NE * 2048};
            pg8::gemm_phase<pg8::EpiUpF8, pg8::MoeOrder<true>, true, true>(wv, ldsl, WP(unsigned char, O_X1Q), D_, S, E);
        }
        SEAM(pb + 5);
        REPL(6) if (EN(6) && IN(pb + 6)) {
            PHASE_BEGIN;
            pg8::MoeOrder<false> S{WP(unsigned char, O_WDN) + (size_t)l_ * NE * D_ * D_, D_, 4, G, bid, (size_t)D_ * D_, tstart, cnts, WP(int, O_LIST)};
            pg8::EpiDnF8 E{WP(bf16, O_YB), INP(22) + (size_t)l_ * NE * D_};
            pg8::gemm_phase<pg8::EpiDnF8, pg8::MoeOrder<false>, true, true>(wv, ldsl, WP(unsigned char, O_ACT), D_, S, E);
        }
        SEAM(pb + 6);
        REPL(7) if (EN(7) && IN(pb + 7)) {
            PHASE_BEGIN; (void)G; (void)bid;
            ph_comb(wv, WP(bf16, O_X1B), WP(bf16, O_YB), WP(int, O_TE), WP(int, O_TS), WP(float, O_TW), INP(23) + l_ * D_, INP(24) + l_ * D_,
                    (l_ == DEPTH - 1) ? ap->out : (float*)nullptr, (l_ == DEPTH - 1) ? (bf16*)nullptr : WP(bf16, O_XB));
        }
#ifdef XTRA_BAR
#pragma unroll 1
        for (int xb_ = 0; xb_ < XTRA_BAR; ++xb_) SEAM(pb + 7);
#endif
        if (l + 1 < DEPTH) SEAM(pb + 7);
    }
#undef IN
#undef SEAM
}
}

extern "C" void kernel_launch(void* const* d_in, const int* in_sizes, int n_in, void* d_out, int out_size, void* d_ws, size_t ws_size, hipStream_t stream) {
    using namespace mk;
    static int grid = 0;
    if (grid == 0) {
        size_t need = WS_NEED;
        if (n_in != 25 || need > ws_size) { fprintf(stderr, "kernel_launch: bad args n_in %d need %zu ws %zu\n", n_in, need, ws_size); grid = -1; return; }
        int dev = 0, cus = 0, per_cu = 0;
        if (hipGetDevice(&dev) != hipSuccess || hipDeviceGetAttribute(&cus, hipDeviceAttributeMultiprocessorCount, dev) != hipSuccess) { grid = -1; return; }
        if (hipFuncSetAttribute((const void*)mega, hipFuncAttributeMaxDynamicSharedMemorySize, LDS_BYTES) != hipSuccess) { fprintf(stderr, "hipFuncSetAttribute failed\n"); grid = -1; return; }
        if (hipOccupancyMaxActiveBlocksPerMultiprocessor(&per_cu, (const void*)mega, NTHR, LDS_BYTES) != hipSuccess || per_cu < 1) fprintf(stderr, "occupancy query: %d\n", per_cu);
        (void)hipGetLastError();
        grid = cus;
    }
    if (grid < 0) return;
    if (hipMemsetAsync(d_ws, 0, CTL_BYTES, stream) != hipSuccess) return;
    Args a{};
    for (int i = 0; i < 25; ++i) a.in[i] = (const float*)d_in[i];
    a.out = (float*)d_out; a.ws = (unsigned char*)d_ws; a.ph_lo = 0; a.ph_hi = 1 + DEPTH * NPH;
    hipLaunchKernelGGL(mega, dim3(grid), dim3(NTHR), LDS_BYTES, stream, a);
}
```

```cpp
#include <hip/hip_runtime.h>
#include <cstdio>
#include <cstdint>
#include <cmath>

__device__ __forceinline__ int mk_tid(int wv) { int lane; asm volatile("v_mbcnt_lo_u32_b32 %0, -1, 0\n\tv_mbcnt_hi_u32_b32 %0, -1, %0" : "=v"(lane)); return (wv << 6) | lane; }
#define XB_TMO      128
#define XB_XCNT(j)  (256  + 64 * (j))
#define XB_XSUB(j)  (1280 + 64 * (j))
#define XB_XGEN(j)  (2304 + 64 * (j))
#define XB_TOP      3328
#define XB_TOPGEN   3392
#define XCD_BAR_WORDS 3456
#define XB_SPIN_CAP (1u << 18)
#define LAS __attribute__((address_space(3)))

__device__ __forceinline__ unsigned xb_ld(unsigned* p)              { return __hip_atomic_load(p, __ATOMIC_RELAXED, __HIP_MEMORY_SCOPE_AGENT); }
__device__ __forceinline__ unsigned xb_add(unsigned* p, unsigned v) { return __hip_atomic_fetch_add(p, v, __ATOMIC_RELAXED, __HIP_MEMORY_SCOPE_AGENT); }
__device__ __forceinline__ unsigned xb_xcc_id() { return (unsigned)__builtin_amdgcn_s_getreg((3 << 11) | 20) & 0xFu; }
#define XB_SPIN(cond, bar) do { unsigned _sp = 0; while (cond) { __builtin_amdgcn_s_sleep(1); \
    if ((++_sp & 255u) == 0u) { if (xb_ld(&(bar)[XB_TMO])) break; if (_sp > XB_SPIN_CAP) { atomicAdd(&(bar)[XB_TMO], 1u); break; } } } } while (0)

struct XcdBarrier {
    unsigned* bar; unsigned x;
    volatile LAS unsigned* st; int wv;
};

__device__ __forceinline__ XcdBarrier xcd_barrier_post(unsigned* bar, volatile LAS unsigned* st, int wv) {
    XcdBarrier b; b.bar = bar; b.x = xb_xcc_id(); b.st = st; b.wv = wv;
    if (mk_tid(b.wv) == 0) (void)xb_add(&bar[XB_XCNT(b.x)], 1u);
    return b;
}
__device__ __forceinline__ void xcd_barrier_complete(unsigned* bar, unsigned x, unsigned& nloc, unsigned& nx) {
    const unsigned G = gridDim.x * gridDim.y * gridDim.z;
    unsigned sum, cnt, mine, sp = 0u;
    for (;;) {
        sum = 0u; cnt = 0u; mine = 0u;
#pragma unroll
        for (unsigned j = 0; j < 16; ++j) { const unsigned c = xb_ld(&bar[XB_XCNT(j)]); sum += c; cnt += (c > 0u) ? 1u : 0u; mine = (j == x) ? c : mine; }
        if (sum == G) break;
        __builtin_amdgcn_s_sleep(1);
        if ((++sp & 255u) == 0u) { if (xb_ld(&bar[XB_TMO])) break; if (sp > XB_SPIN_CAP) { atomicAdd(&bar[XB_TMO], 1u); break; } }
    }
    nloc = mine > 0u ? mine : 1u; nx = cnt > 0u ? cnt : 1u;
}

template <bool FIRST>
__device__ __forceinline__ void xcd_barrier_t(const XcdBarrier& b) {
    asm volatile("s_waitcnt vmcnt(0)" ::: "memory");
    __syncthreads();
    if (mk_tid(b.wv) == 0) {
        unsigned* bar = b.bar; unsigned bx = b.x; asm volatile("" : "+s"(bar), "+s"(bx));
        __builtin_amdgcn_s_waitcnt(0);
        unsigned nloc = b.st[0], nx = b.st[1];
        if (FIRST) { if (nloc == 0u) { xcd_barrier_complete(bar, bx, nloc, nx); b.st[0] = nloc; b.st[1] = nx; } }
        const unsigned old = xb_add(&bar[XB_XSUB(bx)], 1u);
        const unsigned gen = old / nloc;
        if (old + 1u == (gen + 1u) * nloc) {
            __builtin_amdgcn_fence(__ATOMIC_RELEASE, "agent");
            asm volatile("s_waitcnt vmcnt(0)" ::: "memory");
            const unsigned og = xb_add(&bar[XB_TOP], 1u);
            const unsigned tg = og / nx;
            if (og + 1u == (tg + 1u) * nx) xb_add(&bar[XB_TOPGEN], 1u);
            else XB_SPIN(xb_ld(&bar[XB_TOPGEN]) == tg, bar);
            __builtin_amdgcn_fence(__ATOMIC_ACQUIRE, "agent");
            xb_add(&bar[XB_XGEN(bx)], 1u);
            asm volatile("s_waitcnt vmcnt(0)" ::: "memory");
        } else {
            XB_SPIN(xb_ld(&bar[XB_XGEN(bx)]) == gen, bar);
            __builtin_amdgcn_fence(__ATOMIC_ACQUIRE, "agent");
            asm volatile("s_waitcnt vmcnt(0)" ::: "memory");
        }
    }
    __syncthreads();
}


__device__ __forceinline__ void xcd_barrier_first(const XcdBarrier& b) { xcd_barrier_t<true>(b); }
__device__ __forceinline__ void xcd_barrier(const XcdBarrier& b) { xcd_barrier_t<false>(b); }


namespace mk {
constexpr int B_ = 8, S_ = 4096, D_ = 1024, NT = B_ * S_, DEPTH = 2;
constexpr int INW = 2840, HS = 3072;
constexpr int C_HGQ = 0, C_HGF = 256, C_HGI = 512, C_HGG = 768, C_GMU = 1024, C_GMV = 1280, C_NQ = 1536,
              C_KC = 2048, C_VC = 2176, C_KS = 2304, C_VS = 2432, C_KW = 2560, C_VW = 2688, C_NG = 2816;
constexpr int NCMP = 255, NE = 32, TOPK = 4, NASSIGN = NT * TOPK;
constexpr float ALPHA = 1.4142135623730951f;
constexpr int NTHR = 512, LDS_BYTES = 147456, MISC_OFF = 144 * 1024 - 256;
constexpr int NPH = 8;

typedef unsigned short bf16;
__device__ __forceinline__ float bf2f(bf16 v) { return __uint_as_float((unsigned)v << 16); }
__device__ __forceinline__ unsigned f2bf(float f) { unsigned u = __float_as_uint(f); return (u + 0x7fffu + ((u >> 16) & 1u)) >> 16; }
__device__ __forceinline__ unsigned pk2(float lo, float hi) { return f2bf(lo) | (f2bf(hi) << 16); }
__device__ __forceinline__ float gelu_t(float x) { return 0.5f * x * (1.0f + tanhf(0.7978845608028654f * (x + 0.044715f * x * x * x))); }
__device__ __forceinline__ float sigm(float x) { return 1.0f / (1.0f + expf(-x)); }
__device__ __forceinline__ float wsum(float v) {
#pragma unroll
    for (int o = 1; o < 64; o <<= 1) v += __shfl_xor(v, o);
    return v;
}
__device__ __forceinline__ float wmax(float v) {
#pragma unroll
    for (int o = 1; o < 64; o <<= 1) v = fmaxf(v, __shfl_xor(v, o));
    return v;
}

constexpr int MROWS = NASSIGN + NE * 256;
constexpr size_t CTL_BYTES = 65536;
constexpr size_t al256(size_t x) { return (x + 255) & ~(size_t)255; }
constexpr size_t O_COS = CTL_BYTES, O_SIN = O_COS + al256((size_t)NT * 32 * 4), O_LB = O_SIN + al256((size_t)NT * 32 * 4);
constexpr size_t O_WIN = O_LB + al256(512 * 4), O_WOUT = O_WIN + al256((size_t)DEPTH * HS * D_ * 2), O_WUP = O_WOUT + al256((size_t)DEPTH * D_ * D_ * 2);
constexpr size_t O_WDN = O_WUP + al256((size_t)DEPTH * NE * 2048 * D_ * 2), O_XB = O_WDN + al256((size_t)DEPTH * NE * D_ * D_ * 2);
constexpr size_t O_HB = O_XB + al256((size_t)NT * D_ * 2), O_YCAT = O_HB + al256((size_t)NT * HS * 2), O_MIXB = O_YCAT + al256((size_t)NT * D_ * 2);
constexpr size_t O_X1B = O_MIXB + al256((size_t)NT * D_ * 2), O_ACT = O_X1B + al256((size_t)NT * D_ * 2), O_YB = O_ACT + al256((size_t)MROWS * D_ * 2);
constexpr size_t O_X1Q = O_YB + al256((size_t)MROWS * D_ * 2), O_XA = O_X1Q + al256((size_t)NT * D_ * 4);
constexpr size_t O_VLNT = O_XA + al256((size_t)NT * D_ * 4), O_WB = O_VLNT + al256((size_t)NT * 256 * 2), O_W1T = O_WB + al256((size_t)DEPTH * 4 * 128 * 128 * 2);
constexpr size_t O_CBIAS = O_W1T + al256((size_t)DEPTH * 2 * 128 * 2048 * 2), O_W2T = O_CBIAS + al256((size_t)DEPTH * 2 * 128 * 4), O_RWH = O_W2T + al256((size_t)DEPTH * 2 * 64 * 128 * 2), O_RWL = O_RWH + al256((size_t)DEPTH * NE * D_ * 2), O_HQT = O_RWL + al256((size_t)DEPTH * NE * D_ * 2);
constexpr size_t HGB = (size_t)2048 * 4096 * 2;
constexpr size_t O_HKT = O_HQT + HGB, O_HQP = O_HKT + HGB, O_HVT = O_HQP + HGB, O_HST = O_HVT + HGB, O_HUT = O_HST + HGB, O_HDK = O_HUT + 2 * HGB;
constexpr size_t O_KSB = O_HDK + al256((size_t)2048 * 64 * 4), O_VSB = O_KSB + al256((size_t)NT * 128 * 2);
constexpr size_t O_KWB = O_VSB + al256((size_t)NT * 128 * 2), O_VWB = O_KWB + al256((size_t)NT * 128 * 2), O_KCB = O_VWB + al256((size_t)NT * 128 * 2), O_VCB = O_KCB + al256((size_t)B_ * 2 * 256 * 64 * 2);
constexpr size_t O_LIST = O_VCB + al256((size_t)B_ * 2 * 256 * 64 * 2), O_TE = O_LIST + al256((size_t)NE * NT * 4), O_TS = O_TE + al256((size_t)NASSIGN * 4), O_TW = O_TS + al256((size_t)NASSIGN * 4);
constexpr size_t WS_NEED = O_TW + al256((size_t)NASSIGN * 4);
namespace pg8 {
#define PG8_LAS __attribute__((address_space(3)))
typedef unsigned short bf16_t;
typedef short bf16x8 __attribute__((ext_vector_type(8)));
typedef float f32x4 __attribute__((ext_vector_type(4)));
typedef float f32x2 __attribute__((ext_vector_type(2)));
typedef unsigned u32x4 __attribute__((ext_vector_type(4)));
constexpr int BM = 256, BK = 64, HALF = 128, HTB = HALF * BK * 2  , STAGE_BYTES = 8 * HTB, NXCD = 8, WGM = 8;

__host__ __device__ __forceinline__ int lds_byte(int r, int c) { const int st = (r >> 4) * 2 + (c >> 5), rr = r & 15, cc = c & 31, ob = rr * 64 + cc * 2; return st * 1024 + (ob ^ (((ob >> 9) & 1) << 5)); }
__host__ __device__ __forceinline__ void stage_rc(int b, int& R, int& C) { const int st = b / 1024, sb = b % 1024, swz = sb ^ (((sb >> 9) & 1) << 5); R = (st >> 1) * 16 + swz / 64; C = (st & 1) * 32 + (swz % 64) / 2; }
__host__ __device__ __forceinline__ int perm32(int rho) { const int n = rho >> 4, i = rho & 15; return 8 * (i >> 2) + 4 * n + (i & 3); }

struct Unit { int pm, pn, e, mt, cnt; };

__device__ __forceinline__ void deal(int L, int nM, int nN, int& pm, int& pn) {
    const int nwg = nM * nN;
    int wgid = L; { const int q = nwg / NXCD, r = nwg % NXCD, xcd = wgid % NXCD, off = wgid / NXCD; wgid = (xcd < r ? xcd * (q + 1) : r * (q + 1) + (xcd - r) * q) + off; }
    const int nig = WGM * nN, gid = wgid / nig, fm = gid * WGM, gsz = (nM - fm) < WGM ? (nM - fm) : WGM;
    pm = fm + ((wgid % nig) % gsz); pn = (wgid % nig) / gsz;
}
struct PlainOrder {
    static constexpr bool GATHERED = false;
    const bf16_t* Bt; int K; int nM, nN, G, c;
    __device__ __forceinline__ bool next(int i, Unit& u) const { const long L = (long)i * G + c; if (L >= (long)nM * nN) return false; deal((int)L, nM, nN, u.pm, u.pn); u.e = 0; u.mt = 0; u.cnt = 0; return true; }
    __device__ __forceinline__ unsigned a_row(const Unit& u, int r) const { return (unsigned)(u.pm * BM + r); }
    __device__ __forceinline__ const char* b_base(const Unit& u) const { return (const char*)Bt + (size_t)u.pn * BM * K * 2; }
};
template <bool GATHER> struct MoeOrder {
    static constexpr bool GATHERED = GATHER;
    const void* Bt; int rowb; int nN, G, c; size_t estrideb;
    const int* tstart; const int* cnts; const int* list;
    __device__ __forceinline__ bool next(int i, Unit& u) const {
        const int nM = tstart[32]; const long L = (long)i * G + c; if (L >= (long)nM * nN) return false;
        deal((int)L, nM, nN, u.pm, u.pn);
        int e = 0;
#pragma unroll 1
        for (int k = 1; k < 32; ++k) e = (tstart[k] <= u.pm) ? k : e;
        u.e = e; u.mt = u.pm - tstart[e]; u.cnt = cnts[e]; return true;
    }
    __device__ __forceinline__ unsigned a_row(const Unit& u, int r) const {
        if (GATHER) { const int slot = u.mt * BM + r; return (slot < u.cnt) ? (unsigned)list[u.e * 32768 + slot] : 0u; }
        return (unsigned)(u.pm * BM + r);
    }
    __device__ __forceinline__ const char* b_base(const Unit& u) const { return (const char*)Bt + (size_t)u.e * estrideb + (size_t)u.pn * BM * rowb; }
};

__device__ __forceinline__ unsigned cvt_pk_bf16(float lo, float hi) { unsigned r; asm volatile("v_cvt_pk_bf16_f32 %0, %1, %2" : "=v"(r) : "v"(lo), "v"(hi)); return r; }

struct EpiBf16 {
    static constexpr bool PERM = true;
    bf16_t* O; int ldc; const float* bias; int bstride;
    __device__ __forceinline__ void operator()(const f32x4 (&acc)[2][2][4][2], const Unit& u, int wr, int wc, int fr, int fq) const {
        const int row0 = u.pm * BM + wr * 64 + fr; const int col0 = u.pn * BM + wc * 32 + 8 * fq;
        f32x4 bv[2][2];
#pragma unroll
        for (int bj = 0; bj < 2; ++bj)
#pragma unroll
            for (int n = 0; n < 2; ++n) bv[bj][n] = bias ? *(const f32x4*)(bias + (size_t)u.e * bstride + col0 + bj * HALF + 4 * n) : (f32x4){0.f, 0.f, 0.f, 0.f};
#pragma unroll
        for (int ai = 0; ai < 2; ++ai)
#pragma unroll
            for (int m = 0; m < 4; ++m) { bf16_t* rowp = O + (size_t)(row0 + ai * HALF + m * 16) * ldc + col0;
#pragma unroll
                for (int bj = 0; bj < 2; ++bj) { f32x4 v0 = acc[ai][bj][m][0] + bv[bj][0], v1 = acc[ai][bj][m][1] + bv[bj][1];
                    u32x4 w; w.x = cvt_pk_bf16(v0[0], v0[1]); w.y = cvt_pk_bf16(v0[2], v0[3]); w.z = cvt_pk_bf16(v1[0], v1[1]); w.w = cvt_pk_bf16(v1[2], v1[3]);
                    *(u32x4*)(rowp + bj * HALF) = w; } }
    }
};
__device__ __forceinline__ float swiglu1(float g, float l) {
    g = fminf(g, 7.0f); l = fminf(fmaxf(l, -7.0f), 7.0f);
    const float s = __builtin_amdgcn_rcpf(1.0f + __builtin_amdgcn_exp2f(-1.702f * 1.4426950408889634f * g));
    return g * s * (l + 1.0f);
}
struct EpiUp {
    static constexpr bool PERM = true;
    bf16_t* O; const float* bias;
    __device__ __forceinline__ void operator()(const f32x4 (&acc)[2][2][4][2], const Unit& u, int wr, int wc, int fr, int fq) const {
        const int row0 = u.pm * BM + wr * 64 + fr; const int j0 = u.pn * HALF + wc * 32 + 8 * fq;
        const float* bp = bias + (size_t)u.e * 2048 + j0;
        f32x4 bg[2], bl[2];
#pragma unroll
        for (int n = 0; n < 2; ++n) { bg[n] = *(const f32x4*)(bp + 4 * n); bl[n] = *(const f32x4*)(bp + 1024 + 4 * n); }
#pragma unroll
        for (int ai = 0; ai < 2; ++ai)
#pragma unroll
            for (int m = 0; m < 4; ++m) {
                float o[8];
#pragma unroll
                for (int n = 0; n < 2; ++n) { const f32x4 g = acc[ai][0][m][n] + bg[n], l = acc[ai][1][m][n] + bl[n];
#pragma unroll
                    for (int j = 0; j < 4; ++j) o[4 * n + j] = swiglu1(g[j], l[j]); }
                u32x4 w; w.x = cvt_pk_bf16(o[0], o[1]); w.y = cvt_pk_bf16(o[2], o[3]); w.z = cvt_pk_bf16(o[4], o[5]); w.w = cvt_pk_bf16(o[6], o[7]);
                *(u32x4*)(O + (size_t)(row0 + ai * HALF + m * 16) * 1024 + j0) = w; }
    }
};

constexpr float F8_SU = 64.0f, F8_SA = 4.0f, F8_SD = 128.0f;
__device__ __forceinline__ unsigned pk4_fp8(float a, float b, float c, float d) {
    a = fminf(fmaxf(a, -448.f), 448.f); b = fminf(fmaxf(b, -448.f), 448.f); c = fminf(fmaxf(c, -448.f), 448.f); d = fminf(fmaxf(d, -448.f), 448.f);
    int p = __builtin_amdgcn_cvt_pk_fp8_f32(a, b, 0, false); p = __builtin_amdgcn_cvt_pk_fp8_f32(c, d, p, true); return (unsigned)p;
}
struct EpiUpF8 {
    static constexpr bool PERM = true;
    unsigned char* O; const float* bias;
    __device__ __forceinline__ void operator()(const f32x4 (&acc)[2][2][4][2], const Unit& u, int wr, int wc, int fr, int fq) const {
        const int row0 = u.pm * BM + wr * 64 + fr; const int j0 = u.pn * HALF + wc * 32 + 8 * fq;
        const float* bp = bias + (size_t)u.e * 2048 + j0;
        f32x4 bg[2], bl[2];
#pragma unroll
        for (int n = 0; n < 2; ++n) { bg[n] = *(const f32x4*)(bp + 4 * n); bl[n] = *(const f32x4*)(bp + 1024 + 4 * n); }
#pragma unroll
        for (int ai = 0; ai < 2; ++ai)
#pragma unroll
            for (int m = 0; m < 4; ++m) {
                unsigned w[2];
#pragma unroll
                for (int n = 0; n < 2; ++n) { const f32x4 g = acc[ai][0][m][n] * (1.0f / F8_SU) + bg[n], l = acc[ai][1][m][n] * (1.0f / F8_SU) + bl[n];
                    w[n] = pk4_fp8(F8_SA * swiglu1(g[0], l[0]), F8_SA * swiglu1(g[1], l[1]), F8_SA * swiglu1(g[2], l[2]), F8_SA * swiglu1(g[3], l[3])); }
                typedef unsigned u32x2 __attribute__((ext_vector_type(2)));
                u32x2 ww = {w[0], w[1]};
                *(u32x2*)(O + (size_t)(row0 + ai * HALF + m * 16) * 1024 + j0) = ww; }
    }
};
struct EpiDnF8 {
    static constexpr bool PERM = true;
    bf16_t* O; const float* bias;
    __device__ __forceinline__ void operator()(const f32x4 (&acc)[2][2][4][2], const Unit& u, int wr, int wc, int fr, int fq) const {
        const int row0 = u.pm * BM + wr * 64 + fr; const int col0 = u.pn * BM + wc * 32 + 8 * fq;
        f32x4 bv[2][2];
#pragma unroll
        for (int bj = 0; bj < 2; ++bj)
#pragma unroll
            for (int n = 0; n < 2; ++n) bv[bj][n] = *(const f32x4*)(bias + (size_t)u.e * 1024 + col0 + bj * HALF + 4 * n);
#pragma unroll
        for (int ai = 0; ai < 2; ++ai)
#pragma unroll
            for (int m = 0; m < 4; ++m) { bf16_t* rowp = O + (size_t)(row0 + ai * HALF + m * 16) * 1024 + col0;
#pragma unroll
                for (int bj = 0; bj < 2; ++bj) { f32x4 v0 = acc[ai][bj][m][0] * (1.0f / (F8_SA * F8_SD)) + bv[bj][0], v1 = acc[ai][bj][m][1] * (1.0f / (F8_SA * F8_SD)) + bv[bj][1];
                    u32x4 w; w.x = cvt_pk_bf16(v0[0], v0[1]); w.y = cvt_pk_bf16(v0[2], v0[3]); w.z = cvt_pk_bf16(v1[0], v1[1]); w.w = cvt_pk_bf16(v1[2], v1[3]);
                    *(u32x4*)(rowp + bj * HALF) = w; } }
    }
};

typedef int v8i32 __attribute__((ext_vector_type(8)));
__device__ __forceinline__ v8i32 pg8_join(const bf16x8 lo, const bf16x8 hi) { typedef int v4i32 __attribute__((ext_vector_type(4)));
    const v4i32 a = __builtin_bit_cast(v4i32, lo), b = __builtin_bit_cast(v4i32, hi); return __builtin_shufflevector(a, b, 0, 1, 2, 3, 4, 5, 6, 7); }
template <class Epi, class Sched, bool ALIGN_EPI, bool F8 = false>
__device__ __forceinline__ void gemm_phase(const int wv, PG8_LAS unsigned char* lds, const void* Abase, const int Kb  , const Sched& S, const Epi& E) {
    int tid = mk_tid(wv); asm volatile("" : "+v"(tid));
    const int wid = __builtin_amdgcn_readfirstlane(tid >> 6), lane = tid & 63, wr = wid >> 2, wc = wid & 3, fr = lane & 15, fq = lane >> 4;
    const int nt = Kb / 128;
    const char* Ab = (const char*)Abase;
    unsigned voffB[2];
#pragma unroll
    for (int i = 0; i < 2; ++i) { int R, C; stage_rc(tid * 16 + i * 8192, R, C); const int Rb = Epi::PERM ? ((R & ~31) + perm32(R & 31)) : R;
        voffB[i] = (unsigned)(Rb * Kb + C * 2); }
    const size_t kstep = (size_t)(BK * 2);
    const size_t hstep = (size_t)HALF * Kb;
    const unsigned rowb = (unsigned)Kb;
    const unsigned ldsw = (unsigned)wid * 1024u;
    const int aoff = F8 ? lds_byte(wr * 64 + fr, 16 * (fq & 1)) + (fq >> 1) * 1024 : lds_byte(wr * 64 + fr, fq * 8);
    const int boff = F8 ? lds_byte(wc * 32 + fr, 16 * (fq & 1)) + (fq >> 1) * 1024 : lds_byte(wc * 32 + fr, fq * 8);
#define PG8_SA(b, h) (((b) * 2 + (h)) * HTB)
#define PG8_SB(b, h) ((4 + (b) * 2 + (h)) * HTB)
#define PG8_STAGE(bufoff, gbase, voff) do { _Pragma("unroll") for (int _i = 0; _i < 2; ++_i) { unsigned _v = (voff)[_i]; asm volatile("" : "+v"(_v)); \
        __builtin_amdgcn_global_load_lds((const unsigned*)((const char*)(gbase) + _v), (PG8_LAS unsigned*)(lds + (bufoff) + ldsw + _i * 8192), 16, 0, 0); } } while (0)
#define PG8_STAGE_A(bufoff, kb, o0, o1) do { unsigned _o0 = (o0), _o1 = (o1); asm volatile("" : "+v"(_o0), "+v"(_o1)); \
        __builtin_amdgcn_global_load_lds((const unsigned*)(Ab + (kb) + _o0), (PG8_LAS unsigned*)(lds + (bufoff) + ldsw), 16, 0, 0); \
        __builtin_amdgcn_global_load_lds((const unsigned*)(Ab + (kb) + _o1), (PG8_LAS unsigned*)(lds + (bufoff) + ldsw + 8192), 16, 0, 0); } while (0)
#define PG8_LDA(dst, b, h) do { if constexpr (F8) { _Pragma("unroll") for (int m = 0; m < 4; ++m) dst##8[m] = *(const PG8_LAS v8i32*)(lds + PG8_SA(b, h) + aoff + m * 2048); } \
        else { _Pragma("unroll") for (int m = 0; m < 4; ++m) _Pragma("unroll") for (int k = 0; k < 2; ++k) dst[m][k] = *(const PG8_LAS bf16x8*)(lds + PG8_SA(b, h) + aoff + m * 2048 + k * 1024); } } while (0)
#define PG8_LDB(dst, b, h) do { if constexpr (F8) { _Pragma("unroll") for (int n = 0; n < 2; ++n) dst##8[n] = *(const PG8_LAS v8i32*)(lds + PG8_SB(b, h) + boff + n * 2048); } \
        else { _Pragma("unroll") for (int n = 0; n < 2; ++n) _Pragma("unroll") for (int k = 0; k < 2; ++k) dst[n][k] = *(const PG8_LAS bf16x8*)(lds + PG8_SB(b, h) + boff + n * 2048 + k * 1024); } } while (0)
#define PG8_MMA(ai, bj, At, Bt) do { __builtin_amdgcn_s_setprio(1); _Pragma("unroll") for (int m = 0; m < 4; ++m) _Pragma("unroll") for (int n = 0; n < 2; ++n) { \
        if constexpr (F8) { acc[ai][bj][m][n] = __builtin_amdgcn_mfma_scale_f32_16x16x128_f8f6f4(Bt##8[n], At##8[m], acc[ai][bj][m][n], 0, 0, 0, 0, 0, 0); } \
        else { _Pragma("unroll") for (int k = 0; k < 2; ++k) acc[ai][bj][m][n] = __builtin_amdgcn_mfma_f32_16x16x32_bf16(Bt[n][k], At[m][k], acc[ai][bj][m][n], 0, 0, 0); } } \
        __builtin_amdgcn_s_setprio(0); } while (0)
#define PG8_WAIT_V(n) asm volatile("s_waitcnt vmcnt(" #n ")" ::: "memory")
#define PG8_WAIT_L(n) asm volatile("s_waitcnt lgkmcnt(" #n ")" ::: "memory")
#define PG8_BAR __builtin_amdgcn_s_barrier()
#define PG8_SCHED __builtin_amdgcn_sched_barrier(0)
#define PG8_AOFFS(dst, u) do { int _t = mk_tid(wv); asm volatile("" : "+v"(_t)); _Pragma("unroll") for (int _i = 0; _i < 2; ++_i) { int _R, _C; stage_rc(_t * 16 + _i * 8192, _R, _C); \
        _Pragma("unroll") for (int _h = 0; _h < 2; ++_h) dst[_h][_i] = S.a_row(u, _h * HALF + _R) * rowb + (unsigned)_C * 2u; } } while (0)
    Unit cur, nxt; int ui = 0;
    if (!S.next(0, cur)) return;
    f32x4 acc[2][2][4][2];
#pragma unroll
    for (int a = 0; a < 2; ++a)
#pragma unroll
        for (int b = 0; b < 2; ++b)
#pragma unroll
            for (int m = 0; m < 4; ++m)
#pragma unroll
                for (int n = 0; n < 2; ++n) acc[a][b][m][n] = (f32x4){0.f, 0.f, 0.f, 0.f};
    bf16x8 At[4][2], B0[2][2], B1[2][2];
    v8i32 At8[4], B08[2], B18[2];
    unsigned aC[2][2], aN[2][2];
    PG8_AOFFS(aC, cur);
    const char* cB = S.b_base(cur);
    PG8_STAGE(PG8_SB(0, 0), cB, voffB); PG8_STAGE(PG8_SB(0, 1), cB + hstep, voffB); PG8_STAGE_A(PG8_SA(0, 0), 0, aC[0][0], aC[0][1]); PG8_STAGE_A(PG8_SA(0, 1), 0, aC[1][0], aC[1][1]);
    if (wr == 1) PG8_BAR;
    PG8_WAIT_V(2); PG8_BAR;
    PG8_STAGE(PG8_SB(1, 0), cB + kstep, voffB); PG8_STAGE_A(PG8_SA(1, 0), kstep, aC[0][0], aC[0][1]); PG8_STAGE(PG8_SB(1, 1), cB + hstep + kstep, voffB);
    PG8_WAIT_V(6); PG8_BAR;
    for (;;) {
        const bool has_next = S.next(ui + 1, nxt);
        const char* nB = has_next ? S.b_base(nxt) : cB;
        if (has_next) { PG8_AOFFS(aN, nxt); }
        else {
#pragma unroll
            for (int _h = 0; _h < 2; ++_h)
#pragma unroll
                for (int _i = 0; _i < 2; ++_i) aN[_h][_i] = aC[_h][_i]; }
#pragma unroll 1
        for (int t = 0; t < nt; t += 2) {
            const bool last = (t == nt - 2);
            const size_t kb1 = (size_t)(t + 1) * kstep;
            PG8_LDB(B0, 0, 0); PG8_LDB(B1, 0, 1); PG8_SCHED; PG8_LDA(At, 0, 0); PG8_STAGE_A(PG8_SA(1, 1), kb1, aC[1][0], aC[1][1]);
            PG8_WAIT_V(8); PG8_WAIT_L(0); PG8_BAR; PG8_MMA(0, 0, At, B0); PG8_MMA(0, 1, At, B1); PG8_BAR; PG8_SCHED;
            if (last) {
#pragma unroll
                for (int _h = 0; _h < 2; ++_h)
#pragma unroll
                    for (int _i = 0; _i < 2; ++_i) aC[_h][_i] = aN[_h][_i]; }
            const size_t kb2 = last ? (size_t)0 : (size_t)(t + 2) * kstep; const char* b2 = last ? nB : cB + (size_t)(t + 2) * kstep;
            const size_t kb3 = kb2 + kstep; const char* b3 = b2 + kstep;
            PG8_LDA(At, 0, 1); PG8_STAGE(PG8_SB(0, 0), b2, voffB); PG8_STAGE(PG8_SB(0, 1), b2 + hstep, voffB); PG8_STAGE_A(PG8_SA(0, 0), kb2, aC[0][0], aC[0][1]);
            PG8_WAIT_V(8); PG8_WAIT_L(0); PG8_BAR; PG8_MMA(1, 0, At, B0); PG8_MMA(1, 1, At, B1); PG8_BAR; PG8_SCHED;
            PG8_LDB(B0, 1, 0); PG8_LDB(B1, 1, 1); PG8_SCHED; PG8_LDA(At, 1, 0); PG8_STAGE_A(PG8_SA(0, 1), kb2, aC[1][0], aC[1][1]);
            PG8_WAIT_V(8); PG8_WAIT_L(0); PG8_BAR; PG8_MMA(0, 0, At, B0); PG8_MMA(0, 1, At, B1); PG8_BAR; PG8_SCHED;
            PG8_LDA(At, 1, 1); PG8_STAGE(PG8_SB(1, 0), b3, voffB); PG8_STAGE(PG8_SB(1, 1), b3 + hstep, voffB); PG8_STAGE_A(PG8_SA(1, 0), kb3, aC[0][0], aC[0][1]);
            PG8_WAIT_V(8); PG8_WAIT_L(0); PG8_BAR; PG8_MMA(1, 0, At, B0); PG8_MMA(1, 1, At, B1); PG8_BAR; PG8_SCHED;
        }
        if (ALIGN_EPI) { if (wr == 0) PG8_BAR; }
        E(acc, cur, wr, wc, fr, fq);
        if (!has_next) break;
#pragma unroll
        for (int a = 0; a < 2; ++a)
#pragma unroll
            for (int b = 0; b < 2; ++b)
#pragma unroll
                for (int m = 0; m < 4; ++m)
#pragma unroll
                    for (int n = 0; n < 2; ++n) acc[a][b][m][n] = (f32x4){0.f, 0.f, 0.f, 0.f};
        cur = nxt; cB = nB; ++ui;
        if (ALIGN_EPI) { if (wr == 1) PG8_BAR; }
    }
    PG8_WAIT_V(0);
    if (!ALIGN_EPI) { if (wr == 0) PG8_BAR; }
    PG8_BAR;
#undef PG8_SA
#undef PG8_SB
#undef PG8_STAGE
#undef PG8_STAGE_A
#undef PG8_LDA
#undef PG8_LDB
#undef PG8_MMA
#undef PG8_WAIT_V
#undef PG8_WAIT_L
#undef PG8_BAR
#undef PG8_SCHED
#undef PG8_AOFFS
}
}


#ifndef NSA_REP_RANK
#define NSA_REP_RANK 1
#endif
#ifndef NSA_REP_PASSA
#define NSA_REP_PASSA 1
#endif
#ifndef NSA_REP_LOOP
#define NSA_REP_LOOP 1
#endif
namespace nsa {
#define NLAS __attribute__((address_space(3)))
typedef short bf16x8 __attribute__((ext_vector_type(8)));
typedef short s16x4 __attribute__((ext_vector_type(4)));
typedef short v4i16_t __attribute__((ext_vector_type(4)));
typedef float f32x16 __attribute__((ext_vector_type(16)));
typedef float f32x2_t __attribute__((ext_vector_type(2)));
typedef __bf16 bf16x2_t __attribute__((ext_vector_type(2)));
#define NSA_MFMA(a, b, c) __builtin_amdgcn_mfma_f32_32x32x16_bf16((a), (b), (c), 0, 0, 0)
constexpr int L_CK = 0, L_CV = 32768, L_RING = 65536, L_IMP = 0, SLOTB = 16384, L_SELM = 131072 + 1024;
constexpr float QSCALE = 0.125f * 1.4426950408889634f;
constexpr float NEGBIG = -1.0e30f;

__device__ __forceinline__ unsigned cvtpk(float lo, float hi) { f32x2_t v = {lo, hi}; bf16x2_t b = __builtin_convertvector(v, bf16x2_t); return __builtin_bit_cast(unsigned, b); }
__device__ __forceinline__ float bflo(unsigned u) { return __uint_as_float(u << 16); }
__device__ __forceinline__ float bfhi(unsigned u) { return __uint_as_float(u & 0xffff0000u); }
__device__ __forceinline__ float xhalf(float v) { return __shfl_xor(v, 32); }
__device__ __forceinline__ s16x4 vtr(const NLAS unsigned char* p) { return __builtin_bit_cast(s16x4, __builtin_amdgcn_ds_read_tr16_b64_v4i16((NLAS v4i16_t*)p)); }
__device__ __forceinline__ bf16x8 pack8(const f32x16& x, int s) {
    unsigned p0 = cvtpk(x[8 * s], x[8 * s + 1]), p1 = cvtpk(x[8 * s + 2], x[8 * s + 3]), p2 = cvtpk(x[8 * s + 4], x[8 * s + 5]), p3 = cvtpk(x[8 * s + 6], x[8 * s + 7]);
    typedef unsigned u32x4 __attribute__((ext_vector_type(4)));
    u32x4 u = {p0, p1, p2, p3}; return __builtin_bit_cast(bf16x8, u);
}

struct Params {
    const unsigned short* hb;
    const unsigned short *kcb, *vcb;
    const unsigned short *ksb, *vsb, *kwb, *vwb;
    const float *cosT, *sinT;
    const float* normw;
    unsigned short* ycat;
};

__device__ __forceinline__ void qk_tile(const NLAS unsigned char* kt, const bf16x8 (&qf)[4], const int (&kofs)[4], f32x16& st0, f32x16& st1) {
#pragma unroll
    for (int i = 0; i < 16; ++i) { st0[i] = 0.f; st1[i] = 0.f; }
#pragma unroll
    for (int ks = 0; ks < 4; ++ks) {
        const bf16x8 k0 = *(const NLAS bf16x8*)(kt + kofs[ks]);
        const bf16x8 k1 = *(const NLAS bf16x8*)(kt + kofs[ks] + 4096);
        st0 = NSA_MFMA(k0, qf[ks], st0); st1 = NSA_MFMA(k1, qf[ks], st1);
    }
}
__device__ __forceinline__ void pv_tile(const NLAS unsigned char* vt, const int (&vofs)[2][2], const f32x16& p0, const f32x16& p1, f32x16& o0, f32x16& o1) {
#pragma unroll
    for (int kt = 0; kt < 2; ++kt)
#pragma unroll
        for (int s = 0; s < 2; ++s) {
            const bf16x8 pb = pack8(kt ? p1 : p0, s);
            const int kb = (32 * kt + 16 * s) * 128;
#pragma unroll
            for (int mb = 0; mb < 2; ++mb) {
                const s16x4 lo = vtr(vt + kb + vofs[mb][0]), hi = vtr(vt + kb + vofs[mb][1]);
                const bf16x8 va = __builtin_shufflevector(lo, hi, 0, 1, 2, 3, 4, 5, 6, 7);
                if (mb == 0) o0 = NSA_MFMA(va, pb, o0); else o1 = NSA_MFMA(va, pb, o1);
            }
        }
}
__device__ __forceinline__ float max3f(float a, float b, float c) { float r; asm("v_max3_f32 %0, %1, %2, %3" : "=v"(r) : "v"(a), "v"(b), "v"(c)); return r; }
constexpr float NEGINF = -__builtin_inff();
template <bool USE_LO>
__device__ __forceinline__ void mask_tile(f32x16& s0, f32x16& s1, const int hi4, const int lo4) {
#pragma unroll
    for (int i = 0; i < 16; ++i) {
        const int kk0 = (i & 3) + 8 * (i >> 2), kk1 = kk0 + 32;
        bool a0 = kk0 <= hi4, a1 = kk1 <= hi4;
        if (USE_LO) { a0 = a0 && (kk0 >= lo4); a1 = a1 && (kk1 >= lo4); }
        s0[i] = a0 ? s0[i] : NEGINF; s1[i] = a1 ? s1[i] : NEGINF;
    }
}
__device__ __forceinline__ void softmax_core(f32x16& s0, f32x16& s1, float& m, float& l, f32x16& o0, f32x16& o1, const bool live = true) {
    float mx = max3f(s0[0], s0[1], s0[2]);
#pragma unroll
    for (int i = 3; i < 15; i += 2) mx = max3f(mx, s0[i], s0[i + 1]);
    mx = max3f(mx, s0[15], s1[0]);
#pragma unroll
    for (int i = 1; i < 15; i += 2) mx = max3f(mx, s1[i], s1[i + 1]);
    mx = fmaxf(mx, s1[15]);
    mx = fmaxf(mx, xhalf(mx));
    const float mn = fmaxf(m, mx);
    const float alpha = __builtin_amdgcn_exp2f(m - mn);
    m = mn;
    const float mref = live ? mn : __builtin_inff();
    float sum0 = 0.f, sum1 = 0.f;
#pragma unroll
    for (int i = 0; i < 16; ++i) {
        const float e0 = __builtin_amdgcn_exp2f(s0[i] - mref), e1 = __builtin_amdgcn_exp2f(s1[i] - mref);
        s0[i] = e0; s1[i] = e1; sum0 += e0; sum1 += e1;
    }
    l = l * alpha + (sum0 + sum1);
    if (__ballot(alpha != 1.0f) != 0ull) {
#pragma unroll
        for (int i = 0; i < 16; ++i) { o0[i] *= alpha; o1[i] *= alpha; }
    }
}

__device__ __forceinline__ void unit(const Params& P, NLAS unsigned char* lds, const int tid_in, const int b, const int g, const int qb) {
    int tid = tid_in; asm volatile("" : "+v"(tid));
    const int wv = __builtin_amdgcn_readfirstlane(tid >> 6), lane = tid & 63, r = lane & 31, h = lane >> 5;
    const int head = g * 4 + (wv >> 1), qi = 32 * (wv & 1) + r;
    const int t = qb * 64 + qi, tok = b * 4096 + t;
    const int bg = b * 2 + g;
    int kofs[4];
#pragma unroll
    for (int ks = 0; ks < 4; ++ks) kofs[ks] = r * 128 + ((((2 * ks + h) ^ ((r >> 1) & 7))) << 4);
    int vofs[2][2];
    { const int i16 = lane & 15, blk = (lane >> 4) & 1, q = i16 >> 2, p = i16 & 3;
#pragma unroll
      for (int mb = 0; mb < 2; ++mb)
#pragma unroll
          for (int jj = 0; jj < 2; ++jj) { const int key = 4 * h + 8 * jj + q; const int o = 4 * mb + 2 * blk + (p >> 1);
              vofs[mb][jj] = key * 128 + ((o ^ (((key >> 1) & 1) << 2)) << 4) + (p & 1) * 8; } }
    const int drow = tid >> 3, dpos = tid & 7;
    const unsigned srcK = (unsigned)(drow * 128 + ((dpos ^ ((drow >> 1) & 7)) << 4));
    const unsigned srcV = (unsigned)(drow * 128 + ((dpos ^ (((drow >> 1) & 1) << 2)) << 4));
    const unsigned wdst = (unsigned)wv * 1024u;
    const unsigned lds0 = (unsigned)(size_t)lds;
#define NSA_DMA(slotoff, gsrc, soff) do { unsigned _keep; const void* _g = (const void*)((const char*)(gsrc) + (soff)); const unsigned _d = (unsigned)__builtin_amdgcn_readfirstlane((int)(lds0 + (unsigned)(slotoff) + wdst)); \
        asm volatile("s_mov_b32 %0, m0\n\ts_mov_b32 m0, %2\n\ts_nop 0\n\tglobal_load_lds_dwordx4 %1, off\n\ts_mov_b32 m0, %0" : "=&s"(_keep) : "v"(_g), "s"(_d) : "memory"); } while (0)
    const int nsel = qb + 1, jw0 = qb >= 8 ? qb - 8 : 0, ntiles = nsel + (qb - jw0 + 1);
    const char* ksg = (const char*)P.ksb + (size_t)bg * 4096 * 128; const char* vsg = (const char*)P.vsb + (size_t)bg * 4096 * 128;
    const char* kwg = (const char*)P.kwb + (size_t)bg * 4096 * 128; const char* vwg = (const char*)P.vwb + (size_t)bg * 4096 * 128;
#define NSA_ISSUE(pos) do { const int _p = (pos) < ntiles ? (pos) : ntiles - 1; const bool _w = _p >= nsel; const int _j = _w ? jw0 + _p - nsel : _p; \
        const int _slot = L_RING + ((pos) & 3) * SLOTB; \
        NSA_DMA(_slot, (_w ? kwg : ksg) + (size_t)_j * 8192, srcK); NSA_DMA(_slot + 8192, (_w ? vwg : vsg) + (size_t)_j * 8192, srcV); } while (0)
    { const char* kcg = (const char*)P.kcb + (size_t)bg * 256 * 128; const char* vcg = (const char*)P.vcb + (size_t)bg * 256 * 128;
#pragma unroll
      for (int T = 0; T < 4; ++T) { NSA_DMA(L_CK + T * 8192, kcg + T * 8192, srcK); NSA_DMA(L_CV + T * 8192, vcg + T * 8192, srcV); } }
    NSA_ISSUE(0); NSA_ISSUE(1);
    typedef unsigned u32x4 __attribute__((ext_vector_type(4)));
    bf16x8 qf[4];
    const unsigned short* qrow = P.hb + (size_t)tok * 3072 + 1536 + (head & 7) * 64;
    {
        u32x4 qraw[4];
#pragma unroll
        for (int ks = 0; ks < 4; ++ks) qraw[ks] = *(const u32x4*)(qrow + 16 * ks + 8 * h);
#pragma unroll
        for (int ks = 0; ks < 4; ++ks) { u32x4 o;
#pragma unroll
            for (int c = 0; c < 4; ++c) o[c] = cvtpk(bflo(qraw[ks][c]) * QSCALE, bfhi(qraw[ks][c]) * QSCALE);
            qf[ks] = __builtin_bit_cast(bf16x8, o); }
    }
    float gc, gs, gw;
    { const unsigned short* gp = P.hb + (size_t)tok * 3072 + 2816 + head * 3;
      gc = 1.f / (1.f + __expf(-__uint_as_float((unsigned)gp[0] << 16))); gs = 1.f / (1.f + __expf(-__uint_as_float((unsigned)gp[1] << 16))); gw = 1.f / (1.f + __expf(-__uint_as_float((unsigned)gp[2] << 16))); }
    asm volatile("s_waitcnt vmcnt(0)" ::: "memory"); __builtin_amdgcn_s_barrier();
    const int cmax = (t >= 31) ? (((t - 31) >> 4) < 254 ? ((t - 31) >> 4) : 254) : -1;
    float m = NEGBIG, l = 0.f;
    {
        f32x16 s0, s1, d0, d1;
#pragma unroll
        for (int i = 0; i < 16; ++i) { d0[i] = 0.f; d1[i] = 0.f; }
#pragma unroll 1
        for (int repA = 0; repA < NSA_REP_PASSA; ++repA) { m = NEGBIG; l = 0.f;
#pragma unroll 1
        for (int T = 0; T < 4; ++T) {
            qk_tile(lds + L_CK + T * 8192, qf, kofs, s0, s1);
            if (__ballot(cmax - 64 * T < 63) != 0ull) mask_tile<false>(s0, s1, cmax - 64 * T - 4 * h, 0);
            softmax_core(s0, s1, m, l, d0, d1);
        } }
    }
    const float lc = l + xhalf(l);
    const float rinv = lc > 0.f ? 1.0f / lc : 0.f;
    f32x16 of0, of1;
#pragma unroll
    for (int i = 0; i < 16; ++i) { of0[i] = 0.f; of1[i] = 0.f; }
    const bool need_sel = qb >= 16;
    float ow[32];
    float carry_in = 0.f;
#pragma unroll
    for (int T = 0; T < 4; ++T) {
        f32x16 s0, s1;
        qk_tile(lds + L_CK + T * 8192, qf, kofs, s0, s1);
        if (__ballot(cmax - 64 * T < 63) != 0ull) mask_tile<false>(s0, s1, cmax - 64 * T - 4 * h, 0);
#pragma unroll
        for (int i = 0; i < 16; ++i) { s0[i] = __builtin_amdgcn_exp2f(s0[i] - m) * rinv; s1[i] = __builtin_amdgcn_exp2f(s1[i] - m) * rinv; }
#pragma unroll
        for (int kt = 0; kt < 2; ++kt)
#pragma unroll
            for (int u = 0; u < 4; ++u) {
                const float p0 = kt ? s1[4 * u] : s0[4 * u], p1 = kt ? s1[4 * u + 1] : s0[4 * u + 1], p2 = kt ? s1[4 * u + 2] : s0[4 * u + 2], p3 = kt ? s1[4 * u + 3] : s0[4 * u + 3];
                const float x = xhalf(p3);
                const float own = 2.0f * ((p0 + p1) + p2) + p3;
                ow[8 * T + 4 * kt + u] = own + (h ? x : carry_in);
                carry_in = x;
            }
        pv_tile(lds + L_CV + T * 8192, vofs, s0, s1, of0, of1);
    }
#pragma unroll
    for (int i = 0; i < 16; ++i) { of0[i] *= gc; of1[i] *= gc; }
    unsigned long long selmask = (qb >= 63) ? ~0ull : ((1ull << (qb + 1)) - 1ull);
    if (need_sel) {
        __builtin_amdgcn_s_barrier();
        NLAS float* imp = (NLAS float*)(lds + L_IMP) + qi * 64;
#pragma unroll 1
        for (int hh = 0; hh < 4; ++hh) {
            if ((wv >> 1) == hh) {
                if (hh == 0) {
#pragma unroll
                    for (int idx = 0; idx < 32; ++idx) imp[(2 * idx + h + qi) & 63] = ow[idx];
                } else {
#pragma unroll
                    for (int idx = 0; idx < 32; ++idx) imp[(2 * idx + h + qi) & 63] += ow[idx];
                }
            }
            asm volatile("s_waitcnt lgkmcnt(0)" ::: "memory"); __builtin_amdgcn_s_barrier();
        }
        NLAS unsigned long long* selm = (NLAS unsigned long long*)(lds + L_SELM);
        const unsigned long long forced = 1ull | (1ull << qb) | (1ull << (qb - 1));
        const bool cand = (lane >= 1) && (lane <= qb - 2);
#pragma unroll 1
        for (int rep_ = 0; rep_ < NSA_REP_RANK; ++rep_) {
            unsigned vb[8], thr[8];
#pragma unroll
            for (int qq = 0; qq < 8; ++qq) { const int q = 8 * wv + qq; const float v = ((NLAS float*)(lds + L_IMP))[q * 64 + ((lane + q) & 63)];
                vb[qq] = cand ? __float_as_uint(v) : 0u; thr[qq] = 0u; }
#pragma unroll 1
            for (int bit = 30; bit >= 0; --bit) {
#pragma unroll
                for (int qq = 0; qq < 8; ++qq) {
                    const unsigned c2 = thr[qq] | (1u << bit);
                    const int cnt = __popcll(__ballot(cand && vb[qq] >= c2));
                    thr[qq] = (cnt >= 13) ? c2 : thr[qq];
                }
            }
#pragma unroll
            for (int qq = 0; qq < 8; ++qq) {
                unsigned long long sel = __ballot(cand && vb[qq] > thr[qq]);
                unsigned long long eq = __ballot(cand && vb[qq] == thr[qq]);
                int need = 13 - __popcll(sel);
#pragma unroll 1
                for (; need > 0; --need) { const unsigned long long low = eq & (~eq + 1ull); sel |= low; eq ^= low; }
                if (lane == 0) selm[8 * wv + qq] = sel | forced;
            }
        }
        asm volatile("s_waitcnt lgkmcnt(0)" ::: "memory"); __builtin_amdgcn_s_barrier();
        selmask = selm[qi];
    }
    {
        u32x4 qraw[4];
#pragma unroll
        for (int ks = 0; ks < 4; ++ks) qraw[ks] = *(const u32x4*)(qrow + 16 * ks + 8 * h);
        const float4* cp = (const float4*)(P.cosT + (size_t)tok * 32 + 8 * h); const float4* sp = (const float4*)(P.sinT + (size_t)tok * 32 + 8 * h);
#pragma unroll
        for (int ks = 0; ks < 2; ++ks) {
            const float4 c0 = cp[4 * ks], c1 = cp[4 * ks + 1], s0 = sp[4 * ks], s1 = sp[4 * ks + 1];
            const float cs[8] = {c0.x, c0.y, c0.z, c0.w, c1.x, c1.y, c1.z, c1.w}, sn[8] = {s0.x, s0.y, s0.z, s0.w, s1.x, s1.y, s1.z, s1.w};
            u32x4 oa, ob;
#pragma unroll
            for (int c = 0; c < 4; ++c) {
                const float a0 = bflo(qraw[ks][c]), a1 = bfhi(qraw[ks][c]), b0 = bflo(qraw[ks + 2][c]), b1 = bfhi(qraw[ks + 2][c]);
                oa[c] = cvtpk((a0 * cs[2 * c] - b0 * sn[2 * c]) * QSCALE, (a1 * cs[2 * c + 1] - b1 * sn[2 * c + 1]) * QSCALE);
                ob[c] = cvtpk((b0 * cs[2 * c] + a0 * sn[2 * c]) * QSCALE, (b1 * cs[2 * c + 1] + a1 * sn[2 * c + 1]) * QSCALE);
            }
            qf[ks] = __builtin_bit_cast(bf16x8, oa); qf[ks + 2] = __builtin_bit_cast(bf16x8, ob);
        }
    }
    asm volatile("s_waitcnt vmcnt(0)" ::: "memory");
    f32x16 o0, o1;
    const bool lead = wv < 4;
    const float gs_keep = gs, gw_keep = gw;
#pragma unroll 1
    for (int repL = 0; repL < NSA_REP_LOOP; ++repL) {
    if (NSA_REP_LOOP > 1) { gs = (repL == NSA_REP_LOOP - 1) ? gs_keep : 0.f; gw = (repL == NSA_REP_LOOP - 1) ? gw_keep : 0.f;
        if (repL > 0) { asm volatile("s_waitcnt vmcnt(0)" ::: "memory"); __builtin_amdgcn_s_barrier(); NSA_ISSUE(0); NSA_ISSUE(1); asm volatile("s_waitcnt vmcnt(0)" ::: "memory"); } }
#pragma unroll
    for (int i = 0; i < 16; ++i) { o0[i] = 0.f; o1[i] = 0.f; }
    m = NEGBIG; l = 0.f;
    if (!lead) { asm volatile("s_waitcnt vmcnt(2)" ::: "memory"); __builtin_amdgcn_s_barrier(); }
#pragma unroll 1
    for (int pos = 0; pos < ntiles; ++pos) {
        if (lead) asm volatile("s_waitcnt vmcnt(2)" ::: "memory");
        __builtin_amdgcn_s_barrier();
        NSA_ISSUE(pos + 2);
        const NLAS unsigned char* slot = lds + L_RING + (pos & 3) * SLOTB;
        f32x16 s0, s1;
        const bool win = pos >= nsel; const int j = win ? jw0 + pos - nsel : pos;
        const bool live = win || ((selmask >> j) & 1ull);
        qk_tile(slot, qf, kofs, s0, s1);
        if (j == qb) mask_tile<false>(s0, s1, qi - 4 * h, 0);
        else if (win && qb >= 8 && j == qb - 8) mask_tile<true>(s0, s1, 63, qi + 1 - 4 * h);
        softmax_core(s0, s1, m, l, o0, o1, live);
        if (!lead) asm volatile("s_waitcnt vmcnt(2)" ::: "memory");
        __builtin_amdgcn_s_barrier();
        pv_tile(slot + 8192, vofs, s0, s1, o0, o1);
        if (pos == nsel - 1) {
            const float L = l + xhalf(l); const float sc = (L > 0.f) ? gs / L : 0.f;
#pragma unroll
            for (int i = 0; i < 16; ++i) { of0[i] += sc * o0[i]; of1[i] += sc * o1[i]; o0[i] = 0.f; o1[i] = 0.f; }
            m = NEGBIG; l = 0.f;
        }
    }
    if (lead) __builtin_amdgcn_s_barrier();
    if (NSA_REP_LOOP > 1 && repL < NSA_REP_LOOP - 1) {
        const float L0 = l + xhalf(l); (void)L0; }
    if (repL == NSA_REP_LOOP - 1)    {
        float L = l + xhalf(l);
        const float npad = (t < 511) ? (float)(511 - t) : 0.f;
        const float m2 = (npad > 0.f) ? fmaxf(m, 0.f) : m;
        const float a = __builtin_amdgcn_exp2f(m - m2);
        L = L * a + npad * __builtin_amdgcn_exp2f(-m2);
        const float sc = (L > 0.f) ? gw * a / L : 0.f;
#pragma unroll
        for (int i = 0; i < 16; ++i) { of0[i] += sc * o0[i]; of1[i] += sc * o1[i]; }
    }
    }
    float ss = 0.f;
#pragma unroll
    for (int i = 0; i < 16; ++i) ss += of0[i] * of0[i] + of1[i] * of1[i];
    ss += xhalf(ss);
    const float rn = rsqrtf(ss * (1.0f / 64.0f) + 1e-6f);
    unsigned short* yrow = P.ycat + (size_t)tok * 1024 + 512 + head * 64;
    const float* nw = P.normw + head * 64;
    float4 w4a[2][4];
#pragma unroll
    for (int mb = 0; mb < 2; ++mb)
#pragma unroll
        for (int u = 0; u < 4; ++u) w4a[mb][u] = *(const float4*)(nw + 32 * mb + 8 * u + 4 * h);
#pragma unroll
    for (int mb = 0; mb < 2; ++mb)
#pragma unroll
        for (int u = 0; u < 4; ++u) {
            const int d0 = 32 * mb + 8 * u + 4 * h;
            const float4 w4 = w4a[mb][u];
            const float v0 = (mb ? of1[4 * u] : of0[4 * u]) * rn * w4.x, v1 = (mb ? of1[4 * u + 1] : of0[4 * u + 1]) * rn * w4.y;
            const float v2 = (mb ? of1[4 * u + 2] : of0[4 * u + 2]) * rn * w4.z, v3 = (mb ? of1[4 * u + 3] : of0[4 * u + 3]) * rn * w4.w;
            *(uint2*)(yrow + d0) = make_uint2(cvtpk(v0, v1), cvtpk(v2, v3));
        }
    asm volatile("s_waitcnt vmcnt(0)" ::: "memory"); __builtin_amdgcn_s_barrier();
#undef NSA_DMA
#undef NSA_ISSUE
}
__device__ __forceinline__ void phase(const Params& P, NLAS unsigned char* lds, const int tid, const int bid, const int G) {
#pragma unroll 1
    for (int vw = bid; vw < 256; vw += G) {
        const int xcd = vw & 7, slot = vw >> 3, bg = xcd * 2 + (slot >> 4), rr = slot & 15;
#pragma unroll 1
        for (int k = 0; k < 4; ++k) { const int qb = (k == 0) ? 63 - rr : (k == 1) ? 32 + rr : (k == 2) ? 31 - rr : rr; unit(P, lds, tid, bg >> 1, bg & 1, qb); }
    }
}
}


namespace wt {
typedef short bf16x8 __attribute__((ext_vector_type(8)));
typedef float f32x16 __attribute__((ext_vector_type(16)));
typedef unsigned u32x4 __attribute__((ext_vector_type(4)));
typedef unsigned u32x2 __attribute__((ext_vector_type(2)));
typedef float f32x2_t __attribute__((ext_vector_type(2)));
typedef __bf16 bf16x2_t __attribute__((ext_vector_type(2)));
#define WT_MFMA(a, b, c) __builtin_amdgcn_mfma_f32_32x32x16_bf16((a), (b), (c), 0, 0, 0)
__device__ __forceinline__ unsigned cvtpk(float lo, float hi) { f32x2_t v = {lo, hi}; bf16x2_t b = __builtin_convertvector(v, bf16x2_t); return __builtin_bit_cast(unsigned, b); }
__device__ __forceinline__ float bflo(unsigned u) { return __uint_as_float(u << 16); }
__device__ __forceinline__ float bfhi(unsigned u) { return __uint_as_float(u & 0xffff0000u); }
__device__ __forceinline__ float xhalf(float v) { return __shfl_xor(v, 32); }
__device__ __forceinline__ bf16x8 ld16(const unsigned short* p) { return __builtin_bit_cast(bf16x8, *(const u32x4*)p); }
__device__ __forceinline__ bf16x8 ld8x2(const unsigned short* p0, const unsigned short* p1) { const u32x2 a = *(const u32x2*)p0, b = *(const u32x2*)p1; u32x4 u = {a.x, a.y, b.x, b.y}; return __builtin_bit_cast(bf16x8, u); }
__device__ __forceinline__ bf16x8 pack8(const f32x16& x, int s) {
    u32x4 u = {cvtpk(x[8 * s], x[8 * s + 1]), cvtpk(x[8 * s + 2], x[8 * s + 3]), cvtpk(x[8 * s + 4], x[8 * s + 5]), cvtpk(x[8 * s + 6], x[8 * s + 7])};
    return __builtin_bit_cast(bf16x8, u);
}
__device__ __forceinline__ float gelu_t(float x) { const float u = 0.7978845608028654f * (x + 0.044715f * x * x * x); const float e = __expf(2.0f * u); return 0.5f * x * (1.0f + (1.0f - 2.0f / (e + 1.0f))); }
__device__ __forceinline__ float sigm(float x) { return 1.0f / (1.0f + __expf(-x)); }
__device__ __forceinline__ void zero(f32x16& a) {
#pragma unroll
    for (int i = 0; i < 16; ++i) a[i] = 0.f;
}

__device__ __forceinline__ void gm_ln8(const unsigned short* __restrict__ hb, const float* __restrict__ lw, const float* __restrict__ lbias, unsigned short* __restrict__ vlnT, int t8, int lane) {
    const int tok0 = t8 * 8;
    const float4 w4 = *(const float4*)(lw + lane * 4), b4 = *(const float4*)(lbias + lane * 4);
    float o[4][8];
#pragma unroll
    for (int i = 0; i < 8; ++i) {
        const u32x2 v4 = *(const u32x2*)(hb + (size_t)(tok0 + i) * 3072 + 1280 + lane * 4);
        float v[4] = {gelu_t(bflo(v4.x)), gelu_t(bfhi(v4.x)), gelu_t(bflo(v4.y)), gelu_t(bfhi(v4.y))};
        float s = (v[0] + v[1]) + (v[2] + v[3]);
#pragma unroll
        for (int o2 = 1; o2 < 64; o2 <<= 1) s += __shfl_xor(s, o2);
        const float mean = s * (1.0f / 256.0f); float q = 0.f;
#pragma unroll
        for (int c = 0; c < 4; ++c) { v[c] -= mean; q += v[c] * v[c]; }
#pragma unroll
        for (int o2 = 1; o2 < 64; o2 <<= 1) q += __shfl_xor(q, o2);
        const float rstd = rsqrtf(q * (1.0f / 256.0f) + 1e-5f);
        o[0][i] = v[0] * rstd * w4.x + b4.x; o[1][i] = v[1] * rstd * w4.y + b4.y; o[2][i] = v[2] * rstd * w4.z + b4.z; o[3][i] = v[3] * rstd * w4.w + b4.w;
    }
    const int bc = tok0 >> 7, s0 = tok0 & 127;
#pragma unroll
    for (int c = 0; c < 4; ++c) {
        const int ch = lane * 4 + c, g = ch >> 6, cc = ch & 63;
        u32x4 u = {cvtpk(o[c][0], o[c][1]), cvtpk(o[c][2], o[c][3]), cvtpk(o[c][4], o[c][5]), cvtpk(o[c][6], o[c][7])};
        *(u32x4*)(vlnT + ((size_t)(bc * 4 + g) * 64 + cc) * 128 + s0) = u;
    }
}
__device__ __forceinline__ void gm_sp_task(const unsigned short* __restrict__ hb, const unsigned short* __restrict__ vlnT, const unsigned short* __restrict__ Wb, const float* __restrict__ bs,
                                           const float* __restrict__ normw, unsigned short* __restrict__ ycat, int task, int lane) {
    const int tb = task & 3, g = (task >> 2) & 3, bc = task >> 4, r = lane & 31, h = lane >> 5;
    const unsigned short* ap = vlnT + ((size_t)(bc * 4 + g) * 64 + r) * 128 + 8 * h;
    const unsigned short* bp = Wb + ((size_t)g * 128 + 32 * tb + r) * 128 + 8 * h;
    f32x16 a0, a1; zero(a0); zero(a1);
    const int nks = 2 * (tb + 1);
#pragma unroll 2
    for (int ks = 0; ks < nks; ++ks) {
        const bf16x8 bw = ld16(bp + 16 * ks);
        const bf16x8 v0 = ld16(ap + 16 * ks), v1 = ld16(ap + 32 * 128 + 16 * ks);
        a0 = WT_MFMA(v0, bw, a0); a1 = WT_MFMA(v1, bw, a1);
    }
    const int tl = 32 * tb + r, tok = bc * 128 + tl;
    const float bias = bs[g * 128 + tl];
    const unsigned short* up = hb + (size_t)tok * 3072 + 1024 + g * 64;
    float z[32]; float ss = 0.f;
#pragma unroll
    for (int cb = 0; cb < 2; ++cb)
#pragma unroll
        for (int u = 0; u < 4; ++u) {
            const int c0 = 32 * cb + 8 * u + 4 * h;
            const u32x2 uu = *(const u32x2*)(up + c0);
            const float uv[4] = {gelu_t(bflo(uu.x)), gelu_t(bfhi(uu.x)), gelu_t(bflo(uu.y)), gelu_t(bfhi(uu.y))};
#pragma unroll
            for (int k = 0; k < 4; ++k) { const float a = (cb ? a1[4 * u + k] : a0[4 * u + k]) + bias; const float zz = uv[k] * a; z[16 * cb + 4 * u + k] = zz; ss += zz * zz; }
        }
    ss += xhalf(ss);
    const float rn = rsqrtf(ss * (1.0f / 64.0f) + 1e-6f);
    unsigned short* yp = ycat + (size_t)tok * 1024 + 256 + g * 64;
    const float* nw = normw + g * 64;
    float4 w4a[2][4];
#pragma unroll
    for (int cb = 0; cb < 2; ++cb)
#pragma unroll
        for (int u = 0; u < 4; ++u) w4a[cb][u] = *(const float4*)(nw + 32 * cb + 8 * u + 4 * h);
#pragma unroll
    for (int cb = 0; cb < 2; ++cb)
#pragma unroll
        for (int u = 0; u < 4; ++u) {
            const int c0 = 32 * cb + 8 * u + 4 * h;
            const float4 w4 = w4a[cb][u];
            u32x2 o = {cvtpk(z[16 * cb + 4 * u] * rn * w4.x, z[16 * cb + 4 * u + 1] * rn * w4.y), cvtpk(z[16 * cb + 4 * u + 2] * rn * w4.z, z[16 * cb + 4 * u + 3] * rn * w4.w)};
            *(u32x2*)(yp + c0) = o;
        }
}

#define WT_LAS __attribute__((address_space(3)))
__device__ __forceinline__ void cmp_wg(const unsigned short* __restrict__ hb, const unsigned short* __restrict__ w1t, const float* __restrict__ cbias, const unsigned short* __restrict__ w2t,
                                       unsigned short* __restrict__ kcb, unsigned short* __restrict__ vcb, WT_LAS float* red, int task, int wave, int lane) {
    const int cblk = task & 7, kv = (task >> 3) & 1, g = (task >> 4) & 1, b = task >> 5, r = lane & 31, h = lane >> 5;
    const int c = 32 * cblk + r; const int cl = c < 254 ? c : 254;
    const unsigned short* bp = hb + (size_t)(b * 4096 + 16 * cl) * 3072 + (kv ? 2176 : 2048) + g * 64 + 8 * h;
    const unsigned short* ap = w1t + ((size_t)kv * 128 + r) * 2048 + 8 * h;
    f32x16 acc[4];
#pragma unroll
    for (int nt = 0; nt < 4; ++nt) zero(acc[nt]);
#pragma unroll 4
    for (int kk = 0; kk < 16; ++kk) {
        const int ks = 16 * wave + kk;
        const bf16x8 bk = ld16(bp + (size_t)(ks >> 2) * 3072 + 16 * (ks & 3));
#pragma unroll
        for (int nt = 0; nt < 4; ++nt) acc[nt] = WT_MFMA(ld16(ap + (size_t)nt * 32 * 2048 + 16 * ks), bk, acc[nt]);
    }
#pragma unroll
    for (int nt = 0; nt < 4; ++nt)
#pragma unroll
        for (int i = 0; i < 16; ++i) red[(wave * 64 + nt * 16 + i) * 64 + lane] = acc[nt][i];
    asm volatile("s_waitcnt lgkmcnt(0)" ::: "memory"); __builtin_amdgcn_s_barrier();
#pragma unroll
    for (int q = 0; q < 8; ++q) {
        const int row = 8 * wave + q; float sacc = 0.f;
#pragma unroll
        for (int w2 = 0; w2 < 8; ++w2) sacc += red[(w2 * 64 + row) * 64 + lane];
        red[row * 64 + lane] = sacc;
    }
    asm volatile("s_waitcnt lgkmcnt(0)" ::: "memory"); __builtin_amdgcn_s_barrier();
    if (wave == 0) {
#pragma unroll
        for (int nt = 0; nt < 4; ++nt)
#pragma unroll
            for (int i = 0; i < 16; ++i) { const int n = 32 * nt + (i & 3) + 8 * (i >> 2) + 4 * h; acc[nt][i] = gelu_t(red[(nt * 16 + i) * 64 + lane] + cbias[kv * 128 + n]); }
        f32x16 o0, o1; zero(o0); zero(o1);
        const unsigned short* w2p = w2t + ((size_t)kv * 64 + r) * 128 + 4 * h;
#pragma unroll
        for (int nt = 0; nt < 4; ++nt)
#pragma unroll
            for (int s = 0; s < 2; ++s) {
                const bf16x8 pb = pack8(acc[nt], s);
                const unsigned short* wp = w2p + 32 * nt + 16 * s;
                o0 = WT_MFMA(ld8x2(wp, wp + 8), pb, o0);
                o1 = WT_MFMA(ld8x2(wp + 32 * 128, wp + 32 * 128 + 8), pb, o1);
            }
        if (c < 255) {
            unsigned short* op = (kv ? vcb : kcb) + ((size_t)(b * 2 + g) * 256 + c) * 64;
#pragma unroll
            for (int db = 0; db < 2; ++db)
#pragma unroll
                for (int u = 0; u < 4; ++u) {
                    const int d0 = 32 * db + 8 * u + 4 * h;
                    u32x2 o = {cvtpk(db ? o1[4 * u] : o0[4 * u], db ? o1[4 * u + 1] : o0[4 * u + 1]), cvtpk(db ? o1[4 * u + 2] : o0[4 * u + 2], db ? o1[4 * u + 3] : o0[4 * u + 3])};
                    *(u32x2*)(op + d0) = o;
                }
        }
    }
    __builtin_amdgcn_s_barrier();
}

__device__ __forceinline__ void kvprep8(const unsigned short* __restrict__ hb, const float* __restrict__ cosT, const float* __restrict__ sinT,
                                        unsigned short* __restrict__ ksb, unsigned short* __restrict__ vsb, unsigned short* __restrict__ kwb, unsigned short* __restrict__ vwb, int idx) {
    const int j8 = idx & 3, g = (idx >> 2) & 1, tok = idx >> 3, b = tok >> 12, t = tok & 4095;
    const unsigned short* hr = hb + (size_t)tok * 3072 + g * 64 + 8 * j8;
    const float4 c0 = *(const float4*)(cosT + (size_t)tok * 32 + 8 * j8), c1 = *(const float4*)(cosT + (size_t)tok * 32 + 8 * j8 + 4);
    const float4 s0 = *(const float4*)(sinT + (size_t)tok * 32 + 8 * j8), s1 = *(const float4*)(sinT + (size_t)tok * 32 + 8 * j8 + 4);
    u32x4 ka[2], kb[2], va[2], vb[2];
#pragma unroll
    for (int w = 0; w < 2; ++w) { const int col = w ? 2560 : 2304, vcol = w ? 2688 : 2432;
        ka[w] = *(const u32x4*)(hr + col); kb[w] = *(const u32x4*)(hr + col + 32); va[w] = *(const u32x4*)(hr + vcol); vb[w] = *(const u32x4*)(hr + vcol + 32); }
    const float cs[8] = {c0.x, c0.y, c0.z, c0.w, c1.x, c1.y, c1.z, c1.w}, sn[8] = {s0.x, s0.y, s0.z, s0.w, s1.x, s1.y, s1.z, s1.w};
    const size_t o = ((size_t)(b * 2 + g) * 4096 + t) * 64 + 8 * j8;
#pragma unroll
    for (int w = 0; w < 2; ++w) {
        u32x4 oa, ob;
#pragma unroll
        for (int c = 0; c < 4; ++c) {
            const float a0 = bflo(ka[w][c]), a1 = bfhi(ka[w][c]), b0 = bflo(kb[w][c]), b1 = bfhi(kb[w][c]);
            oa[c] = cvtpk(a0 * cs[2 * c] - b0 * sn[2 * c], a1 * cs[2 * c + 1] - b1 * sn[2 * c + 1]);
            ob[c] = cvtpk(b0 * cs[2 * c] + a0 * sn[2 * c], b1 * cs[2 * c + 1] + a1 * sn[2 * c + 1]);
        }
        unsigned short* kd = (w ? kwb : ksb) + o;
        *(u32x4*)kd = oa; *(u32x4*)(kd + 32) = ob;
        unsigned short* vd = (w ? vwb : vsb) + o;
        *(u32x4*)vd = va[w]; *(u32x4*)(vd + 32) = vb[w];
    }
}

__device__ __forceinline__ void hg_pass1(const unsigned short* __restrict__ hb, const float* __restrict__ lbl, unsigned short* __restrict__ Qt, unsigned short* __restrict__ Kt,
                                         unsigned short* __restrict__ Qp, unsigned short* __restrict__ VT, float* __restrict__ Ut, float* __restrict__ Dk, int ci, int lane) {
    const int chunk = ci & 63, hd = (ci >> 6) & 3, b = ci >> 8;
    const unsigned short* hp = hb + (size_t)(b * 4096 + chunk * 64) * 3072 + hd * 64 + lane;
    const float lb = lbl[hd * 64 + lane];
    float run = 0.f, cmid = 0.f;
#pragma unroll 8
    for (int t = 0; t < 64; ++t) {
        const float fr = __uint_as_float((unsigned)hp[(size_t)t * 3072 + 256] << 16);
        run += __logf(lb + (1.0f - lb) * sigm(fr));
        cmid = (t == 31) ? run : cmid;
    }
    const float blast = run;
    Dk[(size_t)ci * 64 + lane] = __expf(blast);
    unsigned short* qt = Qt + (size_t)ci * 4096 + lane; unsigned short* kt = Kt + (size_t)ci * 4096 + lane; unsigned short* qp = Qp + (size_t)ci * 4096 + lane;
    unsigned short* vt = VT + (size_t)ci * 4096 + lane * 64;
    const int h = lane >> 5, r = lane & 31;
    f32x16 acc[2][2];
#pragma unroll
    for (int a = 0; a < 2; ++a)
#pragma unroll
        for (int c = 0; c < 2; ++c) zero(acc[a][c]);
    float bt = 0.f;
#pragma unroll 1
    for (int ks = 0; ks < 4; ++ks) {
        unsigned kp[8], vp[8];
        unsigned short rq[8], rf[8], ri[8];
#pragma unroll
        for (int tp = 0; tp < 8; ++tp) {
            if ((tp & 3) == 0) {
#pragma unroll
                for (int tt = 0; tt < 8; ++tt) { const size_t o = (size_t)(ks * 16 + tp * 2 + tt) * 3072; rq[tt] = hp[o]; rf[tt] = hp[o + 256]; ri[tt] = hp[o + 512]; }
            }
            float k2v[2], ivv[2];
#pragma unroll
            for (int e = 0; e < 2; ++e) {
                const int t = ks * 16 + tp * 2 + e;
                const float qr = __uint_as_float((unsigned)rq[(tp & 3) * 2 + e] << 16), fr = __uint_as_float((unsigned)rf[(tp & 3) * 2 + e] << 16);
                ivv[e] = __uint_as_float((unsigned)ri[(tp & 3) * 2 + e] << 16);
                const float sf = sigm(fr);
                const float q = qr * sigm(qr), kk = (1.0f - lb) * (1.0f - sf);
                bt += __logf(lb + (1.0f - lb) * sf);
                qt[t * 64] = (unsigned short)(cvtpk(q * __expf(bt - cmid), 0.f) & 0xffffu);
                kt[t * 64] = (unsigned short)(cvtpk(kk * __expf(cmid - bt), 0.f) & 0xffffu);
                qp[t * 64] = (unsigned short)(cvtpk(q * __expf(bt), 0.f) & 0xffffu);
                k2v[e] = kk * __expf(blast - bt);
            }
            kp[tp] = cvtpk(k2v[0], k2v[1]); vp[tp] = cvtpk(ivv[0], ivv[1]);
        }
        { u32x4 u0 = {vp[0], vp[1], vp[2], vp[3]}, u1 = {vp[4], vp[5], vp[6], vp[7]};
          *(u32x4*)(vt + ks * 16) = u0; *(u32x4*)(vt + ks * 16 + 8) = u1; }
        u32x4 kown, vown, ksnd, vsnd;
#pragma unroll
        for (int j = 0; j < 4; ++j) { kown[j] = h ? kp[4 + j] : kp[j]; ksnd[j] = h ? kp[j] : kp[4 + j]; vown[j] = h ? vp[4 + j] : vp[j]; vsnd[j] = h ? vp[j] : vp[4 + j]; }
        u32x4 krcv, vrcv;
#pragma unroll
        for (int j = 0; j < 4; ++j) { krcv[j] = (unsigned)__shfl_xor((int)ksnd[j], 32); vrcv[j] = (unsigned)__shfl_xor((int)vsnd[j], 32); }
        const bf16x8 kb0 = __builtin_bit_cast(bf16x8, h ? krcv : kown), kb1 = __builtin_bit_cast(bf16x8, h ? kown : krcv);
        const bf16x8 va0 = __builtin_bit_cast(bf16x8, h ? vrcv : vown), va1 = __builtin_bit_cast(bf16x8, h ? vown : vrcv);
        acc[0][0] = WT_MFMA(va0, kb0, acc[0][0]); acc[0][1] = WT_MFMA(va0, kb1, acc[0][1]);
        acc[1][0] = WT_MFMA(va1, kb0, acc[1][0]); acc[1][1] = WT_MFMA(va1, kb1, acc[1][1]);
    }
    float* up = Ut + (size_t)ci * 4096;
#pragma unroll
    for (int vb = 0; vb < 2; ++vb)
#pragma unroll
        for (int kb = 0; kb < 2; ++kb)
#pragma unroll
            for (int i = 0; i < 16; ++i) { const int v = 32 * vb + (i & 3) + 8 * (i >> 2) + 4 * h; up[v * 64 + 32 * kb + r] = acc[vb][kb][i]; }
}
__device__ __forceinline__ void hg_scan(const float* __restrict__ Ut, const float* __restrict__ Dk, unsigned short* __restrict__ ST, int e) {
    const int k = e & 63, seq = e >> 12, vk = e & 4095;
    float S = 0.f;
    const float* up = Ut + (size_t)seq * 64 * 4096 + vk; const float* dp = Dk + (size_t)seq * 64 * 64 + k; unsigned short* sp = ST + (size_t)seq * 64 * 4096 + vk;
#pragma unroll 8
    for (int c = 0; c < 64; ++c) {
        sp[(size_t)c * 4096] = (unsigned short)(cvtpk(S, 0.f) & 0xffffu);
        S = fmaf(dp[c * 64], S, up[(size_t)c * 4096]);
    }
}
__device__ __forceinline__ void hg_pass3(const unsigned short* __restrict__ hb, const unsigned short* __restrict__ Qt, const unsigned short* __restrict__ Kt, const unsigned short* __restrict__ Qp,
                                         const unsigned short* __restrict__ VT, const unsigned short* __restrict__ ST, const float* __restrict__ normw, unsigned short* __restrict__ ycat, int task, int lane) {
    const int tblk = task & 1, ci = task >> 1, chunk = ci & 63, hd = (ci >> 6) & 3, b = ci >> 8, r = lane & 31, h = lane >> 5;
    const size_t cb = (size_t)ci * 4096;
    f32x16 o0, o1; zero(o0); zero(o1);
    {
        const unsigned short* sp = ST + cb + (size_t)r * 64 + 8 * h; const unsigned short* qp = Qp + cb + (size_t)(32 * tblk + r) * 64 + 8 * h;
#pragma unroll
        for (int ks = 0; ks < 4; ++ks) { const bf16x8 q = ld16(qp + 16 * ks); o0 = WT_MFMA(ld16(sp + 16 * ks), q, o0); o1 = WT_MFMA(ld16(sp + 32 * 64 + 16 * ks), q, o1); }
    }
    const unsigned short* qtp = Qt + cb + (size_t)(32 * tblk + r) * 64 + 8 * h;
    bf16x8 qf[4];
#pragma unroll
    for (int ks = 0; ks < 4; ++ks) qf[ks] = ld16(qtp + 16 * ks);
#pragma unroll 1
    for (int sblk = 0; sblk <= tblk; ++sblk) {
        f32x16 at; zero(at);
        const unsigned short* ktp = Kt + cb + (size_t)(32 * sblk + r) * 64 + 8 * h;
#pragma unroll
        for (int ks = 0; ks < 4; ++ks) at = WT_MFMA(ld16(ktp + 16 * ks), qf[ks], at);
        if (sblk == tblk) {
#pragma unroll
            for (int i = 0; i < 16; ++i) { const int sl = (i & 3) + 8 * (i >> 2) + 4 * h; at[i] = (sl <= r) ? at[i] : 0.f; }
        }
#pragma unroll
        for (int s2 = 0; s2 < 2; ++s2) {
            const bf16x8 pb = pack8(at, s2);
            const unsigned short* vp = VT + cb + (size_t)r * 64 + 32 * sblk + 16 * s2 + 4 * h;
            o0 = WT_MFMA(ld8x2(vp, vp + 8), pb, o0);
            o1 = WT_MFMA(ld8x2(vp + 32 * 64, vp + 32 * 64 + 8), pb, o1);
        }
    }
    const int tok = b * 4096 + chunk * 64 + 32 * tblk + r;
    float ss = 0.f;
#pragma unroll
    for (int i = 0; i < 16; ++i) ss += o0[i] * o0[i] + o1[i] * o1[i];
    ss += xhalf(ss);
    const float rn = rsqrtf(ss * (1.0f / 64.0f) + 1e-6f);
    const unsigned short* gp = hb + (size_t)tok * 3072 + 768 + hd * 64;
    unsigned short* yp = ycat + (size_t)tok * 1024 + hd * 64;
    const float* nw = normw + hd * 64;
    u32x2 gg[2][4]; float4 w4[2][4];
#pragma unroll
    for (int vb = 0; vb < 2; ++vb)
#pragma unroll
        for (int u = 0; u < 4; ++u) { const int v0 = 32 * vb + 8 * u + 4 * h; gg[vb][u] = *(const u32x2*)(gp + v0); w4[vb][u] = *(const float4*)(nw + v0); }
#pragma unroll
    for (int vb = 0; vb < 2; ++vb)
#pragma unroll
        for (int u = 0; u < 4; ++u) {
            const int v0 = 32 * vb + 8 * u + 4 * h;
            const float x0 = (vb ? o1[4 * u] : o0[4 * u]) * rn * w4[vb][u].x * sigm(bflo(gg[vb][u].x)), x1 = (vb ? o1[4 * u + 1] : o0[4 * u + 1]) * rn * w4[vb][u].y * sigm(bfhi(gg[vb][u].x));
            const float x2 = (vb ? o1[4 * u + 2] : o0[4 * u + 2]) * rn * w4[vb][u].z * sigm(bflo(gg[vb][u].y)), x3 = (vb ? o1[4 * u + 3] : o0[4 * u + 3]) * rn * w4[vb][u].w * sigm(bfhi(gg[vb][u].y));
            u32x2 o = {cvtpk(x0, x1), cvtpk(x2, x3)};
            *(u32x2*)(yp + v0) = o;
        }
}

__device__ __forceinline__ void route_task(const unsigned short* __restrict__ x1, const unsigned short* __restrict__ rwh, const unsigned short* __restrict__ rwl, const float* __restrict__ rb,
                                           int* __restrict__ cnt, int* __restrict__ list, int* __restrict__ tok_e, int* __restrict__ tok_slot, float* __restrict__ tok_w, int task, int lane) {
    const int r = lane & 31, h = lane >> 5, tok = task * 32 + r;
    const unsigned short* xp = x1 + (size_t)tok * 1024 + 8 * h;
    const unsigned short* whp = rwh + (size_t)r * 1024 + 8 * h; const unsigned short* wlp = rwl + (size_t)r * 1024 + 8 * h;
    f32x16 acc; zero(acc);
#pragma unroll 8
    for (int ks = 0; ks < 64; ++ks) {
        const bf16x8 xh = ld16(xp + 16 * ks);
        acc = WT_MFMA(ld16(whp + 16 * ks), xh, acc); acc = WT_MFMA(ld16(wlp + 16 * ks), xh, acc);
    }
    float v[16];
#pragma unroll
    for (int i = 0; i < 16; ++i) v[i] = acc[i] + rb[(i & 3) + 8 * (i >> 2) + 4 * h];
    float cv[8]; int ce[8];
#pragma unroll
    for (int k = 0; k < 4; ++k) {
        float best = -3.0e38f; int bi = 0;
#pragma unroll
        for (int i = 0; i < 16; ++i) { const bool ok = v[i] > best; best = ok ? v[i] : best; bi = ok ? i : bi; }
#pragma unroll
        for (int i = 0; i < 16; ++i) v[i] = (i == bi) ? -3.0e38f : v[i];
        cv[k] = best; ce[k] = (bi & 3) + 8 * (bi >> 2) + 4 * h;
    }
#pragma unroll
    for (int k = 0; k < 4; ++k) { cv[4 + k] = xhalf(cv[k]); ce[4 + k] = __shfl_xor(ce[k], 32); }
    float tl[4]; int te[4];
#pragma unroll
    for (int k = 0; k < 4; ++k) {
        float best = -3.0e38f; int be = 64, bj = 0;
#pragma unroll
        for (int j = 0; j < 8; ++j) { const bool ok = (cv[j] > best) || (cv[j] == best && ce[j] < be); best = ok ? cv[j] : best; be = ok ? ce[j] : be; bj = ok ? j : bj; }
#pragma unroll
        for (int j = 0; j < 8; ++j) cv[j] = (j == bj) ? -3.0e38f : cv[j];
        tl[k] = best; te[k] = be;
    }
    const float e1 = __expf(tl[1] - tl[0]), e2 = __expf(tl[2] - tl[0]), e3 = __expf(tl[3] - tl[0]);
    const float inv = 1.0f / (1.0f + e1 + e2 + e3);
    const float tw[4] = {inv, e1 * inv, e2 * inv, e3 * inv};
    unsigned mymask = 0u;
#pragma unroll 1
    for (int e = 0; e < 32; ++e) {
        const unsigned mk = (unsigned)__ballot(h == 0 && (te[0] == e || te[1] == e || te[2] == e || te[3] == e));
        mymask = (lane == e) ? mk : mymask;
    }
    int base = 0;
    if (lane < 32 && mymask != 0u) base = atomicAdd(&cnt[lane], __popc(mymask));
#pragma unroll
    for (int k = 0; k < 4; ++k) {
        const int bk = __shfl(base, te[k]); const unsigned mk = (unsigned)__shfl((int)mymask, te[k]);
        const int slot = bk + __popc(mk & ((1u << r) - 1u));
        if (h == 0) { list[te[k] * 32768 + slot] = tok; tok_e[tok * 4 + k] = te[k]; tok_slot[tok * 4 + k] = slot; tok_w[tok * 4 + k] = tw[k]; }
    }
}
}


__device__ __forceinline__ void ln1_tok2(const float* __restrict__ xin_f, const bf16* __restrict__ xin_b, const bf16* __restrict__ mix, const float* __restrict__ lw, const float* __restrict__ lbias,
                                         bf16* __restrict__ x1b, unsigned char* __restrict__ x1q, int tok0, int lane) {
    float v[2][16]; float s[2] = {0.f, 0.f};
#pragma unroll
    for (int u = 0; u < 2; ++u)
#pragma unroll
        for (int j = 0; j < 4; ++j) {
            const size_t o = (size_t)(tok0 + u) * D_ + j * 256 + lane * 4;
            float4 a;
            if (xin_f) a = *(const float4*)(xin_f + o);
            else { const uint2 ab = *(const uint2*)(xin_b + o);
                   a = make_float4(__uint_as_float(ab.x << 16), __uint_as_float(ab.x & 0xffff0000u), __uint_as_float(ab.y << 16), __uint_as_float(ab.y & 0xffff0000u)); }
            const uint2 mb = *(const uint2*)(mix + o);
            v[u][4 * j] = ALPHA * a.x + __uint_as_float(mb.x << 16); v[u][4 * j + 1] = ALPHA * a.y + __uint_as_float(mb.x & 0xffff0000u);
            v[u][4 * j + 2] = ALPHA * a.z + __uint_as_float(mb.y << 16); v[u][4 * j + 3] = ALPHA * a.w + __uint_as_float(mb.y & 0xffff0000u);
            s[u] += (v[u][4 * j] + v[u][4 * j + 1]) + (v[u][4 * j + 2] + v[u][4 * j + 3]);
        }
    float rstd[2];
#pragma unroll
    for (int u = 0; u < 2; ++u) {
        const float mean = wsum(s[u]) * (1.0f / D_); float q = 0.f;
#pragma unroll
        for (int i = 0; i < 16; ++i) { v[u][i] -= mean; q += v[u][i] * v[u][i]; }
        rstd[u] = rsqrtf(wsum(q) * (1.0f / D_) + 1e-5f);
    }
    float4 w4a[4], b4a[4];
#pragma unroll
    for (int j = 0; j < 4; ++j) { w4a[j] = *(const float4*)(lw + j * 256 + lane * 4); b4a[j] = *(const float4*)(lbias + j * 256 + lane * 4); }
#pragma unroll
    for (int j = 0; j < 4; ++j) {
        const float4 w4 = w4a[j], b4 = b4a[j];
#pragma unroll
        for (int u = 0; u < 2; ++u) {
            const size_t o = (size_t)(tok0 + u) * D_ + j * 256 + lane * 4;
            const float4 r = make_float4(v[u][4 * j] * rstd[u] * w4.x + b4.x, v[u][4 * j + 1] * rstd[u] * w4.y + b4.y, v[u][4 * j + 2] * rstd[u] * w4.z + b4.z, v[u][4 * j + 3] * rstd[u] * w4.w + b4.w);
            *(uint2*)(x1b + o) = make_uint2(pk2(r.x, r.y), pk2(r.z, r.w));
            *(unsigned*)(x1q + o) = pg8::pk4_fp8(r.x, r.y, r.z, r.w);
        }
    }
}
__device__ __forceinline__ void comb_ln2_tok2(const bf16* __restrict__ x1, const bf16* __restrict__ y, const int* __restrict__ offs, const int* __restrict__ tok_e,
                                              const int* __restrict__ tok_slot, const float* __restrict__ tok_w, const float* __restrict__ lw, const float* __restrict__ lbias,
                                              float* __restrict__ xout, bf16* __restrict__ xbout, int tok0, int lane) {
    int row[2][4]; float wk[2][4];
#pragma unroll
    for (int u = 0; u < 2; ++u)
#pragma unroll
        for (int k = 0; k < 4; ++k) { const int i = (tok0 + u) * 4 + k; row[u][k] = offs[tok_e[i]] + tok_slot[i]; wk[u][k] = tok_w[i]; }
    float v[2][16];
#pragma unroll
    for (int u = 0; u < 2; ++u)
#pragma unroll
        for (int j = 0; j < 4; ++j) { const uint2 ab = *(const uint2*)(x1 + (size_t)(tok0 + u) * D_ + j * 256 + lane * 4);
            v[u][4 * j] = ALPHA * __uint_as_float(ab.x << 16); v[u][4 * j + 1] = ALPHA * __uint_as_float(ab.x & 0xffff0000u); v[u][4 * j + 2] = ALPHA * __uint_as_float(ab.y << 16); v[u][4 * j + 3] = ALPHA * __uint_as_float(ab.y & 0xffff0000u); }
#pragma unroll
    for (int u = 0; u < 2; ++u)
#pragma unroll
        for (int k = 0; k < 4; ++k)
#pragma unroll
            for (int j = 0; j < 4; ++j) { const uint2 ab = *(const uint2*)(y + (size_t)row[u][k] * D_ + j * 256 + lane * 4); const float w = wk[u][k];
                v[u][4 * j] = fmaf(w, __uint_as_float(ab.x << 16), v[u][4 * j]); v[u][4 * j + 1] = fmaf(w, __uint_as_float(ab.x & 0xffff0000u), v[u][4 * j + 1]);
                v[u][4 * j + 2] = fmaf(w, __uint_as_float(ab.y << 16), v[u][4 * j + 2]); v[u][4 * j + 3] = fmaf(w, __uint_as_float(ab.y & 0xffff0000u), v[u][4 * j + 3]); }
    float rstd[2];
#pragma unroll
    for (int u = 0; u < 2; ++u) {
        float s = 0.f;
#pragma unroll
        for (int i = 0; i < 16; ++i) s += v[u][i];
        const float mean = wsum(s) * (1.0f / D_); float q = 0.f;
#pragma unroll
        for (int i = 0; i < 16; ++i) { v[u][i] -= mean; q += v[u][i] * v[u][i]; }
        rstd[u] = rsqrtf(wsum(q) * (1.0f / D_) + 1e-5f);
    }
    float4 w4a[4], b4a[4];
#pragma unroll
    for (int j = 0; j < 4; ++j) { w4a[j] = *(const float4*)(lw + j * 256 + lane * 4); b4a[j] = *(const float4*)(lbias + j * 256 + lane * 4); }
#pragma unroll
    for (int j = 0; j < 4; ++j) {
        const float4 w4 = w4a[j], b4 = b4a[j];
#pragma unroll
        for (int u = 0; u < 2; ++u) {
            const size_t o = (size_t)(tok0 + u) * D_ + j * 256 + lane * 4;
            const float4 r = make_float4(v[u][4 * j] * rstd[u] * w4.x + b4.x, v[u][4 * j + 1] * rstd[u] * w4.y + b4.y, v[u][4 * j + 2] * rstd[u] * w4.z + b4.z, v[u][4 * j + 3] * rstd[u] * w4.w + b4.w);
            if (xout) *(float4*)(xout + o) = r;
            if (xbout) *(uint2*)(xbout + o) = make_uint2(pk2(r.x, r.y), pk2(r.z, r.w));
        }
    }
}

struct Args { const float* in[25]; float* out; unsigned char* ws; int ph_lo, ph_hi; };
#define PH __device__ __forceinline__
constexpr int TAB_OFF = 131072;

__device__ __forceinline__ void transpose_item(const float* __restrict__ W, int K, int N, bf16* __restrict__ WT, int k0, int scol0, int drow0, float* scr, int lane) {
    const int cc = lane & 31; const bool cv = (scol0 + cc) < N;
#pragma unroll 8
    for (int i = 0; i < 32; ++i) { const int kk = 2 * i + (lane >> 5); scr[kk * 33 + cc] = cv ? W[(size_t)(k0 + kk) * N + scol0 + cc] : 0.f; }
    asm volatile("s_waitcnt lgkmcnt(0)" ::: "memory");
    const int c = lane & 7;
#pragma unroll
    for (int j = 0; j < 4; ++j) { const int n = (lane >> 3) + 8 * j; const float* s = scr + (8 * c) * 33 + n;
        uint4 o; o.x = pk2(s[0 * 33], s[1 * 33]); o.y = pk2(s[2 * 33], s[3 * 33]); o.z = pk2(s[4 * 33], s[5 * 33]); o.w = pk2(s[6 * 33], s[7 * 33]);
        *(uint4*)(WT + (size_t)(drow0 + n) * K + k0 + 8 * c) = o; }
    asm volatile("s_waitcnt lgkmcnt(0)" ::: "memory");
}
__device__ __forceinline__ void transpose64(const float* __restrict__ W, int K, int N, bf16* __restrict__ WT, int k0, int scol0, int drow0, int lane) {
    const int q = lane >> 4, c = lane & 15;
    const bool cv = (scol0 + 4 * c) < N;
    const float* src = W + (size_t)(k0 + 16 * q) * N + scol0 + 4 * c;
    float4 v[16];
#pragma unroll
    for (int i = 0; i < 16; ++i) v[i] = cv ? *(const float4*)(src + (size_t)i * N) : make_float4(0.f, 0.f, 0.f, 0.f);
    bf16* dst = WT + (size_t)(drow0 + 4 * c) * K + k0 + 16 * q;
#pragma unroll
    for (int j = 0; j < 4; ++j) {
        float e[16];
#pragma unroll
        for (int i = 0; i < 16; ++i) e[i] = (j == 0) ? v[i].x : (j == 1) ? v[i].y : (j == 2) ? v[i].z : v[i].w;
        uint4 o0, o1;
        o0.x = pk2(e[0], e[1]); o0.y = pk2(e[2], e[3]); o0.z = pk2(e[4], e[5]); o0.w = pk2(e[6], e[7]);
        o1.x = pk2(e[8], e[9]); o1.y = pk2(e[10], e[11]); o1.z = pk2(e[12], e[13]); o1.w = pk2(e[14], e[15]);
        *(uint4*)(dst + (size_t)j * K) = o0; *(uint4*)(dst + (size_t)j * K + 8) = o1;
    }
}
__device__ __forceinline__ void transpose64_f8(const float* __restrict__ W, int K, int N, unsigned char* __restrict__ WT, int k0, int scol0, int drow0, float sc, int lane) {
    const int q = lane >> 4, c = lane & 15;
    const float* src = W + (size_t)(k0 + 16 * q) * N + scol0 + 4 * c;
    float4 v[16];
#pragma unroll
    for (int i = 0; i < 16; ++i) { typedef float f4v __attribute__((ext_vector_type(4))); const f4v t = __builtin_nontemporal_load((const f4v*)(src + (size_t)i * N)); v[i] = make_float4(t.x, t.y, t.z, t.w); }
    unsigned char* dst = WT + (size_t)(drow0 + 4 * c) * K + k0 + 16 * q;
#pragma unroll
    for (int j = 0; j < 4; ++j) {
        float e[16];
#pragma unroll
        for (int i = 0; i < 16; ++i) e[i] = sc * ((j == 0) ? v[i].x : (j == 1) ? v[i].y : (j == 2) ? v[i].z : v[i].w);
        uint4 o;
        o.x = pg8::pk4_fp8(e[0], e[1], e[2], e[3]); o.y = pg8::pk4_fp8(e[4], e[5], e[6], e[7]); o.z = pg8::pk4_fp8(e[8], e[9], e[10], e[11]); o.w = pg8::pk4_fp8(e[12], e[13], e[14], e[15]);
        *(uint4*)(dst + (size_t)j * K) = o;
    }
}
PH void ph_prologue(int wv, const int* pos, const float* hg_lb, float* cosT, float* sinT, float* lb,
                    const float* x, bf16* xb, const float* w_in, const float* w_out, const float* w_up, const float* w_dn, bf16* wt_in, bf16* wt_out, bf16* wt_up, bf16* wt_dn,
                    const float* gm_sw, bf16* wb, const float* cpe, const float* cw1, bf16* w1t, float* cbias, const float* cw2, bf16* w2t, const float* rw, bf16* rwh, bf16* rwl) {
    extern __shared__ __attribute__((aligned(16))) unsigned char lds[];
    int tid = mk_tid(wv), bid = blockIdx.x; asm volatile("" : "+v"(tid), "+s"(bid)); const int G = gridDim.x, lane = tid & 63, wave = wv;
#pragma unroll 1
    for (int i = bid * NTHR + tid; i < NT * 32; i += G * NTHR) {
        int t = i >> 5, j = i & 31;
        float inv = (float)pow(10000.0, -(double)(2 * j) / 64.0);
        float ang = (float)pos[t] * inv;
        const double ad = (double)ang, kk = rint(ad * 0.15915494309189535);
        const float rf = (float)fma(-kk, 6.283185307179586, ad);
        cosT[i] = cosf(rf); sinT[i] = sinf(rf);
    }
    if (bid == 0 && tid < 256) {
        float p0 = hg_lb[tid], p1 = hg_lb[256 + tid];
        float m = fmaxf(p0, p1); float ea = expf(p0 - m), eb = expf(p1 - m);
        lb[tid] = 0.f; lb[256 + tid] = eb / (ea + eb);
    }
#pragma unroll 1
    for (size_t i = (size_t)bid * NTHR + tid; i < (size_t)NT * D_ / 4; i += (size_t)G * NTHR) {
        float4 v = ((const float4*)x)[i]; ((uint2*)xb)[i] = make_uint2(pk2(v.x, v.y), pk2(v.z, v.w));
    }
#pragma unroll 1
    for (int i = bid * NTHR + tid; i < DEPTH * NE * D_; i += G * NTHR) { const int k = i & 1023, e = (i >> 10) & 31, l = i >> 15; const float w = rw[((size_t)l * D_ + k) * NE + e];
        const unsigned hi = f2bf(w); rwh[i] = (bf16)hi; rwl[i] = (bf16)f2bf(w - __uint_as_float(hi << 16)); }
#pragma unroll 1
    for (int i = bid * NTHR + tid; i < DEPTH * 4 * 128 * 128; i += G * NTHR) { const int s = i & 127, t = (i >> 7) & 127; wb[i] = (bf16)f2bf(s <= t ? gm_sw[i] : 0.f); }
    {
        const int gwv = bid * 8 + wave, NGWV = G * 8;
#pragma unroll 1
        for (int o = gwv; o < DEPTH * 2 * 128; o += NGWV) {
            const int lk = o >> 7, n = o & 127;
            float a = 0.f;
#pragma unroll 8
            for (int i = lane; i < 2048; i += 64) a = fmaf(cpe[lk * 2048 + i], cw1[((size_t)lk * 2048 + i) * 128 + n], a);
            a = wsum(a);
            if (lane == 0) cbias[o] = a;
        }
    }
    float* scr = (float*)(lds + wave * 16384);
    const int gw = bid * 8 + wave, NGW = G * 8;
    constexpr int I_IN = 16 * 45, I_OUT = 16 * 16;
    constexpr int I_C1 = 32 * 4;
    constexpr int I_C2 = 2 * 2;
    constexpr int PER_L = I_IN + I_OUT + 2 * I_C1 + 2 * I_C2;
#pragma unroll 1
    for (int it = gw; it < DEPTH * PER_L; it += NGW) {
        const int l = it / PER_L; int r = it % PER_L;
        if (r < I_IN) { const int kb = r / 45, nb = r % 45; transpose64(w_in + (size_t)l * D_ * INW, D_, INW, wt_in + (size_t)l * HS * D_, kb * 64, nb * 64, nb * 64, lane); continue; }
        r -= I_IN;
        if (r < I_OUT) { const int kb = r / 16, nb = r % 16; transpose64(w_out + (size_t)l * D_ * D_, D_, D_, wt_out + (size_t)l * D_ * D_, kb * 64, nb * 64, nb * 64, lane); continue; }
        r -= I_OUT;
        if (r < 2 * I_C1) { const int kv = r / I_C1, q = r % I_C1, kb = q / 4, nb = q % 4;
            transpose_item(cw1 + ((size_t)l * 2 + kv) * 2048 * 128, 2048, 128, w1t + ((size_t)l * 2 + kv) * 128 * 2048, kb * 64, nb * 32, nb * 32, scr, lane); continue; }
        r -= 2 * I_C1;
        { const int kv = r / I_C2, q = r % I_C2, kb = q / 2, nb = q % 2;
            transpose_item(cw2 + ((size_t)l * 2 + kv) * 128 * 64, 128, 64, w2t + ((size_t)l * 2 + kv) * 64 * 128, kb * 64, nb * 32, nb * 32, scr, lane); }
    }
}
#define M1EN(x) 1
#ifndef M1REP
#define M1R(x) 1
#else
#define M1R(x) (((x) == M1REP) ? 3 : 1)
#endif
PH void ph_mix1(int wv, const bf16* hb, const float* lb, bf16* hqt, bf16* hkt, bf16* hqp, bf16* hvt, float* hut, float* hdk,
                const float* glw, const float* glb, bf16* vlnT, const bf16* w1t, const float* cbias, const bf16* w2, bf16* kcb, bf16* vcb,
                const float* cosT, const float* sinT, bf16* ksb, bf16* vsb, bf16* kwb, bf16* vwb,
                const float* w_up, const float* w_dn, unsigned char* wt_up, unsigned char* wt_dn) {
    extern __shared__ __attribute__((aligned(16))) unsigned char lds[];
    int tid = mk_tid(wv), bid = blockIdx.x; asm volatile("" : "+v"(tid), "+s"(bid)); const int lane = tid & 63, wave = wv, G = gridDim.x;
    const int gw = bid * 8 + wave, NGW = G * 8;
    { int ln = lane; asm volatile("" : "+v"(ln));
#pragma unroll 1
    for (int rp = 0; rp < M1R(1); ++rp)
#pragma unroll 1
    for (int u = bid; u < 256 && M1EN(1); u += G) wt::cmp_wg(hb, w1t, cbias, w2, kcb, vcb, (WT_LAS float*)lds, u, wave, ln); }
    { int ln = lane; asm volatile("" : "+v"(ln));
#pragma unroll 1
    for (int rp = 0; rp < M1R(2); ++rp)
#pragma unroll 1
    for (int u = gw; u < 2048 && M1EN(2); u += NGW) wt::hg_pass1(hb, lb, hqt, hkt, hqp, hvt, hut, hdk, u, ln); }
    { int ln = lane; asm volatile("" : "+v"(ln));
#pragma unroll 1
    for (int rp = 0; rp < M1R(4); ++rp)
#pragma unroll 1
    for (int u = gw; u < NT / 8 && M1EN(4); u += NGW) wt::gm_ln8(hb, glw, glb, vlnT, u, ln); }
#pragma unroll 1
    for (int rp = 0; rp < M1R(8); ++rp)
#pragma unroll 1
    for (int idx = bid * NTHR + tid; idx < NT * 8; idx += G * NTHR) wt::kvprep8(hb, cosT, sinT, ksb, vsb, kwb, vwb, idx);
    { int ln = lane; asm volatile("" : "+v"(ln));
      constexpr int I_UP = 16 * 32, I_DN = 16 * 16;
#pragma unroll 1
      for (int rp = 0; rp < M1R(16); ++rp)
#pragma unroll 1
      for (int it = gw; it < NE * (I_UP + I_DN); it += NGW) {
          int r = it;
          if (r < NE * I_UP) { const int e = r / I_UP, q = r % I_UP, kb = q / 32, nb = q % 32;
              const int n0 = nb * 64, pn = n0 >> 8, bj = (n0 >> 7) & 1, jj = n0 & 127;
              transpose64_f8(w_up + (size_t)e * D_ * 2048, D_, 2048, wt_up + (size_t)e * 2048 * D_, kb * 64, bj * 1024 + 128 * pn + jj, n0, pg8::F8_SU, ln); continue; }
          r -= NE * I_UP;
          { const int e = r / I_DN, q = r % I_DN, kb = q / 16, nb = q % 16;
              transpose64_f8(w_dn + (size_t)e * D_ * D_, D_, D_, wt_dn + (size_t)e * D_ * D_, kb * 64, nb * 64, nb * 64, pg8::F8_SD, ln); }
      } }
}
PH void ph_mix2(int wv, const float* hut, const float* hdk, bf16* hst, const bf16* hb, const bf16* vlnT, const bf16* wb, const float* sb, const float* nw, bf16* ycat) {
    int tid = mk_tid(wv), bid = blockIdx.x; asm volatile("" : "+v"(tid), "+s"(bid)); const int lane = tid & 63, wave = wv, G = gridDim.x;
#pragma unroll 1
    for (int e = bid * NTHR + tid; e < 32 * 4096; e += G * NTHR) wt::hg_scan(hut, hdk, hst, e);
    const int gw = bid * 8 + wave, NGW = G * 8;
#pragma unroll 1
    for (int u = gw; u < 4096; u += NGW) wt::gm_sp_task(hb, vlnT, wb, sb, nw, ycat, u, lane);
}
PH void ph_hg3(int wv, const bf16* hb, const bf16* hqt, const bf16* hkt, const bf16* hqp, const bf16* hvt, const bf16* hst, const float* nw, bf16* ycat) {
    int tid = mk_tid(wv), bid = blockIdx.x; asm volatile("" : "+v"(tid), "+s"(bid)); const int lane = tid & 63, wave = wv, G = gridDim.x;
    const int gw = bid * 8 + wave, NGW = G * 8;
#pragma unroll 1
    for (int u = gw; u < 4096; u += NGW) wt::hg_pass3(hb, hqt, hkt, hqp, hvt, hst, nw, ycat, u, lane);
}
PH void ph_ln1(int wv, const float* xin_f, const bf16* xin_b, const bf16* mix, const float* lw, const float* lb, bf16* x1b, unsigned char* x1q) {
    int tid = mk_tid(wv), bid = blockIdx.x; asm volatile("" : "+v"(tid), "+s"(bid)); const int lane = tid & 63, wave = wv, G = gridDim.x;
#pragma unroll 1
    for (int t = (bid * 8 + wave) * 2; t < NT; t += G * 16) ln1_tok2(xin_f, xin_b, mix, lw, lb, x1b, x1q, t, lane);
}
PH void ph_route(int wv, const bf16* x1, const bf16* rwh, const bf16* rwl, const float* rb, int* cnt, int* list, int* tok_e, int* tok_slot, float* tok_w) {
    int tid = mk_tid(wv), bid = blockIdx.x; asm volatile("" : "+v"(tid), "+s"(bid)); const int lane = tid & 63, wave = wv, G = gridDim.x;
#pragma unroll 1
    for (int u = bid * 8 + wave; u < NT / 32; u += G * 8) wt::route_task(x1, rwh, rwl, rb, cnt, list, tok_e, tok_slot, tok_w, u, lane);
}
PH void ph_comb(int wv, const bf16* x1, const bf16* ybuf, const int* tok_e, const int* tok_slot, const float* tok_w, const float* lw, const float* lb, float* xo, bf16* xbo) {
    extern __shared__ __attribute__((aligned(16))) unsigned char lds[];
    const int* offs_s = (const int*)(lds + TAB_OFF + 512);
    int tid = mk_tid(wv), bid = blockIdx.x; asm volatile("" : "+v"(tid), "+s"(bid)); const int lane = tid & 63, wave = wv, G = gridDim.x;
#pragma unroll 1
    for (int t = (bid * 8 + wave) * 2; t < NT; t += G * 16) comb_ln2_tok2(x1, ybuf, offs_s, tok_e, tok_slot, tok_w, lw, lb, xo, xbo, t, lane);
}

typedef const Args __attribute__((address_space(4))) CArgs;
#define PHASE_BEGIN CArgs* ap = (CArgs*)__builtin_amdgcn_kernarg_segment_ptr(); int l_ = l; asm volatile("" : "+s"(ap), "+s"(l_)); unsigned char* const ws_ = ap->ws; \
    const int G = gridDim.x; int bid = blockIdx.x; asm volatile("" : "+s"(bid));
#define WP(T, off) ((T*)(ws_ + (off)))
#define INP(k) (ap->in[k])
__global__ void __launch_bounds__(NTHR, 2) mega(Args a) {
    extern __shared__ __attribute__((aligned(16))) unsigned char lds[];
    volatile LAS unsigned* MISC = (volatile LAS unsigned*)((LAS unsigned char*)lds + MISC_OFF);
    int wv = __builtin_amdgcn_readfirstlane((int)threadIdx.x >> 6); asm volatile("" : "+s"(wv));
    { const int t0 = mk_tid(wv); if (t0 < 64) MISC[t0] = 0u; }
    __syncthreads();
    XcdBarrier bar = xcd_barrier_post((unsigned*)a.ws, MISC + 8, wv);
    int* tstart = (int*)(lds + TAB_OFF); int* cnts = (int*)(lds + TAB_OFF + 256); int* offs_s = (int*)(lds + TAB_OFF + 512);
    PG8_LAS unsigned char* ldsl = (PG8_LAS unsigned char*)lds;

#ifndef PH_MASK
#define EN(n) 1
#else
#define EN(n) ((PH_MASK >> ((n) % 20)) & 1)
#endif
#define IN(k) 1
#ifndef REP_PH
#define REPL(id)
#else
#define REPL(id) _Pragma("unroll 1") for (int rep_ = 0; rep_ < (((id) == REP_PH) ? REP_N : 1); ++rep_)
#endif
#define SEAM(k) xcd_barrier(bar)

    REPL(19) if (EN(19) && IN(0)) { const int l = 0; PHASE_BEGIN; (void)l_; (void)G; (void)bid;
        ph_prologue(wv, (const int*)INP(1), INP(3), WP(float, O_COS), WP(float, O_SIN), WP(float, O_LB), INP(0), WP(bf16, O_XB), INP(2), INP(14), INP(19), INP(21),
                    WP(bf16, O_WIN), WP(bf16, O_WOUT), WP(bf16, O_WUP), WP(bf16, O_WDN), INP(7), WP(bf16, O_WB), INP(10), INP(11), WP(bf16, O_W1T), WP(float, O_CBIAS), INP(12), WP(bf16, O_W2T), INP(17), WP(bf16, O_RWH), WP(bf16, O_RWL)); }
    xcd_barrier_first(bar);

#pragma unroll 1
    for (int l = 0; l < DEPTH; ++l) {
        REPL(0) if (EN(0) && IN(pb + 0)) {
            PHASE_BEGIN;
            pg8::PlainOrder S{WP(bf16, O_WIN) + (size_t)l_ * HS * D_, D_, NT / 256, HS / 256, G, bid};
            pg8::EpiBf16 E{WP(bf16, O_HB), HS, nullptr, 0};
            pg8::gemm_phase<pg8::EpiBf16, pg8::PlainOrder, true>(wv, ldsl, WP(bf16, O_XB), D_ * 2, S, E);
#ifdef DUP_WIN
            pg8::gemm_phase<pg8::EpiBf16, pg8::PlainOrder, true>(wv, ldsl, WP(bf16, O_XB), D_ * 2, S, E);
#endif
        }
        SEAM(pb + 0);
        REPL(1) if (EN(1)) {
            PHASE_BEGIN; (void)G; (void)bid;
            ph_mix1(wv, WP(bf16, O_HB), WP(float, O_LB) + l_ * 256, WP(bf16, O_HQT), WP(bf16, O_HKT), WP(bf16, O_HQP), WP(bf16, O_HVT), WP(float, O_HUT), WP(float, O_HDK),
                    INP(5) + l_ * 256, INP(6) + l_ * 256, WP(bf16, O_VLNT), WP(bf16, O_W1T) + (size_t)l_ * 2 * 128 * 2048, WP(float, O_CBIAS) + l_ * 256, WP(bf16, O_W2T) + (size_t)l_ * 2 * 64 * 128,
                    WP(bf16, O_KCB), WP(bf16, O_VCB), WP(float, O_COS), WP(float, O_SIN), WP(bf16, O_KSB), WP(bf16, O_VSB), WP(bf16, O_KWB), WP(bf16, O_VWB),
                    INP(19) + (size_t)l_ * NE * D_ * 2048, INP(21) + (size_t)l_ * NE * D_ * D_, WP(unsigned char, O_WUP) + (size_t)l_ * NE * 2048 * D_, WP(unsigned char, O_WDN) + (size_t)l_ * NE * D_ * D_);
        }
        SEAM(pb + 1);
        REPL(11) if (EN(11)) {
            PHASE_BEGIN; (void)G; (void)bid;
            ph_mix2(wv, WP(float, O_HUT), WP(float, O_HDK), WP(bf16, O_HST), WP(bf16, O_HB), WP(bf16, O_VLNT), WP(bf16, O_WB) + (size_t)l_ * 4 * 128 * 128, INP(8) + l_ * 512, INP(9) + l_ * 256, WP(bf16, O_YCAT));
        }
        SEAM(pb + 1);
        {
            PHASE_BEGIN;
            REPL(2) if (EN(2)) ph_hg3(wv, WP(bf16, O_HB), WP(bf16, O_HQT), WP(bf16, O_HKT), WP(bf16, O_HQP), WP(bf16, O_HVT), WP(bf16, O_HST), INP(4) + l_ * 256, WP(bf16, O_YCAT));
            REPL(12) if (EN(12)) {
                nsa::Params NP{WP(bf16, O_HB), WP(bf16, O_KCB), WP(bf16, O_VCB), WP(bf16, O_KSB), WP(bf16, O_VSB), WP(bf16, O_KWB), WP(bf16, O_VWB), WP(float, O_COS), WP(float, O_SIN), INP(13) + l_ * 512, WP(bf16, O_YCAT)};
                int tid = mk_tid(wv); asm volatile("" : "+v"(tid));
                __syncthreads();
                nsa::phase(NP, ldsl, tid, bid, G);
            }
        }
        SEAM(pb + 2);
        REPL(3) if (EN(3) && IN(pb + 3)) {
            PHASE_BEGIN;
            pg8::PlainOrder S{WP(bf16, O_WOUT) + (size_t)l_ * D_ * D_, D_, NT / 256, D_ / 256, G, bid};
            pg8::EpiBf16 E{WP(bf16, O_MIXB), D_, nullptr, 0};
            pg8::gemm_phase<pg8::EpiBf16, pg8::PlainOrder, true>(wv, ldsl, WP(bf16, O_YCAT), D_ * 2, S, E);
#ifdef DUP_WOUT
            pg8::gemm_phase<pg8::EpiBf16, pg8::PlainOrder, true>(wv, ldsl, WP(bf16, O_YCAT), D_ * 2, S, E);
#endif
        }
        SEAM(pb + 3);
        REPL(4) if (EN(4)) {
            PHASE_BEGIN; (void)G; (void)bid;
            ph_ln1(wv, l_ == 0 ? INP(0) : (const float*)nullptr, WP(bf16, O_XB), WP(bf16, O_MIXB), INP(15) + l_ * D_, INP(16) + l_ * D_, WP(bf16, O_X1B), WP(unsigned char, O_X1Q));
        }
        SEAM(pb + 4);
        if (EN(14)) {
            PHASE_BEGIN; (void)G; (void)bid;
#ifdef DUP_ROUTE
#pragma unroll 1
            for (int rr_ = 0; rr_ < 2; ++rr_)
            ph_route(wv, WP(bf16, O_X1B), WP(bf16, O_RWH) + (size_t)l_ * NE * D_, WP(bf16, O_RWL) + (size_t)l_ * NE * D_, INP(18) + l_ * NE,
                     (int*)(ws_ + 36864) + (l_ * 2 + rr_) * 64, WP(int, O_HUT), WP(int, O_HUT) + 2 * 1048576, WP(int, O_HUT) + 3 * 1048576, WP(float, O_HUT) + 4 * 1048576);
#endif
            ph_route(wv, WP(bf16, O_X1B), WP(bf16, O_RWH) + (size_t)l_ * NE * D_, WP(bf16, O_RWL) + (size_t)l_ * NE * D_, INP(18) + l_ * NE,
                     (int*)(ws_ + 32768) + l_ * 64, WP(int, O_LIST), WP(int, O_TE), WP(int, O_TS), WP(float, O_TW));
        }
        SEAM(pb + 4);
        if (IN(pb + 5) || IN(pb + 6) || IN(pb + 7)) {
            PHASE_BEGIN; (void)G; (void)bid;
            int* cnt = (int*)(ws_ + 32768) + l_ * 64;
            __syncthreads();
            if (mk_tid(wv) == 0) { int acc = 0;
#pragma unroll 1
                for (int e = 0; e < NE; ++e) { const int c = __hip_atomic_load(&cnt[e], __ATOMIC_RELAXED, __HIP_MEMORY_SCOPE_AGENT); tstart[e] = acc; offs_s[e] = acc * 256; cnts[e] = c; acc += (c + 255) >> 8; } tstart[32] = acc; }
            __syncthreads();
        }
        REPL(5) if (EN(5) && IN(pb + 5)) {
            PHASE_BEGIN;
            pg8::MoeOrder<true> S{WP(unsigned char, O_WUP) + (size_t)l_ * NE * 2048 * D_, D_, 8, G, bid, (size_t)2048 * D_, tstart, cnts, WP(int, O_LIST)};
            pg8::EpiUpF8 E{WP(unsigned char, O_ACT), INP(20) + (size_t)l_ * NE * 2048};
            pg8::gemm_phase<pg8::EpiUpF8, pg8::MoeOrder<true>, true, true>(wv, ldsl, WP(unsigned char, O_X1Q), D_, S, E);
        }
        SEAM(pb + 5);
        REPL(6) if (EN(6) && IN(pb + 6)) {
            PHASE_BEGIN;
            pg8::MoeOrder<false> S{WP(unsigned char, O_WDN) + (size_t)l_ * NE * D_ * D_, D_, 4, G, bid, (size_t)D_ * D_, tstart, cnts, WP(int, O_LIST)};
            pg8::EpiDnF8 E{WP(bf16, O_YB), INP(22) + (size_t)l_ * NE * D_};
            pg8::gemm_phase<pg8::EpiDnF8, pg8::MoeOrder<false>, true, true>(wv, ldsl, WP(unsigned char, O_ACT), D_, S, E);
        }
        SEAM(pb + 6);
        REPL(7) if (EN(7) && IN(pb + 7)) {
            PHASE_BEGIN; (void)G; (void)bid;
            ph_comb(wv, WP(bf16, O_X1B), WP(bf16, O_YB), WP(int, O_TE), WP(int, O_TS), WP(float, O_TW), INP(23) + l_ * D_, INP(24) + l_ * D_,
                    (l_ == DEPTH - 1) ? ap->out : (float*)nullptr, (l_ == DEPTH - 1) ? (bf16*)nullptr : WP(bf16, O_XB));
        }
#ifdef XTRA_BAR
#pragma unroll 1
        for (int xb_ = 0; xb_ < XTRA_BAR; ++xb_) SEAM(pb + 7);
#endif
        if (l + 1 < DEPTH) SEAM(pb + 7);
    }
#undef IN
#undef SEAM
}
}

extern "C" void kernel_launch(void* const* d_in, const int* in_sizes, int n_in, void* d_out, int out_size, void* d_ws, size_t ws_size, hipStream_t stream) {
    using namespace mk;
    static int grid = 0;
    if (grid == 0) {
        size_t need = WS_NEED;
        if (n_in != 25 || need > ws_size) { fprintf(stderr, "kernel_launch: bad args n_in %d need %zu ws %zu\n", n_in, need, ws_size); grid = -1; return; }
        int dev = 0, cus = 0, per_cu = 0;
        if (hipGetDevice(&dev) != hipSuccess || hipDeviceGetAttribute(&cus, hipDeviceAttributeMultiprocessorCount, dev) != hipSuccess) { grid = -1; return; }
        if (hipFuncSetAttribute((const void*)mega, hipFuncAttributeMaxDynamicSharedMemorySize, LDS_BYTES) != hipSuccess) { fprintf(stderr, "hipFuncSetAttribute failed\n"); grid = -1; return; }
        if (hipOccupancyMaxActiveBlocksPerMultiprocessor(&per_cu, (const void*)mega, NTHR, LDS_BYTES) != hipSuccess || per_cu < 1) fprintf(stderr, "occupancy query: %d\n", per_cu);
        (void)hipGetLastError();
        grid = cus;
    }
    if (grid < 0) return;
    if (hipMemsetAsync(d_ws, 0, CTL_BYTES, stream) != hipSuccess) return;
    Args a{};
    for (int i = 0; i < 25; ++i) a.in[i] = (const float*)d_in[i];
    a.out = (float*)d_out; a.ws = (unsigned char*)d_ws; a.ph_lo = 0; a.ph_hi = 1 + DEPTH * NPH;
    hipLaunchKernelGGL(mega, dim3(grid), dim3(NTHR), LDS_BYTES, stream, a);
}
```

```cpp
#include <hip/hip_runtime.h>
#include <cstdio>
#include <cstdint>
#include <cmath>

__device__ __forceinline__ int mk_tid(int wv) { int lane; asm volatile("v_mbcnt_lo_u32_b32 %0, -1, 0\n\tv_mbcnt_hi_u32_b32 %0, -1, %0" : "=v"(lane)); return (wv << 6) | lane; }
#define XB_TMO      128
#define XB_XCNT(j)  (256  + 64 * (j))
#define XB_XSUB(j)  (1280 + 64 * (j))
#define XB_XGEN(j)  (2304 + 64 * (j))
#define XB_TOP      3328
#define XB_TOPGEN   3392
#define XCD_BAR_WORDS 3456
#define XB_SPIN_CAP (1u << 18)
#define LAS __attribute__((address_space(3)))

__device__ __forceinline__ unsigned xb_ld(unsigned* p)              { return __hip_atomic_load(p, __ATOMIC_RELAXED, __HIP_MEMORY_SCOPE_AGENT); }
__device__ __forceinline__ unsigned xb_add(unsigned* p, unsigned v) { return __hip_atomic_fetch_add(p, v, __ATOMIC_RELAXED, __HIP_MEMORY_SCOPE_AGENT); }
__device__ __forceinline__ unsigned xb_xcc_id() { return (unsigned)__builtin_amdgcn_s_getreg((3 << 11) | 20) & 0xFu; }
#define XB_SPIN(cond, bar) do { unsigned _sp = 0; while (cond) { __builtin_amdgcn_s_sleep(1); \
    if ((++_sp & 255u) == 0u) { if (xb_ld(&(bar)[XB_TMO])) break; if (_sp > XB_SPIN_CAP) { atomicAdd(&(bar)[XB_TMO], 1u); break; } } } } while (0)

struct XcdBarrier {
    unsigned* bar; unsigned x;
    volatile LAS unsigned* st; int wv;
};

__device__ __forceinline__ XcdBarrier xcd_barrier_post(unsigned* bar, volatile LAS unsigned* st, int wv) {
    XcdBarrier b; b.bar = bar; b.x = xb_xcc_id(); b.st = st; b.wv = wv;
    if (mk_tid(b.wv) == 0) (void)xb_add(&bar[XB_XCNT(b.x)], 1u);
    return b;
}
__device__ __forceinline__ void xcd_barrier_complete(unsigned* bar, unsigned x, unsigned& nloc, unsigned& nx) {
    const unsigned G = gridDim.x * gridDim.y * gridDim.z;
    unsigned sum, cnt, mine, sp = 0u;
    for (;;) {
        sum = 0u; cnt = 0u; mine = 0u;
#pragma unroll
        for (unsigned j = 0; j < 16; ++j) { const unsigned c = xb_ld(&bar[XB_XCNT(j)]); sum += c; cnt += (c > 0u) ? 1u : 0u; mine = (j == x) ? c : mine; }
        if (sum == G) break;
        __builtin_amdgcn_s_sleep(1);
        if ((++sp & 255u) == 0u) { if (xb_ld(&bar[XB_TMO])) break; if (sp > XB_SPIN_CAP) { atomicAdd(&bar[XB_TMO], 1u); break; } }
    }
    nloc = mine > 0u ? mine : 1u; nx = cnt > 0u ? cnt : 1u;
}

template <bool FIRST>
__device__ __forceinline__ void xcd_barrier_t(const XcdBarrier& b) {
    asm volatile("s_waitcnt vmcnt(0)" ::: "memory");
    __syncthreads();
    if (mk_tid(b.wv) == 0) {
        unsigned* bar = b.bar; unsigned bx = b.x; asm volatile("" : "+s"(bar), "+s"(bx));
        __builtin_amdgcn_s_waitcnt(0);
        unsigned nloc = b.st[0], nx = b.st[1];
        if (FIRST) { if (nloc == 0u) { xcd_barrier_complete(bar, bx, nloc, nx); b.st[0] = nloc; b.st[1] = nx; } }
        const unsigned old = xb_add(&bar[XB_XSUB(bx)], 1u);
        const unsigned gen = old / nloc;
        if (old + 1u == (gen + 1u) * nloc) {
            __builtin_amdgcn_fence(__ATOMIC_RELEASE, "agent");
            asm volatile("s_waitcnt vmcnt(0)" ::: "memory");
            const unsigned og = xb_add(&bar[XB_TOP], 1u);
            const unsigned tg = og / nx;
            if (og + 1u == (tg + 1u) * nx) xb_add(&bar[XB_TOPGEN], 1u);
            else XB_SPIN(xb_ld(&bar[XB_TOPGEN]) == tg, bar);
            __builtin_amdgcn_fence(__ATOMIC_ACQUIRE, "agent");
            xb_add(&bar[XB_XGEN(bx)], 1u);
            asm volatile("s_waitcnt vmcnt(0)" ::: "memory");
        } else {
            XB_SPIN(xb_ld(&bar[XB_XGEN(bx)]) == gen, bar);
            __builtin_amdgcn_fence(__ATOMIC_ACQUIRE, "agent");
            asm volatile("s_waitcnt vmcnt(0)" ::: "memory");
        }
    }
    __syncthreads();
}


__device__ __forceinline__ void xcd_barrier_first(const XcdBarrier& b) { xcd_barrier_t<true>(b); }
__device__ __forceinline__ void xcd_barrier(const XcdBarrier& b) { xcd_barrier_t<false>(b); }


namespace mk {
constexpr int B_ = 8, S_ = 4096, D_ = 1024, NT = B_ * S_, DEPTH = 2;
constexpr int INW = 2840, HS = 3072;
constexpr int C_HGQ = 0, C_HGF = 256, C_HGI = 512, C_HGG = 768, C_GMU = 1024, C_GMV = 1280, C_NQ = 1536,
              C_KC = 2048, C_VC = 2176, C_KS = 2304, C_VS = 2432, C_KW = 2560, C_VW = 2688, C_NG = 2816;
constexpr int NCMP = 255, NE = 32, TOPK = 4, NASSIGN = NT * TOPK;
constexpr float ALPHA = 1.4142135623730951f;
constexpr int NTHR = 512, LDS_BYTES = 147456, MISC_OFF = 144 * 1024 - 256;
constexpr int NPH = 8;

typedef unsigned short bf16;
__device__ __forceinline__ float bf2f(bf16 v) { return __uint_as_float((unsigned)v << 16); }
__device__ __forceinline__ unsigned f2bf(float f) { unsigned u = __float_as_uint(f); return (u + 0x7fffu + ((u >> 16) & 1u)) >> 16; }
__device__ __forceinline__ unsigned pk2(float lo, float hi) { return f2bf(lo) | (f2bf(hi) << 16); }
__device__ __forceinline__ float gelu_t(float x) { return 0.5f * x * (1.0f + tanhf(0.7978845608028654f * (x + 0.044715f * x * x * x))); }
__device__ __forceinline__ float sigm(float x) { return 1.0f / (1.0f + expf(-x)); }
__device__ __forceinline__ float wsum(float v) {
#pragma unroll
    for (int o = 1; o < 64; o <<= 1) v += __shfl_xor(v, o);
    return v;
}
__device__ __forceinline__ float wmax(float v) {
#pragma unroll
    for (int o = 1; o < 64; o <<= 1) v = fmaxf(v, __shfl_xor(v, o));
    return v;
}

constexpr int MROWS = NASSIGN + NE * 256;
constexpr size_t CTL_BYTES = 65536;
constexpr size_t al256(size_t x) { return (x + 255) & ~(size_t)255; }
constexpr size_t O_COS = CTL_BYTES, O_SIN = O_COS + al256((size_t)NT * 32 * 4), O_LB = O_SIN + al256((size_t)NT * 32 * 4);
constexpr size_t O_WIN = O_LB + al256(512 * 4), O_WOUT = O_WIN + al256((size_t)DEPTH * HS * D_ * 2), O_WUP = O_WOUT + al256((size_t)DEPTH * D_ * D_ * 2);
constexpr size_t O_WDN = O_WUP + al256((size_t)DEPTH * NE * 2048 * D_ * 2), O_XB = O_WDN + al256((size_t)DEPTH * NE * D_ * D_ * 2);
constexpr size_t O_HB = O_XB + al256((size_t)NT * D_ * 2), O_YCAT = O_HB + al256((size_t)NT * HS * 2), O_MIXB = O_YCAT + al256((size_t)NT * D_ * 2);
constexpr size_t O_X1B = O_MIXB + al256((size_t)NT * D_ * 2), O_ACT = O_X1B + al256((size_t)NT * D_ * 2), O_YB = O_ACT + al256((size_t)MROWS * D_ * 2);
constexpr size_t O_X1Q = O_YB + al256((size_t)MROWS * D_ * 2), O_XA = O_X1Q + al256((size_t)NT * D_ * 4);
constexpr size_t O_VLNT = O_XA + al256((size_t)NT * D_ * 4), O_WB = O_VLNT + al256((size_t)NT * 256 * 2), O_W1T = O_WB + al256((size_t)DEPTH * 4 * 128 * 128 * 2);
constexpr size_t O_CBIAS = O_W1T + al256((size_t)DEPTH * 2 * 128 * 2048 * 2), O_W2T = O_CBIAS + al256((size_t)DEPTH * 2 * 128 * 4), O_RWH = O_W2T + al256((size_t)DEPTH * 2 * 64 * 128 * 2), O_RWL = O_RWH + al256((size_t)DEPTH * NE * D_ * 2), O_HQT = O_RWL + al256((size_t)DEPTH * NE * D_ * 2);
constexpr size_t HGB = (size_t)2048 * 4096 * 2;
constexpr size_t O_HKT = O_HQT + HGB, O_HQP = O_HKT + HGB, O_HVT = O_HQP + HGB, O_HST = O_HVT + HGB, O_HUT = O_HST + HGB, O_HDK = O_HUT + 2 * HGB;
constexpr size_t O_KSB = O_HDK + al256((size_t)2048 * 64 * 4), O_VSB = O_KSB + al256((size_t)NT * 128 * 2);
constexpr size_t O_KWB = O_VSB + al256((size_t)NT * 128 * 2), O_VWB = O_KWB + al256((size_t)NT * 128 * 2), O_KCB = O_VWB + al256((size_t)NT * 128 * 2), O_VCB = O_KCB + al256((size_t)B_ * 2 * 256 * 64 * 2);
constexpr size_t O_LIST = O_VCB + al256((size_t)B_ * 2 * 256 * 64 * 2), O_TE = O_LIST + al256((size_t)NE * NT * 4), O_TS = O_TE + al256((size_t)NASSIGN * 4), O_TW = O_TS + al256((size_t)NASSIGN * 4);
constexpr size_t WS_NEED = O_TW + al256((size_t)NASSIGN * 4);
namespace pg8 {
#define PG8_LAS __attribute__((address_space(3)))
typedef unsigned short bf16_t;
typedef short bf16x8 __attribute__((ext_vector_type(8)));
typedef float f32x4 __attribute__((ext_vector_type(4)));
typedef float f32x2 __attribute__((ext_vector_type(2)));
typedef unsigned u32x4 __attribute__((ext_vector_type(4)));
constexpr int BM = 256, BK = 64, HALF = 128, HTB = HALF * BK * 2  , STAGE_BYTES = 8 * HTB, NXCD = 8, WGM = 8;

__host__ __device__ __forceinline__ int lds_byte(int r, int c) { const int st = (r >> 4) * 2 + (c >> 5), rr = r & 15, cc = c & 31, ob = rr * 64 + cc * 2; return st * 1024 + (ob ^ (((ob >> 9) & 1) << 5)); }
__host__ __device__ __forceinline__ void stage_rc(int b, int& R, int& C) { const int st = b / 1024, sb = b % 1024, swz = sb ^ (((sb >> 9) & 1) << 5); R = (st >> 1) * 16 + swz / 64; C = (st & 1) * 32 + (swz % 64) / 2; }
__host__ __device__ __forceinline__ int perm32(int rho) { const int n = rho >> 4, i = rho & 15; return 8 * (i >> 2) + 4 * n + (i & 3); }

struct Unit { int pm, pn, e, mt, cnt; };

__device__ __forceinline__ void deal(int L, int nM, int nN, int& pm, int& pn) {
    const int nwg = nM * nN;
    int wgid = L; { const int q = nwg / NXCD, r = nwg % NXCD, xcd = wgid % NXCD, off = wgid / NXCD; wgid = (xcd < r ? xcd * (q + 1) : r * (q + 1) + (xcd - r) * q) + off; }
    const int nig = WGM * nN, gid = wgid / nig, fm = gid * WGM, gsz = (nM - fm) < WGM ? (nM - fm) : WGM;
    pm = fm + ((wgid % nig) % gsz); pn = (wgid % nig) / gsz;
}
struct PlainOrder {
    static constexpr bool GATHERED = false;
    const bf16_t* Bt; int K; int nM, nN, G, c;
    __device__ __forceinline__ bool next(int i, Unit& u) const { const long L = (long)i * G + c; if (L >= (long)nM * nN) return false; deal((int)L, nM, nN, u.pm, u.pn); u.e = 0; u.mt = 0; u.cnt = 0; return true; }
    __device__ __forceinline__ unsigned a_row(const Unit& u, int r) const { return (unsigned)(u.pm * BM + r); }
    __device__ __forceinline__ const char* b_base(const Unit& u) const { return (const char*)Bt + (size_t)u.pn * BM * K * 2; }
};
template <bool GATHER> struct MoeOrder {
    static constexpr bool GATHERED = GATHER;
    const void* Bt; int rowb; int nN, G, c; size_t estrideb;
    const int* tstart; const int* cnts; const int* list;
    __device__ __forceinline__ bool next(int i, Unit& u) const {
        const int nM = tstart[32]; const long L = (long)i * G + c; if (L >= (long)nM * nN) return false;
        deal((int)L, nM, nN, u.pm, u.pn);
        int e = 0;
#pragma unroll 1
        for (int k = 1; k < 32; ++k) e = (tstart[k] <= u.pm) ? k : e;
        u.e = e; u.mt = u.pm - tstart[e]; u.cnt = cnts[e]; return true;
    }
    __device__ __forceinline__ unsigned a_row(const Unit& u, int r) const {
        if (GATHER) { const int slot = u.mt * BM + r; return (unsigned)list[u.e * 32768 + (slot < u.cnt ? slot : u.cnt - 1)]; }
        return (unsigned)(u.pm * BM + r);
    }
    __device__ __forceinline__ const char* b_base(const Unit& u) const { return (const char*)Bt + (size_t)u.e * estrideb + (size_t)u.pn * BM * rowb; }
};

__device__ __forceinline__ unsigned cvt_pk_bf16(float lo, float hi) { unsigned r; asm volatile("v_cvt_pk_bf16_f32 %0, %1, %2" : "=v"(r) : "v"(lo), "v"(hi)); return r; }

struct EpiBf16 {
    static constexpr bool PERM = true;
    bf16_t* O; int ldc; const float* bias; int bstride;
    __device__ __forceinline__ void operator()(const f32x4 (&acc)[2][2][4][2], const Unit& u, int wr, int wc, int fr, int fq) const {
        const int row0 = u.pm * BM + wr * 64 + fr; const int col0 = u.pn * BM + wc * 32 + 8 * fq;
        f32x4 bv[2][2];
#pragma unroll
        for (int bj = 0; bj < 2; ++bj)
#pragma unroll
            for (int n = 0; n < 2; ++n) bv[bj][n] = bias ? *(const f32x4*)(bias + (size_t)u.e * bstride + col0 + bj * HALF + 4 * n) : (f32x4){0.f, 0.f, 0.f, 0.f};
#pragma unroll
        for (int ai = 0; ai < 2; ++ai)
#pragma unroll
            for (int m = 0; m < 4; ++m) { bf16_t* rowp = O + (size_t)(row0 + ai * HALF + m * 16) * ldc + col0;
#pragma unroll
                for (int bj = 0; bj < 2; ++bj) { f32x4 v0 = acc[ai][bj][m][0] + bv[bj][0], v1 = acc[ai][bj][m][1] + bv[bj][1];
                    u32x4 w; w.x = cvt_pk_bf16(v0[0], v0[1]); w.y = cvt_pk_bf16(v0[2], v0[3]); w.z = cvt_pk_bf16(v1[0], v1[1]); w.w = cvt_pk_bf16(v1[2], v1[3]);
                    *(u32x4*)(rowp + bj * HALF) = w; } }
    }
};
__device__ __forceinline__ float swiglu1(float g, float l) {
    g = fminf(g, 7.0f); l = fminf(fmaxf(l, -7.0f), 7.0f);
    const float s = __builtin_amdgcn_rcpf(1.0f + __builtin_amdgcn_exp2f(-1.702f * 1.4426950408889634f * g));
    return g * s * (l + 1.0f);
}
struct EpiUp {
    static constexpr bool PERM = true;
    bf16_t* O; const float* bias;
    __device__ __forceinline__ void operator()(const f32x4 (&acc)[2][2][4][2], const Unit& u, int wr, int wc, int fr, int fq) const {
        const int row0 = u.pm * BM + wr * 64 + fr; const int j0 = u.pn * HALF + wc * 32 + 8 * fq;
        const float* bp = bias + (size_t)u.e * 2048 + j0;
        f32x4 bg[2], bl[2];
#pragma unroll
        for (int n = 0; n < 2; ++n) { bg[n] = *(const f32x4*)(bp + 4 * n); bl[n] = *(const f32x4*)(bp + 1024 + 4 * n); }
#pragma unroll
        for (int ai = 0; ai < 2; ++ai)
#pragma unroll
            for (int m = 0; m < 4; ++m) {
                float o[8];
#pragma unroll
                for (int n = 0; n < 2; ++n) { const f32x4 g = acc[ai][0][m][n] + bg[n], l = acc[ai][1][m][n] + bl[n];
#pragma unroll
                    for (int j = 0; j < 4; ++j) o[4 * n + j] = swiglu1(g[j], l[j]); }
                u32x4 w; w.x = cvt_pk_bf16(o[0], o[1]); w.y = cvt_pk_bf16(o[2], o[3]); w.z = cvt_pk_bf16(o[4], o[5]); w.w = cvt_pk_bf16(o[6], o[7]);
                *(u32x4*)(O + (size_t)(row0 + ai * HALF + m * 16) * 1024 + j0) = w; }
    }
};

constexpr float F8_SU = 64.0f, F8_SA = 4.0f, F8_SD = 128.0f;
__device__ __forceinline__ unsigned pk4_fp8(float a, float b, float c, float d) {
    a = fminf(fmaxf(a, -448.f), 448.f); b = fminf(fmaxf(b, -448.f), 448.f); c = fminf(fmaxf(c, -448.f), 448.f); d = fminf(fmaxf(d, -448.f), 448.f);
    int p = __builtin_amdgcn_cvt_pk_fp8_f32(a, b, 0, false); p = __builtin_amdgcn_cvt_pk_fp8_f32(c, d, p, true); return (unsigned)p;
}
struct EpiUpF8 {
    static constexpr bool PERM = true;
    unsigned char* O; const float* bias;
    __device__ __forceinline__ void operator()(const f32x4 (&acc)[2][2][4][2], const Unit& u, int wr, int wc, int fr, int fq) const {
        const int row0 = u.pm * BM + wr * 64 + fr; const int j0 = u.pn * HALF + wc * 32 + 8 * fq;
        const float* bp = bias + (size_t)u.e * 2048 + j0;
        f32x4 bg[2], bl[2];
#pragma unroll
        for (int n = 0; n < 2; ++n) { bg[n] = *(const f32x4*)(bp + 4 * n); bl[n] = *(const f32x4*)(bp + 1024 + 4 * n); }
#pragma unroll
        for (int ai = 0; ai < 2; ++ai)
#pragma unroll
            for (int m = 0; m < 4; ++m) {
                unsigned w[2];
#pragma unroll
                for (int n = 0; n < 2; ++n) { const f32x4 g = acc[ai][0][m][n] * (1.0f / F8_SU) + bg[n], l = acc[ai][1][m][n] * (1.0f / F8_SU) + bl[n];
                    w[n] = pk4_fp8(F8_SA * swiglu1(g[0], l[0]), F8_SA * swiglu1(g[1], l[1]), F8_SA * swiglu1(g[2], l[2]), F8_SA * swiglu1(g[3], l[3])); }
                typedef unsigned u32x2 __attribute__((ext_vector_type(2)));
                u32x2 ww = {w[0], w[1]};
                *(u32x2*)(O + (size_t)(row0 + ai * HALF + m * 16) * 1024 + j0) = ww; }
    }
};
struct EpiDnF8 {
    static constexpr bool PERM = true;
    bf16_t* O; const float* bias;
    __device__ __forceinline__ void operator()(const f32x4 (&acc)[2][2][4][2], const Unit& u, int wr, int wc, int fr, int fq) const {
        const int row0 = u.pm * BM + wr * 64 + fr; const int col0 = u.pn * BM + wc * 32 + 8 * fq;
        f32x4 bv[2][2];
#pragma unroll
        for (int bj = 0; bj < 2; ++bj)
#pragma unroll
            for (int n = 0; n < 2; ++n) bv[bj][n] = *(const f32x4*)(bias + (size_t)u.e * 1024 + col0 + bj * HALF + 4 * n);
#pragma unroll
        for (int ai = 0; ai < 2; ++ai)
#pragma unroll
            for (int m = 0; m < 4; ++m) { bf16_t* rowp = O + (size_t)(row0 + ai * HALF + m * 16) * 1024 + col0;
#pragma unroll
                for (int bj = 0; bj < 2; ++bj) { f32x4 v0 = acc[ai][bj][m][0] * (1.0f / (F8_SA * F8_SD)) + bv[bj][0], v1 = acc[ai][bj][m][1] * (1.0f / (F8_SA * F8_SD)) + bv[bj][1];
                    u32x4 w; w.x = cvt_pk_bf16(v0[0], v0[1]); w.y = cvt_pk_bf16(v0[2], v0[3]); w.z = cvt_pk_bf16(v1[0], v1[1]); w.w = cvt_pk_bf16(v1[2], v1[3]);
                    *(u32x4*)(rowp + bj * HALF) = w; } }
    }
};

typedef int v8i32 __attribute__((ext_vector_type(8)));
__device__ __forceinline__ v8i32 pg8_join(const bf16x8 lo, const bf16x8 hi) { typedef int v4i32 __attribute__((ext_vector_type(4)));
    const v4i32 a = __builtin_bit_cast(v4i32, lo), b = __builtin_bit_cast(v4i32, hi); return __builtin_shufflevector(a, b, 0, 1, 2, 3, 4, 5, 6, 7); }
template <class Epi, class Sched, bool ALIGN_EPI, bool F8 = false>
__device__ __forceinline__ void gemm_phase(const int wv, PG8_LAS unsigned char* lds, const void* Abase, const int Kb  , const Sched& S, const Epi& E) {
    int tid = mk_tid(wv); asm volatile("" : "+v"(tid));
    const int wid = __builtin_amdgcn_readfirstlane(tid >> 6), lane = tid & 63, wr = wid >> 2, wc = wid & 3, fr = lane & 15, fq = lane >> 4;
#ifdef DUP_K
    const int nt0 = Kb / 128, nt = 2 * nt0;
#define PG8_KT(t) ((t) % nt0)
#else
    const int nt = Kb / 128;
#define PG8_KT(t) (t)
#endif
    const char* Ab = (const char*)Abase;
    unsigned voffB[2];
#pragma unroll
    for (int i = 0; i < 2; ++i) { int R, C; stage_rc(tid * 16 + i * 8192, R, C); const int Rb = Epi::PERM ? ((R & ~31) + perm32(R & 31)) : R;
        voffB[i] = (unsigned)(Rb * Kb + C * 2); }
    const size_t kstep = (size_t)(BK * 2);
    const size_t hstep = (size_t)HALF * Kb;
    const unsigned rowb = (unsigned)Kb;
    const unsigned ldsw = (unsigned)wid * 1024u;
    const int aoff = lds_byte(wr * 64 + fr, fq * 8), boff = lds_byte(wc * 32 + fr, fq * 8);
#define PG8_SA(b, h) (((b) * 2 + (h)) * HTB)
#define PG8_SB(b, h) ((4 + (b) * 2 + (h)) * HTB)
#define PG8_STAGE(bufoff, gbase, voff) do { _Pragma("unroll") for (int _i = 0; _i < 2; ++_i) { unsigned _v = (voff)[_i]; asm volatile("" : "+v"(_v)); \
        __builtin_amdgcn_global_load_lds((const unsigned*)((const char*)(gbase) + _v), (PG8_LAS unsigned*)(lds + (bufoff) + ldsw + _i * 8192), 16, 0, 0); } } while (0)
#define PG8_STAGE_A(bufoff, kb, o0, o1) do { unsigned _o0 = (o0), _o1 = (o1); asm volatile("" : "+v"(_o0), "+v"(_o1)); \
        __builtin_amdgcn_global_load_lds((const unsigned*)(Ab + (kb) + _o0), (PG8_LAS unsigned*)(lds + (bufoff) + ldsw), 16, 0, 0); \
        __builtin_amdgcn_global_load_lds((const unsigned*)(Ab + (kb) + _o1), (PG8_LAS unsigned*)(lds + (bufoff) + ldsw + 8192), 16, 0, 0); } while (0)
#define PG8_LDA(dst, b, h) do { if constexpr (F8) { _Pragma("unroll") for (int m = 0; m < 4; ++m) dst##8[m] = pg8_join(*(const PG8_LAS bf16x8*)(lds + PG8_SA(b, h) + aoff + m * 2048), *(const PG8_LAS bf16x8*)(lds + PG8_SA(b, h) + aoff + m * 2048 + 1024)); } \
        else { _Pragma("unroll") for (int m = 0; m < 4; ++m) _Pragma("unroll") for (int k = 0; k < 2; ++k) dst[m][k] = *(const PG8_LAS bf16x8*)(lds + PG8_SA(b, h) + aoff + m * 2048 + k * 1024); } } while (0)
#define PG8_LDB(dst, b, h) do { if constexpr (F8) { _Pragma("unroll") for (int n = 0; n < 2; ++n) dst##8[n] = pg8_join(*(const PG8_LAS bf16x8*)(lds + PG8_SB(b, h) + boff + n * 2048), *(const PG8_LAS bf16x8*)(lds + PG8_SB(b, h) + boff + n * 2048 + 1024)); } \
        else { _Pragma("unroll") for (int n = 0; n < 2; ++n) _Pragma("unroll") for (int k = 0; k < 2; ++k) dst[n][k] = *(const PG8_LAS bf16x8*)(lds + PG8_SB(b, h) + boff + n * 2048 + k * 1024); } } while (0)
#define PG8_MMA(ai, bj, At, Bt) do { __builtin_amdgcn_s_setprio(1); _Pragma("unroll") for (int m = 0; m < 4; ++m) _Pragma("unroll") for (int n = 0; n < 2; ++n) { \
        if constexpr (F8) { acc[ai][bj][m][n] = __builtin_amdgcn_mfma_scale_f32_16x16x128_f8f6f4(Bt##8[n], At##8[m], acc[ai][bj][m][n], 0, 0, 0, 0, 0, 0); } \
        else { _Pragma("unroll") for (int k = 0; k < 2; ++k) acc[ai][bj][m][n] = __builtin_amdgcn_mfma_f32_16x16x32_bf16(Bt[n][k], At[m][k], acc[ai][bj][m][n], 0, 0, 0); } } \
        __builtin_amdgcn_s_setprio(0); } while (0)
#define PG8_WAIT_V(n) asm volatile("s_waitcnt vmcnt(" #n ")" ::: "memory")
#define PG8_WAIT_L(n) asm volatile("s_waitcnt lgkmcnt(" #n ")" ::: "memory")
#define PG8_BAR __builtin_amdgcn_s_barrier()
#define PG8_SCHED __builtin_amdgcn_sched_barrier(0)
#define PG8_AOFFS(dst, u) do { int _t = mk_tid(wv); asm volatile("" : "+v"(_t)); _Pragma("unroll") for (int _i = 0; _i < 2; ++_i) { int _R, _C; stage_rc(_t * 16 + _i * 8192, _R, _C); \
        _Pragma("unroll") for (int _h = 0; _h < 2; ++_h) dst[_h][_i] = S.a_row(u, _h * HALF + _R) * rowb + (unsigned)_C * 2u; } } while (0)
    Unit cur, nxt; int ui = 0;
    if (!S.next(0, cur)) return;
    f32x4 acc[2][2][4][2];
#pragma unroll
    for (int a = 0; a < 2; ++a)
#pragma unroll
        for (int b = 0; b < 2; ++b)
#pragma unroll
            for (int m = 0; m < 4; ++m)
#pragma unroll
                for (int n = 0; n < 2; ++n) acc[a][b][m][n] = (f32x4){0.f, 0.f, 0.f, 0.f};
    bf16x8 At[4][2], B0[2][2], B1[2][2];
    v8i32 At8[4], B08[2], B18[2];
    unsigned aC[2][2], aN[2][2];
    PG8_AOFFS(aC, cur);
    const char* cB = S.b_base(cur);
    PG8_STAGE(PG8_SB(0, 0), cB, voffB); PG8_STAGE(PG8_SB(0, 1), cB + hstep, voffB); PG8_STAGE_A(PG8_SA(0, 0), 0, aC[0][0], aC[0][1]); PG8_STAGE_A(PG8_SA(0, 1), 0, aC[1][0], aC[1][1]);
    if (wr == 1) PG8_BAR;
    PG8_WAIT_V(2); PG8_BAR;
    PG8_STAGE(PG8_SB(1, 0), cB + kstep, voffB); PG8_STAGE_A(PG8_SA(1, 0), kstep, aC[0][0], aC[0][1]); PG8_STAGE(PG8_SB(1, 1), cB + hstep + kstep, voffB);
    PG8_WAIT_V(6); PG8_BAR;
    for (;;) {
        const bool has_next = S.next(ui + 1, nxt);
        const char* nB = has_next ? S.b_base(nxt) : cB;
        if (has_next) { PG8_AOFFS(aN, nxt); }
        else {
#pragma unroll
            for (int _h = 0; _h < 2; ++_h)
#pragma unroll
                for (int _i = 0; _i < 2; ++_i) aN[_h][_i] = aC[_h][_i]; }
#pragma unroll 1
        for (int t = 0; t < nt; t += 2) {
            const bool last = (t == nt - 2);
            const size_t kb1 = (size_t)PG8_KT(t + 1) * kstep;
            PG8_LDB(B0, 0, 0); PG8_LDB(B1, 0, 1); PG8_SCHED; PG8_LDA(At, 0, 0); PG8_STAGE_A(PG8_SA(1, 1), kb1, aC[1][0], aC[1][1]);
            PG8_WAIT_V(8); PG8_WAIT_L(0); PG8_BAR; PG8_MMA(0, 0, At, B0); PG8_MMA(0, 1, At, B1); PG8_BAR; PG8_SCHED;
            if (last) {
#pragma unroll
                for (int _h = 0; _h < 2; ++_h)
#pragma unroll
                    for (int _i = 0; _i < 2; ++_i) aC[_h][_i] = aN[_h][_i]; }
            const size_t kb2 = last ? (size_t)0 : (size_t)PG8_KT(t + 2) * kstep; const char* b2 = last ? nB : cB + (size_t)PG8_KT(t + 2) * kstep;
            const size_t kb3 = kb2 + kstep; const char* b3 = b2 + kstep;
            PG8_LDA(At, 0, 1); PG8_STAGE(PG8_SB(0, 0), b2, voffB); PG8_STAGE(PG8_SB(0, 1), b2 + hstep, voffB); PG8_STAGE_A(PG8_SA(0, 0), kb2, aC[0][0], aC[0][1]);
            PG8_WAIT_V(8); PG8_WAIT_L(0); PG8_BAR; PG8_MMA(1, 0, At, B0); PG8_MMA(1, 1, At, B1); PG8_BAR; PG8_SCHED;
            PG8_LDB(B0, 1, 0); PG8_LDB(B1, 1, 1); PG8_SCHED; PG8_LDA(At, 1, 0); PG8_STAGE_A(PG8_SA(0, 1), kb2, aC[1][0], aC[1][1]);
            PG8_WAIT_V(8); PG8_WAIT_L(0); PG8_BAR; PG8_MMA(0, 0, At, B0); PG8_MMA(0, 1, At, B1); PG8_BAR; PG8_SCHED;
            PG8_LDA(At, 1, 1); PG8_STAGE(PG8_SB(1, 0), b3, voffB); PG8_STAGE(PG8_SB(1, 1), b3 + hstep, voffB); PG8_STAGE_A(PG8_SA(1, 0), kb3, aC[0][0], aC[0][1]);
            PG8_WAIT_V(8); PG8_WAIT_L(0); PG8_BAR; PG8_MMA(1, 0, At, B0); PG8_MMA(1, 1, At, B1); PG8_BAR; PG8_SCHED;
        }
        if (ALIGN_EPI) { if (wr == 0) PG8_BAR; }
#ifdef DUP_K
#pragma unroll
        for (int a = 0; a < 2; ++a)
#pragma unroll
            for (int b = 0; b < 2; ++b)
#pragma unroll
                for (int m = 0; m < 4; ++m)
#pragma unroll
                    for (int n = 0; n < 2; ++n) acc[a][b][m][n] = acc[a][b][m][n] * 0.5f;
#endif
        E(acc, cur, wr, wc, fr, fq);
#ifdef DUP_EPI
        E(acc, cur, wr, wc, fr, fq);
#endif
        if (!has_next) break;
#pragma unroll
        for (int a = 0; a < 2; ++a)
#pragma unroll
            for (int b = 0; b < 2; ++b)
#pragma unroll
                for (int m = 0; m < 4; ++m)
#pragma unroll
                    for (int n = 0; n < 2; ++n) acc[a][b][m][n] = (f32x4){0.f, 0.f, 0.f, 0.f};
        cur = nxt; cB = nB; ++ui;
        if (ALIGN_EPI) { if (wr == 1) PG8_BAR; }
    }
    PG8_WAIT_V(0);
    if (!ALIGN_EPI) { if (wr == 0) PG8_BAR; }
    PG8_BAR;
#undef PG8_SA
#undef PG8_SB
#undef PG8_STAGE
#undef PG8_STAGE_A
#undef PG8_LDA
#undef PG8_LDB
#undef PG8_MMA
#undef PG8_WAIT_V
#undef PG8_WAIT_L
#undef PG8_BAR
#undef PG8_SCHED
#undef PG8_AOFFS
#undef PG8_KT
}
}


#ifndef NSA_REP_RANK
#define NSA_REP_RANK 1
#endif
#ifndef NSA_REP_PASSA
#define NSA_REP_PASSA 1
#endif
#ifndef NSA_REP_LOOP
#define NSA_REP_LOOP 1
#endif
namespace nsa {
#define NLAS __attribute__((address_space(3)))
typedef short bf16x8 __attribute__((ext_vector_type(8)));
typedef short s16x4 __attribute__((ext_vector_type(4)));
typedef short v4i16_t __attribute__((ext_vector_type(4)));
typedef float f32x16 __attribute__((ext_vector_type(16)));
typedef float f32x2_t __attribute__((ext_vector_type(2)));
typedef __bf16 bf16x2_t __attribute__((ext_vector_type(2)));
#define NSA_MFMA(a, b, c) __builtin_amdgcn_mfma_f32_32x32x16_bf16((a), (b), (c), 0, 0, 0)
constexpr int L_CK = 0, L_CV = 32768, L_RING = 65536, L_IMP = 0, SLOTB = 16384, L_SELM = 131072 + 1024;
constexpr float QSCALE = 0.125f * 1.4426950408889634f;
constexpr float NEGBIG = -1.0e30f;

__device__ __forceinline__ unsigned cvtpk(float lo, float hi) { f32x2_t v = {lo, hi}; bf16x2_t b = __builtin_convertvector(v, bf16x2_t); return __builtin_bit_cast(unsigned, b); }
__device__ __forceinline__ float bflo(unsigned u) { return __uint_as_float(u << 16); }
__device__ __forceinline__ float bfhi(unsigned u) { return __uint_as_float(u & 0xffff0000u); }
__device__ __forceinline__ float xhalf(float v) { return __shfl_xor(v, 32); }
__device__ __forceinline__ float xhalf_max(float v) { const auto r = __builtin_amdgcn_permlane32_swap(__float_as_uint(v), __float_as_uint(v), false, false); return fmaxf(__uint_as_float(r[0]), __uint_as_float(r[1])); }
__device__ __forceinline__ float xhalf_sum(float v) { const auto r = __builtin_amdgcn_permlane32_swap(__float_as_uint(v), __float_as_uint(v), false, false); return __uint_as_float(r[0]) + __uint_as_float(r[1]); }
__device__ __forceinline__ s16x4 vtr(const NLAS unsigned char* p) { return __builtin_bit_cast(s16x4, __builtin_amdgcn_ds_read_tr16_b64_v4i16((NLAS v4i16_t*)p)); }
__device__ __forceinline__ bf16x8 pack8(const f32x16& x, int s) {
    unsigned p0 = cvtpk(x[8 * s], x[8 * s + 1]), p1 = cvtpk(x[8 * s + 2], x[8 * s + 3]), p2 = cvtpk(x[8 * s + 4], x[8 * s + 5]), p3 = cvtpk(x[8 * s + 6], x[8 * s + 7]);
    typedef unsigned u32x4 __attribute__((ext_vector_type(4)));
    u32x4 u = {p0, p1, p2, p3}; return __builtin_bit_cast(bf16x8, u);
}

struct Params {
    const unsigned short* hb;
    const unsigned short *kcb, *vcb;
    const unsigned short *ksb, *vsb, *kwb, *vwb;
    const float *cosT, *sinT;
    const float* normw;
    unsigned short* ycat;
};

__device__ __forceinline__ void qk_tile(const NLAS unsigned char* kt, const bf16x8 (&qf)[4], const int (&kofs)[4], f32x16& st0, f32x16& st1) {
#pragma unroll
    for (int i = 0; i < 16; ++i) { st0[i] = 0.f; st1[i] = 0.f; }
#pragma unroll
    for (int ks = 0; ks < 4; ++ks) {
        const bf16x8 k0 = *(const NLAS bf16x8*)(kt + kofs[ks]);
        const bf16x8 k1 = *(const NLAS bf16x8*)(kt + kofs[ks] + 4096);
        st0 = NSA_MFMA(k0, qf[ks], st0); st1 = NSA_MFMA(k1, qf[ks], st1);
    }
}
__device__ __forceinline__ void pv_tile(const NLAS unsigned char* vt, const int (&vofs)[2][2], const f32x16& p0, const f32x16& p1, f32x16& o0, f32x16& o1) {
#pragma unroll
    for (int kt = 0; kt < 2; ++kt)
#pragma unroll
        for (int s = 0; s < 2; ++s) {
            const bf16x8 pb = pack8(kt ? p1 : p0, s);
            const int kb = (32 * kt + 16 * s) * 128;
#pragma unroll
            for (int mb = 0; mb < 2; ++mb) {
                const s16x4 lo = vtr(vt + kb + vofs[mb][0]), hi = vtr(vt + kb + vofs[mb][1]);
                const bf16x8 va = __builtin_shufflevector(lo, hi, 0, 1, 2, 3, 4, 5, 6, 7);
                if (mb == 0) o0 = NSA_MFMA(va, pb, o0); else o1 = NSA_MFMA(va, pb, o1);
            }
        }
}
__device__ __forceinline__ float max3f(float a, float b, float c) { float r; asm("v_max3_f32 %0, %1, %2, %3" : "=v"(r) : "v"(a), "v"(b), "v"(c)); return r; }
constexpr float NEGINF = -__builtin_inff();
template <bool USE_LO>
__device__ __forceinline__ void mask_tile(f32x16& s0, f32x16& s1, const int hi4, const int lo4) {
#pragma unroll
    for (int i = 0; i < 16; ++i) {
        const int kk0 = (i & 3) + 8 * (i >> 2), kk1 = kk0 + 32;
        bool a0 = kk0 <= hi4, a1 = kk1 <= hi4;
        if (USE_LO) { a0 = a0 && (kk0 >= lo4); a1 = a1 && (kk1 >= lo4); }
        s0[i] = a0 ? s0[i] : NEGINF; s1[i] = a1 ? s1[i] : NEGINF;
    }
}
__device__ __forceinline__ void softmax_core(f32x16& s0, f32x16& s1, float& m, float& l, f32x16& o0, f32x16& o1, const bool live = true) {
    float mx = max3f(s0[0], s0[1], s0[2]);
#pragma unroll
    for (int i = 3; i < 15; i += 2) mx = max3f(mx, s0[i], s0[i + 1]);
    mx = max3f(mx, s0[15], s1[0]);
#pragma unroll
    for (int i = 1; i < 15; i += 2) mx = max3f(mx, s1[i], s1[i + 1]);
    mx = fmaxf(mx, s1[15]);
    mx = xhalf_max(mx);
    const float mn = fmaxf(m, mx);
    const float alpha = __builtin_amdgcn_exp2f(m - mn);
    m = mn;
    const float mref = live ? mn : __builtin_inff();
    float sum0 = 0.f, sum1 = 0.f;
#pragma unroll
    for (int i = 0; i < 16; ++i) {
        const float e0 = __builtin_amdgcn_exp2f(s0[i] - mref), e1 = __builtin_amdgcn_exp2f(s1[i] - mref);
        s0[i] = e0; s1[i] = e1; sum0 += e0; sum1 += e1;
    }
    l = l * alpha + (sum0 + sum1);
    if (__ballot(alpha != 1.0f) != 0ull) {
#pragma unroll
        for (int i = 0; i < 16; ++i) { o0[i] *= alpha; o1[i] *= alpha; }
    }
}

__device__ __forceinline__ void unit(const Params& P, NLAS unsigned char* lds, const int tid_in, const int b, const int g, const int qb) {
    int tid = tid_in; asm volatile("" : "+v"(tid));
    const int wv = __builtin_amdgcn_readfirstlane(tid >> 6), lane = tid & 63, r = lane & 31, h = lane >> 5;
    const int head = g * 4 + (wv >> 1), qi = 32 * (wv & 1) + r;
    const int t = qb * 64 + qi, tok = b * 4096 + t;
    const int bg = b * 2 + g;
    int kofs[4];
#pragma unroll
    for (int ks = 0; ks < 4; ++ks) kofs[ks] = r * 128 + ((((2 * ks + h) ^ ((r >> 1) & 7))) << 4);
    int vofs[2][2];
    { const int i16 = lane & 15, blk = (lane >> 4) & 1, q = i16 >> 2, p = i16 & 3;
#pragma unroll
      for (int mb = 0; mb < 2; ++mb)
#pragma unroll
          for (int jj = 0; jj < 2; ++jj) { const int key = 4 * h + 8 * jj + q; const int o = 4 * mb + 2 * blk + (p >> 1);
              vofs[mb][jj] = key * 128 + ((o ^ (((key >> 1) & 1) << 2)) << 4) + (p & 1) * 8; } }
    const int drow = tid >> 3, dpos = tid & 7;
    const unsigned srcK = (unsigned)(drow * 128 + ((dpos ^ ((drow >> 1) & 7)) << 4));
    const unsigned srcV = (unsigned)(drow * 128 + ((dpos ^ (((drow >> 1) & 1) << 2)) << 4));
    const unsigned wdst = (unsigned)wv * 1024u;
    const unsigned lds0 = (unsigned)(size_t)lds;
#define NSA_DMA(slotoff, gsrc, soff) do { unsigned _keep; const void* _g = (const void*)((const char*)(gsrc) + (soff)); const unsigned _d = (unsigned)__builtin_amdgcn_readfirstlane((int)(lds0 + (unsigned)(slotoff) + wdst)); \
        asm volatile("s_mov_b32 %0, m0\n\ts_mov_b32 m0, %2\n\ts_nop 0\n\tglobal_load_lds_dwordx4 %1, off\n\ts_mov_b32 m0, %0" : "=&s"(_keep) : "v"(_g), "s"(_d) : "memory"); } while (0)
    const int nsel = qb + 1, jw0 = qb >= 8 ? qb - 8 : 0, ntiles = nsel + (qb - jw0 + 1);
    const char* ksg = (const char*)P.ksb + (size_t)bg * 4096 * 128; const char* vsg = (const char*)P.vsb + (size_t)bg * 4096 * 128;
    const char* kwg = (const char*)P.kwb + (size_t)bg * 4096 * 128; const char* vwg = (const char*)P.vwb + (size_t)bg * 4096 * 128;
#define NSA_ISSUE(pos) do { const int _p = (pos) < ntiles ? (pos) : ntiles - 1; const bool _w = _p >= nsel; const int _j = _w ? jw0 + _p - nsel : _p; \
        const int _slot = L_RING + ((pos) & 3) * SLOTB; \
        NSA_DMA(_slot, (_w ? kwg : ksg) + (size_t)_j * 8192, srcK); NSA_DMA(_slot + 8192, (_w ? vwg : vsg) + (size_t)_j * 8192, srcV); } while (0)
    { const char* kcg = (const char*)P.kcb + (size_t)bg * 256 * 128; const char* vcg = (const char*)P.vcb + (size_t)bg * 256 * 128;
#pragma unroll
      for (int T = 0; T < 4; ++T) { NSA_DMA(L_CK + T * 8192, kcg + T * 8192, srcK); NSA_DMA(L_CV + T * 8192, vcg + T * 8192, srcV); } }
    NSA_ISSUE(0); NSA_ISSUE(1);
    typedef unsigned u32x4 __attribute__((ext_vector_type(4)));
    bf16x8 qf[4];
    const unsigned short* qrow = P.hb + (size_t)tok * 3072 + 1536 + (head & 7) * 64;
    {
        u32x4 qraw[4];
#pragma unroll
        for (int ks = 0; ks < 4; ++ks) qraw[ks] = *(const u32x4*)(qrow + 16 * ks + 8 * h);
#pragma unroll
        for (int ks = 0; ks < 4; ++ks) { u32x4 o;
#pragma unroll
            for (int c = 0; c < 4; ++c) o[c] = cvtpk(bflo(qraw[ks][c]) * QSCALE, bfhi(qraw[ks][c]) * QSCALE);
            qf[ks] = __builtin_bit_cast(bf16x8, o); }
    }
    float gc, gs, gw;
    { const unsigned short* gp = P.hb + (size_t)tok * 3072 + 2816 + head * 3;
      gc = 1.f / (1.f + __expf(-__uint_as_float((unsigned)gp[0] << 16))); gs = 1.f / (1.f + __expf(-__uint_as_float((unsigned)gp[1] << 16))); gw = 1.f / (1.f + __expf(-__uint_as_float((unsigned)gp[2] << 16))); }
    asm volatile("s_waitcnt vmcnt(0)" ::: "memory"); __builtin_amdgcn_s_barrier();
    const int cmax = (t >= 31) ? (((t - 31) >> 4) < 254 ? ((t - 31) >> 4) : 254) : -1;
    float m = NEGBIG, l = 0.f;
    {
        f32x16 s0, s1, d0, d1;
#pragma unroll
        for (int i = 0; i < 16; ++i) { d0[i] = 0.f; d1[i] = 0.f; }
#pragma unroll 1
        for (int repA = 0; repA < NSA_REP_PASSA; ++repA) { m = NEGBIG; l = 0.f;
#pragma unroll 1
        for (int T = 0; T < 4; ++T) {
            qk_tile(lds + L_CK + T * 8192, qf, kofs, s0, s1);
            if (__ballot(cmax - 64 * T < 63) != 0ull) mask_tile<false>(s0, s1, cmax - 64 * T - 4 * h, 0);
            softmax_core(s0, s1, m, l, d0, d1);
        } }
    }
    const float lc = xhalf_sum(l);
    const float rinv = lc > 0.f ? 1.0f / lc : 0.f;
    f32x16 of0, of1;
#pragma unroll
    for (int i = 0; i < 16; ++i) { of0[i] = 0.f; of1[i] = 0.f; }
    const bool need_sel = qb >= 16;
    float ow[32];
    float carry_in = 0.f;
#pragma unroll
    for (int T = 0; T < 4; ++T) {
        f32x16 s0, s1;
        qk_tile(lds + L_CK + T * 8192, qf, kofs, s0, s1);
        if (__ballot(cmax - 64 * T < 63) != 0ull) mask_tile<false>(s0, s1, cmax - 64 * T - 4 * h, 0);
#pragma unroll
        for (int i = 0; i < 16; ++i) { s0[i] = __builtin_amdgcn_exp2f(s0[i] - m) * rinv; s1[i] = __builtin_amdgcn_exp2f(s1[i] - m) * rinv; }
#pragma unroll
        for (int kt = 0; kt < 2; ++kt)
#pragma unroll
            for (int u = 0; u < 4; ++u) {
                const float p0 = kt ? s1[4 * u] : s0[4 * u], p1 = kt ? s1[4 * u + 1] : s0[4 * u + 1], p2 = kt ? s1[4 * u + 2] : s0[4 * u + 2], p3 = kt ? s1[4 * u + 3] : s0[4 * u + 3];
                const float x = xhalf(p3);
                const float own = 2.0f * ((p0 + p1) + p2) + p3;
                ow[8 * T + 4 * kt + u] = own + (h ? x : carry_in);
                carry_in = x;
            }
        pv_tile(lds + L_CV + T * 8192, vofs, s0, s1, of0, of1);
    }
#pragma unroll
    for (int i = 0; i < 16; ++i) { of0[i] *= gc; of1[i] *= gc; }
    unsigned long long selmask = (qb >= 63) ? ~0ull : ((1ull << (qb + 1)) - 1ull);
    if (need_sel) {
        __builtin_amdgcn_s_barrier();
        NLAS float* imp = (NLAS float*)(lds + L_IMP) + qi * 64;
#pragma unroll 1
        for (int hh = 0; hh < 4; ++hh) {
            if ((wv >> 1) == hh) {
                if (hh == 0) {
#pragma unroll
                    for (int idx = 0; idx < 32; ++idx) imp[(2 * idx + h + qi) & 63] = ow[idx];
                } else {
#pragma unroll
                    for (int idx = 0; idx < 32; ++idx) imp[(2 * idx + h + qi) & 63] += ow[idx];
                }
            }
            asm volatile("s_waitcnt lgkmcnt(0)" ::: "memory"); __builtin_amdgcn_s_barrier();
        }
        NLAS unsigned long long* selm = (NLAS unsigned long long*)(lds + L_SELM);
        const unsigned long long forced = 1ull | (1ull << qb) | (1ull << (qb - 1));
        const bool cand = (lane >= 1) && (lane <= qb - 2);
#pragma unroll 1
        for (int rep_ = 0; rep_ < NSA_REP_RANK; ++rep_) {
            unsigned vb[8], thr[8];
#pragma unroll
            for (int qq = 0; qq < 8; ++qq) { const int q = 8 * wv + qq; const float v = ((NLAS float*)(lds + L_IMP))[q * 64 + ((lane + q) & 63)];
                vb[qq] = cand ? __float_as_uint(v) : 0u; thr[qq] = 0u; }
#pragma unroll 1
            for (int bit = 30; bit >= 0; --bit) {
#pragma unroll
                for (int qq = 0; qq < 8; ++qq) {
                    const unsigned c2 = thr[qq] | (1u << bit);
                    const int cnt = __popcll(__ballot(cand && vb[qq] >= c2));
                    thr[qq] = (cnt >= 13) ? c2 : thr[qq];
                }
            }
#pragma unroll
            for (int qq = 0; qq < 8; ++qq) {
                unsigned long long sel = __ballot(cand && vb[qq] > thr[qq]);
                unsigned long long eq = __ballot(cand && vb[qq] == thr[qq]);
                int need = 13 - __popcll(sel);
#pragma unroll 1
                for (; need > 0; --need) { const unsigned long long low = eq & (~eq + 1ull); sel |= low; eq ^= low; }
                if (lane == 0) selm[8 * wv + qq] = sel | forced;
            }
        }
        asm volatile("s_waitcnt lgkmcnt(0)" ::: "memory"); __builtin_amdgcn_s_barrier();
        selmask = selm[qi];
    }
    {
        u32x4 qraw[4];
#pragma unroll
        for (int ks = 0; ks < 4; ++ks) qraw[ks] = *(const u32x4*)(qrow + 16 * ks + 8 * h);
        const float4* cp = (const float4*)(P.cosT + (size_t)tok * 32 + 8 * h); const float4* sp = (const float4*)(P.sinT + (size_t)tok * 32 + 8 * h);
#pragma unroll
        for (int ks = 0; ks < 2; ++ks) {
            const float4 c0 = cp[4 * ks], c1 = cp[4 * ks + 1], s0 = sp[4 * ks], s1 = sp[4 * ks + 1];
            const float cs[8] = {c0.x, c0.y, c0.z, c0.w, c1.x, c1.y, c1.z, c1.w}, sn[8] = {s0.x, s0.y, s0.z, s0.w, s1.x, s1.y, s1.z, s1.w};
            u32x4 oa, ob;
#pragma unroll
            for (int c = 0; c < 4; ++c) {
                const float a0 = bflo(qraw[ks][c]), a1 = bfhi(qraw[ks][c]), b0 = bflo(qraw[ks + 2][c]), b1 = bfhi(qraw[ks + 2][c]);
                oa[c] = cvtpk((a0 * cs[2 * c] - b0 * sn[2 * c]) * QSCALE, (a1 * cs[2 * c + 1] - b1 * sn[2 * c + 1]) * QSCALE);
                ob[c] = cvtpk((b0 * cs[2 * c] + a0 * sn[2 * c]) * QSCALE, (b1 * cs[2 * c + 1] + a1 * sn[2 * c + 1]) * QSCALE);
            }
            qf[ks] = __builtin_bit_cast(bf16x8, oa); qf[ks + 2] = __builtin_bit_cast(bf16x8, ob);
        }
    }
    asm volatile("s_waitcnt vmcnt(0)" ::: "memory");
    f32x16 o0, o1;
    const bool lead = wv < 4;
    const float gs_keep = gs, gw_keep = gw;
#pragma unroll 1
    for (int repL = 0; repL < NSA_REP_LOOP; ++repL) {
    if (NSA_REP_LOOP > 1) { gs = (repL == NSA_REP_LOOP - 1) ? gs_keep : 0.f; gw = (repL == NSA_REP_LOOP - 1) ? gw_keep : 0.f;
        if (repL > 0) { asm volatile("s_waitcnt vmcnt(0)" ::: "memory"); __builtin_amdgcn_s_barrier(); NSA_ISSUE(0); NSA_ISSUE(1); asm volatile("s_waitcnt vmcnt(0)" ::: "memory"); } }
#pragma unroll
    for (int i = 0; i < 16; ++i) { o0[i] = 0.f; o1[i] = 0.f; }
    m = NEGBIG; l = 0.f;
    if (!lead) { asm volatile("s_waitcnt vmcnt(2)" ::: "memory"); __builtin_amdgcn_s_barrier(); }
#pragma unroll 1
    for (int pos = 0; pos < ntiles; ++pos) {
        if (lead) asm volatile("s_waitcnt vmcnt(2)" ::: "memory");
        __builtin_amdgcn_s_barrier();
        NSA_ISSUE(pos + 2);
        const NLAS unsigned char* slot = lds + L_RING + (pos & 3) * SLOTB;
        f32x16 s0, s1;
        const bool win = pos >= nsel; const int j = win ? jw0 + pos - nsel : pos;
        const bool live = win || ((selmask >> j) & 1ull);
        qk_tile(slot, qf, kofs, s0, s1);
        if (j == qb) mask_tile<false>(s0, s1, qi - 4 * h, 0);
        else if (win && qb >= 8 && j == qb - 8) mask_tile<true>(s0, s1, 63, qi + 1 - 4 * h);
        softmax_core(s0, s1, m, l, o0, o1, live);
        if (!lead) asm volatile("s_waitcnt vmcnt(2)" ::: "memory");
        __builtin_amdgcn_s_barrier();
        pv_tile(slot + 8192, vofs, s0, s1, o0, o1);
        if (pos == nsel - 1) {
            const float L = xhalf_sum(l); const float sc = (L > 0.f) ? gs / L : 0.f;
#pragma unroll
            for (int i = 0; i < 16; ++i) { of0[i] += sc * o0[i]; of1[i] += sc * o1[i]; o0[i] = 0.f; o1[i] = 0.f; }
            m = NEGBIG; l = 0.f;
        }
    }
    if (lead) __builtin_amdgcn_s_barrier();
    if (NSA_REP_LOOP > 1 && repL < NSA_REP_LOOP - 1) {
        const float L0 = l + xhalf(l); (void)L0; }
    if (repL == NSA_REP_LOOP - 1)    {
        float L = xhalf_sum(l);
        const float npad = (t < 511) ? (float)(511 - t) : 0.f;
        const float m2 = (npad > 0.f) ? fmaxf(m, 0.f) : m;
        const float a = __builtin_amdgcn_exp2f(m - m2);
        L = L * a + npad * __builtin_amdgcn_exp2f(-m2);
        const float sc = (L > 0.f) ? gw * a / L : 0.f;
#pragma unroll
        for (int i = 0; i < 16; ++i) { of0[i] += sc * o0[i]; of1[i] += sc * o1[i]; }
    }
    }
    float ss = 0.f;
#pragma unroll
    for (int i = 0; i < 16; ++i) ss += of0[i] * of0[i] + of1[i] * of1[i];
    ss = xhalf_sum(ss);
    const float rn = rsqrtf(ss * (1.0f / 64.0f) + 1e-6f);
    unsigned short* yrow = P.ycat + (size_t)tok * 1024 + 512 + head * 64;
    const float* nw = P.normw + head * 64;
    float4 w4a[2][4];
#pragma unroll
    for (int mb = 0; mb < 2; ++mb)
#pragma unroll
        for (int u = 0; u < 4; ++u) w4a[mb][u] = *(const float4*)(nw + 32 * mb + 8 * u + 4 * h);
#pragma unroll
    for (int mb = 0; mb < 2; ++mb)
#pragma unroll
        for (int u = 0; u < 4; ++u) {
            const int d0 = 32 * mb + 8 * u + 4 * h;
            const float4 w4 = w4a[mb][u];
            const float v0 = (mb ? of1[4 * u] : of0[4 * u]) * rn * w4.x, v1 = (mb ? of1[4 * u + 1] : of0[4 * u + 1]) * rn * w4.y;
            const float v2 = (mb ? of1[4 * u + 2] : of0[4 * u + 2]) * rn * w4.z, v3 = (mb ? of1[4 * u + 3] : of0[4 * u + 3]) * rn * w4.w;
            *(uint2*)(yrow + d0) = make_uint2(cvtpk(v0, v1), cvtpk(v2, v3));
        }
    asm volatile("s_waitcnt vmcnt(0)" ::: "memory"); __builtin_amdgcn_s_barrier();
#undef NSA_DMA
#undef NSA_ISSUE
}
__device__ __forceinline__ void phase(const Params& P, NLAS unsigned char* lds, const int tid, const int bid, const int G) {
#pragma unroll 1
    for (int vw = bid; vw < 256; vw += G) {
        const int xcd = vw & 7, slot = vw >> 3, bg = xcd * 2 + (slot >> 4), rr = slot & 15;
#pragma unroll 1
        for (int k = 0; k < 4; ++k) { const int qb = (k == 0) ? 63 - rr : (k == 1) ? 32 + rr : (k == 2) ? 31 - rr : rr; unit(P, lds, tid, bg >> 1, bg & 1, qb); }
    }
}
}


namespace wt {
typedef short bf16x8 __attribute__((ext_vector_type(8)));
typedef float f32x16 __attribute__((ext_vector_type(16)));
typedef unsigned u32x4 __attribute__((ext_vector_type(4)));
typedef unsigned u32x2 __attribute__((ext_vector_type(2)));
typedef float f32x2_t __attribute__((ext_vector_type(2)));
typedef __bf16 bf16x2_t __attribute__((ext_vector_type(2)));
#define WT_MFMA(a, b, c) __builtin_amdgcn_mfma_f32_32x32x16_bf16((a), (b), (c), 0, 0, 0)
__device__ __forceinline__ unsigned cvtpk(float lo, float hi) { f32x2_t v = {lo, hi}; bf16x2_t b = __builtin_convertvector(v, bf16x2_t); return __builtin_bit_cast(unsigned, b); }
__device__ __forceinline__ float bflo(unsigned u) { return __uint_as_float(u << 16); }
__device__ __forceinline__ float bfhi(unsigned u) { return __uint_as_float(u & 0xffff0000u); }
__device__ __forceinline__ float xhalf(float v) { return __shfl_xor(v, 32); }
__device__ __forceinline__ float xhalf_sum(float v) { const auto r = __builtin_amdgcn_permlane32_swap(__float_as_uint(v), __float_as_uint(v), false, false); return __uint_as_float(r[0]) + __uint_as_float(r[1]); }
__device__ __forceinline__ bf16x8 ld16(const unsigned short* p) { return __builtin_bit_cast(bf16x8, *(const u32x4*)p); }
__device__ __forceinline__ bf16x8 ld8x2(const unsigned short* p0, const unsigned short* p1) { const u32x2 a = *(const u32x2*)p0, b = *(const u32x2*)p1; u32x4 u = {a.x, a.y, b.x, b.y}; return __builtin_bit_cast(bf16x8, u); }
__device__ __forceinline__ bf16x8 pack8(const f32x16& x, int s) {
    u32x4 u = {cvtpk(x[8 * s], x[8 * s + 1]), cvtpk(x[8 * s + 2], x[8 * s + 3]), cvtpk(x[8 * s + 4], x[8 * s + 5]), cvtpk(x[8 * s + 6], x[8 * s + 7])};
    return __builtin_bit_cast(bf16x8, u);
}
__device__ __forceinline__ float gelu_t(float x) { const float u = 0.7978845608028654f * (x + 0.044715f * x * x * x); const float e = __expf(2.0f * u); return 0.5f * x * (1.0f + (1.0f - 2.0f / (e + 1.0f))); }
__device__ __forceinline__ float sigm(float x) { return 1.0f / (1.0f + __expf(-x)); }
__device__ __forceinline__ void zero(f32x16& a) {
#pragma unroll
    for (int i = 0; i < 16; ++i) a[i] = 0.f;
}

__device__ __forceinline__ void gm_ln8(const unsigned short* __restrict__ hb, const float* __restrict__ lw, const float* __restrict__ lbias, unsigned short* __restrict__ vlnT, int t8, int lane) {
    const int tok0 = t8 * 8;
    const float4 w4 = *(const float4*)(lw + lane * 4), b4 = *(const float4*)(lbias + lane * 4);
    float o[4][8];
#pragma unroll
    for (int i = 0; i < 8; ++i) {
        const u32x2 v4 = *(const u32x2*)(hb + (size_t)(tok0 + i) * 3072 + 1280 + lane * 4);
        float v[4] = {gelu_t(bflo(v4.x)), gelu_t(bfhi(v4.x)), gelu_t(bflo(v4.y)), gelu_t(bfhi(v4.y))};
        float s = (v[0] + v[1]) + (v[2] + v[3]);
#pragma unroll
        for (int o2 = 1; o2 < 64; o2 <<= 1) s += __shfl_xor(s, o2);
        const float mean = s * (1.0f / 256.0f); float q = 0.f;
#pragma unroll
        for (int c = 0; c < 4; ++c) { v[c] -= mean; q += v[c] * v[c]; }
#pragma unroll
        for (int o2 = 1; o2 < 64; o2 <<= 1) q += __shfl_xor(q, o2);
        const float rstd = rsqrtf(q * (1.0f / 256.0f) + 1e-5f);
        o[0][i] = v[0] * rstd * w4.x + b4.x; o[1][i] = v[1] * rstd * w4.y + b4.y; o[2][i] = v[2] * rstd * w4.z + b4.z; o[3][i] = v[3] * rstd * w4.w + b4.w;
    }
    const int bc = tok0 >> 7, s0 = tok0 & 127;
#pragma unroll
    for (int c = 0; c < 4; ++c) {
        const int ch = lane * 4 + c, g = ch >> 6, cc = ch & 63;
        u32x4 u = {cvtpk(o[c][0], o[c][1]), cvtpk(o[c][2], o[c][3]), cvtpk(o[c][4], o[c][5]), cvtpk(o[c][6], o[c][7])};
        *(u32x4*)(vlnT + ((size_t)(bc * 4 + g) * 64 + cc) * 128 + s0) = u;
    }
}
__device__ __forceinline__ void gm_sp_task(const unsigned short* __restrict__ hb, const unsigned short* __restrict__ vlnT, const unsigned short* __restrict__ Wb, const float* __restrict__ bs,
                                           const float* __restrict__ normw, unsigned short* __restrict__ ycat, int task, int lane) {
    const int tb = task & 3, g = (task >> 2) & 3, bc = task >> 4, r = lane & 31, h = lane >> 5;
    const unsigned short* ap = vlnT + ((size_t)(bc * 4 + g) * 64 + r) * 128 + 8 * h;
    const unsigned short* bp = Wb + ((size_t)g * 128 + 32 * tb + r) * 128 + 8 * h;
    f32x16 a0, a1; zero(a0); zero(a1);
    const int nks = 2 * (tb + 1);
#pragma unroll 2
    for (int ks = 0; ks < nks; ++ks) {
        const bf16x8 bw = ld16(bp + 16 * ks);
        const bf16x8 v0 = ld16(ap + 16 * ks), v1 = ld16(ap + 32 * 128 + 16 * ks);
        a0 = WT_MFMA(v0, bw, a0); a1 = WT_MFMA(v1, bw, a1);
    }
    const int tl = 32 * tb + r, tok = bc * 128 + tl;
    const float bias = bs[g * 128 + tl];
    const unsigned short* up = hb + (size_t)tok * 3072 + 1024 + g * 64;
    float z[32]; float ss = 0.f;
#pragma unroll
    for (int cb = 0; cb < 2; ++cb)
#pragma unroll
        for (int u = 0; u < 4; ++u) {
            const int c0 = 32 * cb + 8 * u + 4 * h;
            const u32x2 uu = *(const u32x2*)(up + c0);
            const float uv[4] = {gelu_t(bflo(uu.x)), gelu_t(bfhi(uu.x)), gelu_t(bflo(uu.y)), gelu_t(bfhi(uu.y))};
#pragma unroll
            for (int k = 0; k < 4; ++k) { const float a = (cb ? a1[4 * u + k] : a0[4 * u + k]) + bias; const float zz = uv[k] * a; z[16 * cb + 4 * u + k] = zz; ss += zz * zz; }
        }
    ss = xhalf_sum(ss);
    const float rn = rsqrtf(ss * (1.0f / 64.0f) + 1e-6f);
    unsigned short* yp = ycat + (size_t)tok * 1024 + 256 + g * 64;
    const float* nw = normw + g * 64;
    float4 w4a[2][4];
#pragma unroll
    for (int cb = 0; cb < 2; ++cb)
#pragma unroll
        for (int u = 0; u < 4; ++u) w4a[cb][u] = *(const float4*)(nw + 32 * cb + 8 * u + 4 * h);
#pragma unroll
    for (int cb = 0; cb < 2; ++cb)
#pragma unroll
        for (int u = 0; u < 4; ++u) {
            const int c0 = 32 * cb + 8 * u + 4 * h;
            const float4 w4 = w4a[cb][u];
            u32x2 o = {cvtpk(z[16 * cb + 4 * u] * rn * w4.x, z[16 * cb + 4 * u + 1] * rn * w4.y), cvtpk(z[16 * cb + 4 * u + 2] * rn * w4.z, z[16 * cb + 4 * u + 3] * rn * w4.w)};
            *(u32x2*)(yp + c0) = o;
        }
}

#define WT_LAS __attribute__((address_space(3)))
__device__ __forceinline__ void cmp_wg(const unsigned short* __restrict__ hb, const unsigned short* __restrict__ w1t, const float* __restrict__ cbias, const unsigned short* __restrict__ w2t,
                                       unsigned short* __restrict__ kcb, unsigned short* __restrict__ vcb, WT_LAS float* red, int task, int wave, int lane) {
    const int cblk = task & 7, kv = (task >> 3) & 1, g = (task >> 4) & 1, b = task >> 5, r = lane & 31, h = lane >> 5;
    const int c = 32 * cblk + r; const int cl = c < 254 ? c : 254;
    const unsigned short* bp = hb + (size_t)(b * 4096 + 16 * cl) * 3072 + (kv ? 2176 : 2048) + g * 64 + 8 * h;
    const unsigned short* ap = w1t + ((size_t)kv * 128 + r) * 2048 + 8 * h;
    f32x16 acc[4];
#pragma unroll
    for (int nt = 0; nt < 4; ++nt) zero(acc[nt]);
#pragma unroll 4
    for (int kk = 0; kk < 16; ++kk) {
        const int ks = 16 * wave + kk;
        const bf16x8 bk = ld16(bp + (size_t)(ks >> 2) * 3072 + 16 * (ks & 3));
#pragma unroll
        for (int nt = 0; nt < 4; ++nt) acc[nt] = WT_MFMA(ld16(ap + (size_t)nt * 32 * 2048 + 16 * ks), bk, acc[nt]);
    }
#pragma unroll
    for (int nt = 0; nt < 4; ++nt)
#pragma unroll
        for (int i = 0; i < 16; ++i) red[(wave * 64 + nt * 16 + i) * 64 + lane] = acc[nt][i];
    asm volatile("s_waitcnt lgkmcnt(0)" ::: "memory"); __builtin_amdgcn_s_barrier();
#pragma unroll
    for (int q = 0; q < 8; ++q) {
        const int row = 8 * wave + q; float sacc = 0.f;
#pragma unroll
        for (int w2 = 0; w2 < 8; ++w2) sacc += red[(w2 * 64 + row) * 64 + lane];
        red[row * 64 + lane] = sacc;
    }
    asm volatile("s_waitcnt lgkmcnt(0)" ::: "memory"); __builtin_amdgcn_s_barrier();
    if (wave == 0) {
#pragma unroll
        for (int nt = 0; nt < 4; ++nt)
#pragma unroll
            for (int i = 0; i < 16; ++i) { const int n = 32 * nt + (i & 3) + 8 * (i >> 2) + 4 * h; acc[nt][i] = gelu_t(red[(nt * 16 + i) * 64 + lane] + cbias[kv * 128 + n]); }
        f32x16 o0, o1; zero(o0); zero(o1);
        const unsigned short* w2p = w2t + ((size_t)kv * 64 + r) * 128 + 4 * h;
#pragma unroll
        for (int nt = 0; nt < 4; ++nt)
#pragma unroll
            for (int s = 0; s < 2; ++s) {
                const bf16x8 pb = pack8(acc[nt], s);
                const unsigned short* wp = w2p + 32 * nt + 16 * s;
                o0 = WT_MFMA(ld8x2(wp, wp + 8), pb, o0);
                o1 = WT_MFMA(ld8x2(wp + 32 * 128, wp + 32 * 128 + 8), pb, o1);
            }
        if (c < 255) {
            unsigned short* op = (kv ? vcb : kcb) + ((size_t)(b * 2 + g) * 256 + c) * 64;
#pragma unroll
            for (int db = 0; db < 2; ++db)
#pragma unroll
                for (int u = 0; u < 4; ++u) {
                    const int d0 = 32 * db + 8 * u + 4 * h;
                    u32x2 o = {cvtpk(db ? o1[4 * u] : o0[4 * u], db ? o1[4 * u + 1] : o0[4 * u + 1]), cvtpk(db ? o1[4 * u + 2] : o0[4 * u + 2], db ? o1[4 * u + 3] : o0[4 * u + 3])};
                    *(u32x2*)(op + d0) = o;
                }
        }
    }
    __builtin_amdgcn_s_barrier();
}

__device__ __forceinline__ void kvprep8(const unsigned short* __restrict__ hb, const float* __restrict__ cosT, const float* __restrict__ sinT,
                                        unsigned short* __restrict__ ksb, unsigned short* __restrict__ vsb, unsigned short* __restrict__ kwb, unsigned short* __restrict__ vwb, int idx) {
    const int j8 = idx & 3, g = (idx >> 2) & 1, tok = idx >> 3, b = tok >> 12, t = tok & 4095;
    const unsigned short* hr = hb + (size_t)tok * 3072 + g * 64 + 8 * j8;
    const float4 c0 = *(const float4*)(cosT + (size_t)tok * 32 + 8 * j8), c1 = *(const float4*)(cosT + (size_t)tok * 32 + 8 * j8 + 4);
    const float4 s0 = *(const float4*)(sinT + (size_t)tok * 32 + 8 * j8), s1 = *(const float4*)(sinT + (size_t)tok * 32 + 8 * j8 + 4);
    u32x4 ka[2], kb[2], va[2], vb[2];
#pragma unroll
    for (int w = 0; w < 2; ++w) { const int col = w ? 2560 : 2304, vcol = w ? 2688 : 2432;
        ka[w] = *(const u32x4*)(hr + col); kb[w] = *(const u32x4*)(hr + col + 32); va[w] = *(const u32x4*)(hr + vcol); vb[w] = *(const u32x4*)(hr + vcol + 32); }
    const float cs[8] = {c0.x, c0.y, c0.z, c0.w, c1.x, c1.y, c1.z, c1.w}, sn[8] = {s0.x, s0.y, s0.z, s0.w, s1.x, s1.y, s1.z, s1.w};
    const size_t o = ((size_t)(b * 2 + g) * 4096 + t) * 64 + 8 * j8;
#pragma unroll
    for (int w = 0; w < 2; ++w) {
        u32x4 oa, ob;
#pragma unroll
        for (int c = 0; c < 4; ++c) {
            const float a0 = bflo(ka[w][c]), a1 = bfhi(ka[w][c]), b0 = bflo(kb[w][c]), b1 = bfhi(kb[w][c]);
            oa[c] = cvtpk(a0 * cs[2 * c] - b0 * sn[2 * c], a1 * cs[2 * c + 1] - b1 * sn[2 * c + 1]);
            ob[c] = cvtpk(b0 * cs[2 * c] + a0 * sn[2 * c], b1 * cs[2 * c + 1] + a1 * sn[2 * c + 1]);
        }
        unsigned short* kd = (w ? kwb : ksb) + o;
        *(u32x4*)kd = oa; *(u32x4*)(kd + 32) = ob;
        unsigned short* vd = (w ? vwb : vsb) + o;
        *(u32x4*)vd = va[w]; *(u32x4*)(vd + 32) = vb[w];
    }
}

__device__ __forceinline__ void hg_pass1(const unsigned short* __restrict__ hb, const float* __restrict__ lbl, unsigned short* __restrict__ Qt, unsigned short* __restrict__ Kt,
                                         unsigned short* __restrict__ Qp, unsigned short* __restrict__ VT, float* __restrict__ Ut, float* __restrict__ Dk, int ci, int lane_in) {
    int lane = lane_in; asm volatile("" : "+v"(lane));
    const int chunk = ci & 63, hd = (ci >> 6) & 3, b = ci >> 8;
    const unsigned short* hp = hb + (size_t)(b * 4096 + chunk * 64) * 3072 + hd * 64 + lane;
    const float lb = lbl[hd * 64 + lane];
    unsigned fpk[32];
#pragma unroll
    for (int hb2 = 0; hb2 < 2; ++hb2) { unsigned short rf[32];
#pragma unroll
      for (int t = 0; t < 32; ++t) rf[t] = hp[(size_t)(32 * hb2 + t) * 3072 + 256];
#pragma unroll
      for (int t = 0; t < 16; ++t) fpk[16 * hb2 + t] = (unsigned)rf[2 * t] | ((unsigned)rf[2 * t + 1] << 16); }
    float run = 0.f, cmid = 0.f;
#pragma unroll
    for (int t = 0; t < 64; ++t) {
        const float fr = (t & 1) ? bfhi(fpk[t >> 1]) : bflo(fpk[t >> 1]);
        run += __logf(lb + (1.0f - lb) * sigm(fr));
        if (t == 31) cmid = run;
    }
    const float blast = run;
    unsigned short* qt = Qt + (size_t)ci * 4096 + lane; unsigned short* kt = Kt + (size_t)ci * 4096 + lane; unsigned short* qp = Qp + (size_t)ci * 4096 + lane;
    unsigned short* vt = VT + (size_t)ci * 4096 + lane * 64;
    const int h = lane >> 5, r = lane & 31;
    f32x16 acc[2][2];
#pragma unroll
    for (int a = 0; a < 2; ++a)
#pragma unroll
        for (int c = 0; c < 2; ++c) zero(acc[a][c]);
    float bt = 0.f;
    Dk[(size_t)ci * 64 + lane] = __expf(blast);
#pragma unroll 1
    for (int ks = 0; ks < 4; ++ks) {
        unsigned short rq[1][16], ri[1][16];
#pragma unroll
        for (int tt = 0; tt < 16; ++tt) { const size_t o = (size_t)(ks * 16 + tt) * 3072; rq[0][tt] = hp[o]; ri[0][tt] = hp[o + 512]; }
        unsigned kp[8], vp[8];
        unsigned fsel[8];
#pragma unroll
        for (int tp = 0; tp < 8; ++tp) fsel[tp] = (ks == 0) ? fpk[tp] : (ks == 1) ? fpk[8 + tp] : (ks == 2) ? fpk[16 + tp] : fpk[24 + tp];
#pragma unroll
        for (int tp = 0; tp < 8; ++tp) {
            float k2v[2], ivv[2];
#pragma unroll
            for (int e = 0; e < 2; ++e) {
                const int t = ks * 16 + tp * 2 + e;
                const float qr = __uint_as_float((unsigned)rq[0][tp * 2 + e] << 16), fr = e ? bfhi(fsel[tp]) : bflo(fsel[tp]);
                ivv[e] = __uint_as_float((unsigned)ri[0][tp * 2 + e] << 16);
                const float sf = sigm(fr);
                const float q = qr * sigm(qr), kk = (1.0f - lb) * (1.0f - sf);
                bt += __logf(lb + (1.0f - lb) * sf);
                qt[t * 64] = (unsigned short)(cvtpk(q * __expf(bt - cmid), 0.f) & 0xffffu);
                kt[t * 64] = (unsigned short)(cvtpk(kk * __expf(cmid - bt), 0.f) & 0xffffu);
                qp[t * 64] = (unsigned short)(cvtpk(q * __expf(bt), 0.f) & 0xffffu);
                k2v[e] = kk * __expf(blast - bt);
            }
            kp[tp] = cvtpk(k2v[0], k2v[1]); vp[tp] = cvtpk(ivv[0], ivv[1]);
        }
        { u32x4 u0 = {vp[0], vp[1], vp[2], vp[3]}, u1 = {vp[4], vp[5], vp[6], vp[7]};
          *(u32x4*)(vt + ks * 16) = u0; *(u32x4*)(vt + ks * 16 + 8) = u1; }
        u32x4 kown, vown, ksnd, vsnd;
#pragma unroll
        for (int j = 0; j < 4; ++j) { kown[j] = h ? kp[4 + j] : kp[j]; ksnd[j] = h ? kp[j] : kp[4 + j]; vown[j] = h ? vp[4 + j] : vp[j]; vsnd[j] = h ? vp[j] : vp[4 + j]; }
        u32x4 krcv, vrcv;
#pragma unroll
        for (int j = 0; j < 4; ++j) { krcv[j] = (unsigned)__shfl_xor((int)ksnd[j], 32); vrcv[j] = (unsigned)__shfl_xor((int)vsnd[j], 32); }
        const bf16x8 kb0 = __builtin_bit_cast(bf16x8, h ? krcv : kown), kb1 = __builtin_bit_cast(bf16x8, h ? kown : krcv);
        const bf16x8 va0 = __builtin_bit_cast(bf16x8, h ? vrcv : vown), va1 = __builtin_bit_cast(bf16x8, h ? vown : vrcv);
        acc[0][0] = WT_MFMA(va0, kb0, acc[0][0]); acc[0][1] = WT_MFMA(va0, kb1, acc[0][1]);
        acc[1][0] = WT_MFMA(va1, kb0, acc[1][0]); acc[1][1] = WT_MFMA(va1, kb1, acc[1][1]);
    }
    float* up = Ut + (size_t)ci * 4096;
#pragma unroll
    for (int vb = 0; vb < 2; ++vb)
#pragma unroll
        for (int kb = 0; kb < 2; ++kb)
#pragma unroll
            for (int i = 0; i < 16; ++i) { const int v = 32 * vb + (i & 3) + 8 * (i >> 2) + 4 * h; up[v * 64 + 32 * kb + r] = acc[vb][kb][i]; }
}
__device__ __forceinline__ void hg_scan(const float* __restrict__ Ut, const float* __restrict__ Dk, unsigned short* __restrict__ ST, int e) {
    const int k = e & 63, seq = e >> 12, vk = e & 4095;
    float S = 0.f;
    const float* up = Ut + (size_t)seq * 64 * 4096 + vk; const float* dp = Dk + (size_t)seq * 64 * 64 + k; unsigned short* sp = ST + (size_t)seq * 64 * 4096 + vk;
#pragma unroll 8
    for (int c = 0; c < 64; ++c) {
        sp[(size_t)c * 4096] = (unsigned short)(cvtpk(S, 0.f) & 0xffffu);
        S = fmaf(dp[c * 64], S, up[(size_t)c * 4096]);
    }
}
__device__ __forceinline__ void hg_pass3(const unsigned short* __restrict__ hb, const unsigned short* __restrict__ Qt, const unsigned short* __restrict__ Kt, const unsigned short* __restrict__ Qp,
                                         const unsigned short* __restrict__ VT, const unsigned short* __restrict__ ST, const float* __restrict__ normw, unsigned short* __restrict__ ycat, int task, int lane) {
    const int tblk = task & 1, ci = task >> 1, chunk = ci & 63, hd = (ci >> 6) & 3, b = ci >> 8, r = lane & 31, h = lane >> 5;
    const size_t cb = (size_t)ci * 4096;
    f32x16 o0, o1; zero(o0); zero(o1);
    {
        const unsigned short* sp = ST + cb + (size_t)r * 64 + 8 * h; const unsigned short* qp = Qp + cb + (size_t)(32 * tblk + r) * 64 + 8 * h;
#pragma unroll
        for (int ks = 0; ks < 4; ++ks) { const bf16x8 q = ld16(qp + 16 * ks); o0 = WT_MFMA(ld16(sp + 16 * ks), q, o0); o1 = WT_MFMA(ld16(sp + 32 * 64 + 16 * ks), q, o1); }
    }
    const unsigned short* qtp = Qt + cb + (size_t)(32 * tblk + r) * 64 + 8 * h;
    bf16x8 qf[4];
#pragma unroll
    for (int ks = 0; ks < 4; ++ks) qf[ks] = ld16(qtp + 16 * ks);
#pragma unroll 1
    for (int sblk = 0; sblk <= tblk; ++sblk) {
        f32x16 at; zero(at);
        const unsigned short* ktp = Kt + cb + (size_t)(32 * sblk + r) * 64 + 8 * h;
#pragma unroll
        for (int ks = 0; ks < 4; ++ks) at = WT_MFMA(ld16(ktp + 16 * ks), qf[ks], at);
        if (sblk == tblk) {
#pragma unroll
            for (int i = 0; i < 16; ++i) { const int sl = (i & 3) + 8 * (i >> 2) + 4 * h; at[i] = (sl <= r) ? at[i] : 0.f; }
        }
#pragma unroll
        for (int s2 = 0; s2 < 2; ++s2) {
            const bf16x8 pb = pack8(at, s2);
            const unsigned short* vp = VT + cb + (size_t)r * 64 + 32 * sblk + 16 * s2 + 4 * h;
            o0 = WT_MFMA(ld8x2(vp, vp + 8), pb, o0);
            o1 = WT_MFMA(ld8x2(vp + 32 * 64, vp + 32 * 64 + 8), pb, o1);
        }
    }
    const int tok = b * 4096 + chunk * 64 + 32 * tblk + r;
    float ss = 0.f;
#pragma unroll
    for (int i = 0; i < 16; ++i) ss += o0[i] * o0[i] + o1[i] * o1[i];
    ss = xhalf_sum(ss);
    const float rn = rsqrtf(ss * (1.0f / 64.0f) + 1e-6f);
    const unsigned short* gp = hb + (size_t)tok * 3072 + 768 + hd * 64;
    unsigned short* yp = ycat + (size_t)tok * 1024 + hd * 64;
    const float* nw = normw + hd * 64;
    u32x2 gg[2][4]; float4 w4[2][4];
#pragma unroll
    for (int vb = 0; vb < 2; ++vb)
#pragma unroll
        for (int u = 0; u < 4; ++u) { const int v0 = 32 * vb + 8 * u + 4 * h; gg[vb][u] = *(const u32x2*)(gp + v0); w4[vb][u] = *(const float4*)(nw + v0); }
#pragma unroll
    for (int vb = 0; vb < 2; ++vb)
#pragma unroll
        for (int u = 0; u < 4; ++u) {
            const int v0 = 32 * vb + 8 * u + 4 * h;
            const float x0 = (vb ? o1[4 * u] : o0[4 * u]) * rn * w4[vb][u].x * sigm(bflo(gg[vb][u].x)), x1 = (vb ? o1[4 * u + 1] : o0[4 * u + 1]) * rn * w4[vb][u].y * sigm(bfhi(gg[vb][u].x));
            const float x2 = (vb ? o1[4 * u + 2] : o0[4 * u + 2]) * rn * w4[vb][u].z * sigm(bflo(gg[vb][u].y)), x3 = (vb ? o1[4 * u + 3] : o0[4 * u + 3]) * rn * w4[vb][u].w * sigm(bfhi(gg[vb][u].y));
            u32x2 o = {cvtpk(x0, x1), cvtpk(x2, x3)};
            *(u32x2*)(yp + v0) = o;
        }
}

__device__ __forceinline__ void route_task(const unsigned short* __restrict__ x1, const unsigned short* __restrict__ rwh, const unsigned short* __restrict__ rwl, const float* __restrict__ rb,
                                           int* __restrict__ cnt, int* __restrict__ list, int* __restrict__ tok_e, int* __restrict__ tok_slot, float* __restrict__ tok_w, int task, int lane) {
    const int r = lane & 31, h = lane >> 5, tok = task * 32 + r;
    const unsigned short* xp = x1 + (size_t)tok * 1024 + 8 * h;
    const unsigned short* whp = rwh + (size_t)r * 1024 + 8 * h; const unsigned short* wlp = rwl + (size_t)r * 1024 + 8 * h;
    f32x16 acc; zero(acc);
#pragma unroll 8
    for (int ks = 0; ks < 64; ++ks) {
        const bf16x8 xh = ld16(xp + 16 * ks);
        acc = WT_MFMA(ld16(whp + 16 * ks), xh, acc); acc = WT_MFMA(ld16(wlp + 16 * ks), xh, acc);
    }
    float v[16];
#pragma unroll
    for (int i = 0; i < 16; ++i) v[i] = acc[i] + rb[(i & 3) + 8 * (i >> 2) + 4 * h];
    float cv[8]; int ce[8];
#pragma unroll
    for (int k = 0; k < 4; ++k) {
        float best = -3.0e38f; int bi = 0;
#pragma unroll
        for (int i = 0; i < 16; ++i) { const bool ok = v[i] > best; best = ok ? v[i] : best; bi = ok ? i : bi; }
#pragma unroll
        for (int i = 0; i < 16; ++i) v[i] = (i == bi) ? -3.0e38f : v[i];
        cv[k] = best; ce[k] = (bi & 3) + 8 * (bi >> 2) + 4 * h;
    }
#pragma unroll
    for (int k = 0; k < 4; ++k) { cv[4 + k] = xhalf(cv[k]); ce[4 + k] = __shfl_xor(ce[k], 32); }
    float tl[4]; int te[4];
#pragma unroll
    for (int k = 0; k < 4; ++k) {
        float best = -3.0e38f; int be = 64, bj = 0;
#pragma unroll
        for (int j = 0; j < 8; ++j) { const bool ok = (cv[j] > best) || (cv[j] == best && ce[j] < be); best = ok ? cv[j] : best; be = ok ? ce[j] : be; bj = ok ? j : bj; }
#pragma unroll
        for (int j = 0; j < 8; ++j) cv[j] = (j == bj) ? -3.0e38f : cv[j];
        tl[k] = best; te[k] = be;
    }
    const float e1 = __expf(tl[1] - tl[0]), e2 = __expf(tl[2] - tl[0]), e3 = __expf(tl[3] - tl[0]);
    const float inv = 1.0f / (1.0f + e1 + e2 + e3);
    const float tw[4] = {inv, e1 * inv, e2 * inv, e3 * inv};
    unsigned mymask = 0u;
#pragma unroll 1
    for (int e = 0; e < 32; ++e) {
        const unsigned mk = (unsigned)__ballot(h == 0 && (te[0] == e || te[1] == e || te[2] == e || te[3] == e));
        mymask = (lane == e) ? mk : mymask;
    }
    int base = 0;
    if (lane < 32 && mymask != 0u) base = atomicAdd(&cnt[lane], __popc(mymask));
#pragma unroll
    for (int k = 0; k < 4; ++k) {
        const int bk = __shfl(base, te[k]); const unsigned mk = (unsigned)__shfl((int)mymask, te[k]);
        const int slot = bk + __popc(mk & ((1u << r) - 1u));
        if (h == 0) { list[te[k] * 32768 + slot] = tok; tok_e[tok * 4 + k] = te[k]; tok_slot[tok * 4 + k] = slot; tok_w[tok * 4 + k] = tw[k]; }
    }
}
}


__device__ __forceinline__ void ln1_tok2(const float* __restrict__ xin_f, const bf16* __restrict__ xin_b, const bf16* __restrict__ mix, const float* __restrict__ lw, const float* __restrict__ lbias,
                                         bf16* __restrict__ x1b, unsigned char* __restrict__ x1q, int tok0, int lane) {
    float v[2][16]; float s[2] = {0.f, 0.f};
#pragma unroll
    for (int u = 0; u < 2; ++u)
#pragma unroll
        for (int j = 0; j < 4; ++j) {
            const size_t o = (size_t)(tok0 + u) * D_ + j * 256 + lane * 4;
            float4 a;
            if (xin_f) a = *(const float4*)(xin_f + o);
            else { const uint2 ab = *(const uint2*)(xin_b + o);
                   a = make_float4(__uint_as_float(ab.x << 16), __uint_as_float(ab.x & 0xffff0000u), __uint_as_float(ab.y << 16), __uint_as_float(ab.y & 0xffff0000u)); }
            const uint2 mb = *(const uint2*)(mix + o);
            v[u][4 * j] = ALPHA * a.x + __uint_as_float(mb.x << 16); v[u][4 * j + 1] = ALPHA * a.y + __uint_as_float(mb.x & 0xffff0000u);
            v[u][4 * j + 2] = ALPHA * a.z + __uint_as_float(mb.y << 16); v[u][4 * j + 3] = ALPHA * a.w + __uint_as_float(mb.y & 0xffff0000u);
            s[u] += (v[u][4 * j] + v[u][4 * j + 1]) + (v[u][4 * j + 2] + v[u][4 * j + 3]);
        }
    float rstd[2];
#pragma unroll
    for (int u = 0; u < 2; ++u) {
        const float mean = wsum(s[u]) * (1.0f / D_); float q = 0.f;
#pragma unroll
        for (int i = 0; i < 16; ++i) { v[u][i] -= mean; q += v[u][i] * v[u][i]; }
        rstd[u] = rsqrtf(wsum(q) * (1.0f / D_) + 1e-5f);
    }
    float4 w4a[4], b4a[4];
#pragma unroll
    for (int j = 0; j < 4; ++j) { w4a[j] = *(const float4*)(lw + j * 256 + lane * 4); b4a[j] = *(const float4*)(lbias + j * 256 + lane * 4); }
#pragma unroll
    for (int j = 0; j < 4; ++j) {
        const float4 w4 = w4a[j], b4 = b4a[j];
#pragma unroll
        for (int u = 0; u < 2; ++u) {
            const size_t o = (size_t)(tok0 + u) * D_ + j * 256 + lane * 4;
            const float4 r = make_float4(v[u][4 * j] * rstd[u] * w4.x + b4.x, v[u][4 * j + 1] * rstd[u] * w4.y + b4.y, v[u][4 * j + 2] * rstd[u] * w4.z + b4.z, v[u][4 * j + 3] * rstd[u] * w4.w + b4.w);
            *(uint2*)(x1b + o) = make_uint2(pk2(r.x, r.y), pk2(r.z, r.w));
            *(unsigned*)(x1q + o) = pg8::pk4_fp8(r.x, r.y, r.z, r.w);
        }
    }
}
__device__ __forceinline__ void comb_ln2_tok2(const bf16* __restrict__ x1, const bf16* __restrict__ y, const int* __restrict__ offs, const int* __restrict__ tok_e,
                                              const int* __restrict__ tok_slot, const float* __restrict__ tok_w, const float* __restrict__ lw, const float* __restrict__ lbias,
                                              float* __restrict__ xout, bf16* __restrict__ xbout, int tok0, int lane) {
    int row[2][4]; float wk[2][4];
#pragma unroll
    for (int u = 0; u < 2; ++u)
#pragma unroll
        for (int k = 0; k < 4; ++k) { const int i = (tok0 + u) * 4 + k; row[u][k] = offs[tok_e[i]] + tok_slot[i]; wk[u][k] = tok_w[i]; }
    float v[2][16];
#pragma unroll
    for (int u = 0; u < 2; ++u)
#pragma unroll
        for (int j = 0; j < 4; ++j) { const uint2 ab = *(const uint2*)(x1 + (size_t)(tok0 + u) * D_ + j * 256 + lane * 4);
            v[u][4 * j] = ALPHA * __uint_as_float(ab.x << 16); v[u][4 * j + 1] = ALPHA * __uint_as_float(ab.x & 0xffff0000u); v[u][4 * j + 2] = ALPHA * __uint_as_float(ab.y << 16); v[u][4 * j + 3] = ALPHA * __uint_as_float(ab.y & 0xffff0000u); }
#pragma unroll
    for (int u = 0; u < 2; ++u)
#pragma unroll
        for (int k = 0; k < 4; ++k)
#pragma unroll
            for (int j = 0; j < 4; ++j) { const uint2 ab = *(const uint2*)(y + (size_t)row[u][k] * D_ + j * 256 + lane * 4); const float w = wk[u][k];
                v[u][4 * j] = fmaf(w, __uint_as_float(ab.x << 16), v[u][4 * j]); v[u][4 * j + 1] = fmaf(w, __uint_as_float(ab.x & 0xffff0000u), v[u][4 * j + 1]);
                v[u][4 * j + 2] = fmaf(w, __uint_as_float(ab.y << 16), v[u][4 * j + 2]); v[u][4 * j + 3] = fmaf(w, __uint_as_float(ab.y & 0xffff0000u), v[u][4 * j + 3]); }
    float rstd[2];
#pragma unroll
    for (int u = 0; u < 2; ++u) {
        float s = 0.f;
#pragma unroll
        for (int i = 0; i < 16; ++i) s += v[u][i];
        const float mean = wsum(s) * (1.0f / D_); float q = 0.f;
#pragma unroll
        for (int i = 0; i < 16; ++i) { v[u][i] -= mean; q += v[u][i] * v[u][i]; }
        rstd[u] = rsqrtf(wsum(q) * (1.0f / D_) + 1e-5f);
    }
    float4 w4a[4], b4a[4];
#pragma unroll
    for (int j = 0; j < 4; ++j) { w4a[j] = *(const float4*)(lw + j * 256 + lane * 4); b4a[j] = *(const float4*)(lbias + j * 256 + lane * 4); }
#pragma unroll
    for (int j = 0; j < 4; ++j) {
        const float4 w4 = w4a[j], b4 = b4a[j];
#pragma unroll
        for (int u = 0; u < 2; ++u) {
            const size_t o = (size_t)(tok0 + u) * D_ + j * 256 + lane * 4;
            const float4 r = make_float4(v[u][4 * j] * rstd[u] * w4.x + b4.x, v[u][4 * j + 1] * rstd[u] * w4.y + b4.y, v[u][4 * j + 2] * rstd[u] * w4.z + b4.z, v[u][4 * j + 3] * rstd[u] * w4.w + b4.w);
            if (xout) *(float4*)(xout + o) = r;
            if (xbout) *(uint2*)(xbout + o) = make_uint2(pk2(r.x, r.y), pk2(r.z, r.w));
        }
    }
}

struct Args { const float* in[25]; float* out; unsigned char* ws; int ph_lo, ph_hi; };
#define PH __device__ __forceinline__
constexpr int TAB_OFF = 131072;

__device__ __forceinline__ void transpose_item(const float* __restrict__ W, int K, int N, bf16* __restrict__ WT, int k0, int scol0, int drow0, float* scr, int lane) {
    const int cc = lane & 31; const bool cv = (scol0 + cc) < N;
#pragma unroll 8
    for (int i = 0; i < 32; ++i) { const int kk = 2 * i + (lane >> 5); scr[kk * 33 + cc] = cv ? W[(size_t)(k0 + kk) * N + scol0 + cc] : 0.f; }
    asm volatile("s_waitcnt lgkmcnt(0)" ::: "memory");
    const int c = lane & 7;
#pragma unroll
    for (int j = 0; j < 4; ++j) { const int n = (lane >> 3) + 8 * j; const float* s = scr + (8 * c) * 33 + n;
        uint4 o; o.x = pk2(s[0 * 33], s[1 * 33]); o.y = pk2(s[2 * 33], s[3 * 33]); o.z = pk2(s[4 * 33], s[5 * 33]); o.w = pk2(s[6 * 33], s[7 * 33]);
        *(uint4*)(WT + (size_t)(drow0 + n) * K + k0 + 8 * c) = o; }
    asm volatile("s_waitcnt lgkmcnt(0)" ::: "memory");
}
__device__ __forceinline__ void transpose64(const float* __restrict__ W, int K, int N, bf16* __restrict__ WT, int k0, int scol0, int drow0, int lane) {
    const int q = lane >> 4, c = lane & 15;
    const bool cv = (scol0 + 4 * c) < N;
    const float* src = W + (size_t)(k0 + 16 * q) * N + scol0 + 4 * c;
    float4 v[16];
#pragma unroll
    for (int i = 0; i < 16; ++i) v[i] = cv ? *(const float4*)(src + (size_t)i * N) : make_float4(0.f, 0.f, 0.f, 0.f);
    bf16* dst = WT + (size_t)(drow0 + 4 * c) * K + k0 + 16 * q;
#pragma unroll
    for (int j = 0; j < 4; ++j) {
        float e[16];
#pragma unroll
        for (int i = 0; i < 16; ++i) e[i] = (j == 0) ? v[i].x : (j == 1) ? v[i].y : (j == 2) ? v[i].z : v[i].w;
        uint4 o0, o1;
        o0.x = pk2(e[0], e[1]); o0.y = pk2(e[2], e[3]); o0.z = pk2(e[4], e[5]); o0.w = pk2(e[6], e[7]);
        o1.x = pk2(e[8], e[9]); o1.y = pk2(e[10], e[11]); o1.z = pk2(e[12], e[13]); o1.w = pk2(e[14], e[15]);
        *(uint4*)(dst + (size_t)j * K) = o0; *(uint4*)(dst + (size_t)j * K + 8) = o1;
    }
}
struct T64Item { const float* src; unsigned char* dst; };
__device__ __forceinline__ void t64_load(const float* src, int N, float4 (&v)[16]) {
#pragma unroll
    for (int i = 0; i < 16; ++i) { typedef float f4v __attribute__((ext_vector_type(4))); const f4v t = __builtin_nontemporal_load((const f4v*)(src + (size_t)i * N)); v[i] = make_float4(t.x, t.y, t.z, t.w); }
}
__device__ __forceinline__ unsigned pk4_fp8_nc(float a, float b, float c, float d) { int p = __builtin_amdgcn_cvt_pk_fp8_f32(a, b, 0, false); p = __builtin_amdgcn_cvt_pk_fp8_f32(c, d, p, true); return (unsigned)p; }
__device__ __forceinline__ void t64_store_f8(unsigned char* dst, int K, float sc, const float4 (&v)[16]) {
#pragma unroll
    for (int j = 0; j < 4; ++j) {
        float e[16];
#pragma unroll
        for (int i = 0; i < 16; ++i) e[i] = sc * ((j == 0) ? v[i].x : (j == 1) ? v[i].y : (j == 2) ? v[i].z : v[i].w);
        uint4 o;
        o.x = pk4_fp8_nc(e[0], e[1], e[2], e[3]); o.y = pk4_fp8_nc(e[4], e[5], e[6], e[7]); o.z = pk4_fp8_nc(e[8], e[9], e[10], e[11]); o.w = pk4_fp8_nc(e[12], e[13], e[14], e[15]);
        *(uint4*)(dst + (size_t)j * K) = o;
    }
}
__device__ __forceinline__ void t64_item(int it, const float* w_up, const float* w_dn, unsigned char* wt_up, unsigned char* wt_dn, int lane, const float*& src, unsigned char*& dst, int& N, float& sc) {
    constexpr int I_UP = 16 * 32, I_DN = 16 * 16;
    const int q = lane >> 4, c = lane & 15;
    if (it < NE * I_UP) { const int e = it / I_UP, r = it % I_UP, kb = r / 32, nb = r % 32;
        const int n0 = nb * 64, pn = n0 >> 8, bj = (n0 >> 7) & 1, jj = n0 & 127;
        src = w_up + (size_t)e * D_ * 2048 + (size_t)(kb * 64 + 16 * q) * 2048 + bj * 1024 + 128 * pn + jj + 4 * c;
        dst = wt_up + (size_t)e * 2048 * D_ + (size_t)(n0 + 4 * c) * D_ + kb * 64 + 16 * q; N = 2048; sc = pg8::F8_SU; }
    else { const int r0 = it - NE * I_UP; const int e = r0 / I_DN, r = r0 % I_DN, kb = r / 16, nb = r % 16;
        src = w_dn + (size_t)e * D_ * D_ + (size_t)(kb * 64 + 16 * q) * D_ + nb * 64 + 4 * c;
        dst = wt_dn + (size_t)e * D_ * D_ + (size_t)(nb * 64 + 4 * c) * D_ + kb * 64 + 16 * q; N = D_; sc = pg8::F8_SD; }
}
PH void ph_prologue(int wv, const int* pos, const float* hg_lb, float* cosT, float* sinT, float* lb,
                    const float* x, bf16* xb, const float* w_in, const float* w_out, const float* w_up, const float* w_dn, bf16* wt_in, bf16* wt_out, bf16* wt_up, bf16* wt_dn,
                    const float* gm_sw, bf16* wb, const float* cpe, const float* cw1, bf16* w1t, float* cbias, const float* cw2, bf16* w2t, const float* rw, bf16* rwh, bf16* rwl) {
    extern __shared__ __attribute__((aligned(16))) unsigned char lds[];
    int tid = mk_tid(wv), bid = blockIdx.x; asm volatile("" : "+v"(tid), "+s"(bid)); const int G = gridDim.x, lane = tid & 63, wave = wv;
#pragma unroll 1
    for (int i = bid * NTHR + tid; i < NT * 32; i += G * NTHR) {
        int t = i >> 5, j = i & 31;
        float inv = (float)pow(10000.0, -(double)(2 * j) / 64.0);
        float ang = (float)pos[t] * inv;
        const double ad = (double)ang, kk = rint(ad * 0.15915494309189535);
        const float rf = (float)fma(-kk, 6.283185307179586, ad);
        cosT[i] = cosf(rf); sinT[i] = sinf(rf);
    }
    if (bid == 0 && tid < 256) {
        float p0 = hg_lb[tid], p1 = hg_lb[256 + tid];
        float m = fmaxf(p0, p1); float ea = expf(p0 - m), eb = expf(p1 - m);
        lb[tid] = 0.f; lb[256 + tid] = eb / (ea + eb);
    }
#pragma unroll 1
    for (size_t i = (size_t)bid * NTHR + tid; i < (size_t)NT * D_ / 4; i += (size_t)G * NTHR) {
        float4 v = ((const float4*)x)[i]; ((uint2*)xb)[i] = make_uint2(pk2(v.x, v.y), pk2(v.z, v.w));
    }
#pragma unroll 1
    for (int i = bid * NTHR + tid; i < DEPTH * NE * D_; i += G * NTHR) { const int k = i & 1023, e = (i >> 10) & 31, l = i >> 15; const float w = rw[((size_t)l * D_ + k) * NE + e];
        const unsigned hi = f2bf(w); rwh[i] = (bf16)hi; rwl[i] = (bf16)f2bf(w - __uint_as_float(hi << 16)); }
#pragma unroll 1
    for (int i = bid * NTHR + tid; i < DEPTH * 4 * 128 * 128; i += G * NTHR) { const int s = i & 127, t = (i >> 7) & 127; wb[i] = (bf16)f2bf(s <= t ? gm_sw[i] : 0.f); }
    {
        const int gwv = bid * 8 + wave, NGWV = G * 8;
#pragma unroll 1
        for (int o = gwv; o < DEPTH * 2 * 128; o += NGWV) {
            const int lk = o >> 7, n = o & 127;
            float a = 0.f;
#pragma unroll 8
            for (int i = lane; i < 2048; i += 64) a = fmaf(cpe[lk * 2048 + i], cw1[((size_t)lk * 2048 + i) * 128 + n], a);
            a = wsum(a);
            if (lane == 0) cbias[o] = a;
        }
    }
    float* scr = (float*)(lds + wave * 16384);
    const int gw = bid * 8 + wave, NGW = G * 8;
    constexpr int I_IN = 16 * 45, I_OUT = 16 * 16;
    constexpr int I_C1 = 32 * 4;
    constexpr int I_C2 = 2 * 2;
    constexpr int PER_L = I_IN + I_OUT + 2 * I_C1 + 2 * I_C2;
#pragma unroll 1
    for (int it = gw; it < DEPTH * PER_L; it += NGW) {
        const int l = it / PER_L; int r = it % PER_L;
        if (r < I_IN) { const int kb = r / 45, nb = r % 45; transpose64(w_in + (size_t)l * D_ * INW, D_, INW, wt_in + (size_t)l * HS * D_, kb * 64, nb * 64, nb * 64, lane); continue; }
        r -= I_IN;
        if (r < I_OUT) { const int kb = r / 16, nb = r % 16; transpose64(w_out + (size_t)l * D_ * D_, D_, D_, wt_out + (size_t)l * D_ * D_, kb * 64, nb * 64, nb * 64, lane); continue; }
        r -= I_OUT;
        if (r < 2 * I_C1) { const int kv = r / I_C1, q = r % I_C1, kb = q / 4, nb = q % 4;
            transpose_item(cw1 + ((size_t)l * 2 + kv) * 2048 * 128, 2048, 128, w1t + ((size_t)l * 2 + kv) * 128 * 2048, kb * 64, nb * 32, nb * 32, scr, lane); continue; }
        r -= 2 * I_C1;
        { const int kv = r / I_C2, q = r % I_C2, kb = q / 2, nb = q % 2;
            transpose_item(cw2 + ((size_t)l * 2 + kv) * 128 * 64, 128, 64, w2t + ((size_t)l * 2 + kv) * 64 * 128, kb * 64, nb * 32, nb * 32, scr, lane); }
    }
}
#define M1EN(x) 1
#ifndef M1REP
#define M1R(x) 1
#else
#define M1R(x) (((x) == M1REP) ? 3 : 1)
#endif
PH void ph_mix1(int wv, const bf16* hb, const float* lb, bf16* hqt, bf16* hkt, bf16* hqp, bf16* hvt, float* hut, float* hdk,
                const float* glw, const float* glb, bf16* vlnT, const bf16* w1t, const float* cbias, const bf16* w2, bf16* kcb, bf16* vcb,
                const float* cosT, const float* sinT, bf16* ksb, bf16* vsb, bf16* kwb, bf16* vwb,
                const float* w_up, const float* w_dn, unsigned char* wt_up, unsigned char* wt_dn) {
    extern __shared__ __attribute__((aligned(16))) unsigned char lds[];
    int tid = mk_tid(wv), bid = blockIdx.x; asm volatile("" : "+v"(tid), "+s"(bid)); const int lane = tid & 63, wave = wv, G = gridDim.x;
    const int gw = bid * 8 + wave, NGW = G * 8;
    { int ln = lane; asm volatile("" : "+v"(ln));
#pragma unroll 1
    for (int rp = 0; rp < M1R(1); ++rp)
#pragma unroll 1
    for (int u = bid; u < 256 && M1EN(1); u += G) wt::cmp_wg(hb, w1t, cbias, w2, kcb, vcb, (WT_LAS float*)lds, u, wave, ln); }
#pragma unroll 1
    for (int pass = 0; pass < 2; ++pass) {
        if (((pass ^ wave) & 1) == 0) {
            { int ln = lane; asm volatile("" : "+v"(ln));
#pragma unroll 1
            for (int rp = 0; rp < M1R(2); ++rp)
#pragma unroll 1
            for (int u = gw; u < 2048 && M1EN(2); u += NGW) wt::hg_pass1(hb, lb, hqt, hkt, hqp, hvt, hut, hdk, u, ln); }
            { int ln = lane; asm volatile("" : "+v"(ln));
#pragma unroll 1
            for (int rp = 0; rp < M1R(4); ++rp)
#pragma unroll 1
            for (int u = gw; u < NT / 8 && M1EN(4); u += NGW) wt::gm_ln8(hb, glw, glb, vlnT, u, ln); }
            { int t_ = tid; asm volatile("" : "+v"(t_));
#pragma unroll 1
            for (int rp = 0; rp < M1R(8); ++rp)
#pragma unroll 1
            for (int idx = bid * NTHR + t_; idx < NT * 8; idx += G * NTHR) wt::kvprep8(hb, cosT, sinT, ksb, vsb, kwb, vwb, idx); }
        } else {
            int ln = lane; asm volatile("" : "+v"(ln));
            constexpr int NIT = NE * (16 * 32 + 16 * 16);
#pragma unroll 1
            for (int rp = 0; rp < M1R(16); ++rp)
#pragma unroll 1
            for (int it = gw; it < NIT; it += NGW) {
                float4 va[16]; const float* s0; unsigned char* d0; int n0_; float c0_;
                t64_item(it, w_up, w_dn, wt_up, wt_dn, ln, s0, d0, n0_, c0_); t64_load(s0, n0_, va); t64_store_f8(d0, D_, c0_, va);
            }
        }
    }
}
PH void ph_mix2(int wv, const float* hut, const float* hdk, bf16* hst, const bf16* hb, const bf16* vlnT, const bf16* wb, const float* sb, const float* nw, bf16* ycat) {
    int tid = mk_tid(wv), bid = blockIdx.x; asm volatile("" : "+v"(tid), "+s"(bid)); const int lane = tid & 63, wave = wv, G = gridDim.x;
#pragma unroll 1
    for (int e = bid * NTHR + tid; e < 32 * 4096; e += G * NTHR) wt::hg_scan(hut, hdk, hst, e);
    const int gw = bid * 8 + wave, NGW = G * 8;
#pragma unroll 1
    for (int u = gw; u < 4096; u += NGW) wt::gm_sp_task(hb, vlnT, wb, sb, nw, ycat, u, lane);
}
PH void ph_hg3(int wv, const bf16* hb, const bf16* hqt, const bf16* hkt, const bf16* hqp, const bf16* hvt, const bf16* hst, const float* nw, bf16* ycat) {
    int tid = mk_tid(wv), bid = blockIdx.x; asm volatile("" : "+v"(tid), "+s"(bid)); const int lane = tid & 63, wave = wv, G = gridDim.x;
    const int gw = bid * 8 + wave, NGW = G * 8;
#pragma unroll 1
    for (int u = gw; u < 4096; u += NGW) wt::hg_pass3(hb, hqt, hkt, hqp, hvt, hst, nw, ycat, u, lane);
}
PH void ph_ln1(int wv, const float* xin_f, const bf16* xin_b, const bf16* mix, const float* lw, const float* lb, bf16* x1b, unsigned char* x1q) {
    int tid = mk_tid(wv), bid = blockIdx.x; asm volatile("" : "+v"(tid), "+s"(bid)); const int lane = tid & 63, wave = wv, G = gridDim.x;
#pragma unroll 1
    for (int t = (bid * 8 + wave) * 2; t < NT; t += G * 16) ln1_tok2(xin_f, xin_b, mix, lw, lb, x1b, x1q, t, lane);
}
PH void ph_route(int wv, const bf16* x1, const bf16* rwh, const bf16* rwl, const float* rb, int* cnt, int* list, int* tok_e, int* tok_slot, float* tok_w) {
    int tid = mk_tid(wv), bid = blockIdx.x; asm volatile("" : "+v"(tid), "+s"(bid)); const int lane = tid & 63, wave = wv, G = gridDim.x;
#pragma unroll 1
    for (int u = bid * 8 + wave; u < NT / 32; u += G * 8) wt::route_task(x1, rwh, rwl, rb, cnt, list, tok_e, tok_slot, tok_w, u, lane);
}
PH void ph_comb(int wv, const bf16* x1, const bf16* ybuf, const int* tok_e, const int* tok_slot, const float* tok_w, const float* lw, const float* lb, float* xo, bf16* xbo) {
    extern __shared__ __attribute__((aligned(16))) unsigned char lds[];
    const int* offs_s = (const int*)(lds + TAB_OFF + 512);
    int tid = mk_tid(wv), bid = blockIdx.x; asm volatile("" : "+v"(tid), "+s"(bid)); const int lane = tid & 63, wave = wv, G = gridDim.x;
#pragma unroll 1
    for (int t = (bid * 8 + wave) * 2; t < NT; t += G * 16) comb_ln2_tok2(x1, ybuf, offs_s, tok_e, tok_slot, tok_w, lw, lb, xo, xbo, t, lane);
}

typedef const Args __attribute__((address_space(4))) CArgs;
#define PHASE_BEGIN CArgs* ap = (CArgs*)__builtin_amdgcn_kernarg_segment_ptr(); int l_ = l; asm volatile("" : "+s"(ap), "+s"(l_)); unsigned char* const ws_ = ap->ws; \
    const int G = gridDim.x; int bid = blockIdx.x; asm volatile("" : "+s"(bid));
#define WP(T, off) ((T*)(ws_ + (off)))
#define INP(k) (ap->in[k])
__global__ void __launch_bounds__(NTHR, 2) mega(Args a) {
    extern __shared__ __attribute__((aligned(16))) unsigned char lds[];
    volatile LAS unsigned* MISC = (volatile LAS unsigned*)((LAS unsigned char*)lds + MISC_OFF);
    int wv = __builtin_amdgcn_readfirstlane((int)threadIdx.x >> 6); asm volatile("" : "+s"(wv));
    { const int t0 = mk_tid(wv); if (t0 < 64) MISC[t0] = 0u; }
    __syncthreads();
    XcdBarrier bar = xcd_barrier_post((unsigned*)a.ws, MISC + 8, wv);
    int* tstart = (int*)(lds + TAB_OFF); int* cnts = (int*)(lds + TAB_OFF + 256); int* offs_s = (int*)(lds + TAB_OFF + 512);
    PG8_LAS unsigned char* ldsl = (PG8_LAS unsigned char*)lds;

#ifndef PH_MASK
#define EN(n) 1
#else
#define EN(n) ((PH_MASK >> ((n) % 20)) & 1)
#endif
#define IN(k) 1
#ifndef REP_PH
#define REPL(id)
#else
#define REPL(id) _Pragma("unroll 1") for (int rep_ = 0; rep_ < (((id) == REP_PH) ? REP_N : 1); ++rep_)
#endif
#define SEAM(k) xcd_barrier(bar)

    REPL(19) if (EN(19) && IN(0)) { const int l = 0; PHASE_BEGIN; (void)l_; (void)G; (void)bid;
        ph_prologue(wv, (const int*)INP(1), INP(3), WP(float, O_COS), WP(float, O_SIN), WP(float, O_LB), INP(0), WP(bf16, O_XB), INP(2), INP(14), INP(19), INP(21),
                    WP(bf16, O_WIN), WP(bf16, O_WOUT), WP(bf16, O_WUP), WP(bf16, O_WDN), INP(7), WP(bf16, O_WB), INP(10), INP(11), WP(bf16, O_W1T), WP(float, O_CBIAS), INP(12), WP(bf16, O_W2T), INP(17), WP(bf16, O_RWH), WP(bf16, O_RWL)); }
    xcd_barrier_first(bar);

#pragma unroll 1
    for (int l = 0; l < DEPTH; ++l) {
        REPL(0) if (EN(0) && IN(pb + 0)) {
            PHASE_BEGIN;
            pg8::PlainOrder S{WP(bf16, O_WIN) + (size_t)l_ * HS * D_, D_, NT / 256, HS / 256, G, bid};
            pg8::EpiBf16 E{WP(bf16, O_HB), HS, nullptr, 0};
            pg8::gemm_phase<pg8::EpiBf16, pg8::PlainOrder, true>(wv, ldsl, WP(bf16, O_XB), D_ * 2, S, E);
#ifdef DUP_WIN
            pg8::gemm_phase<pg8::EpiBf16, pg8::PlainOrder, true>(wv, ldsl, WP(bf16, O_XB), D_ * 2, S, E);
#endif
        }
        SEAM(pb + 0);
        REPL(1) if (EN(1)) {
            PHASE_BEGIN; (void)G; (void)bid;
            ph_mix1(wv, WP(bf16, O_HB), WP(float, O_LB) + l_ * 256, WP(bf16, O_HQT), WP(bf16, O_HKT), WP(bf16, O_HQP), WP(bf16, O_HVT), WP(float, O_HUT), WP(float, O_HDK),
                    INP(5) + l_ * 256, INP(6) + l_ * 256, WP(bf16, O_VLNT), WP(bf16, O_W1T) + (size_t)l_ * 2 * 128 * 2048, WP(float, O_CBIAS) + l_ * 256, WP(bf16, O_W2T) + (size_t)l_ * 2 * 64 * 128,
                    WP(bf16, O_KCB), WP(bf16, O_VCB), WP(float, O_COS), WP(float, O_SIN), WP(bf16, O_KSB), WP(bf16, O_VSB), WP(bf16, O_KWB), WP(bf16, O_VWB),
                    INP(19) + (size_t)l_ * NE * D_ * 2048, INP(21) + (size_t)l_ * NE * D_ * D_, WP(unsigned char, O_WUP) + (size_t)l_ * NE * 2048 * D_, WP(unsigned char, O_WDN) + (size_t)l_ * NE * D_ * D_);
        }
        SEAM(pb + 1);
        REPL(11) if (EN(11)) {
            PHASE_BEGIN; (void)G; (void)bid;
            ph_mix2(wv, WP(float, O_HUT), WP(float, O_HDK), WP(bf16, O_HST), WP(bf16, O_HB), WP(bf16, O_VLNT), WP(bf16, O_WB) + (size_t)l_ * 4 * 128 * 128, INP(8) + l_ * 512, INP(9) + l_ * 256, WP(bf16, O_YCAT));
        }
        SEAM(pb + 1);
        {
            PHASE_BEGIN;
            REPL(2) if (EN(2)) ph_hg3(wv, WP(bf16, O_HB), WP(bf16, O_HQT), WP(bf16, O_HKT), WP(bf16, O_HQP), WP(bf16, O_HVT), WP(bf16, O_HST), INP(4) + l_ * 256, WP(bf16, O_YCAT));
            REPL(12) if (EN(12)) {
                nsa::Params NP{WP(bf16, O_HB), WP(bf16, O_KCB), WP(bf16, O_VCB), WP(bf16, O_KSB), WP(bf16, O_VSB), WP(bf16, O_KWB), WP(bf16, O_VWB), WP(float, O_COS), WP(float, O_SIN), INP(13) + l_ * 512, WP(bf16, O_YCAT)};
                int tid = mk_tid(wv); asm volatile("" : "+v"(tid));
                __syncthreads();
                nsa::phase(NP, ldsl, tid, bid, G);
            }
        }
        SEAM(pb + 2);
        REPL(3) if (EN(3) && IN(pb + 3)) {
            PHASE_BEGIN;
            pg8::PlainOrder S{WP(bf16, O_WOUT) + (size_t)l_ * D_ * D_, D_, NT / 256, D_ / 256, G, bid};
            pg8::EpiBf16 E{WP(bf16, O_MIXB), D_, nullptr, 0};
            pg8::gemm_phase<pg8::EpiBf16, pg8::PlainOrder, true>(wv, ldsl, WP(bf16, O_YCAT), D_ * 2, S, E);
#ifdef DUP_WOUT
            pg8::gemm_phase<pg8::EpiBf16, pg8::PlainOrder, true>(wv, ldsl, WP(bf16, O_YCAT), D_ * 2, S, E);
#endif
        }
        SEAM(pb + 3);
        REPL(4) if (EN(4)) {
            PHASE_BEGIN; (void)G; (void)bid;
            ph_ln1(wv, l_ == 0 ? INP(0) : (const float*)nullptr, WP(bf16, O_XB), WP(bf16, O_MIXB), INP(15) + l_ * D_, INP(16) + l_ * D_, WP(bf16, O_X1B), WP(unsigned char, O_X1Q));
        }
        SEAM(pb + 4);
        if (EN(14)) {
            PHASE_BEGIN; (void)G; (void)bid;
#ifdef DUP_ROUTE
#pragma unroll 1
            for (int rr_ = 0; rr_ < 2; ++rr_)
            ph_route(wv, WP(bf16, O_X1B), WP(bf16, O_RWH) + (size_t)l_ * NE * D_, WP(bf16, O_RWL) + (size_t)l_ * NE * D_, INP(18) + l_ * NE,
                     (int*)(ws_ + 36864) + (l_ * 2 + rr_) * 64, WP(int, O_HUT), WP(int, O_HUT) + 2 * 1048576, WP(int, O_HUT) + 3 * 1048576, WP(float, O_HUT) + 4 * 1048576);
#endif
            ph_route(wv, WP(bf16, O_X1B), WP(bf16, O_RWH) + (size_t)l_ * NE * D_, WP(bf16, O_RWL) + (size_t)l_ * NE * D_, INP(18) + l_ * NE,
                     (int*)(ws_ + 32768) + l_ * 64, WP(int, O_LIST), WP(int, O_TE), WP(int, O_TS), WP(float, O_TW));
        }
        SEAM(pb + 4);
        if (IN(pb + 5) || IN(pb + 6) || IN(pb + 7)) {
            PHASE_BEGIN; (void)G; (void)bid;
            int* cnt = (int*)(ws_ + 32768) + l_ * 64;
            __syncthreads();
            if (wv == 0) {
                const int ln = mk_tid(wv) & 63, e = ln & 31;
                const int c = __hip_atomic_load(&cnt[e], __ATOMIC_RELAXED, __HIP_MEMORY_SCOPE_AGENT);
                const int nt_ = (c + 255) >> 8; int incl = nt_;
#pragma unroll
                for (int o = 1; o < 32; o <<= 1) { const int v = __shfl_up(incl, o, 32); if (e >= o) incl += v; }
                if (ln < 32) { tstart[e] = incl - nt_; offs_s[e] = (incl - nt_) * 256; cnts[e] = c; if (e == 31) tstart[32] = incl; }
            }
            __syncthreads();
        }
        REPL(5) if (EN(5) && IN(pb + 5)) {
            PHASE_BEGIN;
            pg8::MoeOrder<true> S{WP(unsigned char, O_WUP) + (size_t)l_ * NE * 2048 * D_, D_, 8, G, bid, (size_t)2048 * D_, tstart, cnts, WP(int, O_LIST)};
            pg8::EpiUpF8 E{WP(unsigned char, O_ACT), INP(20) + (size_t)l_ * NE * 2048};
            pg8::gemm_phase<pg8::EpiUpF8, pg8::MoeOrder<true>, true, true>(wv, ldsl, WP(unsigned char, O_X1Q), D_, S, E);
        }
        SEAM(pb + 5);
        REPL(6) if (EN(6) && IN(pb + 6)) {
            PHASE_BEGIN;
            pg8::MoeOrder<false> S{WP(unsigned char, O_WDN) + (size_t)l_ * NE * D_ * D_, D_, 4, G, bid, (size_t)D_ * D_, tstart, cnts, WP(int, O_LIST)};
            pg8::EpiDnF8 E{WP(bf16, O_YB), INP(22) + (size_t)l_ * NE * D_};
            pg8::gemm_phase<pg8::EpiDnF8, pg8::MoeOrder<false>, true, true>(wv, ldsl, WP(unsigned char, O_ACT), D_, S, E);
        }
        SEAM(pb + 6);
        REPL(7) if (EN(7) && IN(pb + 7)) {
            PHASE_BEGIN; (void)G; (void)bid;
            ph_comb(wv, WP(bf16, O_X1B), WP(bf16, O_YB), WP(int, O_TE), WP(int, O_TS), WP(float, O_TW), INP(23) + l_ * D_, INP(24) + l_ * D_,
                    (l_ == DEPTH - 1) ? ap->out : (float*)nullptr, (l_ == DEPTH - 1) ? (bf16*)nullptr : WP(bf16, O_XB));
        }
#ifdef XTRA_BAR
#pragma unroll 1
        for (int xb_ = 0; xb_ < XTRA_BAR; ++xb_) SEAM(pb + 7);
#endif
        if (l + 1 < DEPTH) SEAM(pb + 7);
    }
#undef IN
#undef SEAM
}
}

extern "C" void kernel_launch(void* const* d_in, const int* in_sizes, int n_in, void* d_out, int out_size, void* d_ws, size_t ws_size, hipStream_t stream) {
    using namespace mk;
    static int grid = 0;
    if (grid == 0) {
        size_t need = WS_NEED;
        if (n_in != 25 || need > ws_size) { fprintf(stderr, "kernel_launch: bad args n_in %d need %zu ws %zu\n", n_in, need, ws_size); grid = -1; return; }
        int dev = 0, cus = 0, per_cu = 0;
        if (hipGetDevice(&dev) != hipSuccess || hipDeviceGetAttribute(&cus, hipDeviceAttributeMultiprocessorCount, dev) != hipSuccess) { grid = -1; return; }
        if (hipFuncSetAttribute((const void*)mega, hipFuncAttributeMaxDynamicSharedMemorySize, LDS_BYTES) != hipSuccess) { fprintf(stderr, "hipFuncSetAttribute failed\n"); grid = -1; return; }
        if (hipOccupancyMaxActiveBlocksPerMultiprocessor(&per_cu, (const void*)mega, NTHR, LDS_BYTES) != hipSuccess || per_cu < 1) fprintf(stderr, "occupancy query: %d\n", per_cu);
        (void)hipGetLastError();
        grid = cus;
    }
    if (grid < 0) return;
    if (hipMemsetAsync(d_ws, 0, CTL_BYTES, stream) != hipSuccess) return;
    Args a{};
    for (int i = 0; i < 25; ++i) a.in[i] = (const float*)d_in[i];
    a.out = (float*)d_out; a.ws = (unsigned char*)d_ws; a.ph_lo = 0; a.ph_hi = 1 + DEPTH * NPH;
    hipLaunchKernelGGL(mega, dim3(grid), dim3(NTHR), LDS_BYTES, stream, a);
}
```

```cpp
#include <hip/hip_runtime.h>
#include <cstdio>
#include <cstdint>
#include <cmath>

__device__ __forceinline__ int mk_tid(int wv) { int lane; asm volatile("v_mbcnt_lo_u32_b32 %0, -1, 0\n\tv_mbcnt_hi_u32_b32 %0, -1, %0" : "=v"(lane)); return (wv << 6) | lane; }
#define XB_TMO      128
#define XB_XCNT(j)  (256  + 64 * (j))
#define XB_XSUB(j)  (1280 + 64 * (j))
#define XB_XGEN(j)  (2304 + 64 * (j))
#define XB_TOP      3328
#define XB_TOPGEN   3392
#define XCD_BAR_WORDS 3456
#define XB_SPIN_CAP (1u << 18)
#define LAS __attribute__((address_space(3)))

__device__ __forceinline__ unsigned xb_ld(unsigned* p)              { return __hip_atomic_load(p, __ATOMIC_RELAXED, __HIP_MEMORY_SCOPE_AGENT); }
__device__ __forceinline__ unsigned xb_add(unsigned* p, unsigned v) { return __hip_atomic_fetch_add(p, v, __ATOMIC_RELAXED, __HIP_MEMORY_SCOPE_AGENT); }
__device__ __forceinline__ unsigned xb_xcc_id() { return (unsigned)__builtin_amdgcn_s_getreg((3 << 11) | 20) & 0xFu; }
#define XB_SPIN(cond, bar) do { unsigned _sp = 0; while (cond) { __builtin_amdgcn_s_sleep(1); \
    if ((++_sp & 255u) == 0u) { if (xb_ld(&(bar)[XB_TMO])) break; if (_sp > XB_SPIN_CAP) { atomicAdd(&(bar)[XB_TMO], 1u); break; } } } } while (0)

struct XcdBarrier {
    unsigned* bar; unsigned x;
    volatile LAS unsigned* st; int wv;
};

__device__ __forceinline__ XcdBarrier xcd_barrier_post(unsigned* bar, volatile LAS unsigned* st, int wv) {
    XcdBarrier b; b.bar = bar; b.x = xb_xcc_id(); b.st = st; b.wv = wv;
    if (mk_tid(b.wv) == 0) (void)xb_add(&bar[XB_XCNT(b.x)], 1u);
    return b;
}
__device__ __forceinline__ void xcd_barrier_complete(unsigned* bar, unsigned x, unsigned& nloc, unsigned& nx) {
    const unsigned G = gridDim.x * gridDim.y * gridDim.z;
    unsigned sum, cnt, mine, sp = 0u;
    for (;;) {
        sum = 0u; cnt = 0u; mine = 0u;
#pragma unroll
        for (unsigned j = 0; j < 16; ++j) { const unsigned c = xb_ld(&bar[XB_XCNT(j)]); sum += c; cnt += (c > 0u) ? 1u : 0u; mine = (j == x) ? c : mine; }
        if (sum == G) break;
        __builtin_amdgcn_s_sleep(1);
        if ((++sp & 255u) == 0u) { if (xb_ld(&bar[XB_TMO])) break; if (sp > XB_SPIN_CAP) { atomicAdd(&bar[XB_TMO], 1u); break; } }
    }
    nloc = mine > 0u ? mine : 1u; nx = cnt > 0u ? cnt : 1u;
}

template <bool FIRST>
__device__ __forceinline__ void xcd_barrier_t(const XcdBarrier& b) {
    asm volatile("s_waitcnt vmcnt(0)" ::: "memory");
    __syncthreads();
    if (mk_tid(b.wv) == 0) {
        unsigned* bar = b.bar; unsigned bx = b.x; asm volatile("" : "+s"(bar), "+s"(bx));
        __builtin_amdgcn_s_waitcnt(0);
        unsigned nloc = b.st[0], nx = b.st[1];
        if (FIRST) { if (nloc == 0u) { xcd_barrier_complete(bar, bx, nloc, nx); b.st[0] = nloc; b.st[1] = nx; } }
        const unsigned old = xb_add(&bar[XB_XSUB(bx)], 1u);
        const unsigned gen = old / nloc;
        if (old + 1u == (gen + 1u) * nloc) {
            __builtin_amdgcn_fence(__ATOMIC_RELEASE, "agent");
            asm volatile("s_waitcnt vmcnt(0)" ::: "memory");
            const unsigned og = xb_add(&bar[XB_TOP], 1u);
            const unsigned tg = og / nx;
            if (og + 1u == (tg + 1u) * nx) xb_add(&bar[XB_TOPGEN], 1u);
            else XB_SPIN(xb_ld(&bar[XB_TOPGEN]) == tg, bar);
            __builtin_amdgcn_fence(__ATOMIC_ACQUIRE, "agent");
            xb_add(&bar[XB_XGEN(bx)], 1u);
            asm volatile("s_waitcnt vmcnt(0)" ::: "memory");
        } else {
            XB_SPIN(xb_ld(&bar[XB_XGEN(bx)]) == gen, bar);
            __builtin_amdgcn_fence(__ATOMIC_ACQUIRE, "agent");
            asm volatile("s_waitcnt vmcnt(0)" ::: "memory");
        }
    }
    __syncthreads();
}


__device__ __forceinline__ void xcd_barrier_first(const XcdBarrier& b) { xcd_barrier_t<true>(b); }
__device__ __forceinline__ void xcd_barrier(const XcdBarrier& b) { xcd_barrier_t<false>(b); }


namespace mk {
constexpr int B_ = 8, S_ = 4096, D_ = 1024, NT = B_ * S_, DEPTH = 2;
constexpr int INW = 2840, HS = 3072;
constexpr int C_HGQ = 0, C_HGF = 256, C_HGI = 512, C_HGG = 768, C_GMU = 1024, C_GMV = 1280, C_NQ = 1536,
              C_KC = 2048, C_VC = 2176, C_KS = 2304, C_VS = 2432, C_KW = 2560, C_VW = 2688, C_NG = 2816;
constexpr int NCMP = 255, NE = 32, TOPK = 4, NASSIGN = NT * TOPK;
constexpr float ALPHA = 1.4142135623730951f;
constexpr int NTHR = 512, LDS_BYTES = 147456, MISC_OFF = 144 * 1024 - 256;
constexpr int NPH = 8;

typedef unsigned short bf16;
__device__ __forceinline__ float bf2f(bf16 v) { return __uint_as_float((unsigned)v << 16); }
__device__ __forceinline__ unsigned f2bf(float f) { unsigned u = __float_as_uint(f); return (u + 0x7fffu + ((u >> 16) & 1u)) >> 16; }
__device__ __forceinline__ unsigned pk2(float lo, float hi) { return f2bf(lo) | (f2bf(hi) << 16); }
__device__ __forceinline__ float gelu_t(float x) { return 0.5f * x * (1.0f + tanhf(0.7978845608028654f * (x + 0.044715f * x * x * x))); }
__device__ __forceinline__ float sigm(float x) { return 1.0f / (1.0f + expf(-x)); }
__device__ __forceinline__ float wsum(float v) {
#pragma unroll
    for (int o = 1; o < 64; o <<= 1) v += __shfl_xor(v, o);
    return v;
}
__device__ __forceinline__ float wmax(float v) {
#pragma unroll
    for (int o = 1; o < 64; o <<= 1) v = fmaxf(v, __shfl_xor(v, o));
    return v;
}

constexpr int MROWS = NASSIGN + NE * 256;
constexpr size_t CTL_BYTES = 65536;
constexpr size_t al256(size_t x) { return (x + 255) & ~(size_t)255; }
constexpr size_t O_COS = CTL_BYTES, O_SIN = O_COS + al256((size_t)NT * 32 * 4), O_LB = O_SIN + al256((size_t)NT * 32 * 4);
constexpr size_t O_WIN = O_LB + al256(512 * 4), O_WOUT = O_WIN + al256((size_t)DEPTH * HS * D_ * 2), O_WUP = O_WOUT + al256((size_t)DEPTH * D_ * D_ * 2);
constexpr size_t O_WDN = O_WUP + al256((size_t)DEPTH * NE * 2048 * D_ * 2), O_XB = O_WDN + al256((size_t)DEPTH * NE * D_ * D_ * 2);
constexpr size_t O_HB = O_XB + al256((size_t)NT * D_ * 2), O_YCAT = O_HB + al256((size_t)NT * HS * 2), O_MIXB = O_YCAT + al256((size_t)NT * D_ * 2);
constexpr size_t O_X1B = O_MIXB + al256((size_t)NT * D_ * 2), O_ACT = O_X1B + al256((size_t)NT * D_ * 2), O_YB = O_ACT + al256((size_t)MROWS * D_ * 2);
constexpr size_t O_X1Q = O_YB + al256((size_t)MROWS * D_ * 2), O_XA = O_X1Q + al256((size_t)NT * D_ * 4);
constexpr size_t O_VLNT = O_XA + al256((size_t)NT * D_ * 4), O_WB = O_VLNT + al256((size_t)NT * 256 * 2), O_W1T = O_WB + al256((size_t)DEPTH * 4 * 128 * 128 * 2);
constexpr size_t O_CBIAS = O_W1T + al256((size_t)DEPTH * 2 * 128 * 2048 * 2), O_W2T = O_CBIAS + al256((size_t)DEPTH * 2 * 128 * 4), O_RWH = O_W2T + al256((size_t)DEPTH * 2 * 64 * 128 * 2), O_RWL = O_RWH + al256((size_t)DEPTH * NE * D_ * 2), O_HQT = O_RWL + al256((size_t)DEPTH * NE * D_ * 2);
constexpr size_t HGB = (size_t)2048 * 4096 * 2;
constexpr size_t O_HKT = O_HQT + HGB, O_HQP = O_HKT + HGB, O_HVT = O_HQP + HGB, O_HST = O_HVT + HGB, O_HUT = O_HST + HGB, O_HDK = O_HUT + 2 * HGB;
constexpr size_t O_KSB = O_HDK + al256((size_t)2048 * 64 * 4), O_VSB = O_KSB + al256((size_t)NT * 128 * 2);
constexpr size_t O_KWB = O_VSB + al256((size_t)NT * 128 * 2), O_VWB = O_KWB + al256((size_t)NT * 128 * 2), O_KCB = O_VWB + al256((size_t)NT * 128 * 2), O_VCB = O_KCB + al256((size_t)B_ * 2 * 256 * 64 * 2);
constexpr size_t O_LIST = O_VCB + al256((size_t)B_ * 2 * 256 * 64 * 2), O_TE = O_LIST + al256((size_t)NE * NT * 4), O_TS = O_TE + al256((size_t)NASSIGN * 4), O_TW = O_TS + al256((size_t)NASSIGN * 4);
constexpr size_t WS_NEED = O_TW + al256((size_t)NASSIGN * 4);
namespace pg8 {
#define PG8_LAS __attribute__((address_space(3)))
typedef unsigned short bf16_t;
typedef short bf16x8 __attribute__((ext_vector_type(8)));
typedef float f32x4 __attribute__((ext_vector_type(4)));
typedef float f32x2 __attribute__((ext_vector_type(2)));
typedef unsigned u32x4 __attribute__((ext_vector_type(4)));
constexpr int BM = 256, BK = 64, HALF = 128, HTB = HALF * BK * 2  , STAGE_BYTES = 8 * HTB, NXCD = 8, WGM = 8;

__host__ __device__ __forceinline__ int lds_byte(int r, int c) { const int st = (r >> 4) * 2 + (c >> 5), rr = r & 15, cc = c & 31, ob = rr * 64 + cc * 2; return st * 1024 + (ob ^ (((ob >> 9) & 1) << 5)); }
__host__ __device__ __forceinline__ void stage_rc(int b, int& R, int& C) { const int st = b / 1024, sb = b % 1024, swz = sb ^ (((sb >> 9) & 1) << 5); R = (st >> 1) * 16 + swz / 64; C = (st & 1) * 32 + (swz % 64) / 2; }
__host__ __device__ __forceinline__ int perm32(int rho) { const int n = rho >> 4, i = rho & 15; return 8 * (i >> 2) + 4 * n + (i & 3); }

struct Unit { int pm, pn, e, mt, cnt; };

__device__ __forceinline__ void deal(int L, int nM, int nN, int& pm, int& pn) {
    const int nwg = nM * nN;
    int wgid = L; { const int q = nwg / NXCD, r = nwg % NXCD, xcd = wgid % NXCD, off = wgid / NXCD; wgid = (xcd < r ? xcd * (q + 1) : r * (q + 1) + (xcd - r) * q) + off; }
    const int nig = WGM * nN, gid = wgid / nig, fm = gid * WGM, gsz = (nM - fm) < WGM ? (nM - fm) : WGM;
    pm = fm + ((wgid % nig) % gsz); pn = (wgid % nig) / gsz;
}
struct PlainOrder {
    static constexpr bool GATHERED = false;
    const bf16_t* Bt; int K; int nM, nN, G, c;
    __device__ __forceinline__ bool next(int i, Unit& u) const { const long L = (long)i * G + c; if (L >= (long)nM * nN) return false; deal((int)L, nM, nN, u.pm, u.pn); u.e = 0; u.mt = 0; u.cnt = 0; return true; }
    __device__ __forceinline__ unsigned a_row(const Unit& u, int r) const { return (unsigned)(u.pm * BM + r); }
    __device__ __forceinline__ const char* b_base(const Unit& u) const { return (const char*)Bt + (size_t)u.pn * BM * K * 2; }
};
template <bool GATHER> struct MoeOrder {
    static constexpr bool GATHERED = GATHER;
    const void* Bt; int rowb; int nN, G, c; size_t estrideb;
    const int* tstart; const int* cnts; const int* list;
    __device__ __forceinline__ bool next(int i, Unit& u) const {
        const int nM = tstart[32]; const long L = (long)i * G + c; if (L >= (long)nM * nN) return false;
        deal((int)L, nM, nN, u.pm, u.pn);
        const int ln = (int)__builtin_amdgcn_mbcnt_hi(~0u, __builtin_amdgcn_mbcnt_lo(~0u, 0u));
        const int ts = tstart[ln & 31];
        const int e = __popcll(__ballot(ln < 32 && ts <= u.pm)) - 1;
        u.e = e; u.mt = u.pm - tstart[e]; u.cnt = cnts[e]; return true;
    }
    __device__ __forceinline__ unsigned a_row(const Unit& u, int r) const {
        if (GATHER) { const int slot = u.mt * BM + r; return (unsigned)list[u.e * 32768 + (slot < u.cnt ? slot : u.cnt - 1)]; }
        return (unsigned)(u.pm * BM + r);
    }
    __device__ __forceinline__ const char* b_base(const Unit& u) const { return (const char*)Bt + (size_t)u.e * estrideb + (size_t)u.pn * BM * rowb; }
};

__device__ __forceinline__ unsigned cvt_pk_bf16(float lo, float hi) { unsigned r; asm volatile("v_cvt_pk_bf16_f32 %0, %1, %2" : "=v"(r) : "v"(lo), "v"(hi)); return r; }

struct EpiBf16 {
    static constexpr bool PERM = true;
    bf16_t* O; int ldc; const float* bias; int bstride;
    __device__ __forceinline__ void operator()(const f32x4 (&acc)[2][2][4][2], const Unit& u, int wr, int wc, int fr, int fq) const {
        const int row0 = u.pm * BM + wr * 64 + fr; const int col0 = u.pn * BM + wc * 32 + 8 * fq;
        f32x4 bv[2][2];
#pragma unroll
        for (int bj = 0; bj < 2; ++bj)
#pragma unroll
            for (int n = 0; n < 2; ++n) bv[bj][n] = bias ? *(const f32x4*)(bias + (size_t)u.e * bstride + col0 + bj * HALF + 4 * n) : (f32x4){0.f, 0.f, 0.f, 0.f};
#pragma unroll
        for (int ai = 0; ai < 2; ++ai)
#pragma unroll
            for (int m = 0; m < 4; ++m) { bf16_t* rowp = O + (size_t)(row0 + ai * HALF + m * 16) * ldc + col0;
#pragma unroll
                for (int bj = 0; bj < 2; ++bj) { f32x4 v0 = acc[ai][bj][m][0] + bv[bj][0], v1 = acc[ai][bj][m][1] + bv[bj][1];
                    u32x4 w; w.x = cvt_pk_bf16(v0[0], v0[1]); w.y = cvt_pk_bf16(v0[2], v0[3]); w.z = cvt_pk_bf16(v1[0], v1[1]); w.w = cvt_pk_bf16(v1[2], v1[3]);
                    *(u32x4*)(rowp + bj * HALF) = w; } }
    }
};
__device__ __forceinline__ float swiglu1(float g, float l) {
    g = fminf(g, 7.0f); l = fminf(fmaxf(l, -7.0f), 7.0f);
    const float s = __builtin_amdgcn_rcpf(1.0f + __builtin_amdgcn_exp2f(-1.702f * 1.4426950408889634f * g));
    return g * s * (l + 1.0f);
}
struct EpiUp {
    static constexpr bool PERM = true;
    bf16_t* O; const float* bias;
    __device__ __forceinline__ void operator()(const f32x4 (&acc)[2][2][4][2], const Unit& u, int wr, int wc, int fr, int fq) const {
        const int row0 = u.pm * BM + wr * 64 + fr; const int j0 = u.pn * HALF + wc * 32 + 8 * fq;
        const float* bp = bias + (size_t)u.e * 2048 + j0;
        f32x4 bg[2], bl[2];
#pragma unroll
        for (int n = 0; n < 2; ++n) { bg[n] = *(const f32x4*)(bp + 4 * n); bl[n] = *(const f32x4*)(bp + 1024 + 4 * n); }
#pragma unroll
        for (int ai = 0; ai < 2; ++ai)
#pragma unroll
            for (int m = 0; m < 4; ++m) {
                float o[8];
#pragma unroll
                for (int n = 0; n < 2; ++n) { const f32x4 g = acc[ai][0][m][n] + bg[n], l = acc[ai][1][m][n] + bl[n];
#pragma unroll
                    for (int j = 0; j < 4; ++j) o[4 * n + j] = swiglu1(g[j], l[j]); }
                u32x4 w; w.x = cvt_pk_bf16(o[0], o[1]); w.y = cvt_pk_bf16(o[2], o[3]); w.z = cvt_pk_bf16(o[4], o[5]); w.w = cvt_pk_bf16(o[6], o[7]);
                *(u32x4*)(O + (size_t)(row0 + ai * HALF + m * 16) * 1024 + j0) = w; }
    }
};

constexpr float F8_SU = 64.0f, F8_SA = 4.0f, F8_SD = 128.0f;
__device__ __forceinline__ unsigned pk4_fp8(float a, float b, float c, float d) {
    a = fminf(fmaxf(a, -448.f), 448.f); b = fminf(fmaxf(b, -448.f), 448.f); c = fminf(fmaxf(c, -448.f), 448.f); d = fminf(fmaxf(d, -448.f), 448.f);
    int p = __builtin_amdgcn_cvt_pk_fp8_f32(a, b, 0, false); p = __builtin_amdgcn_cvt_pk_fp8_f32(c, d, p, true); return (unsigned)p;
}
struct EpiUpF8 {
    static constexpr bool PERM = true;
    unsigned char* O; const float* bias;
    __device__ __forceinline__ void operator()(const f32x4 (&acc)[2][2][4][2], const Unit& u, int wr, int wc, int fr, int fq) const {
        const int row0 = u.pm * BM + wr * 64 + fr; const int j0 = u.pn * HALF + wc * 32 + 8 * fq;
        const float* bp = bias + (size_t)u.e * 2048 + j0;
        f32x4 bg[2], bl[2];
#pragma unroll
        for (int n = 0; n < 2; ++n) { bg[n] = *(const f32x4*)(bp + 4 * n); bl[n] = *(const f32x4*)(bp + 1024 + 4 * n); }
#pragma unroll
        for (int ai = 0; ai < 2; ++ai)
#pragma unroll
            for (int m = 0; m < 4; ++m) {
                unsigned w[2];
#pragma unroll
                for (int n = 0; n < 2; ++n) { const f32x4 g = acc[ai][0][m][n] * (1.0f / F8_SU) + bg[n], l = acc[ai][1][m][n] * (1.0f / F8_SU) + bl[n];
                    w[n] = pk4_fp8(F8_SA * swiglu1(g[0], l[0]), F8_SA * swiglu1(g[1], l[1]), F8_SA * swiglu1(g[2], l[2]), F8_SA * swiglu1(g[3], l[3])); }
                typedef unsigned u32x2 __attribute__((ext_vector_type(2)));
                u32x2 ww = {w[0], w[1]};
                *(u32x2*)(O + (size_t)(row0 + ai * HALF + m * 16) * 1024 + j0) = ww; }
    }
};
struct EpiDnF8 {
    static constexpr bool PERM = true;
    bf16_t* O; const float* bias;
    __device__ __forceinline__ void operator()(const f32x4 (&acc)[2][2][4][2], const Unit& u, int wr, int wc, int fr, int fq) const {
        const int row0 = u.pm * BM + wr * 64 + fr; const int col0 = u.pn * BM + wc * 32 + 8 * fq;
        f32x4 bv[2][2];
#pragma unroll
        for (int bj = 0; bj < 2; ++bj)
#pragma unroll
            for (int n = 0; n < 2; ++n) bv[bj][n] = *(const f32x4*)(bias + (size_t)u.e * 1024 + col0 + bj * HALF + 4 * n);
#pragma unroll
        for (int ai = 0; ai < 2; ++ai)
#pragma unroll
            for (int m = 0; m < 4; ++m) { bf16_t* rowp = O + (size_t)(row0 + ai * HALF + m * 16) * 1024 + col0;
#pragma unroll
                for (int bj = 0; bj < 2; ++bj) { f32x4 v0 = acc[ai][bj][m][0] * (1.0f / (F8_SA * F8_SD)) + bv[bj][0], v1 = acc[ai][bj][m][1] * (1.0f / (F8_SA * F8_SD)) + bv[bj][1];
                    u32x4 w; w.x = cvt_pk_bf16(v0[0], v0[1]); w.y = cvt_pk_bf16(v0[2], v0[3]); w.z = cvt_pk_bf16(v1[0], v1[1]); w.w = cvt_pk_bf16(v1[2], v1[3]);
                    *(u32x4*)(rowp + bj * HALF) = w; } }
    }
};

typedef int v8i32 __attribute__((ext_vector_type(8)));
__device__ __forceinline__ v8i32 pg8_join(const bf16x8 lo, const bf16x8 hi) { typedef int v4i32 __attribute__((ext_vector_type(4)));
    const v4i32 a = __builtin_bit_cast(v4i32, lo), b = __builtin_bit_cast(v4i32, hi); return __builtin_shufflevector(a, b, 0, 1, 2, 3, 4, 5, 6, 7); }
template <class Epi, class Sched, bool ALIGN_EPI, bool F8 = false>
__device__ __forceinline__ void gemm_phase(const int wv, PG8_LAS unsigned char* lds, const void* Abase, const int Kb  , const Sched& S, const Epi& E) {
    int tid = mk_tid(wv); asm volatile("" : "+v"(tid));
    const int wid = __builtin_amdgcn_readfirstlane(tid >> 6), lane = tid & 63, wr = wid >> 2, wc = wid & 3, fr = lane & 15, fq = lane >> 4;
#ifdef DUP_K
    const int nt0 = Kb / 128, nt = 2 * nt0;
#define PG8_KT(t) ((t) % nt0)
#else
    const int nt = Kb / 128;
#define PG8_KT(t) (t)
#endif
    const char* Ab = (const char*)Abase;
    unsigned voffB[2];
#pragma unroll
    for (int i = 0; i < 2; ++i) { int R, C; stage_rc(tid * 16 + i * 8192, R, C); const int Rb = Epi::PERM ? ((R & ~31) + perm32(R & 31)) : R;
        voffB[i] = (unsigned)(Rb * Kb + C * 2); }
    const size_t kstep = (size_t)(BK * 2);
    const size_t hstep = (size_t)HALF * Kb;
    const unsigned rowb = (unsigned)Kb;
    const unsigned ldsw = (unsigned)wid * 1024u;
    const int aoff = lds_byte(wr * 64 + fr, fq * 8), boff = lds_byte(wc * 32 + fr, fq * 8);
#define PG8_SA(b, h) (((b) * 2 + (h)) * HTB)
#define PG8_SB(b, h) ((4 + (b) * 2 + (h)) * HTB)
#define PG8_STAGE(bufoff, gbase, voff) do { _Pragma("unroll") for (int _i = 0; _i < 2; ++_i) { unsigned _v = (voff)[_i]; asm volatile("" : "+v"(_v)); \
        __builtin_amdgcn_global_load_lds((const unsigned*)((const char*)(gbase) + _v), (PG8_LAS unsigned*)(lds + (bufoff) + ldsw + _i * 8192), 16, 0, 0); } } while (0)
#define PG8_STAGE_A(bufoff, kb, o0, o1) do { unsigned _o0 = (o0), _o1 = (o1); asm volatile("" : "+v"(_o0), "+v"(_o1)); \
        __builtin_amdgcn_global_load_lds((const unsigned*)(Ab + (kb) + _o0), (PG8_LAS unsigned*)(lds + (bufoff) + ldsw), 16, 0, 0); \
        __builtin_amdgcn_global_load_lds((const unsigned*)(Ab + (kb) + _o1), (PG8_LAS unsigned*)(lds + (bufoff) + ldsw + 8192), 16, 0, 0); } while (0)
#define PG8_LDA(dst, b, h) do { if constexpr (F8) { _Pragma("unroll") for (int m = 0; m < 4; ++m) dst##8[m] = pg8_join(*(const PG8_LAS bf16x8*)(lds + PG8_SA(b, h) + aoff + m * 2048), *(const PG8_LAS bf16x8*)(lds + PG8_SA(b, h) + aoff + m * 2048 + 1024)); } \
        else { _Pragma("unroll") for (int m = 0; m < 4; ++m) _Pragma("unroll") for (int k = 0; k < 2; ++k) dst[m][k] = *(const PG8_LAS bf16x8*)(lds + PG8_SA(b, h) + aoff + m * 2048 + k * 1024); } } while (0)
#define PG8_LDB(dst, b, h) do { if constexpr (F8) { _Pragma("unroll") for (int n = 0; n < 2; ++n) dst##8[n] = pg8_join(*(const PG8_LAS bf16x8*)(lds + PG8_SB(b, h) + boff + n * 2048), *(const PG8_LAS bf16x8*)(lds + PG8_SB(b, h) + boff + n * 2048 + 1024)); } \
        else { _Pragma("unroll") for (int n = 0; n < 2; ++n) _Pragma("unroll") for (int k = 0; k < 2; ++k) dst[n][k] = *(const PG8_LAS bf16x8*)(lds + PG8_SB(b, h) + boff + n * 2048 + k * 1024); } } while (0)
#define PG8_MMA(ai, bj, At, Bt) do { __builtin_amdgcn_s_setprio(1); _Pragma("unroll") for (int m = 0; m < 4; ++m) _Pragma("unroll") for (int n = 0; n < 2; ++n) { \
        if constexpr (F8) { acc[ai][bj][m][n] = __builtin_amdgcn_mfma_scale_f32_16x16x128_f8f6f4(Bt##8[n], At##8[m], acc[ai][bj][m][n], 0, 0, 0, 0, 0, 0); } \
        else { _Pragma("unroll") for (int k = 0; k < 2; ++k) acc[ai][bj][m][n] = __builtin_amdgcn_mfma_f32_16x16x32_bf16(Bt[n][k], At[m][k], acc[ai][bj][m][n], 0, 0, 0); } } \
        __builtin_amdgcn_s_setprio(0); } while (0)
#define PG8_WAIT_V(n) asm volatile("s_waitcnt vmcnt(" #n ")" ::: "memory")
#define PG8_WAIT_L(n) asm volatile("s_waitcnt lgkmcnt(" #n ")" ::: "memory")
#define PG8_BAR __builtin_amdgcn_s_barrier()
#define PG8_SCHED __builtin_amdgcn_sched_barrier(0)
#define PG8_AOFFS(dst, u) do { int _t = mk_tid(wv); asm volatile("" : "+v"(_t)); _Pragma("unroll") for (int _i = 0; _i < 2; ++_i) { int _R, _C; stage_rc(_t * 16 + _i * 8192, _R, _C); \
        _Pragma("unroll") for (int _h = 0; _h < 2; ++_h) dst[_h][_i] = S.a_row(u, _h * HALF + _R) * rowb + (unsigned)_C * 2u; } } while (0)
    Unit cur, nxt; int ui = 0;
    if (!S.next(0, cur)) return;
    f32x4 acc[2][2][4][2];
#pragma unroll
    for (int a = 0; a < 2; ++a)
#pragma unroll
        for (int b = 0; b < 2; ++b)
#pragma unroll
            for (int m = 0; m < 4; ++m)
#pragma unroll
                for (int n = 0; n < 2; ++n) acc[a][b][m][n] = (f32x4){0.f, 0.f, 0.f, 0.f};
    bf16x8 At[4][2], B0[2][2], B1[2][2];
    v8i32 At8[4], B08[2], B18[2];
    unsigned aC[2][2], aN[2][2];
    PG8_AOFFS(aC, cur);
    const char* cB = S.b_base(cur);
    PG8_STAGE(PG8_SB(0, 0), cB, voffB); PG8_STAGE(PG8_SB(0, 1), cB + hstep, voffB); PG8_STAGE_A(PG8_SA(0, 0), 0, aC[0][0], aC[0][1]); PG8_STAGE_A(PG8_SA(0, 1), 0, aC[1][0], aC[1][1]);
    if (wr == 1) PG8_BAR;
    PG8_WAIT_V(2); PG8_BAR;
    PG8_STAGE(PG8_SB(1, 0), cB + kstep, voffB); PG8_STAGE_A(PG8_SA(1, 0), kstep, aC[0][0], aC[0][1]); PG8_STAGE(PG8_SB(1, 1), cB + hstep + kstep, voffB);
    PG8_WAIT_V(6); PG8_BAR;
    for (;;) {
        const bool has_next = S.next(ui + 1, nxt);
        const char* nB = has_next ? S.b_base(nxt) : cB;
        if (has_next) { PG8_AOFFS(aN, nxt); }
        else {
#pragma unroll
            for (int _h = 0; _h < 2; ++_h)
#pragma unroll
                for (int _i = 0; _i < 2; ++_i) aN[_h][_i] = aC[_h][_i]; }
#pragma unroll 1
        for (int t = 0; t < nt; t += 2) {
            const bool last = (t == nt - 2);
            const size_t kb1 = (size_t)PG8_KT(t + 1) * kstep;
            PG8_LDB(B0, 0, 0); PG8_LDB(B1, 0, 1); PG8_SCHED; PG8_LDA(At, 0, 0); PG8_STAGE_A(PG8_SA(1, 1), kb1, aC[1][0], aC[1][1]);
            PG8_WAIT_V(8); PG8_WAIT_L(0); PG8_BAR; PG8_MMA(0, 0, At, B0); PG8_MMA(0, 1, At, B1); PG8_BAR; PG8_SCHED;
            if (last) {
#pragma unroll
                for (int _h = 0; _h < 2; ++_h)
#pragma unroll
                    for (int _i = 0; _i < 2; ++_i) aC[_h][_i] = aN[_h][_i]; }
            const size_t kb2 = last ? (size_t)0 : (size_t)PG8_KT(t + 2) * kstep; const char* b2 = last ? nB : cB + (size_t)PG8_KT(t + 2) * kstep;
            const size_t kb3 = kb2 + kstep; const char* b3 = b2 + kstep;
            PG8_LDA(At, 0, 1); PG8_STAGE(PG8_SB(0, 0), b2, voffB); PG8_STAGE(PG8_SB(0, 1), b2 + hstep, voffB); PG8_STAGE_A(PG8_SA(0, 0), kb2, aC[0][0], aC[0][1]);
            PG8_WAIT_V(8); PG8_WAIT_L(0); PG8_BAR; PG8_MMA(1, 0, At, B0); PG8_MMA(1, 1, At, B1); PG8_BAR; PG8_SCHED;
            PG8_LDB(B0, 1, 0); PG8_LDB(B1, 1, 1); PG8_SCHED; PG8_LDA(At, 1, 0); PG8_STAGE_A(PG8_SA(0, 1), kb2, aC[1][0], aC[1][1]);
            PG8_WAIT_V(8); PG8_WAIT_L(0); PG8_BAR; PG8_MMA(0, 0, At, B0); PG8_MMA(0, 1, At, B1); PG8_BAR; PG8_SCHED;
            PG8_LDA(At, 1, 1); PG8_STAGE(PG8_SB(1, 0), b3, voffB); PG8_STAGE(PG8_SB(1, 1), b3 + hstep, voffB); PG8_STAGE_A(PG8_SA(1, 0), kb3, aC[0][0], aC[0][1]);
            PG8_WAIT_V(8); PG8_WAIT_L(0); PG8_BAR; PG8_MMA(1, 0, At, B0); PG8_MMA(1, 1, At, B1); PG8_BAR; PG8_SCHED;
        }
        if (ALIGN_EPI) { if (wr == 0) PG8_BAR; }
#ifdef DUP_K
#pragma unroll
        for (int a = 0; a < 2; ++a)
#pragma unroll
            for (int b = 0; b < 2; ++b)
#pragma unroll
                for (int m = 0; m < 4; ++m)
#pragma unroll
                    for (int n = 0; n < 2; ++n) acc[a][b][m][n] = acc[a][b][m][n] * 0.5f;
#endif
        E(acc, cur, wr, wc, fr, fq);
#ifdef DUP_EPI
        E(acc, cur, wr, wc, fr, fq);
#endif
        if (!has_next) break;
#pragma unroll
        for (int a = 0; a < 2; ++a)
#pragma unroll
            for (int b = 0; b < 2; ++b)
#pragma unroll
                for (int m = 0; m < 4; ++m)
#pragma unroll
                    for (int n = 0; n < 2; ++n) acc[a][b][m][n] = (f32x4){0.f, 0.f, 0.f, 0.f};
        cur = nxt; cB = nB; ++ui;
        if (ALIGN_EPI) { if (wr == 1) PG8_BAR; }
    }
    PG8_WAIT_V(0);
    if (!ALIGN_EPI) { if (wr == 0) PG8_BAR; }
    PG8_BAR;
#undef PG8_SA
#undef PG8_SB
#undef PG8_STAGE
#undef PG8_STAGE_A
#undef PG8_LDA
#undef PG8_LDB
#undef PG8_MMA
#undef PG8_WAIT_V
#undef PG8_WAIT_L
#undef PG8_BAR
#undef PG8_SCHED
#undef PG8_AOFFS
#undef PG8_KT
}
}


#ifndef NSA_REP_RANK
#define NSA_REP_RANK 1
#endif
#ifndef NSA_REP_PASSA
#define NSA_REP_PASSA 1
#endif
#ifndef NSA_REP_LOOP
#define NSA_REP_LOOP 1
#endif
namespace nsa {
#define NLAS __attribute__((address_space(3)))
typedef short bf16x8 __attribute__((ext_vector_type(8)));
typedef short s16x4 __attribute__((ext_vector_type(4)));
typedef short v4i16_t __attribute__((ext_vector_type(4)));
typedef float f32x16 __attribute__((ext_vector_type(16)));
typedef float f32x2_t __attribute__((ext_vector_type(2)));
typedef __bf16 bf16x2_t __attribute__((ext_vector_type(2)));
#define NSA_MFMA(a, b, c) __builtin_amdgcn_mfma_f32_32x32x16_bf16((a), (b), (c), 0, 0, 0)
constexpr int L_CK = 0, L_CV = 32768, L_RING = 65536, L_IMP = 0, SLOTB = 16384, L_SELM = 131072 + 1024;
constexpr float QSCALE = 0.125f * 1.4426950408889634f;
constexpr float NEGBIG = -1.0e30f;

__device__ __forceinline__ unsigned cvtpk(float lo, float hi) { f32x2_t v = {lo, hi}; bf16x2_t b = __builtin_convertvector(v, bf16x2_t); return __builtin_bit_cast(unsigned, b); }
__device__ __forceinline__ float bflo(unsigned u) { return __uint_as_float(u << 16); }
__device__ __forceinline__ float bfhi(unsigned u) { return __uint_as_float(u & 0xffff0000u); }
__device__ __forceinline__ float xhalf(float v) { return __shfl_xor(v, 32); }
__device__ __forceinline__ float xhalf_max(float v) { const auto r = __builtin_amdgcn_permlane32_swap(__float_as_uint(v), __float_as_uint(v), false, false); return fmaxf(__uint_as_float(r[0]), __uint_as_float(r[1])); }
__device__ __forceinline__ float xhalf_sum(float v) { const auto r = __builtin_amdgcn_permlane32_swap(__float_as_uint(v), __float_as_uint(v), false, false); return __uint_as_float(r[0]) + __uint_as_float(r[1]); }
__device__ __forceinline__ s16x4 vtr(const NLAS unsigned char* p) { return __builtin_bit_cast(s16x4, __builtin_amdgcn_ds_read_tr16_b64_v4i16((NLAS v4i16_t*)p)); }
__device__ __forceinline__ bf16x8 pack8(const f32x16& x, int s) {
    unsigned p0 = cvtpk(x[8 * s], x[8 * s + 1]), p1 = cvtpk(x[8 * s + 2], x[8 * s + 3]), p2 = cvtpk(x[8 * s + 4], x[8 * s + 5]), p3 = cvtpk(x[8 * s + 6], x[8 * s + 7]);
    typedef unsigned u32x4 __attribute__((ext_vector_type(4)));
    u32x4 u = {p0, p1, p2, p3}; return __builtin_bit_cast(bf16x8, u);
}

struct Params {
    const unsigned short* hb;
    const unsigned short *kcb, *vcb;
    const unsigned short *ksb, *vsb, *kwb, *vwb;
    const float *cosT, *sinT;
    const float* normw;
    unsigned short* ycat;
};

__device__ __forceinline__ void qk_tile(const NLAS unsigned char* kt, const bf16x8 (&qf)[4], const int (&kofs)[4], f32x16& st0, f32x16& st1) {
#pragma unroll
    for (int i = 0; i < 16; ++i) { st0[i] = 0.f; st1[i] = 0.f; }
#pragma unroll
    for (int ks = 0; ks < 4; ++ks) {
        const bf16x8 k0 = *(const NLAS bf16x8*)(kt + kofs[ks]);
        const bf16x8 k1 = *(const NLAS bf16x8*)(kt + kofs[ks] + 4096);
        st0 = NSA_MFMA(k0, qf[ks], st0); st1 = NSA_MFMA(k1, qf[ks], st1);
    }
}
__device__ __forceinline__ void pv_tile(const NLAS unsigned char* vt, const int (&vofs)[2][2], const f32x16& p0, const f32x16& p1, f32x16& o0, f32x16& o1) {
#pragma unroll
    for (int kt = 0; kt < 2; ++kt)
#pragma unroll
        for (int s = 0; s < 2; ++s) {
            const bf16x8 pb = pack8(kt ? p1 : p0, s);
            const int kb = (32 * kt + 16 * s) * 128;
#pragma unroll
            for (int mb = 0; mb < 2; ++mb) {
                const s16x4 lo = vtr(vt + kb + vofs[mb][0]), hi = vtr(vt + kb + vofs[mb][1]);
                const bf16x8 va = __builtin_shufflevector(lo, hi, 0, 1, 2, 3, 4, 5, 6, 7);
                if (mb == 0) o0 = NSA_MFMA(va, pb, o0); else o1 = NSA_MFMA(va, pb, o1);
            }
        }
}
__device__ __forceinline__ float max3f(float a, float b, float c) { float r; asm("v_max3_f32 %0, %1, %2, %3" : "=v"(r) : "v"(a), "v"(b), "v"(c)); return r; }
constexpr float NEGINF = -__builtin_inff();
template <bool USE_LO>
__device__ __forceinline__ void mask_tile(f32x16& s0, f32x16& s1, const int hi4, const int lo4) {
#pragma unroll
    for (int i = 0; i < 16; ++i) {
        const int kk0 = (i & 3) + 8 * (i >> 2), kk1 = kk0 + 32;
        bool a0 = kk0 <= hi4, a1 = kk1 <= hi4;
        if (USE_LO) { a0 = a0 && (kk0 >= lo4); a1 = a1 && (kk1 >= lo4); }
        s0[i] = a0 ? s0[i] : NEGINF; s1[i] = a1 ? s1[i] : NEGINF;
    }
}
__device__ __forceinline__ void softmax_core(f32x16& s0, f32x16& s1, float& m, float& l, f32x16& o0, f32x16& o1, const bool live = true) {
    float mx = max3f(s0[0], s0[1], s0[2]);
#pragma unroll
    for (int i = 3; i < 15; i += 2) mx = max3f(mx, s0[i], s0[i + 1]);
    mx = max3f(mx, s0[15], s1[0]);
#pragma unroll
    for (int i = 1; i < 15; i += 2) mx = max3f(mx, s1[i], s1[i + 1]);
    mx = fmaxf(mx, s1[15]);
    mx = xhalf_max(mx);
    const float mn = fmaxf(m, mx);
    const float alpha = __builtin_amdgcn_exp2f(m - mn);
    m = mn;
    const float mref = live ? mn : __builtin_inff();
    float sum0 = 0.f, sum1 = 0.f;
#pragma unroll
    for (int i = 0; i < 16; ++i) {
        const float e0 = __builtin_amdgcn_exp2f(s0[i] - mref), e1 = __builtin_amdgcn_exp2f(s1[i] - mref);
        s0[i] = e0; s1[i] = e1; sum0 += e0; sum1 += e1;
    }
    l = l * alpha + (sum0 + sum1);
    if (__ballot(alpha != 1.0f) != 0ull) {
#pragma unroll
        for (int i = 0; i < 16; ++i) { o0[i] *= alpha; o1[i] *= alpha; }
    }
}

__device__ __forceinline__ void unit(const Params& P, NLAS unsigned char* lds, const int tid_in, const int b, const int g, const int qb) {
    int tid = tid_in; asm volatile("" : "+v"(tid));
    const int wv = __builtin_amdgcn_readfirstlane(tid >> 6), lane = tid & 63, r = lane & 31, h = lane >> 5;
    const int head = g * 4 + (wv >> 1), qi = 32 * (wv & 1) + r;
    const int t = qb * 64 + qi, tok = b * 4096 + t;
    const int bg = b * 2 + g;
    int kofs[4];
#pragma unroll
    for (int ks = 0; ks < 4; ++ks) kofs[ks] = r * 128 + ((((2 * ks + h) ^ ((r >> 1) & 7))) << 4);
    int vofs[2][2];
    { const int i16 = lane & 15, blk = (lane >> 4) & 1, q = i16 >> 2, p = i16 & 3;
#pragma unroll
      for (int mb = 0; mb < 2; ++mb)
#pragma unroll
          for (int jj = 0; jj < 2; ++jj) { const int key = 4 * h + 8 * jj + q; const int o = 4 * mb + 2 * blk + (p >> 1);
              vofs[mb][jj] = key * 128 + ((o ^ (((key >> 1) & 1) << 2)) << 4) + (p & 1) * 8; } }
    const int drow = tid >> 3, dpos = tid & 7;
    const unsigned srcK = (unsigned)(drow * 128 + ((dpos ^ ((drow >> 1) & 7)) << 4));
    const unsigned srcV = (unsigned)(drow * 128 + ((dpos ^ (((drow >> 1) & 1) << 2)) << 4));
    const unsigned wdst = (unsigned)wv * 1024u;
    const unsigned lds0 = (unsigned)(size_t)lds;
#define NSA_DMA(slotoff, gsrc, soff) do { unsigned _keep; const void* _g = (const void*)((const char*)(gsrc) + (soff)); const unsigned _d = (unsigned)__builtin_amdgcn_readfirstlane((int)(lds0 + (unsigned)(slotoff) + wdst)); \
        asm volatile("s_mov_b32 %0, m0\n\ts_mov_b32 m0, %2\n\ts_nop 0\n\tglobal_load_lds_dwordx4 %1, off\n\ts_mov_b32 m0, %0" : "=&s"(_keep) : "v"(_g), "s"(_d) : "memory"); } while (0)
    const int nsel = qb + 1, jw0 = qb >= 8 ? qb - 8 : 0, ntiles = nsel + (qb - jw0 + 1);
    const char* ksg = (const char*)P.ksb + (size_t)bg * 4096 * 128; const char* vsg = (const char*)P.vsb + (size_t)bg * 4096 * 128;
    const char* kwg = (const char*)P.kwb + (size_t)bg * 4096 * 128; const char* vwg = (const char*)P.vwb + (size_t)bg * 4096 * 128;
#define NSA_ISSUE(pos) do { const int _p = (pos) < ntiles ? (pos) : ntiles - 1; const bool _w = _p >= nsel; const int _j = _w ? jw0 + _p - nsel : _p; \
        const int _slot = L_RING + ((pos) & 3) * SLOTB; \
        NSA_DMA(_slot, (_w ? kwg : ksg) + (size_t)_j * 8192, srcK); NSA_DMA(_slot + 8192, (_w ? vwg : vsg) + (size_t)_j * 8192, srcV); } while (0)
    { const char* kcg = (const char*)P.kcb + (size_t)bg * 256 * 128; const char* vcg = (const char*)P.vcb + (size_t)bg * 256 * 128;
#pragma unroll
      for (int T = 0; T < 4; ++T) { NSA_DMA(L_CK + T * 8192, kcg + T * 8192, srcK); NSA_DMA(L_CV + T * 8192, vcg + T * 8192, srcV); } }
    NSA_ISSUE(0); NSA_ISSUE(1);
    typedef unsigned u32x4 __attribute__((ext_vector_type(4)));
    bf16x8 qf[4];
    const unsigned short* qrow = P.hb + (size_t)tok * 3072 + 1536 + (head & 7) * 64;
    {
        u32x4 qraw[4];
#pragma unroll
        for (int ks = 0; ks < 4; ++ks) qraw[ks] = *(const u32x4*)(qrow + 16 * ks + 8 * h);
#pragma unroll
        for (int ks = 0; ks < 4; ++ks) { u32x4 o;
#pragma unroll
            for (int c = 0; c < 4; ++c) o[c] = cvtpk(bflo(qraw[ks][c]) * QSCALE, bfhi(qraw[ks][c]) * QSCALE);
            qf[ks] = __builtin_bit_cast(bf16x8, o); }
    }
    float gc, gs, gw;
    { const unsigned short* gp = P.hb + (size_t)tok * 3072 + 2816 + head * 3;
      gc = 1.f / (1.f + __expf(-__uint_as_float((unsigned)gp[0] << 16))); gs = 1.f / (1.f + __expf(-__uint_as_float((unsigned)gp[1] << 16))); gw = 1.f / (1.f + __expf(-__uint_as_float((unsigned)gp[2] << 16))); }
    asm volatile("s_waitcnt vmcnt(0)" ::: "memory"); __builtin_amdgcn_s_barrier();
    const int cmax = (t >= 31) ? (((t - 31) >> 4) < 254 ? ((t - 31) >> 4) : 254) : -1;
    float m = NEGBIG, l = 0.f;
    f32x16 of0, of1;
#pragma unroll
    for (int i = 0; i < 16; ++i) { of0[i] = 0.f; of1[i] = 0.f; }
    const bool need_sel = qb >= 16;
    float ow[32];
    float carry_in = 0.f;
#pragma unroll
    for (int T = 0; T < 4; ++T) {
        f32x16 s0, s1;
        qk_tile(lds + L_CK + T * 8192, qf, kofs, s0, s1);
        if (__ballot(cmax - 64 * T < 63) != 0ull) mask_tile<false>(s0, s1, cmax - 64 * T - 4 * h, 0);
        float mx = max3f(s0[0], s0[1], s0[2]);
#pragma unroll
        for (int i = 3; i < 15; i += 2) mx = max3f(mx, s0[i], s0[i + 1]);
        mx = max3f(mx, s0[15], s1[0]);
#pragma unroll
        for (int i = 1; i < 15; i += 2) mx = max3f(mx, s1[i], s1[i + 1]);
        mx = xhalf_max(fmaxf(mx, s1[15]));
        const float mn = fmaxf(m, mx), alpha = __builtin_amdgcn_exp2f(m - mn);
        m = mn;
        if (T > 0 && __ballot(alpha != 1.0f) != 0ull) {
#pragma unroll
            for (int i = 0; i < 16; ++i) { of0[i] *= alpha; of1[i] *= alpha; }
#pragma unroll
            for (int idx = 0; idx < 8 * T; ++idx) ow[idx] *= alpha;
            carry_in *= alpha;
        }
        float sum = 0.f;
#pragma unroll
        for (int i = 0; i < 16; ++i) { s0[i] = __builtin_amdgcn_exp2f(s0[i] - mn); s1[i] = __builtin_amdgcn_exp2f(s1[i] - mn); sum += s0[i] + s1[i]; }
        l = l * alpha + sum;
#pragma unroll
        for (int kt = 0; kt < 2; ++kt)
#pragma unroll
            for (int u = 0; u < 4; ++u) {
                const float p0 = kt ? s1[4 * u] : s0[4 * u], p1 = kt ? s1[4 * u + 1] : s0[4 * u + 1], p2 = kt ? s1[4 * u + 2] : s0[4 * u + 2], p3 = kt ? s1[4 * u + 3] : s0[4 * u + 3];
                const float x = xhalf(p3);
                const float own = 2.0f * ((p0 + p1) + p2) + p3;
                ow[8 * T + 4 * kt + u] = own + (h ? x : carry_in);
                carry_in = x;
            }
        pv_tile(lds + L_CV + T * 8192, vofs, s0, s1, of0, of1);
    }
    {
        const float lc = xhalf_sum(l);
        const float rinv = lc > 0.f ? 1.0f / lc : 0.f, gr = gc * rinv;
#pragma unroll
        for (int i = 0; i < 16; ++i) { of0[i] *= gr; of1[i] *= gr; }
        if (need_sel) {
#pragma unroll
            for (int idx = 0; idx < 32; ++idx) ow[idx] *= rinv;
        }
    }
    unsigned long long selmask = (qb >= 63) ? ~0ull : ((1ull << (qb + 1)) - 1ull);
    if (need_sel) {
        __builtin_amdgcn_s_barrier();
        NLAS float* imp = (NLAS float*)(lds + L_IMP) + qi * 64;
#pragma unroll 1
        for (int hh = 0; hh < 4; ++hh) {
            if ((wv >> 1) == hh) {
                if (hh == 0) {
#pragma unroll
                    for (int idx = 0; idx < 32; ++idx) imp[(2 * idx + h + qi) & 63] = ow[idx];
                } else {
#pragma unroll
                    for (int idx = 0; idx < 32; ++idx) imp[(2 * idx + h + qi) & 63] += ow[idx];
                }
            }
            asm volatile("s_waitcnt lgkmcnt(0)" ::: "memory"); __builtin_amdgcn_s_barrier();
        }
        NLAS unsigned long long* selm = (NLAS unsigned long long*)(lds + L_SELM);
        const unsigned long long forced = 1ull | (1ull << qb) | (1ull << (qb - 1));
        const bool cand = (lane >= 1) && (lane <= qb - 2);
#pragma unroll 1
        for (int rep_ = 0; rep_ < NSA_REP_RANK; ++rep_) {
            unsigned vb[8], thr[8];
#pragma unroll
            for (int qq = 0; qq < 8; ++qq) { const int q = 8 * wv + qq; const float v = ((NLAS float*)(lds + L_IMP))[q * 64 + ((lane + q) & 63)];
                vb[qq] = cand ? __float_as_uint(v) : 0u; thr[qq] = 0u; }
#pragma unroll 1
            for (int bit = 30; bit >= 0; --bit) {
#pragma unroll
                for (int qq = 0; qq < 8; ++qq) {
                    const unsigned c2 = thr[qq] | (1u << bit);
                    const int cnt = __popcll(__ballot(cand && vb[qq] >= c2));
                    thr[qq] = (cnt >= 13) ? c2 : thr[qq];
                }
            }
#pragma unroll
            for (int qq = 0; qq < 8; ++qq) {
                unsigned long long sel = __ballot(cand && vb[qq] > thr[qq]);
                unsigned long long eq = __ballot(cand && vb[qq] == thr[qq]);
                int need = 13 - __popcll(sel);
#pragma unroll 1
                for (; need > 0; --need) { const unsigned long long low = eq & (~eq + 1ull); sel |= low; eq ^= low; }
                if (lane == 0) selm[8 * wv + qq] = sel | forced;
            }
        }
        asm volatile("s_waitcnt lgkmcnt(0)" ::: "memory"); __builtin_amdgcn_s_barrier();
        selmask = selm[qi];
    }
    {
        u32x4 qraw[4];
#pragma unroll
        for (int ks = 0; ks < 4; ++ks) qraw[ks] = *(const u32x4*)(qrow + 16 * ks + 8 * h);
        const float4* cp = (const float4*)(P.cosT + (size_t)tok * 32 + 8 * h); const float4* sp = (const float4*)(P.sinT + (size_t)tok * 32 + 8 * h);
#pragma unroll
        for (int ks = 0; ks < 2; ++ks) {
            const float4 c0 = cp[4 * ks], c1 = cp[4 * ks + 1], s0 = sp[4 * ks], s1 = sp[4 * ks + 1];
            const float cs[8] = {c0.x, c0.y, c0.z, c0.w, c1.x, c1.y, c1.z, c1.w}, sn[8] = {s0.x, s0.y, s0.z, s0.w, s1.x, s1.y, s1.z, s1.w};
            u32x4 oa, ob;
#pragma unroll
            for (int c = 0; c < 4; ++c) {
                const float a0 = bflo(qraw[ks][c]), a1 = bfhi(qraw[ks][c]), b0 = bflo(qraw[ks + 2][c]), b1 = bfhi(qraw[ks + 2][c]);
                oa[c] = cvtpk((a0 * cs[2 * c] - b0 * sn[2 * c]) * QSCALE, (a1 * cs[2 * c + 1] - b1 * sn[2 * c + 1]) * QSCALE);
                ob[c] = cvtpk((b0 * cs[2 * c] + a0 * sn[2 * c]) * QSCALE, (b1 * cs[2 * c + 1] + a1 * sn[2 * c + 1]) * QSCALE);
            }
            qf[ks] = __builtin_bit_cast(bf16x8, oa); qf[ks + 2] = __builtin_bit_cast(bf16x8, ob);
        }
    }
    asm volatile("s_waitcnt vmcnt(0)" ::: "memory");
    f32x16 o0, o1;
    const bool lead = wv < 4;
    const float gs_keep = gs, gw_keep = gw;
#pragma unroll 1
    for (int repL = 0; repL < NSA_REP_LOOP; ++repL) {
    if (NSA_REP_LOOP > 1) { gs = (repL == NSA_REP_LOOP - 1) ? gs_keep : 0.f; gw = (repL == NSA_REP_LOOP - 1) ? gw_keep : 0.f;
        if (repL > 0) { asm volatile("s_waitcnt vmcnt(0)" ::: "memory"); __builtin_amdgcn_s_barrier(); NSA_ISSUE(0); NSA_ISSUE(1); asm volatile("s_waitcnt vmcnt(0)" ::: "memory"); } }
#pragma unroll
    for (int i = 0; i < 16; ++i) { o0[i] = 0.f; o1[i] = 0.f; }
    m = NEGBIG; l = 0.f;
    if (!lead) { asm volatile("s_waitcnt vmcnt(2)" ::: "memory"); __builtin_amdgcn_s_barrier(); }
#pragma unroll 1
    for (int pos = 0; pos < ntiles; ++pos) {
        if (lead) asm volatile("s_waitcnt vmcnt(2)" ::: "memory");
        __builtin_amdgcn_s_barrier();
        NSA_ISSUE(pos + 2);
        const NLAS unsigned char* slot = lds + L_RING + (pos & 3) * SLOTB;
        f32x16 s0, s1;
        const bool win = pos >= nsel; const int j = win ? jw0 + pos - nsel : pos;
        const bool live = win || ((selmask >> j) & 1ull);
        qk_tile(slot, qf, kofs, s0, s1);
        if (j == qb) mask_tile<false>(s0, s1, qi - 4 * h, 0);
        else if (win && qb >= 8 && j == qb - 8) mask_tile<true>(s0, s1, 63, qi + 1 - 4 * h);
        softmax_core(s0, s1, m, l, o0, o1, live);
        if (!lead) asm volatile("s_waitcnt vmcnt(2)" ::: "memory");
        __builtin_amdgcn_s_barrier();
        pv_tile(slot + 8192, vofs, s0, s1, o0, o1);
        if (pos == nsel - 1) {
            const float L = xhalf_sum(l); const float sc = (L > 0.f) ? gs / L : 0.f;
#pragma unroll
            for (int i = 0; i < 16; ++i) { of0[i] += sc * o0[i]; of1[i] += sc * o1[i]; o0[i] = 0.f; o1[i] = 0.f; }
            m = NEGBIG; l = 0.f;
        }
    }
    if (lead) __builtin_amdgcn_s_barrier();
    if (NSA_REP_LOOP > 1 && repL < NSA_REP_LOOP - 1) {
        const float L0 = l + xhalf(l); (void)L0; }
    if (repL == NSA_REP_LOOP - 1)    {
        float L = xhalf_sum(l);
        const float npad = (t < 511) ? (float)(511 - t) : 0.f;
        const float m2 = (npad > 0.f) ? fmaxf(m, 0.f) : m;
        const float a = __builtin_amdgcn_exp2f(m - m2);
        L = L * a + npad * __builtin_amdgcn_exp2f(-m2);
        const float sc = (L > 0.f) ? gw * a / L : 0.f;
#pragma unroll
        for (int i = 0; i < 16; ++i) { of0[i] += sc * o0[i]; of1[i] += sc * o1[i]; }
    }
    }
    float ss = 0.f;
#pragma unroll
    for (int i = 0; i < 16; ++i) ss += of0[i] * of0[i] + of1[i] * of1[i];
    ss = xhalf_sum(ss);
    const float rn = rsqrtf(ss * (1.0f / 64.0f) + 1e-6f);
    unsigned short* yrow = P.ycat + (size_t)tok * 1024 + 512 + head * 64;
    const float* nw = P.normw + head * 64;
    float4 w4a[2][4];
#pragma unroll
    for (int mb = 0; mb < 2; ++mb)
#pragma unroll
        for (int u = 0; u < 4; ++u) w4a[mb][u] = *(const float4*)(nw + 32 * mb + 8 * u + 4 * h);
#pragma unroll
    for (int mb = 0; mb < 2; ++mb)
#pragma unroll
        for (int u = 0; u < 4; ++u) {
            const int d0 = 32 * mb + 8 * u + 4 * h;
            const float4 w4 = w4a[mb][u];
            const float v0 = (mb ? of1[4 * u] : of0[4 * u]) * rn * w4.x, v1 = (mb ? of1[4 * u + 1] : of0[4 * u + 1]) * rn * w4.y;
            const float v2 = (mb ? of1[4 * u + 2] : of0[4 * u + 2]) * rn * w4.z, v3 = (mb ? of1[4 * u + 3] : of0[4 * u + 3]) * rn * w4.w;
            *(uint2*)(yrow + d0) = make_uint2(cvtpk(v0, v1), cvtpk(v2, v3));
        }
    asm volatile("s_waitcnt vmcnt(0)" ::: "memory"); __builtin_amdgcn_s_barrier();
#undef NSA_DMA
#undef NSA_ISSUE
}
__device__ __forceinline__ void phase(const Params& P, NLAS unsigned char* lds, const int tid, const int bid, const int G) {
#pragma unroll 1
    for (int vw = bid; vw < 256; vw += G) {
        const int xcd = vw & 7, slot = vw >> 3, bg = xcd * 2 + (slot >> 4), rr = slot & 15;
#pragma unroll 1
        for (int k = 0; k < 4; ++k) { const int qb = (k == 0) ? 63 - rr : (k == 1) ? 32 + rr : (k == 2) ? 31 - rr : rr; unit(P, lds, tid, bg >> 1, bg & 1, qb); }
    }
}
}


namespace wt {
typedef short bf16x8 __attribute__((ext_vector_type(8)));
typedef float f32x16 __attribute__((ext_vector_type(16)));
typedef unsigned u32x4 __attribute__((ext_vector_type(4)));
typedef unsigned u32x2 __attribute__((ext_vector_type(2)));
typedef float f32x2_t __attribute__((ext_vector_type(2)));
typedef __bf16 bf16x2_t __attribute__((ext_vector_type(2)));
#define WT_MFMA(a, b, c) __builtin_amdgcn_mfma_f32_32x32x16_bf16((a), (b), (c), 0, 0, 0)
__device__ __forceinline__ unsigned cvtpk(float lo, float hi) { f32x2_t v = {lo, hi}; bf16x2_t b = __builtin_convertvector(v, bf16x2_t); return __builtin_bit_cast(unsigned, b); }
__device__ __forceinline__ float bflo(unsigned u) { return __uint_as_float(u << 16); }
__device__ __forceinline__ float bfhi(unsigned u) { return __uint_as_float(u & 0xffff0000u); }
__device__ __forceinline__ float xhalf(float v) { return __shfl_xor(v, 32); }
__device__ __forceinline__ float xhalf_sum(float v) { const auto r = __builtin_amdgcn_permlane32_swap(__float_as_uint(v), __float_as_uint(v), false, false); return __uint_as_float(r[0]) + __uint_as_float(r[1]); }
__device__ __forceinline__ bf16x8 ld16(const unsigned short* p) { return __builtin_bit_cast(bf16x8, *(const u32x4*)p); }
__device__ __forceinline__ bf16x8 ld8x2(const unsigned short* p0, const unsigned short* p1) { const u32x2 a = *(const u32x2*)p0, b = *(const u32x2*)p1; u32x4 u = {a.x, a.y, b.x, b.y}; return __builtin_bit_cast(bf16x8, u); }
__device__ __forceinline__ bf16x8 pack8(const f32x16& x, int s) {
    u32x4 u = {cvtpk(x[8 * s], x[8 * s + 1]), cvtpk(x[8 * s + 2], x[8 * s + 3]), cvtpk(x[8 * s + 4], x[8 * s + 5]), cvtpk(x[8 * s + 6], x[8 * s + 7])};
    return __builtin_bit_cast(bf16x8, u);
}
__device__ __forceinline__ float gelu_t(float x) { const float u = 0.7978845608028654f * (x + 0.044715f * x * x * x); const float e = __expf(2.0f * u); return 0.5f * x * (1.0f + (1.0f - 2.0f / (e + 1.0f))); }
__device__ __forceinline__ float sigm(float x) { return 1.0f / (1.0f + __expf(-x)); }
__device__ __forceinline__ void zero(f32x16& a) {
#pragma unroll
    for (int i = 0; i < 16; ++i) a[i] = 0.f;
}

__device__ __forceinline__ void gm_ln8(const unsigned short* __restrict__ hb, const float* __restrict__ lw, const float* __restrict__ lbias, unsigned short* __restrict__ vlnT, int t8, int lane) {
    const int tok0 = t8 * 8;
    const float4 w4 = *(const float4*)(lw + lane * 4), b4 = *(const float4*)(lbias + lane * 4);
    float o[4][8];
#pragma unroll
    for (int i = 0; i < 8; ++i) {
        const u32x2 v4 = *(const u32x2*)(hb + (size_t)(tok0 + i) * 3072 + 1280 + lane * 4);
        float v[4] = {gelu_t(bflo(v4.x)), gelu_t(bfhi(v4.x)), gelu_t(bflo(v4.y)), gelu_t(bfhi(v4.y))};
        float s = (v[0] + v[1]) + (v[2] + v[3]);
#pragma unroll
        for (int o2 = 1; o2 < 64; o2 <<= 1) s += __shfl_xor(s, o2);
        const float mean = s * (1.0f / 256.0f); float q = 0.f;
#pragma unroll
        for (int c = 0; c < 4; ++c) { v[c] -= mean; q += v[c] * v[c]; }
#pragma unroll
        for (int o2 = 1; o2 < 64; o2 <<= 1) q += __shfl_xor(q, o2);
        const float rstd = rsqrtf(q * (1.0f / 256.0f) + 1e-5f);
        o[0][i] = v[0] * rstd * w4.x + b4.x; o[1][i] = v[1] * rstd * w4.y + b4.y; o[2][i] = v[2] * rstd * w4.z + b4.z; o[3][i] = v[3] * rstd * w4.w + b4.w;
    }
    const int bc = tok0 >> 7, s0 = tok0 & 127;
#pragma unroll
    for (int c = 0; c < 4; ++c) {
        const int ch = lane * 4 + c, g = ch >> 6, cc = ch & 63;
        u32x4 u = {cvtpk(o[c][0], o[c][1]), cvtpk(o[c][2], o[c][3]), cvtpk(o[c][4], o[c][5]), cvtpk(o[c][6], o[c][7])};
        *(u32x4*)(vlnT + ((size_t)(bc * 4 + g) * 64 + cc) * 128 + s0) = u;
    }
}
__device__ __forceinline__ void gm_sp_task(const unsigned short* __restrict__ hb, const unsigned short* __restrict__ vlnT, const unsigned short* __restrict__ Wb, const float* __restrict__ bs,
                                           const float* __restrict__ normw, unsigned short* __restrict__ ycat, int task, int lane) {
    const int tb = task & 3, g = (task >> 2) & 3, bc = task >> 4, r = lane & 31, h = lane >> 5;
    const unsigned short* ap = vlnT + ((size_t)(bc * 4 + g) * 64 + r) * 128 + 8 * h;
    const unsigned short* bp = Wb + ((size_t)g * 128 + 32 * tb + r) * 128 + 8 * h;
    f32x16 a0, a1; zero(a0); zero(a1);
    const int nks = 2 * (tb + 1);
#pragma unroll 2
    for (int ks = 0; ks < nks; ++ks) {
        const bf16x8 bw = ld16(bp + 16 * ks);
        const bf16x8 v0 = ld16(ap + 16 * ks), v1 = ld16(ap + 32 * 128 + 16 * ks);
        a0 = WT_MFMA(v0, bw, a0); a1 = WT_MFMA(v1, bw, a1);
    }
    const int tl = 32 * tb + r, tok = bc * 128 + tl;
    const float bias = bs[g * 128 + tl];
    const unsigned short* up = hb + (size_t)tok * 3072 + 1024 + g * 64;
    float z[32]; float ss = 0.f;
#pragma unroll
    for (int cb = 0; cb < 2; ++cb)
#pragma unroll
        for (int u = 0; u < 4; ++u) {
            const int c0 = 32 * cb + 8 * u + 4 * h;
            const u32x2 uu = *(const u32x2*)(up + c0);
            const float uv[4] = {gelu_t(bflo(uu.x)), gelu_t(bfhi(uu.x)), gelu_t(bflo(uu.y)), gelu_t(bfhi(uu.y))};
#pragma unroll
            for (int k = 0; k < 4; ++k) { const float a = (cb ? a1[4 * u + k] : a0[4 * u + k]) + bias; const float zz = uv[k] * a; z[16 * cb + 4 * u + k] = zz; ss += zz * zz; }
        }
    ss = xhalf_sum(ss);
    const float rn = rsqrtf(ss * (1.0f / 64.0f) + 1e-6f);
    unsigned short* yp = ycat + (size_t)tok * 1024 + 256 + g * 64;
    const float* nw = normw + g * 64;
    float4 w4a[2][4];
#pragma unroll
    for (int cb = 0; cb < 2; ++cb)
#pragma unroll
        for (int u = 0; u < 4; ++u) w4a[cb][u] = *(const float4*)(nw + 32 * cb + 8 * u + 4 * h);
#pragma unroll
    for (int cb = 0; cb < 2; ++cb)
#pragma unroll
        for (int u = 0; u < 4; ++u) {
            const int c0 = 32 * cb + 8 * u + 4 * h;
            const float4 w4 = w4a[cb][u];
            u32x2 o = {cvtpk(z[16 * cb + 4 * u] * rn * w4.x, z[16 * cb + 4 * u + 1] * rn * w4.y), cvtpk(z[16 * cb + 4 * u + 2] * rn * w4.z, z[16 * cb + 4 * u + 3] * rn * w4.w)};
            *(u32x2*)(yp + c0) = o;
        }
}

#define WT_LAS __attribute__((address_space(3)))
__device__ __forceinline__ void cmp_wg(const unsigned short* __restrict__ hb, const unsigned short* __restrict__ w1t, const float* __restrict__ cbias, const unsigned short* __restrict__ w2t,
                                       unsigned short* __restrict__ kcb, unsigned short* __restrict__ vcb, WT_LAS float* red, int task, int wave, int lane) {
    const int cblk = task & 7, kv = (task >> 3) & 1, g = (task >> 4) & 1, b = task >> 5, r = lane & 31, h = lane >> 5;
    const int c = 32 * cblk + r; const int cl = c < 254 ? c : 254;
    const unsigned short* bp = hb + (size_t)(b * 4096 + 16 * cl) * 3072 + (kv ? 2176 : 2048) + g * 64 + 8 * h;
    const unsigned short* ap = w1t + ((size_t)kv * 128 + r) * 2048 + 8 * h;
    f32x16 acc[4];
#pragma unroll
    for (int nt = 0; nt < 4; ++nt) zero(acc[nt]);
#pragma unroll 4
    for (int kk = 0; kk < 16; ++kk) {
        const int ks = 16 * wave + kk;
        const bf16x8 bk = ld16(bp + (size_t)(ks >> 2) * 3072 + 16 * (ks & 3));
#pragma unroll
        for (int nt = 0; nt < 4; ++nt) acc[nt] = WT_MFMA(ld16(ap + (size_t)nt * 32 * 2048 + 16 * ks), bk, acc[nt]);
    }
#pragma unroll
    for (int nt = 0; nt < 4; ++nt)
#pragma unroll
        for (int i = 0; i < 16; ++i) red[(wave * 64 + nt * 16 + i) * 64 + lane] = acc[nt][i];
    asm volatile("s_waitcnt lgkmcnt(0)" ::: "memory"); __builtin_amdgcn_s_barrier();
#pragma unroll
    for (int q = 0; q < 8; ++q) {
        const int row = 8 * wave + q; float sacc = 0.f;
#pragma unroll
        for (int w2 = 0; w2 < 8; ++w2) sacc += red[(w2 * 64 + row) * 64 + lane];
        red[row * 64 + lane] = sacc;
    }
    asm volatile("s_waitcnt lgkmcnt(0)" ::: "memory"); __builtin_amdgcn_s_barrier();
    if (wave == 0) {
#pragma unroll
        for (int nt = 0; nt < 4; ++nt)
#pragma unroll
            for (int i = 0; i < 16; ++i) { const int n = 32 * nt + (i & 3) + 8 * (i >> 2) + 4 * h; acc[nt][i] = gelu_t(red[(nt * 16 + i) * 64 + lane] + cbias[kv * 128 + n]); }
        f32x16 o0, o1; zero(o0); zero(o1);
        const unsigned short* w2p = w2t + ((size_t)kv * 64 + r) * 128 + 4 * h;
#pragma unroll
        for (int nt = 0; nt < 4; ++nt)
#pragma unroll
            for (int s = 0; s < 2; ++s) {
                const bf16x8 pb = pack8(acc[nt], s);
                const unsigned short* wp = w2p + 32 * nt + 16 * s;
                o0 = WT_MFMA(ld8x2(wp, wp + 8), pb, o0);
                o1 = WT_MFMA(ld8x2(wp + 32 * 128, wp + 32 * 128 + 8), pb, o1);
            }
        if (c < 255) {
            unsigned short* op = (kv ? vcb : kcb) + ((size_t)(b * 2 + g) * 256 + c) * 64;
#pragma unroll
            for (int db = 0; db < 2; ++db)
#pragma unroll
                for (int u = 0; u < 4; ++u) {
                    const int d0 = 32 * db + 8 * u + 4 * h;
                    u32x2 o = {cvtpk(db ? o1[4 * u] : o0[4 * u], db ? o1[4 * u + 1] : o0[4 * u + 1]), cvtpk(db ? o1[4 * u + 2] : o0[4 * u + 2], db ? o1[4 * u + 3] : o0[4 * u + 3])};
                    *(u32x2*)(op + d0) = o;
                }
        }
    }
    __builtin_amdgcn_s_barrier();
}

__device__ __forceinline__ void kvprep8(const unsigned short* __restrict__ hb, const float* __restrict__ cosT, const float* __restrict__ sinT,
                                        unsigned short* __restrict__ ksb, unsigned short* __restrict__ vsb, unsigned short* __restrict__ kwb, unsigned short* __restrict__ vwb, int idx) {
    const int j8 = idx & 3, g = (idx >> 2) & 1, tok = idx >> 3, b = tok >> 12, t = tok & 4095;
    const unsigned short* hr = hb + (size_t)tok * 3072 + g * 64 + 8 * j8;
    const float4 c0 = *(const float4*)(cosT + (size_t)tok * 32 + 8 * j8), c1 = *(const float4*)(cosT + (size_t)tok * 32 + 8 * j8 + 4);
    const float4 s0 = *(const float4*)(sinT + (size_t)tok * 32 + 8 * j8), s1 = *(const float4*)(sinT + (size_t)tok * 32 + 8 * j8 + 4);
    u32x4 ka[2], kb[2], va[2], vb[2];
#pragma unroll
    for (int w = 0; w < 2; ++w) { const int col = w ? 2560 : 2304, vcol = w ? 2688 : 2432;
        ka[w] = *(const u32x4*)(hr + col); kb[w] = *(const u32x4*)(hr + col + 32); va[w] = *(const u32x4*)(hr + vcol); vb[w] = *(const u32x4*)(hr + vcol + 32); }
    const float cs[8] = {c0.x, c0.y, c0.z, c0.w, c1.x, c1.y, c1.z, c1.w}, sn[8] = {s0.x, s0.y, s0.z, s0.w, s1.x, s1.y, s1.z, s1.w};
    const size_t o = ((size_t)(b * 2 + g) * 4096 + t) * 64 + 8 * j8;
#pragma unroll
    for (int w = 0; w < 2; ++w) {
        u32x4 oa, ob;
#pragma unroll
        for (int c = 0; c < 4; ++c) {
            const float a0 = bflo(ka[w][c]), a1 = bfhi(ka[w][c]), b0 = bflo(kb[w][c]), b1 = bfhi(kb[w][c]);
            oa[c] = cvtpk(a0 * cs[2 * c] - b0 * sn[2 * c], a1 * cs[2 * c + 1] - b1 * sn[2 * c + 1]);
            ob[c] = cvtpk(b0 * cs[2 * c] + a0 * sn[2 * c], b1 * cs[2 * c + 1] + a1 * sn[2 * c + 1]);
        }
        unsigned short* kd = (w ? kwb : ksb) + o;
        *(u32x4*)kd = oa; *(u32x4*)(kd + 32) = ob;
        unsigned short* vd = (w ? vwb : vsb) + o;
        *(u32x4*)vd = va[w]; *(u32x4*)(vd + 32) = vb[w];
    }
}

__device__ __forceinline__ void hg_pass1(const unsigned short* __restrict__ hb, const float* __restrict__ lbl, unsigned short* __restrict__ Qt, unsigned short* __restrict__ Kt,
                                         unsigned short* __restrict__ Qp, unsigned short* __restrict__ VT, float* __restrict__ Ut, float* __restrict__ Dk, int ci, int lane_in) {
    int lane = lane_in; asm volatile("" : "+v"(lane));
    const int chunk = ci & 63, hd = (ci >> 6) & 3, b = ci >> 8;
    const unsigned short* hp = hb + (size_t)(b * 4096 + chunk * 64) * 3072 + hd * 64 + lane;
    const float lb = lbl[hd * 64 + lane];
    unsigned fpk[32];
#pragma unroll
    for (int hb2 = 0; hb2 < 2; ++hb2) { unsigned short rf[32];
#pragma unroll
      for (int t = 0; t < 32; ++t) rf[t] = hp[(size_t)(32 * hb2 + t) * 3072 + 256];
#pragma unroll
      for (int t = 0; t < 16; ++t) fpk[16 * hb2 + t] = (unsigned)rf[2 * t] | ((unsigned)rf[2 * t + 1] << 16); }
    float run = 0.f, cmid = 0.f;
#pragma unroll
    for (int t = 0; t < 64; ++t) {
        const float fr = (t & 1) ? bfhi(fpk[t >> 1]) : bflo(fpk[t >> 1]);
        run += __logf(lb + (1.0f - lb) * sigm(fr));
        if (t == 31) cmid = run;
    }
    const float blast = run;
    unsigned short* qt = Qt + (size_t)ci * 4096 + lane; unsigned short* kt = Kt + (size_t)ci * 4096 + lane; unsigned short* qp = Qp + (size_t)ci * 4096 + lane;
    unsigned short* vt = VT + (size_t)ci * 4096 + lane * 64;
    const int h = lane >> 5, r = lane & 31;
    f32x16 acc[2][2];
#pragma unroll
    for (int a = 0; a < 2; ++a)
#pragma unroll
        for (int c = 0; c < 2; ++c) zero(acc[a][c]);
    float bt = 0.f;
    Dk[(size_t)ci * 64 + lane] = __expf(blast);
#pragma unroll 1
    for (int ks = 0; ks < 4; ++ks) {
        unsigned short rq[1][16], ri[1][16];
#pragma unroll
        for (int tt = 0; tt < 16; ++tt) { const size_t o = (size_t)(ks * 16 + tt) * 3072; rq[0][tt] = hp[o]; ri[0][tt] = hp[o + 512]; }
        unsigned kp[8], vp[8];
        unsigned fsel[8];
#pragma unroll
        for (int tp = 0; tp < 8; ++tp) fsel[tp] = (ks == 0) ? fpk[tp] : (ks == 1) ? fpk[8 + tp] : (ks == 2) ? fpk[16 + tp] : fpk[24 + tp];
#pragma unroll
        for (int tp = 0; tp < 8; ++tp) {
            float k2v[2], ivv[2];
#pragma unroll
            for (int e = 0; e < 2; ++e) {
                const int t = ks * 16 + tp * 2 + e;
                const float qr = __uint_as_float((unsigned)rq[0][tp * 2 + e] << 16), fr = e ? bfhi(fsel[tp]) : bflo(fsel[tp]);
                ivv[e] = __uint_as_float((unsigned)ri[0][tp * 2 + e] << 16);
                const float sf = sigm(fr);
                const float q = qr * sigm(qr), kk = (1.0f - lb) * (1.0f - sf);
                bt += __logf(lb + (1.0f - lb) * sf);
                qt[t * 64] = (unsigned short)(cvtpk(q * __expf(bt - cmid), 0.f) & 0xffffu);
                kt[t * 64] = (unsigned short)(cvtpk(kk * __expf(cmid - bt), 0.f) & 0xffffu);
                qp[t * 64] = (unsigned short)(cvtpk(q * __expf(bt), 0.f) & 0xffffu);
                k2v[e] = kk * __expf(blast - bt);
            }
            kp[tp] = cvtpk(k2v[0], k2v[1]); vp[tp] = cvtpk(ivv[0], ivv[1]);
        }
        { u32x4 u0 = {vp[0], vp[1], vp[2], vp[3]}, u1 = {vp[4], vp[5], vp[6], vp[7]};
          *(u32x4*)(vt + ks * 16) = u0; *(u32x4*)(vt + ks * 16 + 8) = u1; }
        u32x4 kown, vown, ksnd, vsnd;
#pragma unroll
        for (int j = 0; j < 4; ++j) { kown[j] = h ? kp[4 + j] : kp[j]; ksnd[j] = h ? kp[j] : kp[4 + j]; vown[j] = h ? vp[4 + j] : vp[j]; vsnd[j] = h ? vp[j] : vp[4 + j]; }
        u32x4 krcv, vrcv;
#pragma unroll
        for (int j = 0; j < 4; ++j) { krcv[j] = (unsigned)__shfl_xor((int)ksnd[j], 32); vrcv[j] = (unsigned)__shfl_xor((int)vsnd[j], 32); }
        const bf16x8 kb0 = __builtin_bit_cast(bf16x8, h ? krcv : kown), kb1 = __builtin_bit_cast(bf16x8, h ? kown : krcv);
        const bf16x8 va0 = __builtin_bit_cast(bf16x8, h ? vrcv : vown), va1 = __builtin_bit_cast(bf16x8, h ? vown : vrcv);
        acc[0][0] = WT_MFMA(va0, kb0, acc[0][0]); acc[0][1] = WT_MFMA(va0, kb1, acc[0][1]);
        acc[1][0] = WT_MFMA(va1, kb0, acc[1][0]); acc[1][1] = WT_MFMA(va1, kb1, acc[1][1]);
    }
    float* up = Ut + (size_t)ci * 4096;
#pragma unroll
    for (int vb = 0; vb < 2; ++vb)
#pragma unroll
        for (int kb = 0; kb < 2; ++kb)
#pragma unroll
            for (int i = 0; i < 16; ++i) { const int v = 32 * vb + (i & 3) + 8 * (i >> 2) + 4 * h; up[v * 64 + 32 * kb + r] = acc[vb][kb][i]; }
}
__device__ __forceinline__ void hg_scan(const float* __restrict__ Ut, const float* __restrict__ Dk, unsigned short* __restrict__ ST, int e) {
    const int k = e & 63, seq = e >> 12, vk = e & 4095;
    float S = 0.f;
    const float* up = Ut + (size_t)seq * 64 * 4096 + vk; const float* dp = Dk + (size_t)seq * 64 * 64 + k; unsigned short* sp = ST + (size_t)seq * 64 * 4096 + vk;
#pragma unroll 8
    for (int c = 0; c < 64; ++c) {
        sp[(size_t)c * 4096] = (unsigned short)(cvtpk(S, 0.f) & 0xffffu);
        S = fmaf(dp[c * 64], S, up[(size_t)c * 4096]);
    }
}
__device__ __forceinline__ void hg_pass3(const unsigned short* __restrict__ hb, const unsigned short* __restrict__ Qt, const unsigned short* __restrict__ Kt, const unsigned short* __restrict__ Qp,
                                         const unsigned short* __restrict__ VT, const unsigned short* __restrict__ ST, const float* __restrict__ normw, unsigned short* __restrict__ ycat, int task, int lane) {
    const int tblk = task & 1, ci = task >> 1, chunk = ci & 63, hd = (ci >> 6) & 3, b = ci >> 8, r = lane & 31, h = lane >> 5;
    const size_t cb = (size_t)ci * 4096;
    f32x16 o0, o1; zero(o0); zero(o1);
    {
        const unsigned short* sp = ST + cb + (size_t)r * 64 + 8 * h; const unsigned short* qp = Qp + cb + (size_t)(32 * tblk + r) * 64 + 8 * h;
#pragma unroll
        for (int ks = 0; ks < 4; ++ks) { const bf16x8 q = ld16(qp + 16 * ks); o0 = WT_MFMA(ld16(sp + 16 * ks), q, o0); o1 = WT_MFMA(ld16(sp + 32 * 64 + 16 * ks), q, o1); }
    }
    const unsigned short* qtp = Qt + cb + (size_t)(32 * tblk + r) * 64 + 8 * h;
    bf16x8 qf[4];
#pragma unroll
    for (int ks = 0; ks < 4; ++ks) qf[ks] = ld16(qtp + 16 * ks);
#pragma unroll 1
    for (int sblk = 0; sblk <= tblk; ++sblk) {
        f32x16 at; zero(at);
        const unsigned short* ktp = Kt + cb + (size_t)(32 * sblk + r) * 64 + 8 * h;
#pragma unroll
        for (int ks = 0; ks < 4; ++ks) at = WT_MFMA(ld16(ktp + 16 * ks), qf[ks], at);
        if (sblk == tblk) {
#pragma unroll
            for (int i = 0; i < 16; ++i) { const int sl = (i & 3) + 8 * (i >> 2) + 4 * h; at[i] = (sl <= r) ? at[i] : 0.f; }
        }
#pragma unroll
        for (int s2 = 0; s2 < 2; ++s2) {
            const bf16x8 pb = pack8(at, s2);
            const unsigned short* vp = VT + cb + (size_t)r * 64 + 32 * sblk + 16 * s2 + 4 * h;
            o0 = WT_MFMA(ld8x2(vp, vp + 8), pb, o0);
            o1 = WT_MFMA(ld8x2(vp + 32 * 64, vp + 32 * 64 + 8), pb, o1);
        }
    }
    const int tok = b * 4096 + chunk * 64 + 32 * tblk + r;
    float ss = 0.f;
#pragma unroll
    for (int i = 0; i < 16; ++i) ss += o0[i] * o0[i] + o1[i] * o1[i];
    ss = xhalf_sum(ss);
    const float rn = rsqrtf(ss * (1.0f / 64.0f) + 1e-6f);
    const unsigned short* gp = hb + (size_t)tok * 3072 + 768 + hd * 64;
    unsigned short* yp = ycat + (size_t)tok * 1024 + hd * 64;
    const float* nw = normw + hd * 64;
    u32x2 gg[2][4]; float4 w4[2][4];
#pragma unroll
    for (int vb = 0; vb < 2; ++vb)
#pragma unroll
        for (int u = 0; u < 4; ++u) { const int v0 = 32 * vb + 8 * u + 4 * h; gg[vb][u] = *(const u32x2*)(gp + v0); w4[vb][u] = *(const float4*)(nw + v0); }
#pragma unroll
    for (int vb = 0; vb < 2; ++vb)
#pragma unroll
        for (int u = 0; u < 4; ++u) {
            const int v0 = 32 * vb + 8 * u + 4 * h;
            const float x0 = (vb ? o1[4 * u] : o0[4 * u]) * rn * w4[vb][u].x * sigm(bflo(gg[vb][u].x)), x1 = (vb ? o1[4 * u + 1] : o0[4 * u + 1]) * rn * w4[vb][u].y * sigm(bfhi(gg[vb][u].x));
            const float x2 = (vb ? o1[4 * u + 2] : o0[4 * u + 2]) * rn * w4[vb][u].z * sigm(bflo(gg[vb][u].y)), x3 = (vb ? o1[4 * u + 3] : o0[4 * u + 3]) * rn * w4[vb][u].w * sigm(bfhi(gg[vb][u].y));
            u32x2 o = {cvtpk(x0, x1), cvtpk(x2, x3)};
            *(u32x2*)(yp + v0) = o;
        }
}

__device__ __forceinline__ void route_task(const unsigned short* __restrict__ x1, const unsigned short* __restrict__ rwh, const unsigned short* __restrict__ rwl, const float* __restrict__ rb,
                                           int* __restrict__ cnt, int* __restrict__ list, int* __restrict__ tok_e, int* __restrict__ tok_slot, float* __restrict__ tok_w, int task, int lane) {
    const int r = lane & 31, h = lane >> 5, tok = task * 32 + r;
    const unsigned short* xp = x1 + (size_t)tok * 1024 + 8 * h;
    const unsigned short* whp = rwh + (size_t)r * 1024 + 8 * h; const unsigned short* wlp = rwl + (size_t)r * 1024 + 8 * h;
    f32x16 acc; zero(acc);
#pragma unroll 8
    for (int ks = 0; ks < 64; ++ks) {
        const bf16x8 xh = ld16(xp + 16 * ks);
        acc = WT_MFMA(ld16(whp + 16 * ks), xh, acc); acc = WT_MFMA(ld16(wlp + 16 * ks), xh, acc);
    }
    float v[16];
#pragma unroll
    for (int i = 0; i < 16; ++i) v[i] = acc[i] + rb[(i & 3) + 8 * (i >> 2) + 4 * h];
    float cv[8]; int ce[8];
#pragma unroll
    for (int k = 0; k < 4; ++k) {
        float best = -3.0e38f; int bi = 0;
#pragma unroll
        for (int i = 0; i < 16; ++i) { const bool ok = v[i] > best; best = ok ? v[i] : best; bi = ok ? i : bi; }
#pragma unroll
        for (int i = 0; i < 16; ++i) v[i] = (i == bi) ? -3.0e38f : v[i];
        cv[k] = best; ce[k] = (bi & 3) + 8 * (bi >> 2) + 4 * h;
    }
#pragma unroll
    for (int k = 0; k < 4; ++k) { cv[4 + k] = xhalf(cv[k]); ce[4 + k] = __shfl_xor(ce[k], 32); }
    float tl[4]; int te[4];
#pragma unroll
    for (int k = 0; k < 4; ++k) {
        float best = -3.0e38f; int be = 64, bj = 0;
#pragma unroll
        for (int j = 0; j < 8; ++j) { const bool ok = (cv[j] > best) || (cv[j] == best && ce[j] < be); best = ok ? cv[j] : best; be = ok ? ce[j] : be; bj = ok ? j : bj; }
#pragma unroll
        for (int j = 0; j < 8; ++j) cv[j] = (j == bj) ? -3.0e38f : cv[j];
        tl[k] = best; te[k] = be;
    }
    const float e1 = __expf(tl[1] - tl[0]), e2 = __expf(tl[2] - tl[0]), e3 = __expf(tl[3] - tl[0]);
    const float inv = 1.0f / (1.0f + e1 + e2 + e3);
    const float tw[4] = {inv, e1 * inv, e2 * inv, e3 * inv};
    unsigned mymask = 0u;
#pragma unroll 1
    for (int e = 0; e < 32; ++e) {
        const unsigned mk = (unsigned)__ballot(h == 0 && (te[0] == e || te[1] == e || te[2] == e || te[3] == e));
        mymask = (lane == e) ? mk : mymask;
    }
    int base = 0;
    if (lane < 32 && mymask != 0u) base = atomicAdd(&cnt[lane], __popc(mymask));
#pragma unroll
    for (int k = 0; k < 4; ++k) {
        const int bk = __shfl(base, te[k]); const unsigned mk = (unsigned)__shfl((int)mymask, te[k]);
        const int slot = bk + __popc(mk & ((1u << r) - 1u));
        if (h == 0) { list[te[k] * 32768 + slot] = tok; tok_e[tok * 4 + k] = te[k]; tok_slot[tok * 4 + k] = slot; tok_w[tok * 4 + k] = tw[k]; }
    }
}
}


__device__ __forceinline__ void ln1_tok2(const float* __restrict__ xin_f, const bf16* __restrict__ xin_b, const bf16* __restrict__ mix, const float* __restrict__ lw, const float* __restrict__ lbias,
                                         bf16* __restrict__ x1b, unsigned char* __restrict__ x1q, int tok0, int lane) {
    float v[2][16]; float s[2] = {0.f, 0.f};
#pragma unroll
    for (int u = 0; u < 2; ++u)
#pragma unroll
        for (int j = 0; j < 4; ++j) {
            const size_t o = (size_t)(tok0 + u) * D_ + j * 256 + lane * 4;
            float4 a;
            if (xin_f) a = *(const float4*)(xin_f + o);
            else { const uint2 ab = *(const uint2*)(xin_b + o);
                   a = make_float4(__uint_as_float(ab.x << 16), __uint_as_float(ab.x & 0xffff0000u), __uint_as_float(ab.y << 16), __uint_as_float(ab.y & 0xffff0000u)); }
            const uint2 mb = *(const uint2*)(mix + o);
            v[u][4 * j] = ALPHA * a.x + __uint_as_float(mb.x << 16); v[u][4 * j + 1] = ALPHA * a.y + __uint_as_float(mb.x & 0xffff0000u);
            v[u][4 * j + 2] = ALPHA * a.z + __uint_as_float(mb.y << 16); v[u][4 * j + 3] = ALPHA * a.w + __uint_as_float(mb.y & 0xffff0000u);
            s[u] += (v[u][4 * j] + v[u][4 * j + 1]) + (v[u][4 * j + 2] + v[u][4 * j + 3]);
        }
    float rstd[2];
#pragma unroll
    for (int u = 0; u < 2; ++u) {
        const float mean = wsum(s[u]) * (1.0f / D_); float q = 0.f;
#pragma unroll
        for (int i = 0; i < 16; ++i) { v[u][i] -= mean; q += v[u][i] * v[u][i]; }
        rstd[u] = rsqrtf(wsum(q) * (1.0f / D_) + 1e-5f);
    }
    float4 w4a[4], b4a[4];
#pragma unroll
    for (int j = 0; j < 4; ++j) { w4a[j] = *(const float4*)(lw + j * 256 + lane * 4); b4a[j] = *(const float4*)(lbias + j * 256 + lane * 4); }
#pragma unroll
    for (int j = 0; j < 4; ++j) {
        const float4 w4 = w4a[j], b4 = b4a[j];
#pragma unroll
        for (int u = 0; u < 2; ++u) {
            const size_t o = (size_t)(tok0 + u) * D_ + j * 256 + lane * 4;
            const float4 r = make_float4(v[u][4 * j] * rstd[u] * w4.x + b4.x, v[u][4 * j + 1] * rstd[u] * w4.y + b4.y, v[u][4 * j + 2] * rstd[u] * w4.z + b4.z, v[u][4 * j + 3] * rstd[u] * w4.w + b4.w);
            *(uint2*)(x1b + o) = make_uint2(pk2(r.x, r.y), pk2(r.z, r.w));
            *(unsigned*)(x1q + o) = pg8::pk4_fp8(r.x, r.y, r.z, r.w);
        }
    }
}
__device__ __forceinline__ void comb_ln2_tok2(const bf16* __restrict__ x1, const bf16* __restrict__ y, const int* __restrict__ offs, const int* __restrict__ tok_e,
                                              const int* __restrict__ tok_slot, const float* __restrict__ tok_w, const float* __restrict__ lw, const float* __restrict__ lbias,
                                              float* __restrict__ xout, bf16* __restrict__ xbout, int tok0, int lane, const int (&row)[2][4], const float (&wk)[2][4]) {
    float v[2][16];
#pragma unroll
    for (int u = 0; u < 2; ++u)
#pragma unroll
        for (int j = 0; j < 4; ++j) { const uint2 ab = *(const uint2*)(x1 + (size_t)(tok0 + u) * D_ + j * 256 + lane * 4);
            v[u][4 * j] = ALPHA * __uint_as_float(ab.x << 16); v[u][4 * j + 1] = ALPHA * __uint_as_float(ab.x & 0xffff0000u); v[u][4 * j + 2] = ALPHA * __uint_as_float(ab.y << 16); v[u][4 * j + 3] = ALPHA * __uint_as_float(ab.y & 0xffff0000u); }
#pragma unroll
    for (int u = 0; u < 2; ++u)
#pragma unroll
        for (int k = 0; k < 4; ++k)
#pragma unroll
            for (int j = 0; j < 4; ++j) { const uint2 ab = *(const uint2*)(y + (size_t)row[u][k] * D_ + j * 256 + lane * 4); const float w = wk[u][k];
                v[u][4 * j] = fmaf(w, __uint_as_float(ab.x << 16), v[u][4 * j]); v[u][4 * j + 1] = fmaf(w, __uint_as_float(ab.x & 0xffff0000u), v[u][4 * j + 1]);
                v[u][4 * j + 2] = fmaf(w, __uint_as_float(ab.y << 16), v[u][4 * j + 2]); v[u][4 * j + 3] = fmaf(w, __uint_as_float(ab.y & 0xffff0000u), v[u][4 * j + 3]); }
    float rstd[2];
#pragma unroll
    for (int u = 0; u < 2; ++u) {
        float s = 0.f;
#pragma unroll
        for (int i = 0; i < 16; ++i) s += v[u][i];
        const float mean = wsum(s) * (1.0f / D_); float q = 0.f;
#pragma unroll
        for (int i = 0; i < 16; ++i) { v[u][i] -= mean; q += v[u][i] * v[u][i]; }
        rstd[u] = rsqrtf(wsum(q) * (1.0f / D_) + 1e-5f);
    }
    float4 w4a[4], b4a[4];
#pragma unroll
    for (int j = 0; j < 4; ++j) { w4a[j] = *(const float4*)(lw + j * 256 + lane * 4); b4a[j] = *(const float4*)(lbias + j * 256 + lane * 4); }
#pragma unroll
    for (int j = 0; j < 4; ++j) {
        const float4 w4 = w4a[j], b4 = b4a[j];
#pragma unroll
        for (int u = 0; u < 2; ++u) {
            const size_t o = (size_t)(tok0 + u) * D_ + j * 256 + lane * 4;
            const float4 r = make_float4(v[u][4 * j] * rstd[u] * w4.x + b4.x, v[u][4 * j + 1] * rstd[u] * w4.y + b4.y, v[u][4 * j + 2] * rstd[u] * w4.z + b4.z, v[u][4 * j + 3] * rstd[u] * w4.w + b4.w);
            if (xout) *(float4*)(xout + o) = r;
            if (xbout) *(uint2*)(xbout + o) = make_uint2(pk2(r.x, r.y), pk2(r.z, r.w));
        }
    }
}

struct Args { const float* in[25]; float* out; unsigned char* ws; int ph_lo, ph_hi; };
#define PH __device__ __forceinline__
constexpr int TAB_OFF = 131072;

__device__ __forceinline__ void transpose_item(const float* __restrict__ W, int K, int N, bf16* __restrict__ WT, int k0, int scol0, int drow0, float* scr, int lane) {
    const int cc = lane & 31; const bool cv = (scol0 + cc) < N;
#pragma unroll 8
    for (int i = 0; i < 32; ++i) { const int kk = 2 * i + (lane >> 5); scr[kk * 33 + cc] = cv ? W[(size_t)(k0 + kk) * N + scol0 + cc] : 0.f; }
    asm volatile("s_waitcnt lgkmcnt(0)" ::: "memory");
    const int c = lane & 7;
#pragma unroll
    for (int j = 0; j < 4; ++j) { const int n = (lane >> 3) + 8 * j; const float* s = scr + (8 * c) * 33 + n;
        uint4 o; o.x = pk2(s[0 * 33], s[1 * 33]); o.y = pk2(s[2 * 33], s[3 * 33]); o.z = pk2(s[4 * 33], s[5 * 33]); o.w = pk2(s[6 * 33], s[7 * 33]);
        *(uint4*)(WT + (size_t)(drow0 + n) * K + k0 + 8 * c) = o; }
    asm volatile("s_waitcnt lgkmcnt(0)" ::: "memory");
}
__device__ __forceinline__ void transpose64(const float* __restrict__ W, int K, int N, bf16* __restrict__ WT, int k0, int scol0, int drow0, int lane) {
    const int q = lane >> 4, c = lane & 15;
    const bool cv = (scol0 + 4 * c) < N;
    const float* src = W + (size_t)(k0 + 16 * q) * N + scol0 + 4 * c;
    float4 v[16];
#pragma unroll
    for (int i = 0; i < 16; ++i) v[i] = cv ? *(const float4*)(src + (size_t)i * N) : make_float4(0.f, 0.f, 0.f, 0.f);
    bf16* dst = WT + (size_t)(drow0 + 4 * c) * K + k0 + 16 * q;
#pragma unroll
    for (int j = 0; j < 4; ++j) {
        float e[16];
#pragma unroll
        for (int i = 0; i < 16; ++i) e[i] = (j == 0) ? v[i].x : (j == 1) ? v[i].y : (j == 2) ? v[i].z : v[i].w;
        uint4 o0, o1;
        o0.x = pk2(e[0], e[1]); o0.y = pk2(e[2], e[3]); o0.z = pk2(e[4], e[5]); o0.w = pk2(e[6], e[7]);
        o1.x = pk2(e[8], e[9]); o1.y = pk2(e[10], e[11]); o1.z = pk2(e[12], e[13]); o1.w = pk2(e[14], e[15]);
        *(uint4*)(dst + (size_t)j * K) = o0; *(uint4*)(dst + (size_t)j * K + 8) = o1;
    }
}
struct T64Item { const float* src; unsigned char* dst; };
__device__ __forceinline__ void t64_load(const float* src, int N, float4 (&v)[16]) {
#pragma unroll
    for (int i = 0; i < 16; ++i) { typedef float f4v __attribute__((ext_vector_type(4))); const f4v t = __builtin_nontemporal_load((const f4v*)(src + (size_t)i * N)); v[i] = make_float4(t.x, t.y, t.z, t.w); }
}
__device__ __forceinline__ unsigned pk4_fp8_nc(float a, float b, float c, float d) { int p = __builtin_amdgcn_cvt_pk_fp8_f32(a, b, 0, false); p = __builtin_amdgcn_cvt_pk_fp8_f32(c, d, p, true); return (unsigned)p; }
__device__ __forceinline__ void t64_store_f8(unsigned char* dst, int K, float sc, const float4 (&v)[16]) {
#pragma unroll
    for (int j = 0; j < 4; ++j) {
        float e[16];
#pragma unroll
        for (int i = 0; i < 16; ++i) e[i] = sc * ((j == 0) ? v[i].x : (j == 1) ? v[i].y : (j == 2) ? v[i].z : v[i].w);
        uint4 o;
        o.x = pk4_fp8_nc(e[0], e[1], e[2], e[3]); o.y = pk4_fp8_nc(e[4], e[5], e[6], e[7]); o.z = pk4_fp8_nc(e[8], e[9], e[10], e[11]); o.w = pk4_fp8_nc(e[12], e[13], e[14], e[15]);
        *(uint4*)(dst + (size_t)j * K) = o;
    }
}
__device__ __forceinline__ void t64_item(int it, const float* w_up, const float* w_dn, unsigned char* wt_up, unsigned char* wt_dn, int lane, const float*& src, unsigned char*& dst, int& N, float& sc) {
    constexpr int I_UP = 16 * 32, I_DN = 16 * 16;
    const int q = lane >> 4, c = lane & 15;
    if (it < NE * I_UP) { const int e = it / I_UP, r = it % I_UP, kb = r / 32, nb = r % 32;
        const int n0 = nb * 64, pn = n0 >> 8, bj = (n0 >> 7) & 1, jj = n0 & 127;
        src = w_up + (size_t)e * D_ * 2048 + (size_t)(kb * 64 + 16 * q) * 2048 + bj * 1024 + 128 * pn + jj + 4 * c;
        dst = wt_up + (size_t)e * 2048 * D_ + (size_t)(n0 + 4 * c) * D_ + kb * 64 + 16 * q; N = 2048; sc = pg8::F8_SU; }
    else { const int r0 = it - NE * I_UP; const int e = r0 / I_DN, r = r0 % I_DN, kb = r / 16, nb = r % 16;
        src = w_dn + (size_t)e * D_ * D_ + (size_t)(kb * 64 + 16 * q) * D_ + nb * 64 + 4 * c;
        dst = wt_dn + (size_t)e * D_ * D_ + (size_t)(nb * 64 + 4 * c) * D_ + kb * 64 + 16 * q; N = D_; sc = pg8::F8_SD; }
}
PH void ph_prologue(int wv, const int* pos, const float* hg_lb, float* cosT, float* sinT, float* lb,
                    const float* x, bf16* xb, const float* w_in, const float* w_out, const float* w_up, const float* w_dn, bf16* wt_in, bf16* wt_out, bf16* wt_up, bf16* wt_dn,
                    const float* gm_sw, bf16* wb, const float* cpe, const float* cw1, bf16* w1t, float* cbias, const float* cw2, bf16* w2t, const float* rw, bf16* rwh, bf16* rwl) {
    extern __shared__ __attribute__((aligned(16))) unsigned char lds[];
    int tid = mk_tid(wv), bid = blockIdx.x; asm volatile("" : "+v"(tid), "+s"(bid)); const int G = gridDim.x, lane = tid & 63, wave = wv;
#pragma unroll 1
    for (int i0 = bid * NTHR + tid; i0 < NT * 32; i0 += 4 * G * NTHR) {
        int pv[4];
#pragma unroll
        for (int u = 0; u < 4; ++u) { const int i = i0 + u * G * NTHR; pv[u] = (i < NT * 32) ? pos[i >> 5] : 0; }
#pragma unroll
        for (int u = 0; u < 4; ++u) { const int i = i0 + u * G * NTHR; if (i < NT * 32) { const int j = i & 31;
            float inv = (float)pow(10000.0, -(double)(2 * j) / 64.0);
            float ang = (float)pv[u] * inv;
            const double ad = (double)ang, kk = rint(ad * 0.15915494309189535);
            const float rf = (float)fma(-kk, 6.283185307179586, ad);
            cosT[i] = cosf(rf); sinT[i] = sinf(rf); } }
    }
    if (bid == 0 && tid < 256) {
        float p0 = hg_lb[tid], p1 = hg_lb[256 + tid];
        float m = fmaxf(p0, p1); float ea = expf(p0 - m), eb = expf(p1 - m);
        lb[tid] = 0.f; lb[256 + tid] = eb / (ea + eb);
    }
    {
        const size_t n4 = (size_t)NT * D_ / 4, stride = (size_t)G * NTHR;
#pragma unroll 1
        for (size_t i = (size_t)bid * NTHR + tid; i < n4; i += 8 * stride) {
            float4 v[8];
#pragma unroll
            for (int u = 0; u < 8; ++u) { const size_t j = i + u * stride; v[u] = (j < n4) ? ((const float4*)x)[j] : make_float4(0.f, 0.f, 0.f, 0.f); }
#pragma unroll
            for (int u = 0; u < 8; ++u) { const size_t j = i + u * stride; if (j < n4) ((uint2*)xb)[j] = make_uint2(pk2(v[u].x, v[u].y), pk2(v[u].z, v[u].w)); }
        }
    }
#pragma unroll 1
    for (int i = bid * NTHR + tid; i < DEPTH * NE * D_; i += G * NTHR) { const int k = i & 1023, e = (i >> 10) & 31, l = i >> 15; const float w = rw[((size_t)l * D_ + k) * NE + e];
        const unsigned hi = f2bf(w); rwh[i] = (bf16)hi; rwl[i] = (bf16)f2bf(w - __uint_as_float(hi << 16)); }
#pragma unroll 1
    for (int i = bid * NTHR + tid; i < DEPTH * 4 * 128 * 128; i += G * NTHR) { const int s = i & 127, t = (i >> 7) & 127; wb[i] = (bf16)f2bf(s <= t ? gm_sw[i] : 0.f); }
    {
        const int gwv = bid * 8 + wave, NGWV = G * 8;
#pragma unroll 1
        for (int o = gwv; o < DEPTH * 2 * 128; o += NGWV) {
            const int lk = o >> 7, n = o & 127;
            float a = 0.f;
#pragma unroll 8
            for (int i = lane; i < 2048; i += 64) a = fmaf(cpe[lk * 2048 + i], cw1[((size_t)lk * 2048 + i) * 128 + n], a);
            a = wsum(a);
            if (lane == 0) cbias[o] = a;
        }
    }
    float* scr = (float*)(lds + wave * 16384);
    const int gw = bid * 8 + wave, NGW = G * 8;
    constexpr int I_IN = 16 * 45, I_OUT = 16 * 16;
    constexpr int I_C1 = 32 * 4;
    constexpr int I_C2 = 2 * 2;
    constexpr int PER_L = I_IN + I_OUT + 2 * I_C1 + 2 * I_C2;
#pragma unroll 1
    for (int it = gw; it < DEPTH * PER_L; it += NGW) {
        const int l = it / PER_L; int r = it % PER_L;
        if (r < I_IN) { const int kb = r / 45, nb = r % 45; transpose64(w_in + (size_t)l * D_ * INW, D_, INW, wt_in + (size_t)l * HS * D_, kb * 64, nb * 64, nb * 64, lane); continue; }
        r -= I_IN;
        if (r < I_OUT) { const int kb = r / 16, nb = r % 16; transpose64(w_out + (size_t)l * D_ * D_, D_, D_, wt_out + (size_t)l * D_ * D_, kb * 64, nb * 64, nb * 64, lane); continue; }
        r -= I_OUT;
        if (r < 2 * I_C1) { const int kv = r / I_C1, q = r % I_C1, kb = q / 4, nb = q % 4;
            transpose_item(cw1 + ((size_t)l * 2 + kv) * 2048 * 128, 2048, 128, w1t + ((size_t)l * 2 + kv) * 128 * 2048, kb * 64, nb * 32, nb * 32, scr, lane); continue; }
        r -= 2 * I_C1;
        { const int kv = r / I_C2, q = r % I_C2, kb = q / 2, nb = q % 2;
            transpose_item(cw2 + ((size_t)l * 2 + kv) * 128 * 64, 128, 64, w2t + ((size_t)l * 2 + kv) * 64 * 128, kb * 64, nb * 32, nb * 32, scr, lane); }
    }
}
#define M1EN(x) 1
#ifndef M1REP
#define M1R(x) 1
#else
#define M1R(x) (((x) == M1REP) ? 3 : 1)
#endif
PH void ph_mix1(int wv, const bf16* hb, const float* lb, bf16* hqt, bf16* hkt, bf16* hqp, bf16* hvt, float* hut, float* hdk,
                const float* glw, const float* glb, bf16* vlnT, const bf16* w1t, const float* cbias, const bf16* w2, bf16* kcb, bf16* vcb,
                const float* cosT, const float* sinT, bf16* ksb, bf16* vsb, bf16* kwb, bf16* vwb,
                const float* w_up, const float* w_dn, unsigned char* wt_up, unsigned char* wt_dn) {
    extern __shared__ __attribute__((aligned(16))) unsigned char lds[];
    int tid = mk_tid(wv), bid = blockIdx.x; asm volatile("" : "+v"(tid), "+s"(bid)); const int lane = tid & 63, wave = wv, G = gridDim.x;
    const int gw = bid * 8 + wave, NGW = G * 8;
    { int ln = lane; asm volatile("" : "+v"(ln));
#pragma unroll 1
    for (int rp = 0; rp < M1R(1); ++rp)
#pragma unroll 1
    for (int u = bid; u < 256 && M1EN(1); u += G) wt::cmp_wg(hb, w1t, cbias, w2, kcb, vcb, (WT_LAS float*)lds, u, wave, ln); }
#pragma unroll 1
    for (int pass = 0; pass < 2; ++pass) {
        if (((pass ^ wave) & 1) == 0) {
            { int ln = lane; asm volatile("" : "+v"(ln));
#pragma unroll 1
            for (int rp = 0; rp < M1R(2); ++rp)
#pragma unroll 1
            for (int u = gw; u < 2048 && M1EN(2); u += NGW) wt::hg_pass1(hb, lb, hqt, hkt, hqp, hvt, hut, hdk, u, ln); }
            { int ln = lane; asm volatile("" : "+v"(ln));
#pragma unroll 1
            for (int rp = 0; rp < M1R(4); ++rp)
#pragma unroll 1
            for (int u = gw; u < NT / 8 && M1EN(4); u += NGW) wt::gm_ln8(hb, glw, glb, vlnT, u, ln); }
            { int t_ = tid; asm volatile("" : "+v"(t_));
#pragma unroll 1
            for (int rp = 0; rp < M1R(8); ++rp)
#pragma unroll 1
            for (int idx = bid * NTHR + t_; idx < NT * 8; idx += G * NTHR) wt::kvprep8(hb, cosT, sinT, ksb, vsb, kwb, vwb, idx); }
        } else {
            int ln = lane; asm volatile("" : "+v"(ln));
            constexpr int NIT = NE * (16 * 32 + 16 * 16);
#pragma unroll 1
            for (int rp = 0; rp < M1R(16); ++rp)
#pragma unroll 1
            for (int it = gw; it < NIT; it += NGW) {
                float4 va[16]; const float* s0; unsigned char* d0; int n0_; float c0_;
                t64_item(it, w_up, w_dn, wt_up, wt_dn, ln, s0, d0, n0_, c0_); t64_load(s0, n0_, va); t64_store_f8(d0, D_, c0_, va);
            }
        }
    }
}
PH void ph_mix2(int wv, const float* hut, const float* hdk, bf16* hst, const bf16* hb, const bf16* vlnT, const bf16* wb, const float* sb, const float* nw, bf16* ycat) {
    int tid = mk_tid(wv), bid = blockIdx.x; asm volatile("" : "+v"(tid), "+s"(bid)); const int lane = tid & 63, wave = wv, G = gridDim.x;
#pragma unroll 1
    for (int e = bid * NTHR + tid; e < 32 * 4096; e += G * NTHR) wt::hg_scan(hut, hdk, hst, e);
    const int gw = bid * 8 + wave, NGW = G * 8;
#pragma unroll 1
    for (int u = gw; u < 4096; u += NGW) wt::gm_sp_task(hb, vlnT, wb, sb, nw, ycat, u, lane);
}
PH void ph_hg3(int wv, const bf16* hb, const bf16* hqt, const bf16* hkt, const bf16* hqp, const bf16* hvt, const bf16* hst, const float* nw, bf16* ycat) {
    int tid = mk_tid(wv), bid = blockIdx.x; asm volatile("" : "+v"(tid), "+s"(bid)); const int lane = tid & 63, wave = wv, G = gridDim.x;
    const int gw = bid * 8 + wave, NGW = G * 8;
#pragma unroll 1
    for (int u = gw; u < 4096; u += NGW) wt::hg_pass3(hb, hqt, hkt, hqp, hvt, hst, nw, ycat, u, lane);
}
PH void ph_ln1_route(int wv, const float* xin_f, const bf16* xin_b, const bf16* mix, const float* lw, const float* lb, bf16* x1b, unsigned char* x1q,
                     const bf16* rwh, const bf16* rwl, const float* rb, int* cnt, int* list, int* tok_e, int* tok_slot, float* tok_w) {
    int tid = mk_tid(wv), bid = blockIdx.x; asm volatile("" : "+v"(tid), "+s"(bid)); const int lane = tid & 63, wave = wv, G = gridDim.x;
#pragma unroll 1
    for (int it = bid; it < NT / 128; it += G) {
        { int ln = lane; asm volatile("" : "+v"(ln));
#pragma unroll 1
          for (int k = 0; k < 8; ++k) ln1_tok2(xin_f, xin_b, mix, lw, lb, x1b, x1q, it * 128 + wave * 16 + 2 * k, ln); }
        asm volatile("s_waitcnt vmcnt(0)" ::: "memory"); __builtin_amdgcn_fence(__ATOMIC_RELEASE, "workgroup"); __syncthreads(); __builtin_amdgcn_fence(__ATOMIC_ACQUIRE, "workgroup");
        if (wave < 4) { int ln = lane; asm volatile("" : "+v"(ln)); wt::route_task(x1b, rwh, rwl, rb, cnt, list, tok_e, tok_slot, tok_w, it * 4 + wave, ln); }
    }
}
PH void ph_comb(int wv, const bf16* x1, const bf16* ybuf, const int* tok_e, const int* tok_slot, const float* tok_w, const float* lw, const float* lb, float* xo, bf16* xbo) {
    extern __shared__ __attribute__((aligned(16))) unsigned char lds[];
    const int* offs_s = (const int*)(lds + TAB_OFF + 512);
    int tid = mk_tid(wv), bid = blockIdx.x; asm volatile("" : "+v"(tid), "+s"(bid)); const int lane = tid & 63, wave = wv, G = gridDim.x;
#pragma unroll 1
    for (int t0 = (bid * 8 + wave) * 16; t0 < NT; t0 += G * 128) {
        const int ia = t0 * 4 + lane;
        const int rowl = offs_s[tok_e[ia]] + tok_slot[ia]; const float wl = tok_w[ia];
#pragma unroll 1
        for (int p = 0; p < 8; ++p) {
            int row[2][4]; float wk[2][4];
#pragma unroll
            for (int u = 0; u < 2; ++u)
#pragma unroll
                for (int k = 0; k < 4; ++k) { row[u][k] = __shfl(rowl, p * 8 + u * 4 + k); wk[u][k] = __shfl(wl, p * 8 + u * 4 + k); }
            comb_ln2_tok2(x1, ybuf, offs_s, tok_e, tok_slot, tok_w, lw, lb, xo, xbo, t0 + 2 * p, lane, row, wk);
        }
    }
}

typedef const Args __attribute__((address_space(4))) CArgs;
#define PHASE_BEGIN CArgs* ap = (CArgs*)__builtin_amdgcn_kernarg_segment_ptr(); int l_ = l; asm volatile("" : "+s"(ap), "+s"(l_)); unsigned char* const ws_ = ap->ws; \
    const int G = gridDim.x; int bid = blockIdx.x; asm volatile("" : "+s"(bid));
#define WP(T, off) ((T*)(ws_ + (off)))
#define INP(k) (ap->in[k])
__global__ void __launch_bounds__(NTHR, 2) mega(Args a) {
    extern __shared__ __attribute__((aligned(16))) unsigned char lds[];
    volatile LAS unsigned* MISC = (volatile LAS unsigned*)((LAS unsigned char*)lds + MISC_OFF);
    int wv = __builtin_amdgcn_readfirstlane((int)threadIdx.x >> 6); asm volatile("" : "+s"(wv));
    { const int t0 = mk_tid(wv); if (t0 < 64) MISC[t0] = 0u; }
    __syncthreads();
    XcdBarrier bar = xcd_barrier_post((unsigned*)a.ws, MISC + 8, wv);
    int* tstart = (int*)(lds + TAB_OFF); int* cnts = (int*)(lds + TAB_OFF + 256); int* offs_s = (int*)(lds + TAB_OFF + 512);
    PG8_LAS unsigned char* ldsl = (PG8_LAS unsigned char*)lds;

#ifndef PH_MASK
#define EN(n) 1
#else
#define EN(n) ((PH_MASK >> ((n) % 20)) & 1)
#endif
#define IN(k) 1
#ifndef REP_PH
#define REPL(id)
#else
#define REPL(id) _Pragma("unroll 1") for (int rep_ = 0; rep_ < (((id) == REP_PH) ? REP_N : 1); ++rep_)
#endif
#define SEAM(k) xcd_barrier(bar)

    REPL(19) if (EN(19) && IN(0)) { const int l = 0; PHASE_BEGIN; (void)l_; (void)G; (void)bid;
        ph_prologue(wv, (const int*)INP(1), INP(3), WP(float, O_COS), WP(float, O_SIN), WP(float, O_LB), INP(0), WP(bf16, O_XB), INP(2), INP(14), INP(19), INP(21),
                    WP(bf16, O_WIN), WP(bf16, O_WOUT), WP(bf16, O_WUP), WP(bf16, O_WDN), INP(7), WP(bf16, O_WB), INP(10), INP(11), WP(bf16, O_W1T), WP(float, O_CBIAS), INP(12), WP(bf16, O_W2T), INP(17), WP(bf16, O_RWH), WP(bf16, O_RWL)); }
    xcd_barrier_first(bar);

#pragma unroll 1
    for (int l = 0; l < DEPTH; ++l) {
        REPL(0) if (EN(0) && IN(pb + 0)) {
            PHASE_BEGIN;
            pg8::PlainOrder S{WP(bf16, O_WIN) + (size_t)l_ * HS * D_, D_, NT / 256, HS / 256, G, bid};
            pg8::EpiBf16 E{WP(bf16, O_HB), HS, nullptr, 0};
            pg8::gemm_phase<pg8::EpiBf16, pg8::PlainOrder, true>(wv, ldsl, WP(bf16, O_XB), D_ * 2, S, E);
#ifdef DUP_WIN
            pg8::gemm_phase<pg8::EpiBf16, pg8::PlainOrder, true>(wv, ldsl, WP(bf16, O_XB), D_ * 2, S, E);
#endif
        }
        SEAM(pb + 0);
        REPL(1) if (EN(1)) {
            PHASE_BEGIN; (void)G; (void)bid;
            ph_mix1(wv, WP(bf16, O_HB), WP(float, O_LB) + l_ * 256, WP(bf16, O_HQT), WP(bf16, O_HKT), WP(bf16, O_HQP), WP(bf16, O_HVT), WP(float, O_HUT), WP(float, O_HDK),
                    INP(5) + l_ * 256, INP(6) + l_ * 256, WP(bf16, O_VLNT), WP(bf16, O_W1T) + (size_t)l_ * 2 * 128 * 2048, WP(float, O_CBIAS) + l_ * 256, WP(bf16, O_W2T) + (size_t)l_ * 2 * 64 * 128,
                    WP(bf16, O_KCB), WP(bf16, O_VCB), WP(float, O_COS), WP(float, O_SIN), WP(bf16, O_KSB), WP(bf16, O_VSB), WP(bf16, O_KWB), WP(bf16, O_VWB),
                    INP(19) + (size_t)l_ * NE * D_ * 2048, INP(21) + (size_t)l_ * NE * D_ * D_, WP(unsigned char, O_WUP) + (size_t)l_ * NE * 2048 * D_, WP(unsigned char, O_WDN) + (size_t)l_ * NE * D_ * D_);
        }
        SEAM(pb + 1);
        REPL(11) if (EN(11)) {
            PHASE_BEGIN; (void)G; (void)bid;
            ph_mix2(wv, WP(float, O_HUT), WP(float, O_HDK), WP(bf16, O_HST), WP(bf16, O_HB), WP(bf16, O_VLNT), WP(bf16, O_WB) + (size_t)l_ * 4 * 128 * 128, INP(8) + l_ * 512, INP(9) + l_ * 256, WP(bf16, O_YCAT));
        }
        SEAM(pb + 1);
        {
            PHASE_BEGIN;
            REPL(2) if (EN(2)) ph_hg3(wv, WP(bf16, O_HB), WP(bf16, O_HQT), WP(bf16, O_HKT), WP(bf16, O_HQP), WP(bf16, O_HVT), WP(bf16, O_HST), INP(4) + l_ * 256, WP(bf16, O_YCAT));
            REPL(12) if (EN(12)) {
                nsa::Params NP{WP(bf16, O_HB), WP(bf16, O_KCB), WP(bf16, O_VCB), WP(bf16, O_KSB), WP(bf16, O_VSB), WP(bf16, O_KWB), WP(bf16, O_VWB), WP(float, O_COS), WP(float, O_SIN), INP(13) + l_ * 512, WP(bf16, O_YCAT)};
                int tid = mk_tid(wv); asm volatile("" : "+v"(tid));
                __syncthreads();
                nsa::phase(NP, ldsl, tid, bid, G);
            }
        }
        SEAM(pb + 2);
        REPL(3) if (EN(3) && IN(pb + 3)) {
            PHASE_BEGIN;
            pg8::PlainOrder S{WP(bf16, O_WOUT) + (size_t)l_ * D_ * D_, D_, NT / 256, D_ / 256, G, bid};
            pg8::EpiBf16 E{WP(bf16, O_MIXB), D_, nullptr, 0};
            pg8::gemm_phase<pg8::EpiBf16, pg8::PlainOrder, true>(wv, ldsl, WP(bf16, O_YCAT), D_ * 2, S, E);
#ifdef DUP_WOUT
            pg8::gemm_phase<pg8::EpiBf16, pg8::PlainOrder, true>(wv, ldsl, WP(bf16, O_YCAT), D_ * 2, S, E);
#endif
        }
        SEAM(pb + 3);
        if (EN(4)) {
            PHASE_BEGIN; (void)G; (void)bid;
            ph_ln1_route(wv, l_ == 0 ? INP(0) : (const float*)nullptr, WP(bf16, O_XB), WP(bf16, O_MIXB), INP(15) + l_ * D_, INP(16) + l_ * D_, WP(bf16, O_X1B), WP(unsigned char, O_X1Q),
                         WP(bf16, O_RWH) + (size_t)l_ * NE * D_, WP(bf16, O_RWL) + (size_t)l_ * NE * D_, INP(18) + l_ * NE,
                         (int*)(ws_ + 32768) + l_ * 64, WP(int, O_LIST), WP(int, O_TE), WP(int, O_TS), WP(float, O_TW));
        }
        SEAM(pb + 4);
        if (IN(pb + 5) || IN(pb + 6) || IN(pb + 7)) {
            PHASE_BEGIN; (void)G; (void)bid;
            int* cnt = (int*)(ws_ + 32768) + l_ * 64;
            __syncthreads();
            if (wv == 0) {
                const int ln = mk_tid(wv) & 63, e = ln & 31;
                const int c = __hip_atomic_load(&cnt[e], __ATOMIC_RELAXED, __HIP_MEMORY_SCOPE_AGENT);
                const int nt_ = (c + 255) >> 8; int incl = nt_;
#pragma unroll
                for (int o = 1; o < 32; o <<= 1) { const int v = __shfl_up(incl, o, 32); if (e >= o) incl += v; }
                if (ln < 32) { tstart[e] = incl - nt_; offs_s[e] = (incl - nt_) * 256; cnts[e] = c; if (e == 31) tstart[32] = incl; }
            }
            __syncthreads();
        }
        REPL(5) if (EN(5) && IN(pb + 5)) {
            PHASE_BEGIN;
            pg8::MoeOrder<true> S{WP(unsigned char, O_WUP) + (size_t)l_ * NE * 2048 * D_, D_, 8, G, bid, (size_t)2048 * D_, tstart, cnts, WP(int, O_LIST)};
            pg8::EpiUpF8 E{WP(unsigned char, O_ACT), INP(20) + (size_t)l_ * NE * 2048};
            pg8::gemm_phase<pg8::EpiUpF8, pg8::MoeOrder<true>, true, true>(wv, ldsl, WP(unsigned char, O_X1Q), D_, S, E);
        }
        SEAM(pb + 5);
        REPL(6) if (EN(6) && IN(pb + 6)) {
            PHASE_BEGIN;
            pg8::MoeOrder<false> S{WP(unsigned char, O_WDN) + (size_t)l_ * NE * D_ * D_, D_, 4, G, bid, (size_t)D_ * D_, tstart, cnts, WP(int, O_LIST)};
            pg8::EpiDnF8 E{WP(bf16, O_YB), INP(22) + (size_t)l_ * NE * D_};
            pg8::gemm_phase<pg8::EpiDnF8, pg8::MoeOrder<false>, true, true>(wv, ldsl, WP(unsigned char, O_ACT), D_, S, E);
        }
        SEAM(pb + 6);
        REPL(7) if (EN(7) && IN(pb + 7)) {
            PHASE_BEGIN; (void)G; (void)bid;
            ph_comb(wv, WP(bf16, O_X1B), WP(bf16, O_YB), WP(int, O_TE), WP(int, O_TS), WP(float, O_TW), INP(23) + l_ * D_, INP(24) + l_ * D_,
                    (l_ == DEPTH - 1) ? ap->out : (float*)nullptr, (l_ == DEPTH - 1) ? (bf16*)nullptr : WP(bf16, O_XB));
        }
#ifdef XTRA_BAR
#pragma unroll 1
        for (int xb_ = 0; xb_ < XTRA_BAR; ++xb_) SEAM(pb + 7);
#endif
        if (l + 1 < DEPTH) SEAM(pb + 7);
    }
#undef IN
#undef SEAM
}
}

extern "C" void kernel_launch(void* const* d_in, const int* in_sizes, int n_in, void* d_out, int out_size, void* d_ws, size_t ws_size, hipStream_t stream) {
    using namespace mk;
    static int grid = 0;
    if (grid == 0) {
        size_t need = WS_NEED;
        if (n_in != 25 || need > ws_size) { fprintf(stderr, "kernel_launch: bad args n_in %d need %zu ws %zu\n", n_in, need, ws_size); grid = -1; return; }
        int dev = 0, cus = 0, per_cu = 0;
        if (hipGetDevice(&dev) != hipSuccess || hipDeviceGetAttribute(&cus, hipDeviceAttributeMultiprocessorCount, dev) != hipSuccess) { grid = -1; return; }
        if (hipFuncSetAttribute((const void*)mega, hipFuncAttributeMaxDynamicSharedMemorySize, LDS_BYTES) != hipSuccess) { fprintf(stderr, "hipFuncSetAttribute failed\n"); grid = -1; return; }
        if (hipOccupancyMaxActiveBlocksPerMultiprocessor(&per_cu, (const void*)mega, NTHR, LDS_BYTES) != hipSuccess || per_cu < 1) fprintf(stderr, "occupancy query: %d\n", per_cu);
        (void)hipGetLastError();
        grid = cus;
    }
    if (grid < 0) return;
    if (hipMemsetAsync(d_ws, 0, CTL_BYTES, stream) != hipSuccess) return;
    Args a{};
    for (int i = 0; i < 25; ++i) a.in[i] = (const float*)d_in[i];
    a.out = (float*)d_out; a.ws = (unsigned char*)d_ws; a.ph_lo = 0; a.ph_hi = 1 + DEPTH * NPH;
    hipLaunchKernelGGL(mega, dim3(grid), dim3(NTHR), LDS_BYTES, stream, a);
}
```

```cpp
#include <hip/hip_runtime.h>
#include <cstdio>
#include <cstdint>
#include <cmath>

__device__ __forceinline__ int mk_tid(int wv) { int lane; asm volatile("v_mbcnt_lo_u32_b32 %0, -1, 0\n\tv_mbcnt_hi_u32_b32 %0, -1, %0" : "=v"(lane)); return (wv << 6) | lane; }
#define XB_TMO      128
#define XB_XCNT(j)  (256  + 64 * (j))
#define XB_XSUB(j)  (1280 + 64 * (j))
#define XB_XGEN(j)  (2304 + 64 * (j))
#define XB_TOP      3328
#define XB_TOPGEN   3392
#define XCD_BAR_WORDS 3456
#define XB_SPIN_CAP (1u << 18)
#define LAS __attribute__((address_space(3)))

__device__ __forceinline__ unsigned xb_ld(unsigned* p)              { return __hip_atomic_load(p, __ATOMIC_RELAXED, __HIP_MEMORY_SCOPE_AGENT); }
__device__ __forceinline__ unsigned xb_add(unsigned* p, unsigned v) { return __hip_atomic_fetch_add(p, v, __ATOMIC_RELAXED, __HIP_MEMORY_SCOPE_AGENT); }
__device__ __forceinline__ unsigned xb_xcc_id() { return (unsigned)__builtin_amdgcn_s_getreg((3 << 11) | 20) & 0xFu; }
#define XB_SPIN(cond, bar) do { unsigned _sp = 0; while (cond) { __builtin_amdgcn_s_sleep(1); \
    if ((++_sp & 255u) == 0u) { if (xb_ld(&(bar)[XB_TMO])) break; if (_sp > XB_SPIN_CAP) { atomicAdd(&(bar)[XB_TMO], 1u); break; } } } } while (0)

struct XcdBarrier {
    unsigned* bar; unsigned x;
    volatile LAS unsigned* st; int wv;
};

__device__ __forceinline__ XcdBarrier xcd_barrier_post(unsigned* bar, volatile LAS unsigned* st, int wv) {
    XcdBarrier b; b.bar = bar; b.x = xb_xcc_id(); b.st = st; b.wv = wv;
    if (mk_tid(b.wv) == 0) (void)xb_add(&bar[XB_XCNT(b.x)], 1u);
    return b;
}
__device__ __forceinline__ void xcd_barrier_complete(unsigned* bar, unsigned x, unsigned& nloc, unsigned& nx) {
    const unsigned G = gridDim.x * gridDim.y * gridDim.z;
    unsigned sum, cnt, mine, sp = 0u;
    for (;;) {
        sum = 0u; cnt = 0u; mine = 0u;
#pragma unroll
        for (unsigned j = 0; j < 16; ++j) { const unsigned c = xb_ld(&bar[XB_XCNT(j)]); sum += c; cnt += (c > 0u) ? 1u : 0u; mine = (j == x) ? c : mine; }
        if (sum == G) break;
        __builtin_amdgcn_s_sleep(1);
        if ((++sp & 255u) == 0u) { if (xb_ld(&bar[XB_TMO])) break; if (sp > XB_SPIN_CAP) { atomicAdd(&bar[XB_TMO], 1u); break; } }
    }
    nloc = mine > 0u ? mine : 1u; nx = cnt > 0u ? cnt : 1u;
}

template <bool FIRST>
__device__ __forceinline__ void xcd_barrier_t(const XcdBarrier& b) {
    asm volatile("s_waitcnt vmcnt(0)" ::: "memory");
    __syncthreads();
    if (mk_tid(b.wv) == 0) {
        unsigned* bar = b.bar; unsigned bx = b.x; asm volatile("" : "+s"(bar), "+s"(bx));
        __builtin_amdgcn_s_waitcnt(0);
        unsigned nloc = b.st[0], nx = b.st[1];
        if (FIRST) { if (nloc == 0u) { xcd_barrier_complete(bar, bx, nloc, nx); b.st[0] = nloc; b.st[1] = nx; } }
        const unsigned old = xb_add(&bar[XB_XSUB(bx)], 1u);
        const unsigned gen = old / nloc;
        if (old + 1u == (gen + 1u) * nloc) {
            __builtin_amdgcn_fence(__ATOMIC_RELEASE, "agent");
            asm volatile("s_waitcnt vmcnt(0)" ::: "memory");
            const unsigned og = xb_add(&bar[XB_TOP], 1u);
            const unsigned tg = og / nx;
            if (og + 1u == (tg + 1u) * nx) xb_add(&bar[XB_TOPGEN], 1u);
            else XB_SPIN(xb_ld(&bar[XB_TOPGEN]) == tg, bar);
            __builtin_amdgcn_fence(__ATOMIC_ACQUIRE, "agent");
            xb_add(&bar[XB_XGEN(bx)], 1u);
            asm volatile("s_waitcnt vmcnt(0)" ::: "memory");
        } else {
            XB_SPIN(xb_ld(&bar[XB_XGEN(bx)]) == gen, bar);
            __builtin_amdgcn_fence(__ATOMIC_ACQUIRE, "agent");
            asm volatile("s_waitcnt vmcnt(0)" ::: "memory");
        }
    }
    __syncthreads();
}


__device__ __forceinline__ void xcd_barrier_first(const XcdBarrier& b) { xcd_barrier_t<true>(b); }
__device__ __forceinline__ void xcd_barrier(const XcdBarrier& b) { xcd_barrier_t<false>(b); }


namespace mk {
constexpr int B_ = 8, S_ = 4096, D_ = 1024, NT = B_ * S_, DEPTH = 2;
constexpr int INW = 2840, HS = 3072;
constexpr int C_HGQ = 0, C_HGF = 256, C_HGI = 512, C_HGG = 768, C_GMU = 1024, C_GMV = 1280, C_NQ = 1536,
              C_KC = 2048, C_VC = 2176, C_KS = 2304, C_VS = 2432, C_KW = 2560, C_VW = 2688, C_NG = 2816;
constexpr int NCMP = 255, NE = 32, TOPK = 4, NASSIGN = NT * TOPK;
constexpr float ALPHA = 1.4142135623730951f;
constexpr int NTHR = 512, LDS_BYTES = 147456, MISC_OFF = 144 * 1024 - 256;
constexpr int NPH = 8;

typedef unsigned short bf16;
__device__ __forceinline__ float bf2f(bf16 v) { return __uint_as_float((unsigned)v << 16); }
__device__ __forceinline__ unsigned f2bf(float f) { unsigned u = __float_as_uint(f); return (u + 0x7fffu + ((u >> 16) & 1u)) >> 16; }
__device__ __forceinline__ unsigned pk2(float lo, float hi) { return f2bf(lo) | (f2bf(hi) << 16); }
__device__ __forceinline__ float gelu_t(float x) { return 0.5f * x * (1.0f + tanhf(0.7978845608028654f * (x + 0.044715f * x * x * x))); }
__device__ __forceinline__ float sigm(float x) { return 1.0f / (1.0f + expf(-x)); }
__device__ __forceinline__ float wsum(float v) {
#pragma unroll
    for (int o = 1; o < 64; o <<= 1) v += __shfl_xor(v, o);
    return v;
}
__device__ __forceinline__ float wmax(float v) {
#pragma unroll
    for (int o = 1; o < 64; o <<= 1) v = fmaxf(v, __shfl_xor(v, o));
    return v;
}

constexpr int MROWS = NASSIGN + NE * 256;
constexpr size_t CTL_BYTES = 65536;
constexpr size_t al256(size_t x) { return (x + 255) & ~(size_t)255; }
constexpr size_t O_COS = CTL_BYTES, O_SIN = O_COS + al256((size_t)NT * 32 * 4), O_LB = O_SIN + al256((size_t)NT * 32 * 4);
constexpr size_t O_WIN = O_LB + al256(512 * 4), O_WOUT = O_WIN + al256((size_t)DEPTH * HS * D_ * 2), O_WUP = O_WOUT + al256((size_t)DEPTH * D_ * D_ * 2);
constexpr size_t O_WDN = O_WUP + al256((size_t)DEPTH * NE * 2048 * D_ * 2), O_XB = O_WDN + al256((size_t)DEPTH * NE * D_ * D_ * 2);
constexpr size_t O_HB = O_XB + al256((size_t)NT * D_ * 2), O_YCAT = O_HB + al256((size_t)NT * HS * 2), O_MIXB = O_YCAT + al256((size_t)NT * D_ * 2);
constexpr size_t O_X1B = O_MIXB + al256((size_t)NT * D_ * 2), O_ACT = O_X1B + al256((size_t)NT * D_ * 2), O_YB = O_ACT + al256((size_t)MROWS * D_ * 2);
constexpr size_t O_X1Q = O_YB + al256((size_t)MROWS * D_ * 2), O_XA = O_X1Q + al256((size_t)NT * D_ * 4);
constexpr size_t O_VLNT = O_XA + al256((size_t)NT * D_ * 4), O_WB = O_VLNT + al256((size_t)NT * 256 * 2), O_W1T = O_WB + al256((size_t)DEPTH * 4 * 128 * 128 * 2);
constexpr size_t O_CBIAS = O_W1T + al256((size_t)DEPTH * 2 * 128 * 2048 * 2), O_W2T = O_CBIAS + al256((size_t)DEPTH * 2 * 128 * 4), O_RWH = O_W2T + al256((size_t)DEPTH * 2 * 64 * 128 * 2), O_RWL = O_RWH + al256((size_t)DEPTH * NE * D_ * 2), O_HQT = O_RWL + al256((size_t)DEPTH * NE * D_ * 2);
constexpr size_t HGB = (size_t)2048 * 4096 * 2;
constexpr size_t O_HKT = O_HQT + HGB, O_HQP = O_HKT + HGB, O_HVT = O_HQP + HGB, O_HST = O_HVT + HGB, O_HUT = O_HST + HGB, O_HDK = O_HUT + 2 * HGB;
constexpr size_t O_KSB = O_HDK + al256((size_t)2048 * 64 * 4), O_VSB = O_KSB + al256((size_t)NT * 128 * 2);
constexpr size_t O_KWB = O_VSB + al256((size_t)NT * 128 * 2), O_VWB = O_KWB + al256((size_t)NT * 128 * 2), O_KCB = O_VWB + al256((size_t)NT * 128 * 2), O_VCB = O_KCB + al256((size_t)B_ * 2 * 256 * 64 * 2);
constexpr size_t O_LIST = O_VCB + al256((size_t)B_ * 2 * 256 * 64 * 2), O_TE = O_LIST + al256((size_t)NE * NT * 4), O_TS = O_TE + al256((size_t)NASSIGN * 4), O_TW = O_TS + al256((size_t)NASSIGN * 4);
constexpr size_t WS_NEED = O_TW + al256((size_t)NASSIGN * 4);
namespace pg8 {
#define PG8_LAS __attribute__((address_space(3)))
typedef unsigned short bf16_t;
typedef short bf16x8 __attribute__((ext_vector_type(8)));
typedef float f32x4 __attribute__((ext_vector_type(4)));
typedef float f32x2 __attribute__((ext_vector_type(2)));
typedef unsigned u32x4 __attribute__((ext_vector_type(4)));
constexpr int BM = 256, BK = 64, HALF = 128, HTB = HALF * BK * 2  , STAGE_BYTES = 8 * HTB, NXCD = 8, WGM = 8;

__host__ __device__ __forceinline__ int lds_byte(int r, int c) { const int st = (r >> 4) * 2 + (c >> 5), rr = r & 15, cc = c & 31, ob = rr * 64 + cc * 2; return st * 1024 + (ob ^ (((ob >> 9) & 1) << 5)); }
__host__ __device__ __forceinline__ void stage_rc(int b, int& R, int& C) { const int st = b / 1024, sb = b % 1024, swz = sb ^ (((sb >> 9) & 1) << 5); R = (st >> 1) * 16 + swz / 64; C = (st & 1) * 32 + (swz % 64) / 2; }
__host__ __device__ __forceinline__ int perm32(int rho) { const int n = rho >> 4, i = rho & 15; return 8 * (i >> 2) + 4 * n + (i & 3); }

struct Unit { int pm, pn, e, mt, cnt; };

__device__ __forceinline__ void deal(int L, int nM, int nN, int& pm, int& pn) {
    const int nwg = nM * nN;
    int wgid = L; { const int q = nwg / NXCD, r = nwg % NXCD, xcd = wgid % NXCD, off = wgid / NXCD; wgid = (xcd < r ? xcd * (q + 1) : r * (q + 1) + (xcd - r) * q) + off; }
    const int nig = WGM * nN, gid = wgid / nig, fm = gid * WGM, gsz = (nM - fm) < WGM ? (nM - fm) : WGM;
    pm = fm + ((wgid % nig) % gsz); pn = (wgid % nig) / gsz;
}
struct PlainOrder {
    static constexpr bool GATHERED = false;
    const bf16_t* Bt; int K; int nM, nN, G, c;
    __device__ __forceinline__ bool next(int i, Unit& u) const { const long L = (long)i * G + c; if (L >= (long)nM * nN) return false; deal((int)L, nM, nN, u.pm, u.pn); u.e = 0; u.mt = 0; u.cnt = 0; return true; }
    __device__ __forceinline__ unsigned a_row(const Unit& u, int r) const { return (unsigned)(u.pm * BM + r); }
    __device__ __forceinline__ const char* b_base(const Unit& u) const { return (const char*)Bt + (size_t)u.pn * BM * K * 2; }
};
template <bool GATHER> struct MoeOrder {
    static constexpr bool GATHERED = GATHER;
    const void* Bt; int rowb; int nN, G, c; size_t estrideb;
    const int* tstart; const int* cnts; const int* list;
    __device__ __forceinline__ bool next(int i, Unit& u) const {
        const int nM = tstart[32]; const long L = (long)i * G + c; if (L >= (long)nM * nN) return false;
        deal((int)L, nM, nN, u.pm, u.pn);
        const int ln = (int)__builtin_amdgcn_mbcnt_hi(~0u, __builtin_amdgcn_mbcnt_lo(~0u, 0u));
        const int ts = tstart[ln & 31];
        const int e = __popcll(__ballot(ln < 32 && ts <= u.pm)) - 1;
        u.e = e; u.mt = u.pm - tstart[e]; u.cnt = cnts[e]; return true;
    }
    __device__ __forceinline__ unsigned a_row(const Unit& u, int r) const {
        if (GATHER) { const int slot = u.mt * BM + r; return (unsigned)list[u.e * 32768 + (slot < u.cnt ? slot : u.cnt - 1)]; }
        return (unsigned)(u.pm * BM + r);
    }
    __device__ __forceinline__ const char* b_base(const Unit& u) const { return (const char*)Bt + (size_t)u.e * estrideb + (size_t)u.pn * BM * rowb; }
};

__device__ __forceinline__ unsigned cvt_pk_bf16(float lo, float hi) { unsigned r; asm volatile("v_cvt_pk_bf16_f32 %0, %1, %2" : "=v"(r) : "v"(lo), "v"(hi)); return r; }

struct EpiBf16 {
    static constexpr bool PERM = true;
    bf16_t* O; int ldc; const float* bias; int bstride;
    __device__ __forceinline__ void operator()(const f32x4 (&acc)[2][2][4][2], const Unit& u, int wr, int wc, int fr, int fq) const {
        const int row0 = u.pm * BM + wr * 64 + fr; const int col0 = u.pn * BM + wc * 32 + 8 * fq;
        f32x4 bv[2][2];
#pragma unroll
        for (int bj = 0; bj < 2; ++bj)
#pragma unroll
            for (int n = 0; n < 2; ++n) bv[bj][n] = bias ? *(const f32x4*)(bias + (size_t)u.e * bstride + col0 + bj * HALF + 4 * n) : (f32x4){0.f, 0.f, 0.f, 0.f};
#pragma unroll
        for (int ai = 0; ai < 2; ++ai)
#pragma unroll
            for (int m = 0; m < 4; ++m) { bf16_t* rowp = O + (size_t)(row0 + ai * HALF + m * 16) * ldc + col0;
#pragma unroll
                for (int bj = 0; bj < 2; ++bj) { f32x4 v0 = acc[ai][bj][m][0] + bv[bj][0], v1 = acc[ai][bj][m][1] + bv[bj][1];
                    u32x4 w; w.x = cvt_pk_bf16(v0[0], v0[1]); w.y = cvt_pk_bf16(v0[2], v0[3]); w.z = cvt_pk_bf16(v1[0], v1[1]); w.w = cvt_pk_bf16(v1[2], v1[3]);
                    *(u32x4*)(rowp + bj * HALF) = w; } }
    }
};
__device__ __forceinline__ float swiglu1(float g, float l) {
    g = fminf(g, 7.0f); l = fminf(fmaxf(l, -7.0f), 7.0f);
    const float s = __builtin_amdgcn_rcpf(1.0f + __builtin_amdgcn_exp2f(-1.702f * 1.4426950408889634f * g));
    return g * s * (l + 1.0f);
}
struct EpiUp {
    static constexpr bool PERM = true;
    bf16_t* O; const float* bias;
    __device__ __forceinline__ void operator()(const f32x4 (&acc)[2][2][4][2], const Unit& u, int wr, int wc, int fr, int fq) const {
        const int row0 = u.pm * BM + wr * 64 + fr; const int j0 = u.pn * HALF + wc * 32 + 8 * fq;
        const float* bp = bias + (size_t)u.e * 2048 + j0;
        f32x4 bg[2], bl[2];
#pragma unroll
        for (int n = 0; n < 2; ++n) { bg[n] = *(const f32x4*)(bp + 4 * n); bl[n] = *(const f32x4*)(bp + 1024 + 4 * n); }
#pragma unroll
        for (int ai = 0; ai < 2; ++ai)
#pragma unroll
            for (int m = 0; m < 4; ++m) {
                float o[8];
#pragma unroll
                for (int n = 0; n < 2; ++n) { const f32x4 g = acc[ai][0][m][n] + bg[n], l = acc[ai][1][m][n] + bl[n];
#pragma unroll
                    for (int j = 0; j < 4; ++j) o[4 * n + j] = swiglu1(g[j], l[j]); }
                u32x4 w; w.x = cvt_pk_bf16(o[0], o[1]); w.y = cvt_pk_bf16(o[2], o[3]); w.z = cvt_pk_bf16(o[4], o[5]); w.w = cvt_pk_bf16(o[6], o[7]);
                *(u32x4*)(O + (size_t)(row0 + ai * HALF + m * 16) * 1024 + j0) = w; }
    }
};

constexpr float F8_SU = 64.0f, F8_SA = 4.0f, F8_SD = 128.0f;
__device__ __forceinline__ unsigned pk4_fp8(float a, float b, float c, float d) {
    a = fminf(fmaxf(a, -448.f), 448.f); b = fminf(fmaxf(b, -448.f), 448.f); c = fminf(fmaxf(c, -448.f), 448.f); d = fminf(fmaxf(d, -448.f), 448.f);
    int p = __builtin_amdgcn_cvt_pk_fp8_f32(a, b, 0, false); p = __builtin_amdgcn_cvt_pk_fp8_f32(c, d, p, true); return (unsigned)p;
}
struct EpiUpF8 {
    static constexpr bool PERM = true;
    unsigned char* O; const float* bias;
    __device__ __forceinline__ void operator()(const f32x4 (&acc)[2][2][4][2], const Unit& u, int wr, int wc, int fr, int fq) const {
        const int row0 = u.pm * BM + wr * 64 + fr; const int j0 = u.pn * HALF + wc * 32 + 8 * fq;
        const float* bp = bias + (size_t)u.e * 2048 + j0;
        f32x4 bg[2], bl[2];
#pragma unroll
        for (int n = 0; n < 2; ++n) { bg[n] = *(const f32x4*)(bp + 4 * n); bl[n] = *(const f32x4*)(bp + 1024 + 4 * n); }
        const int odd = fq & 1;
        unsigned char* obase = O + (size_t)(row0 + 16 * odd) * 1024 + j0 - 8 * odd;
#pragma unroll
        for (int ai = 0; ai < 2; ++ai)
#pragma unroll
            for (int mp = 0; mp < 2; ++mp) {
                unsigned w[2][2];
#pragma unroll
                for (int mm = 0; mm < 2; ++mm)
#pragma unroll
                    for (int n = 0; n < 2; ++n) { const int m = 2 * mp + mm; const f32x4 g = acc[ai][0][m][n] * (1.0f / F8_SU) + bg[n], l = acc[ai][1][m][n] * (1.0f / F8_SU) + bl[n];
                        w[mm][n] = pk4_fp8(F8_SA * swiglu1(g[0], l[0]), F8_SA * swiglu1(g[1], l[1]), F8_SA * swiglu1(g[2], l[2]), F8_SA * swiglu1(g[3], l[3])); }
                const auto r0 = __builtin_amdgcn_permlane16_swap(w[0][0], w[1][0], false, false);
                const auto r1 = __builtin_amdgcn_permlane16_swap(w[0][1], w[1][1], false, false);
                u32x4 ww = {r0[0], r1[0], r0[1], r1[1]};
                *(u32x4*)(obase + (size_t)(ai * HALF + mp * 32) * 1024) = ww; }
    }
};
struct EpiDnF8 {
    static constexpr bool PERM = true;
    bf16_t* O; const float* bias;
    __device__ __forceinline__ void operator()(const f32x4 (&acc)[2][2][4][2], const Unit& u, int wr, int wc, int fr, int fq) const {
        const int row0 = u.pm * BM + wr * 64 + fr; const int col0 = u.pn * BM + wc * 32 + 8 * fq;
        f32x4 bv[2][2];
#pragma unroll
        for (int bj = 0; bj < 2; ++bj)
#pragma unroll
            for (int n = 0; n < 2; ++n) bv[bj][n] = *(const f32x4*)(bias + (size_t)u.e * 1024 + col0 + bj * HALF + 4 * n);
#pragma unroll
        for (int ai = 0; ai < 2; ++ai)
#pragma unroll
            for (int m = 0; m < 4; ++m) { bf16_t* rowp = O + (size_t)(row0 + ai * HALF + m * 16) * 1024 + col0;
#pragma unroll
                for (int bj = 0; bj < 2; ++bj) { f32x4 v0 = acc[ai][bj][m][0] * (1.0f / (F8_SA * F8_SD)) + bv[bj][0], v1 = acc[ai][bj][m][1] * (1.0f / (F8_SA * F8_SD)) + bv[bj][1];
                    u32x4 w; w.x = cvt_pk_bf16(v0[0], v0[1]); w.y = cvt_pk_bf16(v0[2], v0[3]); w.z = cvt_pk_bf16(v1[0], v1[1]); w.w = cvt_pk_bf16(v1[2], v1[3]);
                    *(u32x4*)(rowp + bj * HALF) = w; } }
    }
};

typedef int v8i32 __attribute__((ext_vector_type(8)));
__device__ __forceinline__ v8i32 pg8_join(const bf16x8 lo, const bf16x8 hi) { typedef int v4i32 __attribute__((ext_vector_type(4)));
    const v4i32 a = __builtin_bit_cast(v4i32, lo), b = __builtin_bit_cast(v4i32, hi); return __builtin_shufflevector(a, b, 0, 1, 2, 3, 4, 5, 6, 7); }
template <class Epi, class Sched, bool ALIGN_EPI, bool F8 = false>
__device__ __forceinline__ void gemm_phase(const int wv, PG8_LAS unsigned char* lds, const void* Abase, const int Kb  , const Sched& S, const Epi& E) {
    int tid = mk_tid(wv); asm volatile("" : "+v"(tid));
    const int wid = __builtin_amdgcn_readfirstlane(tid >> 6), lane = tid & 63, wr = wid >> 2, wc = wid & 3, fr = lane & 15, fq = lane >> 4;
#ifdef DUP_K
    const int nt0 = Kb / 128, nt = 2 * nt0;
#define PG8_KT(t) ((t) % nt0)
#else
    const int nt = Kb / 128;
#define PG8_KT(t) (t)
#endif
    const char* Ab = (const char*)Abase;
    unsigned voffB[2];
#pragma unroll
    for (int i = 0; i < 2; ++i) { int R, C; stage_rc(tid * 16 + i * 8192, R, C); const int Rb = Epi::PERM ? ((R & ~31) + perm32(R & 31)) : R;
        voffB[i] = (unsigned)(Rb * Kb + C * 2); }
    const size_t kstep = (size_t)(BK * 2);
    const size_t hstep = (size_t)HALF * Kb;
    const unsigned rowb = (unsigned)Kb;
    const unsigned ldsw = (unsigned)wid * 1024u;
    const int aoff = lds_byte(wr * 64 + fr, fq * 8), boff = lds_byte(wc * 32 + fr, fq * 8);
#define PG8_SA(b, h) (((b) * 2 + (h)) * HTB)
#define PG8_SB(b, h) ((4 + (b) * 2 + (h)) * HTB)
#define PG8_STAGE(bufoff, gbase, voff) do { _Pragma("unroll") for (int _i = 0; _i < 2; ++_i) { unsigned _v = (voff)[_i]; asm volatile("" : "+v"(_v)); \
        __builtin_amdgcn_global_load_lds((const unsigned*)((const char*)(gbase) + _v), (PG8_LAS unsigned*)(lds + (bufoff) + ldsw + _i * 8192), 16, 0, 0); } } while (0)
#define PG8_STAGE_A(bufoff, kb, o0, o1) do { unsigned _o0 = (o0), _o1 = (o1); asm volatile("" : "+v"(_o0), "+v"(_o1)); \
        __builtin_amdgcn_global_load_lds((const unsigned*)(Ab + (kb) + _o0), (PG8_LAS unsigned*)(lds + (bufoff) + ldsw), 16, 0, 0); \
        __builtin_amdgcn_global_load_lds((const unsigned*)(Ab + (kb) + _o1), (PG8_LAS unsigned*)(lds + (bufoff) + ldsw + 8192), 16, 0, 0); } while (0)
#define PG8_LDA(dst, b, h) do { if constexpr (F8) { _Pragma("unroll") for (int m = 0; m < 4; ++m) dst##8[m] = pg8_join(*(const PG8_LAS bf16x8*)(lds + PG8_SA(b, h) + aoff + m * 2048), *(const PG8_LAS bf16x8*)(lds + PG8_SA(b, h) + aoff + m * 2048 + 1024)); } \
        else { _Pragma("unroll") for (int m = 0; m < 4; ++m) _Pragma("unroll") for (int k = 0; k < 2; ++k) dst[m][k] = *(const PG8_LAS bf16x8*)(lds + PG8_SA(b, h) + aoff + m * 2048 + k * 1024); } } while (0)
#define PG8_LDB(dst, b, h) do { if constexpr (F8) { _Pragma("unroll") for (int n = 0; n < 2; ++n) dst##8[n] = pg8_join(*(const PG8_LAS bf16x8*)(lds + PG8_SB(b, h) + boff + n * 2048), *(const PG8_LAS bf16x8*)(lds + PG8_SB(b, h) + boff + n * 2048 + 1024)); } \
        else { _Pragma("unroll") for (int n = 0; n < 2; ++n) _Pragma("unroll") for (int k = 0; k < 2; ++k) dst[n][k] = *(const PG8_LAS bf16x8*)(lds + PG8_SB(b, h) + boff + n * 2048 + k * 1024); } } while (0)
#define PG8_MMA(ai, bj, At, Bt) do { __builtin_amdgcn_s_setprio(1); _Pragma("unroll") for (int m = 0; m < 4; ++m) _Pragma("unroll") for (int n = 0; n < 2; ++n) { \
        if constexpr (F8) { acc[ai][bj][m][n] = __builtin_amdgcn_mfma_scale_f32_16x16x128_f8f6f4(Bt##8[n], At##8[m], acc[ai][bj][m][n], 0, 0, 0, 0, 0, 0); } \
        else { _Pragma("unroll") for (int k = 0; k < 2; ++k) acc[ai][bj][m][n] = __builtin_amdgcn_mfma_f32_16x16x32_bf16(Bt[n][k], At[m][k], acc[ai][bj][m][n], 0, 0, 0); } } \
        __builtin_amdgcn_s_setprio(0); } while (0)
#define PG8_WAIT_V(n) asm volatile("s_waitcnt vmcnt(" #n ")" ::: "memory")
#define PG8_WAIT_L(n) asm volatile("s_waitcnt lgkmcnt(" #n ")" ::: "memory")
#define PG8_BAR __builtin_amdgcn_s_barrier()
#define PG8_SCHED __builtin_amdgcn_sched_barrier(0)
#define PG8_AOFFS(dst, u) do { int _t = mk_tid(wv); asm volatile("" : "+v"(_t)); _Pragma("unroll") for (int _i = 0; _i < 2; ++_i) { int _R, _C; stage_rc(_t * 16 + _i * 8192, _R, _C); \
        _Pragma("unroll") for (int _h = 0; _h < 2; ++_h) dst[_h][_i] = S.a_row(u, _h * HALF + _R) * rowb + (unsigned)_C * 2u; } } while (0)
    Unit cur, nxt; int ui = 0;
    if (!S.next(0, cur)) return;
    f32x4 acc[2][2][4][2];
#pragma unroll
    for (int a = 0; a < 2; ++a)
#pragma unroll
        for (int b = 0; b < 2; ++b)
#pragma unroll
            for (int m = 0; m < 4; ++m)
#pragma unroll
                for (int n = 0; n < 2; ++n) acc[a][b][m][n] = (f32x4){0.f, 0.f, 0.f, 0.f};
    bf16x8 At[4][2], B0[2][2], B1[2][2];
    v8i32 At8[4], B08[2], B18[2];
    unsigned aC[2][2], aN[2][2];
    PG8_AOFFS(aC, cur);
    const char* cB = S.b_base(cur);
    PG8_STAGE(PG8_SB(0, 0), cB, voffB); PG8_STAGE(PG8_SB(0, 1), cB + hstep, voffB); PG8_STAGE_A(PG8_SA(0, 0), 0, aC[0][0], aC[0][1]); PG8_STAGE_A(PG8_SA(0, 1), 0, aC[1][0], aC[1][1]);
    if (wr == 1) PG8_BAR;
    PG8_WAIT_V(2); PG8_BAR;
    PG8_STAGE(PG8_SB(1, 0), cB + kstep, voffB); PG8_STAGE_A(PG8_SA(1, 0), kstep, aC[0][0], aC[0][1]); PG8_STAGE(PG8_SB(1, 1), cB + hstep + kstep, voffB);
    PG8_WAIT_V(6); PG8_BAR;
    for (;;) {
        const bool has_next = S.next(ui + 1, nxt);
        const char* nB = has_next ? S.b_base(nxt) : cB;
        if (has_next) { PG8_AOFFS(aN, nxt); }
        else {
#pragma unroll
            for (int _h = 0; _h < 2; ++_h)
#pragma unroll
                for (int _i = 0; _i < 2; ++_i) aN[_h][_i] = aC[_h][_i]; }
#pragma unroll 1
        for (int t = 0; t < nt; t += 2) {
            const bool last = (t == nt - 2);
            const size_t kb1 = (size_t)PG8_KT(t + 1) * kstep;
            PG8_LDB(B0, 0, 0); PG8_LDB(B1, 0, 1); PG8_SCHED; PG8_LDA(At, 0, 0); PG8_STAGE_A(PG8_SA(1, 1), kb1, aC[1][0], aC[1][1]);
            PG8_WAIT_V(8); PG8_WAIT_L(0); PG8_BAR; PG8_MMA(0, 0, At, B0); PG8_MMA(0, 1, At, B1); PG8_BAR; PG8_SCHED;
            if (last) {
#pragma unroll
                for (int _h = 0; _h < 2; ++_h)
#pragma unroll
                    for (int _i = 0; _i < 2; ++_i) aC[_h][_i] = aN[_h][_i]; }
            const size_t kb2 = last ? (size_t)0 : (size_t)PG8_KT(t + 2) * kstep; const char* b2 = last ? nB : cB + (size_t)PG8_KT(t + 2) * kstep;
            const size_t kb3 = kb2 + kstep; const char* b3 = b2 + kstep;
            PG8_LDA(At, 0, 1); PG8_STAGE(PG8_SB(0, 0), b2, voffB); PG8_STAGE(PG8_SB(0, 1), b2 + hstep, voffB); PG8_STAGE_A(PG8_SA(0, 0), kb2, aC[0][0], aC[0][1]);
            PG8_WAIT_V(8); PG8_WAIT_L(0); PG8_BAR; PG8_MMA(1, 0, At, B0); PG8_MMA(1, 1, At, B1); PG8_BAR; PG8_SCHED;
            PG8_LDB(B0, 1, 0); PG8_LDB(B1, 1, 1); PG8_SCHED; PG8_LDA(At, 1, 0); PG8_STAGE_A(PG8_SA(0, 1), kb2, aC[1][0], aC[1][1]);
            PG8_WAIT_V(8); PG8_WAIT_L(0); PG8_BAR; PG8_MMA(0, 0, At, B0); PG8_MMA(0, 1, At, B1); PG8_BAR; PG8_SCHED;
            PG8_LDA(At, 1, 1); PG8_STAGE(PG8_SB(1, 0), b3, voffB); PG8_STAGE(PG8_SB(1, 1), b3 + hstep, voffB); PG8_STAGE_A(PG8_SA(1, 0), kb3, aC[0][0], aC[0][1]);
            PG8_WAIT_V(8); PG8_WAIT_L(0); PG8_BAR; PG8_MMA(1, 0, At, B0); PG8_MMA(1, 1, At, B1); PG8_BAR; PG8_SCHED;
        }
        if (ALIGN_EPI) { if (wr == 0) PG8_BAR; }
#ifdef DUP_K
#pragma unroll
        for (int a = 0; a < 2; ++a)
#pragma unroll
            for (int b = 0; b < 2; ++b)
#pragma unroll
                for (int m = 0; m < 4; ++m)
#pragma unroll
                    for (int n = 0; n < 2; ++n) acc[a][b][m][n] = acc[a][b][m][n] * 0.5f;
#endif
        E(acc, cur, wr, wc, fr, fq);
#ifdef DUP_EPI
        E(acc, cur, wr, wc, fr, fq);
#endif
        if (!has_next) break;
#pragma unroll
        for (int a = 0; a < 2; ++a)
#pragma unroll
            for (int b = 0; b < 2; ++b)
#pragma unroll
                for (int m = 0; m < 4; ++m)
#pragma unroll
                    for (int n = 0; n < 2; ++n) acc[a][b][m][n] = (f32x4){0.f, 0.f, 0.f, 0.f};
        cur = nxt; cB = nB; ++ui;
        if (ALIGN_EPI) { if (wr == 1) PG8_BAR; }
    }
    PG8_WAIT_V(0);
    if (!ALIGN_EPI) { if (wr == 0) PG8_BAR; }
    PG8_BAR;
#undef PG8_SA
#undef PG8_SB
#undef PG8_STAGE
#undef PG8_STAGE_A
#undef PG8_LDA
#undef PG8_LDB
#undef PG8_MMA
#undef PG8_WAIT_V
#undef PG8_WAIT_L
#undef PG8_BAR
#undef PG8_SCHED
#undef PG8_AOFFS
#undef PG8_KT
}
}


#ifndef NSA_REP_RANK
#define NSA_REP_RANK 1
#endif
#ifndef NSA_REP_PASSA
#define NSA_REP_PASSA 1
#endif
#ifndef NSA_REP_LOOP
#define NSA_REP_LOOP 1
#endif
namespace nsa {
#define NLAS __attribute__((address_space(3)))
typedef short bf16x8 __attribute__((ext_vector_type(8)));
typedef short s16x4 __attribute__((ext_vector_type(4)));
typedef short v4i16_t __attribute__((ext_vector_type(4)));
typedef float f32x16 __attribute__((ext_vector_type(16)));
typedef float f32x2_t __attribute__((ext_vector_type(2)));
typedef __bf16 bf16x2_t __attribute__((ext_vector_type(2)));
#define NSA_MFMA(a, b, c) __builtin_amdgcn_mfma_f32_32x32x16_bf16((a), (b), (c), 0, 0, 0)
constexpr int L_CK = 0, L_CV = 32768, L_RING = 65536, L_IMP = 0, SLOTB = 16384, L_SELM = 131072 + 1024;
constexpr float QSCALE = 0.125f * 1.4426950408889634f;
constexpr float NEGBIG = -1.0e30f;

__device__ __forceinline__ unsigned cvtpk(float lo, float hi) { f32x2_t v = {lo, hi}; bf16x2_t b = __builtin_convertvector(v, bf16x2_t); return __builtin_bit_cast(unsigned, b); }
__device__ __forceinline__ float bflo(unsigned u) { return __uint_as_float(u << 16); }
__device__ __forceinline__ float bfhi(unsigned u) { return __uint_as_float(u & 0xffff0000u); }
__device__ __forceinline__ float xhalf(float v) { return __shfl_xor(v, 32); }
__device__ __forceinline__ float xhalf_max(float v) { const auto r = __builtin_amdgcn_permlane32_swap(__float_as_uint(v), __float_as_uint(v), false, false); return fmaxf(__uint_as_float(r[0]), __uint_as_float(r[1])); }
__device__ __forceinline__ float xhalf_sum(float v) { const auto r = __builtin_amdgcn_permlane32_swap(__float_as_uint(v), __float_as_uint(v), false, false); return __uint_as_float(r[0]) + __uint_as_float(r[1]); }
__device__ __forceinline__ s16x4 vtr(const NLAS unsigned char* p) { return __builtin_bit_cast(s16x4, __builtin_amdgcn_ds_read_tr16_b64_v4i16((NLAS v4i16_t*)p)); }
__device__ __forceinline__ bf16x8 pack8(const f32x16& x, int s) {
    unsigned p0 = cvtpk(x[8 * s], x[8 * s + 1]), p1 = cvtpk(x[8 * s + 2], x[8 * s + 3]), p2 = cvtpk(x[8 * s + 4], x[8 * s + 5]), p3 = cvtpk(x[8 * s + 6], x[8 * s + 7]);
    typedef unsigned u32x4 __attribute__((ext_vector_type(4)));
    u32x4 u = {p0, p1, p2, p3}; return __builtin_bit_cast(bf16x8, u);
}

struct Params {
    const unsigned short* hb;
    const unsigned short *kcb, *vcb;
    const unsigned short *ksb, *vsb, *kwb, *vwb;
    const float *cosT, *sinT;
    const float* normw;
    unsigned short* ycat;
};

__device__ __forceinline__ void qk_tile(const NLAS unsigned char* kt, const bf16x8 (&qf)[4], const int (&kofs)[4], f32x16& st0, f32x16& st1) {
#pragma unroll
    for (int i = 0; i < 16; ++i) { st0[i] = 0.f; st1[i] = 0.f; }
#pragma unroll
    for (int ks = 0; ks < 4; ++ks) {
        const bf16x8 k0 = *(const NLAS bf16x8*)(kt + kofs[ks]);
        const bf16x8 k1 = *(const NLAS bf16x8*)(kt + kofs[ks] + 4096);
        st0 = NSA_MFMA(k0, qf[ks], st0); st1 = NSA_MFMA(k1, qf[ks], st1);
    }
}
__device__ __forceinline__ void pv_tile(const NLAS unsigned char* vt, const int (&vofs)[2][2], const f32x16& p0, const f32x16& p1, f32x16& o0, f32x16& o1) {
#pragma unroll
    for (int kt = 0; kt < 2; ++kt)
#pragma unroll
        for (int s = 0; s < 2; ++s) {
            const bf16x8 pb = pack8(kt ? p1 : p0, s);
            const int kb = (32 * kt + 16 * s) * 128;
#pragma unroll
            for (int mb = 0; mb < 2; ++mb) {
                const s16x4 lo = vtr(vt + kb + vofs[mb][0]), hi = vtr(vt + kb + vofs[mb][1]);
                const bf16x8 va = __builtin_shufflevector(lo, hi, 0, 1, 2, 3, 4, 5, 6, 7);
                if (mb == 0) o0 = NSA_MFMA(va, pb, o0); else o1 = NSA_MFMA(va, pb, o1);
            }
        }
}
__device__ __forceinline__ float max3f(float a, float b, float c) { float r; asm("v_max3_f32 %0, %1, %2, %3" : "=v"(r) : "v"(a), "v"(b), "v"(c)); return r; }
constexpr float NEGINF = -__builtin_inff();
template <bool USE_LO>
__device__ __forceinline__ void mask_tile(f32x16& s0, f32x16& s1, const int hi4, const int lo4) {
#pragma unroll
    for (int i = 0; i < 16; ++i) {
        const int kk0 = (i & 3) + 8 * (i >> 2), kk1 = kk0 + 32;
        bool a0 = kk0 <= hi4, a1 = kk1 <= hi4;
        if (USE_LO) { a0 = a0 && (kk0 >= lo4); a1 = a1 && (kk1 >= lo4); }
        s0[i] = a0 ? s0[i] : NEGINF; s1[i] = a1 ? s1[i] : NEGINF;
    }
}
__device__ __forceinline__ void softmax_core(f32x16& s0, f32x16& s1, float& m, float& l, f32x16& o0, f32x16& o1, const bool live = true) {
    float mx = max3f(s0[0], s0[1], s0[2]);
#pragma unroll
    for (int i = 3; i < 15; i += 2) mx = max3f(mx, s0[i], s0[i + 1]);
    mx = max3f(mx, s0[15], s1[0]);
#pragma unroll
    for (int i = 1; i < 15; i += 2) mx = max3f(mx, s1[i], s1[i + 1]);
    mx = fmaxf(mx, s1[15]);
    mx = xhalf_max(mx);
    const float mn = fmaxf(m, mx);
    const float alpha = __builtin_amdgcn_exp2f(m - mn);
    m = mn;
    const float mref = live ? mn : __builtin_inff();
    float sum0 = 0.f, sum1 = 0.f;
#pragma unroll
    for (int i = 0; i < 16; ++i) {
        const float e0 = __builtin_amdgcn_exp2f(s0[i] - mref), e1 = __builtin_amdgcn_exp2f(s1[i] - mref);
        s0[i] = e0; s1[i] = e1; sum0 += e0; sum1 += e1;
    }
    l = l * alpha + (sum0 + sum1);
    if (__ballot(alpha != 1.0f) != 0ull) {
#pragma unroll
        for (int i = 0; i < 16; ++i) { o0[i] *= alpha; o1[i] *= alpha; }
    }
}

__device__ __forceinline__ void unit(const Params& P, NLAS unsigned char* lds, const int tid_in, const int b, const int g, const int qb) {
    int tid = tid_in; asm volatile("" : "+v"(tid));
    const int wv = __builtin_amdgcn_readfirstlane(tid >> 6), lane = tid & 63, r = lane & 31, h = lane >> 5;
    const int head = g * 4 + (wv >> 1), qi = 32 * (wv & 1) + r;
    const int t = qb * 64 + qi, tok = b * 4096 + t;
    const int bg = b * 2 + g;
    int kofs[4];
#pragma unroll
    for (int ks = 0; ks < 4; ++ks) kofs[ks] = r * 128 + ((((2 * ks + h) ^ ((r >> 1) & 7))) << 4);
    int vofs[2][2];
    { const int i16 = lane & 15, blk = (lane >> 4) & 1, q = i16 >> 2, p = i16 & 3;
#pragma unroll
      for (int mb = 0; mb < 2; ++mb)
#pragma unroll
          for (int jj = 0; jj < 2; ++jj) { const int key = 4 * h + 8 * jj + q; const int o = 4 * mb + 2 * blk + (p >> 1);
              vofs[mb][jj] = key * 128 + ((o ^ (((key >> 1) & 1) << 2)) << 4) + (p & 1) * 8; } }
    const int drow = tid >> 3, dpos = tid & 7;
    const unsigned srcK = (unsigned)(drow * 128 + ((dpos ^ ((drow >> 1) & 7)) << 4));
    const unsigned srcV = (unsigned)(drow * 128 + ((dpos ^ (((drow >> 1) & 1) << 2)) << 4));
    const unsigned wdst = (unsigned)wv * 1024u;
    const unsigned lds0 = (unsigned)(size_t)lds;
#define NSA_DMA(slotoff, gsrc, soff) do { unsigned _keep; const void* _g = (const void*)((const char*)(gsrc) + (soff)); const unsigned _d = (unsigned)__builtin_amdgcn_readfirstlane((int)(lds0 + (unsigned)(slotoff) + wdst)); \
        asm volatile("s_mov_b32 %0, m0\n\ts_mov_b32 m0, %2\n\ts_nop 0\n\tglobal_load_lds_dwordx4 %1, off\n\ts_mov_b32 m0, %0" : "=&s"(_keep) : "v"(_g), "s"(_d) : "memory"); } while (0)
    const int nsel = qb + 1, jw0 = qb >= 8 ? qb - 8 : 0, ntiles = nsel + (qb - jw0 + 1);
    const char* ksg = (const char*)P.ksb + (size_t)bg * 4096 * 128; const char* vsg = (const char*)P.vsb + (size_t)bg * 4096 * 128;
    const char* kwg = (const char*)P.kwb + (size_t)bg * 4096 * 128; const char* vwg = (const char*)P.vwb + (size_t)bg * 4096 * 128;
#define NSA_ISSUE(pos) do { const int _p = (pos) < ntiles ? (pos) : ntiles - 1; const bool _w = _p >= nsel; const int _j = _w ? jw0 + _p - nsel : _p; \
        const int _slot = L_RING + ((pos) & 3) * SLOTB; \
        NSA_DMA(_slot, (_w ? kwg : ksg) + (size_t)_j * 8192, srcK); NSA_DMA(_slot + 8192, (_w ? vwg : vsg) + (size_t)_j * 8192, srcV); } while (0)
    { const char* kcg = (const char*)P.kcb + (size_t)bg * 256 * 128; const char* vcg = (const char*)P.vcb + (size_t)bg * 256 * 128;
#pragma unroll
      for (int T = 0; T < 4; ++T) { NSA_DMA(L_CK + T * 8192, kcg + T * 8192, srcK); NSA_DMA(L_CV + T * 8192, vcg + T * 8192, srcV); } }
    NSA_ISSUE(0); NSA_ISSUE(1);
    typedef unsigned u32x4 __attribute__((ext_vector_type(4)));
    bf16x8 qf[4];
    const unsigned short* qrow = P.hb + (size_t)tok * 3072 + 1536 + (head & 7) * 64;
    {
        u32x4 qraw[4];
#pragma unroll
        for (int ks = 0; ks < 4; ++ks) qraw[ks] = *(const u32x4*)(qrow + 16 * ks + 8 * h);
#pragma unroll
        for (int ks = 0; ks < 4; ++ks) { u32x4 o;
#pragma unroll
            for (int c = 0; c < 4; ++c) o[c] = cvtpk(bflo(qraw[ks][c]) * QSCALE, bfhi(qraw[ks][c]) * QSCALE);
            qf[ks] = __builtin_bit_cast(bf16x8, o); }
    }
    float gc, gs, gw;
    { const unsigned short* gp = P.hb + (size_t)tok * 3072 + 2816 + head * 3;
      gc = 1.f / (1.f + __expf(-__uint_as_float((unsigned)gp[0] << 16))); gs = 1.f / (1.f + __expf(-__uint_as_float((unsigned)gp[1] << 16))); gw = 1.f / (1.f + __expf(-__uint_as_float((unsigned)gp[2] << 16))); }
    asm volatile("s_waitcnt vmcnt(0)" ::: "memory"); __builtin_amdgcn_s_barrier();
    const int cmax = (t >= 31) ? (((t - 31) >> 4) < 254 ? ((t - 31) >> 4) : 254) : -1;
    float m = NEGBIG, l = 0.f;
    f32x16 of0, of1;
#pragma unroll
    for (int i = 0; i < 16; ++i) { of0[i] = 0.f; of1[i] = 0.f; }
    const bool need_sel = qb >= 16;
    float ow[32];
    float carry_in = 0.f;
#pragma unroll
    for (int T = 0; T < 4; ++T) {
        f32x16 s0, s1;
        qk_tile(lds + L_CK + T * 8192, qf, kofs, s0, s1);
        if (__ballot(cmax - 64 * T < 63) != 0ull) mask_tile<false>(s0, s1, cmax - 64 * T - 4 * h, 0);
        float mx = max3f(s0[0], s0[1], s0[2]);
#pragma unroll
        for (int i = 3; i < 15; i += 2) mx = max3f(mx, s0[i], s0[i + 1]);
        mx = max3f(mx, s0[15], s1[0]);
#pragma unroll
        for (int i = 1; i < 15; i += 2) mx = max3f(mx, s1[i], s1[i + 1]);
        mx = xhalf_max(fmaxf(mx, s1[15]));
        const float mn = fmaxf(m, mx), alpha = __builtin_amdgcn_exp2f(m - mn);
        m = mn;
        if (T > 0 && __ballot(alpha != 1.0f) != 0ull) {
#pragma unroll
            for (int i = 0; i < 16; ++i) { of0[i] *= alpha; of1[i] *= alpha; }
#pragma unroll
            for (int idx = 0; idx < 8 * T; ++idx) ow[idx] *= alpha;
            carry_in *= alpha;
        }
        float sum = 0.f;
#pragma unroll
        for (int i = 0; i < 16; ++i) { s0[i] = __builtin_amdgcn_exp2f(s0[i] - mn); s1[i] = __builtin_amdgcn_exp2f(s1[i] - mn); sum += s0[i] + s1[i]; }
        l = l * alpha + sum;
#pragma unroll
        for (int kt = 0; kt < 2; ++kt)
#pragma unroll
            for (int u = 0; u < 4; ++u) {
                const float p0 = kt ? s1[4 * u] : s0[4 * u], p1 = kt ? s1[4 * u + 1] : s0[4 * u + 1], p2 = kt ? s1[4 * u + 2] : s0[4 * u + 2], p3 = kt ? s1[4 * u + 3] : s0[4 * u + 3];
                const float x = xhalf(p3);
                const float own = 2.0f * ((p0 + p1) + p2) + p3;
                ow[8 * T + 4 * kt + u] = own + (h ? x : carry_in);
                carry_in = x;
            }
        pv_tile(lds + L_CV + T * 8192, vofs, s0, s1, of0, of1);
    }
    {
        const float lc = xhalf_sum(l);
        const float rinv = lc > 0.f ? 1.0f / lc : 0.f, gr = gc * rinv;
#pragma unroll
        for (int i = 0; i < 16; ++i) { of0[i] *= gr; of1[i] *= gr; }
        if (need_sel) {
#pragma unroll
            for (int idx = 0; idx < 32; ++idx) ow[idx] *= rinv;
        }
    }
    unsigned long long selmask = (qb >= 63) ? ~0ull : ((1ull << (qb + 1)) - 1ull);
    if (need_sel) {
        __builtin_amdgcn_s_barrier();
        NLAS float* imp = (NLAS float*)(lds + L_IMP) + qi * 64;
#pragma unroll 1
        for (int hh = 0; hh < 4; ++hh) {
            if ((wv >> 1) == hh) {
                if (hh == 0) {
#pragma unroll
                    for (int idx = 0; idx < 32; ++idx) imp[(2 * idx + h + qi) & 63] = ow[idx];
                } else {
#pragma unroll
                    for (int idx = 0; idx < 32; ++idx) imp[(2 * idx + h + qi) & 63] += ow[idx];
                }
            }
            asm volatile("s_waitcnt lgkmcnt(0)" ::: "memory"); __builtin_amdgcn_s_barrier();
        }
        NLAS unsigned long long* selm = (NLAS unsigned long long*)(lds + L_SELM);
        const unsigned long long forced = 1ull | (1ull << qb) | (1ull << (qb - 1));
        const bool cand = (lane >= 1) && (lane <= qb - 2);
#pragma unroll 1
        for (int rep_ = 0; rep_ < NSA_REP_RANK; ++rep_) {
            unsigned vb[8], thr[8];
#pragma unroll
            for (int qq = 0; qq < 8; ++qq) { const int q = 8 * wv + qq; const float v = ((NLAS float*)(lds + L_IMP))[q * 64 + ((lane + q) & 63)];
                vb[qq] = cand ? __float_as_uint(v) : 0u; thr[qq] = 0u; }
#pragma unroll 1
            for (int bit = 30; bit >= 0; --bit) {
                unsigned long long bm[8];
#pragma unroll
                for (int qq = 0; qq < 8; ++qq) bm[qq] = __builtin_amdgcn_ballot_w64(vb[qq] >= (thr[qq] | (1u << bit)));
#pragma unroll
                for (int qq = 0; qq < 8; ++qq) {
                    const int cnt = __builtin_popcount((unsigned)bm[qq]) + __builtin_popcount((unsigned)(bm[qq] >> 32));
                    thr[qq] = (cnt >= 13) ? (thr[qq] | (1u << bit)) : thr[qq];
                }
            }
#pragma unroll
            for (int qq = 0; qq < 8; ++qq) {
                unsigned long long sel = __ballot(cand && vb[qq] > thr[qq]);
                unsigned long long eq = __ballot(cand && vb[qq] == thr[qq]);
                int need = 13 - __popcll(sel);
#pragma unroll 1
                for (; need > 0; --need) { const unsigned long long low = eq & (~eq + 1ull); sel |= low; eq ^= low; }
                if (lane == 0) selm[8 * wv + qq] = sel | forced;
            }
        }
        asm volatile("s_waitcnt lgkmcnt(0)" ::: "memory"); __builtin_amdgcn_s_barrier();
        selmask = selm[qi];
    }
    {
        u32x4 qraw[4];
#pragma unroll
        for (int ks = 0; ks < 4; ++ks) qraw[ks] = *(const u32x4*)(qrow + 16 * ks + 8 * h);
        const float4* cp = (const float4*)(P.cosT + (size_t)tok * 32 + 8 * h); const float4* sp = (const float4*)(P.sinT + (size_t)tok * 32 + 8 * h);
#pragma unroll
        for (int ks = 0; ks < 2; ++ks) {
            const float4 c0 = cp[4 * ks], c1 = cp[4 * ks + 1], s0 = sp[4 * ks], s1 = sp[4 * ks + 1];
            const float cs[8] = {c0.x, c0.y, c0.z, c0.w, c1.x, c1.y, c1.z, c1.w}, sn[8] = {s0.x, s0.y, s0.z, s0.w, s1.x, s1.y, s1.z, s1.w};
            u32x4 oa, ob;
#pragma unroll
            for (int c = 0; c < 4; ++c) {
                const float a0 = bflo(qraw[ks][c]), a1 = bfhi(qraw[ks][c]), b0 = bflo(qraw[ks + 2][c]), b1 = bfhi(qraw[ks + 2][c]);
                oa[c] = cvtpk((a0 * cs[2 * c] - b0 * sn[2 * c]) * QSCALE, (a1 * cs[2 * c + 1] - b1 * sn[2 * c + 1]) * QSCALE);
                ob[c] = cvtpk((b0 * cs[2 * c] + a0 * sn[2 * c]) * QSCALE, (b1 * cs[2 * c + 1] + a1 * sn[2 * c + 1]) * QSCALE);
            }
            qf[ks] = __builtin_bit_cast(bf16x8, oa); qf[ks + 2] = __builtin_bit_cast(bf16x8, ob);
        }
    }
    asm volatile("s_waitcnt vmcnt(0)" ::: "memory");
    f32x16 o0, o1;
    const bool lead = wv < 4;
    const float gs_keep = gs, gw_keep = gw;
#pragma unroll 1
    for (int repL = 0; repL < NSA_REP_LOOP; ++repL) {
    if (NSA_REP_LOOP > 1) { gs = (repL == NSA_REP_LOOP - 1) ? gs_keep : 0.f; gw = (repL == NSA_REP_LOOP - 1) ? gw_keep : 0.f;
        if (repL > 0) { asm volatile("s_waitcnt vmcnt(0)" ::: "memory"); __builtin_amdgcn_s_barrier(); NSA_ISSUE(0); NSA_ISSUE(1); asm volatile("s_waitcnt vmcnt(0)" ::: "memory"); } }
#pragma unroll
    for (int i = 0; i < 16; ++i) { o0[i] = 0.f; o1[i] = 0.f; }
    m = NEGBIG; l = 0.f;
    if (!lead) { asm volatile("s_waitcnt vmcnt(2)" ::: "memory"); __builtin_amdgcn_s_barrier(); }
#pragma unroll 1
    for (int pos = 0; pos < ntiles; ++pos) {
        if (lead) asm volatile("s_waitcnt vmcnt(2)" ::: "memory");
        __builtin_amdgcn_s_barrier();
        NSA_ISSUE(pos + 2);
        const NLAS unsigned char* slot = lds + L_RING + (pos & 3) * SLOTB;
        f32x16 s0, s1;
        const bool win = pos >= nsel; const int j = win ? jw0 + pos - nsel : pos;
        const bool live = win || ((selmask >> j) & 1ull);
        qk_tile(slot, qf, kofs, s0, s1);
        if (j == qb) mask_tile<false>(s0, s1, qi - 4 * h, 0);
        else if (win && qb >= 8 && j == qb - 8) mask_tile<true>(s0, s1, 63, qi + 1 - 4 * h);
        softmax_core(s0, s1, m, l, o0, o1, live);
        if (!lead) asm volatile("s_waitcnt vmcnt(2)" ::: "memory");
        __builtin_amdgcn_s_barrier();
        pv_tile(slot + 8192, vofs, s0, s1, o0, o1);
        if (pos == nsel - 1) {
            const float L = xhalf_sum(l); const float sc = (L > 0.f) ? gs / L : 0.f;
#pragma unroll
            for (int i = 0; i < 16; ++i) { of0[i] += sc * o0[i]; of1[i] += sc * o1[i]; o0[i] = 0.f; o1[i] = 0.f; }
            m = NEGBIG; l = 0.f;
        }
    }
    if (lead) __builtin_amdgcn_s_barrier();
    if (NSA_REP_LOOP > 1 && repL < NSA_REP_LOOP - 1) {
        const float L0 = l + xhalf(l); (void)L0; }
    if (repL == NSA_REP_LOOP - 1)    {
        float L = xhalf_sum(l);
        const float npad = (t < 511) ? (float)(511 - t) : 0.f;
        const float m2 = (npad > 0.f) ? fmaxf(m, 0.f) : m;
        const float a = __builtin_amdgcn_exp2f(m - m2);
        L = L * a + npad * __builtin_amdgcn_exp2f(-m2);
        const float sc = (L > 0.f) ? gw * a / L : 0.f;
#pragma unroll
        for (int i = 0; i < 16; ++i) { of0[i] += sc * o0[i]; of1[i] += sc * o1[i]; }
    }
    }
    float ss = 0.f;
#pragma unroll
    for (int i = 0; i < 16; ++i) ss += of0[i] * of0[i] + of1[i] * of1[i];
    ss = xhalf_sum(ss);
    const float rn = rsqrtf(ss * (1.0f / 64.0f) + 1e-6f);
    unsigned short* yrow = P.ycat + (size_t)tok * 1024 + 512 + head * 64;
    const float* nw = P.normw + head * 64;
    float4 w4a[2][4];
#pragma unroll
    for (int mb = 0; mb < 2; ++mb)
#pragma unroll
        for (int u = 0; u < 4; ++u) w4a[mb][u] = *(const float4*)(nw + 32 * mb + 8 * u + 4 * h);
#pragma unroll
    for (int mb = 0; mb < 2; ++mb)
#pragma unroll
        for (int u = 0; u < 4; ++u) {
            const int d0 = 32 * mb + 8 * u + 4 * h;
            const float4 w4 = w4a[mb][u];
            const float v0 = (mb ? of1[4 * u] : of0[4 * u]) * rn * w4.x, v1 = (mb ? of1[4 * u + 1] : of0[4 * u + 1]) * rn * w4.y;
            const float v2 = (mb ? of1[4 * u + 2] : of0[4 * u + 2]) * rn * w4.z, v3 = (mb ? of1[4 * u + 3] : of0[4 * u + 3]) * rn * w4.w;
            *(uint2*)(yrow + d0) = make_uint2(cvtpk(v0, v1), cvtpk(v2, v3));
        }
    asm volatile("s_waitcnt vmcnt(0)" ::: "memory"); __builtin_amdgcn_s_barrier();
#undef NSA_DMA
#undef NSA_ISSUE
}
__device__ __forceinline__ void phase(const Params& P, NLAS unsigned char* lds, const int tid, const int bid, const int G) {
#pragma unroll 1
    for (int vw = bid; vw < 256; vw += G) {
        const int xcd = vw & 7, slot = vw >> 3, bg = xcd * 2 + (slot >> 4), rr = slot & 15;
#pragma unroll 1
        for (int k = 0; k < 4; ++k) { const int qb = (k == 0) ? 63 - rr : (k == 1) ? 32 + rr : (k == 2) ? 31 - rr : rr; unit(P, lds, tid, bg >> 1, bg & 1, qb); }
    }
}
}


namespace wt {
typedef short bf16x8 __attribute__((ext_vector_type(8)));
typedef float f32x16 __attribute__((ext_vector_type(16)));
typedef unsigned u32x4 __attribute__((ext_vector_type(4)));
typedef unsigned u32x2 __attribute__((ext_vector_type(2)));
typedef float f32x2_t __attribute__((ext_vector_type(2)));
typedef __bf16 bf16x2_t __attribute__((ext_vector_type(2)));
#define WT_MFMA(a, b, c) __builtin_amdgcn_mfma_f32_32x32x16_bf16((a), (b), (c), 0, 0, 0)
__device__ __forceinline__ unsigned cvtpk(float lo, float hi) { f32x2_t v = {lo, hi}; bf16x2_t b = __builtin_convertvector(v, bf16x2_t); return __builtin_bit_cast(unsigned, b); }
__device__ __forceinline__ float bflo(unsigned u) { return __uint_as_float(u << 16); }
__device__ __forceinline__ float bfhi(unsigned u) { return __uint_as_float(u & 0xffff0000u); }
__device__ __forceinline__ float xhalf(float v) { return __shfl_xor(v, 32); }
__device__ __forceinline__ float xhalf_sum(float v) { const auto r = __builtin_amdgcn_permlane32_swap(__float_as_uint(v), __float_as_uint(v), false, false); return __uint_as_float(r[0]) + __uint_as_float(r[1]); }
__device__ __forceinline__ bf16x8 ld16(const unsigned short* p) { return __builtin_bit_cast(bf16x8, *(const u32x4*)p); }
__device__ __forceinline__ bf16x8 ld8x2(const unsigned short* p0, const unsigned short* p1) { const u32x2 a = *(const u32x2*)p0, b = *(const u32x2*)p1; u32x4 u = {a.x, a.y, b.x, b.y}; return __builtin_bit_cast(bf16x8, u); }
__device__ __forceinline__ bf16x8 pack8(const f32x16& x, int s) {
    u32x4 u = {cvtpk(x[8 * s], x[8 * s + 1]), cvtpk(x[8 * s + 2], x[8 * s + 3]), cvtpk(x[8 * s + 4], x[8 * s + 5]), cvtpk(x[8 * s + 6], x[8 * s + 7])};
    return __builtin_bit_cast(bf16x8, u);
}
__device__ __forceinline__ float gelu_t(float x) { const float u = 0.7978845608028654f * (x + 0.044715f * x * x * x); const float e = __expf(2.0f * u); return 0.5f * x * (1.0f + (1.0f - 2.0f / (e + 1.0f))); }
__device__ __forceinline__ float sigm(float x) { return 1.0f / (1.0f + __expf(-x)); }
__device__ __forceinline__ void zero(f32x16& a) {
#pragma unroll
    for (int i = 0; i < 16; ++i) a[i] = 0.f;
}

__device__ __forceinline__ void gm_ln8(const unsigned short* __restrict__ hb, const float* __restrict__ lw, const float* __restrict__ lbias, unsigned short* __restrict__ vlnT, int t8, int lane) {
    const int tok0 = t8 * 8;
    const float4 w4 = *(const float4*)(lw + lane * 4), b4 = *(const float4*)(lbias + lane * 4);
    float o[4][8];
#pragma unroll
    for (int i = 0; i < 8; ++i) {
        const u32x2 v4 = *(const u32x2*)(hb + (size_t)(tok0 + i) * 3072 + 1280 + lane * 4);
        float v[4] = {gelu_t(bflo(v4.x)), gelu_t(bfhi(v4.x)), gelu_t(bflo(v4.y)), gelu_t(bfhi(v4.y))};
        float s = (v[0] + v[1]) + (v[2] + v[3]);
#pragma unroll
        for (int o2 = 1; o2 < 64; o2 <<= 1) s += __shfl_xor(s, o2);
        const float mean = s * (1.0f / 256.0f); float q = 0.f;
#pragma unroll
        for (int c = 0; c < 4; ++c) { v[c] -= mean; q += v[c] * v[c]; }
#pragma unroll
        for (int o2 = 1; o2 < 64; o2 <<= 1) q += __shfl_xor(q, o2);
        const float rstd = rsqrtf(q * (1.0f / 256.0f) + 1e-5f);
        o[0][i] = v[0] * rstd * w4.x + b4.x; o[1][i] = v[1] * rstd * w4.y + b4.y; o[2][i] = v[2] * rstd * w4.z + b4.z; o[3][i] = v[3] * rstd * w4.w + b4.w;
    }
    const int bc = tok0 >> 7, s0 = tok0 & 127;
#pragma unroll
    for (int c = 0; c < 4; ++c) {
        const int ch = lane * 4 + c, g = ch >> 6, cc = ch & 63;
        u32x4 u = {cvtpk(o[c][0], o[c][1]), cvtpk(o[c][2], o[c][3]), cvtpk(o[c][4], o[c][5]), cvtpk(o[c][6], o[c][7])};
        *(u32x4*)(vlnT + ((size_t)(bc * 4 + g) * 64 + cc) * 128 + s0) = u;
    }
}
__device__ __forceinline__ void gm_sp_task(const unsigned short* __restrict__ hb, const unsigned short* __restrict__ vlnT, const unsigned short* __restrict__ Wb, const float* __restrict__ bs,
                                           const float* __restrict__ normw, unsigned short* __restrict__ ycat, int task, int lane) {
    const int tb = task & 3, g = (task >> 2) & 3, bc = task >> 4, r = lane & 31, h = lane >> 5;
    const unsigned short* ap = vlnT + ((size_t)(bc * 4 + g) * 64 + r) * 128 + 8 * h;
    const unsigned short* bp = Wb + ((size_t)g * 128 + 32 * tb + r) * 128 + 8 * h;
    f32x16 a0, a1; zero(a0); zero(a1);
    const int nks = 2 * (tb + 1);
#pragma unroll 2
    for (int ks = 0; ks < nks; ++ks) {
        const bf16x8 bw = ld16(bp + 16 * ks);
        const bf16x8 v0 = ld16(ap + 16 * ks), v1 = ld16(ap + 32 * 128 + 16 * ks);
        a0 = WT_MFMA(v0, bw, a0); a1 = WT_MFMA(v1, bw, a1);
    }
    const int tl = 32 * tb + r, tok = bc * 128 + tl;
    const float bias = bs[g * 128 + tl];
    const unsigned short* up = hb + (size_t)tok * 3072 + 1024 + g * 64;
    float z[32]; float ss = 0.f;
#pragma unroll
    for (int cb = 0; cb < 2; ++cb)
#pragma unroll
        for (int u = 0; u < 4; ++u) {
            const int c0 = 32 * cb + 8 * u + 4 * h;
            const u32x2 uu = *(const u32x2*)(up + c0);
            const float uv[4] = {gelu_t(bflo(uu.x)), gelu_t(bfhi(uu.x)), gelu_t(bflo(uu.y)), gelu_t(bfhi(uu.y))};
#pragma unroll
            for (int k = 0; k < 4; ++k) { const float a = (cb ? a1[4 * u + k] : a0[4 * u + k]) + bias; const float zz = uv[k] * a; z[16 * cb + 4 * u + k] = zz; ss += zz * zz; }
        }
    ss = xhalf_sum(ss);
    const float rn = rsqrtf(ss * (1.0f / 64.0f) + 1e-6f);
    unsigned short* yp = ycat + (size_t)tok * 1024 + 256 + g * 64;
    const float* nw = normw + g * 64;
    float4 w4a[2][4];
#pragma unroll
    for (int cb = 0; cb < 2; ++cb)
#pragma unroll
        for (int u = 0; u < 4; ++u) w4a[cb][u] = *(const float4*)(nw + 32 * cb + 8 * u + 4 * h);
#pragma unroll
    for (int cb = 0; cb < 2; ++cb)
#pragma unroll
        for (int u = 0; u < 4; ++u) {
            const int c0 = 32 * cb + 8 * u + 4 * h;
            const float4 w4 = w4a[cb][u];
            u32x2 o = {cvtpk(z[16 * cb + 4 * u] * rn * w4.x, z[16 * cb + 4 * u + 1] * rn * w4.y), cvtpk(z[16 * cb + 4 * u + 2] * rn * w4.z, z[16 * cb + 4 * u + 3] * rn * w4.w)};
            *(u32x2*)(yp + c0) = o;
        }
}

#define WT_LAS __attribute__((address_space(3)))
__device__ __forceinline__ void cmp_wg(const unsigned short* __restrict__ hb, const unsigned short* __restrict__ w1t, const float* __restrict__ cbias, const unsigned short* __restrict__ w2t,
                                       unsigned short* __restrict__ kcb, unsigned short* __restrict__ vcb, WT_LAS float* red, int task, int wave, int lane) {
    const int cblk = task & 7, kv = (task >> 3) & 1, g = (task >> 4) & 1, b = task >> 5, r = lane & 31, h = lane >> 5;
    const int c = 32 * cblk + r; const int cl = c < 254 ? c : 254;
    const unsigned short* bp = hb + (size_t)(b * 4096 + 16 * cl) * 3072 + (kv ? 2176 : 2048) + g * 64 + 8 * h;
    const unsigned short* ap = w1t + ((size_t)kv * 128 + r) * 2048 + 8 * h;
    f32x16 acc[4];
#pragma unroll
    for (int nt = 0; nt < 4; ++nt) zero(acc[nt]);
#pragma unroll 4
    for (int kk = 0; kk < 16; ++kk) {
        const int ks = 16 * wave + kk;
        const bf16x8 bk = ld16(bp + (size_t)(ks >> 2) * 3072 + 16 * (ks & 3));
#pragma unroll
        for (int nt = 0; nt < 4; ++nt) acc[nt] = WT_MFMA(ld16(ap + (size_t)nt * 32 * 2048 + 16 * ks), bk, acc[nt]);
    }
#pragma unroll
    for (int nt = 0; nt < 4; ++nt)
#pragma unroll
        for (int i = 0; i < 16; ++i) red[(wave * 64 + nt * 16 + i) * 64 + lane] = acc[nt][i];
    asm volatile("s_waitcnt lgkmcnt(0)" ::: "memory"); __builtin_amdgcn_s_barrier();
#pragma unroll
    for (int q = 0; q < 8; ++q) {
        const int row = 8 * wave + q; float sacc = 0.f;
#pragma unroll
        for (int w2 = 0; w2 < 8; ++w2) sacc += red[(w2 * 64 + row) * 64 + lane];
        red[row * 64 + lane] = sacc;
    }
    asm volatile("s_waitcnt lgkmcnt(0)" ::: "memory"); __builtin_amdgcn_s_barrier();
    if (wave == 0) {
#pragma unroll
        for (int nt = 0; nt < 4; ++nt)
#pragma unroll
            for (int i = 0; i < 16; ++i) { const int n = 32 * nt + (i & 3) + 8 * (i >> 2) + 4 * h; acc[nt][i] = gelu_t(red[(nt * 16 + i) * 64 + lane] + cbias[kv * 128 + n]); }
        f32x16 o0, o1; zero(o0); zero(o1);
        const unsigned short* w2p = w2t + ((size_t)kv * 64 + r) * 128 + 4 * h;
#pragma unroll
        for (int nt = 0; nt < 4; ++nt)
#pragma unroll
            for (int s = 0; s < 2; ++s) {
                const bf16x8 pb = pack8(acc[nt], s);
                const unsigned short* wp = w2p + 32 * nt + 16 * s;
                o0 = WT_MFMA(ld8x2(wp, wp + 8), pb, o0);
                o1 = WT_MFMA(ld8x2(wp + 32 * 128, wp + 32 * 128 + 8), pb, o1);
            }
        if (c < 255) {
            unsigned short* op = (kv ? vcb : kcb) + ((size_t)(b * 2 + g) * 256 + c) * 64;
#pragma unroll
            for (int db = 0; db < 2; ++db)
#pragma unroll
                for (int u = 0; u < 4; ++u) {
                    const int d0 = 32 * db + 8 * u + 4 * h;
                    u32x2 o = {cvtpk(db ? o1[4 * u] : o0[4 * u], db ? o1[4 * u + 1] : o0[4 * u + 1]), cvtpk(db ? o1[4 * u + 2] : o0[4 * u + 2], db ? o1[4 * u + 3] : o0[4 * u + 3])};
                    *(u32x2*)(op + d0) = o;
                }
        }
    }
    __builtin_amdgcn_s_barrier();
}

__device__ __forceinline__ void kvprep8(const unsigned short* __restrict__ hb, const float* __restrict__ cosT, const float* __restrict__ sinT,
                                        unsigned short* __restrict__ ksb, unsigned short* __restrict__ vsb, unsigned short* __restrict__ kwb, unsigned short* __restrict__ vwb, int idx) {
    const int j8 = idx & 3, g = (idx >> 2) & 1, tok = idx >> 3, b = tok >> 12, t = tok & 4095;
    const unsigned short* hr = hb + (size_t)tok * 3072 + g * 64 + 8 * j8;
    const float4 c0 = *(const float4*)(cosT + (size_t)tok * 32 + 8 * j8), c1 = *(const float4*)(cosT + (size_t)tok * 32 + 8 * j8 + 4);
    const float4 s0 = *(const float4*)(sinT + (size_t)tok * 32 + 8 * j8), s1 = *(const float4*)(sinT + (size_t)tok * 32 + 8 * j8 + 4);
    u32x4 ka[2], kb[2], va[2], vb[2];
#pragma unroll
    for (int w = 0; w < 2; ++w) { const int col = w ? 2560 : 2304, vcol = w ? 2688 : 2432;
        ka[w] = *(const u32x4*)(hr + col); kb[w] = *(const u32x4*)(hr + col + 32); va[w] = *(const u32x4*)(hr + vcol); vb[w] = *(const u32x4*)(hr + vcol + 32); }
    const float cs[8] = {c0.x, c0.y, c0.z, c0.w, c1.x, c1.y, c1.z, c1.w}, sn[8] = {s0.x, s0.y, s0.z, s0.w, s1.x, s1.y, s1.z, s1.w};
    const size_t o = ((size_t)(b * 2 + g) * 4096 + t) * 64 + 8 * j8;
#pragma unroll
    for (int w = 0; w < 2; ++w) {
        u32x4 oa, ob;
#pragma unroll
        for (int c = 0; c < 4; ++c) {
            const float a0 = bflo(ka[w][c]), a1 = bfhi(ka[w][c]), b0 = bflo(kb[w][c]), b1 = bfhi(kb[w][c]);
            oa[c] = cvtpk(a0 * cs[2 * c] - b0 * sn[2 * c], a1 * cs[2 * c + 1] - b1 * sn[2 * c + 1]);
            ob[c] = cvtpk(b0 * cs[2 * c] + a0 * sn[2 * c], b1 * cs[2 * c + 1] + a1 * sn[2 * c + 1]);
        }
        unsigned short* kd = (w ? kwb : ksb) + o;
        *(u32x4*)kd = oa; *(u32x4*)(kd + 32) = ob;
        unsigned short* vd = (w ? vwb : vsb) + o;
        *(u32x4*)vd = va[w]; *(u32x4*)(vd + 32) = vb[w];
    }
}

__device__ __forceinline__ void hg_pass1(const unsigned short* __restrict__ hb, const float* __restrict__ lbl, unsigned short* __restrict__ Qt, unsigned short* __restrict__ Kt,
                                         unsigned short* __restrict__ Qp, unsigned short* __restrict__ VT, float* __restrict__ Ut, float* __restrict__ Dk, int ci, int lane_in) {
    int lane = lane_in; asm volatile("" : "+v"(lane));
    const int chunk = ci & 63, hd = (ci >> 6) & 3, b = ci >> 8;
    const unsigned short* hp = hb + (size_t)(b * 4096 + chunk * 64) * 3072 + hd * 64 + lane;
    const float lb = lbl[hd * 64 + lane];
    unsigned fpk[32];
#pragma unroll
    for (int hb2 = 0; hb2 < 2; ++hb2) { unsigned short rf[32];
#pragma unroll
      for (int t = 0; t < 32; ++t) rf[t] = hp[(size_t)(32 * hb2 + t) * 3072 + 256];
#pragma unroll
      for (int t = 0; t < 16; ++t) fpk[16 * hb2 + t] = (unsigned)rf[2 * t] | ((unsigned)rf[2 * t + 1] << 16); }
    float run = 0.f, cmid = 0.f;
#pragma unroll
    for (int t = 0; t < 64; ++t) {
        const float fr = (t & 1) ? bfhi(fpk[t >> 1]) : bflo(fpk[t >> 1]);
        run += __logf(lb + (1.0f - lb) * sigm(fr));
        if (t == 31) cmid = run;
    }
    const float blast = run;
    unsigned short* qt = Qt + (size_t)ci * 4096 + lane; unsigned short* kt = Kt + (size_t)ci * 4096 + lane; unsigned short* qp = Qp + (size_t)ci * 4096 + lane;
    unsigned short* vt = VT + (size_t)ci * 4096 + lane * 64;
    const int h = lane >> 5, r = lane & 31;
    f32x16 acc[2][2];
#pragma unroll
    for (int a = 0; a < 2; ++a)
#pragma unroll
        for (int c = 0; c < 2; ++c) zero(acc[a][c]);
    float bt = 0.f;
    Dk[(size_t)ci * 64 + lane] = __expf(blast);
#pragma unroll 1
    for (int ks = 0; ks < 4; ++ks) {
        unsigned short rq[1][16], ri[1][16];
#pragma unroll
        for (int tt = 0; tt < 16; ++tt) { const size_t o = (size_t)(ks * 16 + tt) * 3072; rq[0][tt] = hp[o]; ri[0][tt] = hp[o + 512]; }
        unsigned kp[8], vp[8];
        unsigned fsel[8];
#pragma unroll
        for (int tp = 0; tp < 8; ++tp) fsel[tp] = (ks == 0) ? fpk[tp] : (ks == 1) ? fpk[8 + tp] : (ks == 2) ? fpk[16 + tp] : fpk[24 + tp];
#pragma unroll
        for (int tp = 0; tp < 8; ++tp) {
            float k2v[2], ivv[2];
#pragma unroll
            for (int e = 0; e < 2; ++e) {
                const int t = ks * 16 + tp * 2 + e;
                const float qr = __uint_as_float((unsigned)rq[0][tp * 2 + e] << 16), fr = e ? bfhi(fsel[tp]) : bflo(fsel[tp]);
                ivv[e] = __uint_as_float((unsigned)ri[0][tp * 2 + e] << 16);
                const float sf = sigm(fr);
                const float q = qr * sigm(qr), kk = (1.0f - lb) * (1.0f - sf);
                bt += __logf(lb + (1.0f - lb) * sf);
                qt[t * 64] = (unsigned short)(cvtpk(q * __expf(bt - cmid), 0.f) & 0xffffu);
                kt[t * 64] = (unsigned short)(cvtpk(kk * __expf(cmid - bt), 0.f) & 0xffffu);
                qp[t * 64] = (unsigned short)(cvtpk(q * __expf(bt), 0.f) & 0xffffu);
                k2v[e] = kk * __expf(blast - bt);
            }
            kp[tp] = cvtpk(k2v[0], k2v[1]); vp[tp] = cvtpk(ivv[0], ivv[1]);
        }
        { u32x4 u0 = {vp[0], vp[1], vp[2], vp[3]}, u1 = {vp[4], vp[5], vp[6], vp[7]};
          *(u32x4*)(vt + ks * 16) = u0; *(u32x4*)(vt + ks * 16 + 8) = u1; }
        u32x4 kown, vown, ksnd, vsnd;
#pragma unroll
        for (int j = 0; j < 4; ++j) { kown[j] = h ? kp[4 + j] : kp[j]; ksnd[j] = h ? kp[j] : kp[4 + j]; vown[j] = h ? vp[4 + j] : vp[j]; vsnd[j] = h ? vp[j] : vp[4 + j]; }
        u32x4 krcv, vrcv;
#pragma unroll
        for (int j = 0; j < 4; ++j) { krcv[j] = (unsigned)__shfl_xor((int)ksnd[j], 32); vrcv[j] = (unsigned)__shfl_xor((int)vsnd[j], 32); }
        const bf16x8 kb0 = __builtin_bit_cast(bf16x8, h ? krcv : kown), kb1 = __builtin_bit_cast(bf16x8, h ? kown : krcv);
        const bf16x8 va0 = __builtin_bit_cast(bf16x8, h ? vrcv : vown), va1 = __builtin_bit_cast(bf16x8, h ? vown : vrcv);
        acc[0][0] = WT_MFMA(va0, kb0, acc[0][0]); acc[0][1] = WT_MFMA(va0, kb1, acc[0][1]);
        acc[1][0] = WT_MFMA(va1, kb0, acc[1][0]); acc[1][1] = WT_MFMA(va1, kb1, acc[1][1]);
    }
    float* up = Ut + (size_t)ci * 4096;
#pragma unroll
    for (int vb = 0; vb < 2; ++vb)
#pragma unroll
        for (int kb = 0; kb < 2; ++kb)
#pragma unroll
            for (int i = 0; i < 16; ++i) { const int v = 32 * vb + (i & 3) + 8 * (i >> 2) + 4 * h; up[v * 64 + 32 * kb + r] = acc[vb][kb][i]; }
}
__device__ __forceinline__ void hg_scan(const float* __restrict__ Ut, const float* __restrict__ Dk, unsigned short* __restrict__ ST, int e) {
    const int k = e & 63, seq = e >> 12, vk = e & 4095;
    float S = 0.f;
    const float* up = Ut + (size_t)seq * 64 * 4096 + vk; const float* dp = Dk + (size_t)seq * 64 * 64 + k; unsigned short* sp = ST + (size_t)seq * 64 * 4096 + vk;
#pragma unroll 8
    for (int c = 0; c < 64; ++c) {
        sp[(size_t)c * 4096] = (unsigned short)(cvtpk(S, 0.f) & 0xffffu);
        S = fmaf(dp[c * 64], S, up[(size_t)c * 4096]);
    }
}
__device__ __forceinline__ void hg_pass3(const unsigned short* __restrict__ hb, const unsigned short* __restrict__ Qt, const unsigned short* __restrict__ Kt, const unsigned short* __restrict__ Qp,
                                         const unsigned short* __restrict__ VT, const unsigned short* __restrict__ ST, const float* __restrict__ normw, unsigned short* __restrict__ ycat, int task, int lane) {
    const int tblk = task & 1, ci = task >> 1, chunk = ci & 63, hd = (ci >> 6) & 3, b = ci >> 8, r = lane & 31, h = lane >> 5;
    const size_t cb = (size_t)ci * 4096;
    f32x16 o0, o1; zero(o0); zero(o1);
    {
        const unsigned short* sp = ST + cb + (size_t)r * 64 + 8 * h; const unsigned short* qp = Qp + cb + (size_t)(32 * tblk + r) * 64 + 8 * h;
#pragma unroll
        for (int ks = 0; ks < 4; ++ks) { const bf16x8 q = ld16(qp + 16 * ks); o0 = WT_MFMA(ld16(sp + 16 * ks), q, o0); o1 = WT_MFMA(ld16(sp + 32 * 64 + 16 * ks), q, o1); }
    }
    const unsigned short* qtp = Qt + cb + (size_t)(32 * tblk + r) * 64 + 8 * h;
    bf16x8 qf[4];
#pragma unroll
    for (int ks = 0; ks < 4; ++ks) qf[ks] = ld16(qtp + 16 * ks);
#pragma unroll 1
    for (int sblk = 0; sblk <= tblk; ++sblk) {
        f32x16 at; zero(at);
        const unsigned short* ktp = Kt + cb + (size_t)(32 * sblk + r) * 64 + 8 * h;
#pragma unroll
        for (int ks = 0; ks < 4; ++ks) at = WT_MFMA(ld16(ktp + 16 * ks), qf[ks], at);
        if (sblk == tblk) {
#pragma unroll
            for (int i = 0; i < 16; ++i) { const int sl = (i & 3) + 8 * (i >> 2) + 4 * h; at[i] = (sl <= r) ? at[i] : 0.f; }
        }
#pragma unroll
        for (int s2 = 0; s2 < 2; ++s2) {
            const bf16x8 pb = pack8(at, s2);
            const unsigned short* vp = VT + cb + (size_t)r * 64 + 32 * sblk + 16 * s2 + 4 * h;
            o0 = WT_MFMA(ld8x2(vp, vp + 8), pb, o0);
            o1 = WT_MFMA(ld8x2(vp + 32 * 64, vp + 32 * 64 + 8), pb, o1);
        }
    }
    const int tok = b * 4096 + chunk * 64 + 32 * tblk + r;
    float ss = 0.f;
#pragma unroll
    for (int i = 0; i < 16; ++i) ss += o0[i] * o0[i] + o1[i] * o1[i];
    ss = xhalf_sum(ss);
    const float rn = rsqrtf(ss * (1.0f / 64.0f) + 1e-6f);
    const unsigned short* gp = hb + (size_t)tok * 3072 + 768 + hd * 64;
    unsigned short* yp = ycat + (size_t)tok * 1024 + hd * 64;
    const float* nw = normw + hd * 64;
    u32x2 gg[2][4]; float4 w4[2][4];
#pragma unroll
    for (int vb = 0; vb < 2; ++vb)
#pragma unroll
        for (int u = 0; u < 4; ++u) { const int v0 = 32 * vb + 8 * u + 4 * h; gg[vb][u] = *(const u32x2*)(gp + v0); w4[vb][u] = *(const float4*)(nw + v0); }
#pragma unroll
    for (int vb = 0; vb < 2; ++vb)
#pragma unroll
        for (int u = 0; u < 4; ++u) {
            const int v0 = 32 * vb + 8 * u + 4 * h;
            const float x0 = (vb ? o1[4 * u] : o0[4 * u]) * rn * w4[vb][u].x * sigm(bflo(gg[vb][u].x)), x1 = (vb ? o1[4 * u + 1] : o0[4 * u + 1]) * rn * w4[vb][u].y * sigm(bfhi(gg[vb][u].x));
            const float x2 = (vb ? o1[4 * u + 2] : o0[4 * u + 2]) * rn * w4[vb][u].z * sigm(bflo(gg[vb][u].y)), x3 = (vb ? o1[4 * u + 3] : o0[4 * u + 3]) * rn * w4[vb][u].w * sigm(bfhi(gg[vb][u].y));
            u32x2 o = {cvtpk(x0, x1), cvtpk(x2, x3)};
            *(u32x2*)(yp + v0) = o;
        }
}

__device__ __forceinline__ void route_task(const unsigned short* __restrict__ x1, const unsigned short* __restrict__ rwh, const unsigned short* __restrict__ rwl, const float* __restrict__ rb,
                                           int* __restrict__ cnt, int* __restrict__ list, int* __restrict__ tok_e, int* __restrict__ tok_slot, float* __restrict__ tok_w, int task, int lane) {
    const int r = lane & 31, h = lane >> 5, tok = task * 32 + r;
    const unsigned short* xp = x1 + (size_t)tok * 1024 + 8 * h;
    const unsigned short* whp = rwh + (size_t)r * 1024 + 8 * h; const unsigned short* wlp = rwl + (size_t)r * 1024 + 8 * h;
    f32x16 acc; zero(acc);
#pragma unroll 8
    for (int ks = 0; ks < 64; ++ks) {
        const bf16x8 xh = ld16(xp + 16 * ks);
        acc = WT_MFMA(ld16(whp + 16 * ks), xh, acc); acc = WT_MFMA(ld16(wlp + 16 * ks), xh, acc);
    }
    float v[16];
#pragma unroll
    for (int i = 0; i < 16; ++i) v[i] = acc[i] + rb[(i & 3) + 8 * (i >> 2) + 4 * h];
    float cv[8]; int ce[8];
#pragma unroll
    for (int k = 0; k < 4; ++k) {
        float best = -3.0e38f; int bi = 0;
#pragma unroll
        for (int i = 0; i < 16; ++i) { const bool ok = v[i] > best; best = ok ? v[i] : best; bi = ok ? i : bi; }
#pragma unroll
        for (int i = 0; i < 16; ++i) v[i] = (i == bi) ? -3.0e38f : v[i];
        cv[k] = best; ce[k] = (bi & 3) + 8 * (bi >> 2) + 4 * h;
    }
#pragma unroll
    for (int k = 0; k < 4; ++k) { cv[4 + k] = xhalf(cv[k]); ce[4 + k] = __shfl_xor(ce[k], 32); }
    float tl[4]; int te[4];
#pragma unroll
    for (int k = 0; k < 4; ++k) {
        float best = -3.0e38f; int be = 64, bj = 0;
#pragma unroll
        for (int j = 0; j < 8; ++j) { const bool ok = (cv[j] > best) || (cv[j] == best && ce[j] < be); best = ok ? cv[j] : best; be = ok ? ce[j] : be; bj = ok ? j : bj; }
#pragma unroll
        for (int j = 0; j < 8; ++j) cv[j] = (j == bj) ? -3.0e38f : cv[j];
        tl[k] = best; te[k] = be;
    }
    const float e1 = __expf(tl[1] - tl[0]), e2 = __expf(tl[2] - tl[0]), e3 = __expf(tl[3] - tl[0]);
    const float inv = 1.0f / (1.0f + e1 + e2 + e3);
    const float tw[4] = {inv, e1 * inv, e2 * inv, e3 * inv};
    unsigned mymask = 0u;
#pragma unroll 1
    for (int e = 0; e < 32; ++e) {
        const unsigned mk = (unsigned)__ballot(h == 0 && (te[0] == e || te[1] == e || te[2] == e || te[3] == e));
        mymask = (lane == e) ? mk : mymask;
    }
    int base = 0;
    if (lane < 32 && mymask != 0u) base = atomicAdd(&cnt[lane], __popc(mymask));
#pragma unroll
    for (int k = 0; k < 4; ++k) {
        const int bk = __shfl(base, te[k]); const unsigned mk = (unsigned)__shfl((int)mymask, te[k]);
        const int slot = bk + __popc(mk & ((1u << r) - 1u));
        if (h == 0) { list[te[k] * 32768 + slot] = tok; tok_e[tok * 4 + k] = te[k]; tok_slot[tok * 4 + k] = slot; tok_w[tok * 4 + k] = tw[k]; }
    }
}
}


__device__ __forceinline__ void ln1_tok2(const float* __restrict__ xin_f, const bf16* __restrict__ xin_b, const bf16* __restrict__ mix, const float* __restrict__ lw, const float* __restrict__ lbias,
                                         bf16* __restrict__ x1b, unsigned char* __restrict__ x1q, int tok0, int lane) {
    float v[2][16]; float s[2] = {0.f, 0.f};
#pragma unroll
    for (int u = 0; u < 2; ++u)
#pragma unroll
        for (int j = 0; j < 4; ++j) {
            const size_t o = (size_t)(tok0 + u) * D_ + j * 256 + lane * 4;
            float4 a;
            if (xin_f) a = *(const float4*)(xin_f + o);
            else { const uint2 ab = *(const uint2*)(xin_b + o);
                   a = make_float4(__uint_as_float(ab.x << 16), __uint_as_float(ab.x & 0xffff0000u), __uint_as_float(ab.y << 16), __uint_as_float(ab.y & 0xffff0000u)); }
            const uint2 mb = *(const uint2*)(mix + o);
            v[u][4 * j] = ALPHA * a.x + __uint_as_float(mb.x << 16); v[u][4 * j + 1] = ALPHA * a.y + __uint_as_float(mb.x & 0xffff0000u);
            v[u][4 * j + 2] = ALPHA * a.z + __uint_as_float(mb.y << 16); v[u][4 * j + 3] = ALPHA * a.w + __uint_as_float(mb.y & 0xffff0000u);
            s[u] += (v[u][4 * j] + v[u][4 * j + 1]) + (v[u][4 * j + 2] + v[u][4 * j + 3]);
        }
    float rstd[2];
#pragma unroll
    for (int u = 0; u < 2; ++u) {
        const float mean = wsum(s[u]) * (1.0f / D_); float q = 0.f;
#pragma unroll
        for (int i = 0; i < 16; ++i) { v[u][i] -= mean; q += v[u][i] * v[u][i]; }
        rstd[u] = rsqrtf(wsum(q) * (1.0f / D_) + 1e-5f);
    }
    float4 w4a[4], b4a[4];
#pragma unroll
    for (int j = 0; j < 4; ++j) { w4a[j] = *(const float4*)(lw + j * 256 + lane * 4); b4a[j] = *(const float4*)(lbias + j * 256 + lane * 4); }
#pragma unroll
    for (int j = 0; j < 4; ++j) {
        const float4 w4 = w4a[j], b4 = b4a[j];
#pragma unroll
        for (int u = 0; u < 2; ++u) {
            const size_t o = (size_t)(tok0 + u) * D_ + j * 256 + lane * 4;
            const float4 r = make_float4(v[u][4 * j] * rstd[u] * w4.x + b4.x, v[u][4 * j + 1] * rstd[u] * w4.y + b4.y, v[u][4 * j + 2] * rstd[u] * w4.z + b4.z, v[u][4 * j + 3] * rstd[u] * w4.w + b4.w);
            *(uint2*)(x1b + o) = make_uint2(pk2(r.x, r.y), pk2(r.z, r.w));
            *(unsigned*)(x1q + o) = pg8::pk4_fp8(r.x, r.y, r.z, r.w);
        }
    }
}
__device__ __forceinline__ void comb_ln2_tok2(const bf16* __restrict__ x1, const bf16* __restrict__ y, const int* __restrict__ offs, const int* __restrict__ tok_e,
                                              const int* __restrict__ tok_slot, const float* __restrict__ tok_w, const float* __restrict__ lw, const float* __restrict__ lbias,
                                              float* __restrict__ xout, bf16* __restrict__ xbout, int tok0, int lane, const int (&row)[2][4], const float (&wk)[2][4]) {
    float v[2][16];
#pragma unroll
    for (int u = 0; u < 2; ++u)
#pragma unroll
        for (int j = 0; j < 4; ++j) { const uint2 ab = *(const uint2*)(x1 + (size_t)(tok0 + u) * D_ + j * 256 + lane * 4);
            v[u][4 * j] = ALPHA * __uint_as_float(ab.x << 16); v[u][4 * j + 1] = ALPHA * __uint_as_float(ab.x & 0xffff0000u); v[u][4 * j + 2] = ALPHA * __uint_as_float(ab.y << 16); v[u][4 * j + 3] = ALPHA * __uint_as_float(ab.y & 0xffff0000u); }
#pragma unroll
    for (int u = 0; u < 2; ++u)
#pragma unroll
        for (int k = 0; k < 4; ++k)
#pragma unroll
            for (int j = 0; j < 4; ++j) { const uint2 ab = *(const uint2*)(y + (size_t)row[u][k] * D_ + j * 256 + lane * 4); const float w = wk[u][k];
                v[u][4 * j] = fmaf(w, __uint_as_float(ab.x << 16), v[u][4 * j]); v[u][4 * j + 1] = fmaf(w, __uint_as_float(ab.x & 0xffff0000u), v[u][4 * j + 1]);
                v[u][4 * j + 2] = fmaf(w, __uint_as_float(ab.y << 16), v[u][4 * j + 2]); v[u][4 * j + 3] = fmaf(w, __uint_as_float(ab.y & 0xffff0000u), v[u][4 * j + 3]); }
    float rstd[2];
#pragma unroll
    for (int u = 0; u < 2; ++u) {
        float s = 0.f;
#pragma unroll
        for (int i = 0; i < 16; ++i) s += v[u][i];
        const float mean = wsum(s) * (1.0f / D_); float q = 0.f;
#pragma unroll
        for (int i = 0; i < 16; ++i) { v[u][i] -= mean; q += v[u][i] * v[u][i]; }
        rstd[u] = rsqrtf(wsum(q) * (1.0f / D_) + 1e-5f);
    }
    float4 w4a[4], b4a[4];
#pragma unroll
    for (int j = 0; j < 4; ++j) { w4a[j] = *(const float4*)(lw + j * 256 + lane * 4); b4a[j] = *(const float4*)(lbias + j * 256 + lane * 4); }
#pragma unroll
    for (int j = 0; j < 4; ++j) {
        const float4 w4 = w4a[j], b4 = b4a[j];
#pragma unroll
        for (int u = 0; u < 2; ++u) {
            const size_t o = (size_t)(tok0 + u) * D_ + j * 256 + lane * 4;
            const float4 r = make_float4(v[u][4 * j] * rstd[u] * w4.x + b4.x, v[u][4 * j + 1] * rstd[u] * w4.y + b4.y, v[u][4 * j + 2] * rstd[u] * w4.z + b4.z, v[u][4 * j + 3] * rstd[u] * w4.w + b4.w);
            if (xout) *(float4*)(xout + o) = r;
            if (xbout) *(uint2*)(xbout + o) = make_uint2(pk2(r.x, r.y), pk2(r.z, r.w));
        }
    }
}

struct Args { const float* in[25]; float* out; unsigned char* ws; int ph_lo, ph_hi; };
#define PH __device__ __forceinline__
constexpr int TAB_OFF = 131072;

__device__ __forceinline__ void transpose_item(const float* __restrict__ W, int K, int N, bf16* __restrict__ WT, int k0, int scol0, int drow0, float* scr, int lane) {
    const int cc = lane & 31; const bool cv = (scol0 + cc) < N;
#pragma unroll 8
    for (int i = 0; i < 32; ++i) { const int kk = 2 * i + (lane >> 5); scr[kk * 33 + cc] = cv ? W[(size_t)(k0 + kk) * N + scol0 + cc] : 0.f; }
    asm volatile("s_waitcnt lgkmcnt(0)" ::: "memory");
    const int c = lane & 7;
#pragma unroll
    for (int j = 0; j < 4; ++j) { const int n = (lane >> 3) + 8 * j; const float* s = scr + (8 * c) * 33 + n;
        uint4 o; o.x = pk2(s[0 * 33], s[1 * 33]); o.y = pk2(s[2 * 33], s[3 * 33]); o.z = pk2(s[4 * 33], s[5 * 33]); o.w = pk2(s[6 * 33], s[7 * 33]);
        *(uint4*)(WT + (size_t)(drow0 + n) * K + k0 + 8 * c) = o; }
    asm volatile("s_waitcnt lgkmcnt(0)" ::: "memory");
}
__device__ __forceinline__ void transpose64(const float* __restrict__ W, int K, int N, bf16* __restrict__ WT, int k0, int scol0, int drow0, int lane) {
    const int q = lane >> 4, c = lane & 15;
    const bool cv = (scol0 + 4 * c) < N;
    const float* src = W + (size_t)(k0 + 16 * q) * N + scol0 + 4 * c;
    float4 v[16];
#pragma unroll
    for (int i = 0; i < 16; ++i) v[i] = cv ? *(const float4*)(src + (size_t)i * N) : make_float4(0.f, 0.f, 0.f, 0.f);
    bf16* dst = WT + (size_t)(drow0 + 4 * c) * K + k0 + 16 * q;
#pragma unroll
    for (int j = 0; j < 4; ++j) {
        float e[16];
#pragma unroll
        for (int i = 0; i < 16; ++i) e[i] = (j == 0) ? v[i].x : (j == 1) ? v[i].y : (j == 2) ? v[i].z : v[i].w;
        uint4 o0, o1;
        o0.x = pk2(e[0], e[1]); o0.y = pk2(e[2], e[3]); o0.z = pk2(e[4], e[5]); o0.w = pk2(e[6], e[7]);
        o1.x = pk2(e[8], e[9]); o1.y = pk2(e[10], e[11]); o1.z = pk2(e[12], e[13]); o1.w = pk2(e[14], e[15]);
        *(uint4*)(dst + (size_t)j * K) = o0; *(uint4*)(dst + (size_t)j * K + 8) = o1;
    }
}
struct T64Item { const float* src; unsigned char* dst; };
__device__ __forceinline__ void t64_load(const float* src, int N, float4 (&v)[16]) {
#pragma unroll
    for (int i = 0; i < 16; ++i) { typedef float f4v __attribute__((ext_vector_type(4))); const f4v t = __builtin_nontemporal_load((const f4v*)(src + (size_t)i * N)); v[i] = make_float4(t.x, t.y, t.z, t.w); }
}
__device__ __forceinline__ unsigned pk4_fp8_nc(float a, float b, float c, float d) { int p = __builtin_amdgcn_cvt_pk_fp8_f32(a, b, 0, false); p = __builtin_amdgcn_cvt_pk_fp8_f32(c, d, p, true); return (unsigned)p; }
__device__ __forceinline__ void t64_store_f8(unsigned char* dst, int K, float sc, const float4 (&v)[16]) {
#pragma unroll
    for (int j = 0; j < 4; ++j) {
        float e[16];
#pragma unroll
        for (int i = 0; i < 16; ++i) e[i] = sc * ((j == 0) ? v[i].x : (j == 1) ? v[i].y : (j == 2) ? v[i].z : v[i].w);
        uint4 o;
        o.x = pk4_fp8_nc(e[0], e[1], e[2], e[3]); o.y = pk4_fp8_nc(e[4], e[5], e[6], e[7]); o.z = pk4_fp8_nc(e[8], e[9], e[10], e[11]); o.w = pk4_fp8_nc(e[12], e[13], e[14], e[15]);
        *(uint4*)(dst + (size_t)j * K) = o;
    }
}
__device__ __forceinline__ void t64_item(int it, const float* w_up, const float* w_dn, unsigned char* wt_up, unsigned char* wt_dn, int lane, const float*& src, unsigned char*& dst, int& N, float& sc) {
    constexpr int I_UP = 16 * 32, I_DN = 16 * 16;
    const int q = lane >> 4, c = lane & 15;
    if (it < NE * I_UP) { const int e = it / I_UP, r = it % I_UP, kb = r / 32, nb = r % 32;
        const int n0 = nb * 64, pn = n0 >> 8, bj = (n0 >> 7) & 1, jj = n0 & 127;
        src = w_up + (size_t)e * D_ * 2048 + (size_t)(kb * 64 + 16 * q) * 2048 + bj * 1024 + 128 * pn + jj + 4 * c;
        dst = wt_up + (size_t)e * 2048 * D_ + (size_t)(n0 + 4 * c) * D_ + kb * 64 + 16 * q; N = 2048; sc = pg8::F8_SU; }
    else { const int r0 = it - NE * I_UP; const int e = r0 / I_DN, r = r0 % I_DN, kb = r / 16, nb = r % 16;
        src = w_dn + (size_t)e * D_ * D_ + (size_t)(kb * 64 + 16 * q) * D_ + nb * 64 + 4 * c;
        dst = wt_dn + (size_t)e * D_ * D_ + (size_t)(nb * 64 + 4 * c) * D_ + kb * 64 + 16 * q; N = D_; sc = pg8::F8_SD; }
}
PH void ph_prologue(int wv, const int* pos, const float* hg_lb, float* cosT, float* sinT, float* lb,
                    const float* x, bf16* xb, const float* w_in, const float* w_out, const float* w_up, const float* w_dn, bf16* wt_in, bf16* wt_out, bf16* wt_up, bf16* wt_dn,
                    const float* gm_sw, bf16* wb, const float* cpe, const float* cw1, bf16* w1t, float* cbias, const float* cw2, bf16* w2t, const float* rw, bf16* rwh, bf16* rwl) {
    extern __shared__ __attribute__((aligned(16))) unsigned char lds[];
    int tid = mk_tid(wv), bid = blockIdx.x; asm volatile("" : "+v"(tid), "+s"(bid)); const int G = gridDim.x, lane = tid & 63, wave = wv;
#pragma unroll 1
    for (int i0 = bid * NTHR + tid; i0 < NT * 32; i0 += 4 * G * NTHR) {
        int pv[4];
#pragma unroll
        for (int u = 0; u < 4; ++u) { const int i = i0 + u * G * NTHR; pv[u] = (i < NT * 32) ? pos[i >> 5] : 0; }
#pragma unroll
        for (int u = 0; u < 4; ++u) { const int i = i0 + u * G * NTHR; if (i < NT * 32) { const int j = i & 31;
            float inv = (float)pow(10000.0, -(double)(2 * j) / 64.0);
            float ang = (float)pv[u] * inv;
            const double ad = (double)ang, kk = rint(ad * 0.15915494309189535);
            const float rf = (float)fma(-kk, 6.283185307179586, ad);
            cosT[i] = cosf(rf); sinT[i] = sinf(rf); } }
    }
    if (bid == 0 && tid < 256) {
        float p0 = hg_lb[tid], p1 = hg_lb[256 + tid];
        float m = fmaxf(p0, p1); float ea = expf(p0 - m), eb = expf(p1 - m);
        lb[tid] = 0.f; lb[256 + tid] = eb / (ea + eb);
    }
    {
        const size_t n4 = (size_t)NT * D_ / 4, stride = (size_t)G * NTHR;
#pragma unroll 1
        for (size_t i = (size_t)bid * NTHR + tid; i < n4; i += 8 * stride) {
            float4 v[8];
#pragma unroll
            for (int u = 0; u < 8; ++u) { const size_t j = i + u * stride; v[u] = (j < n4) ? ((const float4*)x)[j] : make_float4(0.f, 0.f, 0.f, 0.f); }
#pragma unroll
            for (int u = 0; u < 8; ++u) { const size_t j = i + u * stride; if (j < n4) ((uint2*)xb)[j] = make_uint2(pk2(v[u].x, v[u].y), pk2(v[u].z, v[u].w)); }
        }
    }
#pragma unroll 1
    for (int i = bid * NTHR + tid; i < DEPTH * NE * D_; i += G * NTHR) { const int k = i & 1023, e = (i >> 10) & 31, l = i >> 15; const float w = rw[((size_t)l * D_ + k) * NE + e];
        const unsigned hi = f2bf(w); rwh[i] = (bf16)hi; rwl[i] = (bf16)f2bf(w - __uint_as_float(hi << 16)); }
#pragma unroll 1
    for (int i = bid * NTHR + tid; i < DEPTH * 4 * 128 * 128; i += G * NTHR) { const int s = i & 127, t = (i >> 7) & 127; wb[i] = (bf16)f2bf(s <= t ? gm_sw[i] : 0.f); }
    {
        const int gwv = bid * 8 + wave, NGWV = G * 8;
#pragma unroll 1
        for (int o = gwv; o < DEPTH * 2 * 128; o += NGWV) {
            const int lk = o >> 7, n = o & 127;
            float a = 0.f;
#pragma unroll 8
            for (int i = lane; i < 2048; i += 64) a = fmaf(cpe[lk * 2048 + i], cw1[((size_t)lk * 2048 + i) * 128 + n], a);
            a = wsum(a);
            if (lane == 0) cbias[o] = a;
        }
    }
    float* scr = (float*)(lds + wave * 16384);
    const int gw = bid * 8 + wave, NGW = G * 8;
    constexpr int I_IN = 16 * 45, I_OUT = 16 * 16;
    constexpr int I_C1 = 32 * 4;
    constexpr int I_C2 = 2 * 2;
    constexpr int PER_L = I_IN + I_OUT + 2 * I_C1 + 2 * I_C2;
#pragma unroll 1
    for (int it = gw; it < DEPTH * PER_L; it += NGW) {
        const int l = it / PER_L; int r = it % PER_L;
        if (r < I_IN) { const int kb = r / 45, nb = r % 45; transpose64(w_in + (size_t)l * D_ * INW, D_, INW, wt_in + (size_t)l * HS * D_, kb * 64, nb * 64, nb * 64, lane); continue; }
        r -= I_IN;
        if (r < I_OUT) { const int kb = r / 16, nb = r % 16; transpose64(w_out + (size_t)l * D_ * D_, D_, D_, wt_out + (size_t)l * D_ * D_, kb * 64, nb * 64, nb * 64, lane); continue; }
        r -= I_OUT;
        if (r < 2 * I_C1) { const int kv = r / I_C1, q = r % I_C1, kb = q / 4, nb = q % 4;
            transpose_item(cw1 + ((size_t)l * 2 + kv) * 2048 * 128, 2048, 128, w1t + ((size_t)l * 2 + kv) * 128 * 2048, kb * 64, nb * 32, nb * 32, scr, lane); continue; }
        r -= 2 * I_C1;
        { const int kv = r / I_C2, q = r % I_C2, kb = q / 2, nb = q % 2;
            transpose_item(cw2 + ((size_t)l * 2 + kv) * 128 * 64, 128, 64, w2t + ((size_t)l * 2 + kv) * 64 * 128, kb * 64, nb * 32, nb * 32, scr, lane); }
    }
}
#define M1EN(x) 1
#ifndef M1REP
#define M1R(x) 1
#else
#define M1R(x) (((x) == M1REP) ? 3 : 1)
#endif
PH void ph_mix1(int wv, const bf16* hb, const float* lb, bf16* hqt, bf16* hkt, bf16* hqp, bf16* hvt, float* hut, float* hdk,
                const float* glw, const float* glb, bf16* vlnT, const bf16* w1t, const float* cbias, const bf16* w2, bf16* kcb, bf16* vcb,
                const float* cosT, const float* sinT, bf16* ksb, bf16* vsb, bf16* kwb, bf16* vwb,
                const float* w_up, const float* w_dn, unsigned char* wt_up, unsigned char* wt_dn) {
    extern __shared__ __attribute__((aligned(16))) unsigned char lds[];
    int tid = mk_tid(wv), bid = blockIdx.x; asm volatile("" : "+v"(tid), "+s"(bid)); const int lane = tid & 63, wave = wv, G = gridDim.x;
    const int gw = bid * 8 + wave, NGW = G * 8;
    { int ln = lane; asm volatile("" : "+v"(ln));
#pragma unroll 1
    for (int rp = 0; rp < M1R(1); ++rp)
#pragma unroll 1
    for (int u = bid; u < 256 && M1EN(1); u += G) wt::cmp_wg(hb, w1t, cbias, w2, kcb, vcb, (WT_LAS float*)lds, u, wave, ln); }
#pragma unroll 1
    for (int pass = 0; pass < 2; ++pass) {
        if (((pass ^ wave) & 1) == 0) {
            { int ln = lane; asm volatile("" : "+v"(ln));
#pragma unroll 1
            for (int rp = 0; rp < M1R(2); ++rp)
#pragma unroll 1
            for (int u = gw; u < 2048 && M1EN(2); u += NGW) wt::hg_pass1(hb, lb, hqt, hkt, hqp, hvt, hut, hdk, u, ln); }
            { int ln = lane; asm volatile("" : "+v"(ln));
#pragma unroll 1
            for (int rp = 0; rp < M1R(4); ++rp)
#pragma unroll 1
            for (int u = gw; u < NT / 8 && M1EN(4); u += NGW) wt::gm_ln8(hb, glw, glb, vlnT, u, ln); }
            { int t_ = tid; asm volatile("" : "+v"(t_));
#pragma unroll 1
            for (int rp = 0; rp < M1R(8); ++rp)
#pragma unroll 1
            for (int idx = bid * NTHR + t_; idx < NT * 8; idx += G * NTHR) wt::kvprep8(hb, cosT, sinT, ksb, vsb, kwb, vwb, idx); }
        } else {
            int ln = lane; asm volatile("" : "+v"(ln));
            constexpr int NIT = NE * (16 * 32 + 16 * 16);
#pragma unroll 1
            for (int rp = 0; rp < M1R(16); ++rp)
#pragma unroll 1
            for (int it = gw; it < NIT; it += NGW) {
                float4 va[16]; const float* s0; unsigned char* d0; int n0_; float c0_;
                t64_item(it, w_up, w_dn, wt_up, wt_dn, ln, s0, d0, n0_, c0_); t64_load(s0, n0_, va); t64_store_f8(d0, D_, c0_, va);
            }
        }
    }
}
PH void ph_mix2(int wv, const float* hut, const float* hdk, bf16* hst, const bf16* hb, const bf16* vlnT, const bf16* wb, const float* sb, const float* nw, bf16* ycat) {
    int tid = mk_tid(wv), bid = blockIdx.x; asm volatile("" : "+v"(tid), "+s"(bid)); const int lane = tid & 63, wave = wv, G = gridDim.x;
#pragma unroll 1
    for (int e = bid * NTHR + tid; e < 32 * 4096; e += G * NTHR) wt::hg_scan(hut, hdk, hst, e);
    const int gw = bid * 8 + wave, NGW = G * 8;
#pragma unroll 1
    for (int u = gw; u < 4096; u += NGW) wt::gm_sp_task(hb, vlnT, wb, sb, nw, ycat, u, lane);
}
PH void ph_hg3(int wv, const bf16* hb, const bf16* hqt, const bf16* hkt, const bf16* hqp, const bf16* hvt, const bf16* hst, const float* nw, bf16* ycat) {
    int tid = mk_tid(wv), bid = blockIdx.x; asm volatile("" : "+v"(tid), "+s"(bid)); const int lane = tid & 63, wave = wv, G = gridDim.x;
    const int gw = bid * 8 + wave, NGW = G * 8;
#pragma unroll 1
    for (int u = gw; u < 4096; u += NGW) wt::hg_pass3(hb, hqt, hkt, hqp, hvt, hst, nw, ycat, u, lane);
}
PH void ph_ln1_route(int wv, const float* xin_f, const bf16* xin_b, const bf16* mix, const float* lw, const float* lb, bf16* x1b, unsigned char* x1q,
                     const bf16* rwh, const bf16* rwl, const float* rb, int* cnt, int* list, int* tok_e, int* tok_slot, float* tok_w) {
    int tid = mk_tid(wv), bid = blockIdx.x; asm volatile("" : "+v"(tid), "+s"(bid)); const int lane = tid & 63, wave = wv, G = gridDim.x;
#pragma unroll 1
    for (int it = bid; it < NT / 128; it += G) {
        { int ln = lane; asm volatile("" : "+v"(ln));
#pragma unroll 1
          for (int k = 0; k < 8; ++k) ln1_tok2(xin_f, xin_b, mix, lw, lb, x1b, x1q, it * 128 + wave * 16 + 2 * k, ln); }
        asm volatile("s_waitcnt vmcnt(0)" ::: "memory"); __builtin_amdgcn_fence(__ATOMIC_RELEASE, "workgroup"); __syncthreads(); __builtin_amdgcn_fence(__ATOMIC_ACQUIRE, "workgroup");
        if (wave < 4) { int ln = lane; asm volatile("" : "+v"(ln)); wt::route_task(x1b, rwh, rwl, rb, cnt, list, tok_e, tok_slot, tok_w, it * 4 + wave, ln); }
    }
}
PH void ph_comb(int wv, const bf16* x1, const bf16* ybuf, const int* tok_e, const int* tok_slot, const float* tok_w, const float* lw, const float* lb, float* xo, bf16* xbo) {
    extern __shared__ __attribute__((aligned(16))) unsigned char lds[];
    const int* offs_s = (const int*)(lds + TAB_OFF + 512);
    int tid = mk_tid(wv), bid = blockIdx.x; asm volatile("" : "+v"(tid), "+s"(bid)); const int lane = tid & 63, wave = wv, G = gridDim.x;
#pragma unroll 1
    for (int t0 = (bid * 8 + wave) * 16; t0 < NT; t0 += G * 128) {
        const int ia = t0 * 4 + lane;
        const int rowl = offs_s[tok_e[ia]] + tok_slot[ia]; const float wl = tok_w[ia];
#pragma unroll 1
        for (int p = 0; p < 8; ++p) {
            int row[2][4]; float wk[2][4];
#pragma unroll
            for (int u = 0; u < 2; ++u)
#pragma unroll
                for (int k = 0; k < 4; ++k) { row[u][k] = __shfl(rowl, p * 8 + u * 4 + k); wk[u][k] = __shfl(wl, p * 8 + u * 4 + k); }
            comb_ln2_tok2(x1, ybuf, offs_s, tok_e, tok_slot, tok_w, lw, lb, xo, xbo, t0 + 2 * p, lane, row, wk);
        }
    }
}

typedef const Args __attribute__((address_space(4))) CArgs;
#define PHASE_BEGIN CArgs* ap = (CArgs*)__builtin_amdgcn_kernarg_segment_ptr(); int l_ = l; asm volatile("" : "+s"(ap), "+s"(l_)); unsigned char* const ws_ = ap->ws; \
    const int G = gridDim.x; int bid = blockIdx.x; asm volatile("" : "+s"(bid));
#define WP(T, off) ((T*)(ws_ + (off)))
#define INP(k) (ap->in[k])
__global__ void __launch_bounds__(NTHR, 2) mega(Args a) {
    extern __shared__ __attribute__((aligned(16))) unsigned char lds[];
    volatile LAS unsigned* MISC = (volatile LAS unsigned*)((LAS unsigned char*)lds + MISC_OFF);
    int wv = __builtin_amdgcn_readfirstlane((int)threadIdx.x >> 6); asm volatile("" : "+s"(wv));
    { const int t0 = mk_tid(wv); if (t0 < 64) MISC[t0] = 0u; }
    __syncthreads();
    XcdBarrier bar = xcd_barrier_post((unsigned*)a.ws, MISC + 8, wv);
    int* tstart = (int*)(lds + TAB_OFF); int* cnts = (int*)(lds + TAB_OFF + 256); int* offs_s = (int*)(lds + TAB_OFF + 512);
    PG8_LAS unsigned char* ldsl = (PG8_LAS unsigned char*)lds;

#ifndef PH_MASK
#define EN(n) 1
#else
#define EN(n) ((PH_MASK >> ((n) % 20)) & 1)
#endif
#define IN(k) 1
#ifndef REP_PH
#define REPL(id)
#else
#define REPL(id) _Pragma("unroll 1") for (int rep_ = 0; rep_ < (((id) == REP_PH) ? REP_N : 1); ++rep_)
#endif
#define SEAM(k) xcd_barrier(bar)

    REPL(19) if (EN(19) && IN(0)) { const int l = 0; PHASE_BEGIN; (void)l_; (void)G; (void)bid;
        ph_prologue(wv, (const int*)INP(1), INP(3), WP(float, O_COS), WP(float, O_SIN), WP(float, O_LB), INP(0), WP(bf16, O_XB), INP(2), INP(14), INP(19), INP(21),
                    WP(bf16, O_WIN), WP(bf16, O_WOUT), WP(bf16, O_WUP), WP(bf16, O_WDN), INP(7), WP(bf16, O_WB), INP(10), INP(11), WP(bf16, O_W1T), WP(float, O_CBIAS), INP(12), WP(bf16, O_W2T), INP(17), WP(bf16, O_RWH), WP(bf16, O_RWL)); }
    xcd_barrier_first(bar);

#pragma unroll 1
    for (int l = 0; l < DEPTH; ++l) {
        REPL(0) if (EN(0) && IN(pb + 0)) {
            PHASE_BEGIN;
            pg8::PlainOrder S{WP(bf16, O_WIN) + (size_t)l_ * HS * D_, D_, NT / 256, HS / 256, G, bid};
            pg8::EpiBf16 E{WP(bf16, O_HB), HS, nullptr, 0};
            pg8::gemm_phase<pg8::EpiBf16, pg8::PlainOrder, true>(wv, ldsl, WP(bf16, O_XB), D_ * 2, S, E);
#ifdef DUP_WIN
            pg8::gemm_phase<pg8::EpiBf16, pg8::PlainOrder, true>(wv, ldsl, WP(bf16, O_XB), D_ * 2, S, E);
#endif
        }
        SEAM(pb + 0);
        REPL(1) if (EN(1)) {
            PHASE_BEGIN; (void)G; (void)bid;
            ph_mix1(wv, WP(bf16, O_HB), WP(float, O_LB) + l_ * 256, WP(bf16, O_HQT), WP(bf16, O_HKT), WP(bf16, O_HQP), WP(bf16, O_HVT), WP(float, O_HUT), WP(float, O_HDK),
                    INP(5) + l_ * 256, INP(6) + l_ * 256, WP(bf16, O_VLNT), WP(bf16, O_W1T) + (size_t)l_ * 2 * 128 * 2048, WP(float, O_CBIAS) + l_ * 256, WP(bf16, O_W2T) + (size_t)l_ * 2 * 64 * 128,
                    WP(bf16, O_KCB), WP(bf16, O_VCB), WP(float, O_COS), WP(float, O_SIN), WP(bf16, O_KSB), WP(bf16, O_VSB), WP(bf16, O_KWB), WP(bf16, O_VWB),
                    INP(19) + (size_t)l_ * NE * D_ * 2048, INP(21) + (size_t)l_ * NE * D_ * D_, WP(unsigned char, O_WUP) + (size_t)l_ * NE * 2048 * D_, WP(unsigned char, O_WDN) + (size_t)l_ * NE * D_ * D_);
        }
        SEAM(pb + 1);
        REPL(11) if (EN(11)) {
            PHASE_BEGIN; (void)G; (void)bid;
            ph_mix2(wv, WP(float, O_HUT), WP(float, O_HDK), WP(bf16, O_HST), WP(bf16, O_HB), WP(bf16, O_VLNT), WP(bf16, O_WB) + (size_t)l_ * 4 * 128 * 128, INP(8) + l_ * 512, INP(9) + l_ * 256, WP(bf16, O_YCAT));
        }
        SEAM(pb + 1);
        {
            PHASE_BEGIN;
            REPL(2) if (EN(2)) ph_hg3(wv, WP(bf16, O_HB), WP(bf16, O_HQT), WP(bf16, O_HKT), WP(bf16, O_HQP), WP(bf16, O_HVT), WP(bf16, O_HST), INP(4) + l_ * 256, WP(bf16, O_YCAT));
            REPL(12) if (EN(12)) {
                nsa::Params NP{WP(bf16, O_HB), WP(bf16, O_KCB), WP(bf16, O_VCB), WP(bf16, O_KSB), WP(bf16, O_VSB), WP(bf16, O_KWB), WP(bf16, O_VWB), WP(float, O_COS), WP(float, O_SIN), INP(13) + l_ * 512, WP(bf16, O_YCAT)};
                int tid = mk_tid(wv); asm volatile("" : "+v"(tid));
                __syncthreads();
                nsa::phase(NP, ldsl, tid, bid, G);
            }
        }
        SEAM(pb + 2);
        REPL(3) if (EN(3) && IN(pb + 3)) {
            PHASE_BEGIN;
            pg8::PlainOrder S{WP(bf16, O_WOUT) + (size_t)l_ * D_ * D_, D_, NT / 256, D_ / 256, G, bid};
            pg8::EpiBf16 E{WP(bf16, O_MIXB), D_, nullptr, 0};
            pg8::gemm_phase<pg8::EpiBf16, pg8::PlainOrder, true>(wv, ldsl, WP(bf16, O_YCAT), D_ * 2, S, E);
#ifdef DUP_WOUT
            pg8::gemm_phase<pg8::EpiBf16, pg8::PlainOrder, true>(wv, ldsl, WP(bf16, O_YCAT), D_ * 2, S, E);
#endif
        }
        SEAM(pb + 3);
        if (EN(4)) {
            PHASE_BEGIN; (void)G; (void)bid;
            ph_ln1_route(wv, l_ == 0 ? INP(0) : (const float*)nullptr, WP(bf16, O_XB), WP(bf16, O_MIXB), INP(15) + l_ * D_, INP(16) + l_ * D_, WP(bf16, O_X1B), WP(unsigned char, O_X1Q),
                         WP(bf16, O_RWH) + (size_t)l_ * NE * D_, WP(bf16, O_RWL) + (size_t)l_ * NE * D_, INP(18) + l_ * NE,
                         (int*)(ws_ + 32768) + l_ * 64, WP(int, O_LIST), WP(int, O_TE), WP(int, O_TS), WP(float, O_TW));
        }
        SEAM(pb + 4);
        if (IN(pb + 5) || IN(pb + 6) || IN(pb + 7)) {
            PHASE_BEGIN; (void)G; (void)bid;
            int* cnt = (int*)(ws_ + 32768) + l_ * 64;
            __syncthreads();
            if (wv == 0) {
                const int ln = mk_tid(wv) & 63, e = ln & 31;
                const int c = __hip_atomic_load(&cnt[e], __ATOMIC_RELAXED, __HIP_MEMORY_SCOPE_AGENT);
                const int nt_ = (c + 255) >> 8; int incl = nt_;
#pragma unroll
                for (int o = 1; o < 32; o <<= 1) { const int v = __shfl_up(incl, o, 32); if (e >= o) incl += v; }
                if (ln < 32) { tstart[e] = incl - nt_; offs_s[e] = (incl - nt_) * 256; cnts[e] = c; if (e == 31) tstart[32] = incl; }
            }
            __syncthreads();
        }
        REPL(5) if (EN(5) && IN(pb + 5)) {
            PHASE_BEGIN;
            pg8::MoeOrder<true> S{WP(unsigned char, O_WUP) + (size_t)l_ * NE * 2048 * D_, D_, 8, G, bid, (size_t)2048 * D_, tstart, cnts, WP(int, O_LIST)};
            pg8::EpiUpF8 E{WP(unsigned char, O_ACT), INP(20) + (size_t)l_ * NE * 2048};
            pg8::gemm_phase<pg8::EpiUpF8, pg8::MoeOrder<true>, true, true>(wv, ldsl, WP(unsigned char, O_X1Q), D_, S, E);
        }
        SEAM(pb + 5);
        REPL(6) if (EN(6) && IN(pb + 6)) {
            PHASE_BEGIN;
            pg8::MoeOrder<false> S{WP(unsigned char, O_WDN) + (size_t)l_ * NE * D_ * D_, D_, 4, G, bid, (size_t)D_ * D_, tstart, cnts, WP(int, O_LIST)};
            pg8::EpiDnF8 E{WP(bf16, O_YB), INP(22) + (size_t)l_ * NE * D_};
            pg8::gemm_phase<pg8::EpiDnF8, pg8::MoeOrder<false>, true, true>(wv, ldsl, WP(unsigned char, O_ACT), D_, S, E);
        }
        SEAM(pb + 6);
        REPL(7) if (EN(7) && IN(pb + 7)) {
            PHASE_BEGIN; (void)G; (void)bid;
            ph_comb(wv, WP(bf16, O_X1B), WP(bf16, O_YB), WP(int, O_TE), WP(int, O_TS), WP(float, O_TW), INP(23) + l_ * D_, INP(24) + l_ * D_,
                    (l_ == DEPTH - 1) ? ap->out : (float*)nullptr, (l_ == DEPTH - 1) ? (bf16*)nullptr : WP(bf16, O_XB));
        }
#ifdef XTRA_BAR
#pragma unroll 1
        for (int xb_ = 0; xb_ < XTRA_BAR; ++xb_) SEAM(pb + 7);
#endif
        if (l + 1 < DEPTH) SEAM(pb + 7);
    }
#undef IN
#undef SEAM
}
}

extern "C" void kernel_launch(void* const* d_in, const int* in_sizes, int n_in, void* d_out, int out_size, void* d_ws, size_t ws_size, hipStream_t stream) {
    using namespace mk;
    static int grid = 0;
    if (grid == 0) {
        size_t need = WS_NEED;
        if (n_in != 25 || need > ws_size) { fprintf(stderr, "kernel_launch: bad args n_in %d need %zu ws %zu\n", n_in, need, ws_size); grid = -1; return; }
        int dev = 0, cus = 0, per_cu = 0;
        if (hipGetDevice(&dev) != hipSuccess || hipDeviceGetAttribute(&cus, hipDeviceAttributeMultiprocessorCount, dev) != hipSuccess) { grid = -1; return; }
        if (hipFuncSetAttribute((const void*)mega, hipFuncAttributeMaxDynamicSharedMemorySize, LDS_BYTES) != hipSuccess) { fprintf(stderr, "hipFuncSetAttribute failed\n"); grid = -1; return; }
        if (hipOccupancyMaxActiveBlocksPerMultiprocessor(&per_cu, (const void*)mega, NTHR, LDS_BYTES) != hipSuccess || per_cu < 1) fprintf(stderr, "occupancy query: %d\n", per_cu);
        (void)hipGetLastError();
        grid = cus;
    }
    if (grid < 0) return;
    if (hipMemsetAsync(d_ws, 0, CTL_BYTES, stream) != hipSuccess) return;
    Args a{};
    for (int i = 0; i < 25; ++i) a.in[i] = (const float*)d_in[i];
    a.out = (float*)d_out; a.ws = (unsigned char*)d_ws; a.ph_lo = 0; a.ph_hi = 1 + DEPTH * NPH;
    hipLaunchKernelGGL(mega, dim3(grid), dim3(NTHR), LDS_BYTES, stream, a);
}
```

```cpp
#include <hip/hip_runtime.h>
#include <cstdio>
#include <cstdint>
#include <cmath>

__device__ __forceinline__ int mk_tid(int wv) { int lane; asm volatile("v_mbcnt_lo_u32_b32 %0, -1, 0\n\tv_mbcnt_hi_u32_b32 %0, -1, %0" : "=v"(lane)); return (wv << 6) | lane; }
#define XB_TMO      128
#define XB_XCNT(j)  (256  + 64 * (j))
#define XB_XSUB(j)  (1280 + 64 * (j))
#define XB_XGEN(j)  (2304 + 64 * (j))
#define XB_TOP      3328
#define XB_TOPGEN   3392
#define XCD_BAR_WORDS 3456
#define XB_SPIN_CAP (1u << 18)
#define LAS __attribute__((address_space(3)))

__device__ __forceinline__ unsigned xb_ld(unsigned* p)              { return __hip_atomic_load(p, __ATOMIC_RELAXED, __HIP_MEMORY_SCOPE_AGENT); }
__device__ __forceinline__ unsigned xb_add(unsigned* p, unsigned v) { return __hip_atomic_fetch_add(p, v, __ATOMIC_RELAXED, __HIP_MEMORY_SCOPE_AGENT); }
__device__ __forceinline__ unsigned xb_xcc_id() { return (unsigned)__builtin_amdgcn_s_getreg((3 << 11) | 20) & 0xFu; }
#define XB_SPIN(cond, bar) do { unsigned _sp = 0; while (cond) { __builtin_amdgcn_s_sleep(1); \
    if ((++_sp & 255u) == 0u) { if (xb_ld(&(bar)[XB_TMO])) break; if (_sp > XB_SPIN_CAP) { atomicAdd(&(bar)[XB_TMO], 1u); break; } } } } while (0)

struct XcdBarrier {
    unsigned* bar; unsigned x;
    volatile LAS unsigned* st; int wv;
};

__device__ __forceinline__ XcdBarrier xcd_barrier_post(unsigned* bar, volatile LAS unsigned* st, int wv) {
    XcdBarrier b; b.bar = bar; b.x = xb_xcc_id(); b.st = st; b.wv = wv;
    if (mk_tid(b.wv) == 0) (void)xb_add(&bar[XB_XCNT(b.x)], 1u);
    return b;
}
__device__ __forceinline__ void xcd_barrier_complete(unsigned* bar, unsigned x, unsigned& nloc, unsigned& nx) {
    const unsigned G = gridDim.x * gridDim.y * gridDim.z;
    unsigned sum, cnt, mine, sp = 0u;
    for (;;) {
        sum = 0u; cnt = 0u; mine = 0u;
#pragma unroll
        for (unsigned j = 0; j < 16; ++j) { const unsigned c = xb_ld(&bar[XB_XCNT(j)]); sum += c; cnt += (c > 0u) ? 1u : 0u; mine = (j == x) ? c : mine; }
        if (sum == G) break;
        __builtin_amdgcn_s_sleep(1);
        if ((++sp & 255u) == 0u) { if (xb_ld(&bar[XB_TMO])) break; if (sp > XB_SPIN_CAP) { atomicAdd(&bar[XB_TMO], 1u); break; } }
    }
    nloc = mine > 0u ? mine : 1u; nx = cnt > 0u ? cnt : 1u;
}

template <bool FIRST>
__device__ __forceinline__ void xcd_barrier_t(const XcdBarrier& b) {
    asm volatile("s_waitcnt vmcnt(0)" ::: "memory");
    __syncthreads();
    if (mk_tid(b.wv) == 0) {
        unsigned* bar = b.bar; unsigned bx = b.x; asm volatile("" : "+s"(bar), "+s"(bx));
        __builtin_amdgcn_s_waitcnt(0);
        unsigned nloc = b.st[0], nx = b.st[1];
        if (FIRST) { if (nloc == 0u) { xcd_barrier_complete(bar, bx, nloc, nx); b.st[0] = nloc; b.st[1] = nx; } }
        const unsigned old = xb_add(&bar[XB_XSUB(bx)], 1u);
        const unsigned gen = old / nloc;
        if (old + 1u == (gen + 1u) * nloc) {
            __builtin_amdgcn_fence(__ATOMIC_RELEASE, "agent");
            asm volatile("s_waitcnt vmcnt(0)" ::: "memory");
            const unsigned og = xb_add(&bar[XB_TOP], 1u);
            const unsigned tg = og / nx;
            if (og + 1u == (tg + 1u) * nx) xb_add(&bar[XB_TOPGEN], 1u);
            else XB_SPIN(xb_ld(&bar[XB_TOPGEN]) == tg, bar);
            __builtin_amdgcn_fence(__ATOMIC_ACQUIRE, "agent");
            xb_add(&bar[XB_XGEN(bx)], 1u);
            asm volatile("s_waitcnt vmcnt(0)" ::: "memory");
        } else {
            XB_SPIN(xb_ld(&bar[XB_XGEN(bx)]) == gen, bar);
            __builtin_amdgcn_fence(__ATOMIC_ACQUIRE, "agent");
            asm volatile("s_waitcnt vmcnt(0)" ::: "memory");
        }
    }
    __syncthreads();
}


__device__ __forceinline__ void xcd_barrier_first(const XcdBarrier& b) { xcd_barrier_t<true>(b); }
__device__ __forceinline__ void xcd_barrier(const XcdBarrier& b) { xcd_barrier_t<false>(b); }


namespace mk {
constexpr int B_ = 8, S_ = 4096, D_ = 1024, NT = B_ * S_, DEPTH = 2;
constexpr int INW = 2840, HS = 3072;
constexpr int C_HGQ = 0, C_HGF = 256, C_HGI = 512, C_HGG = 768, C_GMU = 1024, C_GMV = 1280, C_NQ = 1536,
              C_KC = 2048, C_VC = 2176, C_KS = 2304, C_VS = 2432, C_KW = 2560, C_VW = 2688, C_NG = 2816;
constexpr int NCMP = 255, NE = 32, TOPK = 4, NASSIGN = NT * TOPK;
constexpr float ALPHA = 1.4142135623730951f;
constexpr int NTHR = 512, LDS_BYTES = 147456, MISC_OFF = 144 * 1024 - 256;
constexpr int NPH = 8;

typedef unsigned short bf16;
__device__ __forceinline__ float bf2f(bf16 v) { return __uint_as_float((unsigned)v << 16); }
__device__ __forceinline__ unsigned f2bf(float f) { unsigned u = __float_as_uint(f); return (u + 0x7fffu + ((u >> 16) & 1u)) >> 16; }
__device__ __forceinline__ unsigned pk2(float lo, float hi) { return f2bf(lo) | (f2bf(hi) << 16); }
__device__ __forceinline__ float gelu_t(float x) { return 0.5f * x * (1.0f + tanhf(0.7978845608028654f * (x + 0.044715f * x * x * x))); }
__device__ __forceinline__ float sigm(float x) { return 1.0f / (1.0f + expf(-x)); }
__device__ __forceinline__ float wsum(float v) {
#pragma unroll
    for (int o = 1; o < 64; o <<= 1) v += __shfl_xor(v, o);
    return v;
}
__device__ __forceinline__ float wmax(float v) {
#pragma unroll
    for (int o = 1; o < 64; o <<= 1) v = fmaxf(v, __shfl_xor(v, o));
    return v;
}

constexpr int MROWS = NASSIGN + NE * 256;
constexpr size_t CTL_BYTES = 65536;
constexpr size_t al256(size_t x) { return (x + 255) & ~(size_t)255; }
constexpr size_t O_COS = CTL_BYTES, O_SIN = O_COS + al256((size_t)NT * 32 * 4), O_LB = O_SIN + al256((size_t)NT * 32 * 4);
constexpr size_t O_WIN = O_LB + al256(512 * 4), O_WOUT = O_WIN + al256((size_t)DEPTH * HS * D_ * 2), O_WUP = O_WOUT + al256((size_t)DEPTH * D_ * D_ * 2);
constexpr size_t O_WDN = O_WUP + al256((size_t)DEPTH * NE * 2048 * D_ * 2), O_XB = O_WDN + al256((size_t)DEPTH * NE * D_ * D_ * 2);
constexpr size_t O_HB = O_XB + al256((size_t)NT * D_ * 2), O_YCAT = O_HB + al256((size_t)NT * HS * 2), O_MIXB = O_YCAT + al256((size_t)NT * D_ * 2);
constexpr size_t O_X1B = O_MIXB + al256((size_t)NT * D_ * 2), O_ACT = O_X1B + al256((size_t)NT * D_ * 2), O_YB = O_ACT + al256((size_t)MROWS * D_ * 2);
constexpr size_t O_X1Q = O_YB + al256((size_t)MROWS * D_ * 2), O_XA = O_X1Q + al256((size_t)NT * D_ * 4);
constexpr size_t O_VLNT = O_XA + al256((size_t)NT * D_ * 4), O_WB = O_VLNT + al256((size_t)NT * 256 * 2), O_W1T = O_WB + al256((size_t)DEPTH * 4 * 128 * 128 * 2);
constexpr size_t O_CBIAS = O_W1T + al256((size_t)DEPTH * 2 * 128 * 2048 * 2), O_W2T = O_CBIAS + al256((size_t)DEPTH * 2 * 128 * 4), O_RWH = O_W2T + al256((size_t)DEPTH * 2 * 64 * 128 * 2), O_RWL = O_RWH + al256((size_t)DEPTH * NE * D_ * 2), O_HQT = O_RWL + al256((size_t)DEPTH * NE * D_ * 2);
constexpr size_t HGB = (size_t)2048 * 4096 * 2;
constexpr size_t O_HKT = O_HQT + HGB, O_HQP = O_HKT + HGB, O_HVT = O_HQP + HGB, O_HST = O_HVT + HGB, O_HUT = O_HST + HGB, O_HDK = O_HUT + 2 * HGB;
constexpr size_t O_KSB = O_HDK + al256((size_t)2048 * 64 * 4), O_VSB = O_KSB + al256((size_t)NT * 128 * 2);
constexpr size_t O_KWB = O_VSB + al256((size_t)NT * 128 * 2), O_VWB = O_KWB + al256((size_t)NT * 128 * 2), O_KCB = O_VWB + al256((size_t)NT * 128 * 2), O_VCB = O_KCB + al256((size_t)B_ * 2 * 256 * 64 * 2);
constexpr size_t O_LIST = O_VCB + al256((size_t)B_ * 2 * 256 * 64 * 2), O_TE = O_LIST + al256((size_t)NE * NT * 4), O_TS = O_TE + al256((size_t)NASSIGN * 4), O_TW = O_TS + al256((size_t)NASSIGN * 4);
constexpr size_t WS_NEED = O_TW + al256((size_t)NASSIGN * 4);
namespace pg8 {
#define PG8_LAS __attribute__((address_space(3)))
typedef unsigned short bf16_t;
typedef short bf16x8 __attribute__((ext_vector_type(8)));
typedef float f32x4 __attribute__((ext_vector_type(4)));
typedef float f32x2 __attribute__((ext_vector_type(2)));
typedef unsigned u32x4 __attribute__((ext_vector_type(4)));
constexpr int BM = 256, BK = 64, HALF = 128, HTB = HALF * BK * 2  , STAGE_BYTES = 8 * HTB, NXCD = 8, WGM = 8;

__host__ __device__ __forceinline__ int lds_byte(int r, int c) { const int st = (r >> 4) * 2 + (c >> 5), rr = r & 15, cc = c & 31, ob = rr * 64 + cc * 2; return st * 1024 + (ob ^ (((ob >> 9) & 1) << 5)); }
__host__ __device__ __forceinline__ void stage_rc(int b, int& R, int& C) { const int st = b / 1024, sb = b % 1024, swz = sb ^ (((sb >> 9) & 1) << 5); R = (st >> 1) * 16 + swz / 64; C = (st & 1) * 32 + (swz % 64) / 2; }
__host__ __device__ __forceinline__ int perm32(int rho) { const int n = rho >> 4, i = rho & 15; return 8 * (i >> 2) + 4 * n + (i & 3); }

struct Unit { int pm, pn, e, mt, cnt; };

__device__ __forceinline__ void deal(int L, int nM, int nN, int& pm, int& pn) {
    const int nwg = nM * nN;
    int wgid = L; { const int q = nwg / NXCD, r = nwg % NXCD, xcd = wgid % NXCD, off = wgid / NXCD; wgid = (xcd < r ? xcd * (q + 1) : r * (q + 1) + (xcd - r) * q) + off; }
    const int nig = WGM * nN, gid = wgid / nig, fm = gid * WGM, gsz = (nM - fm) < WGM ? (nM - fm) : WGM;
    pm = fm + ((wgid % nig) % gsz); pn = (wgid % nig) / gsz;
}
struct PlainOrder {
    static constexpr bool GATHERED = false;
    const bf16_t* Bt; int K; int nM, nN, G, c;
    __device__ __forceinline__ bool next(int i, Unit& u) const { const long L = (long)i * G + c; if (L >= (long)nM * nN) return false; deal((int)L, nM, nN, u.pm, u.pn); u.e = 0; u.mt = 0; u.cnt = 0; return true; }
    __device__ __forceinline__ unsigned a_row(const Unit& u, int r) const { return (unsigned)(u.pm * BM + r); }
    __device__ __forceinline__ const char* b_base(const Unit& u) const { return (const char*)Bt + (size_t)u.pn * BM * K * 2; }
};
template <bool GATHER> struct MoeOrder {
    static constexpr bool GATHERED = GATHER;
    const void* Bt; int rowb; int nN, G, c; size_t estrideb;
    const int* tstart; const int* cnts; const int* list;
    __device__ __forceinline__ bool next(int i, Unit& u) const {
        const int nM = tstart[32]; const long L = (long)i * G + c; if (L >= (long)nM * nN) return false;
        deal((int)L, nM, nN, u.pm, u.pn);
        const int ln = (int)__builtin_amdgcn_mbcnt_hi(~0u, __builtin_amdgcn_mbcnt_lo(~0u, 0u));
        const int ts = tstart[ln & 31];
        const int e = __popcll(__ballot(ln < 32 && ts <= u.pm)) - 1;
        u.e = e; u.mt = u.pm - tstart[e]; u.cnt = cnts[e]; return true;
    }
    __device__ __forceinline__ unsigned a_row(const Unit& u, int r) const {
        if (GATHER) { const int slot = u.mt * BM + r; return (unsigned)list[u.e * 32768 + (slot < u.cnt ? slot : u.cnt - 1)]; }
        return (unsigned)(u.pm * BM + r);
    }
    __device__ __forceinline__ const char* b_base(const Unit& u) const { return (const char*)Bt + (size_t)u.e * estrideb + (size_t)u.pn * BM * rowb; }
};

__device__ __forceinline__ unsigned cvt_pk_bf16(float lo, float hi) { unsigned r; asm volatile("v_cvt_pk_bf16_f32 %0, %1, %2" : "=v"(r) : "v"(lo), "v"(hi)); return r; }

struct EpiBf16 {
    static constexpr bool PERM = true;
    bf16_t* O; int ldc; const float* bias; int bstride;
    __device__ __forceinline__ void operator()(const f32x4 (&acc)[2][2][4][2], const Unit& u, int wr, int wc, int fr, int fq) const {
        const int row0 = u.pm * BM + wr * 64 + fr; const int col0 = u.pn * BM + wc * 32 + 8 * fq;
        f32x4 bv[2][2];
#pragma unroll
        for (int bj = 0; bj < 2; ++bj)
#pragma unroll
            for (int n = 0; n < 2; ++n) bv[bj][n] = bias ? *(const f32x4*)(bias + (size_t)u.e * bstride + col0 + bj * HALF + 4 * n) : (f32x4){0.f, 0.f, 0.f, 0.f};
#pragma unroll
        for (int ai = 0; ai < 2; ++ai)
#pragma unroll
            for (int m = 0; m < 4; ++m) { bf16_t* rowp = O + (size_t)(row0 + ai * HALF + m * 16) * ldc + col0;
#pragma unroll
                for (int bj = 0; bj < 2; ++bj) { f32x4 v0 = acc[ai][bj][m][0] + bv[bj][0], v1 = acc[ai][bj][m][1] + bv[bj][1];
                    u32x4 w; w.x = cvt_pk_bf16(v0[0], v0[1]); w.y = cvt_pk_bf16(v0[2], v0[3]); w.z = cvt_pk_bf16(v1[0], v1[1]); w.w = cvt_pk_bf16(v1[2], v1[3]);
                    *(u32x4*)(rowp + bj * HALF) = w; } }
    }
};
__device__ __forceinline__ float swiglu1(float g, float l) {
    g = fminf(g, 7.0f); l = fminf(fmaxf(l, -7.0f), 7.0f);
    const float s = __builtin_amdgcn_rcpf(1.0f + __builtin_amdgcn_exp2f(-1.702f * 1.4426950408889634f * g));
    return g * s * (l + 1.0f);
}
struct EpiUp {
    static constexpr bool PERM = true;
    bf16_t* O; const float* bias;
    __device__ __forceinline__ void operator()(const f32x4 (&acc)[2][2][4][2], const Unit& u, int wr, int wc, int fr, int fq) const {
        const int row0 = u.pm * BM + wr * 64 + fr; const int j0 = u.pn * HALF + wc * 32 + 8 * fq;
        const float* bp = bias + (size_t)u.e * 2048 + j0;
        f32x4 bg[2], bl[2];
#pragma unroll
        for (int n = 0; n < 2; ++n) { bg[n] = *(const f32x4*)(bp + 4 * n); bl[n] = *(const f32x4*)(bp + 1024 + 4 * n); }
#pragma unroll
        for (int ai = 0; ai < 2; ++ai)
#pragma unroll
            for (int m = 0; m < 4; ++m) {
                float o[8];
#pragma unroll
                for (int n = 0; n < 2; ++n) { const f32x4 g = acc[ai][0][m][n] + bg[n], l = acc[ai][1][m][n] + bl[n];
#pragma unroll
                    for (int j = 0; j < 4; ++j) o[4 * n + j] = swiglu1(g[j], l[j]); }
                u32x4 w; w.x = cvt_pk_bf16(o[0], o[1]); w.y = cvt_pk_bf16(o[2], o[3]); w.z = cvt_pk_bf16(o[4], o[5]); w.w = cvt_pk_bf16(o[6], o[7]);
                *(u32x4*)(O + (size_t)(row0 + ai * HALF + m * 16) * 1024 + j0) = w; }
    }
};

constexpr float F8_SU = 64.0f, F8_SA = 4.0f, F8_SD = 128.0f;
__device__ __forceinline__ unsigned pk4_fp8(float a, float b, float c, float d) {
    a = fminf(fmaxf(a, -448.f), 448.f); b = fminf(fmaxf(b, -448.f), 448.f); c = fminf(fmaxf(c, -448.f), 448.f); d = fminf(fmaxf(d, -448.f), 448.f);
    int p = __builtin_amdgcn_cvt_pk_fp8_f32(a, b, 0, false); p = __builtin_amdgcn_cvt_pk_fp8_f32(c, d, p, true); return (unsigned)p;
}
struct EpiUpF8 {
    static constexpr bool PERM = true;
    unsigned char* O; const float* bias;
    __device__ __forceinline__ void operator()(const f32x4 (&acc)[2][2][4][2], const Unit& u, int wr, int wc, int fr, int fq) const {
        const int row0 = u.pm * BM + wr * 64 + fr; const int j0 = u.pn * HALF + wc * 32 + 8 * fq;
        const float* bp = bias + (size_t)u.e * 2048 + j0;
        f32x4 bg[2], bl[2];
#pragma unroll
        for (int n = 0; n < 2; ++n) { bg[n] = *(const f32x4*)(bp + 4 * n); bl[n] = *(const f32x4*)(bp + 1024 + 4 * n); }
        const int odd = fq & 1;
        unsigned char* obase = O + (size_t)(row0 + 16 * odd) * 1024 + j0 - 8 * odd;
#pragma unroll
        for (int ai = 0; ai < 2; ++ai)
#pragma unroll
            for (int mp = 0; mp < 2; ++mp) {
                unsigned w[2][2];
#pragma unroll
                for (int mm = 0; mm < 2; ++mm)
#pragma unroll
                    for (int n = 0; n < 2; ++n) { const int m = 2 * mp + mm; const f32x4 g = acc[ai][0][m][n] * (1.0f / F8_SU) + bg[n], l = acc[ai][1][m][n] * (1.0f / F8_SU) + bl[n];
                        w[mm][n] = pk4_fp8(F8_SA * swiglu1(g[0], l[0]), F8_SA * swiglu1(g[1], l[1]), F8_SA * swiglu1(g[2], l[2]), F8_SA * swiglu1(g[3], l[3])); }
                const auto r0 = __builtin_amdgcn_permlane16_swap(w[0][0], w[1][0], false, false);
                const auto r1 = __builtin_amdgcn_permlane16_swap(w[0][1], w[1][1], false, false);
                u32x4 ww = {r0[0], r1[0], r0[1], r1[1]};
                *(u32x4*)(obase + (size_t)(ai * HALF + mp * 32) * 1024) = ww; }
    }
};
struct EpiDnF8 {
    static constexpr bool PERM = true;
    bf16_t* O; const float* bias;
    __device__ __forceinline__ void operator()(const f32x4 (&acc)[2][2][4][2], const Unit& u, int wr, int wc, int fr, int fq) const {
        const int row0 = u.pm * BM + wr * 64 + fr; const int col0 = u.pn * BM + wc * 32 + 8 * fq;
        f32x4 bv[2][2];
#pragma unroll
        for (int bj = 0; bj < 2; ++bj)
#pragma unroll
            for (int n = 0; n < 2; ++n) bv[bj][n] = *(const f32x4*)(bias + (size_t)u.e * 1024 + col0 + bj * HALF + 4 * n);
#pragma unroll
        for (int ai = 0; ai < 2; ++ai)
#pragma unroll
            for (int m = 0; m < 4; ++m) { bf16_t* rowp = O + (size_t)(row0 + ai * HALF + m * 16) * 1024 + col0;
#pragma unroll
                for (int bj = 0; bj < 2; ++bj) { f32x4 v0 = acc[ai][bj][m][0] * (1.0f / (F8_SA * F8_SD)) + bv[bj][0], v1 = acc[ai][bj][m][1] * (1.0f / (F8_SA * F8_SD)) + bv[bj][1];
                    u32x4 w; w.x = cvt_pk_bf16(v0[0], v0[1]); w.y = cvt_pk_bf16(v0[2], v0[3]); w.z = cvt_pk_bf16(v1[0], v1[1]); w.w = cvt_pk_bf16(v1[2], v1[3]);
                    *(u32x4*)(rowp + bj * HALF) = w; } }
    }
};

typedef int v8i32 __attribute__((ext_vector_type(8)));
__device__ __forceinline__ v8i32 pg8_join(const bf16x8 lo, const bf16x8 hi) { typedef int v4i32 __attribute__((ext_vector_type(4)));
    const v4i32 a = __builtin_bit_cast(v4i32, lo), b = __builtin_bit_cast(v4i32, hi); return __builtin_shufflevector(a, b, 0, 1, 2, 3, 4, 5, 6, 7); }
template <class Epi, class Sched, bool ALIGN_EPI, bool F8 = false>
__device__ __forceinline__ void gemm_phase(const int wv, PG8_LAS unsigned char* lds, const void* Abase, const int Kb  , const Sched& S, const Epi& E) {
    int tid = mk_tid(wv); asm volatile("" : "+v"(tid));
    const int wid = __builtin_amdgcn_readfirstlane(tid >> 6), lane = tid & 63, wr = wid >> 2, wc = wid & 3, fr = lane & 15, fq = lane >> 4;
#ifdef DUP_K
    const int nt0 = Kb / 128, nt = 2 * nt0;
#define PG8_KT(t) ((t) % nt0)
#else
    const int nt = Kb / 128;
#define PG8_KT(t) (t)
#endif
    const char* Ab = (const char*)Abase;
    unsigned voffB[2];
#pragma unroll
    for (int i = 0; i < 2; ++i) { int R, C; stage_rc(tid * 16 + i * 8192, R, C); const int Rb = Epi::PERM ? ((R & ~31) + perm32(R & 31)) : R;
        voffB[i] = (unsigned)(Rb * Kb + C * 2); }
    const size_t kstep = (size_t)(BK * 2);
    const size_t hstep = (size_t)HALF * Kb;
    const unsigned rowb = (unsigned)Kb;
    const unsigned ldsw = (unsigned)wid * 1024u;
    const int aoff = lds_byte(wr * 64 + fr, fq * 8), boff = lds_byte(wc * 32 + fr, fq * 8);
#define PG8_SA(b, h) (((b) * 2 + (h)) * HTB)
#define PG8_SB(b, h) ((4 + (b) * 2 + (h)) * HTB)
#define PG8_STAGE(bufoff, gbase, voff) do { _Pragma("unroll") for (int _i = 0; _i < 2; ++_i) { unsigned _v = (voff)[_i]; asm volatile("" : "+v"(_v)); \
        __builtin_amdgcn_global_load_lds((const unsigned*)((const char*)(gbase) + _v), (PG8_LAS unsigned*)(lds + (bufoff) + ldsw + _i * 8192), 16, 0, 0); } } while (0)
#define PG8_STAGE_A(bufoff, kb, o0, o1) do { unsigned _o0 = (o0), _o1 = (o1); asm volatile("" : "+v"(_o0), "+v"(_o1)); \
        __builtin_amdgcn_global_load_lds((const unsigned*)(Ab + (kb) + _o0), (PG8_LAS unsigned*)(lds + (bufoff) + ldsw), 16, 0, 0); \
        __builtin_amdgcn_global_load_lds((const unsigned*)(Ab + (kb) + _o1), (PG8_LAS unsigned*)(lds + (bufoff) + ldsw + 8192), 16, 0, 0); } while (0)
#define PG8_LDA(dst, b, h) do { if constexpr (F8) { _Pragma("unroll") for (int m = 0; m < 4; ++m) dst##8[m] = pg8_join(*(const PG8_LAS bf16x8*)(lds + PG8_SA(b, h) + aoff + m * 2048), *(const PG8_LAS bf16x8*)(lds + PG8_SA(b, h) + aoff + m * 2048 + 1024)); } \
        else { _Pragma("unroll") for (int m = 0; m < 4; ++m) _Pragma("unroll") for (int k = 0; k < 2; ++k) dst[m][k] = *(const PG8_LAS bf16x8*)(lds + PG8_SA(b, h) + aoff + m * 2048 + k * 1024); } } while (0)
#define PG8_LDB(dst, b, h) do { if constexpr (F8) { _Pragma("unroll") for (int n = 0; n < 2; ++n) dst##8[n] = pg8_join(*(const PG8_LAS bf16x8*)(lds + PG8_SB(b, h) + boff + n * 2048), *(const PG8_LAS bf16x8*)(lds + PG8_SB(b, h) + boff + n * 2048 + 1024)); } \
        else { _Pragma("unroll") for (int n = 0; n < 2; ++n) _Pragma("unroll") for (int k = 0; k < 2; ++k) dst[n][k] = *(const PG8_LAS bf16x8*)(lds + PG8_SB(b, h) + boff + n * 2048 + k * 1024); } } while (0)
#define PG8_MMA(ai, bj, At, Bt) do { __builtin_amdgcn_s_setprio(1); _Pragma("unroll") for (int m = 0; m < 4; ++m) _Pragma("unroll") for (int n = 0; n < 2; ++n) { \
        if constexpr (F8) { acc[ai][bj][m][n] = __builtin_amdgcn_mfma_scale_f32_16x16x128_f8f6f4(Bt##8[n], At##8[m], acc[ai][bj][m][n], 0, 0, 0, 0, 0, 0); } \
        else { _Pragma("unroll") for (int k = 0; k < 2; ++k) acc[ai][bj][m][n] = __builtin_amdgcn_mfma_f32_16x16x32_bf16(Bt[n][k], At[m][k], acc[ai][bj][m][n], 0, 0, 0); } } \
        __builtin_amdgcn_s_setprio(0); } while (0)
#define PG8_WAIT_V(n) asm volatile("s_waitcnt vmcnt(" #n ")" ::: "memory")
#define PG8_WAIT_L(n) asm volatile("s_waitcnt lgkmcnt(" #n ")" ::: "memory")
#define PG8_BAR __builtin_amdgcn_s_barrier()
#define PG8_SCHED __builtin_amdgcn_sched_barrier(0)
#define PG8_AOFFS(dst, u) do { int _t = mk_tid(wv); asm volatile("" : "+v"(_t)); _Pragma("unroll") for (int _i = 0; _i < 2; ++_i) { int _R, _C; stage_rc(_t * 16 + _i * 8192, _R, _C); \
        _Pragma("unroll") for (int _h = 0; _h < 2; ++_h) dst[_h][_i] = S.a_row(u, _h * HALF + _R) * rowb + (unsigned)_C * 2u; } } while (0)
    Unit cur, nxt; int ui = 0;
    if (!S.next(0, cur)) return;
    f32x4 acc[2][2][4][2];
#pragma unroll
    for (int a = 0; a < 2; ++a)
#pragma unroll
        for (int b = 0; b < 2; ++b)
#pragma unroll
            for (int m = 0; m < 4; ++m)
#pragma unroll
                for (int n = 0; n < 2; ++n) acc[a][b][m][n] = (f32x4){0.f, 0.f, 0.f, 0.f};
    bf16x8 At[4][2], B0[2][2], B1[2][2];
    v8i32 At8[4], B08[2], B18[2];
    unsigned aC[2][2], aN[2][2];
    PG8_AOFFS(aC, cur);
    const char* cB = S.b_base(cur);
    PG8_STAGE(PG8_SB(0, 0), cB, voffB); PG8_STAGE(PG8_SB(0, 1), cB + hstep, voffB); PG8_STAGE_A(PG8_SA(0, 0), 0, aC[0][0], aC[0][1]); PG8_STAGE_A(PG8_SA(0, 1), 0, aC[1][0], aC[1][1]);
    if (wr == 1) PG8_BAR;
    PG8_WAIT_V(2); PG8_BAR;
    PG8_STAGE(PG8_SB(1, 0), cB + kstep, voffB); PG8_STAGE_A(PG8_SA(1, 0), kstep, aC[0][0], aC[0][1]); PG8_STAGE(PG8_SB(1, 1), cB + hstep + kstep, voffB);
    PG8_WAIT_V(6); PG8_BAR;
    for (;;) {
        const bool has_next = S.next(ui + 1, nxt);
        const char* nB = has_next ? S.b_base(nxt) : cB;
        if (has_next) { PG8_AOFFS(aN, nxt); }
        else {
#pragma unroll
            for (int _h = 0; _h < 2; ++_h)
#pragma unroll
                for (int _i = 0; _i < 2; ++_i) aN[_h][_i] = aC[_h][_i]; }
#pragma unroll 1
        for (int t = 0; t < nt; t += 2) {
            const bool last = (t == nt - 2);
            const size_t kb1 = (size_t)PG8_KT(t + 1) * kstep;
            PG8_LDB(B0, 0, 0); PG8_LDB(B1, 0, 1); PG8_SCHED; PG8_LDA(At, 0, 0); PG8_STAGE_A(PG8_SA(1, 1), kb1, aC[1][0], aC[1][1]);
            PG8_WAIT_V(8); PG8_WAIT_L(0); PG8_BAR; PG8_MMA(0, 0, At, B0); PG8_MMA(0, 1, At, B1); PG8_BAR; PG8_SCHED;
            if (last) {
#pragma unroll
                for (int _h = 0; _h < 2; ++_h)
#pragma unroll
                    for (int _i = 0; _i < 2; ++_i) aC[_h][_i] = aN[_h][_i]; }
            const size_t kb2 = last ? (size_t)0 : (size_t)PG8_KT(t + 2) * kstep; const char* b2 = last ? nB : cB + (size_t)PG8_KT(t + 2) * kstep;
            const size_t kb3 = kb2 + kstep; const char* b3 = b2 + kstep;
            PG8_LDA(At, 0, 1); PG8_STAGE(PG8_SB(0, 0), b2, voffB); PG8_STAGE(PG8_SB(0, 1), b2 + hstep, voffB); PG8_STAGE_A(PG8_SA(0, 0), kb2, aC[0][0], aC[0][1]);
            PG8_WAIT_V(8); PG8_WAIT_L(0); PG8_BAR; PG8_MMA(1, 0, At, B0); PG8_MMA(1, 1, At, B1); PG8_BAR; PG8_SCHED;
            PG8_LDB(B0, 1, 0); PG8_LDB(B1, 1, 1); PG8_SCHED; PG8_LDA(At, 1, 0); PG8_STAGE_A(PG8_SA(0, 1), kb2, aC[1][0], aC[1][1]);
            PG8_WAIT_V(8); PG8_WAIT_L(0); PG8_BAR; PG8_MMA(0, 0, At, B0); PG8_MMA(0, 1, At, B1); PG8_BAR; PG8_SCHED;
            PG8_LDA(At, 1, 1); PG8_STAGE(PG8_SB(1, 0), b3, voffB); PG8_STAGE(PG8_SB(1, 1), b3 + hstep, voffB); PG8_STAGE_A(PG8_SA(1, 0), kb3, aC[0][0], aC[0][1]);
            PG8_WAIT_V(8); PG8_WAIT_L(0); PG8_BAR; PG8_MMA(1, 0, At, B0); PG8_MMA(1, 1, At, B1); PG8_BAR; PG8_SCHED;
        }
        if (ALIGN_EPI) { if (wr == 0) PG8_BAR; }
#ifdef DUP_K
#pragma unroll
        for (int a = 0; a < 2; ++a)
#pragma unroll
            for (int b = 0; b < 2; ++b)
#pragma unroll
                for (int m = 0; m < 4; ++m)
#pragma unroll
                    for (int n = 0; n < 2; ++n) acc[a][b][m][n] = acc[a][b][m][n] * 0.5f;
#endif
        E(acc, cur, wr, wc, fr, fq);
#ifdef DUP_EPI
        E(acc, cur, wr, wc, fr, fq);
#endif
        if (!has_next) break;
#pragma unroll
        for (int a = 0; a < 2; ++a)
#pragma unroll
            for (int b = 0; b < 2; ++b)
#pragma unroll
                for (int m = 0; m < 4; ++m)
#pragma unroll
                    for (int n = 0; n < 2; ++n) acc[a][b][m][n] = (f32x4){0.f, 0.f, 0.f, 0.f};
        cur = nxt; cB = nB; ++ui;
        if (ALIGN_EPI) { if (wr == 1) PG8_BAR; }
    }
    PG8_WAIT_V(0);
    if (!ALIGN_EPI) { if (wr == 0) PG8_BAR; }
    PG8_BAR;
#undef PG8_SA
#undef PG8_SB
#undef PG8_STAGE
#undef PG8_STAGE_A
#undef PG8_LDA
#undef PG8_LDB
#undef PG8_MMA
#undef PG8_WAIT_V
#undef PG8_WAIT_L
#undef PG8_BAR
#undef PG8_SCHED
#undef PG8_AOFFS
#undef PG8_KT
}
}


#ifndef NSA_REP_RANK
#define NSA_REP_RANK 1
#endif
#ifndef NSA_REP_PASSA
#define NSA_REP_PASSA 1
#endif
#ifndef NSA_REP_LOOP
#define NSA_REP_LOOP 1
#endif
namespace nsa {
#define NLAS __attribute__((address_space(3)))
typedef short bf16x8 __attribute__((ext_vector_type(8)));
typedef short s16x4 __attribute__((ext_vector_type(4)));
typedef short v4i16_t __attribute__((ext_vector_type(4)));
typedef float f32x16 __attribute__((ext_vector_type(16)));
typedef float f32x2_t __attribute__((ext_vector_type(2)));
typedef __bf16 bf16x2_t __attribute__((ext_vector_type(2)));
#define NSA_MFMA(a, b, c) __builtin_amdgcn_mfma_f32_32x32x16_bf16((a), (b), (c), 0, 0, 0)
constexpr int L_CK = 0, L_CV = 32768, L_RING = 65536, L_IMP = 0, SLOTB = 16384, L_SELM = 131072 + 1024;
constexpr float QSCALE = 0.125f * 1.4426950408889634f;
constexpr float NEGBIG = -1.0e30f;

__device__ __forceinline__ unsigned cvtpk(float lo, float hi) { f32x2_t v = {lo, hi}; bf16x2_t b = __builtin_convertvector(v, bf16x2_t); return __builtin_bit_cast(unsigned, b); }
__device__ __forceinline__ float bflo(unsigned u) { return __uint_as_float(u << 16); }
__device__ __forceinline__ float bfhi(unsigned u) { return __uint_as_float(u & 0xffff0000u); }
__device__ __forceinline__ float xhalf(float v) { return __shfl_xor(v, 32); }
__device__ __forceinline__ float xhalf_max(float v) { const auto r = __builtin_amdgcn_permlane32_swap(__float_as_uint(v), __float_as_uint(v), false, false); return fmaxf(__uint_as_float(r[0]), __uint_as_float(r[1])); }
__device__ __forceinline__ float xhalf_sum(float v) { const auto r = __builtin_amdgcn_permlane32_swap(__float_as_uint(v), __float_as_uint(v), false, false); return __uint_as_float(r[0]) + __uint_as_float(r[1]); }
__device__ __forceinline__ s16x4 vtr(const NLAS unsigned char* p) { return __builtin_bit_cast(s16x4, __builtin_amdgcn_ds_read_tr16_b64_v4i16((NLAS v4i16_t*)p)); }
__device__ __forceinline__ bf16x8 pack8(const f32x16& x, int s) {
    unsigned p0 = cvtpk(x[8 * s], x[8 * s + 1]), p1 = cvtpk(x[8 * s + 2], x[8 * s + 3]), p2 = cvtpk(x[8 * s + 4], x[8 * s + 5]), p3 = cvtpk(x[8 * s + 6], x[8 * s + 7]);
    typedef unsigned u32x4 __attribute__((ext_vector_type(4)));
    u32x4 u = {p0, p1, p2, p3}; return __builtin_bit_cast(bf16x8, u);
}

struct Params {
    const unsigned short* hb;
    const unsigned short *kcb, *vcb;
    const unsigned short *ksb, *vsb, *kwb, *vwb;
    const float *cosT, *sinT;
    const float* normw;
    unsigned short* ycat;
};

__device__ __forceinline__ void qk_tile(const NLAS unsigned char* kt, const bf16x8 (&qf)[4], const int (&kofs)[4], f32x16& st0, f32x16& st1) {
    bf16x8 k0[4], k1[4];
#pragma unroll
    for (int ks = 0; ks < 4; ++ks) { k0[ks] = *(const NLAS bf16x8*)(kt + kofs[ks]); k1[ks] = *(const NLAS bf16x8*)(kt + kofs[ks] + 4096); }
#pragma unroll
    for (int i = 0; i < 16; ++i) { st0[i] = 0.f; st1[i] = 0.f; }
#pragma unroll
    for (int ks = 0; ks < 4; ++ks) { st0 = NSA_MFMA(k0[ks], qf[ks], st0); st1 = NSA_MFMA(k1[ks], qf[ks], st1); }
}
__device__ __forceinline__ void pv_tile(const NLAS unsigned char* vt, const int (&vofs)[2][2], const f32x16& p0, const f32x16& p1, f32x16& o0, f32x16& o1) {
    bf16x8 pb[2][2];
#pragma unroll
    for (int kt = 0; kt < 2; ++kt)
#pragma unroll
        for (int s = 0; s < 2; ++s) pb[kt][s] = pack8(kt ? p1 : p0, s);
    bf16x8 va[2][2][2];
#pragma unroll
    for (int kt = 0; kt < 2; ++kt)
#pragma unroll
        for (int s = 0; s < 2; ++s) {
            const int kb = (32 * kt + 16 * s) * 128;
#pragma unroll
            for (int mb = 0; mb < 2; ++mb) {
                const s16x4 lo = vtr(vt + kb + vofs[mb][0]), hi = vtr(vt + kb + vofs[mb][1]);
                va[kt][s][mb] = __builtin_shufflevector(lo, hi, 0, 1, 2, 3, 4, 5, 6, 7);
            }
        }
#pragma unroll
    for (int kt = 0; kt < 2; ++kt)
#pragma unroll
        for (int s = 0; s < 2; ++s) { o0 = NSA_MFMA(va[kt][s][0], pb[kt][s], o0); o1 = NSA_MFMA(va[kt][s][1], pb[kt][s], o1); }
}
__device__ __forceinline__ float max3f(float a, float b, float c) { float r; asm("v_max3_f32 %0, %1, %2, %3" : "=v"(r) : "v"(a), "v"(b), "v"(c)); return r; }
constexpr float NEGINF = -__builtin_inff();
template <bool USE_LO>
__device__ __forceinline__ void mask_tile(f32x16& s0, f32x16& s1, const int hi4, const int lo4) {
#pragma unroll
    for (int i = 0; i < 16; ++i) {
        const int kk0 = (i & 3) + 8 * (i >> 2), kk1 = kk0 + 32;
        bool a0 = kk0 <= hi4, a1 = kk1 <= hi4;
        if (USE_LO) { a0 = a0 && (kk0 >= lo4); a1 = a1 && (kk1 >= lo4); }
        s0[i] = a0 ? s0[i] : NEGINF; s1[i] = a1 ? s1[i] : NEGINF;
    }
}
__device__ __forceinline__ void softmax_core(f32x16& s0, f32x16& s1, float& m, float& l, f32x16& o0, f32x16& o1, const bool live = true) {
    float mx = max3f(s0[0], s0[1], s0[2]);
#pragma unroll
    for (int i = 3; i < 15; i += 2) mx = max3f(mx, s0[i], s0[i + 1]);
    mx = max3f(mx, s0[15], s1[0]);
#pragma unroll
    for (int i = 1; i < 15; i += 2) mx = max3f(mx, s1[i], s1[i + 1]);
    mx = fmaxf(mx, s1[15]);
    mx = xhalf_max(mx);
    const float mn = fmaxf(m, mx);
    const float alpha = __builtin_amdgcn_exp2f(m - mn);
    m = mn;
    const float mref = live ? mn : __builtin_inff();
    float sum0 = 0.f, sum1 = 0.f;
#pragma unroll
    for (int i = 0; i < 16; ++i) {
        const float e0 = __builtin_amdgcn_exp2f(s0[i] - mref), e1 = __builtin_amdgcn_exp2f(s1[i] - mref);
        s0[i] = e0; s1[i] = e1; sum0 += e0; sum1 += e1;
    }
    l = l * alpha + (sum0 + sum1);
    if (__ballot(alpha != 1.0f) != 0ull) {
#pragma unroll
        for (int i = 0; i < 16; ++i) { o0[i] *= alpha; o1[i] *= alpha; }
    }
}

__device__ __forceinline__ void unit(const Params& P, NLAS unsigned char* lds, const int tid_in, const int b, const int g, const int qb) {
    int tid = tid_in; asm volatile("" : "+v"(tid));
    const int wv = __builtin_amdgcn_readfirstlane(tid >> 6), lane = tid & 63, r = lane & 31, h = lane >> 5;
    const int head = g * 4 + (wv >> 1), qi = 32 * (wv & 1) + r;
    const int t = qb * 64 + qi, tok = b * 4096 + t;
    const int bg = b * 2 + g;
    int kofs[4];
#pragma unroll
    for (int ks = 0; ks < 4; ++ks) kofs[ks] = r * 128 + ((((2 * ks + h) ^ ((r >> 1) & 7))) << 4);
    int vofs[2][2];
    { const int i16 = lane & 15, blk = (lane >> 4) & 1, q = i16 >> 2, p = i16 & 3;
#pragma unroll
      for (int mb = 0; mb < 2; ++mb)
#pragma unroll
          for (int jj = 0; jj < 2; ++jj) { const int key = 4 * h + 8 * jj + q; const int o = 4 * mb + 2 * blk + (p >> 1);
              vofs[mb][jj] = key * 128 + ((o ^ (((key >> 1) & 1) << 2)) << 4) + (p & 1) * 8; } }
    const int drow = tid >> 3, dpos = tid & 7;
    const unsigned srcK = (unsigned)(drow * 128 + ((dpos ^ ((drow >> 1) & 7)) << 4));
    const unsigned srcV = (unsigned)(drow * 128 + ((dpos ^ (((drow >> 1) & 1) << 2)) << 4));
    const unsigned wdst = (unsigned)wv * 1024u;
    const unsigned lds0 = (unsigned)(size_t)lds;
#define NSA_DMA(slotoff, gsrc, soff) do { unsigned _keep; const void* _g = (const void*)((const char*)(gsrc) + (soff)); const unsigned _d = (unsigned)__builtin_amdgcn_readfirstlane((int)(lds0 + (unsigned)(slotoff) + wdst)); \
        asm volatile("s_mov_b32 %0, m0\n\ts_mov_b32 m0, %2\n\ts_nop 0\n\tglobal_load_lds_dwordx4 %1, off\n\ts_mov_b32 m0, %0" : "=&s"(_keep) : "v"(_g), "s"(_d) : "memory"); } while (0)
    const int nsel = qb + 1, jw0 = qb >= 8 ? qb - 8 : 0, ntiles = nsel + (qb - jw0 + 1);
    const char* ksg = (const char*)P.ksb + (size_t)bg * 4096 * 128; const char* vsg = (const char*)P.vsb + (size_t)bg * 4096 * 128;
    const char* kwg = (const char*)P.kwb + (size_t)bg * 4096 * 128; const char* vwg = (const char*)P.vwb + (size_t)bg * 4096 * 128;
#define NSA_ISSUE(pos) do { const int _p = (pos) < ntiles ? (pos) : ntiles - 1; const bool _w = _p >= nsel; const int _j = _w ? jw0 + _p - nsel : _p; \
        const int _slot = L_RING + ((pos) & 3) * SLOTB; \
        NSA_DMA(_slot, (_w ? kwg : ksg) + (size_t)_j * 8192, srcK); NSA_DMA(_slot + 8192, (_w ? vwg : vsg) + (size_t)_j * 8192, srcV); } while (0)
    { const char* kcg = (const char*)P.kcb + (size_t)bg * 256 * 128; const char* vcg = (const char*)P.vcb + (size_t)bg * 256 * 128;
#pragma unroll
      for (int T = 0; T < 4; ++T) { NSA_DMA(L_CK + T * 8192, kcg + T * 8192, srcK); NSA_DMA(L_CV + T * 8192, vcg + T * 8192, srcV); } }
    NSA_ISSUE(0); NSA_ISSUE(1);
    typedef unsigned u32x4 __attribute__((ext_vector_type(4)));
    bf16x8 qf[4];
    const unsigned short* qrow = P.hb + (size_t)tok * 3072 + 1536 + (head & 7) * 64;
    {
        u32x4 qraw[4];
#pragma unroll
        for (int ks = 0; ks < 4; ++ks) qraw[ks] = *(const u32x4*)(qrow + 16 * ks + 8 * h);
#pragma unroll
        for (int ks = 0; ks < 4; ++ks) { u32x4 o;
#pragma unroll
            for (int c = 0; c < 4; ++c) o[c] = cvtpk(bflo(qraw[ks][c]) * QSCALE, bfhi(qraw[ks][c]) * QSCALE);
            qf[ks] = __builtin_bit_cast(bf16x8, o); }
    }
    float gc, gs, gw;
    { const unsigned short* gp = P.hb + (size_t)tok * 3072 + 2816 + head * 3;
      gc = 1.f / (1.f + __expf(-__uint_as_float((unsigned)gp[0] << 16))); gs = 1.f / (1.f + __expf(-__uint_as_float((unsigned)gp[1] << 16))); gw = 1.f / (1.f + __expf(-__uint_as_float((unsigned)gp[2] << 16))); }
    asm volatile("s_waitcnt vmcnt(0)" ::: "memory"); __builtin_amdgcn_s_barrier();
    const int cmax = (t >= 31) ? (((t - 31) >> 4) < 254 ? ((t - 31) >> 4) : 254) : -1;
    float m = NEGBIG, l = 0.f;
    f32x16 of0, of1;
#pragma unroll
    for (int i = 0; i < 16; ++i) { of0[i] = 0.f; of1[i] = 0.f; }
    const bool need_sel = qb >= 16;
    float ow[32];
    float carry_in = 0.f;
#pragma unroll
    for (int T = 0; T < 4; ++T) {
        f32x16 s0, s1;
        qk_tile(lds + L_CK + T * 8192, qf, kofs, s0, s1);
        if (__ballot(cmax - 64 * T < 63) != 0ull) mask_tile<false>(s0, s1, cmax - 64 * T - 4 * h, 0);
        float mx = max3f(s0[0], s0[1], s0[2]);
#pragma unroll
        for (int i = 3; i < 15; i += 2) mx = max3f(mx, s0[i], s0[i + 1]);
        mx = max3f(mx, s0[15], s1[0]);
#pragma unroll
        for (int i = 1; i < 15; i += 2) mx = max3f(mx, s1[i], s1[i + 1]);
        mx = xhalf_max(fmaxf(mx, s1[15]));
        const float mn = fmaxf(m, mx), alpha = __builtin_amdgcn_exp2f(m - mn);
        m = mn;
        if (T > 0 && __ballot(alpha != 1.0f) != 0ull) {
#pragma unroll
            for (int i = 0; i < 16; ++i) { of0[i] *= alpha; of1[i] *= alpha; }
#pragma unroll
            for (int idx = 0; idx < 8 * T; ++idx) ow[idx] *= alpha;
            carry_in *= alpha;
        }
        float sum = 0.f;
#pragma unroll
        for (int i = 0; i < 16; ++i) { s0[i] = __builtin_amdgcn_exp2f(s0[i] - mn); s1[i] = __builtin_amdgcn_exp2f(s1[i] - mn); sum += s0[i] + s1[i]; }
        l = l * alpha + sum;
#pragma unroll
        for (int kt = 0; kt < 2; ++kt)
#pragma unroll
            for (int u = 0; u < 4; ++u) {
                const float p0 = kt ? s1[4 * u] : s0[4 * u], p1 = kt ? s1[4 * u + 1] : s0[4 * u + 1], p2 = kt ? s1[4 * u + 2] : s0[4 * u + 2], p3 = kt ? s1[4 * u + 3] : s0[4 * u + 3];
                const float x = xhalf(p3);
                const float own = 2.0f * ((p0 + p1) + p2) + p3;
                ow[8 * T + 4 * kt + u] = own + (h ? x : carry_in);
                carry_in = x;
            }
        pv_tile(lds + L_CV + T * 8192, vofs, s0, s1, of0, of1);
    }
    {
        const float lc = xhalf_sum(l);
        const float rinv = lc > 0.f ? 1.0f / lc : 0.f, gr = gc * rinv;
#pragma unroll
        for (int i = 0; i < 16; ++i) { of0[i] *= gr; of1[i] *= gr; }
        if (need_sel) {
#pragma unroll
            for (int idx = 0; idx < 32; ++idx) ow[idx] *= rinv;
        }
    }
    unsigned long long selmask = (qb >= 63) ? ~0ull : ((1ull << (qb + 1)) - 1ull);
    if (need_sel) {
        __builtin_amdgcn_s_barrier();
        NLAS float* imp = (NLAS float*)(lds + L_IMP) + qi * 64;
#pragma unroll 1
        for (int hh = 0; hh < 4; ++hh) {
            if ((wv >> 1) == hh) {
                if (hh == 0) {
#pragma unroll
                    for (int idx = 0; idx < 32; ++idx) imp[(2 * idx + h + qi) & 63] = ow[idx];
                } else {
#pragma unroll
                    for (int idx = 0; idx < 32; ++idx) imp[(2 * idx + h + qi) & 63] += ow[idx];
                }
            }
            asm volatile("s_waitcnt lgkmcnt(0)" ::: "memory"); __builtin_amdgcn_s_barrier();
        }
        NLAS unsigned long long* selm = (NLAS unsigned long long*)(lds + L_SELM);
        const unsigned long long forced = 1ull | (1ull << qb) | (1ull << (qb - 1));
        const bool cand = (lane >= 1) && (lane <= qb - 2);
#pragma unroll 1
        for (int rep_ = 0; rep_ < NSA_REP_RANK; ++rep_) {
            unsigned vb[8], thr[8];
#pragma unroll
            for (int qq = 0; qq < 8; ++qq) { const int q = 8 * wv + qq; const float v = ((NLAS float*)(lds + L_IMP))[q * 64 + ((lane + q) & 63)];
                vb[qq] = cand ? __float_as_uint(v) : 0u; thr[qq] = 0u; }
#pragma unroll 1
            for (int bit = 30; bit >= 0; --bit) {
                unsigned long long bm[8];
#pragma unroll
                for (int qq = 0; qq < 8; ++qq) bm[qq] = __builtin_amdgcn_ballot_w64(vb[qq] >= (thr[qq] | (1u << bit)));
#pragma unroll
                for (int qq = 0; qq < 8; ++qq) {
                    const int cnt = __builtin_popcount((unsigned)bm[qq]) + __builtin_popcount((unsigned)(bm[qq] >> 32));
                    thr[qq] = (cnt >= 13) ? (thr[qq] | (1u << bit)) : thr[qq];
                }
            }
#pragma unroll
            for (int qq = 0; qq < 8; ++qq) {
                unsigned long long sel = __ballot(cand && vb[qq] > thr[qq]);
                unsigned long long eq = __ballot(cand && vb[qq] == thr[qq]);
                int need = 13 - __popcll(sel);
#pragma unroll 1
                for (; need > 0; --need) { const unsigned long long low = eq & (~eq + 1ull); sel |= low; eq ^= low; }
                if (lane == 0) selm[8 * wv + qq] = sel | forced;
            }
        }
        asm volatile("s_waitcnt lgkmcnt(0)" ::: "memory"); __builtin_amdgcn_s_barrier();
        selmask = selm[qi];
    }
    {
        u32x4 qraw[4];
#pragma unroll
        for (int ks = 0; ks < 4; ++ks) qraw[ks] = *(const u32x4*)(qrow + 16 * ks + 8 * h);
        const float4* cp = (const float4*)(P.cosT + (size_t)tok * 32 + 8 * h); const float4* sp = (const float4*)(P.sinT + (size_t)tok * 32 + 8 * h);
#pragma unroll
        for (int ks = 0; ks < 2; ++ks) {
            const float4 c0 = cp[4 * ks], c1 = cp[4 * ks + 1], s0 = sp[4 * ks], s1 = sp[4 * ks + 1];
            const float cs[8] = {c0.x, c0.y, c0.z, c0.w, c1.x, c1.y, c1.z, c1.w}, sn[8] = {s0.x, s0.y, s0.z, s0.w, s1.x, s1.y, s1.z, s1.w};
            u32x4 oa, ob;
#pragma unroll
            for (int c = 0; c < 4; ++c) {
                const float a0 = bflo(qraw[ks][c]), a1 = bfhi(qraw[ks][c]), b0 = bflo(qraw[ks + 2][c]), b1 = bfhi(qraw[ks + 2][c]);
                oa[c] = cvtpk((a0 * cs[2 * c] - b0 * sn[2 * c]) * QSCALE, (a1 * cs[2 * c + 1] - b1 * sn[2 * c + 1]) * QSCALE);
                ob[c] = cvtpk((b0 * cs[2 * c] + a0 * sn[2 * c]) * QSCALE, (b1 * cs[2 * c + 1] + a1 * sn[2 * c + 1]) * QSCALE);
            }
            qf[ks] = __builtin_bit_cast(bf16x8, oa); qf[ks + 2] = __builtin_bit_cast(bf16x8, ob);
        }
    }
    asm volatile("s_waitcnt vmcnt(0)" ::: "memory");
    f32x16 o0, o1;
    const bool lead = wv < 4;
    const float gs_keep = gs, gw_keep = gw;
#pragma unroll 1
    for (int repL = 0; repL < NSA_REP_LOOP; ++repL) {
    if (NSA_REP_LOOP > 1) { gs = (repL == NSA_REP_LOOP - 1) ? gs_keep : 0.f; gw = (repL == NSA_REP_LOOP - 1) ? gw_keep : 0.f;
        if (repL > 0) { asm volatile("s_waitcnt vmcnt(0)" ::: "memory"); __builtin_amdgcn_s_barrier(); NSA_ISSUE(0); NSA_ISSUE(1); asm volatile("s_waitcnt vmcnt(0)" ::: "memory"); } }
#pragma unroll
    for (int i = 0; i < 16; ++i) { o0[i] = 0.f; o1[i] = 0.f; }
    m = NEGBIG; l = 0.f;
    if (!lead) { asm volatile("s_waitcnt vmcnt(2)" ::: "memory"); __builtin_amdgcn_s_barrier(); }
#pragma unroll 1
    for (int pos = 0; pos < ntiles; ++pos) {
        if (lead) asm volatile("s_waitcnt vmcnt(2)" ::: "memory");
        __builtin_amdgcn_s_barrier();
        NSA_ISSUE(pos + 2);
        const NLAS unsigned char* slot = lds + L_RING + (pos & 3) * SLOTB;
        f32x16 s0, s1;
        const bool win = pos >= nsel; const int j = win ? jw0 + pos - nsel : pos;
        const bool live = win || ((selmask >> j) & 1ull);
        qk_tile(slot, qf, kofs, s0, s1);
        if (j == qb) mask_tile<false>(s0, s1, qi - 4 * h, 0);
        else if (win && qb >= 8 && j == qb - 8) mask_tile<true>(s0, s1, 63, qi + 1 - 4 * h);
        softmax_core(s0, s1, m, l, o0, o1, live);
        if (!lead) asm volatile("s_waitcnt vmcnt(2)" ::: "memory");
        __builtin_amdgcn_s_barrier();
        pv_tile(slot + 8192, vofs, s0, s1, o0, o1);
        if (pos == nsel - 1) {
            const float L = xhalf_sum(l); const float sc = (L > 0.f) ? gs / L : 0.f;
#pragma unroll
            for (int i = 0; i < 16; ++i) { of0[i] += sc * o0[i]; of1[i] += sc * o1[i]; o0[i] = 0.f; o1[i] = 0.f; }
            m = NEGBIG; l = 0.f;
        }
    }
    if (lead) __builtin_amdgcn_s_barrier();
    if (NSA_REP_LOOP > 1 && repL < NSA_REP_LOOP - 1) {
        const float L0 = l + xhalf(l); (void)L0; }
    if (repL == NSA_REP_LOOP - 1)    {
        float L = xhalf_sum(l);
        const float npad = (t < 511) ? (float)(511 - t) : 0.f;
        const float m2 = (npad > 0.f) ? fmaxf(m, 0.f) : m;
        const float a = __builtin_amdgcn_exp2f(m - m2);
        L = L * a + npad * __builtin_amdgcn_exp2f(-m2);
        const float sc = (L > 0.f) ? gw * a / L : 0.f;
#pragma unroll
        for (int i = 0; i < 16; ++i) { of0[i] += sc * o0[i]; of1[i] += sc * o1[i]; }
    }
    }
    float ss = 0.f;
#pragma unroll
    for (int i = 0; i < 16; ++i) ss += of0[i] * of0[i] + of1[i] * of1[i];
    ss = xhalf_sum(ss);
    const float rn = rsqrtf(ss * (1.0f / 64.0f) + 1e-6f);
    unsigned short* yrow = P.ycat + (size_t)tok * 1024 + 512 + head * 64;
    const float* nw = P.normw + head * 64;
    float4 w4a[2][4];
#pragma unroll
    for (int mb = 0; mb < 2; ++mb)
#pragma unroll
        for (int u = 0; u < 4; ++u) w4a[mb][u] = *(const float4*)(nw + 32 * mb + 8 * u + 4 * h);
#pragma unroll
    for (int mb = 0; mb < 2; ++mb)
#pragma unroll
        for (int u = 0; u < 4; ++u) {
            const int d0 = 32 * mb + 8 * u + 4 * h;
            const float4 w4 = w4a[mb][u];
            const float v0 = (mb ? of1[4 * u] : of0[4 * u]) * rn * w4.x, v1 = (mb ? of1[4 * u + 1] : of0[4 * u + 1]) * rn * w4.y;
            const float v2 = (mb ? of1[4 * u + 2] : of0[4 * u + 2]) * rn * w4.z, v3 = (mb ? of1[4 * u + 3] : of0[4 * u + 3]) * rn * w4.w;
            *(uint2*)(yrow + d0) = make_uint2(cvtpk(v0, v1), cvtpk(v2, v3));
        }
    asm volatile("s_waitcnt vmcnt(0)" ::: "memory"); __builtin_amdgcn_s_barrier();
#undef NSA_DMA
#undef NSA_ISSUE
}
__device__ __forceinline__ void phase(const Params& P, NLAS unsigned char* lds, const int tid, const int bid, const int G) {
#pragma unroll 1
    for (int vw = bid; vw < 256; vw += G) {
        const int xcd = vw & 7, slot = vw >> 3, bg = xcd * 2 + (slot >> 4), rr = slot & 15;
#pragma unroll 1
        for (int k = 0; k < 4; ++k) { const int qb = (k == 0) ? 63 - rr : (k == 1) ? 32 + rr : (k == 2) ? 31 - rr : rr; unit(P, lds, tid, bg >> 1, bg & 1, qb); }
    }
}
}


namespace wt {
typedef short bf16x8 __attribute__((ext_vector_type(8)));
typedef float f32x16 __attribute__((ext_vector_type(16)));
typedef unsigned u32x4 __attribute__((ext_vector_type(4)));
typedef unsigned u32x2 __attribute__((ext_vector_type(2)));
typedef float f32x2_t __attribute__((ext_vector_type(2)));
typedef __bf16 bf16x2_t __attribute__((ext_vector_type(2)));
#define WT_MFMA(a, b, c) __builtin_amdgcn_mfma_f32_32x32x16_bf16((a), (b), (c), 0, 0, 0)
__device__ __forceinline__ unsigned cvtpk(float lo, float hi) { f32x2_t v = {lo, hi}; bf16x2_t b = __builtin_convertvector(v, bf16x2_t); return __builtin_bit_cast(unsigned, b); }
__device__ __forceinline__ float bflo(unsigned u) { return __uint_as_float(u << 16); }
__device__ __forceinline__ float bfhi(unsigned u) { return __uint_as_float(u & 0xffff0000u); }
__device__ __forceinline__ float xhalf(float v) { return __shfl_xor(v, 32); }
__device__ __forceinline__ float xhalf_sum(float v) { const auto r = __builtin_amdgcn_permlane32_swap(__float_as_uint(v), __float_as_uint(v), false, false); return __uint_as_float(r[0]) + __uint_as_float(r[1]); }
__device__ __forceinline__ bf16x8 ld16(const unsigned short* p) { return __builtin_bit_cast(bf16x8, *(const u32x4*)p); }
__device__ __forceinline__ bf16x8 ld8x2(const unsigned short* p0, const unsigned short* p1) { const u32x2 a = *(const u32x2*)p0, b = *(const u32x2*)p1; u32x4 u = {a.x, a.y, b.x, b.y}; return __builtin_bit_cast(bf16x8, u); }
__device__ __forceinline__ bf16x8 pack8(const f32x16& x, int s) {
    u32x4 u = {cvtpk(x[8 * s], x[8 * s + 1]), cvtpk(x[8 * s + 2], x[8 * s + 3]), cvtpk(x[8 * s + 4], x[8 * s + 5]), cvtpk(x[8 * s + 6], x[8 * s + 7])};
    return __builtin_bit_cast(bf16x8, u);
}
__device__ __forceinline__ float gelu_t(float x) { const float u = 0.7978845608028654f * (x + 0.044715f * x * x * x); const float e = __expf(2.0f * u); return 0.5f * x * (1.0f + (1.0f - 2.0f / (e + 1.0f))); }
__device__ __forceinline__ float sigm(float x) { return 1.0f / (1.0f + __expf(-x)); }
__device__ __forceinline__ void zero(f32x16& a) {
#pragma unroll
    for (int i = 0; i < 16; ++i) a[i] = 0.f;
}

__device__ __forceinline__ void gm_ln8(const unsigned short* __restrict__ hb, const float* __restrict__ lw, const float* __restrict__ lbias, unsigned short* __restrict__ vlnT, int t8, int lane) {
    const int tok0 = t8 * 8;
    const float4 w4 = *(const float4*)(lw + lane * 4), b4 = *(const float4*)(lbias + lane * 4);
    float o[4][8];
#pragma unroll
    for (int i = 0; i < 8; ++i) {
        const u32x2 v4 = *(const u32x2*)(hb + (size_t)(tok0 + i) * 3072 + 1280 + lane * 4);
        float v[4] = {gelu_t(bflo(v4.x)), gelu_t(bfhi(v4.x)), gelu_t(bflo(v4.y)), gelu_t(bfhi(v4.y))};
        float s = (v[0] + v[1]) + (v[2] + v[3]);
#pragma unroll
        for (int o2 = 1; o2 < 64; o2 <<= 1) s += __shfl_xor(s, o2);
        const float mean = s * (1.0f / 256.0f); float q = 0.f;
#pragma unroll
        for (int c = 0; c < 4; ++c) { v[c] -= mean; q += v[c] * v[c]; }
#pragma unroll
        for (int o2 = 1; o2 < 64; o2 <<= 1) q += __shfl_xor(q, o2);
        const float rstd = rsqrtf(q * (1.0f / 256.0f) + 1e-5f);
        o[0][i] = v[0] * rstd * w4.x + b4.x; o[1][i] = v[1] * rstd * w4.y + b4.y; o[2][i] = v[2] * rstd * w4.z + b4.z; o[3][i] = v[3] * rstd * w4.w + b4.w;
    }
    const int bc = tok0 >> 7, s0 = tok0 & 127;
#pragma unroll
    for (int c = 0; c < 4; ++c) {
        const int ch = lane * 4 + c, g = ch >> 6, cc = ch & 63;
        u32x4 u = {cvtpk(o[c][0], o[c][1]), cvtpk(o[c][2], o[c][3]), cvtpk(o[c][4], o[c][5]), cvtpk(o[c][6], o[c][7])};
        *(u32x4*)(vlnT + ((size_t)(bc * 4 + g) * 64 + cc) * 128 + s0) = u;
    }
}
__device__ __forceinline__ void gm_sp_task(const unsigned short* __restrict__ hb, const unsigned short* __restrict__ vlnT, const unsigned short* __restrict__ Wb, const float* __restrict__ bs,
                                           const float* __restrict__ normw, unsigned short* __restrict__ ycat, int task, int lane) {
    const int tb = task & 3, g = (task >> 2) & 3, bc = task >> 4, r = lane & 31, h = lane >> 5;
    const unsigned short* ap = vlnT + ((size_t)(bc * 4 + g) * 64 + r) * 128 + 8 * h;
    const unsigned short* bp = Wb + ((size_t)g * 128 + 32 * tb + r) * 128 + 8 * h;
    f32x16 a0, a1; zero(a0); zero(a1);
    const u32x2 uu0 = *(const u32x2*)(hb + (size_t)(bc * 128 + 32 * tb + r) * 3072 + 1024 + g * 64 + 4 * h);
    asm volatile("" :: "v"(uu0));
#pragma unroll 1
    for (int kp = 0; kp <= tb; ++kp) {
        const bf16x8 bw0 = ld16(bp + 32 * kp), bw1 = ld16(bp + 32 * kp + 16);
        const bf16x8 v00 = ld16(ap + 32 * kp), v10 = ld16(ap + 32 * 128 + 32 * kp), v01 = ld16(ap + 32 * kp + 16), v11 = ld16(ap + 32 * 128 + 32 * kp + 16);
        a0 = WT_MFMA(v00, bw0, a0); a1 = WT_MFMA(v10, bw0, a1); a0 = WT_MFMA(v01, bw1, a0); a1 = WT_MFMA(v11, bw1, a1);
    }
    const int tl = 32 * tb + r, tok = bc * 128 + tl;
    const float bias = bs[g * 128 + tl];
    const unsigned short* up = hb + (size_t)tok * 3072 + 1024 + g * 64;
    float z[32]; float ss = 0.f;
#pragma unroll
    for (int cb = 0; cb < 2; ++cb)
#pragma unroll
        for (int u = 0; u < 4; ++u) {
            const int c0 = 32 * cb + 8 * u + 4 * h;
            const u32x2 uu = *(const u32x2*)(up + c0);
            const float uv[4] = {gelu_t(bflo(uu.x)), gelu_t(bfhi(uu.x)), gelu_t(bflo(uu.y)), gelu_t(bfhi(uu.y))};
#pragma unroll
            for (int k = 0; k < 4; ++k) { const float a = (cb ? a1[4 * u + k] : a0[4 * u + k]) + bias; const float zz = uv[k] * a; z[16 * cb + 4 * u + k] = zz; ss += zz * zz; }
        }
    ss = xhalf_sum(ss);
    const float rn = rsqrtf(ss * (1.0f / 64.0f) + 1e-6f);
    unsigned short* yp = ycat + (size_t)tok * 1024 + 256 + g * 64;
    const float* nw = normw + g * 64;
    float4 w4a[2][4];
#pragma unroll
    for (int cb = 0; cb < 2; ++cb)
#pragma unroll
        for (int u = 0; u < 4; ++u) w4a[cb][u] = *(const float4*)(nw + 32 * cb + 8 * u + 4 * h);
#pragma unroll
    for (int cb = 0; cb < 2; ++cb)
#pragma unroll
        for (int u = 0; u < 4; ++u) {
            const int c0 = 32 * cb + 8 * u + 4 * h;
            const float4 w4 = w4a[cb][u];
            u32x2 o = {cvtpk(z[16 * cb + 4 * u] * rn * w4.x, z[16 * cb + 4 * u + 1] * rn * w4.y), cvtpk(z[16 * cb + 4 * u + 2] * rn * w4.z, z[16 * cb + 4 * u + 3] * rn * w4.w)};
            *(u32x2*)(yp + c0) = o;
        }
}

#define WT_LAS __attribute__((address_space(3)))
__device__ __forceinline__ void cmp_wg(const unsigned short* __restrict__ hb, const unsigned short* __restrict__ w1t, const float* __restrict__ cbias, const unsigned short* __restrict__ w2t,
                                       unsigned short* __restrict__ kcb, unsigned short* __restrict__ vcb, WT_LAS float* red, int task, int wave, int lane) {
    const int cblk = task & 7, kv = (task >> 3) & 1, g = (task >> 4) & 1, b = task >> 5, r = lane & 31, h = lane >> 5;
    const int c = 32 * cblk + r; const int cl = c < 254 ? c : 254;
    const unsigned short* bp = hb + (size_t)(b * 4096 + 16 * cl) * 3072 + (kv ? 2176 : 2048) + g * 64 + 8 * h;
    const unsigned short* ap = w1t + ((size_t)kv * 128 + r) * 2048 + 8 * h;
    f32x16 acc[4];
#pragma unroll
    for (int nt = 0; nt < 4; ++nt) zero(acc[nt]);
#pragma unroll 4
    for (int kk = 0; kk < 16; ++kk) {
        const int ks = 16 * wave + kk;
        const bf16x8 bk = ld16(bp + (size_t)(ks >> 2) * 3072 + 16 * (ks & 3));
#pragma unroll
        for (int nt = 0; nt < 4; ++nt) acc[nt] = WT_MFMA(ld16(ap + (size_t)nt * 32 * 2048 + 16 * ks), bk, acc[nt]);
    }
#pragma unroll
    for (int nt = 0; nt < 4; ++nt)
#pragma unroll
        for (int i = 0; i < 16; ++i) red[(wave * 64 + nt * 16 + i) * 64 + lane] = acc[nt][i];
    asm volatile("s_waitcnt lgkmcnt(0)" ::: "memory"); __builtin_amdgcn_s_barrier();
#pragma unroll
    for (int q = 0; q < 8; ++q) {
        const int row = 8 * wave + q; float sacc = 0.f;
#pragma unroll
        for (int w2 = 0; w2 < 8; ++w2) sacc += red[(w2 * 64 + row) * 64 + lane];
        red[row * 64 + lane] = sacc;
    }
    asm volatile("s_waitcnt lgkmcnt(0)" ::: "memory"); __builtin_amdgcn_s_barrier();
    if (wave == 0) {
#pragma unroll
        for (int nt = 0; nt < 4; ++nt)
#pragma unroll
            for (int i = 0; i < 16; ++i) { const int n = 32 * nt + (i & 3) + 8 * (i >> 2) + 4 * h; acc[nt][i] = gelu_t(red[(nt * 16 + i) * 64 + lane] + cbias[kv * 128 + n]); }
        f32x16 o0, o1; zero(o0); zero(o1);
        const unsigned short* w2p = w2t + ((size_t)kv * 64 + r) * 128 + 4 * h;
#pragma unroll
        for (int nt = 0; nt < 4; ++nt)
#pragma unroll
            for (int s = 0; s < 2; ++s) {
                const bf16x8 pb = pack8(acc[nt], s);
                const unsigned short* wp = w2p + 32 * nt + 16 * s;
                o0 = WT_MFMA(ld8x2(wp, wp + 8), pb, o0);
                o1 = WT_MFMA(ld8x2(wp + 32 * 128, wp + 32 * 128 + 8), pb, o1);
            }
        if (c < 255) {
            unsigned short* op = (kv ? vcb : kcb) + ((size_t)(b * 2 + g) * 256 + c) * 64;
#pragma unroll
            for (int db = 0; db < 2; ++db)
#pragma unroll
                for (int u = 0; u < 4; ++u) {
                    const int d0 = 32 * db + 8 * u + 4 * h;
                    u32x2 o = {cvtpk(db ? o1[4 * u] : o0[4 * u], db ? o1[4 * u + 1] : o0[4 * u + 1]), cvtpk(db ? o1[4 * u + 2] : o0[4 * u + 2], db ? o1[4 * u + 3] : o0[4 * u + 3])};
                    *(u32x2*)(op + d0) = o;
                }
        }
    }
    __builtin_amdgcn_s_barrier();
}

__device__ __forceinline__ void kvprep8(const unsigned short* __restrict__ hb, const float* __restrict__ cosT, const float* __restrict__ sinT,
                                        unsigned short* __restrict__ ksb, unsigned short* __restrict__ vsb, unsigned short* __restrict__ kwb, unsigned short* __restrict__ vwb, int idx) {
    const int j8 = idx & 3, g = (idx >> 2) & 1, tok = idx >> 3, b = tok >> 12, t = tok & 4095;
    const unsigned short* hr = hb + (size_t)tok * 3072 + g * 64 + 8 * j8;
    const float4 c0 = *(const float4*)(cosT + (size_t)tok * 32 + 8 * j8), c1 = *(const float4*)(cosT + (size_t)tok * 32 + 8 * j8 + 4);
    const float4 s0 = *(const float4*)(sinT + (size_t)tok * 32 + 8 * j8), s1 = *(const float4*)(sinT + (size_t)tok * 32 + 8 * j8 + 4);
    u32x4 ka[2], kb[2], va[2], vb[2];
#pragma unroll
    for (int w = 0; w < 2; ++w) { const int col = w ? 2560 : 2304, vcol = w ? 2688 : 2432;
        ka[w] = *(const u32x4*)(hr + col); kb[w] = *(const u32x4*)(hr + col + 32); va[w] = *(const u32x4*)(hr + vcol); vb[w] = *(const u32x4*)(hr + vcol + 32); }
    const float cs[8] = {c0.x, c0.y, c0.z, c0.w, c1.x, c1.y, c1.z, c1.w}, sn[8] = {s0.x, s0.y, s0.z, s0.w, s1.x, s1.y, s1.z, s1.w};
    const size_t o = ((size_t)(b * 2 + g) * 4096 + t) * 64 + 8 * j8;
#pragma unroll
    for (int w = 0; w < 2; ++w) {
        u32x4 oa, ob;
#pragma unroll
        for (int c = 0; c < 4; ++c) {
            const float a0 = bflo(ka[w][c]), a1 = bfhi(ka[w][c]), b0 = bflo(kb[w][c]), b1 = bfhi(kb[w][c]);
            oa[c] = cvtpk(a0 * cs[2 * c] - b0 * sn[2 * c], a1 * cs[2 * c + 1] - b1 * sn[2 * c + 1]);
            ob[c] = cvtpk(b0 * cs[2 * c] + a0 * sn[2 * c], b1 * cs[2 * c + 1] + a1 * sn[2 * c + 1]);
        }
        unsigned short* kd = (w ? kwb : ksb) + o;
        *(u32x4*)kd = oa; *(u32x4*)(kd + 32) = ob;
        unsigned short* vd = (w ? vwb : vsb) + o;
        *(u32x4*)vd = va[w]; *(u32x4*)(vd + 32) = vb[w];
    }
}

__device__ __forceinline__ void hg_pass1(const unsigned short* __restrict__ hb, const float* __restrict__ lbl, unsigned short* __restrict__ Qt, unsigned short* __restrict__ Kt,
                                         unsigned short* __restrict__ Qp, unsigned short* __restrict__ VT, float* __restrict__ Ut, float* __restrict__ Dk, int ci, int lane_in) {
    int lane = lane_in; asm volatile("" : "+v"(lane));
    const int chunk = ci & 63, hd = (ci >> 6) & 3, b = ci >> 8;
    const unsigned short* hp = hb + (size_t)(b * 4096 + chunk * 64) * 3072 + hd * 64 + lane;
    const float lb = lbl[hd * 64 + lane];
    unsigned fpk[32];
#pragma unroll
    for (int hb2 = 0; hb2 < 2; ++hb2) { unsigned short rf[32];
#pragma unroll
      for (int t = 0; t < 32; ++t) rf[t] = hp[(size_t)(32 * hb2 + t) * 3072 + 256];
#pragma unroll
      for (int t = 0; t < 16; ++t) fpk[16 * hb2 + t] = (unsigned)rf[2 * t] | ((unsigned)rf[2 * t + 1] << 16); }
    float run = 0.f, cmid = 0.f;
#pragma unroll
    for (int t = 0; t < 64; ++t) {
        const float fr = (t & 1) ? bfhi(fpk[t >> 1]) : bflo(fpk[t >> 1]);
        run += __logf(lb + (1.0f - lb) * sigm(fr));
        if (t == 31) cmid = run;
    }
    const float blast = run;
    unsigned short* qt = Qt + (size_t)ci * 4096 + lane; unsigned short* kt = Kt + (size_t)ci * 4096 + lane; unsigned short* qp = Qp + (size_t)ci * 4096 + lane;
    unsigned short* vt = VT + (size_t)ci * 4096 + lane * 64;
    const int h = lane >> 5, r = lane & 31;
    f32x16 acc[2][2];
#pragma unroll
    for (int a = 0; a < 2; ++a)
#pragma unroll
        for (int c = 0; c < 2; ++c) zero(acc[a][c]);
    float bt = 0.f;
    Dk[(size_t)ci * 64 + lane] = __expf(blast);
#pragma unroll 1
    for (int ks = 0; ks < 4; ++ks) {
        unsigned short rq[1][16], ri[1][16];
#pragma unroll
        for (int tt = 0; tt < 16; ++tt) { const size_t o = (size_t)(ks * 16 + tt) * 3072; rq[0][tt] = hp[o]; ri[0][tt] = hp[o + 512]; }
        unsigned kp[8], vp[8];
        unsigned fsel[8];
#pragma unroll
        for (int tp = 0; tp < 8; ++tp) fsel[tp] = (ks == 0) ? fpk[tp] : (ks == 1) ? fpk[8 + tp] : (ks == 2) ? fpk[16 + tp] : fpk[24 + tp];
#pragma unroll
        for (int tp = 0; tp < 8; ++tp) {
            float k2v[2], ivv[2];
#pragma unroll
            for (int e = 0; e < 2; ++e) {
                const int t = ks * 16 + tp * 2 + e;
                const float qr = __uint_as_float((unsigned)rq[0][tp * 2 + e] << 16), fr = e ? bfhi(fsel[tp]) : bflo(fsel[tp]);
                ivv[e] = __uint_as_float((unsigned)ri[0][tp * 2 + e] << 16);
                const float sf = sigm(fr);
                const float q = qr * sigm(qr), kk = (1.0f - lb) * (1.0f - sf);
                bt += __logf(lb + (1.0f - lb) * sf);
                qt[t * 64] = (unsigned short)(cvtpk(q * __expf(bt - cmid), 0.f) & 0xffffu);
                kt[t * 64] = (unsigned short)(cvtpk(kk * __expf(cmid - bt), 0.f) & 0xffffu);
                qp[t * 64] = (unsigned short)(cvtpk(q * __expf(bt), 0.f) & 0xffffu);
                k2v[e] = kk * __expf(blast - bt);
            }
            kp[tp] = cvtpk(k2v[0], k2v[1]); vp[tp] = cvtpk(ivv[0], ivv[1]);
        }
        { u32x4 u0 = {vp[0], vp[1], vp[2], vp[3]}, u1 = {vp[4], vp[5], vp[6], vp[7]};
          *(u32x4*)(vt + ks * 16) = u0; *(u32x4*)(vt + ks * 16 + 8) = u1; }
        u32x4 kown, vown, ksnd, vsnd;
#pragma unroll
        for (int j = 0; j < 4; ++j) { kown[j] = h ? kp[4 + j] : kp[j]; ksnd[j] = h ? kp[j] : kp[4 + j]; vown[j] = h ? vp[4 + j] : vp[j]; vsnd[j] = h ? vp[j] : vp[4 + j]; }
        u32x4 krcv, vrcv;
#pragma unroll
        for (int j = 0; j < 4; ++j) { krcv[j] = (unsigned)__shfl_xor((int)ksnd[j], 32); vrcv[j] = (unsigned)__shfl_xor((int)vsnd[j], 32); }
        const bf16x8 kb0 = __builtin_bit_cast(bf16x8, h ? krcv : kown), kb1 = __builtin_bit_cast(bf16x8, h ? kown : krcv);
        const bf16x8 va0 = __builtin_bit_cast(bf16x8, h ? vrcv : vown), va1 = __builtin_bit_cast(bf16x8, h ? vown : vrcv);
        acc[0][0] = WT_MFMA(va0, kb0, acc[0][0]); acc[0][1] = WT_MFMA(va0, kb1, acc[0][1]);
        acc[1][0] = WT_MFMA(va1, kb0, acc[1][0]); acc[1][1] = WT_MFMA(va1, kb1, acc[1][1]);
    }
    float* up = Ut + (size_t)ci * 4096;
#pragma unroll
    for (int vb = 0; vb < 2; ++vb)
#pragma unroll
        for (int kb = 0; kb < 2; ++kb)
#pragma unroll
            for (int i = 0; i < 16; ++i) { const int v = 32 * vb + (i & 3) + 8 * (i >> 2) + 4 * h; up[v * 64 + 32 * kb + r] = acc[vb][kb][i]; }
}
__device__ __forceinline__ void hg_scan(const float* __restrict__ Ut, const float* __restrict__ Dk, unsigned short* __restrict__ ST, int e) {
    const int k = e & 63, seq = e >> 12, vk = e & 4095;
    float S = 0.f;
    const float* up = Ut + (size_t)seq * 64 * 4096 + vk; const float* dp = Dk + (size_t)seq * 64 * 64 + k; unsigned short* sp = ST + (size_t)seq * 64 * 4096 + vk;
#pragma unroll 8
    for (int c = 0; c < 64; ++c) {
        sp[(size_t)c * 4096] = (unsigned short)(cvtpk(S, 0.f) & 0xffffu);
        S = fmaf(dp[c * 64], S, up[(size_t)c * 4096]);
    }
}
__device__ __forceinline__ void hg_pass3(const unsigned short* __restrict__ hb, const unsigned short* __restrict__ Qt, const unsigned short* __restrict__ Kt, const unsigned short* __restrict__ Qp,
                                         const unsigned short* __restrict__ VT, const unsigned short* __restrict__ ST, const float* __restrict__ normw, unsigned short* __restrict__ ycat, int task, int lane) {
    const int tblk = task & 1, ci = task >> 1, chunk = ci & 63, hd = (ci >> 6) & 3, b = ci >> 8, r = lane & 31, h = lane >> 5;
    const size_t cb = (size_t)ci * 4096;
    f32x16 o0, o1; zero(o0); zero(o1);
    {
        const unsigned short* sp = ST + cb + (size_t)r * 64 + 8 * h; const unsigned short* qp = Qp + cb + (size_t)(32 * tblk + r) * 64 + 8 * h;
#pragma unroll
        for (int ks = 0; ks < 4; ++ks) { const bf16x8 q = ld16(qp + 16 * ks); o0 = WT_MFMA(ld16(sp + 16 * ks), q, o0); o1 = WT_MFMA(ld16(sp + 32 * 64 + 16 * ks), q, o1); }
    }
    const unsigned short* qtp = Qt + cb + (size_t)(32 * tblk + r) * 64 + 8 * h;
    bf16x8 qf[4];
#pragma unroll
    for (int ks = 0; ks < 4; ++ks) qf[ks] = ld16(qtp + 16 * ks);
#pragma unroll 1
    for (int sblk = 0; sblk <= tblk; ++sblk) {
        f32x16 at; zero(at);
        const unsigned short* ktp = Kt + cb + (size_t)(32 * sblk + r) * 64 + 8 * h;
#pragma unroll
        for (int ks = 0; ks < 4; ++ks) at = WT_MFMA(ld16(ktp + 16 * ks), qf[ks], at);
        if (sblk == tblk) {
#pragma unroll
            for (int i = 0; i < 16; ++i) { const int sl = (i & 3) + 8 * (i >> 2) + 4 * h; at[i] = (sl <= r) ? at[i] : 0.f; }
        }
#pragma unroll
        for (int s2 = 0; s2 < 2; ++s2) {
            const bf16x8 pb = pack8(at, s2);
            const unsigned short* vp = VT + cb + (size_t)r * 64 + 32 * sblk + 16 * s2 + 4 * h;
            o0 = WT_MFMA(ld8x2(vp, vp + 8), pb, o0);
            o1 = WT_MFMA(ld8x2(vp + 32 * 64, vp + 32 * 64 + 8), pb, o1);
        }
    }
    const int tok = b * 4096 + chunk * 64 + 32 * tblk + r;
    float ss = 0.f;
#pragma unroll
    for (int i = 0; i < 16; ++i) ss += o0[i] * o0[i] + o1[i] * o1[i];
    ss = xhalf_sum(ss);
    const float rn = rsqrtf(ss * (1.0f / 64.0f) + 1e-6f);
    const unsigned short* gp = hb + (size_t)tok * 3072 + 768 + hd * 64;
    unsigned short* yp = ycat + (size_t)tok * 1024 + hd * 64;
    const float* nw = normw + hd * 64;
    u32x2 gg[2][4]; float4 w4[2][4];
#pragma unroll
    for (int vb = 0; vb < 2; ++vb)
#pragma unroll
        for (int u = 0; u < 4; ++u) { const int v0 = 32 * vb + 8 * u + 4 * h; gg[vb][u] = *(const u32x2*)(gp + v0); w4[vb][u] = *(const float4*)(nw + v0); }
#pragma unroll
    for (int vb = 0; vb < 2; ++vb)
#pragma unroll
        for (int u = 0; u < 4; ++u) {
            const int v0 = 32 * vb + 8 * u + 4 * h;
            const float x0 = (vb ? o1[4 * u] : o0[4 * u]) * rn * w4[vb][u].x * sigm(bflo(gg[vb][u].x)), x1 = (vb ? o1[4 * u + 1] : o0[4 * u + 1]) * rn * w4[vb][u].y * sigm(bfhi(gg[vb][u].x));
            const float x2 = (vb ? o1[4 * u + 2] : o0[4 * u + 2]) * rn * w4[vb][u].z * sigm(bflo(gg[vb][u].y)), x3 = (vb ? o1[4 * u + 3] : o0[4 * u + 3]) * rn * w4[vb][u].w * sigm(bfhi(gg[vb][u].y));
            u32x2 o = {cvtpk(x0, x1), cvtpk(x2, x3)};
            *(u32x2*)(yp + v0) = o;
        }
}

__device__ __forceinline__ void route_task(const unsigned short* __restrict__ x1, const unsigned short* __restrict__ rwh, const unsigned short* __restrict__ rwl, const float* __restrict__ rb,
                                           int* __restrict__ cnt, int* __restrict__ list, int* __restrict__ tok_e, int* __restrict__ tok_slot, float* __restrict__ tok_w, int task, int lane) {
    const int r = lane & 31, h = lane >> 5, tok = task * 32 + r;
    const unsigned short* xp = x1 + (size_t)tok * 1024 + 8 * h;
    const unsigned short* whp = rwh + (size_t)r * 1024 + 8 * h; const unsigned short* wlp = rwl + (size_t)r * 1024 + 8 * h;
    f32x16 acc; zero(acc);
#pragma unroll 8
    for (int ks = 0; ks < 64; ++ks) {
        const bf16x8 xh = ld16(xp + 16 * ks);
        acc = WT_MFMA(ld16(whp + 16 * ks), xh, acc); acc = WT_MFMA(ld16(wlp + 16 * ks), xh, acc);
    }
    float v[16];
#pragma unroll
    for (int i = 0; i < 16; ++i) v[i] = acc[i] + rb[(i & 3) + 8 * (i >> 2) + 4 * h];
    float cv[8]; int ce[8];
#pragma unroll
    for (int k = 0; k < 4; ++k) {
        float best = -3.0e38f; int bi = 0;
#pragma unroll
        for (int i = 0; i < 16; ++i) { const bool ok = v[i] > best; best = ok ? v[i] : best; bi = ok ? i : bi; }
#pragma unroll
        for (int i = 0; i < 16; ++i) v[i] = (i == bi) ? -3.0e38f : v[i];
        cv[k] = best; ce[k] = (bi & 3) + 8 * (bi >> 2) + 4 * h;
    }
#pragma unroll
    for (int k = 0; k < 4; ++k) { cv[4 + k] = xhalf(cv[k]); ce[4 + k] = __shfl_xor(ce[k], 32); }
    float tl[4]; int te[4];
#pragma unroll
    for (int k = 0; k < 4; ++k) {
        float best = -3.0e38f; int be = 64, bj = 0;
#pragma unroll
        for (int j = 0; j < 8; ++j) { const bool ok = (cv[j] > best) || (cv[j] == best && ce[j] < be); best = ok ? cv[j] : best; be = ok ? ce[j] : be; bj = ok ? j : bj; }
#pragma unroll
        for (int j = 0; j < 8; ++j) cv[j] = (j == bj) ? -3.0e38f : cv[j];
        tl[k] = best; te[k] = be;
    }
    const float e1 = __expf(tl[1] - tl[0]), e2 = __expf(tl[2] - tl[0]), e3 = __expf(tl[3] - tl[0]);
    const float inv = 1.0f / (1.0f + e1 + e2 + e3);
    const float tw[4] = {inv, e1 * inv, e2 * inv, e3 * inv};
    unsigned mymask = 0u;
#pragma unroll 1
    for (int e = 0; e < 32; ++e) {
        const unsigned mk = (unsigned)__ballot(h == 0 && (te[0] == e || te[1] == e || te[2] == e || te[3] == e));
        mymask = (lane == e) ? mk : mymask;
    }
    int base = 0;
    if (lane < 32 && mymask != 0u) base = atomicAdd(&cnt[lane], __popc(mymask));
#pragma unroll
    for (int k = 0; k < 4; ++k) {
        const int bk = __shfl(base, te[k]); const unsigned mk = (unsigned)__shfl((int)mymask, te[k]);
        const int slot = bk + __popc(mk & ((1u << r) - 1u));
        if (h == 0) { list[te[k] * 32768 + slot] = tok; tok_e[tok * 4 + k] = te[k]; tok_slot[tok * 4 + k] = slot; tok_w[tok * 4 + k] = tw[k]; }
    }
}
}


__device__ __forceinline__ void ln1_tok2(const float* __restrict__ xin_f, const bf16* __restrict__ xin_b, const bf16* __restrict__ mix, const float* __restrict__ lw, const float* __restrict__ lbias,
                                         bf16* __restrict__ x1b, unsigned char* __restrict__ x1q, int tok0, int lane) {
    float v[2][16]; float s[2] = {0.f, 0.f};
#pragma unroll
    for (int u = 0; u < 2; ++u)
#pragma unroll
        for (int j = 0; j < 4; ++j) {
            const size_t o = (size_t)(tok0 + u) * D_ + j * 256 + lane * 4;
            float4 a;
            if (xin_f) a = *(const float4*)(xin_f + o);
            else { const uint2 ab = *(const uint2*)(xin_b + o);
                   a = make_float4(__uint_as_float(ab.x << 16), __uint_as_float(ab.x & 0xffff0000u), __uint_as_float(ab.y << 16), __uint_as_float(ab.y & 0xffff0000u)); }
            const uint2 mb = *(const uint2*)(mix + o);
            v[u][4 * j] = ALPHA * a.x + __uint_as_float(mb.x << 16); v[u][4 * j + 1] = ALPHA * a.y + __uint_as_float(mb.x & 0xffff0000u);
            v[u][4 * j + 2] = ALPHA * a.z + __uint_as_float(mb.y << 16); v[u][4 * j + 3] = ALPHA * a.w + __uint_as_float(mb.y & 0xffff0000u);
            s[u] += (v[u][4 * j] + v[u][4 * j + 1]) + (v[u][4 * j + 2] + v[u][4 * j + 3]);
        }
    float rstd[2];
#pragma unroll
    for (int u = 0; u < 2; ++u) {
        const float mean = wsum(s[u]) * (1.0f / D_); float q = 0.f;
#pragma unroll
        for (int i = 0; i < 16; ++i) { v[u][i] -= mean; q += v[u][i] * v[u][i]; }
        rstd[u] = rsqrtf(wsum(q) * (1.0f / D_) + 1e-5f);
    }
    float4 w4a[4], b4a[4];
#pragma unroll
    for (int j = 0; j < 4; ++j) { w4a[j] = *(const float4*)(lw + j * 256 + lane * 4); b4a[j] = *(const float4*)(lbias + j * 256 + lane * 4); }
#pragma unroll
    for (int j = 0; j < 4; ++j) {
        const float4 w4 = w4a[j], b4 = b4a[j];
#pragma unroll
        for (int u = 0; u < 2; ++u) {
            const size_t o = (size_t)(tok0 + u) * D_ + j * 256 + lane * 4;
            const float4 r = make_float4(v[u][4 * j] * rstd[u] * w4.x + b4.x, v[u][4 * j + 1] * rstd[u] * w4.y + b4.y, v[u][4 * j + 2] * rstd[u] * w4.z + b4.z, v[u][4 * j + 3] * rstd[u] * w4.w + b4.w);
            *(uint2*)(x1b + o) = make_uint2(pk2(r.x, r.y), pk2(r.z, r.w));
            *(unsigned*)(x1q + o) = pg8::pk4_fp8(r.x, r.y, r.z, r.w);
        }
    }
}
__device__ __forceinline__ void comb_ln2_tok2(const bf16* __restrict__ x1, const bf16* __restrict__ y, const int* __restrict__ offs, const int* __restrict__ tok_e,
                                              const int* __restrict__ tok_slot, const float* __restrict__ tok_w, const float* __restrict__ lw, const float* __restrict__ lbias,
                                              float* __restrict__ xout, bf16* __restrict__ xbout, int tok0, int lane, const int (&row)[2][4], const float (&wk)[2][4]) {
    float v[2][16];
#pragma unroll
    for (int u = 0; u < 2; ++u)
#pragma unroll
        for (int j = 0; j < 4; ++j) { const uint2 ab = *(const uint2*)(x1 + (size_t)(tok0 + u) * D_ + j * 256 + lane * 4);
            v[u][4 * j] = ALPHA * __uint_as_float(ab.x << 16); v[u][4 * j + 1] = ALPHA * __uint_as_float(ab.x & 0xffff0000u); v[u][4 * j + 2] = ALPHA * __uint_as_float(ab.y << 16); v[u][4 * j + 3] = ALPHA * __uint_as_float(ab.y & 0xffff0000u); }
#pragma unroll
    for (int u = 0; u < 2; ++u)
#pragma unroll
        for (int k = 0; k < 4; ++k)
#pragma unroll
            for (int j = 0; j < 4; ++j) { const uint2 ab = *(const uint2*)(y + (size_t)row[u][k] * D_ + j * 256 + lane * 4); const float w = wk[u][k];
                v[u][4 * j] = fmaf(w, __uint_as_float(ab.x << 16), v[u][4 * j]); v[u][4 * j + 1] = fmaf(w, __uint_as_float(ab.x & 0xffff0000u), v[u][4 * j + 1]);
                v[u][4 * j + 2] = fmaf(w, __uint_as_float(ab.y << 16), v[u][4 * j + 2]); v[u][4 * j + 3] = fmaf(w, __uint_as_float(ab.y & 0xffff0000u), v[u][4 * j + 3]); }
    float rstd[2];
#pragma unroll
    for (int u = 0; u < 2; ++u) {
        float s = 0.f;
#pragma unroll
        for (int i = 0; i < 16; ++i) s += v[u][i];
        const float mean = wsum(s) * (1.0f / D_); float q = 0.f;
#pragma unroll
        for (int i = 0; i < 16; ++i) { v[u][i] -= mean; q += v[u][i] * v[u][i]; }
        rstd[u] = rsqrtf(wsum(q) * (1.0f / D_) + 1e-5f);
    }
    float4 w4a[4], b4a[4];
#pragma unroll
    for (int j = 0; j < 4; ++j) { w4a[j] = *(const float4*)(lw + j * 256 + lane * 4); b4a[j] = *(const float4*)(lbias + j * 256 + lane * 4); }
#pragma unroll
    for (int j = 0; j < 4; ++j) {
        const float4 w4 = w4a[j], b4 = b4a[j];
#pragma unroll
        for (int u = 0; u < 2; ++u) {
            const size_t o = (size_t)(tok0 + u) * D_ + j * 256 + lane * 4;
            const float4 r = make_float4(v[u][4 * j] * rstd[u] * w4.x + b4.x, v[u][4 * j + 1] * rstd[u] * w4.y + b4.y, v[u][4 * j + 2] * rstd[u] * w4.z + b4.z, v[u][4 * j + 3] * rstd[u] * w4.w + b4.w);
            if (xout) *(float4*)(xout + o) = r;
            if (xbout) *(uint2*)(xbout + o) = make_uint2(pk2(r.x, r.y), pk2(r.z, r.w));
        }
    }
}

struct Args { const float* in[25]; float* out; unsigned char* ws; int ph_lo, ph_hi; };
#define PH __device__ __forceinline__
constexpr int TAB_OFF = 131072;

__device__ __forceinline__ void transpose_item(const float* __restrict__ W, int K, int N, bf16* __restrict__ WT, int k0, int scol0, int drow0, float* scr, int lane) {
    const int cc = lane & 31; const bool cv = (scol0 + cc) < N;
#pragma unroll 8
    for (int i = 0; i < 32; ++i) { const int kk = 2 * i + (lane >> 5); scr[kk * 33 + cc] = cv ? W[(size_t)(k0 + kk) * N + scol0 + cc] : 0.f; }
    asm volatile("s_waitcnt lgkmcnt(0)" ::: "memory");
    const int c = lane & 7;
#pragma unroll
    for (int j = 0; j < 4; ++j) { const int n = (lane >> 3) + 8 * j; const float* s = scr + (8 * c) * 33 + n;
        uint4 o; o.x = pk2(s[0 * 33], s[1 * 33]); o.y = pk2(s[2 * 33], s[3 * 33]); o.z = pk2(s[4 * 33], s[5 * 33]); o.w = pk2(s[6 * 33], s[7 * 33]);
        *(uint4*)(WT + (size_t)(drow0 + n) * K + k0 + 8 * c) = o; }
    asm volatile("s_waitcnt lgkmcnt(0)" ::: "memory");
}
__device__ __forceinline__ void transpose64(const float* __restrict__ W, int K, int N, bf16* __restrict__ WT, int k0, int scol0, int drow0, int lane) {
    const int q = lane >> 4, c = lane & 15;
    const bool cv = (scol0 + 4 * c) < N;
    const float* src = W + (size_t)(k0 + 16 * q) * N + scol0 + 4 * c;
    float4 v[16];
#pragma unroll
    for (int i = 0; i < 16; ++i) v[i] = cv ? *(const float4*)(src + (size_t)i * N) : make_float4(0.f, 0.f, 0.f, 0.f);
    bf16* dst = WT + (size_t)(drow0 + 4 * c) * K + k0 + 16 * q;
#pragma unroll
    for (int j = 0; j < 4; ++j) {
        float e[16];
#pragma unroll
        for (int i = 0; i < 16; ++i) e[i] = (j == 0) ? v[i].x : (j == 1) ? v[i].y : (j == 2) ? v[i].z : v[i].w;
        uint4 o0, o1;
        o0.x = pk2(e[0], e[1]); o0.y = pk2(e[2], e[3]); o0.z = pk2(e[4], e[5]); o0.w = pk2(e[6], e[7]);
        o1.x = pk2(e[8], e[9]); o1.y = pk2(e[10], e[11]); o1.z = pk2(e[12], e[13]); o1.w = pk2(e[14], e[15]);
        *(uint4*)(dst + (size_t)j * K) = o0; *(uint4*)(dst + (size_t)j * K + 8) = o1;
    }
}
struct T64Item { const float* src; unsigned char* dst; };
__device__ __forceinline__ void t64_load(const float* src, int N, float4 (&v)[16]) {
#pragma unroll
    for (int i = 0; i < 16; ++i) { typedef float f4v __attribute__((ext_vector_type(4))); const f4v t = __builtin_nontemporal_load((const f4v*)(src + (size_t)i * N)); v[i] = make_float4(t.x, t.y, t.z, t.w); }
}
__device__ __forceinline__ unsigned pk4_fp8_nc(float a, float b, float c, float d) { int p = __builtin_amdgcn_cvt_pk_fp8_f32(a, b, 0, false); p = __builtin_amdgcn_cvt_pk_fp8_f32(c, d, p, true); return (unsigned)p; }
__device__ __forceinline__ void t64_store_f8(unsigned char* dst, int K, float sc, const float4 (&v)[16]) {
#pragma unroll
    for (int j = 0; j < 4; ++j) {
        float e[16];
#pragma unroll
        for (int i = 0; i < 16; ++i) e[i] = sc * ((j == 0) ? v[i].x : (j == 1) ? v[i].y : (j == 2) ? v[i].z : v[i].w);
        uint4 o;
        o.x = pk4_fp8_nc(e[0], e[1], e[2], e[3]); o.y = pk4_fp8_nc(e[4], e[5], e[6], e[7]); o.z = pk4_fp8_nc(e[8], e[9], e[10], e[11]); o.w = pk4_fp8_nc(e[12], e[13], e[14], e[15]);
        *(uint4*)(dst + (size_t)j * K) = o;
    }
}
__device__ __forceinline__ void t64_item(int it, const float* w_up, const float* w_dn, unsigned char* wt_up, unsigned char* wt_dn, int lane, const float*& src, unsigned char*& dst, int& N, float& sc) {
    constexpr int I_UP = 16 * 32, I_DN = 16 * 16;
    const int q = lane >> 4, c = lane & 15;
    if (it < NE * I_UP) { const int e = it / I_UP, r = it % I_UP, kb = r / 32, nb = r % 32;
        const int n0 = nb * 64, pn = n0 >> 8, bj = (n0 >> 7) & 1, jj = n0 & 127;
        src = w_up + (size_t)e * D_ * 2048 + (size_t)(kb * 64 + 16 * q) * 2048 + bj * 1024 + 128 * pn + jj + 4 * c;
        dst = wt_up + (size_t)e * 2048 * D_ + (size_t)(n0 + 4 * c) * D_ + kb * 64 + 16 * q; N = 2048; sc = pg8::F8_SU; }
    else { const int r0 = it - NE * I_UP; const int e = r0 / I_DN, r = r0 % I_DN, kb = r / 16, nb = r % 16;
        src = w_dn + (size_t)e * D_ * D_ + (size_t)(kb * 64 + 16 * q) * D_ + nb * 64 + 4 * c;
        dst = wt_dn + (size_t)e * D_ * D_ + (size_t)(nb * 64 + 4 * c) * D_ + kb * 64 + 16 * q; N = D_; sc = pg8::F8_SD; }
}
PH void ph_prologue(int wv, const int* pos, const float* hg_lb, float* cosT, float* sinT, float* lb,
                    const float* x, bf16* xb, const float* w_in, const float* w_out, const float* w_up, const float* w_dn, bf16* wt_in, bf16* wt_out, bf16* wt_up, bf16* wt_dn,
                    const float* gm_sw, bf16* wb, const float* cpe, const float* cw1, bf16* w1t, float* cbias, const float* cw2, bf16* w2t, const float* rw, bf16* rwh, bf16* rwl) {
    extern __shared__ __attribute__((aligned(16))) unsigned char lds[];
    int tid = mk_tid(wv), bid = blockIdx.x; asm volatile("" : "+v"(tid), "+s"(bid)); const int G = gridDim.x, lane = tid & 63, wave = wv;
#pragma unroll 1
    for (int i0 = bid * NTHR + tid; i0 < NT * 32; i0 += 4 * G * NTHR) {
        int pv[4];
#pragma unroll
        for (int u = 0; u < 4; ++u) { const int i = i0 + u * G * NTHR; pv[u] = (i < NT * 32) ? pos[i >> 5] : 0; }
#pragma unroll
        for (int u = 0; u < 4; ++u) { const int i = i0 + u * G * NTHR; if (i < NT * 32) { const int j = i & 31;
            float inv = (float)pow(10000.0, -(double)(2 * j) / 64.0);
            float ang = (float)pv[u] * inv;
            const double ad = (double)ang, kk = rint(ad * 0.15915494309189535);
            const float rf = (float)fma(-kk, 6.283185307179586, ad);
            cosT[i] = cosf(rf); sinT[i] = sinf(rf); } }
    }
    if (bid == 0 && tid < 256) {
        float p0 = hg_lb[tid], p1 = hg_lb[256 + tid];
        float m = fmaxf(p0, p1); float ea = expf(p0 - m), eb = expf(p1 - m);
        lb[tid] = 0.f; lb[256 + tid] = eb / (ea + eb);
    }
    {
        const size_t n4 = (size_t)NT * D_ / 4, stride = (size_t)G * NTHR;
#pragma unroll 1
        for (size_t i = (size_t)bid * NTHR + tid; i < n4; i += 8 * stride) {
            float4 v[8];
#pragma unroll
            for (int u = 0; u < 8; ++u) { const size_t j = i + u * stride; v[u] = (j < n4) ? ((const float4*)x)[j] : make_float4(0.f, 0.f, 0.f, 0.f); }
#pragma unroll
            for (int u = 0; u < 8; ++u) { const size_t j = i + u * stride; if (j < n4) ((uint2*)xb)[j] = make_uint2(pk2(v[u].x, v[u].y), pk2(v[u].z, v[u].w)); }
        }
    }
#pragma unroll 1
    for (int i = bid * NTHR + tid; i < DEPTH * NE * D_; i += G * NTHR) { const int k = i & 1023, e = (i >> 10) & 31, l = i >> 15; const float w = rw[((size_t)l * D_ + k) * NE + e];
        const unsigned hi = f2bf(w); rwh[i] = (bf16)hi; rwl[i] = (bf16)f2bf(w - __uint_as_float(hi << 16)); }
#pragma unroll 1
    for (int i = bid * NTHR + tid; i < DEPTH * 4 * 128 * 128; i += G * NTHR) { const int s = i & 127, t = (i >> 7) & 127; wb[i] = (bf16)f2bf(s <= t ? gm_sw[i] : 0.f); }
    {
        const int gwv = bid * 8 + wave, NGWV = G * 8;
#pragma unroll 1
        for (int o = gwv; o < DEPTH * 2 * 128; o += NGWV) {
            const int lk = o >> 7, n = o & 127;
            float a = 0.f;
#pragma unroll 8
            for (int i = lane; i < 2048; i += 64) a = fmaf(cpe[lk * 2048 + i], cw1[((size_t)lk * 2048 + i) * 128 + n], a);
            a = wsum(a);
            if (lane == 0) cbias[o] = a;
        }
    }
    float* scr = (float*)(lds + wave * 16384);
    const int gw = bid * 8 + wave, NGW = G * 8;
    constexpr int I_IN = 16 * 45, I_OUT = 16 * 16;
    constexpr int I_C1 = 32 * 4;
    constexpr int I_C2 = 2 * 2;
    constexpr int PER_L = I_IN + I_OUT + 2 * I_C1 + 2 * I_C2;
#pragma unroll 1
    for (int it = gw; it < DEPTH * PER_L; it += NGW) {
        const int l = it / PER_L; int r = it % PER_L;
        if (r < I_IN) { const int kb = r / 45, nb = r % 45; transpose64(w_in + (size_t)l * D_ * INW, D_, INW, wt_in + (size_t)l * HS * D_, kb * 64, nb * 64, nb * 64, lane); continue; }
        r -= I_IN;
        if (r < I_OUT) { const int kb = r / 16, nb = r % 16; transpose64(w_out + (size_t)l * D_ * D_, D_, D_, wt_out + (size_t)l * D_ * D_, kb * 64, nb * 64, nb * 64, lane); continue; }
        r -= I_OUT;
        if (r < 2 * I_C1) { const int kv = r / I_C1, q = r % I_C1, kb = q / 4, nb = q % 4;
            transpose_item(cw1 + ((size_t)l * 2 + kv) * 2048 * 128, 2048, 128, w1t + ((size_t)l * 2 + kv) * 128 * 2048, kb * 64, nb * 32, nb * 32, scr, lane); continue; }
        r -= 2 * I_C1;
        { const int kv = r / I_C2, q = r % I_C2, kb = q / 2, nb = q % 2;
            transpose_item(cw2 + ((size_t)l * 2 + kv) * 128 * 64, 128, 64, w2t + ((size_t)l * 2 + kv) * 64 * 128, kb * 64, nb * 32, nb * 32, scr, lane); }
    }
}
#define M1EN(x) 1
#ifndef M1REP
#define M1R(x) 1
#else
#define M1R(x) (((x) == M1REP) ? 3 : 1)
#endif
PH void ph_mix1(int wv, const bf16* hb, const float* lb, bf16* hqt, bf16* hkt, bf16* hqp, bf16* hvt, float* hut, float* hdk,
                const float* glw, const float* glb, bf16* vlnT, const bf16* w1t, const float* cbias, const bf16* w2, bf16* kcb, bf16* vcb,
                const float* cosT, const float* sinT, bf16* ksb, bf16* vsb, bf16* kwb, bf16* vwb,
                const float* w_up, const float* w_dn, unsigned char* wt_up, unsigned char* wt_dn) {
    extern __shared__ __attribute__((aligned(16))) unsigned char lds[];
    int tid = mk_tid(wv), bid = blockIdx.x; asm volatile("" : "+v"(tid), "+s"(bid)); const int lane = tid & 63, wave = wv, G = gridDim.x;
    const int gw = bid * 8 + wave, NGW = G * 8;
    { int ln = lane; asm volatile("" : "+v"(ln));
#pragma unroll 1
    for (int rp = 0; rp < M1R(1); ++rp)
#pragma unroll 1
    for (int u = bid; u < 256 && M1EN(1); u += G) wt::cmp_wg(hb, w1t, cbias, w2, kcb, vcb, (WT_LAS float*)lds, u, wave, ln); }
#pragma unroll 1
    for (int pass = 0; pass < 2; ++pass) {
        if (((pass ^ wave) & 1) == 0) {
            { int ln = lane; asm volatile("" : "+v"(ln));
#pragma unroll 1
            for (int rp = 0; rp < M1R(2); ++rp)
#pragma unroll 1
            for (int u = gw; u < 2048 && M1EN(2); u += NGW) wt::hg_pass1(hb, lb, hqt, hkt, hqp, hvt, hut, hdk, u, ln); }
            { int ln = lane; asm volatile("" : "+v"(ln));
#pragma unroll 1
            for (int rp = 0; rp < M1R(4); ++rp)
#pragma unroll 1
            for (int u = gw; u < NT / 8 && M1EN(4); u += NGW) wt::gm_ln8(hb, glw, glb, vlnT, u, ln); }
            { int t_ = tid; asm volatile("" : "+v"(t_));
#pragma unroll 1
            for (int rp = 0; rp < M1R(8); ++rp)
#pragma unroll 1
            for (int idx = bid * NTHR + t_; idx < NT * 8; idx += G * NTHR) wt::kvprep8(hb, cosT, sinT, ksb, vsb, kwb, vwb, idx); }
        } else {
            int ln = lane; asm volatile("" : "+v"(ln));
            constexpr int NIT = NE * (16 * 32 + 16 * 16);
#pragma unroll 1
            for (int rp = 0; rp < M1R(16); ++rp)
#pragma unroll 1
            for (int it = gw; it < NIT; it += NGW) {
                float4 va[16]; const float* s0; unsigned char* d0; int n0_; float c0_;
                t64_item(it, w_up, w_dn, wt_up, wt_dn, ln, s0, d0, n0_, c0_); t64_load(s0, n0_, va); t64_store_f8(d0, D_, c0_, va);
            }
        }
    }
}
PH void ph_mix2(int wv, const float* hut, const float* hdk, bf16* hst, const bf16* hb, const bf16* vlnT, const bf16* wb, const float* sb, const float* nw, bf16* ycat) {
    int tid = mk_tid(wv), bid = blockIdx.x; asm volatile("" : "+v"(tid), "+s"(bid)); const int lane = tid & 63, wave = wv, G = gridDim.x;
#pragma unroll 1
    for (int e = bid * NTHR + tid; e < 32 * 4096; e += G * NTHR) wt::hg_scan(hut, hdk, hst, e);
    const int gw = bid * 8 + wave, NGW = G * 8;
#pragma unroll 1
    for (int u = gw; u < 4096; u += NGW) wt::gm_sp_task(hb, vlnT, wb, sb, nw, ycat, u, lane);
}
PH void ph_hg3(int wv, const bf16* hb, const bf16* hqt, const bf16* hkt, const bf16* hqp, const bf16* hvt, const bf16* hst, const float* nw, bf16* ycat) {
    int tid = mk_tid(wv), bid = blockIdx.x; asm volatile("" : "+v"(tid), "+s"(bid)); const int lane = tid & 63, wave = wv, G = gridDim.x;
    const int gw = bid * 8 + wave, NGW = G * 8;
#pragma unroll 1
    for (int u = gw; u < 4096; u += NGW) wt::hg_pass3(hb, hqt, hkt, hqp, hvt, hst, nw, ycat, u, lane);
}
PH void ph_ln1_route(int wv, const float* xin_f, const bf16* xin_b, const bf16* mix, const float* lw, const float* lb, bf16* x1b, unsigned char* x1q,
                     const bf16* rwh, const bf16* rwl, const float* rb, int* cnt, int* list, int* tok_e, int* tok_slot, float* tok_w) {
    int tid = mk_tid(wv), bid = blockIdx.x; asm volatile("" : "+v"(tid), "+s"(bid)); const int lane = tid & 63, wave = wv, G = gridDim.x;
#pragma unroll 1
    for (int it = bid; it < NT / 128; it += G) {
        { int ln = lane; asm volatile("" : "+v"(ln));
#pragma unroll 1
          for (int k = 0; k < 8; ++k) ln1_tok2(xin_f, xin_b, mix, lw, lb, x1b, x1q, it * 128 + wave * 16 + 2 * k, ln); }
        asm volatile("s_waitcnt vmcnt(0)" ::: "memory"); __builtin_amdgcn_fence(__ATOMIC_RELEASE, "workgroup"); __syncthreads(); __builtin_amdgcn_fence(__ATOMIC_ACQUIRE, "workgroup");
        if (wave < 4) { int ln = lane; asm volatile("" : "+v"(ln)); wt::route_task(x1b, rwh, rwl, rb, cnt, list, tok_e, tok_slot, tok_w, it * 4 + wave, ln); }
    }
}
PH void ph_comb(int wv, const bf16* x1, const bf16* ybuf, const int* tok_e, const int* tok_slot, const float* tok_w, const float* lw, const float* lb, float* xo, bf16* xbo) {
    extern __shared__ __attribute__((aligned(16))) unsigned char lds[];
    const int* offs_s = (const int*)(lds + TAB_OFF + 512);
    int tid = mk_tid(wv), bid = blockIdx.x; asm volatile("" : "+v"(tid), "+s"(bid)); const int lane = tid & 63, wave = wv, G = gridDim.x;
#pragma unroll 1
    for (int t0 = (bid * 8 + wave) * 16; t0 < NT; t0 += G * 128) {
        const int ia = t0 * 4 + lane;
        const int rowl = offs_s[tok_e[ia]] + tok_slot[ia]; const float wl = tok_w[ia];
#pragma unroll 1
        for (int p = 0; p < 8; ++p) {
            int row[2][4]; float wk[2][4];
#pragma unroll
            for (int u = 0; u < 2; ++u)
#pragma unroll
                for (int k = 0; k < 4; ++k) { row[u][k] = __shfl(rowl, p * 8 + u * 4 + k); wk[u][k] = __shfl(wl, p * 8 + u * 4 + k); }
            comb_ln2_tok2(x1, ybuf, offs_s, tok_e, tok_slot, tok_w, lw, lb, xo, xbo, t0 + 2 * p, lane, row, wk);
        }
    }
}

typedef const Args __attribute__((address_space(4))) CArgs;
#define PHASE_BEGIN CArgs* ap = (CArgs*)__builtin_amdgcn_kernarg_segment_ptr(); int l_ = l; asm volatile("" : "+s"(ap), "+s"(l_)); unsigned char* const ws_ = ap->ws; \
    const int G = gridDim.x; int bid = blockIdx.x; asm volatile("" : "+s"(bid));
#define WP(T, off) ((T*)(ws_ + (off)))
#define INP(k) (ap->in[k])
__global__ void __launch_bounds__(NTHR, 2) mega(Args a) {
    extern __shared__ __attribute__((aligned(16))) unsigned char lds[];
    volatile LAS unsigned* MISC = (volatile LAS unsigned*)((LAS unsigned char*)lds + MISC_OFF);
    int wv = __builtin_amdgcn_readfirstlane((int)threadIdx.x >> 6); asm volatile("" : "+s"(wv));
    { const int t0 = mk_tid(wv); if (t0 < 64) MISC[t0] = 0u; }
    __syncthreads();
    XcdBarrier bar = xcd_barrier_post((unsigned*)a.ws, MISC + 8, wv);
    int* tstart = (int*)(lds + TAB_OFF); int* cnts = (int*)(lds + TAB_OFF + 256); int* offs_s = (int*)(lds + TAB_OFF + 512);
    PG8_LAS unsigned char* ldsl = (PG8_LAS unsigned char*)lds;

#ifndef PH_MASK
#define EN(n) 1
#else
#define EN(n) ((PH_MASK >> ((n) % 20)) & 1)
#endif
#define IN(k) 1
#ifndef REP_PH
#define REPL(id)
#else
#define REPL(id) _Pragma("unroll 1") for (int rep_ = 0; rep_ < (((id) == REP_PH) ? REP_N : 1); ++rep_)
#endif
#define SEAM(k) xcd_barrier(bar)

    REPL(19) if (EN(19) && IN(0)) { const int l = 0; PHASE_BEGIN; (void)l_; (void)G; (void)bid;
        ph_prologue(wv, (const int*)INP(1), INP(3), WP(float, O_COS), WP(float, O_SIN), WP(float, O_LB), INP(0), WP(bf16, O_XB), INP(2), INP(14), INP(19), INP(21),
                    WP(bf16, O_WIN), WP(bf16, O_WOUT), WP(bf16, O_WUP), WP(bf16, O_WDN), INP(7), WP(bf16, O_WB), INP(10), INP(11), WP(bf16, O_W1T), WP(float, O_CBIAS), INP(12), WP(bf16, O_W2T), INP(17), WP(bf16, O_RWH), WP(bf16, O_RWL)); }
    xcd_barrier_first(bar);

#pragma unroll 1
    for (int l = 0; l < DEPTH; ++l) {
        REPL(0) if (EN(0) && IN(pb + 0)) {
            PHASE_BEGIN;
            pg8::PlainOrder S{WP(bf16, O_WIN) + (size_t)l_ * HS * D_, D_, NT / 256, HS / 256, G, bid};
            pg8::EpiBf16 E{WP(bf16, O_HB), HS, nullptr, 0};
            pg8::gemm_phase<pg8::EpiBf16, pg8::PlainOrder, true>(wv, ldsl, WP(bf16, O_XB), D_ * 2, S, E);
#ifdef DUP_WIN
            pg8::gemm_phase<pg8::EpiBf16, pg8::PlainOrder, true>(wv, ldsl, WP(bf16, O_XB), D_ * 2, S, E);
#endif
        }
        SEAM(pb + 0);
        REPL(1) if (EN(1)) {
            PHASE_BEGIN; (void)G; (void)bid;
            ph_mix1(wv, WP(bf16, O_HB), WP(float, O_LB) + l_ * 256, WP(bf16, O_HQT), WP(bf16, O_HKT), WP(bf16, O_HQP), WP(bf16, O_HVT), WP(float, O_HUT), WP(float, O_HDK),
                    INP(5) + l_ * 256, INP(6) + l_ * 256, WP(bf16, O_VLNT), WP(bf16, O_W1T) + (size_t)l_ * 2 * 128 * 2048, WP(float, O_CBIAS) + l_ * 256, WP(bf16, O_W2T) + (size_t)l_ * 2 * 64 * 128,
                    WP(bf16, O_KCB), WP(bf16, O_VCB), WP(float, O_COS), WP(float, O_SIN), WP(bf16, O_KSB), WP(bf16, O_VSB), WP(bf16, O_KWB), WP(bf16, O_VWB),
                    INP(19) + (size_t)l_ * NE * D_ * 2048, INP(21) + (size_t)l_ * NE * D_ * D_, WP(unsigned char, O_WUP) + (size_t)l_ * NE * 2048 * D_, WP(unsigned char, O_WDN) + (size_t)l_ * NE * D_ * D_);
        }
        SEAM(pb + 1);
        REPL(11) if (EN(11)) {
            PHASE_BEGIN; (void)G; (void)bid;
            ph_mix2(wv, WP(float, O_HUT), WP(float, O_HDK), WP(bf16, O_HST), WP(bf16, O_HB), WP(bf16, O_VLNT), WP(bf16, O_WB) + (size_t)l_ * 4 * 128 * 128, INP(8) + l_ * 512, INP(9) + l_ * 256, WP(bf16, O_YCAT));
        }
        SEAM(pb + 1);
        {
            PHASE_BEGIN;
            REPL(2) if (EN(2)) ph_hg3(wv, WP(bf16, O_HB), WP(bf16, O_HQT), WP(bf16, O_HKT), WP(bf16, O_HQP), WP(bf16, O_HVT), WP(bf16, O_HST), INP(4) + l_ * 256, WP(bf16, O_YCAT));
            REPL(12) if (EN(12)) {
                nsa::Params NP{WP(bf16, O_HB), WP(bf16, O_KCB), WP(bf16, O_VCB), WP(bf16, O_KSB), WP(bf16, O_VSB), WP(bf16, O_KWB), WP(bf16, O_VWB), WP(float, O_COS), WP(float, O_SIN), INP(13) + l_ * 512, WP(bf16, O_YCAT)};
                int tid = mk_tid(wv); asm volatile("" : "+v"(tid));
                __syncthreads();
                nsa::phase(NP, ldsl, tid, bid, G);
            }
        }
        SEAM(pb + 2);
        REPL(3) if (EN(3) && IN(pb + 3)) {
            PHASE_BEGIN;
            pg8::PlainOrder S{WP(bf16, O_WOUT) + (size_t)l_ * D_ * D_, D_, NT / 256, D_ / 256, G, bid};
            pg8::EpiBf16 E{WP(bf16, O_MIXB), D_, nullptr, 0};
            pg8::gemm_phase<pg8::EpiBf16, pg8::PlainOrder, true>(wv, ldsl, WP(bf16, O_YCAT), D_ * 2, S, E);
#ifdef DUP_WOUT
            pg8::gemm_phase<pg8::EpiBf16, pg8::PlainOrder, true>(wv, ldsl, WP(bf16, O_YCAT), D_ * 2, S, E);
#endif
        }
        SEAM(pb + 3);
        if (EN(4)) {
            PHASE_BEGIN; (void)G; (void)bid;
            ph_ln1_route(wv, l_ == 0 ? INP(0) : (const float*)nullptr, WP(bf16, O_XB), WP(bf16, O_MIXB), INP(15) + l_ * D_, INP(16) + l_ * D_, WP(bf16, O_X1B), WP(unsigned char, O_X1Q),
                         WP(bf16, O_RWH) + (size_t)l_ * NE * D_, WP(bf16, O_RWL) + (size_t)l_ * NE * D_, INP(18) + l_ * NE,
                         (int*)(ws_ + 32768) + l_ * 64, WP(int, O_LIST), WP(int, O_TE), WP(int, O_TS), WP(float, O_TW));
        }
        SEAM(pb + 4);
        if (IN(pb + 5) || IN(pb + 6) || IN(pb + 7)) {
            PHASE_BEGIN; (void)G; (void)bid;
            int* cnt = (int*)(ws_ + 32768) + l_ * 64;
            __syncthreads();
            if (wv == 0) {
                const int ln = mk_tid(wv) & 63, e = ln & 31;
                const int c = __hip_atomic_load(&cnt[e], __ATOMIC_RELAXED, __HIP_MEMORY_SCOPE_AGENT);
                const int nt_ = (c + 255) >> 8; int incl = nt_;
#pragma unroll
                for (int o = 1; o < 32; o <<= 1) { const int v = __shfl_up(incl, o, 32); if (e >= o) incl += v; }
                if (ln < 32) { tstart[e] = incl - nt_; offs_s[e] = (incl - nt_) * 256; cnts[e] = c; if (e == 31) tstart[32] = incl; }
            }
            __syncthreads();
        }
        REPL(5) if (EN(5) && IN(pb + 5)) {
            PHASE_BEGIN;
            pg8::MoeOrder<true> S{WP(unsigned char, O_WUP) + (size_t)l_ * NE * 2048 * D_, D_, 8, G, bid, (size_t)2048 * D_, tstart, cnts, WP(int, O_LIST)};
            pg8::EpiUpF8 E{WP(unsigned char, O_ACT), INP(20) + (size_t)l_ * NE * 2048};
            pg8::gemm_phase<pg8::EpiUpF8, pg8::MoeOrder<true>, true, true>(wv, ldsl, WP(unsigned char, O_X1Q), D_, S, E);
        }
        SEAM(pb + 5);
        REPL(6) if (EN(6) && IN(pb + 6)) {
            PHASE_BEGIN;
            pg8::MoeOrder<false> S{WP(unsigned char, O_WDN) + (size_t)l_ * NE * D_ * D_, D_, 4, G, bid, (size_t)D_ * D_, tstart, cnts, WP(int, O_LIST)};
            pg8::EpiDnF8 E{WP(bf16, O_YB), INP(22) + (size_t)l_ * NE * D_};
            pg8::gemm_phase<pg8::EpiDnF8, pg8::MoeOrder<false>, true, true>(wv, ldsl, WP(unsigned char, O_ACT), D_, S, E);
        }
        SEAM(pb + 6);
        REPL(7) if (EN(7) && IN(pb + 7)) {
            PHASE_BEGIN; (void)G; (void)bid;
            ph_comb(wv, WP(bf16, O_X1B), WP(bf16, O_YB), WP(int, O_TE), WP(int, O_TS), WP(float, O_TW), INP(23) + l_ * D_, INP(24) + l_ * D_,
                    (l_ == DEPTH - 1) ? ap->out : (float*)nullptr, (l_ == DEPTH - 1) ? (bf16*)nullptr : WP(bf16, O_XB));
        }
#ifdef XTRA_BAR
#pragma unroll 1
        for (int xb_ = 0; xb_ < XTRA_BAR; ++xb_) SEAM(pb + 7);
#endif
        if (l + 1 < DEPTH) SEAM(pb + 7);
    }
#undef IN
#undef SEAM
}
}

extern "C" void kernel_launch(void* const* d_in, const int* in_sizes, int n_in, void* d_out, int out_size, void* d_ws, size_t ws_size, hipStream_t stream) {
    using namespace mk;
    static int grid = 0;
    if (grid == 0) {
        size_t need = WS_NEED;
        if (n_in != 25 || need > ws_size) { fprintf(stderr, "kernel_launch: bad args n_in %d need %zu ws %zu\n", n_in, need, ws_size); grid = -1; return; }
        int dev = 0, cus = 0, per_cu = 0;
        if (hipGetDevice(&dev) != hipSuccess || hipDeviceGetAttribute(&cus, hipDeviceAttributeMultiprocessorCount, dev) != hipSuccess) { grid = -1; return; }
        if (hipFuncSetAttribute((const void*)mega, hipFuncAttributeMaxDynamicSharedMemorySize, LDS_BYTES) != hipSuccess) { fprintf(stderr, "hipFuncSetAttribute failed\n"); grid = -1; return; }
        if (hipOccupancyMaxActiveBlocksPerMultiprocessor(&per_cu, (const void*)mega, NTHR, LDS_BYTES) != hipSuccess || per_cu < 1) fprintf(stderr, "occupancy query: %d\n", per_cu);
        (void)hipGetLastError();
        grid = cus;
    }
    if (grid < 0) return;
    if (hipMemsetAsync(d_ws, 0, CTL_BYTES, stream) != hipSuccess) return;
    Args a{};
    for (int i = 0; i < 25; ++i) a.in[i] = (const float*)d_in[i];
    a.out = (float*)d_out; a.ws = (unsigned char*)d_ws; a.ph_lo = 0; a.ph_hi = 1 + DEPTH * NPH;
    hipLaunchKernelGGL(mega, dim3(grid), dim3(NTHR), LDS_BYTES, stream, a);
}
```

```cpp
#include <hip/hip_runtime.h>
#include <cstdio>
#include <cstdint>
#include <cmath>

__device__ __forceinline__ int mk_tid(int wv) { int lane; asm volatile("v_mbcnt_lo_u32_b32 %0, -1, 0\n\tv_mbcnt_hi_u32_b32 %0, -1, %0" : "=v"(lane)); return (wv << 6) | lane; }
#define XB_TMO      128
#define XB_XCNT(j)  (256  + 64 * (j))
#define XB_XSUB(j)  (1280 + 64 * (j))
#define XB_XGEN(j)  (2304 + 64 * (j))
#define XB_TOP      3328
#define XB_TOPGEN   3392
#define XCD_BAR_WORDS 3456
#define XB_SPIN_CAP (1u << 18)
#define LAS __attribute__((address_space(3)))

__device__ __forceinline__ unsigned xb_ld(unsigned* p)              { return __hip_atomic_load(p, __ATOMIC_RELAXED, __HIP_MEMORY_SCOPE_AGENT); }
__device__ __forceinline__ unsigned xb_add(unsigned* p, unsigned v) { return __hip_atomic_fetch_add(p, v, __ATOMIC_RELAXED, __HIP_MEMORY_SCOPE_AGENT); }
__device__ __forceinline__ unsigned xb_xcc_id() { return (unsigned)__builtin_amdgcn_s_getreg((3 << 11) | 20) & 0xFu; }
#define XB_SPIN(cond, bar) do { unsigned _sp = 0; while (cond) { __builtin_amdgcn_s_sleep(1); \
    if ((++_sp & 255u) == 0u) { if (xb_ld(&(bar)[XB_TMO])) break; if (_sp > XB_SPIN_CAP) { atomicAdd(&(bar)[XB_TMO], 1u); break; } } } } while (0)

struct XcdBarrier {
    unsigned* bar; unsigned x;
    volatile LAS unsigned* st; int wv;
};

__device__ __forceinline__ XcdBarrier xcd_barrier_post(unsigned* bar, volatile LAS unsigned* st, int wv) {
    XcdBarrier b; b.bar = bar; b.x = xb_xcc_id(); b.st = st; b.wv = wv;
    if (mk_tid(b.wv) == 0) (void)xb_add(&bar[XB_XCNT(b.x)], 1u);
    return b;
}
__device__ __forceinline__ void xcd_barrier_complete(unsigned* bar, unsigned x, unsigned& nloc, unsigned& nx) {
    const unsigned G = gridDim.x * gridDim.y * gridDim.z;
    unsigned sum, cnt, mine, sp = 0u;
    for (;;) {
        sum = 0u; cnt = 0u; mine = 0u;
#pragma unroll
        for (unsigned j = 0; j < 16; ++j) { const unsigned c = xb_ld(&bar[XB_XCNT(j)]); sum += c; cnt += (c > 0u) ? 1u : 0u; mine = (j == x) ? c : mine; }
        if (sum == G) break;
        __builtin_amdgcn_s_sleep(1);
        if ((++sp & 255u) == 0u) { if (xb_ld(&bar[XB_TMO])) break; if (sp > XB_SPIN_CAP) { atomicAdd(&bar[XB_TMO], 1u); break; } }
    }
    nloc = mine > 0u ? mine : 1u; nx = cnt > 0u ? cnt : 1u;
}

template <bool FIRST>
__device__ __forceinline__ void xcd_barrier_t(const XcdBarrier& b) {
    asm volatile("s_waitcnt vmcnt(0)" ::: "memory");
    __syncthreads();
    if (mk_tid(b.wv) == 0) {
        unsigned* bar = b.bar; unsigned bx = b.x; asm volatile("" : "+s"(bar), "+s"(bx));
        __builtin_amdgcn_s_waitcnt(0);
        unsigned nloc = b.st[0], nx = b.st[1];
        if (FIRST) { if (nloc == 0u) { xcd_barrier_complete(bar, bx, nloc, nx); b.st[0] = nloc; b.st[1] = nx; } }
        const unsigned old = xb_add(&bar[XB_XSUB(bx)], 1u);
        const unsigned gen = old / nloc;
        if (old + 1u == (gen + 1u) * nloc) {
            __builtin_amdgcn_fence(__ATOMIC_RELEASE, "agent");
            asm volatile("s_waitcnt vmcnt(0)" ::: "memory");
            const unsigned og = xb_add(&bar[XB_TOP], 1u);
            const unsigned tg = og / nx;
            if (og + 1u == (tg + 1u) * nx) xb_add(&bar[XB_TOPGEN], 1u);
            else XB_SPIN(xb_ld(&bar[XB_TOPGEN]) == tg, bar);
            __builtin_amdgcn_fence(__ATOMIC_ACQUIRE, "agent");
            xb_add(&bar[XB_XGEN(bx)], 1u);
            asm volatile("s_waitcnt vmcnt(0)" ::: "memory");
        } else {
            XB_SPIN(xb_ld(&bar[XB_XGEN(bx)]) == gen, bar);
            __builtin_amdgcn_fence(__ATOMIC_ACQUIRE, "agent");
            asm volatile("s_waitcnt vmcnt(0)" ::: "memory");
        }
    }
    __syncthreads();
}


__device__ __forceinline__ void xcd_barrier_first(const XcdBarrier& b) { xcd_barrier_t<true>(b); }
__device__ __forceinline__ void xcd_barrier(const XcdBarrier& b) { xcd_barrier_t<false>(b); }


namespace mk {
constexpr int B_ = 8, S_ = 4096, D_ = 1024, NT = B_ * S_, DEPTH = 2;
constexpr int INW = 2840, HS = 3072;
constexpr int C_HGQ = 0, C_HGF = 256, C_HGI = 512, C_HGG = 768, C_GMU = 1024, C_GMV = 1280, C_NQ = 1536,
              C_KC = 2048, C_VC = 2176, C_KS = 2304, C_VS = 2432, C_KW = 2560, C_VW = 2688, C_NG = 2816;
constexpr int NCMP = 255, NE = 32, TOPK = 4, NASSIGN = NT * TOPK;
constexpr float ALPHA = 1.4142135623730951f;
constexpr int NTHR = 512, LDS_BYTES = 147456, MISC_OFF = 144 * 1024 - 256;
constexpr int NPH = 8;

typedef unsigned short bf16;
__device__ __forceinline__ float bf2f(bf16 v) { return __uint_as_float((unsigned)v << 16); }
__device__ __forceinline__ unsigned f2bf(float f) { unsigned u = __float_as_uint(f); return (u + 0x7fffu + ((u >> 16) & 1u)) >> 16; }
__device__ __forceinline__ unsigned pk2(float lo, float hi) { return f2bf(lo) | (f2bf(hi) << 16); }
__device__ __forceinline__ float gelu_t(float x) { return 0.5f * x * (1.0f + tanhf(0.7978845608028654f * (x + 0.044715f * x * x * x))); }
__device__ __forceinline__ float sigm(float x) { return 1.0f / (1.0f + expf(-x)); }
__device__ __forceinline__ float wsum(float v) {
#pragma unroll
    for (int o = 1; o < 64; o <<= 1) v += __shfl_xor(v, o);
    return v;
}
__device__ __forceinline__ float wmax(float v) {
#pragma unroll
    for (int o = 1; o < 64; o <<= 1) v = fmaxf(v, __shfl_xor(v, o));
    return v;
}

constexpr int MROWS = NASSIGN + NE * 256;
constexpr size_t CTL_BYTES = 65536;
constexpr size_t al256(size_t x) { return (x + 255) & ~(size_t)255; }
constexpr size_t O_COS = CTL_BYTES, O_SIN = O_COS + al256((size_t)NT * 32 * 4), O_LB = O_SIN + al256((size_t)NT * 32 * 4);
constexpr size_t O_WIN = O_LB + al256(512 * 4), O_WOUT = O_WIN + al256((size_t)DEPTH * HS * D_ * 2), O_WUP = O_WOUT + al256((size_t)DEPTH * D_ * D_ * 2);
constexpr size_t O_WDN = O_WUP + al256((size_t)DEPTH * NE * 2048 * D_ * 2), O_XB = O_WDN + al256((size_t)DEPTH * NE * D_ * D_ * 2);
constexpr size_t O_HB = O_XB + al256((size_t)NT * D_ * 2), O_YCAT = O_HB + al256((size_t)NT * HS * 2), O_MIXB = O_YCAT + al256((size_t)NT * D_ * 2);
constexpr size_t O_X1B = O_MIXB + al256((size_t)NT * D_ * 2), O_ACT = O_X1B + al256((size_t)NT * D_ * 2), O_YB = O_ACT + al256((size_t)MROWS * D_ * 2);
constexpr size_t O_X1Q = O_YB + al256((size_t)MROWS * D_ * 2), O_XA = O_X1Q + al256((size_t)NT * D_ * 4);
constexpr size_t O_VLNT = O_XA + al256((size_t)NT * D_ * 4), O_WB = O_VLNT + al256((size_t)NT * 256 * 2), O_W1T = O_WB + al256((size_t)DEPTH * 4 * 128 * 128 * 2);
constexpr size_t O_CBIAS = O_W1T + al256((size_t)DEPTH * 2 * 128 * 2048 * 2), O_W2T = O_CBIAS + al256((size_t)DEPTH * 2 * 128 * 4), O_RWH = O_W2T + al256((size_t)DEPTH * 2 * 64 * 128 * 2), O_RWL = O_RWH + al256((size_t)DEPTH * NE * D_ * 2), O_HQT = O_RWL + al256((size_t)DEPTH * NE * D_ * 2);
constexpr size_t HGB = (size_t)2048 * 4096 * 2;
constexpr size_t O_HKT = O_HQT + HGB, O_HQP = O_HKT + HGB, O_HVT = O_HQP + HGB, O_HST = O_HVT + HGB, O_HUT = O_HST + HGB, O_HDK = O_HUT + 2 * HGB;
constexpr size_t O_KSB = O_HDK + al256((size_t)2048 * 64 * 4), O_VSB = O_KSB + al256((size_t)NT * 128 * 2);
constexpr size_t O_KWB = O_VSB + al256((size_t)NT * 128 * 2), O_VWB = O_KWB + al256((size_t)NT * 128 * 2), O_KCB = O_VWB + al256((size_t)NT * 128 * 2), O_VCB = O_KCB + al256((size_t)B_ * 2 * 256 * 64 * 2);
constexpr size_t O_LIST = O_VCB + al256((size_t)B_ * 2 * 256 * 64 * 2), O_TE = O_LIST + al256((size_t)NE * NT * 4), O_TS = O_TE + al256((size_t)NASSIGN * 4), O_TW = O_TS + al256((size_t)NASSIGN * 4);
constexpr size_t O_WIN8 = O_TW + al256((size_t)NASSIGN * 4);
constexpr size_t WS_NEED = O_WIN8 + al256((size_t)DEPTH * HS * D_);
namespace pg8 {
#define PG8_LAS __attribute__((address_space(3)))
typedef unsigned short bf16_t;
typedef short bf16x8 __attribute__((ext_vector_type(8)));
typedef float f32x4 __attribute__((ext_vector_type(4)));
typedef float f32x2 __attribute__((ext_vector_type(2)));
typedef unsigned u32x4 __attribute__((ext_vector_type(4)));
constexpr int BM = 256, BK = 64, HALF = 128, HTB = HALF * BK * 2  , STAGE_BYTES = 8 * HTB, NXCD = 8, WGM = 8;

__host__ __device__ __forceinline__ int lds_byte(int r, int c) { const int st = (r >> 4) * 2 + (c >> 5), rr = r & 15, cc = c & 31, ob = rr * 64 + cc * 2; return st * 1024 + (ob ^ (((ob >> 9) & 1) << 5)); }
__host__ __device__ __forceinline__ void stage_rc(int b, int& R, int& C) { const int st = b / 1024, sb = b % 1024, swz = sb ^ (((sb >> 9) & 1) << 5); R = (st >> 1) * 16 + swz / 64; C = (st & 1) * 32 + (swz % 64) / 2; }
__host__ __device__ __forceinline__ int perm32(int rho) { const int n = rho >> 4, i = rho & 15; return 8 * (i >> 2) + 4 * n + (i & 3); }

struct Unit { int pm, pn, e, mt, cnt; };

__device__ __forceinline__ void deal(int L, int nM, int nN, int& pm, int& pn) {
    const int nwg = nM * nN;
    int wgid = L; { const int q = nwg / NXCD, r = nwg % NXCD, xcd = wgid % NXCD, off = wgid / NXCD; wgid = (xcd < r ? xcd * (q + 1) : r * (q + 1) + (xcd - r) * q) + off; }
    const int nig = WGM * nN, gid = wgid / nig, fm = gid * WGM, gsz = (nM - fm) < WGM ? (nM - fm) : WGM;
    pm = fm + ((wgid % nig) % gsz); pn = (wgid % nig) / gsz;
}
struct PlainOrder {
    static constexpr bool GATHERED = false;
    const void* Bt; int rowb; int nM, nN, G, c; int pn0;
    __device__ __forceinline__ bool next(int i, Unit& u) const { const long L = (long)i * G + c; if (L >= (long)nM * nN) return false; deal((int)L, nM, nN, u.pm, u.pn); u.pn += pn0; u.e = 0; u.mt = 0; u.cnt = 0; return true; }
    __device__ __forceinline__ unsigned a_row(const Unit& u, int r) const { return (unsigned)(u.pm * BM + r); }
    __device__ __forceinline__ const char* b_base(const Unit& u) const { return (const char*)Bt + (size_t)u.pn * BM * rowb; }
};
template <bool GATHER> struct MoeOrder {
    static constexpr bool GATHERED = GATHER;
    const void* Bt; int rowb; int nN, G, c; size_t estrideb;
    const int* tstart; const int* cnts; const int* list;
    __device__ __forceinline__ bool next(int i, Unit& u) const {
        const int nM = tstart[32]; const long L = (long)i * G + c; if (L >= (long)nM * nN) return false;
        deal((int)L, nM, nN, u.pm, u.pn);
        const int ln = (int)__builtin_amdgcn_mbcnt_hi(~0u, __builtin_amdgcn_mbcnt_lo(~0u, 0u));
        const int ts = tstart[ln & 31];
        const int e = __popcll(__ballot(ln < 32 && ts <= u.pm)) - 1;
        u.e = e; u.mt = u.pm - tstart[e]; u.cnt = cnts[e]; return true;
    }
    __device__ __forceinline__ unsigned a_row(const Unit& u, int r) const {
        if (GATHER) { const int slot = u.mt * BM + r; return (unsigned)list[u.e * 32768 + (slot < u.cnt ? slot : u.cnt - 1)]; }
        return (unsigned)(u.pm * BM + r);
    }
    __device__ __forceinline__ const char* b_base(const Unit& u) const { return (const char*)Bt + (size_t)u.e * estrideb + (size_t)u.pn * BM * rowb; }
};

__device__ __forceinline__ unsigned cvt_pk_bf16(float lo, float hi) { unsigned r; asm volatile("v_cvt_pk_bf16_f32 %0, %1, %2" : "=v"(r) : "v"(lo), "v"(hi)); return r; }

struct EpiBf16 {
    static constexpr bool PERM = true;
    bf16_t* O; int ldc; const float* bias; int bstride; float scale;
    __device__ __forceinline__ void operator()(const f32x4 (&acc)[2][2][4][2], const Unit& u, int wr, int wc, int fr, int fq) const {
        const int row0 = u.pm * BM + wr * 64 + fr; const int col0 = u.pn * BM + wc * 32 + 8 * fq;
        f32x4 bv[2][2];
#pragma unroll
        for (int bj = 0; bj < 2; ++bj)
#pragma unroll
            for (int n = 0; n < 2; ++n) bv[bj][n] = bias ? *(const f32x4*)(bias + (size_t)u.e * bstride + col0 + bj * HALF + 4 * n) : (f32x4){0.f, 0.f, 0.f, 0.f};
#pragma unroll
        for (int ai = 0; ai < 2; ++ai)
#pragma unroll
            for (int m = 0; m < 4; ++m) { bf16_t* rowp = O + (size_t)(row0 + ai * HALF + m * 16) * ldc + col0;
#pragma unroll
                for (int bj = 0; bj < 2; ++bj) { f32x4 v0 = acc[ai][bj][m][0] * scale + bv[bj][0], v1 = acc[ai][bj][m][1] * scale + bv[bj][1];
                    u32x4 w; w.x = cvt_pk_bf16(v0[0], v0[1]); w.y = cvt_pk_bf16(v0[2], v0[3]); w.z = cvt_pk_bf16(v1[0], v1[1]); w.w = cvt_pk_bf16(v1[2], v1[3]);
                    *(u32x4*)(rowp + bj * HALF) = w; } }
    }
};
__device__ __forceinline__ float swiglu1(float g, float l) {
    g = fminf(g, 7.0f); l = fminf(fmaxf(l, -7.0f), 7.0f);
    const float s = __builtin_amdgcn_rcpf(1.0f + __builtin_amdgcn_exp2f(-1.702f * 1.4426950408889634f * g));
    return g * s * (l + 1.0f);
}
struct EpiUp {
    static constexpr bool PERM = true;
    bf16_t* O; const float* bias;
    __device__ __forceinline__ void operator()(const f32x4 (&acc)[2][2][4][2], const Unit& u, int wr, int wc, int fr, int fq) const {
        const int row0 = u.pm * BM + wr * 64 + fr; const int j0 = u.pn * HALF + wc * 32 + 8 * fq;
        const float* bp = bias + (size_t)u.e * 2048 + j0;
        f32x4 bg[2], bl[2];
#pragma unroll
        for (int n = 0; n < 2; ++n) { bg[n] = *(const f32x4*)(bp + 4 * n); bl[n] = *(const f32x4*)(bp + 1024 + 4 * n); }
#pragma unroll
        for (int ai = 0; ai < 2; ++ai)
#pragma unroll
            for (int m = 0; m < 4; ++m) {
                float o[8];
#pragma unroll
                for (int n = 0; n < 2; ++n) { const f32x4 g = acc[ai][0][m][n] + bg[n], l = acc[ai][1][m][n] + bl[n];
#pragma unroll
                    for (int j = 0; j < 4; ++j) o[4 * n + j] = swiglu1(g[j], l[j]); }
                u32x4 w; w.x = cvt_pk_bf16(o[0], o[1]); w.y = cvt_pk_bf16(o[2], o[3]); w.z = cvt_pk_bf16(o[4], o[5]); w.w = cvt_pk_bf16(o[6], o[7]);
                *(u32x4*)(O + (size_t)(row0 + ai * HALF + m * 16) * 1024 + j0) = w; }
    }
};

constexpr float F8_SU = 64.0f, F8_SA = 4.0f, F8_SD = 128.0f, F8_SI = 64.0f;
__device__ __forceinline__ unsigned pk4_fp8(float a, float b, float c, float d) {
    a = fminf(fmaxf(a, -448.f), 448.f); b = fminf(fmaxf(b, -448.f), 448.f); c = fminf(fmaxf(c, -448.f), 448.f); d = fminf(fmaxf(d, -448.f), 448.f);
    int p = __builtin_amdgcn_cvt_pk_fp8_f32(a, b, 0, false); p = __builtin_amdgcn_cvt_pk_fp8_f32(c, d, p, true); return (unsigned)p;
}
struct EpiUpF8 {
    static constexpr bool PERM = true;
    unsigned char* O; const float* bias;
    __device__ __forceinline__ void operator()(const f32x4 (&acc)[2][2][4][2], const Unit& u, int wr, int wc, int fr, int fq) const {
        const int row0 = u.pm * BM + wr * 64 + fr; const int j0 = u.pn * HALF + wc * 32 + 8 * fq;
        const float* bp = bias + (size_t)u.e * 2048 + j0;
        f32x4 bg[2], bl[2];
#pragma unroll
        for (int n = 0; n < 2; ++n) { bg[n] = *(const f32x4*)(bp + 4 * n); bl[n] = *(const f32x4*)(bp + 1024 + 4 * n); }
        const int odd = fq & 1;
        unsigned char* obase = O + (size_t)(row0 + 16 * odd) * 1024 + j0 - 8 * odd;
#pragma unroll
        for (int ai = 0; ai < 2; ++ai)
#pragma unroll
            for (int mp = 0; mp < 2; ++mp) {
                unsigned w[2][2];
#pragma unroll
                for (int mm = 0; mm < 2; ++mm)
#pragma unroll
                    for (int n = 0; n < 2; ++n) { const int m = 2 * mp + mm; const f32x4 g = acc[ai][0][m][n] * (1.0f / F8_SU) + bg[n], l = acc[ai][1][m][n] * (1.0f / F8_SU) + bl[n];
                        w[mm][n] = pk4_fp8(F8_SA * swiglu1(g[0], l[0]), F8_SA * swiglu1(g[1], l[1]), F8_SA * swiglu1(g[2], l[2]), F8_SA * swiglu1(g[3], l[3])); }
                const auto r0 = __builtin_amdgcn_permlane16_swap(w[0][0], w[1][0], false, false);
                const auto r1 = __builtin_amdgcn_permlane16_swap(w[0][1], w[1][1], false, false);
                u32x4 ww = {r0[0], r1[0], r0[1], r1[1]};
                *(u32x4*)(obase + (size_t)(ai * HALF + mp * 32) * 1024) = ww; }
    }
};
struct EpiDnF8 {
    static constexpr bool PERM = true;
    bf16_t* O; const float* bias;
    __device__ __forceinline__ void operator()(const f32x4 (&acc)[2][2][4][2], const Unit& u, int wr, int wc, int fr, int fq) const {
        const int row0 = u.pm * BM + wr * 64 + fr; const int col0 = u.pn * BM + wc * 32 + 8 * fq;
        f32x4 bv[2][2];
#pragma unroll
        for (int bj = 0; bj < 2; ++bj)
#pragma unroll
            for (int n = 0; n < 2; ++n) bv[bj][n] = *(const f32x4*)(bias + (size_t)u.e * 1024 + col0 + bj * HALF + 4 * n);
#pragma unroll
        for (int ai = 0; ai < 2; ++ai)
#pragma unroll
            for (int m = 0; m < 4; ++m) { bf16_t* rowp = O + (size_t)(row0 + ai * HALF + m * 16) * 1024 + col0;
#pragma unroll
                for (int bj = 0; bj < 2; ++bj) { f32x4 v0 = acc[ai][bj][m][0] * (1.0f / (F8_SA * F8_SD)) + bv[bj][0], v1 = acc[ai][bj][m][1] * (1.0f / (F8_SA * F8_SD)) + bv[bj][1];
                    u32x4 w; w.x = cvt_pk_bf16(v0[0], v0[1]); w.y = cvt_pk_bf16(v0[2], v0[3]); w.z = cvt_pk_bf16(v1[0], v1[1]); w.w = cvt_pk_bf16(v1[2], v1[3]);
                    *(u32x4*)(rowp + bj * HALF) = w; } }
    }
};

typedef int v8i32 __attribute__((ext_vector_type(8)));
__device__ __forceinline__ v8i32 pg8_join(const bf16x8 lo, const bf16x8 hi) { typedef int v4i32 __attribute__((ext_vector_type(4)));
    const v4i32 a = __builtin_bit_cast(v4i32, lo), b = __builtin_bit_cast(v4i32, hi); return __builtin_shufflevector(a, b, 0, 1, 2, 3, 4, 5, 6, 7); }
template <class Epi, class Sched, bool ALIGN_EPI, bool F8 = false>
__device__ __forceinline__ void gemm_phase(const int wv, PG8_LAS unsigned char* lds, const void* Abase, const int Kb  , const Sched& S, const Epi& E) {
    int tid = mk_tid(wv); asm volatile("" : "+v"(tid));
    const int wid = __builtin_amdgcn_readfirstlane(tid >> 6), lane = tid & 63, wr = wid >> 2, wc = wid & 3, fr = lane & 15, fq = lane >> 4;
#ifdef DUP_K
    const int nt0 = Kb / 128, nt = 2 * nt0;
#define PG8_KT(t) ((t) % nt0)
#else
    const int nt = Kb / 128;
#define PG8_KT(t) (t)
#endif
    const char* Ab = (const char*)Abase;
    unsigned voffB[2];
#pragma unroll
    for (int i = 0; i < 2; ++i) { int R, C; stage_rc(tid * 16 + i * 8192, R, C); const int Rb = Epi::PERM ? ((R & ~31) + perm32(R & 31)) : R;
        voffB[i] = (unsigned)(Rb * Kb + C * 2); }
    const size_t kstep = (size_t)(BK * 2);
    const size_t hstep = (size_t)HALF * Kb;
    const unsigned rowb = (unsigned)Kb;
    const unsigned ldsw = (unsigned)wid * 1024u;
    const int aoff = lds_byte(wr * 64 + fr, fq * 8), boff = lds_byte(wc * 32 + fr, fq * 8);
#define PG8_SA(b, h) (((b) * 2 + (h)) * HTB)
#define PG8_SB(b, h) ((4 + (b) * 2 + (h)) * HTB)
#define PG8_STAGE(bufoff, gbase, voff) do { _Pragma("unroll") for (int _i = 0; _i < 2; ++_i) { unsigned _v = (voff)[_i]; asm volatile("" : "+v"(_v)); \
        __builtin_amdgcn_global_load_lds((const unsigned*)((const char*)(gbase) + _v), (PG8_LAS unsigned*)(lds + (bufoff) + ldsw + _i * 8192), 16, 0, 0); } } while (0)
#define PG8_STAGE_A(bufoff, kb, o0, o1) do { unsigned _o0 = (o0), _o1 = (o1); asm volatile("" : "+v"(_o0), "+v"(_o1)); \
        __builtin_amdgcn_global_load_lds((const unsigned*)(Ab + (kb) + _o0), (PG8_LAS unsigned*)(lds + (bufoff) + ldsw), 16, 0, 0); \
        __builtin_amdgcn_global_load_lds((const unsigned*)(Ab + (kb) + _o1), (PG8_LAS unsigned*)(lds + (bufoff) + ldsw + 8192), 16, 0, 0); } while (0)
#define PG8_LDA(dst, b, h) do { if constexpr (F8) { _Pragma("unroll") for (int m = 0; m < 4; ++m) dst##8[m] = pg8_join(*(const PG8_LAS bf16x8*)(lds + PG8_SA(b, h) + aoff + m * 2048), *(const PG8_LAS bf16x8*)(lds + PG8_SA(b, h) + aoff + m * 2048 + 1024)); } \
        else { _Pragma("unroll") for (int m = 0; m < 4; ++m) _Pragma("unroll") for (int k = 0; k < 2; ++k) dst[m][k] = *(const PG8_LAS bf16x8*)(lds + PG8_SA(b, h) + aoff + m * 2048 + k * 1024); } } while (0)
#define PG8_LDB(dst, b, h) do { if constexpr (F8) { _Pragma("unroll") for (int n = 0; n < 2; ++n) dst##8[n] = pg8_join(*(const PG8_LAS bf16x8*)(lds + PG8_SB(b, h) + boff + n * 2048), *(const PG8_LAS bf16x8*)(lds + PG8_SB(b, h) + boff + n * 2048 + 1024)); } \
        else { _Pragma("unroll") for (int n = 0; n < 2; ++n) _Pragma("unroll") for (int k = 0; k < 2; ++k) dst[n][k] = *(const PG8_LAS bf16x8*)(lds + PG8_SB(b, h) + boff + n * 2048 + k * 1024); } } while (0)
#define PG8_MMA(ai, bj, At, Bt) do { __builtin_amdgcn_s_setprio(1); _Pragma("unroll") for (int m = 0; m < 4; ++m) _Pragma("unroll") for (int n = 0; n < 2; ++n) { \
        if constexpr (F8) { acc[ai][bj][m][n] = __builtin_amdgcn_mfma_scale_f32_16x16x128_f8f6f4(Bt##8[n], At##8[m], acc[ai][bj][m][n], 0, 0, 0, 0, 0, 0); } \
        else { _Pragma("unroll") for (int k = 0; k < 2; ++k) acc[ai][bj][m][n] = __builtin_amdgcn_mfma_f32_16x16x32_bf16(Bt[n][k], At[m][k], acc[ai][bj][m][n], 0, 0, 0); } } \
        __builtin_amdgcn_s_setprio(0); } while (0)
#define PG8_WAIT_V(n) asm volatile("s_waitcnt vmcnt(" #n ")" ::: "memory")
#define PG8_WAIT_L(n) asm volatile("s_waitcnt lgkmcnt(" #n ")" ::: "memory")
#define PG8_BAR __builtin_amdgcn_s_barrier()
#define PG8_SCHED __builtin_amdgcn_sched_barrier(0)
#define PG8_AOFFS(dst, u) do { int _t = mk_tid(wv); asm volatile("" : "+v"(_t)); _Pragma("unroll") for (int _i = 0; _i < 2; ++_i) { int _R, _C; stage_rc(_t * 16 + _i * 8192, _R, _C); \
        _Pragma("unroll") for (int _h = 0; _h < 2; ++_h) dst[_h][_i] = S.a_row(u, _h * HALF + _R) * rowb + (unsigned)_C * 2u; } } while (0)
    Unit cur, nxt; int ui = 0;
    if (!S.next(0, cur)) return;
    f32x4 acc[2][2][4][2];
#pragma unroll
    for (int a = 0; a < 2; ++a)
#pragma unroll
        for (int b = 0; b < 2; ++b)
#pragma unroll
            for (int m = 0; m < 4; ++m)
#pragma unroll
                for (int n = 0; n < 2; ++n) acc[a][b][m][n] = (f32x4){0.f, 0.f, 0.f, 0.f};
    bf16x8 At[4][2], B0[2][2], B1[2][2];
    v8i32 At8[4], B08[2], B18[2];
    unsigned aC[2][2], aN[2][2];
    PG8_AOFFS(aC, cur);
    const char* cB = S.b_base(cur);
    PG8_STAGE(PG8_SB(0, 0), cB, voffB); PG8_STAGE(PG8_SB(0, 1), cB + hstep, voffB); PG8_STAGE_A(PG8_SA(0, 0), 0, aC[0][0], aC[0][1]); PG8_STAGE_A(PG8_SA(0, 1), 0, aC[1][0], aC[1][1]);
    if (wr == 1) PG8_BAR;
    PG8_WAIT_V(2); PG8_BAR;
    PG8_STAGE(PG8_SB(1, 0), cB + kstep, voffB); PG8_STAGE_A(PG8_SA(1, 0), kstep, aC[0][0], aC[0][1]); PG8_STAGE(PG8_SB(1, 1), cB + hstep + kstep, voffB);
    PG8_WAIT_V(6); PG8_BAR;
    for (;;) {
        const bool has_next = S.next(ui + 1, nxt);
        const char* nB = has_next ? S.b_base(nxt) : cB;
        if (has_next) { PG8_AOFFS(aN, nxt); }
        else {
#pragma unroll
            for (int _h = 0; _h < 2; ++_h)
#pragma unroll
                for (int _i = 0; _i < 2; ++_i) aN[_h][_i] = aC[_h][_i]; }
#pragma unroll 1
        for (int t = 0; t < nt; t += 2) {
            const bool last = (t == nt - 2);
            const size_t kb1 = (size_t)PG8_KT(t + 1) * kstep;
            PG8_LDB(B0, 0, 0); PG8_LDB(B1, 0, 1); PG8_SCHED; PG8_LDA(At, 0, 0); PG8_STAGE_A(PG8_SA(1, 1), kb1, aC[1][0], aC[1][1]);
            PG8_WAIT_V(8); PG8_WAIT_L(0); PG8_BAR; PG8_MMA(0, 0, At, B0); PG8_MMA(0, 1, At, B1); PG8_BAR; PG8_SCHED;
            if (last) {
#pragma unroll
                for (int _h = 0; _h < 2; ++_h)
#pragma unroll
                    for (int _i = 0; _i < 2; ++_i) aC[_h][_i] = aN[_h][_i]; }
            const size_t kb2 = last ? (size_t)0 : (size_t)PG8_KT(t + 2) * kstep; const char* b2 = last ? nB : cB + (size_t)PG8_KT(t + 2) * kstep;
            const size_t kb3 = kb2 + kstep; const char* b3 = b2 + kstep;
            PG8_LDA(At, 0, 1); PG8_STAGE(PG8_SB(0, 0), b2, voffB); PG8_STAGE(PG8_SB(0, 1), b2 + hstep, voffB); PG8_STAGE_A(PG8_SA(0, 0), kb2, aC[0][0], aC[0][1]);
            PG8_WAIT_V(8); PG8_WAIT_L(0); PG8_BAR; PG8_MMA(1, 0, At, B0); PG8_MMA(1, 1, At, B1); PG8_BAR; PG8_SCHED;
            PG8_LDB(B0, 1, 0); PG8_LDB(B1, 1, 1); PG8_SCHED; PG8_LDA(At, 1, 0); PG8_STAGE_A(PG8_SA(0, 1), kb2, aC[1][0], aC[1][1]);
            PG8_WAIT_V(8); PG8_WAIT_L(0); PG8_BAR; PG8_MMA(0, 0, At, B0); PG8_MMA(0, 1, At, B1); PG8_BAR; PG8_SCHED;
            PG8_LDA(At, 1, 1); PG8_STAGE(PG8_SB(1, 0), b3, voffB); PG8_STAGE(PG8_SB(1, 1), b3 + hstep, voffB); PG8_STAGE_A(PG8_SA(1, 0), kb3, aC[0][0], aC[0][1]);
            PG8_WAIT_V(8); PG8_WAIT_L(0); PG8_BAR; PG8_MMA(1, 0, At, B0); PG8_MMA(1, 1, At, B1); PG8_BAR; PG8_SCHED;
        }
        if (ALIGN_EPI) { if (wr == 0) PG8_BAR; }
#ifdef DUP_K
#pragma unroll
        for (int a = 0; a < 2; ++a)
#pragma unroll
            for (int b = 0; b < 2; ++b)
#pragma unroll
                for (int m = 0; m < 4; ++m)
#pragma unroll
                    for (int n = 0; n < 2; ++n) acc[a][b][m][n] = acc[a][b][m][n] * 0.5f;
#endif
        E(acc, cur, wr, wc, fr, fq);
#ifdef DUP_EPI
        E(acc, cur, wr, wc, fr, fq);
#endif
        if (!has_next) break;
#pragma unroll
        for (int a = 0; a < 2; ++a)
#pragma unroll
            for (int b = 0; b < 2; ++b)
#pragma unroll
                for (int m = 0; m < 4; ++m)
#pragma unroll
                    for (int n = 0; n < 2; ++n) acc[a][b][m][n] = (f32x4){0.f, 0.f, 0.f, 0.f};
        cur = nxt; cB = nB; ++ui;
        if (ALIGN_EPI) { if (wr == 1) PG8_BAR; }
    }
    PG8_WAIT_V(0);
    if (!ALIGN_EPI) { if (wr == 0) PG8_BAR; }
    PG8_BAR;
#undef PG8_SA
#undef PG8_SB
#undef PG8_STAGE
#undef PG8_STAGE_A
#undef PG8_LDA
#undef PG8_LDB
#undef PG8_MMA
#undef PG8_WAIT_V
#undef PG8_WAIT_L
#undef PG8_BAR
#undef PG8_SCHED
#undef PG8_AOFFS
#undef PG8_KT
}
}


#ifndef NSA_REP_RANK
#define NSA_REP_RANK 1
#endif
#ifndef NSA_REP_PASSA
#define NSA_REP_PASSA 1
#endif
#ifndef NSA_REP_LOOP
#define NSA_REP_LOOP 1
#endif
namespace nsa {
#define NLAS __attribute__((address_space(3)))
typedef short bf16x8 __attribute__((ext_vector_type(8)));
typedef short s16x4 __attribute__((ext_vector_type(4)));
typedef short v4i16_t __attribute__((ext_vector_type(4)));
typedef float f32x16 __attribute__((ext_vector_type(16)));
typedef float f32x2_t __attribute__((ext_vector_type(2)));
typedef __bf16 bf16x2_t __attribute__((ext_vector_type(2)));
#define NSA_MFMA(a, b, c) __builtin_amdgcn_mfma_f32_32x32x16_bf16((a), (b), (c), 0, 0, 0)
constexpr int L_CK = 0, L_CV = 32768, L_RING = 65536, L_IMP = 0, SLOTB = 16384, L_SELM = 131072 + 1024;
constexpr float QSCALE = 0.125f * 1.4426950408889634f;
constexpr float NEGBIG = -1.0e30f;

__device__ __forceinline__ unsigned cvtpk(float lo, float hi) { f32x2_t v = {lo, hi}; bf16x2_t b = __builtin_convertvector(v, bf16x2_t); return __builtin_bit_cast(unsigned, b); }
__device__ __forceinline__ float bflo(unsigned u) { return __uint_as_float(u << 16); }
__device__ __forceinline__ float bfhi(unsigned u) { return __uint_as_float(u & 0xffff0000u); }
__device__ __forceinline__ float xhalf(float v) { return __shfl_xor(v, 32); }
__device__ __forceinline__ float xhalf_max(float v) { const auto r = __builtin_amdgcn_permlane32_swap(__float_as_uint(v), __float_as_uint(v), false, false); return fmaxf(__uint_as_float(r[0]), __uint_as_float(r[1])); }
__device__ __forceinline__ float xhalf_sum(float v) { const auto r = __builtin_amdgcn_permlane32_swap(__float_as_uint(v), __float_as_uint(v), false, false); return __uint_as_float(r[0]) + __uint_as_float(r[1]); }
__device__ __forceinline__ s16x4 vtr(const NLAS unsigned char* p) { return __builtin_bit_cast(s16x4, __builtin_amdgcn_ds_read_tr16_b64_v4i16((NLAS v4i16_t*)p)); }
__device__ __forceinline__ bf16x8 pack8(const f32x16& x, int s) {
    unsigned p0 = cvtpk(x[8 * s], x[8 * s + 1]), p1 = cvtpk(x[8 * s + 2], x[8 * s + 3]), p2 = cvtpk(x[8 * s + 4], x[8 * s + 5]), p3 = cvtpk(x[8 * s + 6], x[8 * s + 7]);
    typedef unsigned u32x4 __attribute__((ext_vector_type(4)));
    u32x4 u = {p0, p1, p2, p3}; return __builtin_bit_cast(bf16x8, u);
}

struct Params {
    const unsigned short* hb;
    const unsigned short *kcb, *vcb;
    const unsigned short *ksb, *vsb, *kwb, *vwb;
    const float *cosT, *sinT;
    const float* normw;
    unsigned short* ycat;
};

__device__ __forceinline__ void qk_tile(const NLAS unsigned char* kt, const bf16x8 (&qf)[4], const int (&kofs)[4], f32x16& st0, f32x16& st1) {
    bf16x8 k0[4], k1[4];
#pragma unroll
    for (int ks = 0; ks < 4; ++ks) { k0[ks] = *(const NLAS bf16x8*)(kt + kofs[ks]); k1[ks] = *(const NLAS bf16x8*)(kt + kofs[ks] + 4096); }
#pragma unroll
    for (int i = 0; i < 16; ++i) { st0[i] = 0.f; st1[i] = 0.f; }
#pragma unroll
    for (int ks = 0; ks < 4; ++ks) { st0 = NSA_MFMA(k0[ks], qf[ks], st0); st1 = NSA_MFMA(k1[ks], qf[ks], st1); }
}
__device__ __forceinline__ void pv_tile(const NLAS unsigned char* vt, const int (&vofs)[2][2], const f32x16& p0, const f32x16& p1, f32x16& o0, f32x16& o1) {
    bf16x8 pb[2][2];
#pragma unroll
    for (int kt = 0; kt < 2; ++kt)
#pragma unroll
        for (int s = 0; s < 2; ++s) pb[kt][s] = pack8(kt ? p1 : p0, s);
    bf16x8 va[2][2][2];
#pragma unroll
    for (int kt = 0; kt < 2; ++kt)
#pragma unroll
        for (int s = 0; s < 2; ++s) {
            const int kb = (32 * kt + 16 * s) * 128;
#pragma unroll
            for (int mb = 0; mb < 2; ++mb) {
                const s16x4 lo = vtr(vt + kb + vofs[mb][0]), hi = vtr(vt + kb + vofs[mb][1]);
                va[kt][s][mb] = __builtin_shufflevector(lo, hi, 0, 1, 2, 3, 4, 5, 6, 7);
            }
        }
#pragma unroll
    for (int kt = 0; kt < 2; ++kt)
#pragma unroll
        for (int s = 0; s < 2; ++s) { o0 = NSA_MFMA(va[kt][s][0], pb[kt][s], o0); o1 = NSA_MFMA(va[kt][s][1], pb[kt][s], o1); }
}
__device__ __forceinline__ float max3f(float a, float b, float c) { float r; asm("v_max3_f32 %0, %1, %2, %3" : "=v"(r) : "v"(a), "v"(b), "v"(c)); return r; }
constexpr float NEGINF = -__builtin_inff();
template <bool USE_LO>
__device__ __forceinline__ void mask_tile(f32x16& s0, f32x16& s1, const int hi4, const int lo4) {
#pragma unroll
    for (int i = 0; i < 16; ++i) {
        const int kk0 = (i & 3) + 8 * (i >> 2), kk1 = kk0 + 32;
        bool a0 = kk0 <= hi4, a1 = kk1 <= hi4;
        if (USE_LO) { a0 = a0 && (kk0 >= lo4); a1 = a1 && (kk1 >= lo4); }
        s0[i] = a0 ? s0[i] : NEGINF; s1[i] = a1 ? s1[i] : NEGINF;
    }
}
__device__ __forceinline__ void softmax_core(f32x16& s0, f32x16& s1, float& m, float& l, f32x16& o0, f32x16& o1, const bool live = true) {
    float mx = max3f(s0[0], s0[1], s0[2]);
#pragma unroll
    for (int i = 3; i < 15; i += 2) mx = max3f(mx, s0[i], s0[i + 1]);
    mx = max3f(mx, s0[15], s1[0]);
#pragma unroll
    for (int i = 1; i < 15; i += 2) mx = max3f(mx, s1[i], s1[i + 1]);
    mx = fmaxf(mx, s1[15]);
    mx = xhalf_max(mx);
    const float mn = fmaxf(m, mx);
    const float alpha = __builtin_amdgcn_exp2f(m - mn);
    m = mn;
    const float mref = live ? mn : __builtin_inff();
    float sum0 = 0.f, sum1 = 0.f;
#pragma unroll
    for (int i = 0; i < 16; ++i) {
        const float e0 = __builtin_amdgcn_exp2f(s0[i] - mref), e1 = __builtin_amdgcn_exp2f(s1[i] - mref);
        s0[i] = e0; s1[i] = e1; sum0 += e0; sum1 += e1;
    }
    l = l * alpha + (sum0 + sum1);
    if (__ballot(alpha != 1.0f) != 0ull) {
#pragma unroll
        for (int i = 0; i < 16; ++i) { o0[i] *= alpha; o1[i] *= alpha; }
    }
}

__device__ __forceinline__ void unit(const Params& P, NLAS unsigned char* lds, const int tid_in, const int b, const int g, const int qb) {
    int tid = tid_in; asm volatile("" : "+v"(tid));
    const int wv = __builtin_amdgcn_readfirstlane(tid >> 6), lane = tid & 63, r = lane & 31, h = lane >> 5;
    const int head = g * 4 + (wv >> 1), qi = 32 * (wv & 1) + r;
    const int t = qb * 64 + qi, tok = b * 4096 + t;
    const int bg = b * 2 + g;
    int kofs[4];
#pragma unroll
    for (int ks = 0; ks < 4; ++ks) kofs[ks] = r * 128 + ((((2 * ks + h) ^ ((r >> 1) & 7))) << 4);
    int vofs[2][2];
    { const int i16 = lane & 15, blk = (lane >> 4) & 1, q = i16 >> 2, p = i16 & 3;
#pragma unroll
      for (int mb = 0; mb < 2; ++mb)
#pragma unroll
          for (int jj = 0; jj < 2; ++jj) { const int key = 4 * h + 8 * jj + q; const int o = 4 * mb + 2 * blk + (p >> 1);
              vofs[mb][jj] = key * 128 + ((o ^ (((key >> 1) & 1) << 2)) << 4) + (p & 1) * 8; } }
    const int drow = tid >> 3, dpos = tid & 7;
    const unsigned srcK = (unsigned)(drow * 128 + ((dpos ^ ((drow >> 1) & 7)) << 4));
    const unsigned srcV = (unsigned)(drow * 128 + ((dpos ^ (((drow >> 1) & 1) << 2)) << 4));
    const unsigned wdst = (unsigned)wv * 1024u;
    const unsigned lds0 = (unsigned)(size_t)lds;
#define NSA_DMA(slotoff, gsrc, soff) do { unsigned _keep; const void* _g = (const void*)((const char*)(gsrc) + (soff)); const unsigned _d = (unsigned)__builtin_amdgcn_readfirstlane((int)(lds0 + (unsigned)(slotoff) + wdst)); \
        asm volatile("s_mov_b32 %0, m0\n\ts_mov_b32 m0, %2\n\ts_nop 0\n\tglobal_load_lds_dwordx4 %1, off\n\ts_mov_b32 m0, %0" : "=&s"(_keep) : "v"(_g), "s"(_d) : "memory"); } while (0)
    const int nsel = qb + 1, jw0 = qb >= 8 ? qb - 8 : 0, ntiles = nsel + (qb - jw0 + 1);
    const char* ksg = (const char*)P.ksb + (size_t)bg * 4096 * 128; const char* vsg = (const char*)P.vsb + (size_t)bg * 4096 * 128;
    const char* kwg = (const char*)P.kwb + (size_t)bg * 4096 * 128; const char* vwg = (const char*)P.vwb + (size_t)bg * 4096 * 128;
#define NSA_ISSUE(pos) do { const int _p = (pos) < ntiles ? (pos) : ntiles - 1; const bool _w = _p >= nsel; const int _j = _w ? jw0 + _p - nsel : _p; \
        const int _slot = L_RING + ((pos) & 3) * SLOTB; \
        NSA_DMA(_slot, (_w ? kwg : ksg) + (size_t)_j * 8192, srcK); NSA_DMA(_slot + 8192, (_w ? vwg : vsg) + (size_t)_j * 8192, srcV); } while (0)
    { const char* kcg = (const char*)P.kcb + (size_t)bg * 256 * 128; const char* vcg = (const char*)P.vcb + (size_t)bg * 256 * 128;
#pragma unroll
      for (int T = 0; T < 4; ++T) { NSA_DMA(L_CK + T * 8192, kcg + T * 8192, srcK); NSA_DMA(L_CV + T * 8192, vcg + T * 8192, srcV); } }
    NSA_ISSUE(0); NSA_ISSUE(1);
    typedef unsigned u32x4 __attribute__((ext_vector_type(4)));
    bf16x8 qf[4];
    const unsigned short* qrow = P.hb + (size_t)tok * 3072 + 1536 + (head & 7) * 64;
    {
        u32x4 qraw[4];
#pragma unroll
        for (int ks = 0; ks < 4; ++ks) qraw[ks] = *(const u32x4*)(qrow + 16 * ks + 8 * h);
#pragma unroll
        for (int ks = 0; ks < 4; ++ks) { u32x4 o;
#pragma unroll
            for (int c = 0; c < 4; ++c) o[c] = cvtpk(bflo(qraw[ks][c]) * QSCALE, bfhi(qraw[ks][c]) * QSCALE);
            qf[ks] = __builtin_bit_cast(bf16x8, o); }
    }
    float gc, gs, gw;
    { const unsigned short* gp = P.hb + (size_t)tok * 3072 + 2816 + head * 3;
      gc = 1.f / (1.f + __expf(-__uint_as_float((unsigned)gp[0] << 16))); gs = 1.f / (1.f + __expf(-__uint_as_float((unsigned)gp[1] << 16))); gw = 1.f / (1.f + __expf(-__uint_as_float((unsigned)gp[2] << 16))); }
    asm volatile("s_waitcnt vmcnt(0)" ::: "memory"); __builtin_amdgcn_s_barrier();
    const int cmax = (t >= 31) ? (((t - 31) >> 4) < 254 ? ((t - 31) >> 4) : 254) : -1;
    float m = NEGBIG, l = 0.f;
    f32x16 of0, of1;
#pragma unroll
    for (int i = 0; i < 16; ++i) { of0[i] = 0.f; of1[i] = 0.f; }
    const bool need_sel = qb >= 16;
    float ow[32];
    float carry_in = 0.f;
#pragma unroll
    for (int T = 0; T < 4; ++T) {
        f32x16 s0, s1;
        qk_tile(lds + L_CK + T * 8192, qf, kofs, s0, s1);
        if (__ballot(cmax - 64 * T < 63) != 0ull) mask_tile<false>(s0, s1, cmax - 64 * T - 4 * h, 0);
        float mx = max3f(s0[0], s0[1], s0[2]);
#pragma unroll
        for (int i = 3; i < 15; i += 2) mx = max3f(mx, s0[i], s0[i + 1]);
        mx = max3f(mx, s0[15], s1[0]);
#pragma unroll
        for (int i = 1; i < 15; i += 2) mx = max3f(mx, s1[i], s1[i + 1]);
        mx = xhalf_max(fmaxf(mx, s1[15]));
        const float mn = fmaxf(m, mx), alpha = __builtin_amdgcn_exp2f(m - mn);
        m = mn;
        if (T > 0 && __ballot(alpha != 1.0f) != 0ull) {
#pragma unroll
            for (int i = 0; i < 16; ++i) { of0[i] *= alpha; of1[i] *= alpha; }
#pragma unroll
            for (int idx = 0; idx < 8 * T; ++idx) ow[idx] *= alpha;
            carry_in *= alpha;
        }
        float sum = 0.f;
#pragma unroll
        for (int i = 0; i < 16; ++i) { s0[i] = __builtin_amdgcn_exp2f(s0[i] - mn); s1[i] = __builtin_amdgcn_exp2f(s1[i] - mn); sum += s0[i] + s1[i]; }
        l = l * alpha + sum;
#pragma unroll
        for (int kt = 0; kt < 2; ++kt)
#pragma unroll
            for (int u = 0; u < 4; ++u) {
                const float p0 = kt ? s1[4 * u] : s0[4 * u], p1 = kt ? s1[4 * u + 1] : s0[4 * u + 1], p2 = kt ? s1[4 * u + 2] : s0[4 * u + 2], p3 = kt ? s1[4 * u + 3] : s0[4 * u + 3];
                const float x = xhalf(p3);
                const float own = 2.0f * ((p0 + p1) + p2) + p3;
                ow[8 * T + 4 * kt + u] = own + (h ? x : carry_in);
                carry_in = x;
            }
        pv_tile(lds + L_CV + T * 8192, vofs, s0, s1, of0, of1);
    }
    {
        const float lc = xhalf_sum(l);
        const float rinv = lc > 0.f ? 1.0f / lc : 0.f, gr = gc * rinv;
#pragma unroll
        for (int i = 0; i < 16; ++i) { of0[i] *= gr; of1[i] *= gr; }
        if (need_sel) {
#pragma unroll
            for (int idx = 0; idx < 32; ++idx) ow[idx] *= rinv;
        }
    }
    unsigned long long selmask = (qb >= 63) ? ~0ull : ((1ull << (qb + 1)) - 1ull);
    if (need_sel) {
        __builtin_amdgcn_s_barrier();
        NLAS float* imp = (NLAS float*)(lds + L_IMP) + qi * 64;
#pragma unroll 1
        for (int hh = 0; hh < 4; ++hh) {
            if ((wv >> 1) == hh) {
                if (hh == 0) {
#pragma unroll
                    for (int idx = 0; idx < 32; ++idx) imp[(2 * idx + h + qi) & 63] = ow[idx];
                } else {
#pragma unroll
                    for (int idx = 0; idx < 32; ++idx) imp[(2 * idx + h + qi) & 63] += ow[idx];
                }
            }
            asm volatile("s_waitcnt lgkmcnt(0)" ::: "memory"); __builtin_amdgcn_s_barrier();
        }
        NLAS unsigned long long* selm = (NLAS unsigned long long*)(lds + L_SELM);
        const unsigned long long forced = 1ull | (1ull << qb) | (1ull << (qb - 1));
        const bool cand = (lane >= 1) && (lane <= qb - 2);
#pragma unroll 1
        for (int rep_ = 0; rep_ < NSA_REP_RANK; ++rep_) {
            unsigned vb[8], thr[8];
#pragma unroll
            for (int qq = 0; qq < 8; ++qq) { const int q = 8 * wv + qq; const float v = ((NLAS float*)(lds + L_IMP))[q * 64 + ((lane + q) & 63)];
                vb[qq] = cand ? __float_as_uint(v) : 0u; thr[qq] = 0u; }
#pragma unroll 1
            for (int bit = 30; bit >= 0; --bit) {
                unsigned long long bm[8];
#pragma unroll
                for (int qq = 0; qq < 8; ++qq) bm[qq] = __builtin_amdgcn_ballot_w64(vb[qq] >= (thr[qq] | (1u << bit)));
#pragma unroll
                for (int qq = 0; qq < 8; ++qq) {
                    const int cnt = __builtin_popcount((unsigned)bm[qq]) + __builtin_popcount((unsigned)(bm[qq] >> 32));
                    thr[qq] = (cnt >= 13) ? (thr[qq] | (1u << bit)) : thr[qq];
                }
            }
#pragma unroll
            for (int qq = 0; qq < 8; ++qq) {
                unsigned long long sel = __ballot(cand && vb[qq] > thr[qq]);
                unsigned long long eq = __ballot(cand && vb[qq] == thr[qq]);
                int need = 13 - __popcll(sel);
#pragma unroll 1
                for (; need > 0; --need) { const unsigned long long low = eq & (~eq + 1ull); sel |= low; eq ^= low; }
                if (lane == 0) selm[8 * wv + qq] = sel | forced;
            }
        }
        asm volatile("s_waitcnt lgkmcnt(0)" ::: "memory"); __builtin_amdgcn_s_barrier();
        selmask = selm[qi];
    }
    {
        u32x4 qraw[4];
#pragma unroll
        for (int ks = 0; ks < 4; ++ks) qraw[ks] = *(const u32x4*)(qrow + 16 * ks + 8 * h);
        const float4* cp = (const float4*)(P.cosT + (size_t)tok * 32 + 8 * h); const float4* sp = (const float4*)(P.sinT + (size_t)tok * 32 + 8 * h);
#pragma unroll
        for (int ks = 0; ks < 2; ++ks) {
            const float4 c0 = cp[4 * ks], c1 = cp[4 * ks + 1], s0 = sp[4 * ks], s1 = sp[4 * ks + 1];
            const float cs[8] = {c0.x, c0.y, c0.z, c0.w, c1.x, c1.y, c1.z, c1.w}, sn[8] = {s0.x, s0.y, s0.z, s0.w, s1.x, s1.y, s1.z, s1.w};
            u32x4 oa, ob;
#pragma unroll
            for (int c = 0; c < 4; ++c) {
                const float a0 = bflo(qraw[ks][c]), a1 = bfhi(qraw[ks][c]), b0 = bflo(qraw[ks + 2][c]), b1 = bfhi(qraw[ks + 2][c]);
                oa[c] = cvtpk((a0 * cs[2 * c] - b0 * sn[2 * c]) * QSCALE, (a1 * cs[2 * c + 1] - b1 * sn[2 * c + 1]) * QSCALE);
                ob[c] = cvtpk((b0 * cs[2 * c] + a0 * sn[2 * c]) * QSCALE, (b1 * cs[2 * c + 1] + a1 * sn[2 * c + 1]) * QSCALE);
            }
            qf[ks] = __builtin_bit_cast(bf16x8, oa); qf[ks + 2] = __builtin_bit_cast(bf16x8, ob);
        }
    }
    asm volatile("s_waitcnt vmcnt(0)" ::: "memory");
    f32x16 o0, o1;
    const bool lead = wv < 4;
    const float gs_keep = gs, gw_keep = gw;
#pragma unroll 1
    for (int repL = 0; repL < NSA_REP_LOOP; ++repL) {
    if (NSA_REP_LOOP > 1) { gs = (repL == NSA_REP_LOOP - 1) ? gs_keep : 0.f; gw = (repL == NSA_REP_LOOP - 1) ? gw_keep : 0.f;
        if (repL > 0) { asm volatile("s_waitcnt vmcnt(0)" ::: "memory"); __builtin_amdgcn_s_barrier(); NSA_ISSUE(0); NSA_ISSUE(1); asm volatile("s_waitcnt vmcnt(0)" ::: "memory"); } }
#pragma unroll
    for (int i = 0; i < 16; ++i) { o0[i] = 0.f; o1[i] = 0.f; }
    m = NEGBIG; l = 0.f;
    if (!lead) { asm volatile("s_waitcnt vmcnt(2)" ::: "memory"); __builtin_amdgcn_s_barrier(); }
#pragma unroll 1
    for (int pos = 0; pos < ntiles; ++pos) {
        if (lead) asm volatile("s_waitcnt vmcnt(2)" ::: "memory");
        __builtin_amdgcn_s_barrier();
        NSA_ISSUE(pos + 2);
        const NLAS unsigned char* slot = lds + L_RING + (pos & 3) * SLOTB;
        f32x16 s0, s1;
        const bool win = pos >= nsel; const int j = win ? jw0 + pos - nsel : pos;
        const bool live = win || ((selmask >> j) & 1ull);
        qk_tile(slot, qf, kofs, s0, s1);
        if (j == qb) mask_tile<false>(s0, s1, qi - 4 * h, 0);
        else if (win && qb >= 8 && j == qb - 8) mask_tile<true>(s0, s1, 63, qi + 1 - 4 * h);
        softmax_core(s0, s1, m, l, o0, o1, live);
        if (!lead) asm volatile("s_waitcnt vmcnt(2)" ::: "memory");
        __builtin_amdgcn_s_barrier();
        pv_tile(slot + 8192, vofs, s0, s1, o0, o1);
        if (pos == nsel - 1) {
            const float L = xhalf_sum(l); const float sc = (L > 0.f) ? gs / L : 0.f;
#pragma unroll
            for (int i = 0; i < 16; ++i) { of0[i] += sc * o0[i]; of1[i] += sc * o1[i]; o0[i] = 0.f; o1[i] = 0.f; }
            m = NEGBIG; l = 0.f;
        }
    }
    if (lead) __builtin_amdgcn_s_barrier();
    if (NSA_REP_LOOP > 1 && repL < NSA_REP_LOOP - 1) {
        const float L0 = l + xhalf(l); (void)L0; }
    if (repL == NSA_REP_LOOP - 1)    {
        float L = xhalf_sum(l);
        const float npad = (t < 511) ? (float)(511 - t) : 0.f;
        const float m2 = (npad > 0.f) ? fmaxf(m, 0.f) : m;
        const float a = __builtin_amdgcn_exp2f(m - m2);
        L = L * a + npad * __builtin_amdgcn_exp2f(-m2);
        const float sc = (L > 0.f) ? gw * a / L : 0.f;
#pragma unroll
        for (int i = 0; i < 16; ++i) { of0[i] += sc * o0[i]; of1[i] += sc * o1[i]; }
    }
    }
    float ss = 0.f;
#pragma unroll
    for (int i = 0; i < 16; ++i) ss += of0[i] * of0[i] + of1[i] * of1[i];
    ss = xhalf_sum(ss);
    const float rn = rsqrtf(ss * (1.0f / 64.0f) + 1e-6f);
    unsigned short* yrow = P.ycat + (size_t)tok * 1024 + 512 + head * 64;
    const float* nw = P.normw + head * 64;
    float4 w4a[2][4];
#pragma unroll
    for (int mb = 0; mb < 2; ++mb)
#pragma unroll
        for (int u = 0; u < 4; ++u) w4a[mb][u] = *(const float4*)(nw + 32 * mb + 8 * u + 4 * h);
#pragma unroll
    for (int mb = 0; mb < 2; ++mb)
#pragma unroll
        for (int u = 0; u < 4; ++u) {
            const int d0 = 32 * mb + 8 * u + 4 * h;
            const float4 w4 = w4a[mb][u];
            const float v0 = (mb ? of1[4 * u] : of0[4 * u]) * rn * w4.x, v1 = (mb ? of1[4 * u + 1] : of0[4 * u + 1]) * rn * w4.y;
            const float v2 = (mb ? of1[4 * u + 2] : of0[4 * u + 2]) * rn * w4.z, v3 = (mb ? of1[4 * u + 3] : of0[4 * u + 3]) * rn * w4.w;
            *(uint2*)(yrow + d0) = make_uint2(cvtpk(v0, v1), cvtpk(v2, v3));
        }
    asm volatile("s_waitcnt vmcnt(0)" ::: "memory"); __builtin_amdgcn_s_barrier();
#undef NSA_DMA
#undef NSA_ISSUE
}
__device__ __forceinline__ void phase(const Params& P, NLAS unsigned char* lds, const int tid, const int bid, const int G) {
#pragma unroll 1
    for (int vw = bid; vw < 256; vw += G) {
        const int xcd = vw & 7, slot = vw >> 3, bg = xcd * 2 + (slot >> 4), rr = slot & 15;
#pragma unroll 1
        for (int k = 0; k < 4; ++k) { const int qb = (k == 0) ? 63 - rr : (k == 1) ? 32 + rr : (k == 2) ? 31 - rr : rr; unit(P, lds, tid, bg >> 1, bg & 1, qb); }
    }
}
}


namespace wt {
typedef short bf16x8 __attribute__((ext_vector_type(8)));
typedef float f32x16 __attribute__((ext_vector_type(16)));
typedef unsigned u32x4 __attribute__((ext_vector_type(4)));
typedef unsigned u32x2 __attribute__((ext_vector_type(2)));
typedef float f32x2_t __attribute__((ext_vector_type(2)));
typedef __bf16 bf16x2_t __attribute__((ext_vector_type(2)));
#define WT_MFMA(a, b, c) __builtin_amdgcn_mfma_f32_32x32x16_bf16((a), (b), (c), 0, 0, 0)
__device__ __forceinline__ unsigned cvtpk(float lo, float hi) { f32x2_t v = {lo, hi}; bf16x2_t b = __builtin_convertvector(v, bf16x2_t); return __builtin_bit_cast(unsigned, b); }
__device__ __forceinline__ float bflo(unsigned u) { return __uint_as_float(u << 16); }
__device__ __forceinline__ float bfhi(unsigned u) { return __uint_as_float(u & 0xffff0000u); }
__device__ __forceinline__ float xhalf(float v) { return __shfl_xor(v, 32); }
__device__ __forceinline__ float xhalf_sum(float v) { const auto r = __builtin_amdgcn_permlane32_swap(__float_as_uint(v), __float_as_uint(v), false, false); return __uint_as_float(r[0]) + __uint_as_float(r[1]); }
__device__ __forceinline__ bf16x8 ld16(const unsigned short* p) { return __builtin_bit_cast(bf16x8, *(const u32x4*)p); }
__device__ __forceinline__ bf16x8 ld8x2(const unsigned short* p0, const unsigned short* p1) { const u32x2 a = *(const u32x2*)p0, b = *(const u32x2*)p1; u32x4 u = {a.x, a.y, b.x, b.y}; return __builtin_bit_cast(bf16x8, u); }
__device__ __forceinline__ bf16x8 pack8(const f32x16& x, int s) {
    u32x4 u = {cvtpk(x[8 * s], x[8 * s + 1]), cvtpk(x[8 * s + 2], x[8 * s + 3]), cvtpk(x[8 * s + 4], x[8 * s + 5]), cvtpk(x[8 * s + 6], x[8 * s + 7])};
    return __builtin_bit_cast(bf16x8, u);
}
__device__ __forceinline__ float gelu_t(float x) { const float u = 0.7978845608028654f * (x + 0.044715f * x * x * x); const float e = __expf(2.0f * u); return 0.5f * x * (1.0f + (1.0f - 2.0f / (e + 1.0f))); }
__device__ __forceinline__ float sigm(float x) { return 1.0f / (1.0f + __expf(-x)); }
__device__ __forceinline__ void zero(f32x16& a) {
#pragma unroll
    for (int i = 0; i < 16; ++i) a[i] = 0.f;
}

__device__ __forceinline__ void gm_ln8(const unsigned short* __restrict__ hb, const float* __restrict__ lw, const float* __restrict__ lbias, unsigned short* __restrict__ vlnT, int t8, int lane) {
    const int tok0 = t8 * 8;
    const float4 w4 = *(const float4*)(lw + lane * 4), b4 = *(const float4*)(lbias + lane * 4);
    float o[4][8];
#pragma unroll
    for (int i = 0; i < 8; ++i) {
        const u32x2 v4 = *(const u32x2*)(hb + (size_t)(tok0 + i) * 3072 + 1280 + lane * 4);
        float v[4] = {gelu_t(bflo(v4.x)), gelu_t(bfhi(v4.x)), gelu_t(bflo(v4.y)), gelu_t(bfhi(v4.y))};
        float s = (v[0] + v[1]) + (v[2] + v[3]);
#pragma unroll
        for (int o2 = 1; o2 < 64; o2 <<= 1) s += __shfl_xor(s, o2);
        const float mean = s * (1.0f / 256.0f); float q = 0.f;
#pragma unroll
        for (int c = 0; c < 4; ++c) { v[c] -= mean; q += v[c] * v[c]; }
#pragma unroll
        for (int o2 = 1; o2 < 64; o2 <<= 1) q += __shfl_xor(q, o2);
        const float rstd = rsqrtf(q * (1.0f / 256.0f) + 1e-5f);
        o[0][i] = v[0] * rstd * w4.x + b4.x; o[1][i] = v[1] * rstd * w4.y + b4.y; o[2][i] = v[2] * rstd * w4.z + b4.z; o[3][i] = v[3] * rstd * w4.w + b4.w;
    }
    const int bc = tok0 >> 7, s0 = tok0 & 127;
#pragma unroll
    for (int c = 0; c < 4; ++c) {
        const int ch = lane * 4 + c, g = ch >> 6, cc = ch & 63;
        u32x4 u = {cvtpk(o[c][0], o[c][1]), cvtpk(o[c][2], o[c][3]), cvtpk(o[c][4], o[c][5]), cvtpk(o[c][6], o[c][7])};
        *(u32x4*)(vlnT + ((size_t)(bc * 4 + g) * 64 + cc) * 128 + s0) = u;
    }
}
__device__ __forceinline__ void gm_sp_task(const unsigned short* __restrict__ hb, const unsigned short* __restrict__ vlnT, const unsigned short* __restrict__ Wb, const float* __restrict__ bs,
                                           const float* __restrict__ normw, unsigned short* __restrict__ ycat, int task, int lane) {
    const int tb = task & 3, g = (task >> 2) & 3, bc = task >> 4, r = lane & 31, h = lane >> 5;
    const unsigned short* ap = vlnT + ((size_t)(bc * 4 + g) * 64 + r) * 128 + 8 * h;
    const unsigned short* bp = Wb + ((size_t)g * 128 + 32 * tb + r) * 128 + 8 * h;
    f32x16 a0, a1; zero(a0); zero(a1);
    const u32x2 uu0 = *(const u32x2*)(hb + (size_t)(bc * 128 + 32 * tb + r) * 3072 + 1024 + g * 64 + 4 * h);
    asm volatile("" :: "v"(uu0));
#pragma unroll 1
    for (int kp = 0; kp <= tb; ++kp) {
        const bf16x8 bw0 = ld16(bp + 32 * kp), bw1 = ld16(bp + 32 * kp + 16);
        const bf16x8 v00 = ld16(ap + 32 * kp), v10 = ld16(ap + 32 * 128 + 32 * kp), v01 = ld16(ap + 32 * kp + 16), v11 = ld16(ap + 32 * 128 + 32 * kp + 16);
        a0 = WT_MFMA(v00, bw0, a0); a1 = WT_MFMA(v10, bw0, a1); a0 = WT_MFMA(v01, bw1, a0); a1 = WT_MFMA(v11, bw1, a1);
    }
    const int tl = 32 * tb + r, tok = bc * 128 + tl;
    const float bias = bs[g * 128 + tl];
    const unsigned short* up = hb + (size_t)tok * 3072 + 1024 + g * 64;
    float z[32]; float ss = 0.f;
#pragma unroll
    for (int cb = 0; cb < 2; ++cb)
#pragma unroll
        for (int u = 0; u < 4; ++u) {
            const int c0 = 32 * cb + 8 * u + 4 * h;
            const u32x2 uu = *(const u32x2*)(up + c0);
            const float uv[4] = {gelu_t(bflo(uu.x)), gelu_t(bfhi(uu.x)), gelu_t(bflo(uu.y)), gelu_t(bfhi(uu.y))};
#pragma unroll
            for (int k = 0; k < 4; ++k) { const float a = (cb ? a1[4 * u + k] : a0[4 * u + k]) + bias; const float zz = uv[k] * a; z[16 * cb + 4 * u + k] = zz; ss += zz * zz; }
        }
    ss = xhalf_sum(ss);
    const float rn = rsqrtf(ss * (1.0f / 64.0f) + 1e-6f);
    unsigned short* yp = ycat + (size_t)tok * 1024 + 256 + g * 64;
    const float* nw = normw + g * 64;
    float4 w4a[2][4];
#pragma unroll
    for (int cb = 0; cb < 2; ++cb)
#pragma unroll
        for (int u = 0; u < 4; ++u) w4a[cb][u] = *(const float4*)(nw + 32 * cb + 8 * u + 4 * h);
#pragma unroll
    for (int cb = 0; cb < 2; ++cb)
#pragma unroll
        for (int u = 0; u < 4; ++u) {
            const int c0 = 32 * cb + 8 * u + 4 * h;
            const float4 w4 = w4a[cb][u];
            u32x2 o = {cvtpk(z[16 * cb + 4 * u] * rn * w4.x, z[16 * cb + 4 * u + 1] * rn * w4.y), cvtpk(z[16 * cb + 4 * u + 2] * rn * w4.z, z[16 * cb + 4 * u + 3] * rn * w4.w)};
            *(u32x2*)(yp + c0) = o;
        }
}

#define WT_LAS __attribute__((address_space(3)))
__device__ __forceinline__ void cmp_wg(const unsigned short* __restrict__ hb, const unsigned short* __restrict__ w1t, const float* __restrict__ cbias, const unsigned short* __restrict__ w2t,
                                       unsigned short* __restrict__ kcb, unsigned short* __restrict__ vcb, WT_LAS float* red, int task, int wave, int lane) {
    const int cblk = task & 7, kv = (task >> 3) & 1, g = (task >> 4) & 1, b = task >> 5, r = lane & 31, h = lane >> 5;
    const int c = 32 * cblk + r; const int cl = c < 254 ? c : 254;
    const unsigned short* bp = hb + (size_t)(b * 4096 + 16 * cl) * 3072 + (kv ? 2176 : 2048) + g * 64 + 8 * h;
    const unsigned short* ap = w1t + ((size_t)kv * 128 + r) * 2048 + 8 * h;
    f32x16 acc[4];
#pragma unroll
    for (int nt = 0; nt < 4; ++nt) zero(acc[nt]);
#pragma unroll 4
    for (int kk = 0; kk < 16; ++kk) {
        const int ks = 16 * wave + kk;
        const bf16x8 bk = ld16(bp + (size_t)(ks >> 2) * 3072 + 16 * (ks & 3));
#pragma unroll
        for (int nt = 0; nt < 4; ++nt) acc[nt] = WT_MFMA(ld16(ap + (size_t)nt * 32 * 2048 + 16 * ks), bk, acc[nt]);
    }
#pragma unroll
    for (int nt = 0; nt < 4; ++nt)
#pragma unroll
        for (int i = 0; i < 16; ++i) red[(wave * 64 + nt * 16 + i) * 64 + lane] = acc[nt][i];
    asm volatile("s_waitcnt lgkmcnt(0)" ::: "memory"); __builtin_amdgcn_s_barrier();
#pragma unroll
    for (int q = 0; q < 8; ++q) {
        const int row = 8 * wave + q; float sacc = 0.f;
#pragma unroll
        for (int w2 = 0; w2 < 8; ++w2) sacc += red[(w2 * 64 + row) * 64 + lane];
        red[row * 64 + lane] = sacc;
    }
    asm volatile("s_waitcnt lgkmcnt(0)" ::: "memory"); __builtin_amdgcn_s_barrier();
    if (wave == 0) {
#pragma unroll
        for (int nt = 0; nt < 4; ++nt)
#pragma unroll
            for (int i = 0; i < 16; ++i) { const int n = 32 * nt + (i & 3) + 8 * (i >> 2) + 4 * h; acc[nt][i] = gelu_t(red[(nt * 16 + i) * 64 + lane] + cbias[kv * 128 + n]); }
        f32x16 o0, o1; zero(o0); zero(o1);
        const unsigned short* w2p = w2t + ((size_t)kv * 64 + r) * 128 + 4 * h;
#pragma unroll
        for (int nt = 0; nt < 4; ++nt)
#pragma unroll
            for (int s = 0; s < 2; ++s) {
                const bf16x8 pb = pack8(acc[nt], s);
                const unsigned short* wp = w2p + 32 * nt + 16 * s;
                o0 = WT_MFMA(ld8x2(wp, wp + 8), pb, o0);
                o1 = WT_MFMA(ld8x2(wp + 32 * 128, wp + 32 * 128 + 8), pb, o1);
            }
        if (c < 255) {
            unsigned short* op = (kv ? vcb : kcb) + ((size_t)(b * 2 + g) * 256 + c) * 64;
#pragma unroll
            for (int db = 0; db < 2; ++db)
#pragma unroll
                for (int u = 0; u < 4; ++u) {
                    const int d0 = 32 * db + 8 * u + 4 * h;
                    u32x2 o = {cvtpk(db ? o1[4 * u] : o0[4 * u], db ? o1[4 * u + 1] : o0[4 * u + 1]), cvtpk(db ? o1[4 * u + 2] : o0[4 * u + 2], db ? o1[4 * u + 3] : o0[4 * u + 3])};
                    *(u32x2*)(op + d0) = o;
                }
        }
    }
    __builtin_amdgcn_s_barrier();
}

__device__ __forceinline__ void kvprep8(const unsigned short* __restrict__ hb, const float* __restrict__ cosT, const float* __restrict__ sinT,
                                        unsigned short* __restrict__ ksb, unsigned short* __restrict__ vsb, unsigned short* __restrict__ kwb, unsigned short* __restrict__ vwb, int idx) {
    const int j8 = idx & 3, g = (idx >> 2) & 1, tok = idx >> 3, b = tok >> 12, t = tok & 4095;
    const unsigned short* hr = hb + (size_t)tok * 3072 + g * 64 + 8 * j8;
    const float4 c0 = *(const float4*)(cosT + (size_t)tok * 32 + 8 * j8), c1 = *(const float4*)(cosT + (size_t)tok * 32 + 8 * j8 + 4);
    const float4 s0 = *(const float4*)(sinT + (size_t)tok * 32 + 8 * j8), s1 = *(const float4*)(sinT + (size_t)tok * 32 + 8 * j8 + 4);
    u32x4 ka[2], kb[2], va[2], vb[2];
#pragma unroll
    for (int w = 0; w < 2; ++w) { const int col = w ? 2560 : 2304, vcol = w ? 2688 : 2432;
        ka[w] = *(const u32x4*)(hr + col); kb[w] = *(const u32x4*)(hr + col + 32); va[w] = *(const u32x4*)(hr + vcol); vb[w] = *(const u32x4*)(hr + vcol + 32); }
    const float cs[8] = {c0.x, c0.y, c0.z, c0.w, c1.x, c1.y, c1.z, c1.w}, sn[8] = {s0.x, s0.y, s0.z, s0.w, s1.x, s1.y, s1.z, s1.w};
    const size_t o = ((size_t)(b * 2 + g) * 4096 + t) * 64 + 8 * j8;
#pragma unroll
    for (int w = 0; w < 2; ++w) {
        u32x4 oa, ob;
#pragma unroll
        for (int c = 0; c < 4; ++c) {
            const float a0 = bflo(ka[w][c]), a1 = bfhi(ka[w][c]), b0 = bflo(kb[w][c]), b1 = bfhi(kb[w][c]);
            oa[c] = cvtpk(a0 * cs[2 * c] - b0 * sn[2 * c], a1 * cs[2 * c + 1] - b1 * sn[2 * c + 1]);
            ob[c] = cvtpk(b0 * cs[2 * c] + a0 * sn[2 * c], b1 * cs[2 * c + 1] + a1 * sn[2 * c + 1]);
        }
        unsigned short* kd = (w ? kwb : ksb) + o;
        *(u32x4*)kd = oa; *(u32x4*)(kd + 32) = ob;
        unsigned short* vd = (w ? vwb : vsb) + o;
        *(u32x4*)vd = va[w]; *(u32x4*)(vd + 32) = vb[w];
    }
}

__device__ __forceinline__ void hg_pass1(const unsigned short* __restrict__ hb, const float* __restrict__ lbl, unsigned short* __restrict__ Qt, unsigned short* __restrict__ Kt,
                                         unsigned short* __restrict__ Qp, unsigned short* __restrict__ VT, float* __restrict__ Ut, float* __restrict__ Dk, int ci, int lane_in) {
    int lane = lane_in; asm volatile("" : "+v"(lane));
    const int chunk = ci & 63, hd = (ci >> 6) & 3, b = ci >> 8;
    const unsigned short* hp = hb + (size_t)(b * 4096 + chunk * 64) * 3072 + hd * 64 + lane;
    const float lb = lbl[hd * 64 + lane];
    unsigned fpk[32];
#pragma unroll
    for (int hb2 = 0; hb2 < 2; ++hb2) { unsigned short rf[32];
#pragma unroll
      for (int t = 0; t < 32; ++t) rf[t] = hp[(size_t)(32 * hb2 + t) * 3072 + 256];
#pragma unroll
      for (int t = 0; t < 16; ++t) fpk[16 * hb2 + t] = (unsigned)rf[2 * t] | ((unsigned)rf[2 * t + 1] << 16); }
    float run = 0.f, cmid = 0.f;
#pragma unroll
    for (int t = 0; t < 64; ++t) {
        const float fr = (t & 1) ? bfhi(fpk[t >> 1]) : bflo(fpk[t >> 1]);
        run += __logf(lb + (1.0f - lb) * sigm(fr));
        if (t == 31) cmid = run;
    }
    const float blast = run;
    unsigned short* qt = Qt + (size_t)ci * 4096 + lane; unsigned short* kt = Kt + (size_t)ci * 4096 + lane; unsigned short* qp = Qp + (size_t)ci * 4096 + lane;
    unsigned short* vt = VT + (size_t)ci * 4096 + lane * 64;
    const int h = lane >> 5, r = lane & 31;
    f32x16 acc[2][2];
#pragma unroll
    for (int a = 0; a < 2; ++a)
#pragma unroll
        for (int c = 0; c < 2; ++c) zero(acc[a][c]);
    float bt = 0.f;
    Dk[(size_t)ci * 64 + lane] = __expf(blast);
#pragma unroll 1
    for (int ks = 0; ks < 4; ++ks) {
        unsigned short rq[1][16], ri[1][16];
#pragma unroll
        for (int tt = 0; tt < 16; ++tt) { const size_t o = (size_t)(ks * 16 + tt) * 3072; rq[0][tt] = hp[o]; ri[0][tt] = hp[o + 512]; }
        unsigned kp[8], vp[8];
        unsigned fsel[8];
#pragma unroll
        for (int tp = 0; tp < 8; ++tp) fsel[tp] = (ks == 0) ? fpk[tp] : (ks == 1) ? fpk[8 + tp] : (ks == 2) ? fpk[16 + tp] : fpk[24 + tp];
#pragma unroll
        for (int tp = 0; tp < 8; ++tp) {
            float k2v[2], ivv[2];
#pragma unroll
            for (int e = 0; e < 2; ++e) {
                const int t = ks * 16 + tp * 2 + e;
                const float qr = __uint_as_float((unsigned)rq[0][tp * 2 + e] << 16), fr = e ? bfhi(fsel[tp]) : bflo(fsel[tp]);
                ivv[e] = __uint_as_float((unsigned)ri[0][tp * 2 + e] << 16);
                const float sf = sigm(fr);
                const float q = qr * sigm(qr), kk = (1.0f - lb) * (1.0f - sf);
                bt += __logf(lb + (1.0f - lb) * sf);
                qt[t * 64] = (unsigned short)(cvtpk(q * __expf(bt - cmid), 0.f) & 0xffffu);
                kt[t * 64] = (unsigned short)(cvtpk(kk * __expf(cmid - bt), 0.f) & 0xffffu);
                qp[t * 64] = (unsigned short)(cvtpk(q * __expf(bt), 0.f) & 0xffffu);
                k2v[e] = kk * __expf(blast - bt);
            }
            kp[tp] = cvtpk(k2v[0], k2v[1]); vp[tp] = cvtpk(ivv[0], ivv[1]);
        }
        { u32x4 u0 = {vp[0], vp[1], vp[2], vp[3]}, u1 = {vp[4], vp[5], vp[6], vp[7]};
          *(u32x4*)(vt + ks * 16) = u0; *(u32x4*)(vt + ks * 16 + 8) = u1; }
        u32x4 kown, vown, ksnd, vsnd;
#pragma unroll
        for (int j = 0; j < 4; ++j) { kown[j] = h ? kp[4 + j] : kp[j]; ksnd[j] = h ? kp[j] : kp[4 + j]; vown[j] = h ? vp[4 + j] : vp[j]; vsnd[j] = h ? vp[j] : vp[4 + j]; }
        u32x4 krcv, vrcv;
#pragma unroll
        for (int j = 0; j < 4; ++j) { krcv[j] = (unsigned)__shfl_xor((int)ksnd[j], 32); vrcv[j] = (unsigned)__shfl_xor((int)vsnd[j], 32); }
        const bf16x8 kb0 = __builtin_bit_cast(bf16x8, h ? krcv : kown), kb1 = __builtin_bit_cast(bf16x8, h ? kown : krcv);
        const bf16x8 va0 = __builtin_bit_cast(bf16x8, h ? vrcv : vown), va1 = __builtin_bit_cast(bf16x8, h ? vown : vrcv);
        acc[0][0] = WT_MFMA(va0, kb0, acc[0][0]); acc[0][1] = WT_MFMA(va0, kb1, acc[0][1]);
        acc[1][0] = WT_MFMA(va1, kb0, acc[1][0]); acc[1][1] = WT_MFMA(va1, kb1, acc[1][1]);
    }
    float* up = Ut + (size_t)ci * 4096;
#pragma unroll
    for (int vb = 0; vb < 2; ++vb)
#pragma unroll
        for (int kb = 0; kb < 2; ++kb)
#pragma unroll
            for (int i = 0; i < 16; ++i) { const int v = 32 * vb + (i & 3) + 8 * (i >> 2) + 4 * h; up[v * 64 + 32 * kb + r] = acc[vb][kb][i]; }
}
__device__ __forceinline__ void hg_scan(const float* __restrict__ Ut, const float* __restrict__ Dk, unsigned short* __restrict__ ST, int e) {
    const int k = e & 63, seq = e >> 12, vk = e & 4095;
    float S = 0.f;
    const float* up = Ut + (size_t)seq * 64 * 4096 + vk; const float* dp = Dk + (size_t)seq * 64 * 64 + k; unsigned short* sp = ST + (size_t)seq * 64 * 4096 + vk;
#pragma unroll 8
    for (int c = 0; c < 64; ++c) {
        sp[(size_t)c * 4096] = (unsigned short)(cvtpk(S, 0.f) & 0xffffu);
        S = fmaf(dp[c * 64], S, up[(size_t)c * 4096]);
    }
}
__device__ __forceinline__ void hg_pass3(const unsigned short* __restrict__ hb, const unsigned short* __restrict__ Qt, const unsigned short* __restrict__ Kt, const unsigned short* __restrict__ Qp,
                                         const unsigned short* __restrict__ VT, const unsigned short* __restrict__ ST, const float* __restrict__ normw, unsigned short* __restrict__ ycat, int task, int lane) {
    const int tblk = task & 1, ci = task >> 1, chunk = ci & 63, hd = (ci >> 6) & 3, b = ci >> 8, r = lane & 31, h = lane >> 5;
    const size_t cb = (size_t)ci * 4096;
    f32x16 o0, o1; zero(o0); zero(o1);
    {
        const unsigned short* sp = ST + cb + (size_t)r * 64 + 8 * h; const unsigned short* qp = Qp + cb + (size_t)(32 * tblk + r) * 64 + 8 * h;
#pragma unroll
        for (int ks = 0; ks < 4; ++ks) { const bf16x8 q = ld16(qp + 16 * ks); o0 = WT_MFMA(ld16(sp + 16 * ks), q, o0); o1 = WT_MFMA(ld16(sp + 32 * 64 + 16 * ks), q, o1); }
    }
    const unsigned short* qtp = Qt + cb + (size_t)(32 * tblk + r) * 64 + 8 * h;
    bf16x8 qf[4];
#pragma unroll
    for (int ks = 0; ks < 4; ++ks) qf[ks] = ld16(qtp + 16 * ks);
#pragma unroll 1
    for (int sblk = 0; sblk <= tblk; ++sblk) {
        f32x16 at; zero(at);
        const unsigned short* ktp = Kt + cb + (size_t)(32 * sblk + r) * 64 + 8 * h;
#pragma unroll
        for (int ks = 0; ks < 4; ++ks) at = WT_MFMA(ld16(ktp + 16 * ks), qf[ks], at);
        if (sblk == tblk) {
#pragma unroll
            for (int i = 0; i < 16; ++i) { const int sl = (i & 3) + 8 * (i >> 2) + 4 * h; at[i] = (sl <= r) ? at[i] : 0.f; }
        }
#pragma unroll
        for (int s2 = 0; s2 < 2; ++s2) {
            const bf16x8 pb = pack8(at, s2);
            const unsigned short* vp = VT + cb + (size_t)r * 64 + 32 * sblk + 16 * s2 + 4 * h;
            o0 = WT_MFMA(ld8x2(vp, vp + 8), pb, o0);
            o1 = WT_MFMA(ld8x2(vp + 32 * 64, vp + 32 * 64 + 8), pb, o1);
        }
    }
    const int tok = b * 4096 + chunk * 64 + 32 * tblk + r;
    float ss = 0.f;
#pragma unroll
    for (int i = 0; i < 16; ++i) ss += o0[i] * o0[i] + o1[i] * o1[i];
    ss = xhalf_sum(ss);
    const float rn = rsqrtf(ss * (1.0f / 64.0f) + 1e-6f);
    const unsigned short* gp = hb + (size_t)tok * 3072 + 768 + hd * 64;
    unsigned short* yp = ycat + (size_t)tok * 1024 + hd * 64;
    const float* nw = normw + hd * 64;
    u32x2 gg[2][4]; float4 w4[2][4];
#pragma unroll
    for (int vb = 0; vb < 2; ++vb)
#pragma unroll
        for (int u = 0; u < 4; ++u) { const int v0 = 32 * vb + 8 * u + 4 * h; gg[vb][u] = *(const u32x2*)(gp + v0); w4[vb][u] = *(const float4*)(nw + v0); }
#pragma unroll
    for (int vb = 0; vb < 2; ++vb)
#pragma unroll
        for (int u = 0; u < 4; ++u) {
            const int v0 = 32 * vb + 8 * u + 4 * h;
            const float x0 = (vb ? o1[4 * u] : o0[4 * u]) * rn * w4[vb][u].x * sigm(bflo(gg[vb][u].x)), x1 = (vb ? o1[4 * u + 1] : o0[4 * u + 1]) * rn * w4[vb][u].y * sigm(bfhi(gg[vb][u].x));
            const float x2 = (vb ? o1[4 * u + 2] : o0[4 * u + 2]) * rn * w4[vb][u].z * sigm(bflo(gg[vb][u].y)), x3 = (vb ? o1[4 * u + 3] : o0[4 * u + 3]) * rn * w4[vb][u].w * sigm(bfhi(gg[vb][u].y));
            u32x2 o = {cvtpk(x0, x1), cvtpk(x2, x3)};
            *(u32x2*)(yp + v0) = o;
        }
}

__device__ __forceinline__ void route_task(const unsigned short* __restrict__ x1, const unsigned short* __restrict__ rwh, const unsigned short* __restrict__ rwl, const float* __restrict__ rb,
                                           int* __restrict__ cnt, int* __restrict__ list, int* __restrict__ tok_e, int* __restrict__ tok_slot, float* __restrict__ tok_w, int task, int lane) {
    const int r = lane & 31, h = lane >> 5, tok = task * 32 + r;
    const unsigned short* xp = x1 + (size_t)tok * 1024 + 8 * h;
    const unsigned short* whp = rwh + (size_t)r * 1024 + 8 * h; const unsigned short* wlp = rwl + (size_t)r * 1024 + 8 * h;
    f32x16 acc; zero(acc);
#pragma unroll 8
    for (int ks = 0; ks < 64; ++ks) {
        const bf16x8 xh = ld16(xp + 16 * ks);
        acc = WT_MFMA(ld16(whp + 16 * ks), xh, acc); acc = WT_MFMA(ld16(wlp + 16 * ks), xh, acc);
    }
    float v[16];
#pragma unroll
    for (int i = 0; i < 16; ++i) v[i] = acc[i] + rb[(i & 3) + 8 * (i >> 2) + 4 * h];
    float cv[8]; int ce[8];
#pragma unroll
    for (int k = 0; k < 4; ++k) {
        float best = -3.0e38f; int bi = 0;
#pragma unroll
        for (int i = 0; i < 16; ++i) { const bool ok = v[i] > best; best = ok ? v[i] : best; bi = ok ? i : bi; }
#pragma unroll
        for (int i = 0; i < 16; ++i) v[i] = (i == bi) ? -3.0e38f : v[i];
        cv[k] = best; ce[k] = (bi & 3) + 8 * (bi >> 2) + 4 * h;
    }
#pragma unroll
    for (int k = 0; k < 4; ++k) { cv[4 + k] = xhalf(cv[k]); ce[4 + k] = __shfl_xor(ce[k], 32); }
    float tl[4]; int te[4];
#pragma unroll
    for (int k = 0; k < 4; ++k) {
        float best = -3.0e38f; int be = 64, bj = 0;
#pragma unroll
        for (int j = 0; j < 8; ++j) { const bool ok = (cv[j] > best) || (cv[j] == best && ce[j] < be); best = ok ? cv[j] : best; be = ok ? ce[j] : be; bj = ok ? j : bj; }
#pragma unroll
        for (int j = 0; j < 8; ++j) cv[j] = (j == bj) ? -3.0e38f : cv[j];
        tl[k] = best; te[k] = be;
    }
    const float e1 = __expf(tl[1] - tl[0]), e2 = __expf(tl[2] - tl[0]), e3 = __expf(tl[3] - tl[0]);
    const float inv = 1.0f / (1.0f + e1 + e2 + e3);
    const float tw[4] = {inv, e1 * inv, e2 * inv, e3 * inv};
    unsigned mymask = 0u;
#pragma unroll 1
    for (int e = 0; e < 32; ++e) {
        const unsigned mk = (unsigned)__ballot(h == 0 && (te[0] == e || te[1] == e || te[2] == e || te[3] == e));
        mymask = (lane == e) ? mk : mymask;
    }
    int base = 0;
    if (lane < 32 && mymask != 0u) base = atomicAdd(&cnt[lane], __popc(mymask));
#pragma unroll
    for (int k = 0; k < 4; ++k) {
        const int bk = __shfl(base, te[k]); const unsigned mk = (unsigned)__shfl((int)mymask, te[k]);
        const int slot = bk + __popc(mk & ((1u << r) - 1u));
        if (h == 0) { list[te[k] * 32768 + slot] = tok; tok_e[tok * 4 + k] = te[k]; tok_slot[tok * 4 + k] = slot; tok_w[tok * 4 + k] = tw[k]; }
    }
}
}


__device__ __forceinline__ void ln1_tok2(const float* __restrict__ xin_f, const bf16* __restrict__ xin_b, const bf16* __restrict__ mix, const float* __restrict__ lw, const float* __restrict__ lbias,
                                         bf16* __restrict__ x1b, unsigned char* __restrict__ x1q, int tok0, int lane) {
    float v[2][16]; float s[2] = {0.f, 0.f};
#pragma unroll
    for (int u = 0; u < 2; ++u)
#pragma unroll
        for (int j = 0; j < 4; ++j) {
            const size_t o = (size_t)(tok0 + u) * D_ + j * 256 + lane * 4;
            float4 a;
            if (xin_f) a = *(const float4*)(xin_f + o);
            else { const uint2 ab = *(const uint2*)(xin_b + o);
                   a = make_float4(__uint_as_float(ab.x << 16), __uint_as_float(ab.x & 0xffff0000u), __uint_as_float(ab.y << 16), __uint_as_float(ab.y & 0xffff0000u)); }
            const uint2 mb = *(const uint2*)(mix + o);
            v[u][4 * j] = ALPHA * a.x + __uint_as_float(mb.x << 16); v[u][4 * j + 1] = ALPHA * a.y + __uint_as_float(mb.x & 0xffff0000u);
            v[u][4 * j + 2] = ALPHA * a.z + __uint_as_float(mb.y << 16); v[u][4 * j + 3] = ALPHA * a.w + __uint_as_float(mb.y & 0xffff0000u);
            s[u] += (v[u][4 * j] + v[u][4 * j + 1]) + (v[u][4 * j + 2] + v[u][4 * j + 3]);
        }
    float rstd[2];
#pragma unroll
    for (int u = 0; u < 2; ++u) {
        const float mean = wsum(s[u]) * (1.0f / D_); float q = 0.f;
#pragma unroll
        for (int i = 0; i < 16; ++i) { v[u][i] -= mean; q += v[u][i] * v[u][i]; }
        rstd[u] = rsqrtf(wsum(q) * (1.0f / D_) + 1e-5f);
    }
    float4 w4a[4], b4a[4];
#pragma unroll
    for (int j = 0; j < 4; ++j) { w4a[j] = *(const float4*)(lw + j * 256 + lane * 4); b4a[j] = *(const float4*)(lbias + j * 256 + lane * 4); }
#pragma unroll
    for (int j = 0; j < 4; ++j) {
        const float4 w4 = w4a[j], b4 = b4a[j];
#pragma unroll
        for (int u = 0; u < 2; ++u) {
            const size_t o = (size_t)(tok0 + u) * D_ + j * 256 + lane * 4;
            const float4 r = make_float4(v[u][4 * j] * rstd[u] * w4.x + b4.x, v[u][4 * j + 1] * rstd[u] * w4.y + b4.y, v[u][4 * j + 2] * rstd[u] * w4.z + b4.z, v[u][4 * j + 3] * rstd[u] * w4.w + b4.w);
            *(uint2*)(x1b + o) = make_uint2(pk2(r.x, r.y), pk2(r.z, r.w));
            *(unsigned*)(x1q + o) = pg8::pk4_fp8(r.x, r.y, r.z, r.w);
        }
    }
}
__device__ __forceinline__ void comb_ln2_tok2(const bf16* __restrict__ x1, const bf16* __restrict__ y, const int* __restrict__ offs, const int* __restrict__ tok_e,
                                              const int* __restrict__ tok_slot, const float* __restrict__ tok_w, const float* __restrict__ lw, const float* __restrict__ lbias,
                                              float* __restrict__ xout, bf16* __restrict__ xbout, unsigned char* __restrict__ xqout, int tok0, int lane, const int (&row)[2][4], const float (&wk)[2][4]) {
    float v[2][16];
#pragma unroll
    for (int u = 0; u < 2; ++u)
#pragma unroll
        for (int j = 0; j < 4; ++j) { const uint2 ab = *(const uint2*)(x1 + (size_t)(tok0 + u) * D_ + j * 256 + lane * 4);
            v[u][4 * j] = ALPHA * __uint_as_float(ab.x << 16); v[u][4 * j + 1] = ALPHA * __uint_as_float(ab.x & 0xffff0000u); v[u][4 * j + 2] = ALPHA * __uint_as_float(ab.y << 16); v[u][4 * j + 3] = ALPHA * __uint_as_float(ab.y & 0xffff0000u); }
#pragma unroll
    for (int u = 0; u < 2; ++u)
#pragma unroll
        for (int k = 0; k < 4; ++k)
#pragma unroll
            for (int j = 0; j < 4; ++j) { const uint2 ab = *(const uint2*)(y + (size_t)row[u][k] * D_ + j * 256 + lane * 4); const float w = wk[u][k];
                v[u][4 * j] = fmaf(w, __uint_as_float(ab.x << 16), v[u][4 * j]); v[u][4 * j + 1] = fmaf(w, __uint_as_float(ab.x & 0xffff0000u), v[u][4 * j + 1]);
                v[u][4 * j + 2] = fmaf(w, __uint_as_float(ab.y << 16), v[u][4 * j + 2]); v[u][4 * j + 3] = fmaf(w, __uint_as_float(ab.y & 0xffff0000u), v[u][4 * j + 3]); }
    float rstd[2];
#pragma unroll
    for (int u = 0; u < 2; ++u) {
        float s = 0.f;
#pragma unroll
        for (int i = 0; i < 16; ++i) s += v[u][i];
        const float mean = wsum(s) * (1.0f / D_); float q = 0.f;
#pragma unroll
        for (int i = 0; i < 16; ++i) { v[u][i] -= mean; q += v[u][i] * v[u][i]; }
        rstd[u] = rsqrtf(wsum(q) * (1.0f / D_) + 1e-5f);
    }
    float4 w4a[4], b4a[4];
#pragma unroll
    for (int j = 0; j < 4; ++j) { w4a[j] = *(const float4*)(lw + j * 256 + lane * 4); b4a[j] = *(const float4*)(lbias + j * 256 + lane * 4); }
#pragma unroll
    for (int j = 0; j < 4; ++j) {
        const float4 w4 = w4a[j], b4 = b4a[j];
#pragma unroll
        for (int u = 0; u < 2; ++u) {
            const size_t o = (size_t)(tok0 + u) * D_ + j * 256 + lane * 4;
            const float4 r = make_float4(v[u][4 * j] * rstd[u] * w4.x + b4.x, v[u][4 * j + 1] * rstd[u] * w4.y + b4.y, v[u][4 * j + 2] * rstd[u] * w4.z + b4.z, v[u][4 * j + 3] * rstd[u] * w4.w + b4.w);
            if (xout) *(float4*)(xout + o) = r;
            if (xbout) { *(uint2*)(xbout + o) = make_uint2(pk2(r.x, r.y), pk2(r.z, r.w));
                         *(unsigned*)(xqout + o) = pg8::pk4_fp8(r.x, r.y, r.z, r.w); }
        }
    }
}

struct Args { const float* in[25]; float* out; unsigned char* ws; int ph_lo, ph_hi; };
#define PH __device__ __forceinline__
#ifndef WIN_SPLIT
#define WIN_SPLIT 12
#endif
constexpr int TAB_OFF = 131072;

__device__ __forceinline__ void transpose_item(const float* __restrict__ W, int K, int N, bf16* __restrict__ WT, int k0, int scol0, int drow0, float* scr, int lane) {
    const int cc = lane & 31; const bool cv = (scol0 + cc) < N;
#pragma unroll 8
    for (int i = 0; i < 32; ++i) { const int kk = 2 * i + (lane >> 5); scr[kk * 33 + cc] = cv ? W[(size_t)(k0 + kk) * N + scol0 + cc] : 0.f; }
    asm volatile("s_waitcnt lgkmcnt(0)" ::: "memory");
    const int c = lane & 7;
#pragma unroll
    for (int j = 0; j < 4; ++j) { const int n = (lane >> 3) + 8 * j; const float* s = scr + (8 * c) * 33 + n;
        uint4 o; o.x = pk2(s[0 * 33], s[1 * 33]); o.y = pk2(s[2 * 33], s[3 * 33]); o.z = pk2(s[4 * 33], s[5 * 33]); o.w = pk2(s[6 * 33], s[7 * 33]);
        *(uint4*)(WT + (size_t)(drow0 + n) * K + k0 + 8 * c) = o; }
    asm volatile("s_waitcnt lgkmcnt(0)" ::: "memory");
}
__device__ __forceinline__ void transpose64(const float* __restrict__ W, int K, int N, bf16* __restrict__ WT, int k0, int scol0, int drow0, int lane) {
    const int q = lane >> 4, c = lane & 15;
    const bool cv = (scol0 + 4 * c) < N;
    const float* src = W + (size_t)(k0 + 16 * q) * N + scol0 + 4 * c;
    float4 v[16];
#pragma unroll
    for (int i = 0; i < 16; ++i) v[i] = cv ? *(const float4*)(src + (size_t)i * N) : make_float4(0.f, 0.f, 0.f, 0.f);
    bf16* dst = WT + (size_t)(drow0 + 4 * c) * K + k0 + 16 * q;
#pragma unroll
    for (int j = 0; j < 4; ++j) {
        float e[16];
#pragma unroll
        for (int i = 0; i < 16; ++i) e[i] = (j == 0) ? v[i].x : (j == 1) ? v[i].y : (j == 2) ? v[i].z : v[i].w;
        uint4 o0, o1;
        o0.x = pk2(e[0], e[1]); o0.y = pk2(e[2], e[3]); o0.z = pk2(e[4], e[5]); o0.w = pk2(e[6], e[7]);
        o1.x = pk2(e[8], e[9]); o1.y = pk2(e[10], e[11]); o1.z = pk2(e[12], e[13]); o1.w = pk2(e[14], e[15]);
        *(uint4*)(dst + (size_t)j * K) = o0; *(uint4*)(dst + (size_t)j * K + 8) = o1;
    }
}
struct T64Item { const float* src; unsigned char* dst; };
__device__ __forceinline__ void t64_load(const float* src, int N, float4 (&v)[16]) {
#pragma unroll
    for (int i = 0; i < 16; ++i) { typedef float f4v __attribute__((ext_vector_type(4))); const f4v t = __builtin_nontemporal_load((const f4v*)(src + (size_t)i * N)); v[i] = make_float4(t.x, t.y, t.z, t.w); }
}
__device__ __forceinline__ unsigned pk4_fp8_nc(float a, float b, float c, float d) { int p = __builtin_amdgcn_cvt_pk_fp8_f32(a, b, 0, false); p = __builtin_amdgcn_cvt_pk_fp8_f32(c, d, p, true); return (unsigned)p; }
__device__ __forceinline__ void t64_store_f8(unsigned char* dst, int K, float sc, const float4 (&v)[16]) {
#pragma unroll
    for (int j = 0; j < 4; ++j) {
        float e[16];
#pragma unroll
        for (int i = 0; i < 16; ++i) e[i] = sc * ((j == 0) ? v[i].x : (j == 1) ? v[i].y : (j == 2) ? v[i].z : v[i].w);
        uint4 o;
        o.x = pk4_fp8_nc(e[0], e[1], e[2], e[3]); o.y = pk4_fp8_nc(e[4], e[5], e[6], e[7]); o.z = pk4_fp8_nc(e[8], e[9], e[10], e[11]); o.w = pk4_fp8_nc(e[12], e[13], e[14], e[15]);
        *(uint4*)(dst + (size_t)j * K) = o;
    }
}
__device__ __forceinline__ void transpose64_f8(const float* __restrict__ W, int K, int N, unsigned char* __restrict__ WT, int k0, int scol0, int drow0, int lane, float sc) {
    const int q = lane >> 4, c = lane & 15;
    const bool cv = (scol0 + 4 * c) < N;
    const float* src = W + (size_t)(k0 + 16 * q) * N + scol0 + 4 * c;
    float4 v[16];
#pragma unroll
    for (int i = 0; i < 16; ++i) v[i] = cv ? *(const float4*)(src + (size_t)i * N) : make_float4(0.f, 0.f, 0.f, 0.f);
    t64_store_f8(WT + (size_t)(drow0 + 4 * c) * K + k0 + 16 * q, K, sc, v);
}
__device__ __forceinline__ void t64_item(int it, const float* w_up, const float* w_dn, unsigned char* wt_up, unsigned char* wt_dn, int lane, const float*& src, unsigned char*& dst, int& N, float& sc) {
    constexpr int I_UP = 16 * 32, I_DN = 16 * 16;
    const int q = lane >> 4, c = lane & 15;
#ifdef CONV_KBFAST
    if (it < NE * I_UP) { const int e = it / I_UP, r = it % I_UP, kb = r % 16, nb = r / 16;
#else
    if (it < NE * I_UP) { const int e = it / I_UP, r = it % I_UP, kb = r / 32, nb = r % 32;
#endif
        const int n0 = nb * 64, pn = n0 >> 8, bj = (n0 >> 7) & 1, jj = n0 & 127;
        src = w_up + (size_t)e * D_ * 2048 + (size_t)(kb * 64 + 16 * q) * 2048 + bj * 1024 + 128 * pn + jj + 4 * c;
        dst = wt_up + (size_t)e * 2048 * D_ + (size_t)(n0 + 4 * c) * D_ + kb * 64 + 16 * q; N = 2048; sc = pg8::F8_SU; }
#ifdef CONV_KBFAST
    else { const int r0 = it - NE * I_UP; const int e = r0 / I_DN, r = r0 % I_DN, kb = r % 16, nb = r / 16;
#else
    else { const int r0 = it - NE * I_UP; const int e = r0 / I_DN, r = r0 % I_DN, kb = r / 16, nb = r % 16;
#endif
        src = w_dn + (size_t)e * D_ * D_ + (size_t)(kb * 64 + 16 * q) * D_ + nb * 64 + 4 * c;
        dst = wt_dn + (size_t)e * D_ * D_ + (size_t)(nb * 64 + 4 * c) * D_ + kb * 64 + 16 * q; N = D_; sc = pg8::F8_SD; }
}
#ifdef CONV_R32
__device__ __forceinline__ void t64_item_r32(int it, const float* w_up, const float* w_dn, unsigned char* wt_up, unsigned char* wt_dn, int lane, const float*& src, unsigned char*& dst, int& N, float& sc) {
    constexpr int I_UP = 32 * 16, I_DN = 32 * 8;
    const int q = lane >> 5, c = lane & 31;
    if (it < NE * I_UP) { const int e = it / I_UP, r = it % I_UP, kb = r / 16, nb = r % 16;
        const int n0 = nb * 128, pn = n0 >> 8, bj = (n0 >> 7) & 1;
        src = w_up + (size_t)e * D_ * 2048 + (size_t)(kb * 32 + 16 * q) * 2048 + bj * 1024 + 128 * pn + 4 * c;
        dst = wt_up + (size_t)e * 2048 * D_ + (size_t)(n0 + 4 * c) * D_ + kb * 32 + 16 * q; N = 2048; sc = pg8::F8_SU; }
    else { const int r0 = it - NE * I_UP; const int e = r0 / I_DN, r = r0 % I_DN, kb = r / 8, nb = r % 8;
        src = w_dn + (size_t)e * D_ * D_ + (size_t)(kb * 32 + 16 * q) * D_ + nb * 128 + 4 * c;
        dst = wt_dn + (size_t)e * D_ * D_ + (size_t)(nb * 128 + 4 * c) * D_ + kb * 32 + 16 * q; N = D_; sc = pg8::F8_SD; }
}
#define t64_item t64_item_r32
#endif
#ifdef CONV_R8
__device__ __forceinline__ void t64_item_r8(int it, const float* w_up, const float* w_dn, unsigned char* wt_up, unsigned char* wt_dn, int lane, const float*& src, unsigned char*& dst, int& N, float& sc) {
    constexpr int I_UP = 8 * 64, I_DN = 8 * 32;
    const int q = lane >> 3, c = lane & 7;
    if (it < NE * I_UP) { const int e = it / I_UP, r = it % I_UP, kb = r / 64, nb = r % 64;
        const int n0 = nb * 32, pn = n0 >> 8, bj = (n0 >> 7) & 1, jj = n0 & 127;
        src = w_up + (size_t)e * D_ * 2048 + (size_t)(kb * 128 + 16 * q) * 2048 + bj * 1024 + 128 * pn + jj + 4 * c;
        dst = wt_up + (size_t)e * 2048 * D_ + (size_t)(n0 + 4 * c) * D_ + kb * 128 + 16 * q; N = 2048; sc = pg8::F8_SU; }
    else { const int r0 = it - NE * I_UP; const int e = r0 / I_DN, r = r0 % I_DN, kb = r / 32, nb = r % 32;
        src = w_dn + (size_t)e * D_ * D_ + (size_t)(kb * 128 + 16 * q) * D_ + nb * 32 + 4 * c;
        dst = wt_dn + (size_t)e * D_ * D_ + (size_t)(nb * 32 + 4 * c) * D_ + kb * 128 + 16 * q; N = D_; sc = pg8::F8_SD; }
}
#define t64_item t64_item_r8
#endif
PH void ph_prologue(int wv, const int* pos, const float* hg_lb, float* cosT, float* sinT, float* lb,
                    const float* x, bf16* xb, unsigned char* xq, const float* w_in, const float* w_out, const float* w_up, const float* w_dn, bf16* wt_in, unsigned char* wt_in8, bf16* wt_out, bf16* wt_up, bf16* wt_dn,
                    const float* gm_sw, bf16* wb, const float* cpe, const float* cw1, bf16* w1t, float* cbias, const float* cw2, bf16* w2t, const float* rw, bf16* rwh, bf16* rwl) {
    extern __shared__ __attribute__((aligned(16))) unsigned char lds[];
    int tid = mk_tid(wv), bid = blockIdx.x; asm volatile("" : "+v"(tid), "+s"(bid)); const int G = gridDim.x, lane = tid & 63, wave = wv;
#pragma unroll 1
    for (int i0 = bid * NTHR + tid; i0 < NT * 32; i0 += 4 * G * NTHR) {
        int pv[4];
#pragma unroll
        for (int u = 0; u < 4; ++u) { const int i = i0 + u * G * NTHR; pv[u] = (i < NT * 32) ? pos[i >> 5] : 0; }
#pragma unroll
        for (int u = 0; u < 4; ++u) { const int i = i0 + u * G * NTHR; if (i < NT * 32) { const int j = i & 31;
            float inv = (float)pow(10000.0, -(double)(2 * j) / 64.0);
            float ang = (float)pv[u] * inv;
            const double ad = (double)ang, kk = rint(ad * 0.15915494309189535);
            const float rf = (float)fma(-kk, 6.283185307179586, ad);
            cosT[i] = cosf(rf); sinT[i] = sinf(rf); } }
    }
    if (bid == 0 && tid < 256) {
        float p0 = hg_lb[tid], p1 = hg_lb[256 + tid];
        float m = fmaxf(p0, p1); float ea = expf(p0 - m), eb = expf(p1 - m);
        lb[tid] = 0.f; lb[256 + tid] = eb / (ea + eb);
    }
    {
        const size_t n4 = (size_t)NT * D_ / 4, stride = (size_t)G * NTHR;
#pragma unroll 1
        for (size_t i = (size_t)bid * NTHR + tid; i < n4; i += 8 * stride) {
            float4 v[8];
#pragma unroll
            for (int u = 0; u < 8; ++u) { const size_t j = i + u * stride; v[u] = (j < n4) ? ((const float4*)x)[j] : make_float4(0.f, 0.f, 0.f, 0.f); }
#pragma unroll
            for (int u = 0; u < 8; ++u) { const size_t j = i + u * stride; if (j < n4) { ((unsigned*)xq)[j] = pg8::pk4_fp8(v[u].x, v[u].y, v[u].z, v[u].w); if (WIN_SPLIT < HS / 256) ((uint2*)xb)[j] = make_uint2(pk2(v[u].x, v[u].y), pk2(v[u].z, v[u].w)); } }
        }
    }
#pragma unroll 1
    for (int i = bid * NTHR + tid; i < DEPTH * NE * D_; i += G * NTHR) { const int k = i & 1023, e = (i >> 10) & 31, l = i >> 15; const float w = rw[((size_t)l * D_ + k) * NE + e];
        const unsigned hi = f2bf(w); rwh[i] = (bf16)hi; rwl[i] = (bf16)f2bf(w - __uint_as_float(hi << 16)); }
#pragma unroll 1
    for (int i = bid * NTHR + tid; i < DEPTH * 4 * 128 * 128; i += G * NTHR) { const int s = i & 127, t = (i >> 7) & 127; wb[i] = (bf16)f2bf(s <= t ? gm_sw[i] : 0.f); }
    {
        const int gwv = bid * 8 + wave, NGWV = G * 8;
#pragma unroll 1
        for (int o = gwv; o < DEPTH * 2 * 128; o += NGWV) {
            const int lk = o >> 7, n = o & 127;
            float a = 0.f;
#pragma unroll 8
            for (int i = lane; i < 2048; i += 64) a = fmaf(cpe[lk * 2048 + i], cw1[((size_t)lk * 2048 + i) * 128 + n], a);
            a = wsum(a);
            if (lane == 0) cbias[o] = a;
        }
    }
    float* scr = (float*)(lds + wave * 16384);
    const int gw = bid * 8 + wave, NGW = G * 8;
    constexpr int I_IN = 16 * 45, I_OUT = 16 * 16;
    constexpr int I_C1 = 32 * 4;
    constexpr int I_C2 = 2 * 2;
    constexpr int PER_L = I_IN + I_OUT + 2 * I_C1 + 2 * I_C2;
#pragma unroll 1
    for (int it = gw; it < DEPTH * PER_L; it += NGW) {
        const int l = it / PER_L; int r = it % PER_L;
        if (r < I_IN) { const int kb = r / 45, nb = r % 45;
            if (nb < WIN_SPLIT * 4) transpose64_f8(w_in + (size_t)l * D_ * INW, D_, INW, wt_in8 + (size_t)l * HS * D_, kb * 64, nb * 64, nb * 64, lane, pg8::F8_SI);
            else transpose64(w_in + (size_t)l * D_ * INW, D_, INW, wt_in + (size_t)l * HS * D_, kb * 64, nb * 64, nb * 64, lane);
            continue; }
        r -= I_IN;
        if (r < I_OUT) { const int kb = r / 16, nb = r % 16; transpose64(w_out + (size_t)l * D_ * D_, D_, D_, wt_out + (size_t)l * D_ * D_, kb * 64, nb * 64, nb * 64, lane); continue; }
        r -= I_OUT;
        if (r < 2 * I_C1) { const int kv = r / I_C1, q = r % I_C1, kb = q / 4, nb = q % 4;
            transpose_item(cw1 + ((size_t)l * 2 + kv) * 2048 * 128, 2048, 128, w1t + ((size_t)l * 2 + kv) * 128 * 2048, kb * 64, nb * 32, nb * 32, scr, lane); continue; }
        r -= 2 * I_C1;
        { const int kv = r / I_C2, q = r % I_C2, kb = q / 2, nb = q % 2;
            transpose_item(cw2 + ((size_t)l * 2 + kv) * 128 * 64, 128, 64, w2t + ((size_t)l * 2 + kv) * 64 * 128, kb * 64, nb * 32, nb * 32, scr, lane); }
    }
}
constexpr int CONV_NIT = NE * (16 * 32 + 16 * 16);
#ifndef CONV_C1
#define CONV_C1 (NE * 16 * 32)
#endif
__device__ __forceinline__ void conv_items(int lo, int hi, int gw, int NGW, int lane, const float* w_up, const float* w_dn, unsigned char* wt_up, unsigned char* wt_dn) {
    int ln = lane; asm volatile("" : "+v"(ln));
#pragma unroll 1
    for (int it = lo + gw; it < hi; it += 2 * NGW) {
        float4 va[16], vb[16]; const float* s0; unsigned char* d0; int n0_; float c0_; const float* s1; unsigned char* d1; int n1_; float c1_;
        const int it1 = (it + NGW < hi) ? it + NGW : it;
        t64_item(it, w_up, w_dn, wt_up, wt_dn, ln, s0, d0, n0_, c0_); t64_item(it1, w_up, w_dn, wt_up, wt_dn, ln, s1, d1, n1_, c1_);
        t64_load(s0, n0_, va); t64_load(s1, n1_, vb);
        t64_store_f8(d0, D_, c0_, va); t64_store_f8(d1, D_, c1_, vb);
    }
}
#define M1EN(x) ((MM & (x)) != 0)
#ifndef M1REP
#define M1R(x) 1
#else
#define M1R(x) (((x) == M1REP) ? 3 : 1)
#endif
template <int MM = 31> PH void ph_mix1(int wv, const bf16* hb, const float* lb, bf16* hqt, bf16* hkt, bf16* hqp, bf16* hvt, float* hut, float* hdk,
                const float* glw, const float* glb, bf16* vlnT, const bf16* w1t, const float* cbias, const bf16* w2, bf16* kcb, bf16* vcb,
                const float* cosT, const float* sinT, bf16* ksb, bf16* vsb, bf16* kwb, bf16* vwb,
                const float* w_up, const float* w_dn, unsigned char* wt_up, unsigned char* wt_dn) {
    extern __shared__ __attribute__((aligned(16))) unsigned char lds[];
    int tid = mk_tid(wv), bid = blockIdx.x; asm volatile("" : "+v"(tid), "+s"(bid)); const int lane = tid & 63, wave = wv, G = gridDim.x;
    const int gw = bid * 8 + wave, NGW = G * 8;
    { int ln = lane; asm volatile("" : "+v"(ln));
#pragma unroll 1
    for (int rp = 0; rp < M1R(1); ++rp)
#pragma unroll 1
    for (int u = bid; u < 256 && M1EN(1); u += G) wt::cmp_wg(hb, w1t, cbias, w2, kcb, vcb, (WT_LAS float*)lds, u, wave, ln); }
#pragma unroll 1
    for (int pass = 0; pass < 2; ++pass) {
#ifdef M1_SEQ
        if (pass == 0) {
#else
        if (((pass ^ wave) & 1) == 0) {
#endif
            { int ln = lane; asm volatile("" : "+v"(ln));
#pragma unroll 1
            for (int rp = 0; rp < M1R(2); ++rp)
#pragma unroll 1
            for (int u = gw; u < 2048 && M1EN(2); u += NGW) wt::hg_pass1(hb, lb, hqt, hkt, hqp, hvt, hut, hdk, u, ln); }
            { int ln = lane; asm volatile("" : "+v"(ln));
#pragma unroll 1
            for (int rp = 0; rp < M1R(4); ++rp)
#pragma unroll 1
            for (int u = gw; u < NT / 8 && M1EN(4); u += NGW) wt::gm_ln8(hb, glw, glb, vlnT, u, ln); }
            { int t_ = tid; asm volatile("" : "+v"(t_));
#pragma unroll 1
            for (int rp = 0; rp < M1R(8); ++rp)
#pragma unroll 1
            for (int idx = bid * NTHR + t_; idx < NT * 8 && M1EN(8); idx += G * NTHR) wt::kvprep8(hb, cosT, sinT, ksb, vsb, kwb, vwb, idx); }
        } else {
            int ln = lane; asm volatile("" : "+v"(ln));
            constexpr int NIT = NE * (16 * 32 + 16 * 16);
            if (M1EN(16)) conv_items(0, CONV_C1, gw, NGW, ln, w_up, w_dn, wt_up, wt_dn);
            if (MM & 64) {
#pragma unroll 1
                for (int it = gw; it < NIT; it += NGW) {
                    float4 va[16]; const float* s0; unsigned char* d0; int n0_; float c0_;
                    t64_item(it, w_up, w_dn, wt_up, wt_dn, ln, s0, d0, n0_, c0_);
                    d0 = wt_up + ((size_t)1 << 30) + (size_t)it * 4096 + ln * 16;
                    t64_load(s0, n0_, va); t64_store_f8(d0, 1024, c0_, va);
                }
            }
            if (MM & 128) {
#pragma unroll 1
                for (int it = gw; it < NIT; it += NGW) {
                    float4 va[16]; const float* s0; unsigned char* d0; int n0_; float c0_;
                    t64_item(it, w_up, w_dn, wt_up, wt_dn, ln, s0, d0, n0_, c0_);
                    s0 = (it < NE * 512) ? w_up + (size_t)it * 4096 + ln * 4 : w_dn + (size_t)(it - NE * 512) * 4096 + ln * 4;
                    d0 += ((size_t)1 << 30);
                    t64_load(s0, 256, va); t64_store_f8(d0, D_, c0_, va);
                }
            }
            if (MM & 256) {
#pragma unroll 1
                for (int it = gw; it < NIT; it += NGW) {
                    float4 va[16];
                    const float* s0; int n0_;
                    if (it < NE * 512) { const int e = it / 512, r = it % 512, kb = r / 8, nb = r % 8; s0 = w_up + (size_t)e * D_ * 2048 + (size_t)(kb * 16) * 2048 + nb * 256 + ln * 4; n0_ = 2048; }
                    else { const int r0 = it - NE * 512; const int e = r0 / 256, r = r0 % 256, kb = r / 4, nb = r % 4; s0 = w_dn + (size_t)e * D_ * D_ + (size_t)(kb * 16) * D_ + nb * 256 + ln * 4; n0_ = D_; }
                    unsigned char* d0 = wt_up + ((size_t)1 << 30) + (size_t)it * 4096 + ln * 16;
                    t64_load(s0, n0_, va); t64_store_f8(d0, 1024, 64.f, va);
                }
            }
            if (MM & 512) {
#pragma unroll 1
                for (int it = gw; it < NIT; it += NGW) {
                    float4 va[16];
                    const float* s0; int n0_;
                    if (it < NE * 512) { const int e = it / 512, r = it % 512, kb = r / 2, nb = r % 2; s0 = w_up + (size_t)e * D_ * 2048 + (size_t)(kb * 4) * 2048 + nb * 1024 + ln * 4; n0_ = 2048; }
                    else { const int r0 = it - NE * 512; const int e = r0 / 256, r = r0 % 256; s0 = w_dn + (size_t)e * D_ * D_ + (size_t)(r * 4) * D_ + ln * 4; n0_ = D_; }
#pragma unroll
                    for (int i = 0; i < 16; ++i) { typedef float f4v __attribute__((ext_vector_type(4))); const f4v t = __builtin_nontemporal_load((const f4v*)(s0 + (size_t)(i >> 2) * n0_ + (i & 3) * 256)); va[i] = make_float4(t.x, t.y, t.z, t.w); }
                    unsigned char* d0 = wt_up + ((size_t)1 << 30) + (size_t)it * 4096 + ln * 16;
                    t64_store_f8(d0, 1024, 64.f, va);
                }
            }
            if (MM & 1024) {
                const unsigned lbase = (unsigned)(size_t)lds + (unsigned)wave * 16384u;
                LAS const unsigned char* lrd = (LAS const unsigned char*)lds + wave * 16384 + ln * 16;
#pragma unroll 1
                for (int it = gw; it < NIT; it += NGW) {
                    float4 va[16]; const float* s0; unsigned char* d0; int n0_; float c0_;
                    t64_item(it, w_up, w_dn, wt_up, wt_dn, ln, s0, d0, n0_, c0_);
#pragma unroll
                    for (int i = 0; i < 16; ++i) { unsigned _keep; const void* _g = (const void*)(s0 + (size_t)i * n0_); const unsigned _d = (unsigned)__builtin_amdgcn_readfirstlane((int)(lbase + i * 1024));
                        asm volatile("s_mov_b32 %0, m0\n\ts_mov_b32 m0, %2\n\ts_nop 0\n\tglobal_load_lds_dwordx4 %1, off\n\ts_mov_b32 m0, %0" : "=&s"(_keep) : "v"(_g), "s"(_d) : "memory"); }
                    asm volatile("s_waitcnt vmcnt(0)" ::: "memory");
#pragma unroll
                    for (int i = 0; i < 16; ++i) { typedef float f4v __attribute__((ext_vector_type(4))); const f4v t = *(LAS const f4v*)(lrd + i * 1024); va[i] = make_float4(t.x, t.y, t.z, t.w); }
                    t64_store_f8(d0, D_, c0_, va);
                }
            }
            if (MM & 2048) {
#pragma unroll 1
                for (int it = gw; it < NIT; it += 2 * NGW) {
                    float4 va[16], vb[16]; const float* s0; unsigned char* d0; int n0_; float c0_; const float* s1; unsigned char* d1; int n1_; float c1_;
                    const int it1 = (it + NGW < NIT) ? it + NGW : it;
                    t64_item(it, w_up, w_dn, wt_up, wt_dn, ln, s0, d0, n0_, c0_); t64_item(it1, w_up, w_dn, wt_up, wt_dn, ln, s1, d1, n1_, c1_);
                    t64_load(s0, n0_, va); t64_load(s1, n1_, vb);
                    t64_store_f8(d0, D_, c0_, va); t64_store_f8(d1, D_, c1_, vb);
                }
            }
            if (MM & 32) {
#pragma unroll 1
                for (int it = gw; it < NIT; it += NGW) {
                    float4 va[16];
                    const float* s0 = (it < NE * 512) ? w_up + (size_t)it * 4096 + ln * 4 : w_dn + (size_t)(it - NE * 512) * 4096 + ln * 4;
                    unsigned char* d0 = wt_up + ((size_t)1 << 30) + (size_t)it * 4096 + ln * 16;
                    t64_load(s0, 256, va); t64_store_f8(d0, 1024, 64.f, va);
                }
            }
        }
    }
}
PH void ph_mix2(int wv, const float* hut, const float* hdk, bf16* hst, const bf16* hb, const bf16* vlnT, const bf16* wb, const float* sb, const float* nw, bf16* ycat,
                const float* w_up, const float* w_dn, unsigned char* wt_up, unsigned char* wt_dn) {
    int tid = mk_tid(wv), bid = blockIdx.x; asm volatile("" : "+v"(tid), "+s"(bid)); const int lane = tid & 63, wave = wv, G = gridDim.x;
    const int gw = bid * 8 + wave, NGW = G * 8;
#pragma unroll 1
    for (int pass = 0; pass < 2; ++pass) {
        if (((pass ^ wave) & 1) == 0) {
            int t_ = tid; asm volatile("" : "+v"(t_));
#pragma unroll 1
            for (int e = bid * NTHR + t_; e < 32 * 4096; e += G * NTHR) wt::hg_scan(hut, hdk, hst, e);
            int ln = t_ & 63; asm volatile("" : "+v"(ln));
#pragma unroll 1
            for (int u = gw; u < 4096; u += NGW) wt::gm_sp_task(hb, vlnT, wb, sb, nw, ycat, u, ln);
        } else {
            conv_items(CONV_C1, CONV_NIT, gw, NGW, lane, w_up, w_dn, wt_up, wt_dn);
        }
    }
}
PH void ph_hg3(int wv, const bf16* hb, const bf16* hqt, const bf16* hkt, const bf16* hqp, const bf16* hvt, const bf16* hst, const float* nw, bf16* ycat) {
    int tid = mk_tid(wv), bid = blockIdx.x; asm volatile("" : "+v"(tid), "+s"(bid)); const int lane = tid & 63, wave = wv, G = gridDim.x;
    const int gw = bid * 8 + wave, NGW = G * 8;
#pragma unroll 1
    for (int u = gw; u < 4096; u += NGW) wt::hg_pass3(hb, hqt, hkt, hqp, hvt, hst, nw, ycat, u, lane);
}
PH void ph_ln1_route(int wv, const float* xin_f, const bf16* xin_b, const bf16* mix, const float* lw, const float* lb, bf16* x1b, unsigned char* x1q,
                     const bf16* rwh, const bf16* rwl, const float* rb, int* cnt, int* list, int* tok_e, int* tok_slot, float* tok_w) {
    int tid = mk_tid(wv), bid = blockIdx.x; asm volatile("" : "+v"(tid), "+s"(bid)); const int lane = tid & 63, wave = wv, G = gridDim.x;
#pragma unroll 1
    for (int it = bid; it < NT / 128; it += G) {
        { int ln = lane; asm volatile("" : "+v"(ln));
#pragma unroll 1
          for (int k = 0; k < 8; ++k) ln1_tok2(xin_f, xin_b, mix, lw, lb, x1b, x1q, it * 128 + wave * 16 + 2 * k, ln); }
        asm volatile("s_waitcnt vmcnt(0)" ::: "memory"); __builtin_amdgcn_fence(__ATOMIC_RELEASE, "workgroup"); __syncthreads(); __builtin_amdgcn_fence(__ATOMIC_ACQUIRE, "workgroup");
        if (wave < 4) { int ln = lane; asm volatile("" : "+v"(ln)); wt::route_task(x1b, rwh, rwl, rb, cnt, list, tok_e, tok_slot, tok_w, it * 4 + wave, ln); }
    }
}
PH void ph_comb(int wv, const bf16* x1, const bf16* ybuf, const int* tok_e, const int* tok_slot, const float* tok_w, const float* lw, const float* lb, float* xo, bf16* xbo, unsigned char* xqo) {
    extern __shared__ __attribute__((aligned(16))) unsigned char lds[];
    const int* offs_s = (const int*)(lds + TAB_OFF + 512);
    int tid = mk_tid(wv), bid = blockIdx.x; asm volatile("" : "+v"(tid), "+s"(bid)); const int lane = tid & 63, wave = wv, G = gridDim.x;
#pragma unroll 1
    for (int t0 = (bid * 8 + wave) * 16; t0 < NT; t0 += G * 128) {
        const int ia = t0 * 4 + lane;
        const int rowl = offs_s[tok_e[ia]] + tok_slot[ia]; const float wl = tok_w[ia];
#pragma unroll 1
        for (int p = 0; p < 8; ++p) {
            int row[2][4]; float wk[2][4];
#pragma unroll
            for (int u = 0; u < 2; ++u)
#pragma unroll
                for (int k = 0; k < 4; ++k) { row[u][k] = __shfl(rowl, p * 8 + u * 4 + k); wk[u][k] = __shfl(wl, p * 8 + u * 4 + k); }
            comb_ln2_tok2(x1, ybuf, offs_s, tok_e, tok_slot, tok_w, lw, lb, xo, xbo, xqo, t0 + 2 * p, lane, row, wk);
        }
    }
}

typedef const Args __attribute__((address_space(4))) CArgs;
#define PHASE_BEGIN CArgs* ap = (CArgs*)__builtin_amdgcn_kernarg_segment_ptr(); int l_ = l; asm volatile("" : "+s"(ap), "+s"(l_)); unsigned char* const ws_ = ap->ws; \
    const int G = gridDim.x; int bid = blockIdx.x; asm volatile("" : "+s"(bid));
#define WP(T, off) ((T*)(ws_ + (off)))
#define INP(k) (ap->in[k])
__global__ void __launch_bounds__(NTHR, 2) mega(Args a) {
    extern __shared__ __attribute__((aligned(16))) unsigned char lds[];
    volatile LAS unsigned* MISC = (volatile LAS unsigned*)((LAS unsigned char*)lds + MISC_OFF);
    int wv = __builtin_amdgcn_readfirstlane((int)threadIdx.x >> 6); asm volatile("" : "+s"(wv));
    { const int t0 = mk_tid(wv); if (t0 < 64) MISC[t0] = 0u; }
    __syncthreads();
    XcdBarrier bar = xcd_barrier_post((unsigned*)a.ws, MISC + 8, wv);
    int* tstart = (int*)(lds + TAB_OFF); int* cnts = (int*)(lds + TAB_OFF + 256); int* offs_s = (int*)(lds + TAB_OFF + 512);
    PG8_LAS unsigned char* ldsl = (PG8_LAS unsigned char*)lds;

#ifndef PH_MASK
#define EN(n) 1
#else
#define EN(n) ((PH_MASK >> ((n) % 20)) & 1)
#endif
#define IN(k) 1
#ifndef REP_PH
#define REPL(id)
#else
#define REPL(id) _Pragma("unroll 1") for (int rep_ = 0; rep_ < (((id) == REP_PH) ? REP_N : 1); ++rep_)
#endif
#define SEAM(k) xcd_barrier(bar)

    REPL(19) if (EN(19) && IN(0)) { const int l = 0; PHASE_BEGIN; (void)l_; (void)G; (void)bid;
        ph_prologue(wv, (const int*)INP(1), INP(3), WP(float, O_COS), WP(float, O_SIN), WP(float, O_LB), INP(0), WP(bf16, O_XB), WP(unsigned char, O_X1Q), INP(2), INP(14), INP(19), INP(21),
                    WP(bf16, O_WIN), WP(unsigned char, O_WIN8), WP(bf16, O_WOUT), WP(bf16, O_WUP), WP(bf16, O_WDN), INP(7), WP(bf16, O_WB), INP(10), INP(11), WP(bf16, O_W1T), WP(float, O_CBIAS), INP(12), WP(bf16, O_W2T), INP(17), WP(bf16, O_RWH), WP(bf16, O_RWL)); }
    xcd_barrier_first(bar);

#pragma unroll 1
    for (int l = 0; l < DEPTH; ++l) {
        REPL(0) if (EN(0) && IN(pb + 0)) {
            PHASE_BEGIN;
            if (WIN_SPLIT > 0) {
                pg8::PlainOrder S{WP(unsigned char, O_WIN8) + (size_t)l_ * HS * D_, D_, NT / 256, WIN_SPLIT, G, bid, 0};
                pg8::EpiBf16 E{WP(bf16, O_HB), HS, nullptr, 0, 1.0f / pg8::F8_SI};
                pg8::gemm_phase<pg8::EpiBf16, pg8::PlainOrder, true, true>(wv, ldsl, WP(unsigned char, O_X1Q), D_, S, E);
            }
            if (WIN_SPLIT < HS / 256) {
                pg8::PlainOrder S{WP(bf16, O_WIN) + (size_t)l_ * HS * D_, D_ * 2, NT / 256, HS / 256 - WIN_SPLIT, G, bid, WIN_SPLIT};
                pg8::EpiBf16 E{WP(bf16, O_HB), HS, nullptr, 0, 1.0f};
                pg8::gemm_phase<pg8::EpiBf16, pg8::PlainOrder, true>(wv, ldsl, WP(bf16, O_XB), D_ * 2, S, E);
            }
        }
        SEAM(pb + 0);
        REPL(1) if (EN(1)) {
            PHASE_BEGIN; (void)G; (void)bid;
            ph_mix1(wv, WP(bf16, O_HB), WP(float, O_LB) + l_ * 256, WP(bf16, O_HQT), WP(bf16, O_HKT), WP(bf16, O_HQP), WP(bf16, O_HVT), WP(float, O_HUT), WP(float, O_HDK),
                    INP(5) + l_ * 256, INP(6) + l_ * 256, WP(bf16, O_VLNT), WP(bf16, O_W1T) + (size_t)l_ * 2 * 128 * 2048, WP(float, O_CBIAS) + l_ * 256, WP(bf16, O_W2T) + (size_t)l_ * 2 * 64 * 128,
                    WP(bf16, O_KCB), WP(bf16, O_VCB), WP(float, O_COS), WP(float, O_SIN), WP(bf16, O_KSB), WP(bf16, O_VSB), WP(bf16, O_KWB), WP(bf16, O_VWB),
                    INP(19) + (size_t)l_ * NE * D_ * 2048, INP(21) + (size_t)l_ * NE * D_ * D_, WP(unsigned char, O_WUP) + (size_t)l_ * NE * 2048 * D_, WP(unsigned char, O_WDN) + (size_t)l_ * NE * D_ * D_);
        }
        SEAM(pb + 1);
#ifdef DUP_MIX1
        {
            PHASE_BEGIN; (void)G; (void)bid;
            ph_mix1<DUP_MIX1>(wv, WP(bf16, O_HB), WP(float, O_LB) + l_ * 256, WP(bf16, O_HQT), WP(bf16, O_HKT), WP(bf16, O_HQP), WP(bf16, O_HVT), WP(float, O_HUT), WP(float, O_HDK),
                    INP(5) + l_ * 256, INP(6) + l_ * 256, WP(bf16, O_VLNT), WP(bf16, O_W1T) + (size_t)l_ * 2 * 128 * 2048, WP(float, O_CBIAS) + l_ * 256, WP(bf16, O_W2T) + (size_t)l_ * 2 * 64 * 128,
                    WP(bf16, O_KCB), WP(bf16, O_VCB), WP(float, O_COS), WP(float, O_SIN), WP(bf16, O_KSB), WP(bf16, O_VSB), WP(bf16, O_KWB), WP(bf16, O_VWB),
                    INP(19) + (size_t)l_ * NE * D_ * 2048, INP(21) + (size_t)l_ * NE * D_ * D_, WP(unsigned char, O_WUP) + (size_t)l_ * NE * 2048 * D_, WP(unsigned char, O_WDN) + (size_t)l_ * NE * D_ * D_);
        }
        SEAM(pb + 1);
#endif
        REPL(11) if (EN(11)) {
            PHASE_BEGIN; (void)G; (void)bid;
            ph_mix2(wv, WP(float, O_HUT), WP(float, O_HDK), WP(bf16, O_HST), WP(bf16, O_HB), WP(bf16, O_VLNT), WP(bf16, O_WB) + (size_t)l_ * 4 * 128 * 128, INP(8) + l_ * 512, INP(9) + l_ * 256, WP(bf16, O_YCAT),
                    INP(19) + (size_t)l_ * NE * D_ * 2048, INP(21) + (size_t)l_ * NE * D_ * D_, WP(unsigned char, O_WUP) + (size_t)l_ * NE * 2048 * D_, WP(unsigned char, O_WDN) + (size_t)l_ * NE * D_ * D_);
        }
        SEAM(pb + 1);
        {
            PHASE_BEGIN;
            REPL(2) if (EN(2)) ph_hg3(wv, WP(bf16, O_HB), WP(bf16, O_HQT), WP(bf16, O_HKT), WP(bf16, O_HQP), WP(bf16, O_HVT), WP(bf16, O_HST), INP(4) + l_ * 256, WP(bf16, O_YCAT));
            REPL(12) if (EN(12)) {
                nsa::Params NP{WP(bf16, O_HB), WP(bf16, O_KCB), WP(bf16, O_VCB), WP(bf16, O_KSB), WP(bf16, O_VSB), WP(bf16, O_KWB), WP(bf16, O_VWB), WP(float, O_COS), WP(float, O_SIN), INP(13) + l_ * 512, WP(bf16, O_YCAT)};
                int tid = mk_tid(wv); asm volatile("" : "+v"(tid));
                __syncthreads();
                nsa::phase(NP, ldsl, tid, bid, G);
            }
        }
        SEAM(pb + 2);
        REPL(3) if (EN(3) && IN(pb + 3)) {
            PHASE_BEGIN;
            pg8::PlainOrder S{WP(bf16, O_WOUT) + (size_t)l_ * D_ * D_, D_ * 2, NT / 256, D_ / 256, G, bid, 0};
            pg8::EpiBf16 E{WP(bf16, O_MIXB), D_, nullptr, 0, 1.0f};
            pg8::gemm_phase<pg8::EpiBf16, pg8::PlainOrder, true>(wv, ldsl, WP(bf16, O_YCAT), D_ * 2, S, E);
#ifdef DUP_WOUT
            pg8::gemm_phase<pg8::EpiBf16, pg8::PlainOrder, true>(wv, ldsl, WP(bf16, O_YCAT), D_ * 2, S, E);
#endif
        }
        SEAM(pb + 3);
        if (EN(4)) {
            PHASE_BEGIN; (void)G; (void)bid;
            ph_ln1_route(wv, l_ == 0 ? INP(0) : (const float*)nullptr, WP(bf16, O_XB), WP(bf16, O_MIXB), INP(15) + l_ * D_, INP(16) + l_ * D_, WP(bf16, O_X1B), WP(unsigned char, O_X1Q),
                         WP(bf16, O_RWH) + (size_t)l_ * NE * D_, WP(bf16, O_RWL) + (size_t)l_ * NE * D_, INP(18) + l_ * NE,
                         (int*)(ws_ + 32768) + l_ * 64, WP(int, O_LIST), WP(int, O_TE), WP(int, O_TS), WP(float, O_TW));
        }
        SEAM(pb + 4);
        if (IN(pb + 5) || IN(pb + 6) || IN(pb + 7)) {
            PHASE_BEGIN; (void)G; (void)bid;
            int* cnt = (int*)(ws_ + 32768) + l_ * 64;
            __syncthreads();
            if (wv == 0) {
                const int ln = mk_tid(wv) & 63, e = ln & 31;
                const int c = __hip_atomic_load(&cnt[e], __ATOMIC_RELAXED, __HIP_MEMORY_SCOPE_AGENT);
                const int nt_ = (c + 255) >> 8; int incl = nt_;
#pragma unroll
                for (int o = 1; o < 32; o <<= 1) { const int v = __shfl_up(incl, o, 32); if (e >= o) incl += v; }
                if (ln < 32) { tstart[e] = incl - nt_; offs_s[e] = (incl - nt_) * 256; cnts[e] = c; if (e == 31) tstart[32] = incl; }
            }
            __syncthreads();
        }
        REPL(5) if (EN(5) && IN(pb + 5)) {
            PHASE_BEGIN;
            pg8::MoeOrder<true> S{WP(unsigned char, O_WUP) + (size_t)l_ * NE * 2048 * D_, D_, 8, G, bid, (size_t)2048 * D_, tstart, cnts, WP(int, O_LIST)};
            pg8::EpiUpF8 E{WP(unsigned char, O_ACT), INP(20) + (size_t)l_ * NE * 2048};
            pg8::gemm_phase<pg8::EpiUpF8, pg8::MoeOrder<true>, true, true>(wv, ldsl, WP(unsigned char, O_X1Q), D_, S, E);
        }
        SEAM(pb + 5);
        REPL(6) if (EN(6) && IN(pb + 6)) {
            PHASE_BEGIN;
            pg8::MoeOrder<false> S{WP(unsigned char, O_WDN) + (size_t)l_ * NE * D_ * D_, D_, 4, G, bid, (size_t)D_ * D_, tstart, cnts, WP(int, O_LIST)};
            pg8::EpiDnF8 E{WP(bf16, O_YB), INP(22) + (size_t)l_ * NE * D_};
            pg8::gemm_phase<pg8::EpiDnF8, pg8::MoeOrder<false>, true, true>(wv, ldsl, WP(unsigned char, O_ACT), D_, S, E);
        }
        SEAM(pb + 6);
        REPL(7) if (EN(7) && IN(pb + 7)) {
            PHASE_BEGIN; (void)G; (void)bid;
            ph_comb(wv, WP(bf16, O_X1B), WP(bf16, O_YB), WP(int, O_TE), WP(int, O_TS), WP(float, O_TW), INP(23) + l_ * D_, INP(24) + l_ * D_,
                    (l_ == DEPTH - 1) ? ap->out : (float*)nullptr, (l_ == DEPTH - 1) ? (bf16*)nullptr : WP(bf16, O_XB), WP(unsigned char, O_X1Q));
        }
#ifdef XTRA_BAR
#pragma unroll 1
        for (int xb_ = 0; xb_ < XTRA_BAR; ++xb_) SEAM(pb + 7);
#endif
        if (l + 1 < DEPTH) SEAM(pb + 7);
    }
#undef IN
#undef SEAM
}
}

extern "C" void kernel_launch(void* const* d_in, const int* in_sizes, int n_in, void* d_out, int out_size, void* d_ws, size_t ws_size, hipStream_t stream) {
    using namespace mk;
    static int grid = 0;
    if (grid == 0) {
        size_t need = WS_NEED;
        if (n_in != 25 || need > ws_size) { fprintf(stderr, "kernel_launch: bad args n_in %d need %zu ws %zu\n", n_in, need, ws_size); grid = -1; return; }
        int dev = 0, cus = 0, per_cu = 0;
        if (hipGetDevice(&dev) != hipSuccess || hipDeviceGetAttribute(&cus, hipDeviceAttributeMultiprocessorCount, dev) != hipSuccess) { grid = -1; return; }
        if (hipFuncSetAttribute((const void*)mega, hipFuncAttributeMaxDynamicSharedMemorySize, LDS_BYTES) != hipSuccess) { fprintf(stderr, "hipFuncSetAttribute failed\n"); grid = -1; return; }
        if (hipOccupancyMaxActiveBlocksPerMultiprocessor(&per_cu, (const void*)mega, NTHR, LDS_BYTES) != hipSuccess || per_cu < 1) fprintf(stderr, "occupancy query: %d\n", per_cu);
        (void)hipGetLastError();
        grid = cus;
    }
    if (grid < 0) return;
    if (hipMemsetAsync(d_ws, 0, CTL_BYTES, stream) != hipSuccess) return;
    Args a{};
    for (int i = 0; i < 25; ++i) a.in[i] = (const float*)d_in[i];
    a.out = (float*)d_out; a.ws = (unsigned char*)d_ws; a.ph_lo = 0; a.ph_hi = 1 + DEPTH * NPH;
    hipLaunchKernelGGL(mega, dim3(grid), dim3(NTHR), LDS_BYTES, stream, a);
}
```

```cpp
#include <hip/hip_runtime.h>
#include <cstdio>
#include <cstdint>
#include <cmath>

__device__ __forceinline__ int mk_tid(int wv) { int lane; asm volatile("v_mbcnt_lo_u32_b32 %0, -1, 0\n\tv_mbcnt_hi_u32_b32 %0, -1, %0" : "=v"(lane)); return (wv << 6) | lane; }
#define XB_TMO      128
#define XB_XCNT(j)  (256  + 64 * (j))
#define XB_XSUB(j)  (1280 + 64 * (j))
#define XB_XGEN(j)  (2304 + 64 * (j))
#define XB_TOP      3328
#define XB_TOPGEN   3392
#define XCD_BAR_WORDS 3456
#define XB_SPIN_CAP (1u << 18)
#define LAS __attribute__((address_space(3)))

__device__ __forceinline__ unsigned xb_ld(unsigned* p)              { return __hip_atomic_load(p, __ATOMIC_RELAXED, __HIP_MEMORY_SCOPE_AGENT); }
__device__ __forceinline__ unsigned xb_add(unsigned* p, unsigned v) { return __hip_atomic_fetch_add(p, v, __ATOMIC_RELAXED, __HIP_MEMORY_SCOPE_AGENT); }
__device__ __forceinline__ unsigned xb_xcc_id() { return (unsigned)__builtin_amdgcn_s_getreg((3 << 11) | 20) & 0xFu; }
#define XB_SPIN(cond, bar) do { unsigned _sp = 0; while (cond) { __builtin_amdgcn_s_sleep(1); \
    if ((++_sp & 255u) == 0u) { if (xb_ld(&(bar)[XB_TMO])) break; if (_sp > XB_SPIN_CAP) { atomicAdd(&(bar)[XB_TMO], 1u); break; } } } } while (0)

struct XcdBarrier {
    unsigned* bar; unsigned x;
    volatile LAS unsigned* st; int wv;
};

__device__ __forceinline__ XcdBarrier xcd_barrier_post(unsigned* bar, volatile LAS unsigned* st, int wv) {
    XcdBarrier b; b.bar = bar; b.x = xb_xcc_id(); b.st = st; b.wv = wv;
    if (mk_tid(b.wv) == 0) (void)xb_add(&bar[XB_XCNT(b.x)], 1u);
    return b;
}
__device__ __forceinline__ void xcd_barrier_complete(unsigned* bar, unsigned x, unsigned& nloc, unsigned& nx) {
    const unsigned G = gridDim.x * gridDim.y * gridDim.z;
    unsigned sum, cnt, mine, sp = 0u;
    for (;;) {
        sum = 0u; cnt = 0u; mine = 0u;
#pragma unroll
        for (unsigned j = 0; j < 16; ++j) { const unsigned c = xb_ld(&bar[XB_XCNT(j)]); sum += c; cnt += (c > 0u) ? 1u : 0u; mine = (j == x) ? c : mine; }
        if (sum == G) break;
        __builtin_amdgcn_s_sleep(1);
        if ((++sp & 255u) == 0u) { if (xb_ld(&bar[XB_TMO])) break; if (sp > XB_SPIN_CAP) { atomicAdd(&bar[XB_TMO], 1u); break; } }
    }
    nloc = mine > 0u ? mine : 1u; nx = cnt > 0u ? cnt : 1u;
}

template <bool FIRST>
__device__ __forceinline__ void xcd_barrier_t(const XcdBarrier& b) {
    asm volatile("s_waitcnt vmcnt(0)" ::: "memory");
    __syncthreads();
    if (mk_tid(b.wv) == 0) {
        unsigned* bar = b.bar; unsigned bx = b.x; asm volatile("" : "+s"(bar), "+s"(bx));
        __builtin_amdgcn_s_waitcnt(0);
        unsigned nloc = b.st[0], nx = b.st[1];
        if (FIRST) { if (nloc == 0u) { xcd_barrier_complete(bar, bx, nloc, nx); b.st[0] = nloc; b.st[1] = nx; } }
        const unsigned old = xb_add(&bar[XB_XSUB(bx)], 1u);
        const unsigned gen = old / nloc;
        if (old + 1u == (gen + 1u) * nloc) {
            __builtin_amdgcn_fence(__ATOMIC_RELEASE, "agent");
            asm volatile("s_waitcnt vmcnt(0)" ::: "memory");
            const unsigned og = xb_add(&bar[XB_TOP], 1u);
            const unsigned tg = og / nx;
            if (og + 1u == (tg + 1u) * nx) xb_add(&bar[XB_TOPGEN], 1u);
            else XB_SPIN(xb_ld(&bar[XB_TOPGEN]) == tg, bar);
            __builtin_amdgcn_fence(__ATOMIC_ACQUIRE, "agent");
            xb_add(&bar[XB_XGEN(bx)], 1u);
            asm volatile("s_waitcnt vmcnt(0)" ::: "memory");
        } else {
            XB_SPIN(xb_ld(&bar[XB_XGEN(bx)]) == gen, bar);
            __builtin_amdgcn_fence(__ATOMIC_ACQUIRE, "agent");
            asm volatile("s_waitcnt vmcnt(0)" ::: "memory");
        }
    }
    __syncthreads();
}


__device__ __forceinline__ void xcd_barrier_first(const XcdBarrier& b) { xcd_barrier_t<true>(b); }
__device__ __forceinline__ void xcd_barrier(const XcdBarrier& b) { xcd_barrier_t<false>(b); }


namespace mk {
constexpr int B_ = 8, S_ = 4096, D_ = 1024, NT = B_ * S_, DEPTH = 2;
constexpr int INW = 2840, HS = 3072;
constexpr int C_HGQ = 0, C_HGF = 256, C_HGI = 512, C_HGG = 768, C_GMU = 1024, C_GMV = 1280, C_NQ = 1536,
              C_KC = 2048, C_VC = 2176, C_KS = 2304, C_VS = 2432, C_KW = 2560, C_VW = 2688, C_NG = 2816;
constexpr int NCMP = 255, NE = 32, TOPK = 4, NASSIGN = NT * TOPK;
constexpr float ALPHA = 1.4142135623730951f;
constexpr int NTHR = 512, LDS_BYTES = 147456, MISC_OFF = 144 * 1024 - 256;
constexpr int NPH = 8;

typedef unsigned short bf16;
__device__ __forceinline__ float bf2f(bf16 v) { return __uint_as_float((unsigned)v << 16); }
__device__ __forceinline__ unsigned f2bf(float f) { unsigned u = __float_as_uint(f); return (u + 0x7fffu + ((u >> 16) & 1u)) >> 16; }
__device__ __forceinline__ unsigned pk2(float lo, float hi) { return f2bf(lo) | (f2bf(hi) << 16); }
__device__ __forceinline__ float gelu_t(float x) { return 0.5f * x * (1.0f + tanhf(0.7978845608028654f * (x + 0.044715f * x * x * x))); }
__device__ __forceinline__ float sigm(float x) { return 1.0f / (1.0f + expf(-x)); }
__device__ __forceinline__ float wsum(float v) {
#pragma unroll
    for (int o = 1; o < 64; o <<= 1) v += __shfl_xor(v, o);
    return v;
}
__device__ __forceinline__ float wmax(float v) {
#pragma unroll
    for (int o = 1; o < 64; o <<= 1) v = fmaxf(v, __shfl_xor(v, o));
    return v;
}

constexpr int MROWS = NASSIGN + NE * 256;
constexpr size_t CTL_BYTES = 65536;
constexpr size_t al256(size_t x) { return (x + 255) & ~(size_t)255; }
constexpr size_t O_COS = CTL_BYTES, O_SIN = O_COS + al256((size_t)NT * 32 * 4), O_LB = O_SIN + al256((size_t)NT * 32 * 4);
constexpr size_t O_WIN = O_LB + al256(512 * 4), O_WOUT = O_WIN + al256((size_t)DEPTH * HS * D_ * 2), O_WUP = O_WOUT + al256((size_t)DEPTH * D_ * D_ * 2);
constexpr size_t O_WDN = O_WUP + al256((size_t)DEPTH * NE * 2048 * D_ * 2), O_XB = O_WDN + al256((size_t)DEPTH * NE * D_ * D_ * 2);
constexpr size_t O_HB = O_XB + al256((size_t)NT * D_ * 2), O_YCAT = O_HB + al256((size_t)NT * HS * 2), O_MIXB = O_YCAT + al256((size_t)NT * D_ * 2);
constexpr size_t O_X1B = O_MIXB + al256((size_t)NT * D_ * 2), O_ACT = O_X1B + al256((size_t)NT * D_ * 2), O_YB = O_ACT + al256((size_t)MROWS * D_ * 2);
constexpr size_t O_X1Q = O_YB + al256((size_t)MROWS * D_ * 2), O_XA = O_X1Q + al256((size_t)NT * D_ * 4);
constexpr size_t O_VLNT = O_XA + al256((size_t)NT * D_ * 4), O_WB = O_VLNT + al256((size_t)NT * 256 * 2), O_W1T = O_WB + al256((size_t)DEPTH * 4 * 128 * 128 * 2);
constexpr size_t O_CBIAS = O_W1T + al256((size_t)DEPTH * 2 * 128 * 2048 * 2), O_W2T = O_CBIAS + al256((size_t)DEPTH * 2 * 128 * 4), O_RWH = O_W2T + al256((size_t)DEPTH * 2 * 64 * 128 * 2), O_RWL = O_RWH + al256((size_t)DEPTH * NE * D_ * 2), O_HQT = O_RWL + al256((size_t)DEPTH * NE * D_ * 2);
constexpr size_t HGB = (size_t)2048 * 4096 * 2;
constexpr size_t O_HKT = O_HQT + HGB, O_HQP = O_HKT + HGB, O_HVT = O_HQP + HGB, O_HST = O_HVT + HGB, O_HUT = O_HST + HGB, O_HDK = O_HUT + 2 * HGB;
constexpr size_t O_KSB = O_HDK + al256((size_t)2048 * 64 * 4), O_VSB = O_KSB + al256((size_t)NT * 128 * 2);
constexpr size_t O_KWB = O_VSB + al256((size_t)NT * 128 * 2), O_VWB = O_KWB + al256((size_t)NT * 128 * 2), O_KCB = O_VWB + al256((size_t)NT * 128 * 2), O_VCB = O_KCB + al256((size_t)B_ * 2 * 256 * 64 * 2);
constexpr size_t O_LIST = O_VCB + al256((size_t)B_ * 2 * 256 * 64 * 2), O_TE = O_LIST + al256((size_t)NE * NT * 4), O_TS = O_TE + al256((size_t)NASSIGN * 4), O_TW = O_TS + al256((size_t)NASSIGN * 4);
constexpr size_t O_WIN8 = O_TW + al256((size_t)NASSIGN * 4);
constexpr size_t WS_NEED = O_WIN8 + al256((size_t)DEPTH * HS * D_);
#ifndef YCAT_BF16
#define YCAT_F8 1
#endif
namespace pg8 {
#define PG8_LAS __attribute__((address_space(3)))
typedef unsigned short bf16_t;
typedef short bf16x8 __attribute__((ext_vector_type(8)));
typedef float f32x4 __attribute__((ext_vector_type(4)));
typedef float f32x2 __attribute__((ext_vector_type(2)));
typedef unsigned u32x4 __attribute__((ext_vector_type(4)));
constexpr int BM = 256, BK = 64, HALF = 128, HTB = HALF * BK * 2  , STAGE_BYTES = 8 * HTB, NXCD = 8, WGM = 8;

__host__ __device__ __forceinline__ int lds_byte(int r, int c) { const int st = (r >> 4) * 2 + (c >> 5), rr = r & 15, cc = c & 31, ob = rr * 64 + cc * 2; return st * 1024 + (ob ^ (((ob >> 9) & 1) << 5)); }
__host__ __device__ __forceinline__ void stage_rc(int b, int& R, int& C) { const int st = b / 1024, sb = b % 1024, swz = sb ^ (((sb >> 9) & 1) << 5); R = (st >> 1) * 16 + swz / 64; C = (st & 1) * 32 + (swz % 64) / 2; }
__host__ __device__ __forceinline__ int perm32(int rho) { const int n = rho >> 4, i = rho & 15; return 8 * (i >> 2) + 4 * n + (i & 3); }

struct Unit { int pm, pn, e, mt, cnt; };

__device__ __forceinline__ void deal(int L, int nM, int nN, int& pm, int& pn) {
    const int nwg = nM * nN;
    int wgid = L; { const int q = nwg / NXCD, r = nwg % NXCD, xcd = wgid % NXCD, off = wgid / NXCD; wgid = (xcd < r ? xcd * (q + 1) : r * (q + 1) + (xcd - r) * q) + off; }
    const int nig = WGM * nN, gid = wgid / nig, fm = gid * WGM, gsz = (nM - fm) < WGM ? (nM - fm) : WGM;
    pm = fm + ((wgid % nig) % gsz); pn = (wgid % nig) / gsz;
}
struct PlainOrder {
    static constexpr bool GATHERED = false;
    const void* Bt; int rowb; int nM, nN, G, c; int pn0;
    __device__ __forceinline__ bool next(int i, Unit& u) const { const long L = (long)i * G + c; if (L >= (long)nM * nN) return false; deal((int)L, nM, nN, u.pm, u.pn); u.pn += pn0; u.e = 0; u.mt = 0; u.cnt = 0; return true; }
    __device__ __forceinline__ unsigned a_row(const Unit& u, int r) const { return (unsigned)(u.pm * BM + r); }
    __device__ __forceinline__ const char* b_base(const Unit& u) const { return (const char*)Bt + (size_t)u.pn * BM * rowb; }
};
template <bool GATHER> struct MoeOrder {
    static constexpr bool GATHERED = GATHER;
    const void* Bt; int rowb; int nN, G, c; size_t estrideb;
    const int* tstart; const int* cnts; const int* list;
    __device__ __forceinline__ bool next(int i, Unit& u) const {
        const int nM = tstart[32]; const long L = (long)i * G + c; if (L >= (long)nM * nN) return false;
        deal((int)L, nM, nN, u.pm, u.pn);
        const int ln = (int)__builtin_amdgcn_mbcnt_hi(~0u, __builtin_amdgcn_mbcnt_lo(~0u, 0u));
        const int ts = tstart[ln & 31];
        const int e = __popcll(__ballot(ln < 32 && ts <= u.pm)) - 1;
        u.e = e; u.mt = u.pm - __builtin_amdgcn_readfirstlane(tstart[e]); u.cnt = __builtin_amdgcn_readfirstlane(cnts[e]); return true;
    }
    __device__ __forceinline__ unsigned a_row(const Unit& u, int r) const {
        if (GATHER) { const int slot = u.mt * BM + r; return (unsigned)list[u.e * 32768 + (slot < u.cnt ? slot : u.cnt - 1)]; }
        return (unsigned)(u.pm * BM + r);
    }
    __device__ __forceinline__ const char* b_base(const Unit& u) const { return (const char*)Bt + (size_t)u.e * estrideb + (size_t)u.pn * BM * rowb; }
};

__device__ __forceinline__ unsigned cvt_pk_bf16(float lo, float hi) { unsigned r; asm volatile("v_cvt_pk_bf16_f32 %0, %1, %2" : "=v"(r) : "v"(lo), "v"(hi)); return r; }

struct EpiBf16 {
    static constexpr bool PERM = true;
    bf16_t* O; int ldc; const float* bias; int bstride; float scale;
    __device__ __forceinline__ void operator()(const f32x4 (&acc)[2][2][4][2], const Unit& u, int wr, int wc, int fr, int fq) const {
        const int row0 = u.pm * BM + wr * 64 + fr; const int col0 = u.pn * BM + wc * 32 + 8 * fq;
        f32x4 bv[2][2];
#pragma unroll
        for (int bj = 0; bj < 2; ++bj)
#pragma unroll
            for (int n = 0; n < 2; ++n) bv[bj][n] = bias ? *(const f32x4*)(bias + (size_t)u.e * bstride + col0 + bj * HALF + 4 * n) : (f32x4){0.f, 0.f, 0.f, 0.f};
#pragma unroll
        for (int ai = 0; ai < 2; ++ai)
#pragma unroll
            for (int m = 0; m < 4; ++m) { bf16_t* rowp = O + (size_t)(row0 + ai * HALF + m * 16) * ldc + col0;
#pragma unroll
                for (int bj = 0; bj < 2; ++bj) { f32x4 v0 = acc[ai][bj][m][0] * scale + bv[bj][0], v1 = acc[ai][bj][m][1] * scale + bv[bj][1];
                    u32x4 w; w.x = cvt_pk_bf16(v0[0], v0[1]); w.y = cvt_pk_bf16(v0[2], v0[3]); w.z = cvt_pk_bf16(v1[0], v1[1]); w.w = cvt_pk_bf16(v1[2], v1[3]);
                    *(u32x4*)(rowp + bj * HALF) = w; } }
    }
};
__device__ __forceinline__ float swiglu1(float g, float l) {
    g = fminf(g, 7.0f); l = fminf(fmaxf(l, -7.0f), 7.0f);
    const float s = __builtin_amdgcn_rcpf(1.0f + __builtin_amdgcn_exp2f(-1.702f * 1.4426950408889634f * g));
    return g * s * (l + 1.0f);
}
struct EpiUp {
    static constexpr bool PERM = true;
    bf16_t* O; const float* bias;
    __device__ __forceinline__ void operator()(const f32x4 (&acc)[2][2][4][2], const Unit& u, int wr, int wc, int fr, int fq) const {
        const int row0 = u.pm * BM + wr * 64 + fr; const int j0 = u.pn * HALF + wc * 32 + 8 * fq;
        const float* bp = bias + (size_t)u.e * 2048 + j0;
        f32x4 bg[2], bl[2];
#pragma unroll
        for (int n = 0; n < 2; ++n) { bg[n] = *(const f32x4*)(bp + 4 * n); bl[n] = *(const f32x4*)(bp + 1024 + 4 * n); }
#pragma unroll
        for (int ai = 0; ai < 2; ++ai)
#pragma unroll
            for (int m = 0; m < 4; ++m) {
                float o[8];
#pragma unroll
                for (int n = 0; n < 2; ++n) { const f32x4 g = acc[ai][0][m][n] + bg[n], l = acc[ai][1][m][n] + bl[n];
#pragma unroll
                    for (int j = 0; j < 4; ++j) o[4 * n + j] = swiglu1(g[j], l[j]); }
                u32x4 w; w.x = cvt_pk_bf16(o[0], o[1]); w.y = cvt_pk_bf16(o[2], o[3]); w.z = cvt_pk_bf16(o[4], o[5]); w.w = cvt_pk_bf16(o[6], o[7]);
                *(u32x4*)(O + (size_t)(row0 + ai * HALF + m * 16) * 1024 + j0) = w; }
    }
};

constexpr float F8_SU = 64.0f, F8_SA = 4.0f, F8_SD = 128.0f, F8_SI = 64.0f, F8_SO = 64.0f;
__device__ __forceinline__ unsigned pk4_fp8(float a, float b, float c, float d) {
    a = fminf(fmaxf(a, -448.f), 448.f); b = fminf(fmaxf(b, -448.f), 448.f); c = fminf(fmaxf(c, -448.f), 448.f); d = fminf(fmaxf(d, -448.f), 448.f);
    int p = __builtin_amdgcn_cvt_pk_fp8_f32(a, b, 0, false); p = __builtin_amdgcn_cvt_pk_fp8_f32(c, d, p, true); return (unsigned)p;
}
__device__ __forceinline__ unsigned pk4_fp8_raw(float a, float b, float c, float d) { int p = __builtin_amdgcn_cvt_pk_fp8_f32(a, b, 0, false); p = __builtin_amdgcn_cvt_pk_fp8_f32(c, d, p, true); return (unsigned)p; }
struct EpiUpF8 {
    static constexpr bool PERM = true;
    unsigned char* O; const float* bias;
    __device__ __forceinline__ void operator()(const f32x4 (&acc)[2][2][4][2], const Unit& u, int wr, int wc, int fr, int fq) const {
        const int row0 = u.pm * BM + wr * 64 + fr; const int j0 = u.pn * HALF + wc * 32 + 8 * fq;
        const float* bp = bias + (size_t)u.e * 2048 + j0;
        f32x4 bg[2], bl[2];
#pragma unroll
        for (int n = 0; n < 2; ++n) { bg[n] = *(const f32x4*)(bp + 4 * n); bl[n] = *(const f32x4*)(bp + 1024 + 4 * n); }
        const int odd = fq & 1;
        unsigned char* obase = O + (size_t)(row0 + 16 * odd) * 1024 + j0 - 8 * odd;
#pragma unroll
        for (int ai = 0; ai < 2; ++ai)
#pragma unroll
            for (int mp = 0; mp < 2; ++mp) {
                unsigned w[2][2];
#pragma unroll
                for (int mm = 0; mm < 2; ++mm)
#pragma unroll
                    for (int n = 0; n < 2; ++n) { const int m = 2 * mp + mm; const f32x4 g = acc[ai][0][m][n] * (1.0f / F8_SU) + bg[n], l = acc[ai][1][m][n] * (1.0f / F8_SU) + bl[n];
                        w[mm][n] = pk4_fp8(F8_SA * swiglu1(g[0], l[0]), F8_SA * swiglu1(g[1], l[1]), F8_SA * swiglu1(g[2], l[2]), F8_SA * swiglu1(g[3], l[3])); }
                const auto r0 = __builtin_amdgcn_permlane16_swap(w[0][0], w[1][0], false, false);
                const auto r1 = __builtin_amdgcn_permlane16_swap(w[0][1], w[1][1], false, false);
                u32x4 ww = {r0[0], r1[0], r0[1], r1[1]};
                *(u32x4*)(obase + (size_t)(ai * HALF + mp * 32) * 1024) = ww; }
    }
};
struct EpiDnF8 {
    static constexpr bool PERM = true;
    bf16_t* O; const float* bias;
    __device__ __forceinline__ void operator()(const f32x4 (&acc)[2][2][4][2], const Unit& u, int wr, int wc, int fr, int fq) const {
        const int row0 = u.pm * BM + wr * 64 + fr; const int col0 = u.pn * BM + wc * 32 + 8 * fq;
        f32x4 bv[2][2];
#pragma unroll
        for (int bj = 0; bj < 2; ++bj)
#pragma unroll
            for (int n = 0; n < 2; ++n) bv[bj][n] = *(const f32x4*)(bias + (size_t)u.e * 1024 + col0 + bj * HALF + 4 * n);
#pragma unroll
        for (int ai = 0; ai < 2; ++ai)
#pragma unroll
            for (int m = 0; m < 4; ++m) { bf16_t* rowp = O + (size_t)(row0 + ai * HALF + m * 16) * 1024 + col0;
#pragma unroll
                for (int bj = 0; bj < 2; ++bj) { f32x4 v0 = acc[ai][bj][m][0] * (1.0f / (F8_SA * F8_SD)) + bv[bj][0], v1 = acc[ai][bj][m][1] * (1.0f / (F8_SA * F8_SD)) + bv[bj][1];
                    u32x4 w; w.x = cvt_pk_bf16(v0[0], v0[1]); w.y = cvt_pk_bf16(v0[2], v0[3]); w.z = cvt_pk_bf16(v1[0], v1[1]); w.w = cvt_pk_bf16(v1[2], v1[3]);
                    *(u32x4*)(rowp + bj * HALF) = w; } }
    }
};

typedef int v8i32 __attribute__((ext_vector_type(8)));
__device__ __forceinline__ v8i32 pg8_join(const bf16x8 lo, const bf16x8 hi) { typedef int v4i32 __attribute__((ext_vector_type(4)));
    const v4i32 a = __builtin_bit_cast(v4i32, lo), b = __builtin_bit_cast(v4i32, hi); return __builtin_shufflevector(a, b, 0, 1, 2, 3, 4, 5, 6, 7); }
template <class Epi, class Sched, bool ALIGN_EPI, bool F8 = false>
__device__ __forceinline__ void gemm_phase(const int wv, PG8_LAS unsigned char* lds, const void* Abase, const int Kb  , const Sched& S, const Epi& E) {
    int tid = mk_tid(wv); asm volatile("" : "+v"(tid));
    const int wid = __builtin_amdgcn_readfirstlane(tid >> 6), lane = tid & 63, wr = wid >> 2, wc = wid & 3, fr = lane & 15, fq = lane >> 4;
#ifdef DUP_K
    const int nt0 = Kb / 128, nt = 2 * nt0;
#define PG8_KT(t) ((t) % nt0)
#else
    const int nt = Kb / 128;
#define PG8_KT(t) (t)
#endif
    const char* Ab = (const char*)Abase;
    unsigned voffB[2];
#pragma unroll
    for (int i = 0; i < 2; ++i) { int R, C; stage_rc(tid * 16 + i * 8192, R, C); const int Rb = Epi::PERM ? ((R & ~31) + perm32(R & 31)) : R;
        voffB[i] = (unsigned)(Rb * Kb + C * 2); }
    const size_t kstep = (size_t)(BK * 2);
    const size_t hstep = (size_t)HALF * Kb;
    const unsigned rowb = (unsigned)Kb;
    const unsigned ldsw = (unsigned)wid * 1024u;
    const int aoff = lds_byte(wr * 64 + fr, fq * 8), boff = lds_byte(wc * 32 + fr, fq * 8);
#define PG8_SA(b, h) (((b) * 2 + (h)) * HTB)
#define PG8_SB(b, h) ((4 + (b) * 2 + (h)) * HTB)
#define PG8_STAGE(bufoff, gbase, voff) do { _Pragma("unroll") for (int _i = 0; _i < 2; ++_i) { unsigned _v = (voff)[_i]; asm volatile("" : "+v"(_v)); \
        __builtin_amdgcn_global_load_lds((const unsigned*)((const char*)(gbase) + _v), (PG8_LAS unsigned*)(lds + (bufoff) + ldsw + _i * 8192), 16, 0, 0); } } while (0)
#define PG8_STAGE_A(bufoff, kb, o0, o1) do { unsigned _o0 = (o0), _o1 = (o1); asm volatile("" : "+v"(_o0), "+v"(_o1)); \
        __builtin_amdgcn_global_load_lds((const unsigned*)(Ab + (kb) + _o0), (PG8_LAS unsigned*)(lds + (bufoff) + ldsw), 16, 0, 0); \
        __builtin_amdgcn_global_load_lds((const unsigned*)(Ab + (kb) + _o1), (PG8_LAS unsigned*)(lds + (bufoff) + ldsw + 8192), 16, 0, 0); } while (0)
#define PG8_LDA(dst, b, h) do { if constexpr (F8) { _Pragma("unroll") for (int m = 0; m < 4; ++m) dst##8[m] = pg8_join(*(const PG8_LAS bf16x8*)(lds + PG8_SA(b, h) + aoff + m * 2048), *(const PG8_LAS bf16x8*)(lds + PG8_SA(b, h) + aoff + m * 2048 + 1024)); } \
        else { _Pragma("unroll") for (int m = 0; m < 4; ++m) _Pragma("unroll") for (int k = 0; k < 2; ++k) dst[m][k] = *(const PG8_LAS bf16x8*)(lds + PG8_SA(b, h) + aoff + m * 2048 + k * 1024); } } while (0)
#define PG8_LDB(dst, b, h) do { if constexpr (F8) { _Pragma("unroll") for (int n = 0; n < 2; ++n) dst##8[n] = pg8_join(*(const PG8_LAS bf16x8*)(lds + PG8_SB(b, h) + boff + n * 2048), *(const PG8_LAS bf16x8*)(lds + PG8_SB(b, h) + boff + n * 2048 + 1024)); } \
        else { _Pragma("unroll") for (int n = 0; n < 2; ++n) _Pragma("unroll") for (int k = 0; k < 2; ++k) dst[n][k] = *(const PG8_LAS bf16x8*)(lds + PG8_SB(b, h) + boff + n * 2048 + k * 1024); } } while (0)
#define PG8_MMA(ai, bj, At, Bt) do { __builtin_amdgcn_s_setprio(1); _Pragma("unroll") for (int m = 0; m < 4; ++m) _Pragma("unroll") for (int n = 0; n < 2; ++n) { \
        if constexpr (F8) { acc[ai][bj][m][n] = __builtin_amdgcn_mfma_scale_f32_16x16x128_f8f6f4(Bt##8[n], At##8[m], acc[ai][bj][m][n], 0, 0, 0, 0, 0, 0); } \
        else { _Pragma("unroll") for (int k = 0; k < 2; ++k) acc[ai][bj][m][n] = __builtin_amdgcn_mfma_f32_16x16x32_bf16(Bt[n][k], At[m][k], acc[ai][bj][m][n], 0, 0, 0); } } \
        __builtin_amdgcn_s_setprio(0); } while (0)
#define PG8_WAIT_V(n) asm volatile("s_waitcnt vmcnt(" #n ")" ::: "memory")
#define PG8_WAIT_L(n) asm volatile("s_waitcnt lgkmcnt(" #n ")" ::: "memory")
#define PG8_BAR __builtin_amdgcn_s_barrier()
#define PG8_SCHED __builtin_amdgcn_sched_barrier(0)
#define PG8_AOFFS(dst, u) do { int _t = mk_tid(wv); asm volatile("" : "+v"(_t)); _Pragma("unroll") for (int _i = 0; _i < 2; ++_i) { int _R, _C; stage_rc(_t * 16 + _i * 8192, _R, _C); \
        _Pragma("unroll") for (int _h = 0; _h < 2; ++_h) dst[_h][_i] = S.a_row(u, _h * HALF + _R) * rowb + (unsigned)_C * 2u; } } while (0)
    Unit cur, nxt; int ui = 0;
    if (!S.next(0, cur)) return;
    f32x4 acc[2][2][4][2];
#pragma unroll
    for (int a = 0; a < 2; ++a)
#pragma unroll
        for (int b = 0; b < 2; ++b)
#pragma unroll
            for (int m = 0; m < 4; ++m)
#pragma unroll
                for (int n = 0; n < 2; ++n) acc[a][b][m][n] = (f32x4){0.f, 0.f, 0.f, 0.f};
    bf16x8 At[4][2], B0[2][2], B1[2][2];
    v8i32 At8[4], B08[2], B18[2];
    unsigned aC[2][2], aN[2][2];
    PG8_AOFFS(aC, cur);
    const char* cB = S.b_base(cur);
    PG8_STAGE(PG8_SB(0, 0), cB, voffB); PG8_STAGE(PG8_SB(0, 1), cB + hstep, voffB); PG8_STAGE_A(PG8_SA(0, 0), 0, aC[0][0], aC[0][1]); PG8_STAGE_A(PG8_SA(0, 1), 0, aC[1][0], aC[1][1]);
    if (wr == 1) PG8_BAR;
    PG8_WAIT_V(2); PG8_BAR;
    PG8_STAGE(PG8_SB(1, 0), cB + kstep, voffB); PG8_STAGE_A(PG8_SA(1, 0), kstep, aC[0][0], aC[0][1]); PG8_STAGE(PG8_SB(1, 1), cB + hstep + kstep, voffB);
    PG8_WAIT_V(6); PG8_BAR;
    for (;;) {
        const bool has_next = S.next(ui + 1, nxt);
        const char* nB = has_next ? S.b_base(nxt) : cB;
        if (has_next) { PG8_AOFFS(aN, nxt); }
        else {
#pragma unroll
            for (int _h = 0; _h < 2; ++_h)
#pragma unroll
                for (int _i = 0; _i < 2; ++_i) aN[_h][_i] = aC[_h][_i]; }
#pragma unroll 1
        for (int t = 0; t < nt; t += 2) {
            const bool last = (t == nt - 2);
            const size_t kb1 = (size_t)PG8_KT(t + 1) * kstep;
            PG8_LDB(B0, 0, 0); PG8_LDB(B1, 0, 1); PG8_SCHED; PG8_LDA(At, 0, 0); PG8_STAGE_A(PG8_SA(1, 1), kb1, aC[1][0], aC[1][1]);
            PG8_WAIT_V(8); PG8_WAIT_L(0); PG8_BAR; PG8_MMA(0, 0, At, B0); PG8_MMA(0, 1, At, B1); PG8_BAR; PG8_SCHED;
            if (last) {
#pragma unroll
                for (int _h = 0; _h < 2; ++_h)
#pragma unroll
                    for (int _i = 0; _i < 2; ++_i) aC[_h][_i] = aN[_h][_i]; }
            const size_t kb2 = last ? (size_t)0 : (size_t)PG8_KT(t + 2) * kstep; const char* b2 = last ? nB : cB + (size_t)PG8_KT(t + 2) * kstep;
            const size_t kb3 = kb2 + kstep; const char* b3 = b2 + kstep;
            PG8_LDA(At, 0, 1); PG8_STAGE(PG8_SB(0, 0), b2, voffB); PG8_STAGE(PG8_SB(0, 1), b2 + hstep, voffB); PG8_STAGE_A(PG8_SA(0, 0), kb2, aC[0][0], aC[0][1]);
            PG8_WAIT_V(8); PG8_WAIT_L(0); PG8_BAR; PG8_MMA(1, 0, At, B0); PG8_MMA(1, 1, At, B1); PG8_BAR; PG8_SCHED;
            PG8_LDB(B0, 1, 0); PG8_LDB(B1, 1, 1); PG8_SCHED; PG8_LDA(At, 1, 0); PG8_STAGE_A(PG8_SA(0, 1), kb2, aC[1][0], aC[1][1]);
            PG8_WAIT_V(8); PG8_WAIT_L(0); PG8_BAR; PG8_MMA(0, 0, At, B0); PG8_MMA(0, 1, At, B1); PG8_BAR; PG8_SCHED;
            PG8_LDA(At, 1, 1); PG8_STAGE(PG8_SB(1, 0), b3, voffB); PG8_STAGE(PG8_SB(1, 1), b3 + hstep, voffB); PG8_STAGE_A(PG8_SA(1, 0), kb3, aC[0][0], aC[0][1]);
            PG8_WAIT_V(8); PG8_WAIT_L(0); PG8_BAR; PG8_MMA(1, 0, At, B0); PG8_MMA(1, 1, At, B1); PG8_BAR; PG8_SCHED;
        }
        if (ALIGN_EPI) { if (wr == 0) PG8_BAR; }
#ifdef DUP_K
#pragma unroll
        for (int a = 0; a < 2; ++a)
#pragma unroll
            for (int b = 0; b < 2; ++b)
#pragma unroll
                for (int m = 0; m < 4; ++m)
#pragma unroll
                    for (int n = 0; n < 2; ++n) acc[a][b][m][n] = acc[a][b][m][n] * 0.5f;
#endif
        E(acc, cur, wr, wc, fr, fq);
#ifdef DUP_EPI
        E(acc, cur, wr, wc, fr, fq);
#endif
        if (!has_next) break;
#pragma unroll
        for (int a = 0; a < 2; ++a)
#pragma unroll
            for (int b = 0; b < 2; ++b)
#pragma unroll
                for (int m = 0; m < 4; ++m)
#pragma unroll
                    for (int n = 0; n < 2; ++n) acc[a][b][m][n] = (f32x4){0.f, 0.f, 0.f, 0.f};
        cur = nxt; cB = nB; ++ui;
        if (ALIGN_EPI) { if (wr == 1) PG8_BAR; }
    }
    PG8_WAIT_V(0);
    if (!ALIGN_EPI) { if (wr == 0) PG8_BAR; }
    PG8_BAR;
#undef PG8_SA
#undef PG8_SB
#undef PG8_STAGE
#undef PG8_STAGE_A
#undef PG8_LDA
#undef PG8_LDB
#undef PG8_MMA
#undef PG8_WAIT_V
#undef PG8_WAIT_L
#undef PG8_BAR
#undef PG8_SCHED
#undef PG8_AOFFS
#undef PG8_KT
}
}


#ifndef NSA_REP_RANK
#define NSA_REP_RANK 1
#endif
#ifndef NSA_REP_PASSA
#define NSA_REP_PASSA 1
#endif
#ifndef NSA_REP_LOOP
#define NSA_REP_LOOP 1
#endif
namespace nsa {
#define NLAS __attribute__((address_space(3)))
typedef short bf16x8 __attribute__((ext_vector_type(8)));
typedef short s16x4 __attribute__((ext_vector_type(4)));
typedef short v4i16_t __attribute__((ext_vector_type(4)));
typedef float f32x16 __attribute__((ext_vector_type(16)));
typedef float f32x2_t __attribute__((ext_vector_type(2)));
typedef __bf16 bf16x2_t __attribute__((ext_vector_type(2)));
#define NSA_MFMA(a, b, c) __builtin_amdgcn_mfma_f32_32x32x16_bf16((a), (b), (c), 0, 0, 0)
constexpr int L_CK = 0, L_CV = 32768, L_RING = 65536, L_IMP = 0, SLOTB = 16384, L_SELM = 131072 + 1024;
constexpr float QSCALE = 0.125f * 1.4426950408889634f;
constexpr float NEGBIG = -1.0e30f;

__device__ __forceinline__ unsigned cvtpk(float lo, float hi) { f32x2_t v = {lo, hi}; bf16x2_t b = __builtin_convertvector(v, bf16x2_t); return __builtin_bit_cast(unsigned, b); }
__device__ __forceinline__ float bflo(unsigned u) { return __uint_as_float(u << 16); }
__device__ __forceinline__ float bfhi(unsigned u) { return __uint_as_float(u & 0xffff0000u); }
__device__ __forceinline__ float xhalf(float v) { return __shfl_xor(v, 32); }
__device__ __forceinline__ float xhalf_max(float v) { const auto r = __builtin_amdgcn_permlane32_swap(__float_as_uint(v), __float_as_uint(v), false, false); return fmaxf(__uint_as_float(r[0]), __uint_as_float(r[1])); }
__device__ __forceinline__ float xhalf_sum(float v) { const auto r = __builtin_amdgcn_permlane32_swap(__float_as_uint(v), __float_as_uint(v), false, false); return __uint_as_float(r[0]) + __uint_as_float(r[1]); }
__device__ __forceinline__ s16x4 vtr(const NLAS unsigned char* p) { return __builtin_bit_cast(s16x4, __builtin_amdgcn_ds_read_tr16_b64_v4i16((NLAS v4i16_t*)p)); }
__device__ __forceinline__ bf16x8 pack8(const f32x16& x, int s) {
    unsigned p0 = cvtpk(x[8 * s], x[8 * s + 1]), p1 = cvtpk(x[8 * s + 2], x[8 * s + 3]), p2 = cvtpk(x[8 * s + 4], x[8 * s + 5]), p3 = cvtpk(x[8 * s + 6], x[8 * s + 7]);
    typedef unsigned u32x4 __attribute__((ext_vector_type(4)));
    u32x4 u = {p0, p1, p2, p3}; return __builtin_bit_cast(bf16x8, u);
}

struct Params {
    const unsigned short* hb;
    const unsigned short *kcb, *vcb;
    const unsigned short *ksb, *vsb, *kwb, *vwb;
    const float *cosT, *sinT;
    const float* normw;
    unsigned short* ycat;
};

__device__ __forceinline__ void qk_tile(const NLAS unsigned char* kt, const bf16x8 (&qf)[4], const int (&kofs)[4], f32x16& st0, f32x16& st1) {
    bf16x8 k0[4], k1[4];
#pragma unroll
    for (int ks = 0; ks < 4; ++ks) { k0[ks] = *(const NLAS bf16x8*)(kt + kofs[ks]); k1[ks] = *(const NLAS bf16x8*)(kt + kofs[ks] + 4096); }
#pragma unroll
    for (int i = 0; i < 16; ++i) { st0[i] = 0.f; st1[i] = 0.f; }
#pragma unroll
    for (int ks = 0; ks < 4; ++ks) { st0 = NSA_MFMA(k0[ks], qf[ks], st0); st1 = NSA_MFMA(k1[ks], qf[ks], st1); }
}
__device__ __forceinline__ void pv_tile(const NLAS unsigned char* vt, const int (&vofs)[2][2], const f32x16& p0, const f32x16& p1, f32x16& o0, f32x16& o1) {
    bf16x8 pb[2][2];
#pragma unroll
    for (int kt = 0; kt < 2; ++kt)
#pragma unroll
        for (int s = 0; s < 2; ++s) pb[kt][s] = pack8(kt ? p1 : p0, s);
    bf16x8 va[2][2][2];
#pragma unroll
    for (int kt = 0; kt < 2; ++kt)
#pragma unroll
        for (int s = 0; s < 2; ++s) {
            const int kb = (32 * kt + 16 * s) * 128;
#pragma unroll
            for (int mb = 0; mb < 2; ++mb) {
                const s16x4 lo = vtr(vt + kb + vofs[mb][0]), hi = vtr(vt + kb + vofs[mb][1]);
                va[kt][s][mb] = __builtin_shufflevector(lo, hi, 0, 1, 2, 3, 4, 5, 6, 7);
            }
        }
#pragma unroll
    for (int kt = 0; kt < 2; ++kt)
#pragma unroll
        for (int s = 0; s < 2; ++s) { o0 = NSA_MFMA(va[kt][s][0], pb[kt][s], o0); o1 = NSA_MFMA(va[kt][s][1], pb[kt][s], o1); }
}
__device__ __forceinline__ float max3f(float a, float b, float c) { float r; asm("v_max3_f32 %0, %1, %2, %3" : "=v"(r) : "v"(a), "v"(b), "v"(c)); return r; }
constexpr float NEGINF = -__builtin_inff();
template <bool USE_LO>
__device__ __forceinline__ void mask_tile(f32x16& s0, f32x16& s1, const int hi4, const int lo4) {
#pragma unroll
    for (int i = 0; i < 16; ++i) {
        const int kk0 = (i & 3) + 8 * (i >> 2), kk1 = kk0 + 32;
        bool a0 = kk0 <= hi4, a1 = kk1 <= hi4;
        if (USE_LO) { a0 = a0 && (kk0 >= lo4); a1 = a1 && (kk1 >= lo4); }
        s0[i] = a0 ? s0[i] : NEGINF; s1[i] = a1 ? s1[i] : NEGINF;
    }
}
__device__ __forceinline__ void softmax_core(f32x16& s0, f32x16& s1, float& m, float& l, f32x16& o0, f32x16& o1, const bool live = true) {
    float mx = max3f(s0[0], s0[1], s0[2]);
#pragma unroll
    for (int i = 3; i < 15; i += 2) mx = max3f(mx, s0[i], s0[i + 1]);
    mx = max3f(mx, s0[15], s1[0]);
#pragma unroll
    for (int i = 1; i < 15; i += 2) mx = max3f(mx, s1[i], s1[i + 1]);
    mx = fmaxf(mx, s1[15]);
    mx = xhalf_max(mx);
    const float mn = fmaxf(m, mx);
    const float alpha = __builtin_amdgcn_exp2f(m - mn);
    m = mn;
    const float mref = live ? mn : __builtin_inff();
    float sum0 = 0.f, sum1 = 0.f;
#pragma unroll
    for (int i = 0; i < 16; ++i) {
        const float e0 = __builtin_amdgcn_exp2f(s0[i] - mref), e1 = __builtin_amdgcn_exp2f(s1[i] - mref);
        s0[i] = e0; s1[i] = e1; sum0 += e0; sum1 += e1;
    }
    l = l * alpha + (sum0 + sum1);
    if (__ballot(alpha != 1.0f) != 0ull) {
#pragma unroll
        for (int i = 0; i < 16; ++i) { o0[i] *= alpha; o1[i] *= alpha; }
    }
}

__device__ __forceinline__ void unit(const Params& P, NLAS unsigned char* lds, const int tid_in, const int b, const int g, const int qb) {
    int tid = tid_in; asm volatile("" : "+v"(tid));
    const int wv = __builtin_amdgcn_readfirstlane(tid >> 6), lane = tid & 63, r = lane & 31, h = lane >> 5;
    const int head = g * 4 + (wv >> 1), qi = 32 * (wv & 1) + r;
    const int t = qb * 64 + qi, tok = b * 4096 + t;
    const int bg = b * 2 + g;
    int kofs[4];
#pragma unroll
    for (int ks = 0; ks < 4; ++ks) kofs[ks] = r * 128 + ((((2 * ks + h) ^ ((r >> 1) & 7))) << 4);
    int vofs[2][2];
    { const int i16 = lane & 15, blk = (lane >> 4) & 1, q = i16 >> 2, p = i16 & 3;
#pragma unroll
      for (int mb = 0; mb < 2; ++mb)
#pragma unroll
          for (int jj = 0; jj < 2; ++jj) { const int key = 4 * h + 8 * jj + q; const int o = 4 * mb + 2 * blk + (p >> 1);
              vofs[mb][jj] = key * 128 + ((o ^ (((key >> 1) & 1) << 2)) << 4) + (p & 1) * 8; } }
    const int drow = tid >> 3, dpos = tid & 7;
    const unsigned srcK = (unsigned)(drow * 128 + ((dpos ^ ((drow >> 1) & 7)) << 4));
    const unsigned srcV = (unsigned)(drow * 128 + ((dpos ^ (((drow >> 1) & 1) << 2)) << 4));
    const unsigned wdst = (unsigned)wv * 1024u;
    const unsigned lds0 = (unsigned)(size_t)lds;
#define NSA_DMA(slotoff, gsrc, soff) do { unsigned _keep; const void* _g = (const void*)((const char*)(gsrc) + (soff)); const unsigned _d = (unsigned)__builtin_amdgcn_readfirstlane((int)(lds0 + (unsigned)(slotoff) + wdst)); \
        asm volatile("s_mov_b32 %0, m0\n\ts_mov_b32 m0, %2\n\ts_nop 0\n\tglobal_load_lds_dwordx4 %1, off\n\ts_mov_b32 m0, %0" : "=&s"(_keep) : "v"(_g), "s"(_d) : "memory"); } while (0)
    const int nsel = qb + 1, jw0 = qb >= 8 ? qb - 8 : 0, ntiles = nsel + (qb - jw0 + 1);
    const char* ksg = (const char*)P.ksb + (size_t)bg * 4096 * 128; const char* vsg = (const char*)P.vsb + (size_t)bg * 4096 * 128;
    const char* kwg = (const char*)P.kwb + (size_t)bg * 4096 * 128; const char* vwg = (const char*)P.vwb + (size_t)bg * 4096 * 128;
#define NSA_ISSUE(pos) do { const int _p = (pos) < ntiles ? (pos) : ntiles - 1; const bool _w = _p >= nsel; const int _j = _w ? jw0 + _p - nsel : _p; \
        const int _slot = L_RING + ((pos) & 3) * SLOTB; \
        NSA_DMA(_slot, (_w ? kwg : ksg) + (size_t)_j * 8192, srcK); NSA_DMA(_slot + 8192, (_w ? vwg : vsg) + (size_t)_j * 8192, srcV); } while (0)
    { const char* kcg = (const char*)P.kcb + (size_t)bg * 256 * 128; const char* vcg = (const char*)P.vcb + (size_t)bg * 256 * 128;
#pragma unroll
      for (int T = 0; T < 4; ++T) { NSA_DMA(L_CK + T * 8192, kcg + T * 8192, srcK); NSA_DMA(L_CV + T * 8192, vcg + T * 8192, srcV); } }
    NSA_ISSUE(0); NSA_ISSUE(1);
    typedef unsigned u32x4 __attribute__((ext_vector_type(4)));
    bf16x8 qf[4];
    const unsigned short* qrow = P.hb + (size_t)tok * 3072 + 1536 + (head & 7) * 64;
    {
        u32x4 qraw[4];
#pragma unroll
        for (int ks = 0; ks < 4; ++ks) qraw[ks] = *(const u32x4*)(qrow + 16 * ks + 8 * h);
#pragma unroll
        for (int ks = 0; ks < 4; ++ks) { u32x4 o;
#pragma unroll
            for (int c = 0; c < 4; ++c) o[c] = cvtpk(bflo(qraw[ks][c]) * QSCALE, bfhi(qraw[ks][c]) * QSCALE);
            qf[ks] = __builtin_bit_cast(bf16x8, o); }
    }
    float gc, gs, gw;
    { const unsigned short* gp = P.hb + (size_t)tok * 3072 + 2816 + head * 3;
      gc = 1.f / (1.f + __expf(-__uint_as_float((unsigned)gp[0] << 16))); gs = 1.f / (1.f + __expf(-__uint_as_float((unsigned)gp[1] << 16))); gw = 1.f / (1.f + __expf(-__uint_as_float((unsigned)gp[2] << 16))); }
    asm volatile("s_waitcnt vmcnt(0)" ::: "memory"); __builtin_amdgcn_s_barrier();
    const int cmax = (t >= 31) ? (((t - 31) >> 4) < 254 ? ((t - 31) >> 4) : 254) : -1;
    float m = NEGBIG, l = 0.f;
    f32x16 of0, of1;
#pragma unroll
    for (int i = 0; i < 16; ++i) { of0[i] = 0.f; of1[i] = 0.f; }
    const bool need_sel = qb >= 16;
    float ow[32];
    float carry_in = 0.f;
#pragma unroll
    for (int T = 0; T < 4; ++T) {
        f32x16 s0, s1;
        qk_tile(lds + L_CK + T * 8192, qf, kofs, s0, s1);
        if (__ballot(cmax - 64 * T < 63) != 0ull) mask_tile<false>(s0, s1, cmax - 64 * T - 4 * h, 0);
        float mx = max3f(s0[0], s0[1], s0[2]);
#pragma unroll
        for (int i = 3; i < 15; i += 2) mx = max3f(mx, s0[i], s0[i + 1]);
        mx = max3f(mx, s0[15], s1[0]);
#pragma unroll
        for (int i = 1; i < 15; i += 2) mx = max3f(mx, s1[i], s1[i + 1]);
        mx = xhalf_max(fmaxf(mx, s1[15]));
        const float mn = fmaxf(m, mx), alpha = __builtin_amdgcn_exp2f(m - mn);
        m = mn;
        if (T > 0 && __ballot(alpha != 1.0f) != 0ull) {
#pragma unroll
            for (int i = 0; i < 16; ++i) { of0[i] *= alpha; of1[i] *= alpha; }
#pragma unroll
            for (int idx = 0; idx < 8 * T; ++idx) ow[idx] *= alpha;
            carry_in *= alpha;
        }
        float sum = 0.f;
#pragma unroll
        for (int i = 0; i < 16; ++i) { s0[i] = __builtin_amdgcn_exp2f(s0[i] - mn); s1[i] = __builtin_amdgcn_exp2f(s1[i] - mn); sum += s0[i] + s1[i]; }
        l = l * alpha + sum;
#pragma unroll
        for (int kt = 0; kt < 2; ++kt)
#pragma unroll
            for (int u = 0; u < 4; ++u) {
                const float p0 = kt ? s1[4 * u] : s0[4 * u], p1 = kt ? s1[4 * u + 1] : s0[4 * u + 1], p2 = kt ? s1[4 * u + 2] : s0[4 * u + 2], p3 = kt ? s1[4 * u + 3] : s0[4 * u + 3];
                const float x = xhalf(p3);
                const float own = 2.0f * ((p0 + p1) + p2) + p3;
                ow[8 * T + 4 * kt + u] = own + (h ? x : carry_in);
                carry_in = x;
            }
        pv_tile(lds + L_CV + T * 8192, vofs, s0, s1, of0, of1);
    }
    {
        const float lc = xhalf_sum(l);
        const float rinv = lc > 0.f ? 1.0f / lc : 0.f, gr = gc * rinv;
#pragma unroll
        for (int i = 0; i < 16; ++i) { of0[i] *= gr; of1[i] *= gr; }
        if (need_sel) {
#pragma unroll
            for (int idx = 0; idx < 32; ++idx) ow[idx] *= rinv;
        }
    }
    unsigned long long selmask = (qb >= 63) ? ~0ull : ((1ull << (qb + 1)) - 1ull);
    if (need_sel) {
        __builtin_amdgcn_s_barrier();
        NLAS float* imp = (NLAS float*)(lds + L_IMP) + qi * 64;
#pragma unroll 1
        for (int hh = 0; hh < 4; ++hh) {
            if ((wv >> 1) == hh) {
                if (hh == 0) {
#pragma unroll
                    for (int idx = 0; idx < 32; ++idx) imp[(2 * idx + h + qi) & 63] = ow[idx];
                } else {
#pragma unroll
                    for (int idx = 0; idx < 32; ++idx) imp[(2 * idx + h + qi) & 63] += ow[idx];
                }
            }
            asm volatile("s_waitcnt lgkmcnt(0)" ::: "memory"); __builtin_amdgcn_s_barrier();
        }
        NLAS unsigned long long* selm = (NLAS unsigned long long*)(lds + L_SELM);
        const unsigned long long forced = 1ull | (1ull << qb) | (1ull << (qb - 1));
        const bool cand = (lane >= 1) && (lane <= qb - 2);
#pragma unroll 1
        for (int rep_ = 0; rep_ < NSA_REP_RANK; ++rep_) {
            unsigned vb[8], thr[8];
#pragma unroll
            for (int qq = 0; qq < 8; ++qq) { const int q = 8 * wv + qq; const float v = ((NLAS float*)(lds + L_IMP))[q * 64 + ((lane + q) & 63)];
                vb[qq] = cand ? __float_as_uint(v) : 0u; thr[qq] = 0u; }
#pragma unroll 1
            for (int bit = 30; bit >= 0; --bit) {
                unsigned long long bm[8];
#pragma unroll
                for (int qq = 0; qq < 8; ++qq) bm[qq] = __builtin_amdgcn_ballot_w64(vb[qq] >= (thr[qq] | (1u << bit)));
#pragma unroll
                for (int qq = 0; qq < 8; ++qq) {
                    const int cnt = __builtin_popcount((unsigned)bm[qq]) + __builtin_popcount((unsigned)(bm[qq] >> 32));
                    thr[qq] = (cnt >= 13) ? (thr[qq] | (1u << bit)) : thr[qq];
                }
            }
#pragma unroll
            for (int qq = 0; qq < 8; ++qq) {
                unsigned long long sel = __ballot(cand && vb[qq] > thr[qq]);
                unsigned long long eq = __ballot(cand && vb[qq] == thr[qq]);
                int need = 13 - __popcll(sel);
#pragma unroll 1
                for (; need > 0; --need) { const unsigned long long low = eq & (~eq + 1ull); sel |= low; eq ^= low; }
                if (lane == 0) selm[8 * wv + qq] = sel | forced;
            }
        }
        asm volatile("s_waitcnt lgkmcnt(0)" ::: "memory"); __builtin_amdgcn_s_barrier();
        selmask = selm[qi];
    }
    {
        u32x4 qraw[4];
#pragma unroll
        for (int ks = 0; ks < 4; ++ks) qraw[ks] = *(const u32x4*)(qrow + 16 * ks + 8 * h);
        const float4* cp = (const float4*)(P.cosT + (size_t)tok * 32 + 8 * h); const float4* sp = (const float4*)(P.sinT + (size_t)tok * 32 + 8 * h);
#pragma unroll
        for (int ks = 0; ks < 2; ++ks) {
            const float4 c0 = cp[4 * ks], c1 = cp[4 * ks + 1], s0 = sp[4 * ks], s1 = sp[4 * ks + 1];
            const float cs[8] = {c0.x, c0.y, c0.z, c0.w, c1.x, c1.y, c1.z, c1.w}, sn[8] = {s0.x, s0.y, s0.z, s0.w, s1.x, s1.y, s1.z, s1.w};
            u32x4 oa, ob;
#pragma unroll
            for (int c = 0; c < 4; ++c) {
                const float a0 = bflo(qraw[ks][c]), a1 = bfhi(qraw[ks][c]), b0 = bflo(qraw[ks + 2][c]), b1 = bfhi(qraw[ks + 2][c]);
                oa[c] = cvtpk((a0 * cs[2 * c] - b0 * sn[2 * c]) * QSCALE, (a1 * cs[2 * c + 1] - b1 * sn[2 * c + 1]) * QSCALE);
                ob[c] = cvtpk((b0 * cs[2 * c] + a0 * sn[2 * c]) * QSCALE, (b1 * cs[2 * c + 1] + a1 * sn[2 * c + 1]) * QSCALE);
            }
            qf[ks] = __builtin_bit_cast(bf16x8, oa); qf[ks + 2] = __builtin_bit_cast(bf16x8, ob);
        }
    }
    asm volatile("s_waitcnt vmcnt(0)" ::: "memory");
    f32x16 o0, o1;
    const bool lead = wv < 4;
    const float gs_keep = gs, gw_keep = gw;
#pragma unroll 1
    for (int repL = 0; repL < NSA_REP_LOOP; ++repL) {
    if (NSA_REP_LOOP > 1) { gs = (repL == NSA_REP_LOOP - 1) ? gs_keep : 0.f; gw = (repL == NSA_REP_LOOP - 1) ? gw_keep : 0.f;
        if (repL > 0) { asm volatile("s_waitcnt vmcnt(0)" ::: "memory"); __builtin_amdgcn_s_barrier(); NSA_ISSUE(0); NSA_ISSUE(1); asm volatile("s_waitcnt vmcnt(0)" ::: "memory"); } }
#pragma unroll
    for (int i = 0; i < 16; ++i) { o0[i] = 0.f; o1[i] = 0.f; }
    m = NEGBIG; l = 0.f;
    if (!lead) { asm volatile("s_waitcnt vmcnt(2)" ::: "memory"); __builtin_amdgcn_s_barrier(); }
#pragma unroll 1
    for (int pos = 0; pos < ntiles; ++pos) {
        if (lead) asm volatile("s_waitcnt vmcnt(2)" ::: "memory");
        __builtin_amdgcn_s_barrier();
        NSA_ISSUE(pos + 2);
        const NLAS unsigned char* slot = lds + L_RING + (pos & 3) * SLOTB;
        f32x16 s0, s1;
        const bool win = pos >= nsel; const int j = win ? jw0 + pos - nsel : pos;
        const bool live = win || ((selmask >> j) & 1ull);
        qk_tile(slot, qf, kofs, s0, s1);
        if (j == qb) mask_tile<false>(s0, s1, qi - 4 * h, 0);
        else if (win && qb >= 8 && j == qb - 8) mask_tile<true>(s0, s1, 63, qi + 1 - 4 * h);
        softmax_core(s0, s1, m, l, o0, o1, live);
        if (!lead) asm volatile("s_waitcnt vmcnt(2)" ::: "memory");
        __builtin_amdgcn_s_barrier();
        pv_tile(slot + 8192, vofs, s0, s1, o0, o1);
        if (pos == nsel - 1) {
            const float L = xhalf_sum(l); const float sc = (L > 0.f) ? gs / L : 0.f;
#pragma unroll
            for (int i = 0; i < 16; ++i) { of0[i] += sc * o0[i]; of1[i] += sc * o1[i]; o0[i] = 0.f; o1[i] = 0.f; }
            m = NEGBIG; l = 0.f;
        }
    }
    if (lead) __builtin_amdgcn_s_barrier();
    if (NSA_REP_LOOP > 1 && repL < NSA_REP_LOOP - 1) {
        const float L0 = l + xhalf(l); (void)L0; }
    if (repL == NSA_REP_LOOP - 1)    {
        float L = xhalf_sum(l);
        const float npad = (t < 511) ? (float)(511 - t) : 0.f;
        const float m2 = (npad > 0.f) ? fmaxf(m, 0.f) : m;
        const float a = __builtin_amdgcn_exp2f(m - m2);
        L = L * a + npad * __builtin_amdgcn_exp2f(-m2);
        const float sc = (L > 0.f) ? gw * a / L : 0.f;
#pragma unroll
        for (int i = 0; i < 16; ++i) { of0[i] += sc * o0[i]; of1[i] += sc * o1[i]; }
    }
    }
    float ss = 0.f;
#pragma unroll
    for (int i = 0; i < 16; ++i) ss += of0[i] * of0[i] + of1[i] * of1[i];
    ss = xhalf_sum(ss);
    const float rn = rsqrtf(ss * (1.0f / 64.0f) + 1e-6f);
    unsigned short* yrow = P.ycat + (size_t)tok * 1024 + 512 + head * 64;
    const float* nw = P.normw + head * 64;
    float4 w4a[2][4];
#pragma unroll
    for (int mb = 0; mb < 2; ++mb)
#pragma unroll
        for (int u = 0; u < 4; ++u) w4a[mb][u] = *(const float4*)(nw + 32 * mb + 8 * u + 4 * h);
#pragma unroll
    for (int mb = 0; mb < 2; ++mb)
#pragma unroll
        for (int u = 0; u < 4; ++u) {
            const int d0 = 32 * mb + 8 * u + 4 * h;
            const float4 w4 = w4a[mb][u];
            const float v0 = (mb ? of1[4 * u] : of0[4 * u]) * rn * w4.x, v1 = (mb ? of1[4 * u + 1] : of0[4 * u + 1]) * rn * w4.y;
            const float v2 = (mb ? of1[4 * u + 2] : of0[4 * u + 2]) * rn * w4.z, v3 = (mb ? of1[4 * u + 3] : of0[4 * u + 3]) * rn * w4.w;
#ifdef YCAT_F8
            *(unsigned*)((unsigned char*)P.ycat + (size_t)tok * 1024 + 512 + head * 64 + d0) = pg8::pk4_fp8_raw(v0, v1, v2, v3);
#else
            *(uint2*)(yrow + d0) = make_uint2(cvtpk(v0, v1), cvtpk(v2, v3));
#endif
        }
    asm volatile("s_waitcnt vmcnt(0)" ::: "memory"); __builtin_amdgcn_s_barrier();
#undef NSA_DMA
#undef NSA_ISSUE
}
__device__ __forceinline__ void phase(const Params& P, NLAS unsigned char* lds, const int tid, const int bid, const int G) {
#pragma unroll 1
    for (int vw = bid; vw < 256; vw += G) {
        const int xcd = vw & 7, slot = vw >> 3, bg = xcd * 2 + (slot >> 4), rr = slot & 15;
#pragma unroll 1
        for (int k = 0; k < 4; ++k) { const int qb = (k == 0) ? 63 - rr : (k == 1) ? 32 + rr : (k == 2) ? 31 - rr : rr; unit(P, lds, tid, bg >> 1, bg & 1, qb); }
    }
}
}


namespace wt {
typedef short bf16x8 __attribute__((ext_vector_type(8)));
typedef float f32x16 __attribute__((ext_vector_type(16)));
typedef unsigned u32x4 __attribute__((ext_vector_type(4)));
typedef unsigned u32x2 __attribute__((ext_vector_type(2)));
typedef float f32x2_t __attribute__((ext_vector_type(2)));
typedef __bf16 bf16x2_t __attribute__((ext_vector_type(2)));
#define WT_MFMA(a, b, c) __builtin_amdgcn_mfma_f32_32x32x16_bf16((a), (b), (c), 0, 0, 0)
__device__ __forceinline__ unsigned cvtpk(float lo, float hi) { f32x2_t v = {lo, hi}; bf16x2_t b = __builtin_convertvector(v, bf16x2_t); return __builtin_bit_cast(unsigned, b); }
__device__ __forceinline__ float bflo(unsigned u) { return __uint_as_float(u << 16); }
__device__ __forceinline__ float bfhi(unsigned u) { return __uint_as_float(u & 0xffff0000u); }
__device__ __forceinline__ float xhalf(float v) { return __shfl_xor(v, 32); }
__device__ __forceinline__ float xhalf_sum(float v) { const auto r = __builtin_amdgcn_permlane32_swap(__float_as_uint(v), __float_as_uint(v), false, false); return __uint_as_float(r[0]) + __uint_as_float(r[1]); }
__device__ __forceinline__ bf16x8 ld16(const unsigned short* p) { return __builtin_bit_cast(bf16x8, *(const u32x4*)p); }
__device__ __forceinline__ bf16x8 ld8x2(const unsigned short* p0, const unsigned short* p1) { const u32x2 a = *(const u32x2*)p0, b = *(const u32x2*)p1; u32x4 u = {a.x, a.y, b.x, b.y}; return __builtin_bit_cast(bf16x8, u); }
__device__ __forceinline__ bf16x8 pack8(const f32x16& x, int s) {
    u32x4 u = {cvtpk(x[8 * s], x[8 * s + 1]), cvtpk(x[8 * s + 2], x[8 * s + 3]), cvtpk(x[8 * s + 4], x[8 * s + 5]), cvtpk(x[8 * s + 6], x[8 * s + 7])};
    return __builtin_bit_cast(bf16x8, u);
}
__device__ __forceinline__ float gelu_t(float x) { const float u = 0.7978845608028654f * (x + 0.044715f * x * x * x); const float e = __expf(2.0f * u); return 0.5f * x * (1.0f + (1.0f - 2.0f / (e + 1.0f))); }
__device__ __forceinline__ float sigm(float x) { return 1.0f / (1.0f + __expf(-x)); }
__device__ __forceinline__ void zero(f32x16& a) {
#pragma unroll
    for (int i = 0; i < 16; ++i) a[i] = 0.f;
}

__device__ __forceinline__ void gm_ln8(const unsigned short* __restrict__ hb, const float* __restrict__ lw, const float* __restrict__ lbias, unsigned short* __restrict__ vlnT, int t8, int lane) {
    const int tok0 = t8 * 8;
    const float4 w4 = *(const float4*)(lw + lane * 4), b4 = *(const float4*)(lbias + lane * 4);
    float o[4][8];
#pragma unroll
    for (int i = 0; i < 8; ++i) {
        const u32x2 v4 = *(const u32x2*)(hb + (size_t)(tok0 + i) * 3072 + 1280 + lane * 4);
        float v[4] = {gelu_t(bflo(v4.x)), gelu_t(bfhi(v4.x)), gelu_t(bflo(v4.y)), gelu_t(bfhi(v4.y))};
        float s = (v[0] + v[1]) + (v[2] + v[3]);
#pragma unroll
        for (int o2 = 1; o2 < 64; o2 <<= 1) s += __shfl_xor(s, o2);
        const float mean = s * (1.0f / 256.0f); float q = 0.f;
#pragma unroll
        for (int c = 0; c < 4; ++c) { v[c] -= mean; q += v[c] * v[c]; }
#pragma unroll
        for (int o2 = 1; o2 < 64; o2 <<= 1) q += __shfl_xor(q, o2);
        const float rstd = rsqrtf(q * (1.0f / 256.0f) + 1e-5f);
        o[0][i] = v[0] * rstd * w4.x + b4.x; o[1][i] = v[1] * rstd * w4.y + b4.y; o[2][i] = v[2] * rstd * w4.z + b4.z; o[3][i] = v[3] * rstd * w4.w + b4.w;
    }
    const int bc = tok0 >> 7, s0 = tok0 & 127;
#pragma unroll
    for (int c = 0; c < 4; ++c) {
        const int ch = lane * 4 + c, g = ch >> 6, cc = ch & 63;
        u32x4 u = {cvtpk(o[c][0], o[c][1]), cvtpk(o[c][2], o[c][3]), cvtpk(o[c][4], o[c][5]), cvtpk(o[c][6], o[c][7])};
        *(u32x4*)(vlnT + ((size_t)(bc * 4 + g) * 64 + cc) * 128 + s0) = u;
    }
}
__device__ __forceinline__ void gm_sp_task(const unsigned short* __restrict__ hb, const unsigned short* __restrict__ vlnT, const unsigned short* __restrict__ Wb, const float* __restrict__ bs,
                                           const float* __restrict__ normw, unsigned short* __restrict__ ycat, int task, int lane) {
    const int tb = task & 3, g = (task >> 2) & 3, bc = task >> 4, r = lane & 31, h = lane >> 5;
    const unsigned short* ap = vlnT + ((size_t)(bc * 4 + g) * 64 + r) * 128 + 8 * h;
    const unsigned short* bp = Wb + ((size_t)g * 128 + 32 * tb + r) * 128 + 8 * h;
    f32x16 a0, a1; zero(a0); zero(a1);
    const u32x2 uu0 = *(const u32x2*)(hb + (size_t)(bc * 128 + 32 * tb + r) * 3072 + 1024 + g * 64 + 4 * h);
    asm volatile("" :: "v"(uu0));
#pragma unroll 1
    for (int kp = 0; kp <= tb; ++kp) {
        const bf16x8 bw0 = ld16(bp + 32 * kp), bw1 = ld16(bp + 32 * kp + 16);
        const bf16x8 v00 = ld16(ap + 32 * kp), v10 = ld16(ap + 32 * 128 + 32 * kp), v01 = ld16(ap + 32 * kp + 16), v11 = ld16(ap + 32 * 128 + 32 * kp + 16);
        a0 = WT_MFMA(v00, bw0, a0); a1 = WT_MFMA(v10, bw0, a1); a0 = WT_MFMA(v01, bw1, a0); a1 = WT_MFMA(v11, bw1, a1);
    }
    const int tl = 32 * tb + r, tok = bc * 128 + tl;
    const float bias = bs[g * 128 + tl];
    const unsigned short* up = hb + (size_t)tok * 3072 + 1024 + g * 64;
    float z[32]; float ss = 0.f;
#pragma unroll
    for (int cb = 0; cb < 2; ++cb)
#pragma unroll
        for (int u = 0; u < 4; ++u) {
            const int c0 = 32 * cb + 8 * u + 4 * h;
            const u32x2 uu = *(const u32x2*)(up + c0);
            const float uv[4] = {gelu_t(bflo(uu.x)), gelu_t(bfhi(uu.x)), gelu_t(bflo(uu.y)), gelu_t(bfhi(uu.y))};
#pragma unroll
            for (int k = 0; k < 4; ++k) { const float a = (cb ? a1[4 * u + k] : a0[4 * u + k]) + bias; const float zz = uv[k] * a; z[16 * cb + 4 * u + k] = zz; ss += zz * zz; }
        }
    ss = xhalf_sum(ss);
    const float rn = rsqrtf(ss * (1.0f / 64.0f) + 1e-6f);
    unsigned short* yp = ycat + (size_t)tok * 1024 + 256 + g * 64;
    const float* nw = normw + g * 64;
    float4 w4a[2][4];
#pragma unroll
    for (int cb = 0; cb < 2; ++cb)
#pragma unroll
        for (int u = 0; u < 4; ++u) w4a[cb][u] = *(const float4*)(nw + 32 * cb + 8 * u + 4 * h);
#pragma unroll
    for (int cb = 0; cb < 2; ++cb)
#pragma unroll
        for (int u = 0; u < 4; ++u) {
            const int c0 = 32 * cb + 8 * u + 4 * h;
            const float4 w4 = w4a[cb][u];
#ifdef YCAT_F8
            *(unsigned*)((unsigned char*)ycat + (size_t)tok * 1024 + 256 + g * 64 + c0) = pg8::pk4_fp8_raw(z[16 * cb + 4 * u] * rn * w4.x, z[16 * cb + 4 * u + 1] * rn * w4.y, z[16 * cb + 4 * u + 2] * rn * w4.z, z[16 * cb + 4 * u + 3] * rn * w4.w);
#else
            u32x2 o = {cvtpk(z[16 * cb + 4 * u] * rn * w4.x, z[16 * cb + 4 * u + 1] * rn * w4.y), cvtpk(z[16 * cb + 4 * u + 2] * rn * w4.z, z[16 * cb + 4 * u + 3] * rn * w4.w)};
            *(u32x2*)(yp + c0) = o;
#endif
        }
}

#define WT_LAS __attribute__((address_space(3)))
__device__ __forceinline__ void cmp_wg(const unsigned short* __restrict__ hb, const unsigned short* __restrict__ w1t, const float* __restrict__ cbias, const unsigned short* __restrict__ w2t,
                                       unsigned short* __restrict__ kcb, unsigned short* __restrict__ vcb, WT_LAS float* red, int task, int wave, int lane) {
    const int cblk = task & 7, kv = (task >> 3) & 1, g = (task >> 4) & 1, b = task >> 5, r = lane & 31, h = lane >> 5;
    const int c = 32 * cblk + r; const int cl = c < 254 ? c : 254;
    const unsigned short* bp = hb + (size_t)(b * 4096 + 16 * cl) * 3072 + (kv ? 2176 : 2048) + g * 64 + 8 * h;
    const unsigned short* ap = w1t + ((size_t)kv * 128 + r) * 2048 + 8 * h;
    f32x16 acc[4];
#pragma unroll
    for (int nt = 0; nt < 4; ++nt) zero(acc[nt]);
#pragma unroll 4
    for (int kk = 0; kk < 16; ++kk) {
        const int ks = 16 * wave + kk;
        const bf16x8 bk = ld16(bp + (size_t)(ks >> 2) * 3072 + 16 * (ks & 3));
#pragma unroll
        for (int nt = 0; nt < 4; ++nt) acc[nt] = WT_MFMA(ld16(ap + (size_t)nt * 32 * 2048 + 16 * ks), bk, acc[nt]);
    }
#pragma unroll
    for (int nt = 0; nt < 4; ++nt)
#pragma unroll
        for (int i = 0; i < 16; ++i) red[(wave * 64 + nt * 16 + i) * 64 + lane] = acc[nt][i];
    asm volatile("s_waitcnt lgkmcnt(0)" ::: "memory"); __builtin_amdgcn_s_barrier();
#pragma unroll
    for (int q = 0; q < 8; ++q) {
        const int row = 8 * wave + q; float sacc = 0.f;
#pragma unroll
        for (int w2 = 0; w2 < 8; ++w2) sacc += red[(w2 * 64 + row) * 64 + lane];
        red[row * 64 + lane] = sacc;
    }
    asm volatile("s_waitcnt lgkmcnt(0)" ::: "memory"); __builtin_amdgcn_s_barrier();
    if (wave == 0) {
#pragma unroll
        for (int nt = 0; nt < 4; ++nt)
#pragma unroll
            for (int i = 0; i < 16; ++i) { const int n = 32 * nt + (i & 3) + 8 * (i >> 2) + 4 * h; acc[nt][i] = gelu_t(red[(nt * 16 + i) * 64 + lane] + cbias[kv * 128 + n]); }
        f32x16 o0, o1; zero(o0); zero(o1);
        const unsigned short* w2p = w2t + ((size_t)kv * 64 + r) * 128 + 4 * h;
#pragma unroll
        for (int nt = 0; nt < 4; ++nt)
#pragma unroll
            for (int s = 0; s < 2; ++s) {
                const bf16x8 pb = pack8(acc[nt], s);
                const unsigned short* wp = w2p + 32 * nt + 16 * s;
                o0 = WT_MFMA(ld8x2(wp, wp + 8), pb, o0);
                o1 = WT_MFMA(ld8x2(wp + 32 * 128, wp + 32 * 128 + 8), pb, o1);
            }
        if (c < 255) {
            unsigned short* op = (kv ? vcb : kcb) + ((size_t)(b * 2 + g) * 256 + c) * 64;
#pragma unroll
            for (int db = 0; db < 2; ++db)
#pragma unroll
                for (int u = 0; u < 4; ++u) {
                    const int d0 = 32 * db + 8 * u + 4 * h;
                    u32x2 o = {cvtpk(db ? o1[4 * u] : o0[4 * u], db ? o1[4 * u + 1] : o0[4 * u + 1]), cvtpk(db ? o1[4 * u + 2] : o0[4 * u + 2], db ? o1[4 * u + 3] : o0[4 * u + 3])};
                    *(u32x2*)(op + d0) = o;
                }
        }
    }
    __builtin_amdgcn_s_barrier();
}

__device__ __forceinline__ void kvprep8(const unsigned short* __restrict__ hb, const float* __restrict__ cosT, const float* __restrict__ sinT,
                                        unsigned short* __restrict__ ksb, unsigned short* __restrict__ vsb, unsigned short* __restrict__ kwb, unsigned short* __restrict__ vwb, int idx) {
    const int j8 = idx & 3, g = (idx >> 2) & 1, tok = idx >> 3, b = tok >> 12, t = tok & 4095;
    const unsigned short* hr = hb + (size_t)tok * 3072 + g * 64 + 8 * j8;
    const float4 c0 = *(const float4*)(cosT + (size_t)tok * 32 + 8 * j8), c1 = *(const float4*)(cosT + (size_t)tok * 32 + 8 * j8 + 4);
    const float4 s0 = *(const float4*)(sinT + (size_t)tok * 32 + 8 * j8), s1 = *(const float4*)(sinT + (size_t)tok * 32 + 8 * j8 + 4);
    u32x4 ka[2], kb[2], va[2], vb[2];
#pragma unroll
    for (int w = 0; w < 2; ++w) { const int col = w ? 2560 : 2304, vcol = w ? 2688 : 2432;
        ka[w] = *(const u32x4*)(hr + col); kb[w] = *(const u32x4*)(hr + col + 32); va[w] = *(const u32x4*)(hr + vcol); vb[w] = *(const u32x4*)(hr + vcol + 32); }
    const float cs[8] = {c0.x, c0.y, c0.z, c0.w, c1.x, c1.y, c1.z, c1.w}, sn[8] = {s0.x, s0.y, s0.z, s0.w, s1.x, s1.y, s1.z, s1.w};
    const size_t o = ((size_t)(b * 2 + g) * 4096 + t) * 64 + 8 * j8;
#pragma unroll
    for (int w = 0; w < 2; ++w) {
        u32x4 oa, ob;
#pragma unroll
        for (int c = 0; c < 4; ++c) {
            const float a0 = bflo(ka[w][c]), a1 = bfhi(ka[w][c]), b0 = bflo(kb[w][c]), b1 = bfhi(kb[w][c]);
            oa[c] = cvtpk(a0 * cs[2 * c] - b0 * sn[2 * c], a1 * cs[2 * c + 1] - b1 * sn[2 * c + 1]);
            ob[c] = cvtpk(b0 * cs[2 * c] + a0 * sn[2 * c], b1 * cs[2 * c + 1] + a1 * sn[2 * c + 1]);
        }
        unsigned short* kd = (w ? kwb : ksb) + o;
        *(u32x4*)kd = oa; *(u32x4*)(kd + 32) = ob;
        unsigned short* vd = (w ? vwb : vsb) + o;
        *(u32x4*)vd = va[w]; *(u32x4*)(vd + 32) = vb[w];
    }
}

__device__ __forceinline__ void hg_pass1(const unsigned short* __restrict__ hb, const float* __restrict__ lbl, unsigned short* __restrict__ Qt, unsigned short* __restrict__ Kt,
                                         unsigned short* __restrict__ Qp, unsigned short* __restrict__ VT, float* __restrict__ Ut, float* __restrict__ Dk, int ci, int lane_in) {
    int lane = lane_in; asm volatile("" : "+v"(lane));
    const int chunk = ci & 63, hd = (ci >> 6) & 3, b = ci >> 8;
    const unsigned short* hp = hb + (size_t)(b * 4096 + chunk * 64) * 3072 + hd * 64 + lane;
    const float lb = lbl[hd * 64 + lane];
    unsigned fpk[32];
#pragma unroll
    for (int hb2 = 0; hb2 < 2; ++hb2) { unsigned short rf[32];
#pragma unroll
      for (int t = 0; t < 32; ++t) rf[t] = hp[(size_t)(32 * hb2 + t) * 3072 + 256];
#pragma unroll
      for (int t = 0; t < 16; ++t) fpk[16 * hb2 + t] = (unsigned)rf[2 * t] | ((unsigned)rf[2 * t + 1] << 16); }
    float run = 0.f, cmid = 0.f;
#pragma unroll
    for (int t = 0; t < 64; ++t) {
        const float fr = (t & 1) ? bfhi(fpk[t >> 1]) : bflo(fpk[t >> 1]);
        run += __logf(lb + (1.0f - lb) * sigm(fr));
        if (t == 31) cmid = run;
    }
    const float blast = run;
    unsigned short* qt = Qt + (size_t)ci * 4096 + lane; unsigned short* kt = Kt + (size_t)ci * 4096 + lane; unsigned short* qp = Qp + (size_t)ci * 4096 + lane;
    unsigned short* vt = VT + (size_t)ci * 4096 + lane * 64;
    const int h = lane >> 5, r = lane & 31;
    f32x16 acc[2][2];
#pragma unroll
    for (int a = 0; a < 2; ++a)
#pragma unroll
        for (int c = 0; c < 2; ++c) zero(acc[a][c]);
    float bt = 0.f;
    Dk[(size_t)ci * 64 + lane] = __expf(blast);
#pragma unroll 1
    for (int ks = 0; ks < 4; ++ks) {
        unsigned short rq[1][16], ri[1][16];
#pragma unroll
        for (int tt = 0; tt < 16; ++tt) { const size_t o = (size_t)(ks * 16 + tt) * 3072; rq[0][tt] = hp[o]; ri[0][tt] = hp[o + 512]; }
        unsigned kp[8], vp[8];
        unsigned fsel[8];
#pragma unroll
        for (int tp = 0; tp < 8; ++tp) fsel[tp] = (ks == 0) ? fpk[tp] : (ks == 1) ? fpk[8 + tp] : (ks == 2) ? fpk[16 + tp] : fpk[24 + tp];
#pragma unroll
        for (int tp = 0; tp < 8; ++tp) {
            float k2v[2], ivv[2];
#pragma unroll
            for (int e = 0; e < 2; ++e) {
                const int t = ks * 16 + tp * 2 + e;
                const float qr = __uint_as_float((unsigned)rq[0][tp * 2 + e] << 16), fr = e ? bfhi(fsel[tp]) : bflo(fsel[tp]);
                ivv[e] = __uint_as_float((unsigned)ri[0][tp * 2 + e] << 16);
                const float sf = sigm(fr);
                const float q = qr * sigm(qr), kk = (1.0f - lb) * (1.0f - sf);
                bt += __logf(lb + (1.0f - lb) * sf);
                qt[t * 64] = (unsigned short)(cvtpk(q * __expf(bt - cmid), 0.f) & 0xffffu);
                kt[t * 64] = (unsigned short)(cvtpk(kk * __expf(cmid - bt), 0.f) & 0xffffu);
                qp[t * 64] = (unsigned short)(cvtpk(q * __expf(bt), 0.f) & 0xffffu);
                k2v[e] = kk * __expf(blast - bt);
            }
            kp[tp] = cvtpk(k2v[0], k2v[1]); vp[tp] = cvtpk(ivv[0], ivv[1]);
        }
        { u32x4 u0 = {vp[0], vp[1], vp[2], vp[3]}, u1 = {vp[4], vp[5], vp[6], vp[7]};
          *(u32x4*)(vt + ks * 16) = u0; *(u32x4*)(vt + ks * 16 + 8) = u1; }
        u32x4 kown, vown, ksnd, vsnd;
#pragma unroll
        for (int j = 0; j < 4; ++j) { kown[j] = h ? kp[4 + j] : kp[j]; ksnd[j] = h ? kp[j] : kp[4 + j]; vown[j] = h ? vp[4 + j] : vp[j]; vsnd[j] = h ? vp[j] : vp[4 + j]; }
        u32x4 krcv, vrcv;
#pragma unroll
        for (int j = 0; j < 4; ++j) { krcv[j] = (unsigned)__shfl_xor((int)ksnd[j], 32); vrcv[j] = (unsigned)__shfl_xor((int)vsnd[j], 32); }
        const bf16x8 kb0 = __builtin_bit_cast(bf16x8, h ? krcv : kown), kb1 = __builtin_bit_cast(bf16x8, h ? kown : krcv);
        const bf16x8 va0 = __builtin_bit_cast(bf16x8, h ? vrcv : vown), va1 = __builtin_bit_cast(bf16x8, h ? vown : vrcv);
        acc[0][0] = WT_MFMA(va0, kb0, acc[0][0]); acc[0][1] = WT_MFMA(va0, kb1, acc[0][1]);
        acc[1][0] = WT_MFMA(va1, kb0, acc[1][0]); acc[1][1] = WT_MFMA(va1, kb1, acc[1][1]);
    }
    float* up = Ut + (size_t)ci * 4096;
#pragma unroll
    for (int vb = 0; vb < 2; ++vb)
#pragma unroll
        for (int kb = 0; kb < 2; ++kb)
#pragma unroll
            for (int i = 0; i < 16; ++i) { const int v = 32 * vb + (i & 3) + 8 * (i >> 2) + 4 * h; up[v * 64 + 32 * kb + r] = acc[vb][kb][i]; }
}
__device__ __forceinline__ void hg_scan(const float* __restrict__ Ut, const float* __restrict__ Dk, unsigned short* __restrict__ ST, int e) {
    const int k = e & 63, seq = e >> 12, vk = e & 4095;
    float S = 0.f;
    const float* up = Ut + (size_t)seq * 64 * 4096 + vk; const float* dp = Dk + (size_t)seq * 64 * 64 + k; unsigned short* sp = ST + (size_t)seq * 64 * 4096 + vk;
#pragma unroll 8
    for (int c = 0; c < 64; ++c) {
        sp[(size_t)c * 4096] = (unsigned short)(cvtpk(S, 0.f) & 0xffffu);
        S = fmaf(dp[c * 64], S, up[(size_t)c * 4096]);
    }
}
__device__ __forceinline__ void hg_pass3(const unsigned short* __restrict__ hb, const unsigned short* __restrict__ Qt, const unsigned short* __restrict__ Kt, const unsigned short* __restrict__ Qp,
                                         const unsigned short* __restrict__ VT, const unsigned short* __restrict__ ST, const float* __restrict__ normw, unsigned short* __restrict__ ycat, int task, int lane) {
    const int tblk = task & 1, ci = task >> 1, chunk = ci & 63, hd = (ci >> 6) & 3, b = ci >> 8, r = lane & 31, h = lane >> 5;
    const size_t cb = (size_t)ci * 4096;
    f32x16 o0, o1; zero(o0); zero(o1);
    {
        const unsigned short* sp = ST + cb + (size_t)r * 64 + 8 * h; const unsigned short* qp = Qp + cb + (size_t)(32 * tblk + r) * 64 + 8 * h;
#pragma unroll
        for (int ks = 0; ks < 4; ++ks) { const bf16x8 q = ld16(qp + 16 * ks); o0 = WT_MFMA(ld16(sp + 16 * ks), q, o0); o1 = WT_MFMA(ld16(sp + 32 * 64 + 16 * ks), q, o1); }
    }
    const unsigned short* qtp = Qt + cb + (size_t)(32 * tblk + r) * 64 + 8 * h;
    bf16x8 qf[4];
#pragma unroll
    for (int ks = 0; ks < 4; ++ks) qf[ks] = ld16(qtp + 16 * ks);
#pragma unroll 1
    for (int sblk = 0; sblk <= tblk; ++sblk) {
        f32x16 at; zero(at);
        const unsigned short* ktp = Kt + cb + (size_t)(32 * sblk + r) * 64 + 8 * h;
#pragma unroll
        for (int ks = 0; ks < 4; ++ks) at = WT_MFMA(ld16(ktp + 16 * ks), qf[ks], at);
        if (sblk == tblk) {
#pragma unroll
            for (int i = 0; i < 16; ++i) { const int sl = (i & 3) + 8 * (i >> 2) + 4 * h; at[i] = (sl <= r) ? at[i] : 0.f; }
        }
#pragma unroll
        for (int s2 = 0; s2 < 2; ++s2) {
            const bf16x8 pb = pack8(at, s2);
            const unsigned short* vp = VT + cb + (size_t)r * 64 + 32 * sblk + 16 * s2 + 4 * h;
            o0 = WT_MFMA(ld8x2(vp, vp + 8), pb, o0);
            o1 = WT_MFMA(ld8x2(vp + 32 * 64, vp + 32 * 64 + 8), pb, o1);
        }
    }
    const int tok = b * 4096 + chunk * 64 + 32 * tblk + r;
    float ss = 0.f;
#pragma unroll
    for (int i = 0; i < 16; ++i) ss += o0[i] * o0[i] + o1[i] * o1[i];
    ss = xhalf_sum(ss);
    const float rn = rsqrtf(ss * (1.0f / 64.0f) + 1e-6f);
    const unsigned short* gp = hb + (size_t)tok * 3072 + 768 + hd * 64;
    unsigned short* yp = ycat + (size_t)tok * 1024 + hd * 64;
    const float* nw = normw + hd * 64;
    u32x2 gg[2][4]; float4 w4[2][4];
#pragma unroll
    for (int vb = 0; vb < 2; ++vb)
#pragma unroll
        for (int u = 0; u < 4; ++u) { const int v0 = 32 * vb + 8 * u + 4 * h; gg[vb][u] = *(const u32x2*)(gp + v0); w4[vb][u] = *(const float4*)(nw + v0); }
#pragma unroll
    for (int vb = 0; vb < 2; ++vb)
#pragma unroll
        for (int u = 0; u < 4; ++u) {
            const int v0 = 32 * vb + 8 * u + 4 * h;
            const float x0 = (vb ? o1[4 * u] : o0[4 * u]) * rn * w4[vb][u].x * sigm(bflo(gg[vb][u].x)), x1 = (vb ? o1[4 * u + 1] : o0[4 * u + 1]) * rn * w4[vb][u].y * sigm(bfhi(gg[vb][u].x));
            const float x2 = (vb ? o1[4 * u + 2] : o0[4 * u + 2]) * rn * w4[vb][u].z * sigm(bflo(gg[vb][u].y)), x3 = (vb ? o1[4 * u + 3] : o0[4 * u + 3]) * rn * w4[vb][u].w * sigm(bfhi(gg[vb][u].y));
#ifdef YCAT_F8
            *(unsigned*)((unsigned char*)ycat + (size_t)tok * 1024 + hd * 64 + v0) = pg8::pk4_fp8_raw(x0, x1, x2, x3);
#else
            u32x2 o = {cvtpk(x0, x1), cvtpk(x2, x3)};
            *(u32x2*)(yp + v0) = o;
#endif
        }
}

__device__ __forceinline__ void route_task(const unsigned short* __restrict__ x1, const unsigned short* __restrict__ rwh, const unsigned short* __restrict__ rwl, const float* __restrict__ rb,
                                           int* __restrict__ cnt, int* __restrict__ list, int* __restrict__ tok_e, int* __restrict__ tok_slot, float* __restrict__ tok_w, int task, int lane) {
    const int r = lane & 31, h = lane >> 5, tok = task * 32 + r;
    const unsigned short* xp = x1 + (size_t)tok * 1024 + 8 * h;
    const unsigned short* whp = rwh + (size_t)r * 1024 + 8 * h; const unsigned short* wlp = rwl + (size_t)r * 1024 + 8 * h;
    f32x16 acc; zero(acc);
#pragma unroll 8
    for (int ks = 0; ks < 64; ++ks) {
        const bf16x8 xh = ld16(xp + 16 * ks);
        acc = WT_MFMA(ld16(whp + 16 * ks), xh, acc); acc = WT_MFMA(ld16(wlp + 16 * ks), xh, acc);
    }
    float v[16];
#pragma unroll
    for (int i = 0; i < 16; ++i) v[i] = acc[i] + rb[(i & 3) + 8 * (i >> 2) + 4 * h];
    float cv[8]; int ce[8];
#pragma unroll
    for (int k = 0; k < 4; ++k) {
        float best = -3.0e38f; int bi = 0;
#pragma unroll
        for (int i = 0; i < 16; ++i) { const bool ok = v[i] > best; best = ok ? v[i] : best; bi = ok ? i : bi; }
#pragma unroll
        for (int i = 0; i < 16; ++i) v[i] = (i == bi) ? -3.0e38f : v[i];
        cv[k] = best; ce[k] = (bi & 3) + 8 * (bi >> 2) + 4 * h;
    }
#pragma unroll
    for (int k = 0; k < 4; ++k) { cv[4 + k] = xhalf(cv[k]); ce[4 + k] = __shfl_xor(ce[k], 32); }
    float tl[4]; int te[4];
#pragma unroll
    for (int k = 0; k < 4; ++k) {
        float best = -3.0e38f; int be = 64, bj = 0;
#pragma unroll
        for (int j = 0; j < 8; ++j) { const bool ok = (cv[j] > best) || (cv[j] == best && ce[j] < be); best = ok ? cv[j] : best; be = ok ? ce[j] : be; bj = ok ? j : bj; }
#pragma unroll
        for (int j = 0; j < 8; ++j) cv[j] = (j == bj) ? -3.0e38f : cv[j];
        tl[k] = best; te[k] = be;
    }
    const float e1 = __expf(tl[1] - tl[0]), e2 = __expf(tl[2] - tl[0]), e3 = __expf(tl[3] - tl[0]);
    const float inv = 1.0f / (1.0f + e1 + e2 + e3);
    const float tw[4] = {inv, e1 * inv, e2 * inv, e3 * inv};
    unsigned mymask = 0u;
#pragma unroll 1
    for (int e = 0; e < 32; ++e) {
        const unsigned mk = (unsigned)__ballot(h == 0 && (te[0] == e || te[1] == e || te[2] == e || te[3] == e));
        mymask = (lane == e) ? mk : mymask;
    }
    int base = 0;
    if (lane < 32 && mymask != 0u) base = atomicAdd(&cnt[lane], __popc(mymask));
#pragma unroll
    for (int k = 0; k < 4; ++k) {
        const int bk = __shfl(base, te[k]); const unsigned mk = (unsigned)__shfl((int)mymask, te[k]);
        const int slot = bk + __popc(mk & ((1u << r) - 1u));
        if (h == 0) { list[te[k] * 32768 + slot] = tok; tok_e[tok * 4 + k] = te[k]; tok_slot[tok * 4 + k] = slot; tok_w[tok * 4 + k] = tw[k]; }
    }
}
}


__device__ __forceinline__ void bf8_to_f32(const uint4 u, float (&f)[8]) {
    f[0] = __uint_as_float(u.x << 16); f[1] = __uint_as_float(u.x & 0xffff0000u); f[2] = __uint_as_float(u.y << 16); f[3] = __uint_as_float(u.y & 0xffff0000u);
    f[4] = __uint_as_float(u.z << 16); f[5] = __uint_as_float(u.z & 0xffff0000u); f[6] = __uint_as_float(u.w << 16); f[7] = __uint_as_float(u.w & 0xffff0000u);
}
__device__ __forceinline__ void ln1_tok2(const float* __restrict__ xin_f, const bf16* __restrict__ xin_b, const bf16* __restrict__ mix, const float* __restrict__ lw, const float* __restrict__ lbias,
                                         bf16* __restrict__ x1b, unsigned char* __restrict__ x1q, int tok0, int lane) {
    float v[2][16]; float s[2] = {0.f, 0.f};
#pragma unroll
    for (int u = 0; u < 2; ++u)
#pragma unroll
        for (int jj = 0; jj < 2; ++jj) {
            const size_t o = (size_t)(tok0 + u) * D_ + jj * 512 + lane * 8;
            float a[8], mf[8];
            if (xin_f) { const float4 a0 = *(const float4*)(xin_f + o), a1 = *(const float4*)(xin_f + o + 4); a[0] = a0.x; a[1] = a0.y; a[2] = a0.z; a[3] = a0.w; a[4] = a1.x; a[5] = a1.y; a[6] = a1.z; a[7] = a1.w; }
            else bf8_to_f32(*(const uint4*)(xin_b + o), a);
            bf8_to_f32(*(const uint4*)(mix + o), mf);
#pragma unroll
            for (int c = 0; c < 8; ++c) { v[u][8 * jj + c] = ALPHA * a[c] + mf[c]; s[u] += v[u][8 * jj + c]; }
        }
    float rstd[2];
#pragma unroll
    for (int u = 0; u < 2; ++u) {
        const float mean = wsum(s[u]) * (1.0f / D_); float q = 0.f;
#pragma unroll
        for (int i = 0; i < 16; ++i) { v[u][i] -= mean; q += v[u][i] * v[u][i]; }
        rstd[u] = rsqrtf(wsum(q) * (1.0f / D_) + 1e-5f);
    }
    float4 w4a[4], b4a[4];
#pragma unroll
    for (int j = 0; j < 4; ++j) { w4a[j] = *(const float4*)(lw + (j >> 1) * 512 + lane * 8 + (j & 1) * 4); b4a[j] = *(const float4*)(lbias + (j >> 1) * 512 + lane * 8 + (j & 1) * 4); }
#pragma unroll
    for (int jj = 0; jj < 2; ++jj) {
        const float wv_[8] = {w4a[2 * jj].x, w4a[2 * jj].y, w4a[2 * jj].z, w4a[2 * jj].w, w4a[2 * jj + 1].x, w4a[2 * jj + 1].y, w4a[2 * jj + 1].z, w4a[2 * jj + 1].w};
        const float bv_[8] = {b4a[2 * jj].x, b4a[2 * jj].y, b4a[2 * jj].z, b4a[2 * jj].w, b4a[2 * jj + 1].x, b4a[2 * jj + 1].y, b4a[2 * jj + 1].z, b4a[2 * jj + 1].w};
#pragma unroll
        for (int u = 0; u < 2; ++u) {
            const size_t o = (size_t)(tok0 + u) * D_ + jj * 512 + lane * 8;
            float r[8];
#pragma unroll
            for (int c = 0; c < 8; ++c) r[c] = v[u][8 * jj + c] * rstd[u] * wv_[c] + bv_[c];
            *(uint4*)(x1b + o) = make_uint4(pk2(r[0], r[1]), pk2(r[2], r[3]), pk2(r[4], r[5]), pk2(r[6], r[7]));
            *(uint2*)(x1q + o) = make_uint2(pg8::pk4_fp8(r[0], r[1], r[2], r[3]), pg8::pk4_fp8(r[4], r[5], r[6], r[7]));
        }
    }
}
__device__ __forceinline__ void comb_ln2_tok2(const bf16* __restrict__ x1, const bf16* __restrict__ y, const int* __restrict__ offs, const int* __restrict__ tok_e,
                                              const int* __restrict__ tok_slot, const float* __restrict__ tok_w, const float* __restrict__ lw, const float* __restrict__ lbias,
                                              float* __restrict__ xout, bf16* __restrict__ xbout, unsigned char* __restrict__ xqout, int tok0, int lane, const int (&row)[2][4], const float (&wk)[2][4]) {
    float v[2][16];
#pragma unroll
    for (int u = 0; u < 2; ++u)
#pragma unroll
        for (int jj = 0; jj < 2; ++jj) { float a[8]; bf8_to_f32(*(const uint4*)(x1 + (size_t)(tok0 + u) * D_ + jj * 512 + lane * 8), a);
#pragma unroll
            for (int c = 0; c < 8; ++c) v[u][8 * jj + c] = ALPHA * a[c]; }
#pragma unroll
    for (int u = 0; u < 2; ++u)
#pragma unroll
        for (int k = 0; k < 4; ++k)
#pragma unroll
            for (int jj = 0; jj < 2; ++jj) { float a[8]; bf8_to_f32(*(const uint4*)(y + (size_t)row[u][k] * D_ + jj * 512 + lane * 8), a); const float w = wk[u][k];
#pragma unroll
                for (int c = 0; c < 8; ++c) v[u][8 * jj + c] = fmaf(w, a[c], v[u][8 * jj + c]); }
    float rstd[2];
#pragma unroll
    for (int u = 0; u < 2; ++u) {
        float s = 0.f;
#pragma unroll
        for (int i = 0; i < 16; ++i) s += v[u][i];
        const float mean = wsum(s) * (1.0f / D_); float q = 0.f;
#pragma unroll
        for (int i = 0; i < 16; ++i) { v[u][i] -= mean; q += v[u][i] * v[u][i]; }
        rstd[u] = rsqrtf(wsum(q) * (1.0f / D_) + 1e-5f);
    }
    float4 w4a[4], b4a[4];
#pragma unroll
    for (int j = 0; j < 4; ++j) { w4a[j] = *(const float4*)(lw + (j >> 1) * 512 + lane * 8 + (j & 1) * 4); b4a[j] = *(const float4*)(lbias + (j >> 1) * 512 + lane * 8 + (j & 1) * 4); }
#pragma unroll
    for (int jj = 0; jj < 2; ++jj) {
        const float wv_[8] = {w4a[2 * jj].x, w4a[2 * jj].y, w4a[2 * jj].z, w4a[2 * jj].w, w4a[2 * jj + 1].x, w4a[2 * jj + 1].y, w4a[2 * jj + 1].z, w4a[2 * jj + 1].w};
        const float bv_[8] = {b4a[2 * jj].x, b4a[2 * jj].y, b4a[2 * jj].z, b4a[2 * jj].w, b4a[2 * jj + 1].x, b4a[2 * jj + 1].y, b4a[2 * jj + 1].z, b4a[2 * jj + 1].w};
#pragma unroll
        for (int u = 0; u < 2; ++u) {
            const size_t o = (size_t)(tok0 + u) * D_ + jj * 512 + lane * 8;
            float r[8];
#pragma unroll
            for (int c = 0; c < 8; ++c) r[c] = v[u][8 * jj + c] * rstd[u] * wv_[c] + bv_[c];
            if (xout) { *(float4*)(xout + o) = make_float4(r[0], r[1], r[2], r[3]); *(float4*)(xout + o + 4) = make_float4(r[4], r[5], r[6], r[7]); }
            if (xbout) { *(uint4*)(xbout + o) = make_uint4(pk2(r[0], r[1]), pk2(r[2], r[3]), pk2(r[4], r[5]), pk2(r[6], r[7]));
                         *(uint2*)(xqout + o) = make_uint2(pg8::pk4_fp8(r[0], r[1], r[2], r[3]), pg8::pk4_fp8(r[4], r[5], r[6], r[7])); }
        }
    }
}

struct Args { const float* in[25]; float* out; unsigned char* ws; int ph_lo, ph_hi; };
#define PH __device__ __forceinline__
#ifndef WIN_SPLIT
#define WIN_SPLIT 12
#endif
constexpr int TAB_OFF = 131072;

__device__ __forceinline__ void transpose_item(const float* __restrict__ W, int K, int N, bf16* __restrict__ WT, int k0, int scol0, int drow0, float* scr, int lane) {
    const int cc = lane & 31; const bool cv = (scol0 + cc) < N;
#pragma unroll 8
    for (int i = 0; i < 32; ++i) { const int kk = 2 * i + (lane >> 5); scr[kk * 33 + cc] = cv ? W[(size_t)(k0 + kk) * N + scol0 + cc] : 0.f; }
    asm volatile("s_waitcnt lgkmcnt(0)" ::: "memory");
    const int c = lane & 7;
#pragma unroll
    for (int j = 0; j < 4; ++j) { const int n = (lane >> 3) + 8 * j; const float* s = scr + (8 * c) * 33 + n;
        uint4 o; o.x = pk2(s[0 * 33], s[1 * 33]); o.y = pk2(s[2 * 33], s[3 * 33]); o.z = pk2(s[4 * 33], s[5 * 33]); o.w = pk2(s[6 * 33], s[7 * 33]);
        *(uint4*)(WT + (size_t)(drow0 + n) * K + k0 + 8 * c) = o; }
    asm volatile("s_waitcnt lgkmcnt(0)" ::: "memory");
}
__device__ __forceinline__ void transpose64(const float* __restrict__ W, int K, int N, bf16* __restrict__ WT, int k0, int scol0, int drow0, int lane) {
    const int q = lane >> 4, c = lane & 15;
    const bool cv = (scol0 + 4 * c) < N;
    const float* src = W + (size_t)(k0 + 16 * q) * N + scol0 + 4 * c;
    float4 v[16];
#pragma unroll
    for (int i = 0; i < 16; ++i) v[i] = cv ? *(const float4*)(src + (size_t)i * N) : make_float4(0.f, 0.f, 0.f, 0.f);
    bf16* dst = WT + (size_t)(drow0 + 4 * c) * K + k0 + 16 * q;
#pragma unroll
    for (int j = 0; j < 4; ++j) {
        float e[16];
#pragma unroll
        for (int i = 0; i < 16; ++i) e[i] = (j == 0) ? v[i].x : (j == 1) ? v[i].y : (j == 2) ? v[i].z : v[i].w;
        uint4 o0, o1;
        o0.x = pk2(e[0], e[1]); o0.y = pk2(e[2], e[3]); o0.z = pk2(e[4], e[5]); o0.w = pk2(e[6], e[7]);
        o1.x = pk2(e[8], e[9]); o1.y = pk2(e[10], e[11]); o1.z = pk2(e[12], e[13]); o1.w = pk2(e[14], e[15]);
        *(uint4*)(dst + (size_t)j * K) = o0; *(uint4*)(dst + (size_t)j * K + 8) = o1;
    }
}
struct T64Item { const float* src; unsigned char* dst; };
__device__ __forceinline__ void t64_load(const float* src, int N, float4 (&v)[16]) {
#pragma unroll
    for (int i = 0; i < 16; ++i) { typedef float f4v __attribute__((ext_vector_type(4))); const f4v t = __builtin_nontemporal_load((const f4v*)(src + (size_t)i * N)); v[i] = make_float4(t.x, t.y, t.z, t.w); }
}
__device__ __forceinline__ unsigned pk4_fp8_nc(float a, float b, float c, float d) { int p = __builtin_amdgcn_cvt_pk_fp8_f32(a, b, 0, false); p = __builtin_amdgcn_cvt_pk_fp8_f32(c, d, p, true); return (unsigned)p; }
__device__ __forceinline__ void t64_store_f8(unsigned char* dst, int K, float sc, const float4 (&v)[16]) {
#pragma unroll
    for (int j = 0; j < 4; ++j) {
        float e[16];
#pragma unroll
        for (int i = 0; i < 16; ++i) e[i] = sc * ((j == 0) ? v[i].x : (j == 1) ? v[i].y : (j == 2) ? v[i].z : v[i].w);
        uint4 o;
        o.x = pk4_fp8_nc(e[0], e[1], e[2], e[3]); o.y = pk4_fp8_nc(e[4], e[5], e[6], e[7]); o.z = pk4_fp8_nc(e[8], e[9], e[10], e[11]); o.w = pk4_fp8_nc(e[12], e[13], e[14], e[15]);
        *(uint4*)(dst + (size_t)j * K) = o;
    }
}
__device__ __forceinline__ void transpose64_f8(const float* __restrict__ W, int K, int N, unsigned char* __restrict__ WT, int k0, int scol0, int drow0, int lane, float sc) {
    const int q = lane >> 4, c = lane & 15;
    const bool cv = (scol0 + 4 * c) < N;
    const float* src = W + (size_t)(k0 + 16 * q) * N + scol0 + 4 * c;
    float4 v[16];
#pragma unroll
    for (int i = 0; i < 16; ++i) v[i] = cv ? *(const float4*)(src + (size_t)i * N) : make_float4(0.f, 0.f, 0.f, 0.f);
    t64_store_f8(WT + (size_t)(drow0 + 4 * c) * K + k0 + 16 * q, K, sc, v);
}
__device__ __forceinline__ void t64_item(int it, const float* w_up, const float* w_dn, unsigned char* wt_up, unsigned char* wt_dn, int lane, const float*& src, unsigned char*& dst, int& N, float& sc) {
    constexpr int I_UP = 16 * 32, I_DN = 16 * 16;
    const int q = lane >> 4, c = lane & 15;
#ifdef CONV_KBFAST
    if (it < NE * I_UP) { const int e = it / I_UP, r = it % I_UP, kb = r % 16, nb = r / 16;
#else
    if (it < NE * I_UP) { const int e = it / I_UP, r = it % I_UP, kb = r / 32, nb = r % 32;
#endif
        const int n0 = nb * 64, pn = n0 >> 8, bj = (n0 >> 7) & 1, jj = n0 & 127;
        src = w_up + (size_t)e * D_ * 2048 + (size_t)(kb * 64 + 16 * q) * 2048 + bj * 1024 + 128 * pn + jj + 4 * c;
        dst = wt_up + (size_t)e * 2048 * D_ + (size_t)(n0 + 4 * c) * D_ + kb * 64 + 16 * q; N = 2048; sc = pg8::F8_SU; }
#ifdef CONV_KBFAST
    else { const int r0 = it - NE * I_UP; const int e = r0 / I_DN, r = r0 % I_DN, kb = r % 16, nb = r / 16;
#else
    else { const int r0 = it - NE * I_UP; const int e = r0 / I_DN, r = r0 % I_DN, kb = r / 16, nb = r % 16;
#endif
        src = w_dn + (size_t)e * D_ * D_ + (size_t)(kb * 64 + 16 * q) * D_ + nb * 64 + 4 * c;
        dst = wt_dn + (size_t)e * D_ * D_ + (size_t)(nb * 64 + 4 * c) * D_ + kb * 64 + 16 * q; N = D_; sc = pg8::F8_SD; }
}
#ifdef CONV_R32
__device__ __forceinline__ void t64_item_r32(int it, const float* w_up, const float* w_dn, unsigned char* wt_up, unsigned char* wt_dn, int lane, const float*& src, unsigned char*& dst, int& N, float& sc) {
    constexpr int I_UP = 32 * 16, I_DN = 32 * 8;
    const int q = lane >> 5, c = lane & 31;
    if (it < NE * I_UP) { const int e = it / I_UP, r = it % I_UP, kb = r / 16, nb = r % 16;
        const int n0 = nb * 128, pn = n0 >> 8, bj = (n0 >> 7) & 1;
        src = w_up + (size_t)e * D_ * 2048 + (size_t)(kb * 32 + 16 * q) * 2048 + bj * 1024 + 128 * pn + 4 * c;
        dst = wt_up + (size_t)e * 2048 * D_ + (size_t)(n0 + 4 * c) * D_ + kb * 32 + 16 * q; N = 2048; sc = pg8::F8_SU; }
    else { const int r0 = it - NE * I_UP; const int e = r0 / I_DN, r = r0 % I_DN, kb = r / 8, nb = r % 8;
        src = w_dn + (size_t)e * D_ * D_ + (size_t)(kb * 32 + 16 * q) * D_ + nb * 128 + 4 * c;
        dst = wt_dn + (size_t)e * D_ * D_ + (size_t)(nb * 128 + 4 * c) * D_ + kb * 32 + 16 * q; N = D_; sc = pg8::F8_SD; }
}
#define t64_item t64_item_r32
#endif
#ifdef CONV_R8
__device__ __forceinline__ void t64_item_r8(int it, const float* w_up, const float* w_dn, unsigned char* wt_up, unsigned char* wt_dn, int lane, const float*& src, unsigned char*& dst, int& N, float& sc) {
    constexpr int I_UP = 8 * 64, I_DN = 8 * 32;
    const int q = lane >> 3, c = lane & 7;
    if (it < NE * I_UP) { const int e = it / I_UP, r = it % I_UP, kb = r / 64, nb = r % 64;
        const int n0 = nb * 32, pn = n0 >> 8, bj = (n0 >> 7) & 1, jj = n0 & 127;
        src = w_up + (size_t)e * D_ * 2048 + (size_t)(kb * 128 + 16 * q) * 2048 + bj * 1024 + 128 * pn + jj + 4 * c;
        dst = wt_up + (size_t)e * 2048 * D_ + (size_t)(n0 + 4 * c) * D_ + kb * 128 + 16 * q; N = 2048; sc = pg8::F8_SU; }
    else { const int r0 = it - NE * I_UP; const int e = r0 / I_DN, r = r0 % I_DN, kb = r / 32, nb = r % 32;
        src = w_dn + (size_t)e * D_ * D_ + (size_t)(kb * 128 + 16 * q) * D_ + nb * 32 + 4 * c;
        dst = wt_dn + (size_t)e * D_ * D_ + (size_t)(nb * 32 + 4 * c) * D_ + kb * 128 + 16 * q; N = D_; sc = pg8::F8_SD; }
}
#define t64_item t64_item_r8
#endif
PH void ph_prologue(int wv, const int* pos, const float* hg_lb, float* cosT, float* sinT, float* lb,
                    const float* x, bf16* xb, unsigned char* xq, const float* w_in, const float* w_out, const float* w_up, const float* w_dn, bf16* wt_in, unsigned char* wt_in8, bf16* wt_out, bf16* wt_up, bf16* wt_dn,
                    const float* gm_sw, bf16* wb, const float* cpe, const float* cw1, bf16* w1t, float* cbias, const float* cw2, bf16* w2t, const float* rw, bf16* rwh, bf16* rwl) {
    extern __shared__ __attribute__((aligned(16))) unsigned char lds[];
    int tid = mk_tid(wv), bid = blockIdx.x; asm volatile("" : "+v"(tid), "+s"(bid)); const int G = gridDim.x, lane = tid & 63, wave = wv;
#pragma unroll 1
    for (int i0 = bid * NTHR + tid; i0 < NT * 32; i0 += 4 * G * NTHR) {
        int pv[4];
#pragma unroll
        for (int u = 0; u < 4; ++u) { const int i = i0 + u * G * NTHR; pv[u] = (i < NT * 32) ? pos[i >> 5] : 0; }
#pragma unroll
        for (int u = 0; u < 4; ++u) { const int i = i0 + u * G * NTHR; if (i < NT * 32) { const int j = i & 31;
            float inv = (float)pow(10000.0, -(double)(2 * j) / 64.0);
            float ang = (float)pv[u] * inv;
            const double ad = (double)ang, kk = rint(ad * 0.15915494309189535);
            const float rf = (float)fma(-kk, 6.283185307179586, ad);
            cosT[i] = cosf(rf); sinT[i] = sinf(rf); } }
    }
    if (bid == 0 && tid < 256) {
        float p0 = hg_lb[tid], p1 = hg_lb[256 + tid];
        float m = fmaxf(p0, p1); float ea = expf(p0 - m), eb = expf(p1 - m);
        lb[tid] = 0.f; lb[256 + tid] = eb / (ea + eb);
    }
    {
        const size_t n4 = (size_t)NT * D_ / 4, stride = (size_t)G * NTHR;
#pragma unroll 1
        for (size_t i = (size_t)bid * NTHR + tid; i < n4; i += 8 * stride) {
            float4 v[8];
#pragma unroll
            for (int u = 0; u < 8; ++u) { const size_t j = i + u * stride; v[u] = (j < n4) ? ((const float4*)x)[j] : make_float4(0.f, 0.f, 0.f, 0.f); }
#pragma unroll
            for (int u = 0; u < 8; ++u) { const size_t j = i + u * stride; if (j < n4) { ((unsigned*)xq)[j] = pg8::pk4_fp8(v[u].x, v[u].y, v[u].z, v[u].w); if (WIN_SPLIT < HS / 256) ((uint2*)xb)[j] = make_uint2(pk2(v[u].x, v[u].y), pk2(v[u].z, v[u].w)); } }
        }
    }
#pragma unroll 1
    for (int i = bid * NTHR + tid; i < DEPTH * NE * D_; i += G * NTHR) { const int k = i & 1023, e = (i >> 10) & 31, l = i >> 15; const float w = rw[((size_t)l * D_ + k) * NE + e];
        const unsigned hi = f2bf(w); rwh[i] = (bf16)hi; rwl[i] = (bf16)f2bf(w - __uint_as_float(hi << 16)); }
#pragma unroll 1
    for (int i = bid * NTHR + tid; i < DEPTH * 4 * 128 * 128; i += G * NTHR) { const int s = i & 127, t = (i >> 7) & 127; wb[i] = (bf16)f2bf(s <= t ? gm_sw[i] : 0.f); }
    {
        const int gwv = bid * 8 + wave, NGWV = G * 8;
#pragma unroll 1
        for (int o = gwv; o < DEPTH * 2 * 128; o += NGWV) {
            const int lk = o >> 7, n = o & 127;
            float a = 0.f;
#pragma unroll 8
            for (int i = lane; i < 2048; i += 64) a = fmaf(cpe[lk * 2048 + i], cw1[((size_t)lk * 2048 + i) * 128 + n], a);
            a = wsum(a);
            if (lane == 0) cbias[o] = a;
        }
    }
    float* scr = (float*)(lds + wave * 16384);
    const int gw = bid * 8 + wave, NGW = G * 8;
    constexpr int I_IN = 16 * 45, I_OUT = 16 * 16;
    constexpr int I_C1 = 32 * 4;
    constexpr int I_C2 = 2 * 2;
    constexpr int PER_L = I_IN + I_OUT + 2 * I_C1 + 2 * I_C2;
#pragma unroll 1
    for (int it = gw; it < DEPTH * PER_L; it += NGW) {
        const int l = it / PER_L; int r = it % PER_L;
        if (r < I_IN) { const int kb = r / 45, nb = r % 45;
            if (nb < WIN_SPLIT * 4) transpose64_f8(w_in + (size_t)l * D_ * INW, D_, INW, wt_in8 + (size_t)l * HS * D_, kb * 64, nb * 64, nb * 64, lane, pg8::F8_SI);
            else transpose64(w_in + (size_t)l * D_ * INW, D_, INW, wt_in + (size_t)l * HS * D_, kb * 64, nb * 64, nb * 64, lane);
            continue; }
        r -= I_IN;
        if (r < I_OUT) { const int kb = r / 16, nb = r % 16;
#ifdef YCAT_F8
            transpose64_f8(w_out + (size_t)l * D_ * D_, D_, D_, (unsigned char*)wt_out + (size_t)l * D_ * D_, kb * 64, nb * 64, nb * 64, lane, pg8::F8_SO);
#else
            transpose64(w_out + (size_t)l * D_ * D_, D_, D_, wt_out + (size_t)l * D_ * D_, kb * 64, nb * 64, nb * 64, lane);
#endif
            continue; }
        r -= I_OUT;
        if (r < 2 * I_C1) { const int kv = r / I_C1, q = r % I_C1, kb = q / 4, nb = q % 4;
            transpose_item(cw1 + ((size_t)l * 2 + kv) * 2048 * 128, 2048, 128, w1t + ((size_t)l * 2 + kv) * 128 * 2048, kb * 64, nb * 32, nb * 32, scr, lane); continue; }
        r -= 2 * I_C1;
        { const int kv = r / I_C2, q = r % I_C2, kb = q / 2, nb = q % 2;
            transpose_item(cw2 + ((size_t)l * 2 + kv) * 128 * 64, 128, 64, w2t + ((size_t)l * 2 + kv) * 64 * 128, kb * 64, nb * 32, nb * 32, scr, lane); }
    }
}
constexpr int CONV_NIT = NE * (16 * 32 + 16 * 16);
#ifndef CONV_C1
#define CONV_C1 (NE * 16 * 32)
#endif
__device__ __forceinline__ void conv_items(int lo, int hi, int gw, int NGW, int lane, const float* w_up, const float* w_dn, unsigned char* wt_up, unsigned char* wt_dn) {
    int ln = lane; asm volatile("" : "+v"(ln));
#pragma unroll 1
    for (int it = lo + gw; it < hi; it += 2 * NGW) {
        float4 va[16], vb[16]; const float* s0; unsigned char* d0; int n0_; float c0_; const float* s1; unsigned char* d1; int n1_; float c1_;
        const int it1 = (it + NGW < hi) ? it + NGW : it;
        t64_item(it, w_up, w_dn, wt_up, wt_dn, ln, s0, d0, n0_, c0_); t64_item(it1, w_up, w_dn, wt_up, wt_dn, ln, s1, d1, n1_, c1_);
        t64_load(s0, n0_, va); t64_load(s1, n1_, vb);
        t64_store_f8(d0, D_, c0_, va); t64_store_f8(d1, D_, c1_, vb);
    }
}
#define M1EN(x) ((MM & (x)) != 0)
#ifndef M1REP
#define M1R(x) 1
#else
#define M1R(x) (((x) == M1REP) ? 3 : 1)
#endif
template <int MM = 31> PH void ph_mix1(int wv, const bf16* hb, const float* lb, bf16* hqt, bf16* hkt, bf16* hqp, bf16* hvt, float* hut, float* hdk,
                const float* glw, const float* glb, bf16* vlnT, const bf16* w1t, const float* cbias, const bf16* w2, bf16* kcb, bf16* vcb,
                const float* cosT, const float* sinT, bf16* ksb, bf16* vsb, bf16* kwb, bf16* vwb,
                const float* w_up, const float* w_dn, unsigned char* wt_up, unsigned char* wt_dn) {
    extern __shared__ __attribute__((aligned(16))) unsigned char lds[];
    int tid = mk_tid(wv), bid = blockIdx.x; asm volatile("" : "+v"(tid), "+s"(bid)); const int lane = tid & 63, wave = wv, G = gridDim.x;
    const int gw = bid * 8 + wave, NGW = G * 8;
    { int ln = lane; asm volatile("" : "+v"(ln));
#pragma unroll 1
    for (int rp = 0; rp < M1R(1); ++rp)
#pragma unroll 1
    for (int u = bid; u < 256 && M1EN(1); u += G) wt::cmp_wg(hb, w1t, cbias, w2, kcb, vcb, (WT_LAS float*)lds, u, wave, ln); }
#pragma unroll 1
    for (int pass = 0; pass < 2; ++pass) {
#ifdef M1_SEQ
        if (pass == 0) {
#else
        if (((pass ^ wave) & 1) == 0) {
#endif
            { int ln = lane; asm volatile("" : "+v"(ln));
#pragma unroll 1
            for (int rp = 0; rp < M1R(2); ++rp)
#pragma unroll 1
            for (int u = gw; u < 2048 && M1EN(2); u += NGW) wt::hg_pass1(hb, lb, hqt, hkt, hqp, hvt, hut, hdk, u, ln); }
            { int ln = lane; asm volatile("" : "+v"(ln));
#pragma unroll 1
            for (int rp = 0; rp < M1R(4); ++rp)
#pragma unroll 1
            for (int u = gw; u < NT / 8 && M1EN(4); u += NGW) wt::gm_ln8(hb, glw, glb, vlnT, u, ln); }
            { int t_ = tid; asm volatile("" : "+v"(t_));
#pragma unroll 1
            for (int rp = 0; rp < M1R(8); ++rp)
#pragma unroll 1
            for (int idx = bid * NTHR + t_; idx < NT * 8 && M1EN(8); idx += G * NTHR) wt::kvprep8(hb, cosT, sinT, ksb, vsb, kwb, vwb, idx); }
        } else {
            int ln = lane; asm volatile("" : "+v"(ln));
            constexpr int NIT = NE * (16 * 32 + 16 * 16);
            if (M1EN(16)) conv_items(0, CONV_C1, gw, NGW, ln, w_up, w_dn, wt_up, wt_dn);
            if (MM & 64) {
#pragma unroll 1
                for (int it = gw; it < NIT; it += NGW) {
                    float4 va[16]; const float* s0; unsigned char* d0; int n0_; float c0_;
                    t64_item(it, w_up, w_dn, wt_up, wt_dn, ln, s0, d0, n0_, c0_);
                    d0 = wt_up + ((size_t)1 << 30) + (size_t)it * 4096 + ln * 16;
                    t64_load(s0, n0_, va); t64_store_f8(d0, 1024, c0_, va);
                }
            }
            if (MM & 128) {
#pragma unroll 1
                for (int it = gw; it < NIT; it += NGW) {
                    float4 va[16]; const float* s0; unsigned char* d0; int n0_; float c0_;
                    t64_item(it, w_up, w_dn, wt_up, wt_dn, ln, s0, d0, n0_, c0_);
                    s0 = (it < NE * 512) ? w_up + (size_t)it * 4096 + ln * 4 : w_dn + (size_t)(it - NE * 512) * 4096 + ln * 4;
                    d0 += ((size_t)1 << 30);
                    t64_load(s0, 256, va); t64_store_f8(d0, D_, c0_, va);
                }
            }
            if (MM & 256) {
#pragma unroll 1
                for (int it = gw; it < NIT; it += NGW) {
                    float4 va[16];
                    const float* s0; int n0_;
                    if (it < NE * 512) { const int e = it / 512, r = it % 512, kb = r / 8, nb = r % 8; s0 = w_up + (size_t)e * D_ * 2048 + (size_t)(kb * 16) * 2048 + nb * 256 + ln * 4; n0_ = 2048; }
                    else { const int r0 = it - NE * 512; const int e = r0 / 256, r = r0 % 256, kb = r / 4, nb = r % 4; s0 = w_dn + (size_t)e * D_ * D_ + (size_t)(kb * 16) * D_ + nb * 256 + ln * 4; n0_ = D_; }
                    unsigned char* d0 = wt_up + ((size_t)1 << 30) + (size_t)it * 4096 + ln * 16;
                    t64_load(s0, n0_, va); t64_store_f8(d0, 1024, 64.f, va);
                }
            }
            if (MM & 512) {
#pragma unroll 1
                for (int it = gw; it < NIT; it += NGW) {
                    float4 va[16];
                    const float* s0; int n0_;
                    if (it < NE * 512) { const int e = it / 512, r = it % 512, kb = r / 2, nb = r % 2; s0 = w_up + (size_t)e * D_ * 2048 + (size_t)(kb * 4) * 2048 + nb * 1024 + ln * 4; n0_ = 2048; }
                    else { const int r0 = it - NE * 512; const int e = r0 / 256, r = r0 % 256; s0 = w_dn + (size_t)e * D_ * D_ + (size_t)(r * 4) * D_ + ln * 4; n0_ = D_; }
#pragma unroll
                    for (int i = 0; i < 16; ++i) { typedef float f4v __attribute__((ext_vector_type(4))); const f4v t = __builtin_nontemporal_load((const f4v*)(s0 + (size_t)(i >> 2) * n0_ + (i & 3) * 256)); va[i] = make_float4(t.x, t.y, t.z, t.w); }
                    unsigned char* d0 = wt_up + ((size_t)1 << 30) + (size_t)it * 4096 + ln * 16;
                    t64_store_f8(d0, 1024, 64.f, va);
                }
            }
            if (MM & 1024) {
                const unsigned lbase = (unsigned)(size_t)lds + (unsigned)wave * 16384u;
                LAS const unsigned char* lrd = (LAS const unsigned char*)lds + wave * 16384 + ln * 16;
#pragma unroll 1
                for (int it = gw; it < NIT; it += NGW) {
                    float4 va[16]; const float* s0; unsigned char* d0; int n0_; float c0_;
                    t64_item(it, w_up, w_dn, wt_up, wt_dn, ln, s0, d0, n0_, c0_);
#pragma unroll
                    for (int i = 0; i < 16; ++i) { unsigned _keep; const void* _g = (const void*)(s0 + (size_t)i * n0_); const unsigned _d = (unsigned)__builtin_amdgcn_readfirstlane((int)(lbase + i * 1024));
                        asm volatile("s_mov_b32 %0, m0\n\ts_mov_b32 m0, %2\n\ts_nop 0\n\tglobal_load_lds_dwordx4 %1, off\n\ts_mov_b32 m0, %0" : "=&s"(_keep) : "v"(_g), "s"(_d) : "memory"); }
                    asm volatile("s_waitcnt vmcnt(0)" ::: "memory");
#pragma unroll
                    for (int i = 0; i < 16; ++i) { typedef float f4v __attribute__((ext_vector_type(4))); const f4v t = *(LAS const f4v*)(lrd + i * 1024); va[i] = make_float4(t.x, t.y, t.z, t.w); }
                    t64_store_f8(d0, D_, c0_, va);
                }
            }
            if (MM & 2048) {
#pragma unroll 1
                for (int it = gw; it < NIT; it += 2 * NGW) {
                    float4 va[16], vb[16]; const float* s0; unsigned char* d0; int n0_; float c0_; const float* s1; unsigned char* d1; int n1_; float c1_;
                    const int it1 = (it + NGW < NIT) ? it + NGW : it;
                    t64_item(it, w_up, w_dn, wt_up, wt_dn, ln, s0, d0, n0_, c0_); t64_item(it1, w_up, w_dn, wt_up, wt_dn, ln, s1, d1, n1_, c1_);
                    t64_load(s0, n0_, va); t64_load(s1, n1_, vb);
                    t64_store_f8(d0, D_, c0_, va); t64_store_f8(d1, D_, c1_, vb);
                }
            }
            if (MM & 32) {
#pragma unroll 1
                for (int it = gw; it < NIT; it += NGW) {
                    float4 va[16];
                    const float* s0 = (it < NE * 512) ? w_up + (size_t)it * 4096 + ln * 4 : w_dn + (size_t)(it - NE * 512) * 4096 + ln * 4;
                    unsigned char* d0 = wt_up + ((size_t)1 << 30) + (size_t)it * 4096 + ln * 16;
                    t64_load(s0, 256, va); t64_store_f8(d0, 1024, 64.f, va);
                }
            }
        }
    }
}
PH void ph_mix2(int wv, const float* hut, const float* hdk, bf16* hst, const bf16* hb, const bf16* vlnT, const bf16* wb, const float* sb, const float* nw, bf16* ycat,
                const float* w_up, const float* w_dn, unsigned char* wt_up, unsigned char* wt_dn) {
    int tid = mk_tid(wv), bid = blockIdx.x; asm volatile("" : "+v"(tid), "+s"(bid)); const int lane = tid & 63, wave = wv, G = gridDim.x;
    const int gw = bid * 8 + wave, NGW = G * 8;
#pragma unroll 1
    for (int pass = 0; pass < 2; ++pass) {
        if (((pass ^ wave) & 1) == 0) {
            int t_ = tid; asm volatile("" : "+v"(t_));
#pragma unroll 1
            for (int e = bid * NTHR + t_; e < 32 * 4096; e += G * NTHR) wt::hg_scan(hut, hdk, hst, e);
            int ln = t_ & 63; asm volatile("" : "+v"(ln));
#pragma unroll 1
            for (int u = gw; u < 4096; u += NGW) wt::gm_sp_task(hb, vlnT, wb, sb, nw, ycat, u, ln);
        } else {
            conv_items(CONV_C1, CONV_NIT, gw, NGW, lane, w_up, w_dn, wt_up, wt_dn);
        }
    }
}
PH void ph_hg3(int wv, const bf16* hb, const bf16* hqt, const bf16* hkt, const bf16* hqp, const bf16* hvt, const bf16* hst, const float* nw, bf16* ycat) {
    int tid = mk_tid(wv), bid = blockIdx.x; asm volatile("" : "+v"(tid), "+s"(bid)); const int lane = tid & 63, wave = wv, G = gridDim.x;
    const int gw = bid * 8 + wave, NGW = G * 8;
#pragma unroll 1
    for (int u = gw; u < 4096; u += NGW) wt::hg_pass3(hb, hqt, hkt, hqp, hvt, hst, nw, ycat, u, lane);
}
PH void ph_ln1_route(int wv, const float* xin_f, const bf16* xin_b, const bf16* mix, const float* lw, const float* lb, bf16* x1b, unsigned char* x1q,
                     const bf16* rwh, const bf16* rwl, const float* rb, int* cnt, int* list, int* tok_e, int* tok_slot, float* tok_w) {
    int tid = mk_tid(wv), bid = blockIdx.x; asm volatile("" : "+v"(tid), "+s"(bid)); const int lane = tid & 63, wave = wv, G = gridDim.x;
#pragma unroll 1
    for (int it = bid; it < NT / 128; it += G) {
        { int ln = lane; asm volatile("" : "+v"(ln));
#pragma unroll 1
          for (int k = 0; k < 8; ++k) ln1_tok2(xin_f, xin_b, mix, lw, lb, x1b, x1q, it * 128 + wave * 16 + 2 * k, ln); }
        asm volatile("s_waitcnt vmcnt(0)" ::: "memory"); __builtin_amdgcn_fence(__ATOMIC_RELEASE, "workgroup"); __syncthreads(); __builtin_amdgcn_fence(__ATOMIC_ACQUIRE, "workgroup");
        if (wave < 4) { int ln = lane; asm volatile("" : "+v"(ln)); wt::route_task(x1b, rwh, rwl, rb, cnt, list, tok_e, tok_slot, tok_w, it * 4 + wave, ln); }
    }
}
PH void ph_comb(int wv, const bf16* x1, const bf16* ybuf, const int* tok_e, const int* tok_slot, const float* tok_w, const float* lw, const float* lb, float* xo, bf16* xbo, unsigned char* xqo) {
    extern __shared__ __attribute__((aligned(16))) unsigned char lds[];
    const int* offs_s = (const int*)(lds + TAB_OFF + 512);
    int tid = mk_tid(wv), bid = blockIdx.x; asm volatile("" : "+v"(tid), "+s"(bid)); const int lane = tid & 63, wave = wv, G = gridDim.x;
#pragma unroll 1
    for (int t0 = (bid * 8 + wave) * 16; t0 < NT; t0 += G * 128) {
        const int ia = t0 * 4 + lane;
        const int rowl = offs_s[tok_e[ia]] + tok_slot[ia]; const float wl = tok_w[ia];
#pragma unroll 1
        for (int p = 0; p < 8; ++p) {
            int row[2][4]; float wk[2][4];
#pragma unroll
            for (int u = 0; u < 2; ++u)
#pragma unroll
                for (int k = 0; k < 4; ++k) { row[u][k] = __shfl(rowl, p * 8 + u * 4 + k); wk[u][k] = __shfl(wl, p * 8 + u * 4 + k); }
            comb_ln2_tok2(x1, ybuf, offs_s, tok_e, tok_slot, tok_w, lw, lb, xo, xbo, xqo, t0 + 2 * p, lane, row, wk);
        }
    }
}

typedef const Args __attribute__((address_space(4))) CArgs;
#define PHASE_BEGIN CArgs* ap = (CArgs*)__builtin_amdgcn_kernarg_segment_ptr(); int l_ = l; asm volatile("" : "+s"(ap), "+s"(l_)); unsigned char* const ws_ = ap->ws; \
    const int G = gridDim.x; int bid = blockIdx.x; asm volatile("" : "+s"(bid));
#define WP(T, off) ((T*)(ws_ + (off)))
#define INP(k) (ap->in[k])
__global__ void __launch_bounds__(NTHR, 2) mega(Args a) {
    extern __shared__ __attribute__((aligned(16))) unsigned char lds[];
    volatile LAS unsigned* MISC = (volatile LAS unsigned*)((LAS unsigned char*)lds + MISC_OFF);
    int wv = __builtin_amdgcn_readfirstlane((int)threadIdx.x >> 6); asm volatile("" : "+s"(wv));
    { const int t0 = mk_tid(wv); if (t0 < 64) MISC[t0] = 0u; }
    __syncthreads();
    XcdBarrier bar = xcd_barrier_post((unsigned*)a.ws, MISC + 8, wv);
    int* tstart = (int*)(lds + TAB_OFF); int* cnts = (int*)(lds + TAB_OFF + 256); int* offs_s = (int*)(lds + TAB_OFF + 512);
    PG8_LAS unsigned char* ldsl = (PG8_LAS unsigned char*)lds;

#ifndef PH_MASK
#define EN(n) 1
#else
#define EN(n) ((PH_MASK >> ((n) % 20)) & 1)
#endif
#define IN(k) 1
#ifndef REP_PH
#define REPL(id)
#else
#define REPL(id) _Pragma("unroll 1") for (int rep_ = 0; rep_ < (((id) == REP_PH) ? REP_N : 1); ++rep_)
#endif
#define SEAM(k) xcd_barrier(bar)

    REPL(19) if (EN(19) && IN(0)) { const int l = 0; PHASE_BEGIN; (void)l_; (void)G; (void)bid;
        ph_prologue(wv, (const int*)INP(1), INP(3), WP(float, O_COS), WP(float, O_SIN), WP(float, O_LB), INP(0), WP(bf16, O_XB), WP(unsigned char, O_X1Q), INP(2), INP(14), INP(19), INP(21),
                    WP(bf16, O_WIN), WP(unsigned char, O_WIN8), WP(bf16, O_WOUT), WP(bf16, O_WUP), WP(bf16, O_WDN), INP(7), WP(bf16, O_WB), INP(10), INP(11), WP(bf16, O_W1T), WP(float, O_CBIAS), INP(12), WP(bf16, O_W2T), INP(17), WP(bf16, O_RWH), WP(bf16, O_RWL)); }
    xcd_barrier_first(bar);

#pragma unroll 1
    for (int l = 0; l < DEPTH; ++l) {
        REPL(0) if (EN(0) && IN(pb + 0)) {
            PHASE_BEGIN;
            if (WIN_SPLIT > 0) {
                pg8::PlainOrder S{WP(unsigned char, O_WIN8) + (size_t)l_ * HS * D_, D_, NT / 256, WIN_SPLIT, G, bid, 0};
                pg8::EpiBf16 E{WP(bf16, O_HB), HS, nullptr, 0, 1.0f / pg8::F8_SI};
                pg8::gemm_phase<pg8::EpiBf16, pg8::PlainOrder, true, true>(wv, ldsl, WP(unsigned char, O_X1Q), D_, S, E);
            }
            if (WIN_SPLIT < HS / 256) {
                pg8::PlainOrder S{WP(bf16, O_WIN) + (size_t)l_ * HS * D_, D_ * 2, NT / 256, HS / 256 - WIN_SPLIT, G, bid, WIN_SPLIT};
                pg8::EpiBf16 E{WP(bf16, O_HB), HS, nullptr, 0, 1.0f};
                pg8::gemm_phase<pg8::EpiBf16, pg8::PlainOrder, true>(wv, ldsl, WP(bf16, O_XB), D_ * 2, S, E);
            }
        }
        SEAM(pb + 0);
        REPL(1) if (EN(1)) {
            PHASE_BEGIN; (void)G; (void)bid;
            ph_mix1(wv, WP(bf16, O_HB), WP(float, O_LB) + l_ * 256, WP(bf16, O_HQT), WP(bf16, O_HKT), WP(bf16, O_HQP), WP(bf16, O_HVT), WP(float, O_HUT), WP(float, O_HDK),
                    INP(5) + l_ * 256, INP(6) + l_ * 256, WP(bf16, O_VLNT), WP(bf16, O_W1T) + (size_t)l_ * 2 * 128 * 2048, WP(float, O_CBIAS) + l_ * 256, WP(bf16, O_W2T) + (size_t)l_ * 2 * 64 * 128,
                    WP(bf16, O_KCB), WP(bf16, O_VCB), WP(float, O_COS), WP(float, O_SIN), WP(bf16, O_KSB), WP(bf16, O_VSB), WP(bf16, O_KWB), WP(bf16, O_VWB),
                    INP(19) + (size_t)l_ * NE * D_ * 2048, INP(21) + (size_t)l_ * NE * D_ * D_, WP(unsigned char, O_WUP) + (size_t)l_ * NE * 2048 * D_, WP(unsigned char, O_WDN) + (size_t)l_ * NE * D_ * D_);
        }
        SEAM(pb + 1);
#ifdef DUP_MIX1
        {
            PHASE_BEGIN; (void)G; (void)bid;
            ph_mix1<DUP_MIX1>(wv, WP(bf16, O_HB), WP(float, O_LB) + l_ * 256, WP(bf16, O_HQT), WP(bf16, O_HKT), WP(bf16, O_HQP), WP(bf16, O_HVT), WP(float, O_HUT), WP(float, O_HDK),
                    INP(5) + l_ * 256, INP(6) + l_ * 256, WP(bf16, O_VLNT), WP(bf16, O_W1T) + (size_t)l_ * 2 * 128 * 2048, WP(float, O_CBIAS) + l_ * 256, WP(bf16, O_W2T) + (size_t)l_ * 2 * 64 * 128,
                    WP(bf16, O_KCB), WP(bf16, O_VCB), WP(float, O_COS), WP(float, O_SIN), WP(bf16, O_KSB), WP(bf16, O_VSB), WP(bf16, O_KWB), WP(bf16, O_VWB),
                    INP(19) + (size_t)l_ * NE * D_ * 2048, INP(21) + (size_t)l_ * NE * D_ * D_, WP(unsigned char, O_WUP) + (size_t)l_ * NE * 2048 * D_, WP(unsigned char, O_WDN) + (size_t)l_ * NE * D_ * D_);
        }
        SEAM(pb + 1);
#endif
        REPL(11) if (EN(11)) {
            PHASE_BEGIN; (void)G; (void)bid;
            ph_mix2(wv, WP(float, O_HUT), WP(float, O_HDK), WP(bf16, O_HST), WP(bf16, O_HB), WP(bf16, O_VLNT), WP(bf16, O_WB) + (size_t)l_ * 4 * 128 * 128, INP(8) + l_ * 512, INP(9) + l_ * 256, WP(bf16, O_YCAT),
                    INP(19) + (size_t)l_ * NE * D_ * 2048, INP(21) + (size_t)l_ * NE * D_ * D_, WP(unsigned char, O_WUP) + (size_t)l_ * NE * 2048 * D_, WP(unsigned char, O_WDN) + (size_t)l_ * NE * D_ * D_);
        }
        SEAM(pb + 1);
        {
            PHASE_BEGIN;
            REPL(2) if (EN(2)) ph_hg3(wv, WP(bf16, O_HB), WP(bf16, O_HQT), WP(bf16, O_HKT), WP(bf16, O_HQP), WP(bf16, O_HVT), WP(bf16, O_HST), INP(4) + l_ * 256, WP(bf16, O_YCAT));
            REPL(12) if (EN(12)) {
                nsa::Params NP{WP(bf16, O_HB), WP(bf16, O_KCB), WP(bf16, O_VCB), WP(bf16, O_KSB), WP(bf16, O_VSB), WP(bf16, O_KWB), WP(bf16, O_VWB), WP(float, O_COS), WP(float, O_SIN), INP(13) + l_ * 512, WP(bf16, O_YCAT)};
                int tid = mk_tid(wv); asm volatile("" : "+v"(tid));
                __syncthreads();
                nsa::phase(NP, ldsl, tid, bid, G);
            }
        }
        SEAM(pb + 2);
        REPL(3) if (EN(3) && IN(pb + 3)) {
            PHASE_BEGIN;
#ifdef YCAT_F8
            pg8::PlainOrder S{WP(unsigned char, O_WOUT) + (size_t)l_ * D_ * D_, D_, NT / 256, D_ / 256, G, bid, 0};
            pg8::EpiBf16 E{WP(bf16, O_MIXB), D_, nullptr, 0, 1.0f / pg8::F8_SO};
            pg8::gemm_phase<pg8::EpiBf16, pg8::PlainOrder, true, true>(wv, ldsl, WP(unsigned char, O_YCAT), D_, S, E);
#else
            pg8::PlainOrder S{WP(bf16, O_WOUT) + (size_t)l_ * D_ * D_, D_ * 2, NT / 256, D_ / 256, G, bid, 0};
            pg8::EpiBf16 E{WP(bf16, O_MIXB), D_, nullptr, 0, 1.0f};
            pg8::gemm_phase<pg8::EpiBf16, pg8::PlainOrder, true>(wv, ldsl, WP(bf16, O_YCAT), D_ * 2, S, E);
#endif
#ifdef DUP_WOUT
            pg8::gemm_phase<pg8::EpiBf16, pg8::PlainOrder, true>(wv, ldsl, WP(bf16, O_YCAT), D_ * 2, S, E);
#endif
        }
        SEAM(pb + 3);
        if (EN(4)) {
            PHASE_BEGIN; (void)G; (void)bid;
            ph_ln1_route(wv, l_ == 0 ? INP(0) : (const float*)nullptr, WP(bf16, O_XB), WP(bf16, O_MIXB), INP(15) + l_ * D_, INP(16) + l_ * D_, WP(bf16, O_X1B), WP(unsigned char, O_X1Q),
                         WP(bf16, O_RWH) + (size_t)l_ * NE * D_, WP(bf16, O_RWL) + (size_t)l_ * NE * D_, INP(18) + l_ * NE,
                         (int*)(ws_ + 32768) + l_ * 64, WP(int, O_LIST), WP(int, O_TE), WP(int, O_TS), WP(float, O_TW));
        }
        SEAM(pb + 4);
        if (IN(pb + 5) || IN(pb + 6) || IN(pb + 7)) {
            PHASE_BEGIN; (void)G; (void)bid;
            int* cnt = (int*)(ws_ + 32768) + l_ * 64;
            __syncthreads();
            if (wv == 0) {
                const int ln = mk_tid(wv) & 63, e = ln & 31;
                const int c = __hip_atomic_load(&cnt[e], __ATOMIC_RELAXED, __HIP_MEMORY_SCOPE_AGENT);
                const int nt_ = (c + 255) >> 8; int incl = nt_;
#pragma unroll
                for (int o = 1; o < 32; o <<= 1) { const int v = __shfl_up(incl, o, 32); if (e >= o) incl += v; }
                if (ln < 32) { tstart[e] = incl - nt_; offs_s[e] = (incl - nt_) * 256; cnts[e] = c; if (e == 31) tstart[32] = incl; }
            }
            __syncthreads();
        }
        REPL(5) if (EN(5) && IN(pb + 5)) {
            PHASE_BEGIN;
            pg8::MoeOrder<true> S{WP(unsigned char, O_WUP) + (size_t)l_ * NE * 2048 * D_, D_, 8, G, bid, (size_t)2048 * D_, tstart, cnts, WP(int, O_LIST)};
            pg8::EpiUpF8 E{WP(unsigned char, O_ACT), INP(20) + (size_t)l_ * NE * 2048};
            pg8::gemm_phase<pg8::EpiUpF8, pg8::MoeOrder<true>, true, true>(wv, ldsl, WP(unsigned char, O_X1Q), D_, S, E);
        }
        SEAM(pb + 5);
        REPL(6) if (EN(6) && IN(pb + 6)) {
            PHASE_BEGIN;
            pg8::MoeOrder<false> S{WP(unsigned char, O_WDN) + (size_t)l_ * NE * D_ * D_, D_, 4, G, bid, (size_t)D_ * D_, tstart, cnts, WP(int, O_LIST)};
            pg8::EpiDnF8 E{WP(bf16, O_YB), INP(22) + (size_t)l_ * NE * D_};
            pg8::gemm_phase<pg8::EpiDnF8, pg8::MoeOrder<false>, true, true>(wv, ldsl, WP(unsigned char, O_ACT), D_, S, E);
        }
        SEAM(pb + 6);
        REPL(7) if (EN(7) && IN(pb + 7)) {
            PHASE_BEGIN; (void)G; (void)bid;
            ph_comb(wv, WP(bf16, O_X1B), WP(bf16, O_YB), WP(int, O_TE), WP(int, O_TS), WP(float, O_TW), INP(23) + l_ * D_, INP(24) + l_ * D_,
                    (l_ == DEPTH - 1) ? ap->out : (float*)nullptr, (l_ == DEPTH - 1) ? (bf16*)nullptr : WP(bf16, O_XB), WP(unsigned char, O_X1Q));
        }
#ifdef XTRA_BAR
#pragma unroll 1
        for (int xb_ = 0; xb_ < XTRA_BAR; ++xb_) SEAM(pb + 7);
#endif
        if (l + 1 < DEPTH) SEAM(pb + 7);
    }
#undef IN
#undef SEAM
}
}

extern "C" void kernel_launch(void* const* d_in, const int* in_sizes, int n_in, void* d_out, int out_size, void* d_ws, size_t ws_size, hipStream_t stream) {
    using namespace mk;
    static int grid = 0;
    if (grid == 0) {
        size_t need = WS_NEED;
        if (n_in != 25 || need > ws_size) { fprintf(stderr, "kernel_launch: bad args n_in %d need %zu ws %zu\n", n_in, need, ws_size); grid = -1; return; }
        int dev = 0, cus = 0, per_cu = 0;
        if (hipGetDevice(&dev) != hipSuccess || hipDeviceGetAttribute(&cus, hipDeviceAttributeMultiprocessorCount, dev) != hipSuccess) { grid = -1; return; }
        if (hipFuncSetAttribute((const void*)mega, hipFuncAttributeMaxDynamicSharedMemorySize, LDS_BYTES) != hipSuccess) { fprintf(stderr, "hipFuncSetAttribute failed\n"); grid = -1; return; }
        if (hipOccupancyMaxActiveBlocksPerMultiprocessor(&per_cu, (const void*)mega, NTHR, LDS_BYTES) != hipSuccess || per_cu < 1) fprintf(stderr, "occupancy query: %d\n", per_cu);
        (void)hipGetLastError();
        grid = cus;
    }
    if (grid < 0) return;
    if (hipMemsetAsync(d_ws, 0, CTL_BYTES, stream) != hipSuccess) return;
    Args a{};
    for (int i = 0; i < 25; ++i) a.in[i] = (const float*)d_in[i];
    a.out = (float*)d_out; a.ws = (unsigned char*)d_ws; a.ph_lo = 0; a.ph_hi = 1 + DEPTH * NPH;
    hipLaunchKernelGGL(mega, dim3(grid), dim3(NTHR), LDS_BYTES, stream, a);
}
```
